# Optimizing an MI355X kernel written in HIP

```python
import math
import jax, jax.numpy as jnp
from jax import lax
import numpy as np

D_MODEL = 1024
BATCH = 16
SEQ = 256
DEPTH = 2
DEC_BATCH = 4
DEC_SEQ = 1024
PAST_LEN = 512

GRID_W = 64
MIX_W = D_MODEL // 2
N_RET_HEADS = 4
RET_DK = MIX_W // N_RET_HEADS
RET_DV = MIX_W // N_RET_HEADS
RET_CHUNK = 128
SSM_CH = MIX_W
SSM_GROUP = 16
SSM_GROUPS = SSM_CH // SSM_GROUP
SSM_STATE = 64
NA_HEADS = 8
NA_HEAD_DIM = MIX_W // NA_HEADS
NA_KR = 8
NA_KW = 16
N_BRANCH = 3
D_FF = ((8 * D_MODEL // 3 + 127) // 128) * 128
ROPE_BASE = 10000.0
LN_EPS = 1e-5
NEG_INF = -1e30
DEEPNORM_ALPHA = (2 * DEPTH) ** 0.25
DEEPNORM_BETA = (8 * DEPTH) ** -0.25
IN_SPLITS = (MIX_W, MIX_W, MIX_W, MIX_W, SSM_CH, MIX_W, MIX_W, MIX_W, N_BRANCH * D_MODEL)
IN_COLS = sum(IN_SPLITS)

kernel_name = 'hybrid_diffusion_retention_s5_natten_step'


def _layer_norm(x, g, b):
    xf = x.astype(jnp.float32)
    mu = jnp.mean(xf, -1, keepdims=True)
    var = jnp.mean(jnp.square(xf - mu), -1, keepdims=True)
    return ((xf - mu) * lax.rsqrt(var + LN_EPS) * g.astype(jnp.float32) + b.astype(jnp.float32)).astype(x.dtype)


def _head_norm(o):
    mu = jnp.mean(o, -1, keepdims=True)
    var = jnp.mean(jnp.square(o - mu), -1, keepdims=True)
    return (o - mu) * lax.rsqrt(var + LN_EPS)


def _ada(cond, w_ada, b_ada):
    p = jax.nn.silu(cond) @ w_ada + b_ada
    return jnp.split(p[:, None, :], 6, axis=-1)


def _split_in(h, w_in):
    z = h @ w_in
    cuts = [int(o) for o in np.cumsum(IN_SPLITS)[:-1]]
    return jnp.split(z, cuts, axis=-1)


def _axial_rope(x):
    B, L, H, Dh = x.shape
    pos = jnp.arange(L)
    row = (pos // GRID_W).astype(jnp.float32)
    col = (pos % GRID_W).astype(jnp.float32)
    half = Dh // 2
    quarter = half // 2
    inv_freq = ROPE_BASE ** (-jnp.arange(quarter, dtype=jnp.float32) / quarter)

    def rot(xa, p):
        ang = p[:, None] * inv_freq[None, :]
        cos = jnp.cos(ang)[None, :, None, :]
        sin = jnp.sin(ang)[None, :, None, :]
        x1, x2 = xa[..., :quarter], xa[..., quarter:]
        return jnp.concatenate([x1 * cos - x2 * sin, x1 * sin + x2 * cos], -1)

    xf = x.astype(jnp.float32)
    return jnp.concatenate([rot(xf[..., :half], row), rot(xf[..., half:], col)], -1)


def _retention_scan(q, k, v, s0, log_gamma):
    B, L, H, DK = q.shape
    DV = v.shape[-1]
    C = RET_CHUNK
    n = L // C
    idx = jnp.arange(C, dtype=jnp.float32)
    diff = idx[:, None] - idx[None, :]
    inner_decay = jnp.where(diff >= 0, jnp.exp(log_gamma[:, None, None] * jnp.maximum(diff, 0.0)), 0.0)
    q_decay = jnp.exp(log_gamma[:, None] * (idx + 1.0)).T[None, :, :, None]
    k_decay = jnp.exp(log_gamma[:, None] * (C - 1.0 - idx)).T[None, :, :, None]
    chunk_decay = jnp.exp(log_gamma * C)[None, :, None, None]
    qc = q.reshape(B, n, C, H, DK).swapaxes(0, 1)
    kc = k.reshape(B, n, C, H, DK).swapaxes(0, 1)
    vc = v.reshape(B, n, C, H, DV).swapaxes(0, 1)

    def step(s, inp):
        qi, ki, vi = inp
        att = jnp.einsum('bqhd,bkhd->bhqk', qi, ki) * inner_decay[None]
        o = jnp.einsum('bhqk,bkhe->bqhe', att, vi)
        o = o + jnp.einsum('bqhd,bhde->bqhe', qi, s) * q_decay
        s = s * chunk_decay + jnp.einsum('bkhd,bkhe->bhde', ki * k_decay, vi)
        return s, o

    s, o = lax.scan(step, s0, (qc, kc, vc))
    return o.swapaxes(0, 1).reshape(B, L, H, DV), s


def _retention(q, k, v, g, s0, decay_logit):
    B, L = q.shape[:2]
    log_gamma = jax.nn.log_sigmoid(decay_logit.astype(jnp.float32))
    k = k * RET_DK ** -0.5
    s0 = s0.astype(jnp.float32)
    o_f, s_f = _retention_scan(q, k, v, s0[:, 0], log_gamma[0])
    o_b, s_b = _retention_scan(q[:, ::-1], k[:, ::-1], v[:, ::-1], s0[:, 1], log_gamma[1])
    o = _head_norm(o_f + o_b[:, ::-1]).reshape(B, L, MIX_W)
    out = o * jax.nn.silu(g.astype(jnp.float32))
    return out.astype(g.dtype), jnp.stack([s_f, s_b], axis=1)


def _complex_scan(bu, a_bar, h0):
    bu = bu.at[:, 0].add(a_bar * h0)
    a = jnp.broadcast_to(a_bar, bu.shape)

    def combine(e1, e2):
        a1, b1 = e1
        a2, b2 = e2
        return a1 * a2, a2 * b1 + b2

    _, xs = lax.associative_scan(combine, (a, bu), axis=1)
    return xs


def _s5(u, h0, a_re, a_im, log_dt, b_re, b_im, c_re, c_im, d_skip, w_glu):
    f32 = jnp.float32
    B, L, _ = u.shape
    uf = u.astype(f32)
    ug = uf.reshape(B, L, SSM_GROUPS, SSM_GROUP).astype(jnp.complex64)
    lam = lax.complex(jnp.minimum(a_re.astype(f32), -1e-4), a_im.astype(f32))
    dt = jnp.exp(log_dt.astype(f32))[..., None]
    a_bar = jnp.exp(lam * dt)
    b = lax.complex(b_re.astype(f32), b_im.astype(f32))
    b_bar = ((a_bar - 1.0) / lam)[..., None] * b[None]
    c = lax.complex(c_re.astype(f32), c_im.astype(f32))
    h0c = lax.complex(h0[..., 0].astype(f32), h0[..., 1].astype(f32))
    y = d_skip.astype(f32) * uf
    finals = []
    for di in range(2):
        ud = ug if di == 0 else ug[:, ::-1]
        bu = jnp.einsum('blgc,gpc->blgp', ud, b_bar[di])
        xs = _complex_scan(bu, a_bar[di], h0c[:, di])
        yd = jnp.einsum('blgp,gcp->blgc', xs, c[di]).real
        if di == 1:
            yd = yd[:, ::-1]
        y = y + yd.reshape(B, L, SSM_CH)
        finals.append(xs[:, -1])
    y = jax.nn.gelu(y)
    y = y * jax.nn.sigmoid(y @ w_glu.astype(f32))
    fin = jnp.stack(finals, axis=1)
    return y.astype(u.dtype), jnp.stack([fin.real, fin.imag], axis=-1)


def _context_attention(q, k, v):
    s = jnp.einsum('bqhd,bkhd->bhqk', q, k).astype(jnp.float32) * NA_HEAD_DIM ** -0.5
    p = jax.nn.softmax(s, axis=-1).astype(v.dtype)
    return jnp.einsum('bhqk,bkhd->bqhd', p, v)


def _neighbourhood_attention(q, k, v, k_ctx, v_ctx, rpb):
    B, L, H, Dh = q.shape
    rows = L // GRID_W
    kr = min(NA_KR, rows)
    ncb = GRID_W // NA_KW
    span = 2 * NA_KW
    r = jnp.arange(rows)
    key_rows = jnp.clip(r - kr // 2, 0, rows - kr)[:, None] + jnp.arange(kr)[None, :]
    qcol = jnp.arange(GRID_W).reshape(ncb, NA_KW)
    win_start = jnp.clip(qcol - NA_KW // 2, 0, GRID_W - NA_KW)
    blk_start = jnp.clip(jnp.arange(ncb) * NA_KW - NA_KW // 2, 0, GRID_W - span)
    key_cols = blk_start[:, None] + jnp.arange(span)[None, :]
    ridx = key_rows[:, None, :, None]
    cidx = key_cols[None, :, None, :]
    kb = k.reshape(B, rows, GRID_W, H, Dh)[:, ridx, cidx]
    vb = v.reshape(B, rows, GRID_W, H, Dh)[:, ridx, cidx]
    qb = q.reshape(B, rows, ncb, NA_KW, H, Dh)
    scale = Dh ** -0.5
    s_loc = jnp.einsum('brjqhd,brjkshd->bhrjqks', qb, kb).astype(jnp.float32) * scale
    kc = key_cols[:, None, :]
    valid = (kc >= win_start[:, :, None]) & (kc < win_start[:, :, None] + NA_KW)
    roff = key_rows - r[:, None] + NA_KR - 1
    coff = jnp.clip(kc - qcol[:, :, None] + NA_KW - 1, 0, 2 * NA_KW - 2)
    bias = rpb.astype(jnp.float32)[:, roff[:, None, None, :, None], coff[None, :, :, None, :]]
    s_loc = jnp.where(valid[None, None, None, :, :, None, :], s_loc + bias[None], NEG_INF)
    n_loc = kr * span
    s_loc = s_loc.reshape(B, H, rows, ncb, NA_KW, n_loc)
    s_ctx = jnp.einsum('brjqhd,bchd->bhrjqc', qb, k_ctx).astype(jnp.float32) * scale
    p = jax.nn.softmax(jnp.concatenate([s_loc, s_ctx], axis=-1), axis=-1).astype(v.dtype)
    p_loc = p[..., :n_loc].reshape(B, H, rows, ncb, NA_KW, kr, span)
    out = (jnp.einsum('bhrjqks,brjkshd->brjqhd', p_loc, vb)
           + jnp.einsum('bhrjqc,bchd->brjqhd', p[..., n_loc:], v_ctx))
    return out.reshape(B, L, H * Dh)


def _merge_branches(r_out, s_out, n_out, gates, w_branch, w_o):
    g = jax.nn.sigmoid(gates.astype(jnp.float32)).astype(r_out.dtype)
    ga, gb, gc = jnp.split(g, 3, axis=-1)
    merged = ga * (r_out @ w_branch[0]) + gb * (s_out @ w_branch[1]) + gc * (n_out @ w_branch[2])
    return merged @ w_o


def _conv_ffn(h, w_up, conv_w, conv_b, w_down):
    z = h @ w_up
    zp = jnp.pad(z, ((0, 0), (1, 1), (0, 0)))
    z = zp[:, :-2] * conv_w[0] + zp[:, 1:-1] * conv_w[1] + zp[:, 2:] * conv_w[2] + conv_b
    a, b = jnp.split(z, 2, axis=-1)
    return (jax.nn.gelu(a) * b) @ w_down


def _s5_call(su, h0, lw):
    return _s5(su, h0, lw['ssm_a_re'], lw['ssm_a_im'], lw['ssm_log_dt'], lw['ssm_b_re'], lw['ssm_b_im'],
               lw['ssm_c_re'], lw['ssm_c_im'], lw['ssm_d'], lw['ssm_w_glu'])


def _context_mixer(h, lw):
    B, L, _ = h.shape
    f32 = jnp.float32
    rq, rk, rv, rg, su, nq, nk, nv, gates = _split_in(h, lw['w_in'])
    rq = rq.reshape(B, L, N_RET_HEADS, RET_DK).astype(f32)
    rk = rk.reshape(B, L, N_RET_HEADS, RET_DK).astype(f32)
    rv = rv.reshape(B, L, N_RET_HEADS, RET_DV).astype(f32)
    zero_ret = jnp.zeros((B, 2, N_RET_HEADS, RET_DK, RET_DV), f32)
    r_out, ret_state = _retention(rq, rk, rv, rg, zero_ret, lw['ret_decay'])
    zero_ssm = jnp.zeros((B, 2, SSM_GROUPS, SSM_STATE, 2), f32)
    s_out, ssm_state = _s5_call(su, zero_ssm, lw)
    nq = nq.reshape(B, L, NA_HEADS, NA_HEAD_DIM)
    nk = nk.reshape(B, L, NA_HEADS, NA_HEAD_DIM)
    nv = nv.reshape(B, L, NA_HEADS, NA_HEAD_DIM)
    n_out = _context_attention(nq, nk, nv).reshape(B, L, MIX_W)
    m = _merge_branches(r_out, s_out, n_out, gates, lw['w_branch'], lw['w_o'])
    return m, (ret_state, ssm_state, nk, nv)


def _latent_mixer(h, lw, s_ret, s_ssm, k_ctx, v_ctx):
    B, L, _ = h.shape
    rq, rk, rv, rg, su, nq, nk, nv, gates = _split_in(h, lw['w_in'])
    rq = _axial_rope(rq.reshape(B, L, N_RET_HEADS, RET_DK))
    rk = _axial_rope(rk.reshape(B, L, N_RET_HEADS, RET_DK))
    rv = rv.reshape(B, L, N_RET_HEADS, RET_DV).astype(jnp.float32)
    r_out, _ = _retention(rq, rk, rv, rg, s_ret, lw['ret_decay'])
    s_out, _ = _s5_call(su, s_ssm, lw)
    nq = nq.reshape(B, L, NA_HEADS, NA_HEAD_DIM)
    nk = nk.reshape(B, L, NA_HEADS, NA_HEAD_DIM)
    nv = nv.reshape(B, L, NA_HEADS, NA_HEAD_DIM)
    n_out = _neighbourhood_attention(nq, nk, nv, k_ctx.astype(nq.dtype), v_ctx.astype(nv.dtype), lw['na_rpb'])
    m = _merge_branches(r_out, s_out, n_out, gates, lw['w_branch'], lw['w_o'])
    return m, None


def _trunk_layer(x, cond, lw, mix):
    sh1, sc1, g1, sh2, sc2, g2 = _ada(cond, lw['w_ada'], lw['b_ada'])
    m, extras = mix(x * (1.0 + sc1) + sh1)
    x = _layer_norm(DEEPNORM_ALPHA * x + g1 * m, lw['ln1_g'], lw['ln1_b'])
    f = _conv_ffn(x * (1.0 + sc2) + sh2, lw['w_up'], lw['conv_w'], lw['conv_b'], lw['w_down'])
    x = _layer_norm(DEEPNORM_ALPHA * x + g2 * f, lw['ln2_g'], lw['ln2_b'])
    return x, extras


def setup_inputs(seed: int = 0) -> dict:
    key = jax.random.key(seed)
    ks = jax.random.split(key, 32)
    f32 = jnp.float32

    def nrm(k, shape, s):
        return jax.random.normal(k, shape, f32) * s

    gamma0 = 1.0 - 2.0 ** (-5.0 - jnp.arange(N_RET_HEADS, dtype=f32))
    ret_logit = jnp.log(gamma0) - jnp.log1p(-gamma0)
    return {
        'x_prompt': nrm(ks[0], (BATCH, SEQ, D_MODEL), 1.0),
        'x_sample': nrm(ks[1], (DEC_BATCH, DEC_SEQ, D_MODEL), 1.0),
        'state_ret': nrm(ks[2], (DEC_BATCH, DEPTH, 2, N_RET_HEADS, RET_DK, RET_DV), 0.5),
        'state_ssm': nrm(ks[3], (DEC_BATCH, DEPTH, 2, SSM_GROUPS, SSM_STATE, 2), 0.5),
        'cache_na_k': nrm(ks[4], (DEC_BATCH, DEPTH, PAST_LEN, NA_HEADS, NA_HEAD_DIM), 1.0),
        'cache_na_v': nrm(ks[5], (DEC_BATCH, DEPTH, PAST_LEN, NA_HEADS, NA_HEAD_DIM), 1.0),
        'c': nrm(ks[6], (DEC_BATCH, D_MODEL), 1.0),
        'c_ctx': nrm(ks[7], (D_MODEL,), 1.0),
        'w_ada': nrm(ks[8], (DEPTH, D_MODEL, 6 * D_MODEL), 0.5 * D_MODEL ** -0.5),
        'b_ada': nrm(ks[9], (DEPTH, 6 * D_MODEL), 0.02),
        'w_in': nrm(ks[10], (DEPTH, D_MODEL, IN_COLS), D_MODEL ** -0.5),
        'ret_decay': ret_logit + nrm(ks[11], (DEPTH, 2, N_RET_HEADS), 0.05),
        'ssm_a_re': -0.5 + nrm(ks[12], (DEPTH, 2, SSM_GROUPS, SSM_STATE), 0.01),
        'ssm_a_im': jnp.pi * jnp.arange(SSM_STATE, dtype=f32) + nrm(ks[13], (DEPTH, 2, SSM_GROUPS, SSM_STATE), 0.01),
        'ssm_log_dt': jax.random.uniform(ks[14], (DEPTH, 2, SSM_GROUPS), f32, math.log(1e-3), math.log(1e-1)),
        'ssm_b_re': nrm(ks[15], (DEPTH, SSM_GROUPS, SSM_STATE, SSM_GROUP), (2 * SSM_GROUP) ** -0.5),
        'ssm_b_im': nrm(ks[16], (DEPTH, SSM_GROUPS, SSM_STATE, SSM_GROUP), (2 * SSM_GROUP) ** -0.5),
        'ssm_c_re': nrm(ks[17], (DEPTH, 2, SSM_GROUPS, SSM_GROUP, SSM_STATE), (2 * SSM_STATE) ** -0.5),
        'ssm_c_im': nrm(ks[18], (DEPTH, 2, SSM_GROUPS, SSM_GROUP, SSM_STATE), (2 * SSM_STATE) ** -0.5),
        'ssm_d': nrm(ks[19], (DEPTH, SSM_CH), 1.0),
        'ssm_w_glu': nrm(ks[20], (DEPTH, SSM_CH, SSM_CH), SSM_CH ** -0.5),
        'na_rpb': nrm(ks[21], (DEPTH, NA_HEADS, 2 * NA_KR - 1, 2 * NA_KW - 1), 0.1),
        'w_branch': nrm(ks[22], (DEPTH, N_BRANCH, MIX_W, D_MODEL), DEEPNORM_BETA * MIX_W ** -0.5),
        'w_o': nrm(ks[23], (DEPTH, D_MODEL, D_MODEL), DEEPNORM_BETA * D_MODEL ** -0.5),
        'ln1_g': 1.0 + nrm(ks[24], (DEPTH, D_MODEL), 0.02),
        'ln1_b': nrm(ks[25], (DEPTH, D_MODEL), 0.02),
        'w_up': nrm(ks[26], (DEPTH, D_MODEL, 2 * D_FF), D_MODEL ** -0.5),
        'conv_w': nrm(ks[27], (DEPTH, 3, 2 * D_FF), 3 ** -0.5),
        'conv_b': nrm(ks[28], (DEPTH, 2 * D_FF), 0.02),
        'w_down': nrm(ks[29], (DEPTH, D_FF, D_MODEL), DEEPNORM_BETA * D_FF ** -0.5),
        'ln2_g': 1.0 + nrm(ks[30], (DEPTH, D_MODEL), 0.02),
        'ln2_b': nrm(ks[31], (DEPTH, D_MODEL), 0.02),
    }


def reference(x_prompt, x_sample, state_ret, state_ssm, cache_na_k, cache_na_v, c, c_ctx,
              w_ada, b_ada, w_in, ret_decay, ssm_a_re, ssm_a_im, ssm_log_dt, ssm_b_re, ssm_b_im,
              ssm_c_re, ssm_c_im, ssm_d, ssm_w_glu, na_rpb, w_branch, w_o, ln1_g, ln1_b,
              w_up, conv_w, conv_b, w_down, ln2_g, ln2_b):
    cond_ctx = jnp.broadcast_to(c_ctx[None, :], (x_prompt.shape[0], D_MODEL))
    xp = x_prompt
    xs = x_sample
    ret_states, ssm_states, na_ks, na_vs = [], [], [], []
    for l in range(DEPTH):
        lw = dict(w_ada=w_ada[l], b_ada=b_ada[l], w_in=w_in[l], ret_decay=ret_decay[l],
                  ssm_a_re=ssm_a_re[l], ssm_a_im=ssm_a_im[l], ssm_log_dt=ssm_log_dt[l],
                  ssm_b_re=ssm_b_re[l], ssm_b_im=ssm_b_im[l], ssm_c_re=ssm_c_re[l], ssm_c_im=ssm_c_im[l],
                  ssm_d=ssm_d[l], ssm_w_glu=ssm_w_glu[l], na_rpb=na_rpb[l], w_branch=w_branch[l],
                  w_o=w_o[l], ln1_g=ln1_g[l], ln1_b=ln1_b[l], w_up=w_up[l], conv_w=conv_w[l],
                  conv_b=conv_b[l], w_down=w_down[l], ln2_g=ln2_g[l], ln2_b=ln2_b[l])
        xp, (s_ret, s_ssm, k_ctx, v_ctx) = _trunk_layer(xp, cond_ctx, lw, lambda h: _context_mixer(h, lw))
        ret_states.append(s_ret)
        ssm_states.append(s_ssm)
        na_ks.append(k_ctx)
        na_vs.append(v_ctx)
        xs, _ = _trunk_layer(xs, c, lw, lambda h: _latent_mixer(h, lw, state_ret[:, l], state_ssm[:, l],
                                                                cache_na_k[:, l], cache_na_v[:, l]))
    new_state_ret = jnp.stack(ret_states, axis=1).astype(x_prompt.dtype)
    new_state_ssm = jnp.stack(ssm_states, axis=1).astype(x_prompt.dtype)
    new_cache_na_k = jnp.stack(na_ks, axis=1).astype(x_prompt.dtype)
    new_cache_na_v = jnp.stack(na_vs, axis=1).astype(x_prompt.dtype)
    return (xp, xs, new_state_ret, new_state_ssm, new_cache_na_k, new_cache_na_v)
```

```cpp
#include <hip/hip_runtime.h>
#include <hip/hip_cooperative_groups.h>
#include <cstdio>
namespace cg = cooperative_groups;

#ifndef SINGLE_LAUNCH
#define SINGLE_LAUNCH 0
#endif

typedef __attribute__((ext_vector_type(8))) short s8v;
typedef __attribute__((ext_vector_type(4))) float f4v;
typedef __attribute__((ext_vector_type(16))) float f16v;
typedef unsigned short u16;
typedef __attribute__((ext_vector_type(4))) unsigned u4v;
__device__ __forceinline__ s8v bc8(u4v x) { return __builtin_bit_cast(s8v, x); }


#define TALL 8192
#define TCTX 4096
#define ALPHA 1.41421356237309515f
#define LNEPS 1e-5f
#define VTR_LAT 2097152
#define NVT_LAT 2097152
#define OUT_SRET 8388608
#define OUT_SSSM 12582912
#define OUT_CK 12845056
#define OUT_CV 17039360

struct Params {
  const float *x_prompt, *x_sample, *state_ret, *state_ssm, *cache_k, *cache_v, *c, *c_ctx;
  const float *w_ada, *b_ada, *w_in, *ret_decay, *a_re, *a_im, *log_dt, *b_re, *b_im, *c_re, *c_im;
  const float *ssm_d, *w_glu, *rpb, *w_branch, *w_o, *ln1_g, *ln1_b, *w_up, *conv_w, *conv_b, *w_down, *ln2_g, *ln2_b;
  float* out;
  float *mod, *stats, *ropetab, *abar, *pre1;
  u16 *bbarT, *cmT, *CK, *CVt, *S0t;
  u16 *Q, *K, *VtR, *KtR, *G, *SU, *NQ, *NK, *NVt, *GT, *rout, *sout, *nout, *YD, *merged, *z2, *act;
};

__device__ __forceinline__ u16 f2bf(float f) {
  unsigned u = __float_as_uint(f);
  u += 0x7fffu + ((u >> 16) & 1u);
  return (u16)(u >> 16);
}
__device__ __forceinline__ float bf2f(unsigned h) { return __uint_as_float((h & 0xffffu) << 16); }
__device__ __forceinline__ float bflo(unsigned w) { return __uint_as_float(w << 16); }
__device__ __forceinline__ float bfhi(unsigned w) { return __uint_as_float(w & 0xffff0000u); }
__device__ __forceinline__ unsigned pack2(float a, float b) { return (unsigned)f2bf(a) | ((unsigned)f2bf(b) << 16); }
__device__ __forceinline__ float sigmoidf_(float x) { return 1.f / (1.f + __expf(-x)); }
__device__ __forceinline__ float siluf_(float x) { return x / (1.f + __expf(-x)); }
__device__ __forceinline__ float geluf_(float x) {
  float u = 0.7978845608028654f * (x + 0.044715f * x * x * x);
  float e = __expf(2.f * u);
  float t = 1.f - 2.f / (e + 1.f);
  return 0.5f * x * (1.f + t);
}
__device__ __forceinline__ f16v zero16() {
  return (f16v){0.f, 0.f, 0.f, 0.f, 0.f, 0.f, 0.f, 0.f, 0.f, 0.f, 0.f, 0.f, 0.f, 0.f, 0.f, 0.f};
}
__device__ __forceinline__ int ltid() { int t = threadIdx.x; asm volatile("" : "+v"(t)); return t; }
__device__ __forceinline__ int cond_of_row(int row) { return row < TCTX ? 0 : 1 + ((row - TCTX) >> 10); }

struct AArgs {
  const u16* A16; int lda;
  const float* A32lo; const float* A32hi;
  const float* stats;
  const float* lng; const float* lnb;
  const float* sc; const float* sh;
  const u16* SU; const u16* YD0; const u16* YD1; const float* dsk;
};

#define LDS_AS 0
#define LDS_BS (2 * 128 * 40 * 2)
#define LDS_GS (LDS_BS + 2 * 128 * 40 * 2)

template <int AMODE>
__device__ __forceinline__ void gemm_mainloop(char* smem, const AArgs& a, const float* __restrict__ W, int ldw, int K,
                                              int m0, int n0, f16v (&acc)[2][2]) {
  u16* As = (u16*)(smem + LDS_AS);
  u16* Bs = (u16*)(smem + LDS_BS);
  float* Gs = (float*)(smem + LDS_GS);
  float* Bv = Gs + 1024;
  const int tid = ltid(), lane = tid & 63, wave = tid >> 6;
  const int wm = wave >> 1, wn = wave & 1;
  const int ar = tid >> 1, akh = tid & 1;
  const int bn = tid & 31, bk = tid >> 5;
  const int row = m0 + ar;
  float mu = 0.f, rstd = 1.f;
  const float* srow = nullptr;
  __syncthreads();
  if constexpr (AMODE == 1) {
    const int ci = cond_of_row(m0);
    for (int k = tid; k < 1024; k += 256) {
      float sc = a.sc[ci * 6144 + k], sh = a.sh[ci * 6144 + k];
      float g = a.lng ? a.lng[k] : 1.f, b = a.lnb ? a.lnb[k] : 0.f;
      Gs[k] = g * (1.f + sc);
      Bv[k] = b * (1.f + sc) + sh;
    }
    if (a.stats) {
      float s = a.stats[row * 2], q = a.stats[row * 2 + 1];
      mu = s * (1.f / 1024.f);
      float var = q * (1.f / 1024.f) - mu * mu;
      rstd = rsqrtf(fmaxf(var, 0.f) + LNEPS);
    }
    srow = row < TCTX ? a.A32lo + (size_t)row * 1024 : a.A32hi + (size_t)(row - TCTX) * 1024;
    __syncthreads();
  }
  acc[0][0] = zero16(); acc[0][1] = zero16(); acc[1][0] = zero16(); acc[1][1] = zero16();

  uint4 ra[6];
  float4 rb[4];
  auto issue = [&](int kt) {
    const int k0 = kt * 32 + akh * 16;
    if constexpr (AMODE == 0) {
      const uint4* p = (const uint4*)(a.A16 + (size_t)row * a.lda + k0);
      ra[0] = p[0]; ra[1] = p[1];
    } else if constexpr (AMODE == 1) {
      const uint4* p = (const uint4*)(srow + k0);
      ra[0] = p[0]; ra[1] = p[1]; ra[2] = p[2]; ra[3] = p[3];
    } else {
      const uint4* p0 = (const uint4*)(a.SU + (size_t)row * 512 + k0);
      const uint4* p1 = (const uint4*)(a.YD0 + (size_t)row * 512 + k0);
      const uint4* p2 = (const uint4*)(a.YD1 + (size_t)row * 512 + k0);
      ra[0] = p0[0]; ra[1] = p0[1]; ra[2] = p1[0]; ra[3] = p1[1]; ra[4] = p2[0]; ra[5] = p2[1];
    }
    const float* wp = W + (size_t)(kt * 32 + bk * 4) * ldw + n0 + bn * 4;
#pragma unroll
    for (int i = 0; i < 4; ++i) rb[i] = *(const float4*)(wp + (size_t)i * ldw);
  };
  auto stage = [&](int buf, int kt) {
    uint4 o0, o1;
    if constexpr (AMODE == 0) {
      o0 = ra[0]; o1 = ra[1];
    } else if constexpr (AMODE == 1) {
      const int k0 = kt * 32 + akh * 16;
      unsigned w[8];
#pragma unroll
      for (int i = 0; i < 4; ++i) {
        float4 g = *(const float4*)(Gs + k0 + i * 4);
        float4 b = *(const float4*)(Bv + k0 + i * 4);
        float x0 = __uint_as_float(ra[i].x), x1 = __uint_as_float(ra[i].y), x2 = __uint_as_float(ra[i].z), x3 = __uint_as_float(ra[i].w);
        float h0 = (x0 - mu) * rstd * g.x + b.x;
        float h1 = (x1 - mu) * rstd * g.y + b.y;
        float h2 = (x2 - mu) * rstd * g.z + b.z;
        float h3 = (x3 - mu) * rstd * g.w + b.w;
        w[i * 2] = pack2(h0, h1); w[i * 2 + 1] = pack2(h2, h3);
      }
      o0 = make_uint4(w[0], w[1], w[2], w[3]); o1 = make_uint4(w[4], w[5], w[6], w[7]);
    } else {
      const int k0 = kt * 32 + akh * 16;
      unsigned w[8];
#pragma unroll
      for (int i = 0; i < 2; ++i) {
        unsigned su[4] = {ra[i].x, ra[i].y, ra[i].z, ra[i].w};
        unsigned y0[4] = {ra[2 + i].x, ra[2 + i].y, ra[2 + i].z, ra[2 + i].w};
        unsigned y1[4] = {ra[4 + i].x, ra[4 + i].y, ra[4 + i].z, ra[4 + i].w};
#pragma unroll
        for (int j = 0; j < 4; ++j) {
          float d0 = a.dsk[k0 + i * 8 + j * 2], d1 = a.dsk[k0 + i * 8 + j * 2 + 1];
          float v0 = geluf_(d0 * bflo(su[j]) + bflo(y0[j]) + bflo(y1[j]));
          float v1 = geluf_(d1 * bfhi(su[j]) + bfhi(y0[j]) + bfhi(y1[j]));
          w[i * 4 + j] = pack2(v0, v1);
        }
      }
      o0 = make_uint4(w[0], w[1], w[2], w[3]); o1 = make_uint4(w[4], w[5], w[6], w[7]);
    }
    uint4* ap = (uint4*)(As + buf * (128 * 40) + ar * 40 + akh * 16);
    ap[0] = o0; ap[1] = o1;
    u16* bp = Bs + buf * (128 * 40) + (bn * 4) * 40 + bk * 4;
    *(uint2*)(bp) = make_uint2(pack2(rb[0].x, rb[1].x), pack2(rb[2].x, rb[3].x));
    *(uint2*)(bp + 40) = make_uint2(pack2(rb[0].y, rb[1].y), pack2(rb[2].y, rb[3].y));
    *(uint2*)(bp + 80) = make_uint2(pack2(rb[0].z, rb[1].z), pack2(rb[2].z, rb[3].z));
    *(uint2*)(bp + 120) = make_uint2(pack2(rb[0].w, rb[1].w), pack2(rb[2].w, rb[3].w));
  };

  const int nk = K >> 5;
  issue(0);
  stage(0, 0);
  __syncthreads();
#pragma unroll 1
  for (int kt = 0; kt < nk; ++kt) {
    const int buf = kt & 1;
    if (kt + 1 < nk) issue(kt + 1);
    const u16* Ab = As + buf * (128 * 40) + (wm * 64 + (lane & 31)) * 40 + (lane >> 5) * 8;
    const u16* Bb = Bs + buf * (128 * 40) + (wn * 64 + (lane & 31)) * 40 + (lane >> 5) * 8;
#pragma unroll
    for (int ks = 0; ks < 2; ++ks) {
      s8v af0 = *(const s8v*)(Ab + ks * 16);
      s8v af1 = *(const s8v*)(Ab + 32 * 40 + ks * 16);
      s8v bf0 = *(const s8v*)(Bb + ks * 16);
      s8v bf1 = *(const s8v*)(Bb + 32 * 40 + ks * 16);
      acc[0][0] = __builtin_amdgcn_mfma_f32_32x32x16_bf16(af0, bf0, acc[0][0], 0, 0, 0);
      acc[0][1] = __builtin_amdgcn_mfma_f32_32x32x16_bf16(af0, bf1, acc[0][1], 0, 0, 0);
      acc[1][0] = __builtin_amdgcn_mfma_f32_32x32x16_bf16(af1, bf0, acc[1][0], 0, 0, 0);
      acc[1][1] = __builtin_amdgcn_mfma_f32_32x32x16_bf16(af1, bf1, acc[1][1], 0, 0, 0);
    }
    if (kt + 1 < nk) stage(buf ^ 1, kt + 1);
    __syncthreads();
  }
}

#define EPI_ROW(mi, reg) (m0 + wm * 64 + (mi) * 32 + ((reg) & 3) + 8 * ((reg) >> 2) + 4 * (lane >> 5))
#define EPI_COL(ni) (n0 + wn * 64 + (ni) * 32 + (lane & 31))

__device__ __forceinline__ void stats_accum(float* stats, int row, float v0, float v1, int lane) {
  float s = v0 + v1, q = v0 * v0 + v1 * v1;
#pragma unroll
  for (int o = 1; o < 32; o <<= 1) {
    s += __shfl_xor(s, o);
    q += __shfl_xor(q, o);
  }
  if ((lane & 31) == 0) {
    atomicAdd(stats + row * 2, s);
    atomicAdd(stats + row * 2 + 1, q);
  }
}

#define P0_ADA 768
#define P0_ROPE 1
#define P0_CACHE 64
#define P0_S0 64
#define P0_S5 128
#define P0_ITEMS (P0_ADA + P0_ROPE + P0_CACHE + P0_S0 + P0_S5)

__device__ __forceinline__ void phase0_item(const Params& p, char* smem, int item) {
  const int tid = ltid();
  if (item < P0_ADA) {
    const int ks = item & 3, cg = (item >> 2) % 96, l = item / 384;
    float* scs = (float*)smem;
    float* red = scs + 5 * 256;
    __syncthreads();
    for (int i = tid; i < 5 * 256; i += 256) {
      int ci = i >> 8, k = ks * 256 + (i & 255);
      float v = ci == 0 ? p.c_ctx[k] : p.c[(ci - 1) * 1024 + k];
      scs[i] = siluf_(v);
    }
    __syncthreads();
    const int ct = tid & 15, kg = tid >> 4;
    const float* wp = p.w_ada + (size_t)l * 1024 * 6144 + (size_t)(ks * 256 + kg * 16) * 6144 + cg * 64 + ct * 4;
    float acc[5][4];
#pragma unroll
    for (int i = 0; i < 5; ++i)
#pragma unroll
      for (int j = 0; j < 4; ++j) acc[i][j] = 0.f;
#pragma unroll 4
    for (int k = 0; k < 16; ++k) {
      float4 w = *(const float4*)(wp + (size_t)k * 6144);
#pragma unroll
      for (int ci = 0; ci < 5; ++ci) {
        float s = scs[ci * 256 + kg * 16 + k];
        acc[ci][0] += s * w.x; acc[ci][1] += s * w.y; acc[ci][2] += s * w.z; acc[ci][3] += s * w.w;
      }
    }
#pragma unroll
    for (int ci = 0; ci < 5; ++ci)
#pragma unroll
      for (int j = 0; j < 4; ++j) red[(kg * 5 + ci) * 64 + ct * 4 + j] = acc[ci][j];
    __syncthreads();
    for (int i = tid; i < 320; i += 256) {
      int ci = i >> 6, col = i & 63;
      float s = 0.f;
#pragma unroll
      for (int g = 0; g < 16; ++g) s += red[(g * 5 + ci) * 64 + col];
      if (ks == 0) s += p.b_ada[l * 6144 + cg * 64 + col];
      atomicAdd(p.mod + (l * 5 + ci) * 6144 + cg * 64 + col, s);
    }
    return;
  }
  item -= P0_ADA;
  if (item < P0_ROPE) {
    for (int i = tid; i < 64 * 32; i += 256) {
      int pos = i >> 5, fi = i & 31;
      float inv = (float)pow(10000.0, -(double)fi / 32.0);
      float ang = (float)pos * inv;
      p.ropetab[i * 2] = (float)cos((double)ang);
      p.ropetab[i * 2 + 1] = (float)sin((double)ang);
    }
    return;
  }
  item -= P0_ROPE;
  if (item < P0_CACHE) {
    const int pc = item & 7, b = (item >> 3) & 3, l = item >> 5;
    const float* ksrc = p.cache_k + ((size_t)(b * 2 + l) * 512 + pc * 64) * 512;
    const float* vsrc = p.cache_v + ((size_t)(b * 2 + l) * 512 + pc * 64) * 512;
    u16* kdst = p.CK + ((size_t)(l * 4 + b) * 512 + pc * 64) * 512;
    for (int i = tid; i < 64 * 512 / 4; i += 256) {
      float4 v = *(const float4*)(ksrc + (size_t)i * 4);
      *(uint2*)(kdst + (size_t)i * 4) = make_uint2(pack2(v.x, v.y), pack2(v.z, v.w));
    }
    for (int cc = 0; cc < 2; ++cc) {
      const int col = tid + cc * 256;
      u16* vdst = p.CVt + ((size_t)(l * 4 + b) * 512 + col) * 512 + pc * 64;
      for (int j = 0; j < 8; ++j) {
        float v[8];
#pragma unroll
        for (int e = 0; e < 8; ++e) v[e] = vsrc[(size_t)(j * 8 + e) * 512 + col];
        *(uint4*)(vdst + j * 8) = make_uint4(pack2(v[0], v[1]), pack2(v[2], v[3]), pack2(v[4], v[5]), pack2(v[6], v[7]));
      }
    }
    return;
  }
  item -= P0_CACHE;
  if (item < P0_S0) {
    const int hh = item & 3, dir = (item >> 2) & 1, b = (item >> 3) & 3, l = item >> 5;
    const float* src = p.state_ret + ((size_t)(((b * 2 + l) * 2 + dir) * 4 + hh)) * 16384;
    u16* dst = p.S0t + ((size_t)(((l * 4 + b) * 2 + dir) * 4 + hh)) * 16384;
    const int dv = tid & 127, kh = tid >> 7;
    for (int j = 0; j < 8; ++j) {
      const int dk0 = kh * 64 + j * 8;
      float v[8];
#pragma unroll
      for (int e = 0; e < 8; ++e) v[e] = src[(size_t)(dk0 + e) * 128 + dv];
      *(uint4*)(dst + (size_t)dv * 128 + dk0) = make_uint4(pack2(v[0], v[1]), pack2(v[2], v[3]), pack2(v[4], v[5]), pack2(v[6], v[7]));
    }
    return;
  }
  item -= P0_S0;
  {
    const int g = item & 31, dir = (item >> 5) & 1, l = item >> 6;
    if (tid < 64) {
      const int pp = tid;
      const int ai = ((l * 2 + dir) * 32 + g) * 64 + pp;
      double lre = fmin((double)p.a_re[ai], -1e-4), lim = (double)p.a_im[ai];
      double dt = exp((double)p.log_dt[(l * 2 + dir) * 32 + g]);
      double er = exp(lre * dt);
      double abr = er * cos(lim * dt), abi = er * sin(lim * dt);
      p.abar[ai * 2] = (float)abr;
      p.abar[ai * 2 + 1] = (float)abi;
      double nr = abr - 1.0, ni = abi;
      double den = lre * lre + lim * lim;
      double cr = (nr * lre + ni * lim) / den, cim = (ni * lre - nr * lim) / den;
      u16* bt = p.bbarT + (size_t)((l * 2 + dir) * 32 + g) * 128 * 16;
      const float* br = p.b_re + ((size_t)(l * 32 + g) * 64 + pp) * 16;
      const float* bi = p.b_im + ((size_t)(l * 32 + g) * 64 + pp) * 16;
      for (int c = 0; c < 16; ++c) {
        double xr = br[c], xi = bi[c];
        bt[pp * 16 + c] = f2bf((float)(cr * xr - cim * xi));
        bt[(64 + pp) * 16 + c] = f2bf((float)(cr * xi + cim * xr));
      }
      u16* ct = p.cmT + (size_t)((l * 2 + dir) * 32 + g) * 16 * 128;
      const float* cre = p.c_re + ((size_t)((l * 2 + dir) * 32 + g) * 16) * 64;
      const float* cie = p.c_im + ((size_t)((l * 2 + dir) * 32 + g) * 16) * 64;
      for (int c = 0; c < 16; ++c) {
        ct[c * 128 + pp] = f2bf(cre[c * 64 + pp]);
        ct[c * 128 + 64 + pp] = f2bf(-cie[c * 64 + pp]);
      }
    }
  }
}

__device__ __forceinline__ void p1_item(const Params& p, char* smem, int l, int item) {
  const int mt = item & 63, nt = item >> 6;
  const int m0 = mt * 128, n0 = nt * 128;
  const int tid = ltid(), lane = tid & 63, wave = tid >> 6, wm = wave >> 1, wn = wave & 1;
  AArgs a{};
  const float* mod = p.mod + l * 5 * 6144;
  if (l == 0) {
    a.A32lo = p.x_prompt; a.A32hi = p.x_sample; a.stats = nullptr; a.lng = nullptr; a.lnb = nullptr;
  } else {
    a.A32lo = p.out; a.A32hi = p.out + (size_t)TCTX * 1024; a.stats = p.stats + (size_t)(0 * 2 + 1) * TALL * 2;
    a.lng = p.ln2_g; a.lnb = p.ln2_b;
  }
  a.sc = mod + 1024; a.sh = mod;
  f16v acc[2][2];
  gemm_mainloop<1>(smem, a, p.w_in + (size_t)l * 1024 * 7168, 7168, 1024, m0, n0, acc);

  const bool latent = m0 >= TCTX;
  const int seg = n0 >> 9;
  const int csw = (n0 & 511) + wn * 64;
  const int l31 = lane & 31;
  if (seg >= 8) {
    const int gc = (n0 - 4096) + wn * 64 + l31;
#pragma unroll
    for (int mi = 0; mi < 2; ++mi)
#pragma unroll
      for (int reg = 0; reg < 16; ++reg) {
        const int row = EPI_ROW(mi, reg);
        p.GT[(size_t)row * 3072 + gc] = f2bf(sigmoidf_(acc[mi][0][reg]));
        p.GT[(size_t)row * 3072 + gc + 32] = f2bf(sigmoidf_(acc[mi][1][reg]));
      }
    return;
  }
  if (seg <= 1) {
    u16* dst = seg == 0 ? p.Q : p.K;
    const float scl = seg == 0 ? 1.f : 0.08838834764831845f;
    const bool colhalf = (csw & 64) != 0;
#pragma unroll
    for (int mi = 0; mi < 2; ++mi)
#pragma unroll
      for (int q = 0; q < 4; ++q) {
        float o0[4], o1[4];
#pragma unroll
        for (int j = 0; j < 4; ++j) {
          const int reg = q * 4 + j;
          const int row = EPI_ROW(mi, reg);
          float x1 = acc[mi][0][reg], x2 = acc[mi][1][reg];
          if (latent) {
            const int pos = (row - TCTX) & 1023;
            const int pidx = colhalf ? (pos & 63) : (pos >> 6);
            const float cs = p.ropetab[(pidx * 32 + l31) * 2], sn = p.ropetab[(pidx * 32 + l31) * 2 + 1];
            float t1 = x1 * cs - x2 * sn, t2 = x1 * sn + x2 * cs;
            x1 = t1; x2 = t2;
          }
          x1 *= scl; x2 *= scl;
          o0[j] = x1; o1[j] = x2;
          dst[(size_t)row * 512 + csw + l31] = f2bf(x1);
          dst[(size_t)row * 512 + csw + 32 + l31] = f2bf(x2);
        }
        if (seg == 1 && !latent) {
          const int row0 = EPI_ROW(mi, q * 4);
          const int b = row0 >> 8, pos = row0 & 255;
          const int c0 = csw + l31, c1 = c0 + 32;
          *(uint2*)(p.KtR + ((size_t)(b * 4 + (c0 >> 7)) * 128 + (c0 & 127)) * 256 + pos) = make_uint2(pack2(o0[0], o0[1]), pack2(o0[2], o0[3]));
          *(uint2*)(p.KtR + ((size_t)(b * 4 + (c1 >> 7)) * 128 + (c1 & 127)) * 256 + pos) = make_uint2(pack2(o1[0], o1[1]), pack2(o1[2], o1[3]));
        }
      }
    return;
  }
  if (seg == 2 || seg == 7) {
#pragma unroll
    for (int mi = 0; mi < 2; ++mi)
#pragma unroll
      for (int q = 0; q < 4; ++q) {
        const int row0 = EPI_ROW(mi, q * 4);
#pragma unroll
        for (int ni = 0; ni < 2; ++ni) {
          const int col = csw + ni * 32 + l31;
          float v0 = acc[mi][ni][q * 4], v1 = acc[mi][ni][q * 4 + 1], v2 = acc[mi][ni][q * 4 + 2], v3 = acc[mi][ni][q * 4 + 3];
          uint2 pk = make_uint2(pack2(v0, v1), pack2(v2, v3));
          if (seg == 2) {
            const int hh = col >> 7, dd = col & 127;
            if (!latent) {
              const int b = row0 >> 8, pos = row0 & 255;
              *(uint2*)(p.VtR + ((size_t)(b * 4 + hh) * 128 + dd) * 256 + pos) = pk;
            } else {
              const int b = (row0 - TCTX) >> 10, pos = (row0 - TCTX) & 1023;
              *(uint2*)(p.VtR + VTR_LAT + ((size_t)(b * 4 + hh) * 128 + dd) * 1024 + pos) = pk;
            }
          } else {
            const int hh = col >> 6, dd = col & 63;
            if (!latent) {
              const int b = row0 >> 8, pos = row0 & 255;
              *(uint2*)(p.NVt + ((size_t)(b * 8 + hh) * 64 + dd) * 256 + pos) = pk;
              float* o = p.out + OUT_CV + ((size_t)(b * 2 + l) * 256 + pos) * 512 + col;
              o[0] = v0; o[512] = v1; o[1024] = v2; o[1536] = v3;
            } else {
              const int b = (row0 - TCTX) >> 10, pos = (row0 - TCTX) & 1023;
              *(uint2*)(p.NVt + NVT_LAT + ((size_t)(b * 8 + hh) * 64 + dd) * 1024 + pos) = pk;
            }
          }
        }
      }
    return;
  }
  u16* dst = seg == 3 ? p.G : seg == 4 ? p.SU : seg == 5 ? p.NQ : p.NK;
#pragma unroll
  for (int mi = 0; mi < 2; ++mi)
#pragma unroll
    for (int reg = 0; reg < 16; ++reg) {
      const int row = EPI_ROW(mi, reg);
#pragma unroll
      for (int ni = 0; ni < 2; ++ni) {
        const int col = csw + ni * 32 + l31;
        float v = acc[mi][ni][reg];
        float w = seg == 3 ? siluf_(v) : (seg == 5 ? v * 0.125f : v);
        dst[(size_t)row * 512 + col] = f2bf(w);
        if (seg == 6 && !latent) {
          const int b = row >> 8, pos = row & 255;
          p.out[OUT_CK + ((size_t)(b * 2 + l) * 256 + pos) * 512 + col] = v;
        }
      }
    }
}

template <int D, int MODE>
__device__ __forceinline__ void attn_item(const Params& p, char* smem, int l, int idx) {
  constexpr int KSTR = D + 8;
  constexpr int NKS = D / 32;
  constexpr int NB = D / 16;
  constexpr int NCH = D / 32;
  u16* Ks = (u16*)smem;
  u16* Vts = Ks + 64 * KSTR;
  float* rpbs = (float*)(Vts + D * 72);
  const int tid = ltid(), lane = tid & 63, wave = tid >> 6;
  const int l15 = lane & 15, g = lane >> 4;

  int b, hh, qt, L, tokbase, nt;
  bool latent = false;
  int kr0 = 0, rrow = 0;
  if constexpr (MODE == 0) {
    if (idx < 256) { latent = true; b = idx >> 6; hh = (idx >> 4) & 3; qt = idx & 15; L = 1024; tokbase = TCTX + b * 1024; nt = 16 + 4; }
    else { idx -= 256; b = idx >> 4; hh = (idx >> 2) & 3; qt = idx & 3; L = 256; tokbase = b * 256; nt = 4; }
  } else if constexpr (MODE == 1) {
    b = idx >> 5; hh = (idx >> 2) & 7; qt = idx & 3; L = 256; tokbase = b * 256; nt = 4;
  } else {
    b = idx >> 7; hh = (idx >> 4) & 7; qt = idx & 15; rrow = qt; L = 1024; tokbase = TCTX + b * 1024; nt = 16; latent = true;
    kr0 = min(max(rrow - 4, 0), 8);
  }
  const int tq = qt * 64 + wave * 16 + l15;
  const int qtok = tokbase + tq;

  float lgf2 = 0.f, lgb2 = 0.f;
  if constexpr (MODE == 0) {
    float xf = p.ret_decay[(l * 2 + 0) * 4 + hh], xb = p.ret_decay[(l * 2 + 1) * 4 + hh];
    lgf2 = -log1pf(expf(-xf)) * 1.4426950408889634f;
    lgb2 = -log1pf(expf(-xb)) * 1.4426950408889634f;
  }

  __syncthreads();
  if constexpr (MODE == 2) {
    for (int i = tid; i < 465; i += 256) rpbs[i] = p.rpb[(size_t)(l * 8 + hh) * 465 + i];
  }

  u4v qf[NKS];
  {
    const u16* qb = (MODE == 0 ? p.Q : p.NQ) + (size_t)qtok * 512 + hh * D + g * 8;
#pragma unroll
    for (int ks = 0; ks < NKS; ++ks) qf[ks] = *(const u4v*)(qb + ks * 32);
  }

  f4v ot[NB];
#pragma unroll
  for (int nb = 0; nb < NB; ++nb) ot[nb] = (f4v){0.f, 0.f, 0.f, 0.f};
  float mrun = -1e30f, lsum = 0.f;

  const int ntk = (MODE == 0) ? (L >> 6) : nt;
  u4v kr[NCH], vr[NCH];
#define ATTN_ISSUE(KT)                                                                                   \
  {                                                                                                      \
    const int kt_ = (KT);                                                                                \
    const u16* kp; const u16* vp; int ldv;                                                               \
    if constexpr (MODE == 0) {                                                                           \
      kp = p.K + (size_t)(tokbase + kt_ * 64) * 512 + hh * 128;                                          \
      if (latent) { vp = p.VtR + VTR_LAT + ((size_t)(b * 4 + hh) * 128) * 1024 + kt_ * 64; ldv = 1024; } \
      else { vp = p.VtR + ((size_t)(b * 4 + hh) * 128) * 256 + kt_ * 64; ldv = 256; }                    \
    } else if constexpr (MODE == 1) {                                                                    \
      kp = p.NK + (size_t)(tokbase + kt_ * 64) * 512 + hh * 64;                                          \
      vp = p.NVt + ((size_t)(b * 8 + hh) * 64) * 256 + kt_ * 64; ldv = 256;                              \
    } else {                                                                                             \
      if (kt_ < 8) {                                                                                     \
        const int krow = kr0 + kt_;                                                                      \
        kp = p.NK + (size_t)(tokbase + krow * 64) * 512 + hh * 64;                                       \
        vp = p.NVt + NVT_LAT + ((size_t)(b * 8 + hh) * 64) * 1024 + krow * 64; ldv = 1024;               \
      } else {                                                                                           \
        kp = p.CK + ((size_t)(l * 4 + b) * 512 + (kt_ - 8) * 64) * 512 + hh * 64;                        \
        vp = p.CVt + ((size_t)((l * 4 + b) * 8 + hh) * 64) * 512 + (kt_ - 8) * 64; ldv = 512;            \
      }                                                                                                  \
    }                                                                                                    \
    _Pragma("unroll") for (int i = 0; i < NCH; ++i) {                                                    \
      const int c = tid + 256 * i;                                                                       \
      const int r = c / (D / 8), cc = c % (D / 8);                                                       \
      kr[i] = *(const u4v*)(kp + (size_t)r * 512 + cc * 8);                                              \
      const int vrw = c >> 3, vc = c & 7;                                                                \
      vr[i] = *(const u4v*)(vp + (size_t)vrw * ldv + vc * 8);                                            \
    }                                                                                                    \
  }
#define ATTN_STAGE()                                                                                     \
  {                                                                                                      \
    _Pragma("unroll") for (int i = 0; i < NCH; ++i) {                                                    \
      const int c = tid + 256 * i;                                                                       \
      const int r = c / (D / 8), cc = c % (D / 8);                                                       \
      *(u4v*)(Ks + r * KSTR + cc * 8) = kr[i];                                                           \
      const int vrw = c >> 3, vc = c & 7;                                                                \
      *(u4v*)(Vts + vrw * 72 + vc * 8) = vr[i];                                                          \
    }                                                                                                    \
  }

  ATTN_ISSUE(0)
#pragma unroll 1
  for (int kt = 0; kt < ntk; ++kt) {
    __syncthreads();
    ATTN_STAGE()
    __syncthreads();
    if (kt + 1 < ntk) ATTN_ISSUE(kt + 1)
    f4v st[4];
#pragma unroll
    for (int kb = 0; kb < 4; ++kb) {
      st[kb] = (f4v){0.f, 0.f, 0.f, 0.f};
#pragma unroll
      for (int ks = 0; ks < NKS; ++ks) {
        s8v kf = *(const s8v*)(Ks + (kb * 16 + l15) * KSTR + ks * 32 + g * 8);
        st[kb] = __builtin_amdgcn_mfma_f32_16x16x32_bf16(kf, bc8(qf[ks]), st[kb], 0, 0, 0);
      }
    }
    if constexpr (MODE == 0) {
#pragma unroll
      for (int kb = 0; kb < 4; ++kb)
#pragma unroll
        for (int r = 0; r < 4; ++r) {
          const int ts = kt * 64 + kb * 16 + g * 4 + r;
          const int d = tq - ts;
          float dec = d > 0 ? exp2f(lgf2 * (float)d) : (d < 0 ? exp2f(lgb2 * (float)(-d)) : 2.f);
          st[kb][r] *= dec;
        }
    } else {
      if constexpr (MODE == 2) {
        if (kt < 8) {
          const int qc = wave * 16 + l15;
          const int ws = min(max(qc - 8, 0), 48);
          const int roff = (kr0 + kt) - rrow + 7;
#pragma unroll
          for (int kb = 0; kb < 4; ++kb)
#pragma unroll
            for (int r = 0; r < 4; ++r) {
              const int kc = kb * 16 + g * 4 + r;
              const bool valid = (kc >= ws) && (kc < ws + 16);
              const int coff = min(max(kc - qc + 15, 0), 30);
              const float bias = rpbs[roff * 31 + coff];
              st[kb][r] = valid ? st[kb][r] + bias : -1e30f;
            }
        }
      }
      float tmax = st[0][0];
#pragma unroll
      for (int kb = 0; kb < 4; ++kb)
#pragma unroll
        for (int r = 0; r < 4; ++r) tmax = fmaxf(tmax, st[kb][r]);
      tmax = fmaxf(tmax, __shfl_xor(tmax, 16));
      tmax = fmaxf(tmax, __shfl_xor(tmax, 32));
      const float mnew = fmaxf(mrun, tmax);
      const float alpha = __expf(mrun - mnew);
      float ps = 0.f;
#pragma unroll
      for (int kb = 0; kb < 4; ++kb)
#pragma unroll
        for (int r = 0; r < 4; ++r) {
          float e = __expf(st[kb][r] - mnew);
          st[kb][r] = e;
          ps += e;
        }
      lsum = lsum * alpha + ps;
      mrun = mnew;
#pragma unroll
      for (int nb = 0; nb < NB; ++nb) ot[nb] *= alpha;
    }
    u4v pf[2];
#pragma unroll
    for (int s = 0; s < 2; ++s) {
      pf[s] = (u4v){pack2(st[2 * s][0], st[2 * s][1]), pack2(st[2 * s][2], st[2 * s][3]),
                    pack2(st[2 * s + 1][0], st[2 * s + 1][1]), pack2(st[2 * s + 1][2], st[2 * s + 1][3])};
    }
#pragma unroll
    for (int nb = 0; nb < NB; ++nb)
#pragma unroll
      for (int s = 0; s < 2; ++s) {
        const u16* vb = Vts + (nb * 16 + l15) * 72 + s * 32 + g * 4;
        uint2 lo = *(const uint2*)(vb);
        uint2 hi = *(const uint2*)(vb + 16);
        u4v vf = (u4v){lo.x, lo.y, hi.x, hi.y};
        ot[nb] = __builtin_amdgcn_mfma_f32_16x16x32_bf16(bc8(vf), bc8(pf[s]), ot[nb], 0, 0, 0);
      }
  }

  if constexpr (MODE == 0) {
    if (latent) {
#pragma unroll 1
      for (int dir = 0; dir < 2; ++dir) {
        const float scale = dir == 0 ? exp2f(lgf2 * (float)(tq + 1)) : exp2f(lgb2 * (float)(L - tq));
        const u16* S0 = p.S0t + ((size_t)(((l * 4 + b) * 2 + dir) * 4 + hh)) * 16384;
#pragma unroll
        for (int s = 0; s < NKS; ++s) {
          u4v pq = (u4v){pack2(bflo(qf[s][0]) * scale, bfhi(qf[s][0]) * scale), pack2(bflo(qf[s][1]) * scale, bfhi(qf[s][1]) * scale),
                         pack2(bflo(qf[s][2]) * scale, bfhi(qf[s][2]) * scale), pack2(bflo(qf[s][3]) * scale, bfhi(qf[s][3]) * scale)};
#pragma unroll
          for (int nb = 0; nb < NB; ++nb) {
            u4v vf = *(const u4v*)(S0 + (size_t)(nb * 16 + l15) * 128 + s * 32 + g * 8);
            ot[nb] = __builtin_amdgcn_mfma_f32_16x16x32_bf16(bc8(vf), bc8(pq), ot[nb], 0, 0, 0);
          }
        }
      }
    }
    float s = 0.f;
#pragma unroll
    for (int nb = 0; nb < NB; ++nb) s += ot[nb][0] + ot[nb][1] + ot[nb][2] + ot[nb][3];
    s += __shfl_xor(s, 16); s += __shfl_xor(s, 32);
    const float mu = s * (1.f / 128.f);
    float q = 0.f;
#pragma unroll
    for (int nb = 0; nb < NB; ++nb)
#pragma unroll
      for (int r = 0; r < 4; ++r) { float dlt = ot[nb][r] - mu; q += dlt * dlt; }
    q += __shfl_xor(q, 16); q += __shfl_xor(q, 32);
    const float rstd = rsqrtf(q * (1.f / 128.f) + LNEPS);
#pragma unroll
    for (int nb = 0; nb < NB; ++nb) {
      const size_t off = (size_t)qtok * 512 + hh * 128 + nb * 16 + g * 4;
      uint2 gg = *(const uint2*)(p.G + off);
      float o0 = (ot[nb][0] - mu) * rstd * bflo(gg.x);
      float o1 = (ot[nb][1] - mu) * rstd * bfhi(gg.x);
      float o2 = (ot[nb][2] - mu) * rstd * bflo(gg.y);
      float o3 = (ot[nb][3] - mu) * rstd * bfhi(gg.y);
      *(uint2*)(p.rout + off) = make_uint2(pack2(o0, o1), pack2(o2, o3));
    }
  } else {
    lsum += __shfl_xor(lsum, 16); lsum += __shfl_xor(lsum, 32);
    const float inv = 1.f / lsum;
#pragma unroll
    for (int nb = 0; nb < NB; ++nb) {
      const size_t off = (size_t)qtok * 512 + hh * 64 + nb * 16 + g * 4;
      *(uint2*)(p.nout + off) = make_uint2(pack2(ot[nb][0] * inv, ot[nb][1] * inv), pack2(ot[nb][2] * inv, ot[nb][3] * inv));
    }
  }
}

__device__ __forceinline__ void retstate_item(const Params& p, int l, int idx) {
  const int dir = idx & 1, hh = (idx >> 1) & 3, b = idx >> 3;
  const int tid = ltid(), lane = tid & 63, wave = tid >> 6;
  const int r = lane & 31, h2 = lane >> 5;
  const float x = p.ret_decay[(l * 2 + dir) * 4 + hh];
  const float lg2 = -log1pf(expf(-x)) * 1.4426950408889634f;
  const u16* Kt = p.KtR + ((size_t)(b * 4 + hh) * 128) * 256;
  const u16* Vt = p.VtR + ((size_t)(b * 4 + hh) * 128) * 256;
  f16v acc[4];
#pragma unroll
  for (int i = 0; i < 4; ++i) acc[i] = zero16();
#pragma unroll 2
  for (int ks = 0; ks < 16; ++ks) {
    const int tok0 = ks * 16 + h2 * 8;
    const u4v a = *(const u4v*)(Kt + (size_t)(wave * 32 + r) * 256 + tok0);
    u4v af;
#pragma unroll
    for (int w = 0; w < 4; ++w) {
      const int t0 = tok0 + 2 * w, t1 = t0 + 1;
      float w0 = dir == 0 ? exp2f(lg2 * (float)(255 - t0)) : exp2f(lg2 * (float)t0);
      float w1 = dir == 0 ? exp2f(lg2 * (float)(255 - t1)) : exp2f(lg2 * (float)t1);
      af[w] = pack2(bflo(a[w]) * w0, bfhi(a[w]) * w1);
    }
#pragma unroll
    for (int nt = 0; nt < 4; ++nt) {
      const u4v bfr = *(const u4v*)(Vt + (size_t)(nt * 32 + r) * 256 + tok0);
      acc[nt] = __builtin_amdgcn_mfma_f32_32x32x16_bf16(bc8(af), bc8(bfr), acc[nt], 0, 0, 0);
    }
  }
  float* o = p.out + OUT_SRET + ((size_t)(((b * 2 + l) * 2 + dir) * 4 + hh)) * 16384;
#pragma unroll
  for (int nt = 0; nt < 4; ++nt)
#pragma unroll
    for (int reg = 0; reg < 16; ++reg) {
      const int dk = wave * 32 + (reg & 3) + 8 * (reg >> 2) + 4 * h2;
      o[(size_t)dk * 128 + nt * 32 + r] = acc[nt][reg];
    }
}

__device__ __forceinline__ void s5_item(const Params& p, char* smem, int l, int item) {
  const int tid = ltid(), lane = tid & 63, wave = tid >> 6;
  const int l15 = lane & 15, g4 = lane >> 4;
  int seq = item * 4 + wave;
  int b, dir, g, L, tokbase;
  bool latent;
  if (seq < 256) { latent = true; b = seq >> 6; dir = (seq >> 5) & 1; g = seq & 31; L = 1024; tokbase = TCTX + b * 1024; }
  else { seq -= 256; latent = false; b = seq >> 6; dir = (seq >> 5) & 1; g = seq & 31; L = 256; tokbase = b * 256; }
  float* buf = (float*)smem + wave * (16 * 132);
  const int tg = (l * 2 + dir) * 32 + g;
  const float ar = p.abar[(tg * 64 + lane) * 2], ai = p.abar[(tg * 64 + lane) * 2 + 1];
  u4v bfrag[8];
#pragma unroll
  for (int nt = 0; nt < 8; ++nt) {
    if (g4 < 2) bfrag[nt] = *(const u4v*)(p.bbarT + ((size_t)tg * 128 + nt * 16 + l15) * 16 + g4 * 8);
    else bfrag[nt] = (u4v){0u, 0u, 0u, 0u};
  }
  u4v cfrag[4];
#pragma unroll
  for (int ks = 0; ks < 4; ++ks) cfrag[ks] = *(const u4v*)(p.cmT + ((size_t)tg * 16 + l15) * 128 + ks * 32 + g4 * 8);
  float xr = 0.f, xi = 0.f;
  if (latent) {
    const float* h0 = p.state_ssm + ((size_t)(((b * 2 + l) * 2 + dir) * 32 + g) * 64 + lane) * 2;
    xr = h0[0]; xi = h0[1];
  }
  u16* yd = p.YD + (size_t)dir * TALL * 512;
  __syncthreads();
  const int nsub = L >> 4;
#pragma unroll 1
  for (int sub = 0; sub < nsub; ++sub) {
    u4v af;
    {
      const int tau = sub * 16 + l15;
      const int pos = dir == 0 ? tau : L - 1 - tau;
      if (g4 < 2) af = *(const u4v*)(p.SU + (size_t)(tokbase + pos) * 512 + g * 16 + g4 * 8);
      else af = (u4v){0u, 0u, 0u, 0u};
    }
#pragma unroll
    for (int nt = 0; nt < 8; ++nt) {
      f4v c = (f4v){0.f, 0.f, 0.f, 0.f};
      c = __builtin_amdgcn_mfma_f32_16x16x32_bf16(bc8(af), bc8(bfrag[nt]), c, 0, 0, 0);
#pragma unroll
      for (int r = 0; r < 4; ++r) buf[(g4 * 4 + r) * 132 + nt * 16 + l15] = c[r];
    }
    __syncthreads();
#pragma unroll
    for (int i = 0; i < 16; ++i) {
      const float bur = buf[i * 132 + lane], bui = buf[i * 132 + 64 + lane];
      const float nr = ar * xr - ai * xi + bur;
      const float ni = ar * xi + ai * xr + bui;
      xr = nr; xi = ni;
      buf[i * 132 + lane] = xr;
      buf[i * 132 + 64 + lane] = xi;
    }
    __syncthreads();
    f4v y = (f4v){0.f, 0.f, 0.f, 0.f};
#pragma unroll
    for (int ks = 0; ks < 4; ++ks) {
      const float* bp = buf + l15 * 132 + ks * 32 + g4 * 8;
      float4 v0 = *(const float4*)(bp), v1 = *(const float4*)(bp + 4);
      const u4v xa = (u4v){pack2(v0.x, v0.y), pack2(v0.z, v0.w), pack2(v1.x, v1.y), pack2(v1.z, v1.w)};
      y = __builtin_amdgcn_mfma_f32_16x16x32_bf16(bc8(xa), bc8(cfrag[ks]), y, 0, 0, 0);
    }
#pragma unroll
    for (int r = 0; r < 4; ++r) {
      const int tau = sub * 16 + g4 * 4 + r;
      const int pos = dir == 0 ? tau : L - 1 - tau;
      yd[(size_t)(tokbase + pos) * 512 + g * 16 + l15] = f2bf(y[r]);
    }
    __syncthreads();
  }
  if (!latent) {
    float* o = p.out + OUT_SSSM + ((size_t)(((b * 2 + l) * 2 + dir) * 32 + g) * 64 + lane) * 2;
    o[0] = xr; o[1] = xi;
  }
}

#define MX_S5 320
#define MX_RET 512
#define MX_NA 512
#define MX_CA 512
#define MX_RS 128
#define MX_ITEMS (MX_S5 + MX_RET + MX_NA + MX_CA + MX_RS)
__device__ __forceinline__ void mixer_item(const Params& p, char* smem, int l, int item) {
  if (item < 64) { s5_item(p, smem, l, item); return; }
  item -= 64;
  if (item < 256) { attn_item<128, 0>(p, smem, l, item); return; }
  item -= 256;
  if (item < 512) { attn_item<64, 2>(p, smem, l, item); return; }
  item -= 512;
  if (item < 256) { s5_item(p, smem, l, 64 + item); return; }
  item -= 256;
  if (item < 256) { attn_item<128, 0>(p, smem, l, 256 + item); return; }
  item -= 256;
  if (item < 512) { attn_item<64, 1>(p, smem, l, item); return; }
  item -= 512;
  retstate_item(p, l, item);
}

__device__ __forceinline__ void p3a_item(const Params& p, char* smem, int l, int item) {
  const int mt = item & 63, nt = item >> 6;
  const int m0 = mt * 128, n0 = nt * 128;
  const int tid = ltid(), lane = tid & 63, wave = tid >> 6, wm = wave >> 1, wn = wave & 1;
  AArgs a{};
  a.SU = p.SU; a.YD0 = p.YD; a.YD1 = p.YD + (size_t)TALL * 512; a.dsk = p.ssm_d + l * 512;
  f16v acc[2][2];
  gemm_mainloop<2>(smem, a, p.w_glu + (size_t)l * 512 * 512, 512, 512, m0, n0, acc);
#pragma unroll
  for (int mi = 0; mi < 2; ++mi)
#pragma unroll
    for (int reg = 0; reg < 16; ++reg) {
      const int row = EPI_ROW(mi, reg);
#pragma unroll
      for (int ni = 0; ni < 2; ++ni) {
        const int col = EPI_COL(ni);
        const size_t off = (size_t)row * 512 + col;
        float y = geluf_(a.dsk[col] * bf2f(p.SU[off]) + bf2f(a.YD0[off]) + bf2f(a.YD1[off]));
        p.sout[off] = f2bf(y * sigmoidf_(acc[mi][ni][reg]));
      }
    }
}

__device__ __forceinline__ void p3b_item(const Params& p, char* smem, int l, int item) {
  const int mt = item & 63, nt = item >> 6;
  const int m0 = mt * 128, n0 = nt * 128;
  const int tid = ltid(), lane = tid & 63, wave = tid >> 6, wm = wave >> 1, wn = wave & 1;
  int nbr = 3;
  asm volatile("" : "+s"(nbr));
#pragma unroll 1
  for (int br = 0; br < nbr; ++br) {
    AArgs a{};
    a.A16 = br == 0 ? p.rout : (br == 1 ? p.sout : p.nout); a.lda = 512;
    f16v acc[2][2];
    gemm_mainloop<0>(smem, a, p.w_branch + ((size_t)l * 3 + br) * 512 * 1024, 1024, 512, m0, n0, acc);
#pragma unroll
    for (int mi = 0; mi < 2; ++mi)
#pragma unroll
      for (int reg = 0; reg < 16; ++reg) {
        const int row = EPI_ROW(mi, reg);
        const u16* gp = p.GT + (size_t)row * 3072 + br * 1024 + EPI_COL(0);
        u16* mp = p.merged + (size_t)row * 1024 + EPI_COL(0);
        float t0 = bf2f(gp[0]) * acc[mi][0][reg];
        float t1 = bf2f(gp[32]) * acc[mi][1][reg];
        if (br > 0) { t0 += bf2f(mp[0]); t1 += bf2f(mp[32]); }
        mp[0] = f2bf(t0);
        mp[32] = f2bf(t1);
      }
  }
}

__device__ __forceinline__ void p3c_item(const Params& p, char* smem, int l, int item) {
  const int mt = item & 63, nt = item >> 6;
  const int m0 = mt * 128, n0 = nt * 128;
  const int tid = ltid(), lane = tid & 63, wave = tid >> 6, wm = wave >> 1, wn = wave & 1;
  AArgs a{};
  a.A16 = p.merged; a.lda = 1024;
  f16v acc[2][2];
  gemm_mainloop<0>(smem, a, p.w_o + (size_t)l * 1024 * 1024, 1024, 1024, m0, n0, acc);
  const int ci = cond_of_row(m0);
  const float* g1 = p.mod + (l * 5 + ci) * 6144 + 2048;
  float* st1 = p.stats + (size_t)(l * 2 + 0) * TALL * 2;
  const float* st2p = p.stats + (size_t)(0 * 2 + 1) * TALL * 2;
  const int c0 = EPI_COL(0), c1 = EPI_COL(1);
  const float g1a = g1[c0], g1b = g1[c1];
  float lga = 1.f, lgb = 1.f, lba = 0.f, lbb = 0.f;
  if (l == 1) { lga = p.ln2_g[c0]; lgb = p.ln2_g[c1]; lba = p.ln2_b[c0]; lbb = p.ln2_b[c1]; }
#pragma unroll
  for (int mi = 0; mi < 2; ++mi)
#pragma unroll
    for (int reg = 0; reg < 16; ++reg) {
      const int row = EPI_ROW(mi, reg);
      float xa, xb;
      if (l == 0) {
        const float* xr = row < TCTX ? p.x_prompt + (size_t)row * 1024 : p.x_sample + (size_t)(row - TCTX) * 1024;
        xa = xr[c0]; xb = xr[c1];
      } else {
        const float s = st2p[row * 2], q = st2p[row * 2 + 1];
        const float mu = s * (1.f / 1024.f);
        const float rstd = rsqrtf(fmaxf(q * (1.f / 1024.f) - mu * mu, 0.f) + LNEPS);
        xa = (p.out[(size_t)row * 1024 + c0] - mu) * rstd * lga + lba;
        xb = (p.out[(size_t)row * 1024 + c1] - mu) * rstd * lgb + lbb;
      }
      const float va = ALPHA * xa + g1a * acc[mi][0][reg];
      const float vb = ALPHA * xb + g1b * acc[mi][1][reg];
      p.pre1[(size_t)row * 1024 + c0] = va;
      p.pre1[(size_t)row * 1024 + c1] = vb;
      stats_accum(st1, row, va, vb, lane);
    }
}

__device__ __forceinline__ void p4_item(const Params& p, char* smem, int l, int item) {
  const int mt = item & 63, nt = item >> 6;
  const int m0 = mt * 128, n0 = nt * 128;
  const int tid = ltid(), lane = tid & 63, wave = tid >> 6, wm = wave >> 1, wn = wave & 1;
  AArgs a{};
  const float* mod = p.mod + l * 5 * 6144;
  a.A32lo = p.pre1; a.A32hi = p.pre1 + (size_t)TCTX * 1024; a.stats = p.stats + (size_t)(l * 2 + 0) * TALL * 2;
  a.lng = p.ln1_g + l * 1024; a.lnb = p.ln1_b + l * 1024;
  a.sc = mod + 4 * 1024; a.sh = mod + 3 * 1024;
  f16v acc[2][2];
  gemm_mainloop<1>(smem, a, p.w_up + (size_t)l * 1024 * 5632, 5632, 1024, m0, n0, acc);
#pragma unroll
  for (int mi = 0; mi < 2; ++mi)
#pragma unroll
    for (int reg = 0; reg < 16; ++reg) {
      const int row = EPI_ROW(mi, reg);
#pragma unroll
      for (int ni = 0; ni < 2; ++ni) p.z2[(size_t)row * 5632 + EPI_COL(ni)] = f2bf(acc[mi][ni][reg]);
    }
}

__device__ __forceinline__ void p4b_item(const Params& p, int l, int item) {
  const float* cw = p.conv_w + (size_t)l * 3 * 5632;
  const float* cb = p.conv_b + (size_t)l * 5632;
  for (int i = ltid(); i < 16 * 352; i += 256) {
    const int row = item * 16 + i / 352, v = i % 352;
    const int j0 = v * 8;
    int pos, L;
    if (row < TCTX) { pos = row & 255; L = 256; } else { pos = (row - TCTX) & 1023; L = 1024; }
    const bool hp = pos > 0, hn = pos < L - 1;
    const u16* zr = p.z2 + (size_t)row * 5632;
    uint4 zero = make_uint4(0, 0, 0, 0);
    uint4 a0 = hp ? *(const uint4*)(zr - 5632 + j0) : zero;
    uint4 a1 = *(const uint4*)(zr + j0);
    uint4 a2 = hn ? *(const uint4*)(zr + 5632 + j0) : zero;
    uint4 b0 = hp ? *(const uint4*)(zr - 5632 + 2816 + j0) : zero;
    uint4 b1 = *(const uint4*)(zr + 2816 + j0);
    uint4 b2 = hn ? *(const uint4*)(zr + 5632 + 2816 + j0) : zero;
    unsigned aw0[4] = {a0.x, a0.y, a0.z, a0.w}, aw1[4] = {a1.x, a1.y, a1.z, a1.w}, aw2[4] = {a2.x, a2.y, a2.z, a2.w};
    unsigned bw0[4] = {b0.x, b0.y, b0.z, b0.w}, bw1[4] = {b1.x, b1.y, b1.z, b1.w}, bw2[4] = {b2.x, b2.y, b2.z, b2.w};
    unsigned ow[4];
#pragma unroll
    for (int w = 0; w < 4; ++w) {
      const int j = j0 + 2 * w;
      float av0 = cw[j] * bflo(aw0[w]) + cw[5632 + j] * bflo(aw1[w]) + cw[2 * 5632 + j] * bflo(aw2[w]) + cb[j];
      float av1 = cw[j + 1] * bfhi(aw0[w]) + cw[5632 + j + 1] * bfhi(aw1[w]) + cw[2 * 5632 + j + 1] * bfhi(aw2[w]) + cb[j + 1];
      const int jb = j + 2816;
      float bv0 = cw[jb] * bflo(bw0[w]) + cw[5632 + jb] * bflo(bw1[w]) + cw[2 * 5632 + jb] * bflo(bw2[w]) + cb[jb];
      float bv1 = cw[jb + 1] * bfhi(bw0[w]) + cw[5632 + jb + 1] * bfhi(bw1[w]) + cw[2 * 5632 + jb + 1] * bfhi(bw2[w]) + cb[jb + 1];
      ow[w] = pack2(geluf_(av0) * bv0, geluf_(av1) * bv1);
    }
    *(uint4*)(p.act + (size_t)row * 2816 + j0) = make_uint4(ow[0], ow[1], ow[2], ow[3]);
  }
}

__device__ __forceinline__ void p5_item(const Params& p, char* smem, int l, int item) {
  const int mt = item & 63, nt = item >> 6;
  const int m0 = mt * 128, n0 = nt * 128;
  const int tid = ltid(), lane = tid & 63, wave = tid >> 6, wm = wave >> 1, wn = wave & 1;
  AArgs a{};
  a.A16 = p.act; a.lda = 2816;
  f16v acc[2][2];
  gemm_mainloop<0>(smem, a, p.w_down + (size_t)l * 2816 * 1024, 1024, 2816, m0, n0, acc);
  const int ci = cond_of_row(m0);
  const float* g2 = p.mod + (l * 5 + ci) * 6144 + 5 * 1024;
  const float* st1 = p.stats + (size_t)(l * 2 + 0) * TALL * 2;
  float* st2 = p.stats + (size_t)(l * 2 + 1) * TALL * 2;
  const int c0 = EPI_COL(0), c1 = EPI_COL(1);
  const float g2a = g2[c0], g2b = g2[c1];
  const float lga = p.ln1_g[l * 1024 + c0], lgb = p.ln1_g[l * 1024 + c1];
  const float lba = p.ln1_b[l * 1024 + c0], lbb = p.ln1_b[l * 1024 + c1];
#pragma unroll
  for (int mi = 0; mi < 2; ++mi)
#pragma unroll
    for (int reg = 0; reg < 16; ++reg) {
      const int row = EPI_ROW(mi, reg);
      const float s = st1[row * 2], q = st1[row * 2 + 1];
      const float mu = s * (1.f / 1024.f);
      const float rstd = rsqrtf(fmaxf(q * (1.f / 1024.f) - mu * mu, 0.f) + LNEPS);
      const float xa = (p.pre1[(size_t)row * 1024 + c0] - mu) * rstd * lga + lba;
      const float xb = (p.pre1[(size_t)row * 1024 + c1] - mu) * rstd * lgb + lbb;
      const float va = ALPHA * xa + g2a * acc[mi][0][reg];
      const float vb = ALPHA * xb + g2b * acc[mi][1][reg];
      p.out[(size_t)row * 1024 + c0] = va;
      p.out[(size_t)row * 1024 + c1] = vb;
      stats_accum(st2, row, va, vb, lane);
    }
}

__device__ __forceinline__ void final_item(const Params& p, int item) {
  const float* st = p.stats + (size_t)(1 * 2 + 1) * TALL * 2;
  const int c = ltid() * 4;
  const float4 g = *(const float4*)(p.ln2_g + 1024 + c);
  const float4 b = *(const float4*)(p.ln2_b + 1024 + c);
  for (int r = 0; r < 8; ++r) {
    const int row = item * 8 + r;
    const float s = st[row * 2], q = st[row * 2 + 1];
    const float mu = s * (1.f / 1024.f);
    const float rstd = rsqrtf(fmaxf(q * (1.f / 1024.f) - mu * mu, 0.f) + LNEPS);
    float4 v = *(float4*)(p.out + (size_t)row * 1024 + c);
    v.x = (v.x - mu) * rstd * g.x + b.x;
    v.y = (v.y - mu) * rstd * g.y + b.y;
    v.z = (v.z - mu) * rstd * g.z + b.z;
    v.w = (v.w - mu) * rstd * g.w + b.w;
    *(float4*)(p.out + (size_t)row * 1024 + c) = v;
  }
}

#define NPHASES 18
#define RUN_PHASE(PH, N, CALL)                                              \
  if (ph_lo <= (PH) && (PH) < ph_hi) {                                      \
    for (int it = blockIdx.x; it < (N); it += nb) { CALL; }                 \
    if ((PH) + 1 < ph_hi) cg::this_grid().sync();                           \
  }
#define RUN_LAYER(L)                                                        \
  RUN_PHASE(1 + 8 * (L) + 0, 64 * 56, p1_item(p, smem, (L), it))            \
  RUN_PHASE(1 + 8 * (L) + 1, MX_ITEMS, mixer_item(p, smem, (L), it))        \
  RUN_PHASE(1 + 8 * (L) + 2, 64 * 4, p3a_item(p, smem, (L), it))            \
  RUN_PHASE(1 + 8 * (L) + 3, 64 * 8, p3b_item(p, smem, (L), it))            \
  RUN_PHASE(1 + 8 * (L) + 4, 64 * 8, p3c_item(p, smem, (L), it))            \
  RUN_PHASE(1 + 8 * (L) + 5, 64 * 44, p4_item(p, smem, (L), it))            \
  RUN_PHASE(1 + 8 * (L) + 6, 512, p4b_item(p, (L), it))                     \
  RUN_PHASE(1 + 8 * (L) + 7, 64 * 8, p5_item(p, smem, (L), it))

__global__ void __launch_bounds__(256, 2) mega(Params p, int ph_lo, int ph_hi) {
  __shared__ __attribute__((aligned(16))) char smem[49152];
  const int nb = gridDim.x;
  RUN_PHASE(0, P0_ITEMS, phase0_item(p, smem, it))
  RUN_LAYER(0)
  RUN_LAYER(1)
  RUN_PHASE(17, 1024, final_item(p, it))
}

extern "C" void kernel_launch(void* const* d_in, const int* in_sizes, int n_in, void* d_out, int out_size, void* d_ws,
                              size_t ws_size, hipStream_t stream) {
  Params p{};
  const float** ins = (const float**)&p;
  for (int i = 0; i < 32; ++i) ins[i] = (const float*)d_in[i];
  p.out = (float*)d_out;
  char* ws = (char*)d_ws;
  size_t off = 0;
  auto take = [&](size_t bytes) { char* r = ws + off; off += (bytes + 255) & ~(size_t)255; return r; };
  p.mod = (float*)take(2 * 5 * 6144 * 4);
  p.stats = (float*)take(2 * 2 * TALL * 2 * 4);
  const size_t zero_bytes = off;
  p.ropetab = (float*)take(64 * 32 * 2 * 4);
  p.abar = (float*)take(2 * 2 * 32 * 64 * 2 * 4);
  p.bbarT = (u16*)take(2 * 2 * 32 * 128 * 16 * 2);
  p.cmT = (u16*)take(2 * 2 * 32 * 16 * 128 * 2);
  p.CK = (u16*)take((size_t)2 * 4 * 512 * 512 * 2);
  p.CVt = (u16*)take((size_t)2 * 4 * 512 * 512 * 2);
  p.S0t = (u16*)take((size_t)2 * 4 * 2 * 4 * 128 * 128 * 2);
  p.pre1 = (float*)take((size_t)TALL * 1024 * 4);
  const size_t region = off;
  const size_t E = (size_t)TALL * 512 * 2;
  p.Q = (u16*)take(E); p.K = (u16*)take(E); p.VtR = (u16*)take(E); p.KtR = (u16*)take(E / 2);
  p.G = (u16*)take(E); p.SU = (u16*)take(E); p.NQ = (u16*)take(E); p.NK = (u16*)take(E); p.NVt = (u16*)take(E);
  p.GT = (u16*)take((size_t)TALL * 3072 * 2);
  p.rout = (u16*)take(E); p.sout = (u16*)take(E); p.nout = (u16*)take(E);
  p.YD = (u16*)take(2 * E);
  p.merged = p.YD;
  const size_t total = off;
  p.z2 = (u16*)(ws + region);
  p.act = (u16*)(ws + region + (size_t)TALL * 5632 * 2);
  if (total > ws_size || region + (size_t)TALL * (5632 + 2816) * 2 > total) {
    fprintf(stderr, "kernel_launch: workspace too small (%zu needed, %zu given)\n", total, ws_size);
    return;
  }
  hipMemsetAsync(ws, 0, zero_bytes, stream);
#if SINGLE_LAUNCH
  static int grid_blocks = 0;
  if (!grid_blocks) {
    int dev = 0, cus = 0, per_cu = 0;
    hipGetDevice(&dev);
    hipDeviceGetAttribute(&cus, hipDeviceAttributeMultiprocessorCount, dev);
    hipOccupancyMaxActiveBlocksPerMultiprocessor(&per_cu, mega, 256, 0);
    if (per_cu > 2) per_cu = 2;
    if (per_cu < 1) per_cu = 1;
    grid_blocks = cus * per_cu;
  }
  int lo = 0, hi = NPHASES;
  void* args[] = {&p, &lo, &hi};
  hipError_t e = hipLaunchCooperativeKernel((void*)mega, dim3(grid_blocks), dim3(256), args, 0, stream);
  if (e != hipSuccess) fprintf(stderr, "cooperative launch failed: %s (grid %d)\n", hipGetErrorString(e), grid_blocks);
#else
  for (int ph = 0; ph < NPHASES; ++ph) {
    hipLaunchKernelGGL(mega, dim3(512), dim3(256), 0, stream, p, ph, ph + 1);
  }
#endif
}
```

```cpp
#include <hip/hip_runtime.h>
#include <hip/hip_cooperative_groups.h>
#include <cstdio>
namespace cg = cooperative_groups;

#ifndef SINGLE_LAUNCH
#define SINGLE_LAUNCH 1
#endif

typedef __attribute__((ext_vector_type(8))) short s8v;
typedef __attribute__((ext_vector_type(4))) float f4v;
typedef __attribute__((ext_vector_type(16))) float f16v;
typedef unsigned short u16;
typedef __attribute__((ext_vector_type(4))) unsigned u4v;
__device__ __forceinline__ s8v bc8(u4v x) { return __builtin_bit_cast(s8v, x); }


#define TALL 8192
#define TCTX 4096
#define ALPHA 1.41421356237309515f
#define LNEPS 1e-5f
#define VTR_LAT 2097152
#define NVT_LAT 2097152
#define OUT_SRET 8388608
#define OUT_SSSM 12582912
#define OUT_CK 12845056
#define OUT_CV 17039360

struct Params {
  const float *x_prompt, *x_sample, *state_ret, *state_ssm, *cache_k, *cache_v, *c, *c_ctx;
  const float *w_ada, *b_ada, *w_in, *ret_decay, *a_re, *a_im, *log_dt, *b_re, *b_im, *c_re, *c_im;
  const float *ssm_d, *w_glu, *rpb, *w_branch, *w_o, *ln1_g, *ln1_b, *w_up, *conv_w, *conv_b, *w_down, *ln2_g, *ln2_b;
  float* out;
  float *mod, *stats, *ropetab, *abar, *pre1;
  u16 *bbarT, *cmT, *CK, *CVt, *S0t;
  u16 *Q, *K, *VtR, *KtR, *G, *SU, *NQ, *NK, *NVt, *GT, *rout, *sout, *nout, *YD, *merged, *z2, *act;
};

__device__ __forceinline__ u16 f2bf(float f) {
  unsigned u = __float_as_uint(f);
  u += 0x7fffu + ((u >> 16) & 1u);
  return (u16)(u >> 16);
}
__device__ __forceinline__ float bf2f(unsigned h) { return __uint_as_float((h & 0xffffu) << 16); }
__device__ __forceinline__ float bflo(unsigned w) { return __uint_as_float(w << 16); }
__device__ __forceinline__ float bfhi(unsigned w) { return __uint_as_float(w & 0xffff0000u); }
__device__ __forceinline__ unsigned pack2(float a, float b) { return (unsigned)f2bf(a) | ((unsigned)f2bf(b) << 16); }
__device__ __forceinline__ float sigmoidf_(float x) { return 1.f / (1.f + __expf(-x)); }
__device__ __forceinline__ float siluf_(float x) { return x / (1.f + __expf(-x)); }
__device__ __forceinline__ float geluf_(float x) {
  float u = 0.7978845608028654f * (x + 0.044715f * x * x * x);
  float e = __expf(2.f * u);
  float t = 1.f - 2.f / (e + 1.f);
  return 0.5f * x * (1.f + t);
}
__device__ __forceinline__ f16v zero16() {
  return (f16v){0.f, 0.f, 0.f, 0.f, 0.f, 0.f, 0.f, 0.f, 0.f, 0.f, 0.f, 0.f, 0.f, 0.f, 0.f, 0.f};
}
__device__ __forceinline__ int ltid() { int t = threadIdx.x; asm volatile("" : "+v"(t)); return t; }
__device__ __forceinline__ int cond_of_row(int row) { return row < TCTX ? 0 : 1 + ((row - TCTX) >> 10); }

struct AArgs {
  const u16* A16; int lda;
  const float* A32lo; const float* A32hi;
  const float* stats;
  const float* lng; const float* lnb;
  const float* sc; const float* sh;
  const u16* SU; const u16* YD0; const u16* YD1; const float* dsk;
};

#define LDS_AS 0
#define LDS_BS (2 * 128 * 40 * 2)
#define LDS_GS (LDS_BS + 2 * 128 * 40 * 2)

template <int AMODE>
__device__ __forceinline__ void gemm_mainloop(char* smem, const AArgs& a, const float* __restrict__ W, int ldw, int K,
                                              int m0, int n0, f16v (&acc)[2][2]) {
  u16* As = (u16*)(smem + LDS_AS);
  u16* Bs = (u16*)(smem + LDS_BS);
  float* Gs = (float*)(smem + LDS_GS);
  float* Bv = Gs + 1024;
  const int tid = ltid(), lane = tid & 63, wave = tid >> 6;
  const int wm = wave >> 1, wn = wave & 1;
  const int ar = tid >> 1, akh = tid & 1;
  const int bn = tid & 31, bk = tid >> 5;
  const int row = m0 + ar;
  float mu = 0.f, rstd = 1.f;
  const float* srow = nullptr;
  __syncthreads();
  if constexpr (AMODE == 1) {
    const int ci = cond_of_row(m0);
    for (int k = tid; k < 1024; k += 256) {
      float sc = a.sc[ci * 6144 + k], sh = a.sh[ci * 6144 + k];
      float g = a.lng ? a.lng[k] : 1.f, b = a.lnb ? a.lnb[k] : 0.f;
      Gs[k] = g * (1.f + sc);
      Bv[k] = b * (1.f + sc) + sh;
    }
    if (a.stats) {
      float s = a.stats[row * 2], q = a.stats[row * 2 + 1];
      mu = s * (1.f / 1024.f);
      float var = q * (1.f / 1024.f) - mu * mu;
      rstd = rsqrtf(fmaxf(var, 0.f) + LNEPS);
    }
    srow = row < TCTX ? a.A32lo + (size_t)row * 1024 : a.A32hi + (size_t)(row - TCTX) * 1024;
    __syncthreads();
  }
  acc[0][0] = zero16(); acc[0][1] = zero16(); acc[1][0] = zero16(); acc[1][1] = zero16();

  uint4 ra[6];
  float4 rb[4];
  auto issue = [&](int kt) {
    const int k0 = kt * 32 + akh * 16;
    if constexpr (AMODE == 0) {
      const uint4* p = (const uint4*)(a.A16 + (size_t)row * a.lda + k0);
      ra[0] = p[0]; ra[1] = p[1];
    } else if constexpr (AMODE == 1) {
      const uint4* p = (const uint4*)(srow + k0);
      ra[0] = p[0]; ra[1] = p[1]; ra[2] = p[2]; ra[3] = p[3];
    } else {
      const uint4* p0 = (const uint4*)(a.SU + (size_t)row * 512 + k0);
      const uint4* p1 = (const uint4*)(a.YD0 + (size_t)row * 512 + k0);
      const uint4* p2 = (const uint4*)(a.YD1 + (size_t)row * 512 + k0);
      ra[0] = p0[0]; ra[1] = p0[1]; ra[2] = p1[0]; ra[3] = p1[1]; ra[4] = p2[0]; ra[5] = p2[1];
    }
    const float* wp = W + (size_t)(kt * 32 + bk * 4) * ldw + n0 + bn * 4;
#pragma unroll
    for (int i = 0; i < 4; ++i) rb[i] = *(const float4*)(wp + (size_t)i * ldw);
  };
  auto stage = [&](int buf, int kt) {
    uint4 o0, o1;
    if constexpr (AMODE == 0) {
      o0 = ra[0]; o1 = ra[1];
    } else if constexpr (AMODE == 1) {
      const int k0 = kt * 32 + akh * 16;
      unsigned w[8];
#pragma unroll
      for (int i = 0; i < 4; ++i) {
        float4 g = *(const float4*)(Gs + k0 + i * 4);
        float4 b = *(const float4*)(Bv + k0 + i * 4);
        float x0 = __uint_as_float(ra[i].x), x1 = __uint_as_float(ra[i].y), x2 = __uint_as_float(ra[i].z), x3 = __uint_as_float(ra[i].w);
        float h0 = (x0 - mu) * rstd * g.x + b.x;
        float h1 = (x1 - mu) * rstd * g.y + b.y;
        float h2 = (x2 - mu) * rstd * g.z + b.z;
        float h3 = (x3 - mu) * rstd * g.w + b.w;
        w[i * 2] = pack2(h0, h1); w[i * 2 + 1] = pack2(h2, h3);
      }
      o0 = make_uint4(w[0], w[1], w[2], w[3]); o1 = make_uint4(w[4], w[5], w[6], w[7]);
    } else {
      const int k0 = kt * 32 + akh * 16;
      unsigned w[8];
#pragma unroll
      for (int i = 0; i < 2; ++i) {
        unsigned su[4] = {ra[i].x, ra[i].y, ra[i].z, ra[i].w};
        unsigned y0[4] = {ra[2 + i].x, ra[2 + i].y, ra[2 + i].z, ra[2 + i].w};
        unsigned y1[4] = {ra[4 + i].x, ra[4 + i].y, ra[4 + i].z, ra[4 + i].w};
#pragma unroll
        for (int j = 0; j < 4; ++j) {
          float d0 = a.dsk[k0 + i * 8 + j * 2], d1 = a.dsk[k0 + i * 8 + j * 2 + 1];
          float v0 = geluf_(d0 * bflo(su[j]) + bflo(y0[j]) + bflo(y1[j]));
          float v1 = geluf_(d1 * bfhi(su[j]) + bfhi(y0[j]) + bfhi(y1[j]));
          w[i * 4 + j] = pack2(v0, v1);
        }
      }
      o0 = make_uint4(w[0], w[1], w[2], w[3]); o1 = make_uint4(w[4], w[5], w[6], w[7]);
    }
    uint4* ap = (uint4*)(As + buf * (128 * 40) + ar * 40 + akh * 16);
    ap[0] = o0; ap[1] = o1;
    u16* bp = Bs + buf * (128 * 40) + (bn * 4) * 40 + bk * 4;
    *(uint2*)(bp) = make_uint2(pack2(rb[0].x, rb[1].x), pack2(rb[2].x, rb[3].x));
    *(uint2*)(bp + 40) = make_uint2(pack2(rb[0].y, rb[1].y), pack2(rb[2].y, rb[3].y));
    *(uint2*)(bp + 80) = make_uint2(pack2(rb[0].z, rb[1].z), pack2(rb[2].z, rb[3].z));
    *(uint2*)(bp + 120) = make_uint2(pack2(rb[0].w, rb[1].w), pack2(rb[2].w, rb[3].w));
  };

  const int nk = K >> 5;
  issue(0);
  stage(0, 0);
  __syncthreads();
#pragma unroll 1
  for (int kt = 0; kt < nk; ++kt) {
    const int buf = kt & 1;
    if (kt + 1 < nk) issue(kt + 1);
    const u16* Ab = As + buf * (128 * 40) + (wm * 64 + (lane & 31)) * 40 + (lane >> 5) * 8;
    const u16* Bb = Bs + buf * (128 * 40) + (wn * 64 + (lane & 31)) * 40 + (lane >> 5) * 8;
#pragma unroll
    for (int ks = 0; ks < 2; ++ks) {
      s8v af0 = *(const s8v*)(Ab + ks * 16);
      s8v af1 = *(const s8v*)(Ab + 32 * 40 + ks * 16);
      s8v bf0 = *(const s8v*)(Bb + ks * 16);
      s8v bf1 = *(const s8v*)(Bb + 32 * 40 + ks * 16);
      acc[0][0] = __builtin_amdgcn_mfma_f32_32x32x16_bf16(af0, bf0, acc[0][0], 0, 0, 0);
      acc[0][1] = __builtin_amdgcn_mfma_f32_32x32x16_bf16(af0, bf1, acc[0][1], 0, 0, 0);
      acc[1][0] = __builtin_amdgcn_mfma_f32_32x32x16_bf16(af1, bf0, acc[1][0], 0, 0, 0);
      acc[1][1] = __builtin_amdgcn_mfma_f32_32x32x16_bf16(af1, bf1, acc[1][1], 0, 0, 0);
    }
    if (kt + 1 < nk) stage(buf ^ 1, kt + 1);
    __syncthreads();
  }
}

#define EPI_ROW(mi, reg) (m0 + wm * 64 + (mi) * 32 + ((reg) & 3) + 8 * ((reg) >> 2) + 4 * (lane >> 5))
#define EPI_COL(ni) (n0 + wn * 64 + (ni) * 32 + (lane & 31))

__device__ __forceinline__ void stats_accum(float* stats, int row, float v0, float v1, int lane) {
  float s = v0 + v1, q = v0 * v0 + v1 * v1;
#pragma unroll
  for (int o = 1; o < 32; o <<= 1) {
    s += __shfl_xor(s, o);
    q += __shfl_xor(q, o);
  }
  if ((lane & 31) == 0) {
    atomicAdd(stats + row * 2, s);
    atomicAdd(stats + row * 2 + 1, q);
  }
}

#define P0_ADA 768
#define P0_ROPE 1
#define P0_CACHE 64
#define P0_S0 64
#define P0_S5 128
#define P0_ITEMS (P0_ADA + P0_ROPE + P0_CACHE + P0_S0 + P0_S5)

__device__ __forceinline__ void phase0_item(const Params& p, char* smem, int item) {
  const int tid = ltid();
  if (item < P0_ADA) {
    const int ks = item & 3, cg = (item >> 2) % 96, l = item / 384;
    float* scs = (float*)smem;
    float* red = scs + 5 * 256;
    __syncthreads();
    for (int i = tid; i < 5 * 256; i += 256) {
      int ci = i >> 8, k = ks * 256 + (i & 255);
      float v = ci == 0 ? p.c_ctx[k] : p.c[(ci - 1) * 1024 + k];
      scs[i] = siluf_(v);
    }
    __syncthreads();
    const int ct = tid & 15, kg = tid >> 4;
    const float* wp = p.w_ada + (size_t)l * 1024 * 6144 + (size_t)(ks * 256 + kg * 16) * 6144 + cg * 64 + ct * 4;
    float acc[5][4];
#pragma unroll
    for (int i = 0; i < 5; ++i)
#pragma unroll
      for (int j = 0; j < 4; ++j) acc[i][j] = 0.f;
#pragma unroll 4
    for (int k = 0; k < 16; ++k) {
      float4 w = *(const float4*)(wp + (size_t)k * 6144);
#pragma unroll
      for (int ci = 0; ci < 5; ++ci) {
        float s = scs[ci * 256 + kg * 16 + k];
        acc[ci][0] += s * w.x; acc[ci][1] += s * w.y; acc[ci][2] += s * w.z; acc[ci][3] += s * w.w;
      }
    }
#pragma unroll
    for (int ci = 0; ci < 5; ++ci)
#pragma unroll
      for (int j = 0; j < 4; ++j) red[(kg * 5 + ci) * 64 + ct * 4 + j] = acc[ci][j];
    __syncthreads();
    for (int i = tid; i < 320; i += 256) {
      int ci = i >> 6, col = i & 63;
      float s = 0.f;
#pragma unroll
      for (int g = 0; g < 16; ++g) s += red[(g * 5 + ci) * 64 + col];
      if (ks == 0) s += p.b_ada[l * 6144 + cg * 64 + col];
      atomicAdd(p.mod + (l * 5 + ci) * 6144 + cg * 64 + col, s);
    }
    return;
  }
  item -= P0_ADA;
  if (item < P0_ROPE) {
    for (int i = tid; i < 64 * 32; i += 256) {
      int pos = i >> 5, fi = i & 31;
      float inv = (float)pow(10000.0, -(double)fi / 32.0);
      float ang = (float)pos * inv;
      p.ropetab[i * 2] = (float)cos((double)ang);
      p.ropetab[i * 2 + 1] = (float)sin((double)ang);
    }
    return;
  }
  item -= P0_ROPE;
  if (item < P0_CACHE) {
    const int pc = item & 7, b = (item >> 3) & 3, l = item >> 5;
    const float* ksrc = p.cache_k + ((size_t)(b * 2 + l) * 512 + pc * 64) * 512;
    const float* vsrc = p.cache_v + ((size_t)(b * 2 + l) * 512 + pc * 64) * 512;
    u16* kdst = p.CK + ((size_t)(l * 4 + b) * 512 + pc * 64) * 512;
    for (int i = tid; i < 64 * 512 / 4; i += 256) {
      float4 v = *(const float4*)(ksrc + (size_t)i * 4);
      *(uint2*)(kdst + (size_t)i * 4) = make_uint2(pack2(v.x, v.y), pack2(v.z, v.w));
    }
    for (int cc = 0; cc < 2; ++cc) {
      const int col = tid + cc * 256;
      u16* vdst = p.CVt + ((size_t)(l * 4 + b) * 512 + col) * 512 + pc * 64;
      for (int j = 0; j < 8; ++j) {
        float v[8];
#pragma unroll
        for (int e = 0; e < 8; ++e) v[e] = vsrc[(size_t)(j * 8 + e) * 512 + col];
        *(uint4*)(vdst + j * 8) = make_uint4(pack2(v[0], v[1]), pack2(v[2], v[3]), pack2(v[4], v[5]), pack2(v[6], v[7]));
      }
    }
    return;
  }
  item -= P0_CACHE;
  if (item < P0_S0) {
    const int hh = item & 3, dir = (item >> 2) & 1, b = (item >> 3) & 3, l = item >> 5;
    const float* src = p.state_ret + ((size_t)(((b * 2 + l) * 2 + dir) * 4 + hh)) * 16384;
    u16* dst = p.S0t + ((size_t)(((l * 4 + b) * 2 + dir) * 4 + hh)) * 16384;
    const int dv = tid & 127, kh = tid >> 7;
    for (int j = 0; j < 8; ++j) {
      const int dk0 = kh * 64 + j * 8;
      float v[8];
#pragma unroll
      for (int e = 0; e < 8; ++e) v[e] = src[(size_t)(dk0 + e) * 128 + dv];
      *(uint4*)(dst + (size_t)dv * 128 + dk0) = make_uint4(pack2(v[0], v[1]), pack2(v[2], v[3]), pack2(v[4], v[5]), pack2(v[6], v[7]));
    }
    return;
  }
  item -= P0_S0;
  {
    const int g = item & 31, dir = (item >> 5) & 1, l = item >> 6;
    if (tid < 64) {
      const int pp = tid;
      const int ai = ((l * 2 + dir) * 32 + g) * 64 + pp;
      double lre = fmin((double)p.a_re[ai], -1e-4), lim = (double)p.a_im[ai];
      double dt = exp((double)p.log_dt[(l * 2 + dir) * 32 + g]);
      double er = exp(lre * dt);
      double abr = er * cos(lim * dt), abi = er * sin(lim * dt);
      p.abar[ai * 2] = (float)abr;
      p.abar[ai * 2 + 1] = (float)abi;
      double nr = abr - 1.0, ni = abi;
      double den = lre * lre + lim * lim;
      double cr = (nr * lre + ni * lim) / den, cim = (ni * lre - nr * lim) / den;
      u16* bt = p.bbarT + (size_t)((l * 2 + dir) * 32 + g) * 128 * 16;
      const float* br = p.b_re + ((size_t)(l * 32 + g) * 64 + pp) * 16;
      const float* bi = p.b_im + ((size_t)(l * 32 + g) * 64 + pp) * 16;
      for (int c = 0; c < 16; ++c) {
        double xr = br[c], xi = bi[c];
        bt[pp * 16 + c] = f2bf((float)(cr * xr - cim * xi));
        bt[(64 + pp) * 16 + c] = f2bf((float)(cr * xi + cim * xr));
      }
      u16* ct = p.cmT + (size_t)((l * 2 + dir) * 32 + g) * 16 * 128;
      const float* cre = p.c_re + ((size_t)((l * 2 + dir) * 32 + g) * 16) * 64;
      const float* cie = p.c_im + ((size_t)((l * 2 + dir) * 32 + g) * 16) * 64;
      for (int c = 0; c < 16; ++c) {
        ct[c * 128 + pp] = f2bf(cre[c * 64 + pp]);
        ct[c * 128 + 64 + pp] = f2bf(-cie[c * 64 + pp]);
      }
    }
  }
}

__device__ __forceinline__ void p1_item(const Params& p, char* smem, int l, int item) {
  const int mt = item & 63, nt = item >> 6;
  const int m0 = mt * 128, n0 = nt * 128;
  const int tid = ltid(), lane = tid & 63, wave = tid >> 6, wm = wave >> 1, wn = wave & 1;
  AArgs a{};
  const float* mod = p.mod + l * 5 * 6144;
  if (l == 0) {
    a.A32lo = p.x_prompt; a.A32hi = p.x_sample; a.stats = nullptr; a.lng = nullptr; a.lnb = nullptr;
  } else {
    a.A32lo = p.out; a.A32hi = p.out + (size_t)TCTX * 1024; a.stats = p.stats + (size_t)(0 * 2 + 1) * TALL * 2;
    a.lng = p.ln2_g; a.lnb = p.ln2_b;
  }
  a.sc = mod + 1024; a.sh = mod;
  f16v acc[2][2];
  gemm_mainloop<1>(smem, a, p.w_in + (size_t)l * 1024 * 7168, 7168, 1024, m0, n0, acc);

  const bool latent = m0 >= TCTX;
  const int seg = n0 >> 9;
  const int csw = (n0 & 511) + wn * 64;
  const int l31 = lane & 31;
  if (seg >= 8) {
    const int gc = (n0 - 4096) + wn * 64 + l31;
#pragma unroll
    for (int mi = 0; mi < 2; ++mi)
#pragma unroll
      for (int reg = 0; reg < 16; ++reg) {
        const int row = EPI_ROW(mi, reg);
        p.GT[(size_t)row * 3072 + gc] = f2bf(sigmoidf_(acc[mi][0][reg]));
        p.GT[(size_t)row * 3072 + gc + 32] = f2bf(sigmoidf_(acc[mi][1][reg]));
      }
    return;
  }
  if (seg <= 1) {
    u16* dst = seg == 0 ? p.Q : p.K;
    const float scl = seg == 0 ? 1.f : 0.08838834764831845f;
    const bool colhalf = (csw & 64) != 0;
#pragma unroll
    for (int mi = 0; mi < 2; ++mi)
#pragma unroll
      for (int q = 0; q < 4; ++q) {
        float o0[4], o1[4];
#pragma unroll
        for (int j = 0; j < 4; ++j) {
          const int reg = q * 4 + j;
          const int row = EPI_ROW(mi, reg);
          float x1 = acc[mi][0][reg], x2 = acc[mi][1][reg];
          if (latent) {
            const int pos = (row - TCTX) & 1023;
            const int pidx = colhalf ? (pos & 63) : (pos >> 6);
            const float cs = p.ropetab[(pidx * 32 + l31) * 2], sn = p.ropetab[(pidx * 32 + l31) * 2 + 1];
            float t1 = x1 * cs - x2 * sn, t2 = x1 * sn + x2 * cs;
            x1 = t1; x2 = t2;
          }
          x1 *= scl; x2 *= scl;
          o0[j] = x1; o1[j] = x2;
          dst[(size_t)row * 512 + csw + l31] = f2bf(x1);
          dst[(size_t)row * 512 + csw + 32 + l31] = f2bf(x2);
        }
        if (seg == 1 && !latent) {
          const int row0 = EPI_ROW(mi, q * 4);
          const int b = row0 >> 8, pos = row0 & 255;
          const int c0 = csw + l31, c1 = c0 + 32;
          *(uint2*)(p.KtR + ((size_t)(b * 4 + (c0 >> 7)) * 128 + (c0 & 127)) * 256 + pos) = make_uint2(pack2(o0[0], o0[1]), pack2(o0[2], o0[3]));
          *(uint2*)(p.KtR + ((size_t)(b * 4 + (c1 >> 7)) * 128 + (c1 & 127)) * 256 + pos) = make_uint2(pack2(o1[0], o1[1]), pack2(o1[2], o1[3]));
        }
      }
    return;
  }
  if (seg == 2 || seg == 7) {
#pragma unroll
    for (int mi = 0; mi < 2; ++mi)
#pragma unroll
      for (int q = 0; q < 4; ++q) {
        const int row0 = EPI_ROW(mi, q * 4);
#pragma unroll
        for (int ni = 0; ni < 2; ++ni) {
          const int col = csw + ni * 32 + l31;
          float v0 = acc[mi][ni][q * 4], v1 = acc[mi][ni][q * 4 + 1], v2 = acc[mi][ni][q * 4 + 2], v3 = acc[mi][ni][q * 4 + 3];
          uint2 pk = make_uint2(pack2(v0, v1), pack2(v2, v3));
          if (seg == 2) {
            const int hh = col >> 7, dd = col & 127;
            if (!latent) {
              const int b = row0 >> 8, pos = row0 & 255;
              *(uint2*)(p.VtR + ((size_t)(b * 4 + hh) * 128 + dd) * 256 + pos) = pk;
            } else {
              const int b = (row0 - TCTX) >> 10, pos = (row0 - TCTX) & 1023;
              *(uint2*)(p.VtR + VTR_LAT + ((size_t)(b * 4 + hh) * 128 + dd) * 1024 + pos) = pk;
            }
          } else {
            const int hh = col >> 6, dd = col & 63;
            if (!latent) {
              const int b = row0 >> 8, pos = row0 & 255;
              *(uint2*)(p.NVt + ((size_t)(b * 8 + hh) * 64 + dd) * 256 + pos) = pk;
              float* o = p.out + OUT_CV + ((size_t)(b * 2 + l) * 256 + pos) * 512 + col;
              o[0] = v0; o[512] = v1; o[1024] = v2; o[1536] = v3;
            } else {
              const int b = (row0 - TCTX) >> 10, pos = (row0 - TCTX) & 1023;
              *(uint2*)(p.NVt + NVT_LAT + ((size_t)(b * 8 + hh) * 64 + dd) * 1024 + pos) = pk;
            }
          }
        }
      }
    return;
  }
  u16* dst = seg == 3 ? p.G : seg == 4 ? p.SU : seg == 5 ? p.NQ : p.NK;
#pragma unroll
  for (int mi = 0; mi < 2; ++mi)
#pragma unroll
    for (int reg = 0; reg < 16; ++reg) {
      const int row = EPI_ROW(mi, reg);
#pragma unroll
      for (int ni = 0; ni < 2; ++ni) {
        const int col = csw + ni * 32 + l31;
        float v = acc[mi][ni][reg];
        float w = seg == 3 ? siluf_(v) : (seg == 5 ? v * 0.125f : v);
        dst[(size_t)row * 512 + col] = f2bf(w);
        if (seg == 6 && !latent) {
          const int b = row >> 8, pos = row & 255;
          p.out[OUT_CK + ((size_t)(b * 2 + l) * 256 + pos) * 512 + col] = v;
        }
      }
    }
}

template <int D, int MODE>
__device__ __forceinline__ void attn_item(const Params& p, char* smem, int l, int idx) {
  constexpr int KSTR = D + 8;
  constexpr int NKS = D / 32;
  constexpr int NB = D / 16;
  constexpr int NCH = D / 32;
  u16* Ks = (u16*)smem;
  u16* Vts = Ks + 64 * KSTR;
  float* rpbs = (float*)(Vts + D * 72);
  const int tid = ltid(), lane = tid & 63, wave = tid >> 6;
  const int l15 = lane & 15, g = lane >> 4;

  int b, hh, qt, L, tokbase, nt;
  bool latent = false;
  int kr0 = 0, rrow = 0;
  if constexpr (MODE == 0) {
    if (idx < 256) { latent = true; b = idx >> 6; hh = (idx >> 4) & 3; qt = idx & 15; L = 1024; tokbase = TCTX + b * 1024; nt = 16 + 4; }
    else { idx -= 256; b = idx >> 4; hh = (idx >> 2) & 3; qt = idx & 3; L = 256; tokbase = b * 256; nt = 4; }
  } else if constexpr (MODE == 1) {
    b = idx >> 5; hh = (idx >> 2) & 7; qt = idx & 3; L = 256; tokbase = b * 256; nt = 4;
  } else {
    b = idx >> 7; hh = (idx >> 4) & 7; qt = idx & 15; rrow = qt; L = 1024; tokbase = TCTX + b * 1024; nt = 16; latent = true;
    kr0 = min(max(rrow - 4, 0), 8);
  }
  const int tq = qt * 64 + wave * 16 + l15;
  const int qtok = tokbase + tq;

  float lgf2 = 0.f, lgb2 = 0.f;
  if constexpr (MODE == 0) {
    float xf = p.ret_decay[(l * 2 + 0) * 4 + hh], xb = p.ret_decay[(l * 2 + 1) * 4 + hh];
    lgf2 = -log1pf(expf(-xf)) * 1.4426950408889634f;
    lgb2 = -log1pf(expf(-xb)) * 1.4426950408889634f;
  }

  __syncthreads();
  if constexpr (MODE == 2) {
    for (int i = tid; i < 465; i += 256) rpbs[i] = p.rpb[(size_t)(l * 8 + hh) * 465 + i];
  }

  u4v qf[NKS];
  {
    const u16* qb = (MODE == 0 ? p.Q : p.NQ) + (size_t)qtok * 512 + hh * D + g * 8;
#pragma unroll
    for (int ks = 0; ks < NKS; ++ks) qf[ks] = *(const u4v*)(qb + ks * 32);
  }

  f4v ot[NB];
#pragma unroll
  for (int nb = 0; nb < NB; ++nb) ot[nb] = (f4v){0.f, 0.f, 0.f, 0.f};
  float mrun = -1e30f, lsum = 0.f;

  const int ntk = (MODE == 0) ? (L >> 6) : nt;
  u4v kr[NCH], vr[NCH];
#define ATTN_ISSUE(KT)                                                                                   \
  {                                                                                                      \
    const int kt_ = (KT);                                                                                \
    const u16* kp; const u16* vp; int ldv;                                                               \
    if constexpr (MODE == 0) {                                                                           \
      kp = p.K + (size_t)(tokbase + kt_ * 64) * 512 + hh * 128;                                          \
      if (latent) { vp = p.VtR + VTR_LAT + ((size_t)(b * 4 + hh) * 128) * 1024 + kt_ * 64; ldv = 1024; } \
      else { vp = p.VtR + ((size_t)(b * 4 + hh) * 128) * 256 + kt_ * 64; ldv = 256; }                    \
    } else if constexpr (MODE == 1) {                                                                    \
      kp = p.NK + (size_t)(tokbase + kt_ * 64) * 512 + hh * 64;                                          \
      vp = p.NVt + ((size_t)(b * 8 + hh) * 64) * 256 + kt_ * 64; ldv = 256;                              \
    } else {                                                                                             \
      if (kt_ < 8) {                                                                                     \
        const int krow = kr0 + kt_;                                                                      \
        kp = p.NK + (size_t)(tokbase + krow * 64) * 512 + hh * 64;                                       \
        vp = p.NVt + NVT_LAT + ((size_t)(b * 8 + hh) * 64) * 1024 + krow * 64; ldv = 1024;               \
      } else {                                                                                           \
        kp = p.CK + ((size_t)(l * 4 + b) * 512 + (kt_ - 8) * 64) * 512 + hh * 64;                        \
        vp = p.CVt + ((size_t)((l * 4 + b) * 8 + hh) * 64) * 512 + (kt_ - 8) * 64; ldv = 512;            \
      }                                                                                                  \
    }                                                                                                    \
    _Pragma("unroll") for (int i = 0; i < NCH; ++i) {                                                    \
      const int c = tid + 256 * i;                                                                       \
      const int r = c / (D / 8), cc = c % (D / 8);                                                       \
      kr[i] = *(const u4v*)(kp + (size_t)r * 512 + cc * 8);                                              \
      const int vrw = c >> 3, vc = c & 7;                                                                \
      vr[i] = *(const u4v*)(vp + (size_t)vrw * ldv + vc * 8);                                            \
    }                                                                                                    \
  }
#define ATTN_STAGE()                                                                                     \
  {                                                                                                      \
    _Pragma("unroll") for (int i = 0; i < NCH; ++i) {                                                    \
      const int c = tid + 256 * i;                                                                       \
      const int r = c / (D / 8), cc = c % (D / 8);                                                       \
      *(u4v*)(Ks + r * KSTR + cc * 8) = kr[i];                                                           \
      const int vrw = c >> 3, vc = c & 7;                                                                \
      *(u4v*)(Vts + vrw * 72 + vc * 8) = vr[i];                                                          \
    }                                                                                                    \
  }

  ATTN_ISSUE(0)
#pragma unroll 1
  for (int kt = 0; kt < ntk; ++kt) {
    __syncthreads();
    ATTN_STAGE()
    __syncthreads();
    if (kt + 1 < ntk) ATTN_ISSUE(kt + 1)
    f4v st[4];
#pragma unroll
    for (int kb = 0; kb < 4; ++kb) {
      st[kb] = (f4v){0.f, 0.f, 0.f, 0.f};
#pragma unroll
      for (int ks = 0; ks < NKS; ++ks) {
        s8v kf = *(const s8v*)(Ks + (kb * 16 + l15) * KSTR + ks * 32 + g * 8);
        st[kb] = __builtin_amdgcn_mfma_f32_16x16x32_bf16(kf, bc8(qf[ks]), st[kb], 0, 0, 0);
      }
    }
    if constexpr (MODE == 0) {
#pragma unroll
      for (int kb = 0; kb < 4; ++kb)
#pragma unroll
        for (int r = 0; r < 4; ++r) {
          const int ts = kt * 64 + kb * 16 + g * 4 + r;
          const int d = tq - ts;
          float dec = d > 0 ? exp2f(lgf2 * (float)d) : (d < 0 ? exp2f(lgb2 * (float)(-d)) : 2.f);
          st[kb][r] *= dec;
        }
    } else {
      if constexpr (MODE == 2) {
        if (kt < 8) {
          const int qc = wave * 16 + l15;
          const int ws = min(max(qc - 8, 0), 48);
          const int roff = (kr0 + kt) - rrow + 7;
#pragma unroll
          for (int kb = 0; kb < 4; ++kb)
#pragma unroll
            for (int r = 0; r < 4; ++r) {
              const int kc = kb * 16 + g * 4 + r;
              const bool valid = (kc >= ws) && (kc < ws + 16);
              const int coff = min(max(kc - qc + 15, 0), 30);
              const float bias = rpbs[roff * 31 + coff];
              st[kb][r] = valid ? st[kb][r] + bias : -1e30f;
            }
        }
      }
      float tmax = st[0][0];
#pragma unroll
      for (int kb = 0; kb < 4; ++kb)
#pragma unroll
        for (int r = 0; r < 4; ++r) tmax = fmaxf(tmax, st[kb][r]);
      tmax = fmaxf(tmax, __shfl_xor(tmax, 16));
      tmax = fmaxf(tmax, __shfl_xor(tmax, 32));
      const float mnew = fmaxf(mrun, tmax);
      const float alpha = __expf(mrun - mnew);
      float ps = 0.f;
#pragma unroll
      for (int kb = 0; kb < 4; ++kb)
#pragma unroll
        for (int r = 0; r < 4; ++r) {
          float e = __expf(st[kb][r] - mnew);
          st[kb][r] = e;
          ps += e;
        }
      lsum = lsum * alpha + ps;
      mrun = mnew;
#pragma unroll
      for (int nb = 0; nb < NB; ++nb) ot[nb] *= alpha;
    }
    u4v pf[2];
#pragma unroll
    for (int s = 0; s < 2; ++s) {
      pf[s] = (u4v){pack2(st[2 * s][0], st[2 * s][1]), pack2(st[2 * s][2], st[2 * s][3]),
                    pack2(st[2 * s + 1][0], st[2 * s + 1][1]), pack2(st[2 * s + 1][2], st[2 * s + 1][3])};
    }
#pragma unroll
    for (int nb = 0; nb < NB; ++nb)
#pragma unroll
      for (int s = 0; s < 2; ++s) {
        const u16* vb = Vts + (nb * 16 + l15) * 72 + s * 32 + g * 4;
        uint2 lo = *(const uint2*)(vb);
        uint2 hi = *(const uint2*)(vb + 16);
        u4v vf = (u4v){lo.x, lo.y, hi.x, hi.y};
        ot[nb] = __builtin_amdgcn_mfma_f32_16x16x32_bf16(bc8(vf), bc8(pf[s]), ot[nb], 0, 0, 0);
      }
  }

  if constexpr (MODE == 0) {
    if (latent) {
#pragma unroll 1
      for (int dir = 0; dir < 2; ++dir) {
        const float scale = dir == 0 ? exp2f(lgf2 * (float)(tq + 1)) : exp2f(lgb2 * (float)(L - tq));
        const u16* S0 = p.S0t + ((size_t)(((l * 4 + b) * 2 + dir) * 4 + hh)) * 16384;
#pragma unroll
        for (int s = 0; s < NKS; ++s) {
          u4v pq = (u4v){pack2(bflo(qf[s][0]) * scale, bfhi(qf[s][0]) * scale), pack2(bflo(qf[s][1]) * scale, bfhi(qf[s][1]) * scale),
                         pack2(bflo(qf[s][2]) * scale, bfhi(qf[s][2]) * scale), pack2(bflo(qf[s][3]) * scale, bfhi(qf[s][3]) * scale)};
#pragma unroll
          for (int nb = 0; nb < NB; ++nb) {
            u4v vf = *(const u4v*)(S0 + (size_t)(nb * 16 + l15) * 128 + s * 32 + g * 8);
            ot[nb] = __builtin_amdgcn_mfma_f32_16x16x32_bf16(bc8(vf), bc8(pq), ot[nb], 0, 0, 0);
          }
        }
      }
    }
    float s = 0.f;
#pragma unroll
    for (int nb = 0; nb < NB; ++nb) s += ot[nb][0] + ot[nb][1] + ot[nb][2] + ot[nb][3];
    s += __shfl_xor(s, 16); s += __shfl_xor(s, 32);
    const float mu = s * (1.f / 128.f);
    float q = 0.f;
#pragma unroll
    for (int nb = 0; nb < NB; ++nb)
#pragma unroll
      for (int r = 0; r < 4; ++r) { float dlt = ot[nb][r] - mu; q += dlt * dlt; }
    q += __shfl_xor(q, 16); q += __shfl_xor(q, 32);
    const float rstd = rsqrtf(q * (1.f / 128.f) + LNEPS);
#pragma unroll
    for (int nb = 0; nb < NB; ++nb) {
      const size_t off = (size_t)qtok * 512 + hh * 128 + nb * 16 + g * 4;
      uint2 gg = *(const uint2*)(p.G + off);
      float o0 = (ot[nb][0] - mu) * rstd * bflo(gg.x);
      float o1 = (ot[nb][1] - mu) * rstd * bfhi(gg.x);
      float o2 = (ot[nb][2] - mu) * rstd * bflo(gg.y);
      float o3 = (ot[nb][3] - mu) * rstd * bfhi(gg.y);
      *(uint2*)(p.rout + off) = make_uint2(pack2(o0, o1), pack2(o2, o3));
    }
  } else {
    lsum += __shfl_xor(lsum, 16); lsum += __shfl_xor(lsum, 32);
    const float inv = 1.f / lsum;
#pragma unroll
    for (int nb = 0; nb < NB; ++nb) {
      const size_t off = (size_t)qtok * 512 + hh * 64 + nb * 16 + g * 4;
      *(uint2*)(p.nout + off) = make_uint2(pack2(ot[nb][0] * inv, ot[nb][1] * inv), pack2(ot[nb][2] * inv, ot[nb][3] * inv));
    }
  }
}

__device__ __forceinline__ void retstate_item(const Params& p, int l, int idx) {
  const int dir = idx & 1, hh = (idx >> 1) & 3, b = idx >> 3;
  const int tid = ltid(), lane = tid & 63, wave = tid >> 6;
  const int r = lane & 31, h2 = lane >> 5;
  const float x = p.ret_decay[(l * 2 + dir) * 4 + hh];
  const float lg2 = -log1pf(expf(-x)) * 1.4426950408889634f;
  const u16* Kt = p.KtR + ((size_t)(b * 4 + hh) * 128) * 256;
  const u16* Vt = p.VtR + ((size_t)(b * 4 + hh) * 128) * 256;
  f16v acc[4];
#pragma unroll
  for (int i = 0; i < 4; ++i) acc[i] = zero16();
#pragma unroll 2
  for (int ks = 0; ks < 16; ++ks) {
    const int tok0 = ks * 16 + h2 * 8;
    const u4v a = *(const u4v*)(Kt + (size_t)(wave * 32 + r) * 256 + tok0);
    u4v af;
#pragma unroll
    for (int w = 0; w < 4; ++w) {
      const int t0 = tok0 + 2 * w, t1 = t0 + 1;
      float w0 = dir == 0 ? exp2f(lg2 * (float)(255 - t0)) : exp2f(lg2 * (float)t0);
      float w1 = dir == 0 ? exp2f(lg2 * (float)(255 - t1)) : exp2f(lg2 * (float)t1);
      af[w] = pack2(bflo(a[w]) * w0, bfhi(a[w]) * w1);
    }
#pragma unroll
    for (int nt = 0; nt < 4; ++nt) {
      const u4v bfr = *(const u4v*)(Vt + (size_t)(nt * 32 + r) * 256 + tok0);
      acc[nt] = __builtin_amdgcn_mfma_f32_32x32x16_bf16(bc8(af), bc8(bfr), acc[nt], 0, 0, 0);
    }
  }
  float* o = p.out + OUT_SRET + ((size_t)(((b * 2 + l) * 2 + dir) * 4 + hh)) * 16384;
#pragma unroll
  for (int nt = 0; nt < 4; ++nt)
#pragma unroll
    for (int reg = 0; reg < 16; ++reg) {
      const int dk = wave * 32 + (reg & 3) + 8 * (reg >> 2) + 4 * h2;
      o[(size_t)dk * 128 + nt * 32 + r] = acc[nt][reg];
    }
}

__device__ __forceinline__ void s5_item(const Params& p, char* smem, int l, int item) {
  const int tid = ltid(), lane = tid & 63, wave = tid >> 6;
  const int l15 = lane & 15, g4 = lane >> 4;
  int seq = item * 4 + wave;
  int b, dir, g, L, tokbase;
  bool latent;
  if (seq < 256) { latent = true; b = seq >> 6; dir = (seq >> 5) & 1; g = seq & 31; L = 1024; tokbase = TCTX + b * 1024; }
  else { seq -= 256; latent = false; b = seq >> 6; dir = (seq >> 5) & 1; g = seq & 31; L = 256; tokbase = b * 256; }
  float* buf = (float*)smem + wave * (16 * 132);
  const int tg = (l * 2 + dir) * 32 + g;
  const float ar = p.abar[(tg * 64 + lane) * 2], ai = p.abar[(tg * 64 + lane) * 2 + 1];
  u4v bfrag[8];
#pragma unroll
  for (int nt = 0; nt < 8; ++nt) {
    if (g4 < 2) bfrag[nt] = *(const u4v*)(p.bbarT + ((size_t)tg * 128 + nt * 16 + l15) * 16 + g4 * 8);
    else bfrag[nt] = (u4v){0u, 0u, 0u, 0u};
  }
  u4v cfrag[4];
#pragma unroll
  for (int ks = 0; ks < 4; ++ks) cfrag[ks] = *(const u4v*)(p.cmT + ((size_t)tg * 16 + l15) * 128 + ks * 32 + g4 * 8);
  float xr = 0.f, xi = 0.f;
  if (latent) {
    const float* h0 = p.state_ssm + ((size_t)(((b * 2 + l) * 2 + dir) * 32 + g) * 64 + lane) * 2;
    xr = h0[0]; xi = h0[1];
  }
  u16* yd = p.YD + (size_t)dir * TALL * 512;
  __syncthreads();
  const int nsub = L >> 4;
#pragma unroll 1
  for (int sub = 0; sub < nsub; ++sub) {
    u4v af;
    {
      const int tau = sub * 16 + l15;
      const int pos = dir == 0 ? tau : L - 1 - tau;
      if (g4 < 2) af = *(const u4v*)(p.SU + (size_t)(tokbase + pos) * 512 + g * 16 + g4 * 8);
      else af = (u4v){0u, 0u, 0u, 0u};
    }
#pragma unroll
    for (int nt = 0; nt < 8; ++nt) {
      f4v c = (f4v){0.f, 0.f, 0.f, 0.f};
      c = __builtin_amdgcn_mfma_f32_16x16x32_bf16(bc8(af), bc8(bfrag[nt]), c, 0, 0, 0);
#pragma unroll
      for (int r = 0; r < 4; ++r) buf[(g4 * 4 + r) * 132 + nt * 16 + l15] = c[r];
    }
    __syncthreads();
#pragma unroll
    for (int i = 0; i < 16; ++i) {
      const float bur = buf[i * 132 + lane], bui = buf[i * 132 + 64 + lane];
      const float nr = ar * xr - ai * xi + bur;
      const float ni = ar * xi + ai * xr + bui;
      xr = nr; xi = ni;
      buf[i * 132 + lane] = xr;
      buf[i * 132 + 64 + lane] = xi;
    }
    __syncthreads();
    f4v y = (f4v){0.f, 0.f, 0.f, 0.f};
#pragma unroll
    for (int ks = 0; ks < 4; ++ks) {
      const float* bp = buf + l15 * 132 + ks * 32 + g4 * 8;
      float4 v0 = *(const float4*)(bp), v1 = *(const float4*)(bp + 4);
      const u4v xa = (u4v){pack2(v0.x, v0.y), pack2(v0.z, v0.w), pack2(v1.x, v1.y), pack2(v1.z, v1.w)};
      y = __builtin_amdgcn_mfma_f32_16x16x32_bf16(bc8(xa), bc8(cfrag[ks]), y, 0, 0, 0);
    }
#pragma unroll
    for (int r = 0; r < 4; ++r) {
      const int tau = sub * 16 + g4 * 4 + r;
      const int pos = dir == 0 ? tau : L - 1 - tau;
      yd[(size_t)(tokbase + pos) * 512 + g * 16 + l15] = f2bf(y[r]);
    }
    __syncthreads();
  }
  if (!latent) {
    float* o = p.out + OUT_SSSM + ((size_t)(((b * 2 + l) * 2 + dir) * 32 + g) * 64 + lane) * 2;
    o[0] = xr; o[1] = xi;
  }
}

#define MX_S5 320
#define MX_RET 512
#define MX_NA 512
#define MX_CA 512
#define MX_RS 128
#define MX_ITEMS (MX_S5 + MX_RET + MX_NA + MX_CA + MX_RS)
__device__ __forceinline__ void mixer_item(const Params& p, char* smem, int l, int item) {
  if (item < 64) { s5_item(p, smem, l, item); return; }
  item -= 64;
  if (item < 256) { attn_item<128, 0>(p, smem, l, item); return; }
  item -= 256;
  if (item < 512) { attn_item<64, 2>(p, smem, l, item); return; }
  item -= 512;
  if (item < 256) { s5_item(p, smem, l, 64 + item); return; }
  item -= 256;
  if (item < 256) { attn_item<128, 0>(p, smem, l, 256 + item); return; }
  item -= 256;
  if (item < 512) { attn_item<64, 1>(p, smem, l, item); return; }
  item -= 512;
  retstate_item(p, l, item);
}

__device__ __forceinline__ void p3a_item(const Params& p, char* smem, int l, int item) {
  const int mt = item & 63, nt = item >> 6;
  const int m0 = mt * 128, n0 = nt * 128;
  const int tid = ltid(), lane = tid & 63, wave = tid >> 6, wm = wave >> 1, wn = wave & 1;
  AArgs a{};
  a.SU = p.SU; a.YD0 = p.YD; a.YD1 = p.YD + (size_t)TALL * 512; a.dsk = p.ssm_d + l * 512;
  f16v acc[2][2];
  gemm_mainloop<2>(smem, a, p.w_glu + (size_t)l * 512 * 512, 512, 512, m0, n0, acc);
#pragma unroll
  for (int mi = 0; mi < 2; ++mi)
#pragma unroll
    for (int reg = 0; reg < 16; ++reg) {
      const int row = EPI_ROW(mi, reg);
#pragma unroll
      for (int ni = 0; ni < 2; ++ni) {
        const int col = EPI_COL(ni);
        const size_t off = (size_t)row * 512 + col;
        float y = geluf_(a.dsk[col] * bf2f(p.SU[off]) + bf2f(a.YD0[off]) + bf2f(a.YD1[off]));
        p.sout[off] = f2bf(y * sigmoidf_(acc[mi][ni][reg]));
      }
    }
}

__device__ __forceinline__ void p3b_item(const Params& p, char* smem, int l, int item) {
  const int mt = item & 63, nt = item >> 6;
  const int m0 = mt * 128, n0 = nt * 128;
  const int tid = ltid(), lane = tid & 63, wave = tid >> 6, wm = wave >> 1, wn = wave & 1;
  int nbr = 3;
  asm volatile("" : "+s"(nbr));
#pragma unroll 1
  for (int br = 0; br < nbr; ++br) {
    AArgs a{};
    a.A16 = br == 0 ? p.rout : (br == 1 ? p.sout : p.nout); a.lda = 512;
    f16v acc[2][2];
    gemm_mainloop<0>(smem, a, p.w_branch + ((size_t)l * 3 + br) * 512 * 1024, 1024, 512, m0, n0, acc);
#pragma unroll
    for (int mi = 0; mi < 2; ++mi)
#pragma unroll
      for (int reg = 0; reg < 16; ++reg) {
        const int row = EPI_ROW(mi, reg);
        const u16* gp = p.GT + (size_t)row * 3072 + br * 1024 + EPI_COL(0);
        u16* mp = p.merged + (size_t)row * 1024 + EPI_COL(0);
        float t0 = bf2f(gp[0]) * acc[mi][0][reg];
        float t1 = bf2f(gp[32]) * acc[mi][1][reg];
        if (br > 0) { t0 += bf2f(mp[0]); t1 += bf2f(mp[32]); }
        mp[0] = f2bf(t0);
        mp[32] = f2bf(t1);
      }
  }
}

__device__ __forceinline__ void p3c_item(const Params& p, char* smem, int l, int item) {
  const int mt = item & 63, nt = item >> 6;
  const int m0 = mt * 128, n0 = nt * 128;
  const int tid = ltid(), lane = tid & 63, wave = tid >> 6, wm = wave >> 1, wn = wave & 1;
  AArgs a{};
  a.A16 = p.merged; a.lda = 1024;
  f16v acc[2][2];
  gemm_mainloop<0>(smem, a, p.w_o + (size_t)l * 1024 * 1024, 1024, 1024, m0, n0, acc);
  const int ci = cond_of_row(m0);
  const float* g1 = p.mod + (l * 5 + ci) * 6144 + 2048;
  float* st1 = p.stats + (size_t)(l * 2 + 0) * TALL * 2;
  const float* st2p = p.stats + (size_t)(0 * 2 + 1) * TALL * 2;
  const int c0 = EPI_COL(0), c1 = EPI_COL(1);
  const float g1a = g1[c0], g1b = g1[c1];
  float lga = 1.f, lgb = 1.f, lba = 0.f, lbb = 0.f;
  if (l == 1) { lga = p.ln2_g[c0]; lgb = p.ln2_g[c1]; lba = p.ln2_b[c0]; lbb = p.ln2_b[c1]; }
#pragma unroll
  for (int mi = 0; mi < 2; ++mi)
#pragma unroll
    for (int reg = 0; reg < 16; ++reg) {
      const int row = EPI_ROW(mi, reg);
      float xa, xb;
      if (l == 0) {
        const float* xr = row < TCTX ? p.x_prompt + (size_t)row * 1024 : p.x_sample + (size_t)(row - TCTX) * 1024;
        xa = xr[c0]; xb = xr[c1];
      } else {
        const float s = st2p[row * 2], q = st2p[row * 2 + 1];
        const float mu = s * (1.f / 1024.f);
        const float rstd = rsqrtf(fmaxf(q * (1.f / 1024.f) - mu * mu, 0.f) + LNEPS);
        xa = (p.out[(size_t)row * 1024 + c0] - mu) * rstd * lga + lba;
        xb = (p.out[(size_t)row * 1024 + c1] - mu) * rstd * lgb + lbb;
      }
      const float va = ALPHA * xa + g1a * acc[mi][0][reg];
      const float vb = ALPHA * xb + g1b * acc[mi][1][reg];
      p.pre1[(size_t)row * 1024 + c0] = va;
      p.pre1[(size_t)row * 1024 + c1] = vb;
      stats_accum(st1, row, va, vb, lane);
    }
}

__device__ __forceinline__ void p4_item(const Params& p, char* smem, int l, int item) {
  const int mt = item & 63, nt = item >> 6;
  const int m0 = mt * 128, n0 = nt * 128;
  const int tid = ltid(), lane = tid & 63, wave = tid >> 6, wm = wave >> 1, wn = wave & 1;
  AArgs a{};
  const float* mod = p.mod + l * 5 * 6144;
  a.A32lo = p.pre1; a.A32hi = p.pre1 + (size_t)TCTX * 1024; a.stats = p.stats + (size_t)(l * 2 + 0) * TALL * 2;
  a.lng = p.ln1_g + l * 1024; a.lnb = p.ln1_b + l * 1024;
  a.sc = mod + 4 * 1024; a.sh = mod + 3 * 1024;
  f16v acc[2][2];
  gemm_mainloop<1>(smem, a, p.w_up + (size_t)l * 1024 * 5632, 5632, 1024, m0, n0, acc);
#pragma unroll
  for (int mi = 0; mi < 2; ++mi)
#pragma unroll
    for (int reg = 0; reg < 16; ++reg) {
      const int row = EPI_ROW(mi, reg);
#pragma unroll
      for (int ni = 0; ni < 2; ++ni) p.z2[(size_t)row * 5632 + EPI_COL(ni)] = f2bf(acc[mi][ni][reg]);
    }
}

__device__ __forceinline__ void p4b_item(const Params& p, int l, int item) {
  const float* cw = p.conv_w + (size_t)l * 3 * 5632;
  const float* cb = p.conv_b + (size_t)l * 5632;
  for (int i = ltid(); i < 16 * 352; i += 256) {
    const int row = item * 16 + i / 352, v = i % 352;
    const int j0 = v * 8;
    int pos, L;
    if (row < TCTX) { pos = row & 255; L = 256; } else { pos = (row - TCTX) & 1023; L = 1024; }
    const bool hp = pos > 0, hn = pos < L - 1;
    const u16* zr = p.z2 + (size_t)row * 5632;
    uint4 zero = make_uint4(0, 0, 0, 0);
    uint4 a0 = hp ? *(const uint4*)(zr - 5632 + j0) : zero;
    uint4 a1 = *(const uint4*)(zr + j0);
    uint4 a2 = hn ? *(const uint4*)(zr + 5632 + j0) : zero;
    uint4 b0 = hp ? *(const uint4*)(zr - 5632 + 2816 + j0) : zero;
    uint4 b1 = *(const uint4*)(zr + 2816 + j0);
    uint4 b2 = hn ? *(const uint4*)(zr + 5632 + 2816 + j0) : zero;
    unsigned aw0[4] = {a0.x, a0.y, a0.z, a0.w}, aw1[4] = {a1.x, a1.y, a1.z, a1.w}, aw2[4] = {a2.x, a2.y, a2.z, a2.w};
    unsigned bw0[4] = {b0.x, b0.y, b0.z, b0.w}, bw1[4] = {b1.x, b1.y, b1.z, b1.w}, bw2[4] = {b2.x, b2.y, b2.z, b2.w};
    unsigned ow[4];
#pragma unroll
    for (int w = 0; w < 4; ++w) {
      const int j = j0 + 2 * w;
      float av0 = cw[j] * bflo(aw0[w]) + cw[5632 + j] * bflo(aw1[w]) + cw[2 * 5632 + j] * bflo(aw2[w]) + cb[j];
      float av1 = cw[j + 1] * bfhi(aw0[w]) + cw[5632 + j + 1] * bfhi(aw1[w]) + cw[2 * 5632 + j + 1] * bfhi(aw2[w]) + cb[j + 1];
      const int jb = j + 2816;
      float bv0 = cw[jb] * bflo(bw0[w]) + cw[5632 + jb] * bflo(bw1[w]) + cw[2 * 5632 + jb] * bflo(bw2[w]) + cb[jb];
      float bv1 = cw[jb + 1] * bfhi(bw0[w]) + cw[5632 + jb + 1] * bfhi(bw1[w]) + cw[2 * 5632 + jb + 1] * bfhi(bw2[w]) + cb[jb + 1];
      ow[w] = pack2(geluf_(av0) * bv0, geluf_(av1) * bv1);
    }
    *(uint4*)(p.act + (size_t)row * 2816 + j0) = make_uint4(ow[0], ow[1], ow[2], ow[3]);
  }
}

__device__ __forceinline__ void p5_item(const Params& p, char* smem, int l, int item) {
  const int mt = item & 63, nt = item >> 6;
  const int m0 = mt * 128, n0 = nt * 128;
  const int tid = ltid(), lane = tid & 63, wave = tid >> 6, wm = wave >> 1, wn = wave & 1;
  AArgs a{};
  a.A16 = p.act; a.lda = 2816;
  f16v acc[2][2];
  gemm_mainloop<0>(smem, a, p.w_down + (size_t)l * 2816 * 1024, 1024, 2816, m0, n0, acc);
  const int ci = cond_of_row(m0);
  const float* g2 = p.mod + (l * 5 + ci) * 6144 + 5 * 1024;
  const float* st1 = p.stats + (size_t)(l * 2 + 0) * TALL * 2;
  float* st2 = p.stats + (size_t)(l * 2 + 1) * TALL * 2;
  const int c0 = EPI_COL(0), c1 = EPI_COL(1);
  const float g2a = g2[c0], g2b = g2[c1];
  const float lga = p.ln1_g[l * 1024 + c0], lgb = p.ln1_g[l * 1024 + c1];
  const float lba = p.ln1_b[l * 1024 + c0], lbb = p.ln1_b[l * 1024 + c1];
#pragma unroll
  for (int mi = 0; mi < 2; ++mi)
#pragma unroll
    for (int reg = 0; reg < 16; ++reg) {
      const int row = EPI_ROW(mi, reg);
      const float s = st1[row * 2], q = st1[row * 2 + 1];
      const float mu = s * (1.f / 1024.f);
      const float rstd = rsqrtf(fmaxf(q * (1.f / 1024.f) - mu * mu, 0.f) + LNEPS);
      const float xa = (p.pre1[(size_t)row * 1024 + c0] - mu) * rstd * lga + lba;
      const float xb = (p.pre1[(size_t)row * 1024 + c1] - mu) * rstd * lgb + lbb;
      const float va = ALPHA * xa + g2a * acc[mi][0][reg];
      const float vb = ALPHA * xb + g2b * acc[mi][1][reg];
      p.out[(size_t)row * 1024 + c0] = va;
      p.out[(size_t)row * 1024 + c1] = vb;
      stats_accum(st2, row, va, vb, lane);
    }
}

__device__ __forceinline__ void final_item(const Params& p, int item) {
  const float* st = p.stats + (size_t)(1 * 2 + 1) * TALL * 2;
  const int c = ltid() * 4;
  const float4 g = *(const float4*)(p.ln2_g + 1024 + c);
  const float4 b = *(const float4*)(p.ln2_b + 1024 + c);
  for (int r = 0; r < 8; ++r) {
    const int row = item * 8 + r;
    const float s = st[row * 2], q = st[row * 2 + 1];
    const float mu = s * (1.f / 1024.f);
    const float rstd = rsqrtf(fmaxf(q * (1.f / 1024.f) - mu * mu, 0.f) + LNEPS);
    float4 v = *(float4*)(p.out + (size_t)row * 1024 + c);
    v.x = (v.x - mu) * rstd * g.x + b.x;
    v.y = (v.y - mu) * rstd * g.y + b.y;
    v.z = (v.z - mu) * rstd * g.z + b.z;
    v.w = (v.w - mu) * rstd * g.w + b.w;
    *(float4*)(p.out + (size_t)row * 1024 + c) = v;
  }
}

#define NPHASES 18
#define RUN_PHASE(PH, N, CALL)                                              \
  if (ph_lo <= (PH) && (PH) < ph_hi) {                                      \
    for (int it = blockIdx.x; it < (N); it += nb) { CALL; }                 \
    if ((PH) + 1 < ph_hi) cg::this_grid().sync();                           \
  }
#define RUN_LAYER(L)                                                        \
  RUN_PHASE(1 + 8 * (L) + 0, 64 * 56, p1_item(p, smem, (L), it))            \
  RUN_PHASE(1 + 8 * (L) + 1, MX_ITEMS, mixer_item(p, smem, (L), it))        \
  RUN_PHASE(1 + 8 * (L) + 2, 64 * 4, p3a_item(p, smem, (L), it))            \
  RUN_PHASE(1 + 8 * (L) + 3, 64 * 8, p3b_item(p, smem, (L), it))            \
  RUN_PHASE(1 + 8 * (L) + 4, 64 * 8, p3c_item(p, smem, (L), it))            \
  RUN_PHASE(1 + 8 * (L) + 5, 64 * 44, p4_item(p, smem, (L), it))            \
  RUN_PHASE(1 + 8 * (L) + 6, 512, p4b_item(p, (L), it))                     \
  RUN_PHASE(1 + 8 * (L) + 7, 64 * 8, p5_item(p, smem, (L), it))

__global__ void __launch_bounds__(256, 2) mega(Params p, int ph_lo, int ph_hi) {
  __shared__ __attribute__((aligned(16))) char smem[49152];
  const int nb = gridDim.x;
  RUN_PHASE(0, P0_ITEMS, phase0_item(p, smem, it))
  RUN_LAYER(0)
  RUN_LAYER(1)
  RUN_PHASE(17, 1024, final_item(p, it))
}

extern "C" void kernel_launch(void* const* d_in, const int* in_sizes, int n_in, void* d_out, int out_size, void* d_ws,
                              size_t ws_size, hipStream_t stream) {
  Params p{};
  const float** ins = (const float**)&p;
  for (int i = 0; i < 32; ++i) ins[i] = (const float*)d_in[i];
  p.out = (float*)d_out;
  char* ws = (char*)d_ws;
  size_t off = 0;
  auto take = [&](size_t bytes) { char* r = ws + off; off += (bytes + 255) & ~(size_t)255; return r; };
  p.mod = (float*)take(2 * 5 * 6144 * 4);
  p.stats = (float*)take(2 * 2 * TALL * 2 * 4);
  const size_t zero_bytes = off;
  p.ropetab = (float*)take(64 * 32 * 2 * 4);
  p.abar = (float*)take(2 * 2 * 32 * 64 * 2 * 4);
  p.bbarT = (u16*)take(2 * 2 * 32 * 128 * 16 * 2);
  p.cmT = (u16*)take(2 * 2 * 32 * 16 * 128 * 2);
  p.CK = (u16*)take((size_t)2 * 4 * 512 * 512 * 2);
  p.CVt = (u16*)take((size_t)2 * 4 * 512 * 512 * 2);
  p.S0t = (u16*)take((size_t)2 * 4 * 2 * 4 * 128 * 128 * 2);
  p.pre1 = (float*)take((size_t)TALL * 1024 * 4);
  const size_t region = off;
  const size_t E = (size_t)TALL * 512 * 2;
  p.Q = (u16*)take(E); p.K = (u16*)take(E); p.VtR = (u16*)take(E); p.KtR = (u16*)take(E / 2);
  p.G = (u16*)take(E); p.SU = (u16*)take(E); p.NQ = (u16*)take(E); p.NK = (u16*)take(E); p.NVt = (u16*)take(E);
  p.GT = (u16*)take((size_t)TALL * 3072 * 2);
  p.rout = (u16*)take(E); p.sout = (u16*)take(E); p.nout = (u16*)take(E);
  p.YD = (u16*)take(2 * E);
  p.merged = p.YD;
  const size_t total = off;
  p.z2 = (u16*)(ws + region);
  p.act = (u16*)(ws + region + (size_t)TALL * 5632 * 2);
  if (total > ws_size || region + (size_t)TALL * (5632 + 2816) * 2 > total) {
    fprintf(stderr, "kernel_launch: workspace too small (%zu needed, %zu given)\n", total, ws_size);
    return;
  }
  (void)hipMemsetAsync(ws, 0, zero_bytes, stream);
#if SINGLE_LAUNCH
  static int grid_blocks = 0;
  if (!grid_blocks) {
    int dev = 0, cus = 0, per_cu = 0;
    hipGetDevice(&dev);
    hipDeviceGetAttribute(&cus, hipDeviceAttributeMultiprocessorCount, dev);
    hipOccupancyMaxActiveBlocksPerMultiprocessor(&per_cu, mega, 256, 0);
    if (per_cu > 2) per_cu = 2;
    if (per_cu < 1) per_cu = 1;
    grid_blocks = cus * per_cu;
  }
  int lo = 0, hi = NPHASES;
  void* args[] = {&p, &lo, &hi};
  hipError_t e = hipLaunchCooperativeKernel((void*)mega, dim3(grid_blocks), dim3(256), args, 0, stream);
  if (e != hipSuccess) fprintf(stderr, "cooperative launch failed: %s (grid %d)\n", hipGetErrorString(e), grid_blocks);
#else
  for (int ph = 0; ph < NPHASES; ++ph) {
    hipLaunchKernelGGL(mega, dim3(512), dim3(256), 0, stream, p, ph, ph + 1);
  }
#endif
}
```

```cpp
#include <hip/hip_runtime.h>
#include <hip/hip_cooperative_groups.h>
#include <cstdio>
namespace cg = cooperative_groups;

#ifndef SINGLE_LAUNCH
#define SINGLE_LAUNCH 1
#endif

typedef __attribute__((ext_vector_type(8))) short s8v;
typedef __attribute__((ext_vector_type(4))) float f4v;
typedef __attribute__((ext_vector_type(16))) float f16v;
typedef unsigned short u16;
typedef __attribute__((ext_vector_type(4))) unsigned u4v;
__device__ __forceinline__ s8v bc8(u4v x) { return __builtin_bit_cast(s8v, x); }


#define TALL 8192
#define TCTX 4096
#define ALPHA 1.41421356237309515f
#define LNEPS 1e-5f
#define VTR_LAT 2097152
#define NVT_LAT 2097152
#define OUT_SRET 8388608
#define OUT_SSSM 12582912
#define OUT_CK 12845056
#define OUT_CV 17039360
#define WT_IN 0
#define WT_GLU (WT_IN + 7168 * 1024)
#define WT_BR (WT_GLU + 512 * 512)
#define WT_O (WT_BR + 3 * 1024 * 512)
#define WT_UP (WT_O + 1024 * 1024)
#define WT_DOWN (WT_UP + 5632 * 1024)
#define WT_LAYER ((size_t)(WT_DOWN + 1024 * 2816))

struct Params {
  const float *x_prompt, *x_sample, *state_ret, *state_ssm, *cache_k, *cache_v, *c, *c_ctx;
  const float *w_ada, *b_ada, *w_in, *ret_decay, *a_re, *a_im, *log_dt, *b_re, *b_im, *c_re, *c_im;
  const float *ssm_d, *w_glu, *rpb, *w_branch, *w_o, *ln1_g, *ln1_b, *w_up, *conv_w, *conv_b, *w_down, *ln2_g, *ln2_b;
  float* out;
  char* ws;
};

typedef __bf16 bf2v __attribute__((ext_vector_type(2)));
typedef float fl2v __attribute__((ext_vector_type(2)));
__device__ __forceinline__ unsigned pack2(float a, float b) {
  fl2v f = {a, b};
  bf2v h = __builtin_convertvector(f, bf2v);
  return __builtin_bit_cast(unsigned, h);
}
__device__ __forceinline__ u16 f2bf(float f) { return (u16)(pack2(f, 0.f) & 0xffffu); }

constexpr size_t al256(size_t x) { return (x + 255) & ~(size_t)255; }
constexpr size_t EB = (size_t)TALL * 512 * 2;
constexpr size_t OFF_mod = 0;
constexpr size_t OFF_stats = OFF_mod + al256(2 * 5 * 6144 * 4);
constexpr size_t OFF_bar = OFF_stats + al256(2 * 2 * TALL * 2 * 4);
constexpr size_t ZERO_BYTES = OFF_bar + al256(3456 * 4);
constexpr size_t OFF_ropetab = ZERO_BYTES;
constexpr size_t OFF_abar = OFF_ropetab + al256(64 * 32 * 2 * 4);
constexpr size_t OFF_bbarT = OFF_abar + al256(2 * 2 * 32 * 64 * 2 * 4);
constexpr size_t OFF_cmT = OFF_bbarT + al256(2 * 2 * 32 * 128 * 16 * 2);
constexpr size_t OFF_CK = OFF_cmT + al256(2 * 2 * 32 * 16 * 128 * 2);
constexpr size_t OFF_CVt = OFF_CK + al256((size_t)2 * 4 * 512 * 512 * 2);
constexpr size_t OFF_S0t = OFF_CVt + al256((size_t)2 * 4 * 512 * 512 * 2);
constexpr size_t OFF_Wt = OFF_S0t + al256((size_t)2 * 4 * 2 * 4 * 128 * 128 * 2);
constexpr size_t OFF_REGION = OFF_Wt + al256(2 * WT_LAYER * 2);
constexpr size_t OFF_z2 = OFF_REGION;
constexpr size_t OFF_act = OFF_z2 + (size_t)TALL * 5632 * 2;
constexpr size_t OFF_pre1 = OFF_act + (size_t)TALL * 2816 * 2;
constexpr size_t WS_TOTAL = OFF_pre1 + (size_t)TALL * 1024 * 4;
constexpr size_t OFF_K = OFF_pre1;
constexpr size_t OFF_VtR = OFF_K + EB;
constexpr size_t OFF_NQ = OFF_VtR + EB;
constexpr size_t OFF_NK = OFF_NQ + EB;
constexpr size_t OFF_GT = OFF_REGION;
constexpr size_t OFF_rout = OFF_GT + (size_t)TALL * 3072 * 2;
constexpr size_t OFF_nout = OFF_rout + EB;
constexpr size_t OFF_YD = OFF_nout + EB;
constexpr size_t OFF_merged = OFF_YD;
constexpr size_t OFF_Q = OFF_YD + 2 * EB;
constexpr size_t OFF_sout = OFF_Q;
constexpr size_t OFF_KtR = OFF_Q + EB;
constexpr size_t OFF_G = OFF_KtR + EB / 2;
constexpr size_t OFF_SU = OFF_G + EB;
constexpr size_t OFF_NVt = OFF_SU + EB;
static_assert(OFF_NVt + EB <= OFF_pre1, "mixer buffers overflow the z2+act area");
#define WS_mod ((float*)(p.ws + OFF_mod))
#define WS_stats ((float*)(p.ws + OFF_stats))
#define WS_ropetab ((float*)(p.ws + OFF_ropetab))
#define WS_abar ((float*)(p.ws + OFF_abar))
#define WS_pre1 ((float*)(p.ws + OFF_pre1))
#define WS_bbarT ((u16*)(p.ws + OFF_bbarT))
#define WS_cmT ((u16*)(p.ws + OFF_cmT))
#define WS_CK ((u16*)(p.ws + OFF_CK))
#define WS_CVt ((u16*)(p.ws + OFF_CVt))
#define WS_S0t ((u16*)(p.ws + OFF_S0t))
#define WS_Wt ((u16*)(p.ws + OFF_Wt))
#define WS_Q ((u16*)(p.ws + OFF_Q))
#define WS_K ((u16*)(p.ws + OFF_K))
#define WS_VtR ((u16*)(p.ws + OFF_VtR))
#define WS_KtR ((u16*)(p.ws + OFF_KtR))
#define WS_G ((u16*)(p.ws + OFF_G))
#define WS_SU ((u16*)(p.ws + OFF_SU))
#define WS_NQ ((u16*)(p.ws + OFF_NQ))
#define WS_NK ((u16*)(p.ws + OFF_NK))
#define WS_NVt ((u16*)(p.ws + OFF_NVt))
#define WS_GT ((u16*)(p.ws + OFF_GT))
#define WS_rout ((u16*)(p.ws + OFF_rout))
#define WS_sout ((u16*)(p.ws + OFF_sout))
#define WS_nout ((u16*)(p.ws + OFF_nout))
#define WS_YD ((u16*)(p.ws + OFF_YD))
#define WS_merged ((u16*)(p.ws + OFF_merged))
#define WS_z2 ((u16*)(p.ws + OFF_z2))
#define WS_act ((u16*)(p.ws + OFF_act))

__device__ __forceinline__ float bf2f(unsigned h) { return __uint_as_float((h & 0xffffu) << 16); }
__device__ __forceinline__ float bflo(unsigned w) { return __uint_as_float(w << 16); }
__device__ __forceinline__ float bfhi(unsigned w) { return __uint_as_float(w & 0xffff0000u); }
__device__ __forceinline__ float sigmoidf_(float x) { return 1.f / (1.f + __expf(-x)); }
__device__ __forceinline__ float siluf_(float x) { return x / (1.f + __expf(-x)); }
__device__ __forceinline__ float geluf_(float x) {
  float u = 0.7978845608028654f * (x + 0.044715f * x * x * x);
  float e = __expf(2.f * u);
  float t = 1.f - 2.f / (e + 1.f);
  return 0.5f * x * (1.f + t);
}
__device__ __forceinline__ f16v zero16() {
  return (f16v){0.f, 0.f, 0.f, 0.f, 0.f, 0.f, 0.f, 0.f, 0.f, 0.f, 0.f, 0.f, 0.f, 0.f, 0.f, 0.f};
}
__device__ __forceinline__ int ltid() { int t = threadIdx.x; asm volatile("" : "+v"(t)); return t; }
__device__ __forceinline__ int cond_of_row(int row) { return row < TCTX ? 0 : 1 + ((row - TCTX) >> 10); }

struct AArgs {
  const u16* A16; int lda;
  const float* A32lo; const float* A32hi;
  const float* stats;
  const float* lng; const float* lnb;
  const float* sc; const float* sh;
  const u16* SU; const u16* YD0; const u16* YD1; const float* dsk;
};

#define LDS_AS 0
#define LDS_BS (2 * 128 * 40 * 2)
#define LDS_GS (LDS_BS + 2 * 128 * 40 * 2)

template <int AMODE>
__device__ __forceinline__ void gemm_mainloop(char* smem, const AArgs& a, const u16* __restrict__ Bt, int ldb, int K,
                                              int m0, int n0, f16v (&acc)[2][2]) {
  u16* As = (u16*)(smem + LDS_AS);
  u16* Bs = (u16*)(smem + LDS_BS);
  float* Gs = (float*)(smem + LDS_GS);
  float* Bv = Gs + 1024;
  const int tid = ltid(), lane = tid & 63, wave = tid >> 6;
  const int wm = wave >> 1, wn = wave & 1;
  const int ar = tid >> 1, akh = tid & 1;
  const int row = m0 + ar;
  float mu = 0.f, rstd = 1.f;
  const float* srow = nullptr;
  __syncthreads();
  if constexpr (AMODE == 1) {
    const int ci = cond_of_row(m0);
    for (int k = tid; k < 1024; k += 256) {
      float sc = a.sc[ci * 6144 + k], sh = a.sh[ci * 6144 + k];
      float g = a.lng ? a.lng[k] : 1.f, b = a.lnb ? a.lnb[k] : 0.f;
      Gs[k] = g * (1.f + sc);
      Bv[k] = b * (1.f + sc) + sh;
    }
    if (a.stats) {
      float s = a.stats[row * 2], q = a.stats[row * 2 + 1];
      mu = s * (1.f / 1024.f);
      float var = q * (1.f / 1024.f) - mu * mu;
      rstd = rsqrtf(fmaxf(var, 0.f) + LNEPS);
    }
    srow = row < TCTX ? a.A32lo + (size_t)row * 1024 : a.A32hi + (size_t)(row - TCTX) * 1024;
    __syncthreads();
  }
  const float nmr = -mu * rstd;
  acc[0][0] = zero16(); acc[0][1] = zero16(); acc[1][0] = zero16(); acc[1][1] = zero16();

  u4v ra[6];
  u4v rb[2];
  const u16* brow = Bt + (size_t)(n0 + ar) * ldb + akh * 16;
  auto issue = [&](int kt) {
    const int k0 = kt * 32 + akh * 16;
    if constexpr (AMODE == 0) {
      const u4v* p = (const u4v*)(a.A16 + (size_t)row * a.lda + k0);
      ra[0] = p[0]; ra[1] = p[1];
    } else if constexpr (AMODE == 1) {
      const u4v* p = (const u4v*)(srow + k0);
      ra[0] = p[0]; ra[1] = p[1]; ra[2] = p[2]; ra[3] = p[3];
    } else {
      const u4v* p0 = (const u4v*)(a.SU + (size_t)row * 512 + k0);
      const u4v* p1 = (const u4v*)(a.YD0 + (size_t)row * 512 + k0);
      const u4v* p2 = (const u4v*)(a.YD1 + (size_t)row * 512 + k0);
      ra[0] = p0[0]; ra[1] = p0[1]; ra[2] = p1[0]; ra[3] = p1[1]; ra[4] = p2[0]; ra[5] = p2[1];
    }
    const u4v* bp = (const u4v*)(brow + kt * 32);
    rb[0] = bp[0]; rb[1] = bp[1];
  };
  auto stage = [&](int buf, int kt) {
    u4v o0, o1;
    if constexpr (AMODE == 0) {
      o0 = ra[0]; o1 = ra[1];
    } else if constexpr (AMODE == 1) {
      const int k0 = kt * 32 + akh * 16;
      unsigned w[8];
#pragma unroll
      for (int i = 0; i < 4; ++i) {
        float4 g = *(const float4*)(Gs + k0 + i * 4);
        float4 b = *(const float4*)(Bv + k0 + i * 4);
        float x0 = __uint_as_float(ra[i][0]), x1 = __uint_as_float(ra[i][1]), x2 = __uint_as_float(ra[i][2]), x3 = __uint_as_float(ra[i][3]);
        float h0 = fmaf(fmaf(x0, rstd, nmr), g.x, b.x);
        float h1 = fmaf(fmaf(x1, rstd, nmr), g.y, b.y);
        float h2 = fmaf(fmaf(x2, rstd, nmr), g.z, b.z);
        float h3 = fmaf(fmaf(x3, rstd, nmr), g.w, b.w);
        w[i * 2] = pack2(h0, h1); w[i * 2 + 1] = pack2(h2, h3);
      }
      o0 = (u4v){w[0], w[1], w[2], w[3]}; o1 = (u4v){w[4], w[5], w[6], w[7]};
    } else {
      const int k0 = kt * 32 + akh * 16;
      unsigned w[8];
#pragma unroll
      for (int i = 0; i < 2; ++i) {
        const u4v su = ra[i];
        const u4v y0 = ra[2 + i];
        const u4v y1 = ra[4 + i];
#pragma unroll
        for (int j = 0; j < 4; ++j) {
          float d0 = a.dsk[k0 + i * 8 + j * 2], d1 = a.dsk[k0 + i * 8 + j * 2 + 1];
          float v0 = geluf_(d0 * bflo(su[j]) + bflo(y0[j]) + bflo(y1[j]));
          float v1 = geluf_(d1 * bfhi(su[j]) + bfhi(y0[j]) + bfhi(y1[j]));
          w[i * 4 + j] = pack2(v0, v1);
        }
      }
      o0 = (u4v){w[0], w[1], w[2], w[3]}; o1 = (u4v){w[4], w[5], w[6], w[7]};
    }
    u4v* ap = (u4v*)(As + buf * (128 * 40) + ar * 40 + akh * 16);
    ap[0] = o0; ap[1] = o1;
    u4v* bsp = (u4v*)(Bs + buf * (128 * 40) + ar * 40 + akh * 16);
    bsp[0] = rb[0]; bsp[1] = rb[1];
  };

  const int nk = K >> 5;
  issue(0);
  stage(0, 0);
  __syncthreads();
#pragma unroll 1
  for (int kt = 0; kt < nk; ++kt) {
    const int buf = kt & 1;
    if (kt + 1 < nk) issue(kt + 1);
    const u16* Ab = As + buf * (128 * 40) + (wm * 64 + (lane & 31)) * 40 + (lane >> 5) * 8;
    const u16* Bb = Bs + buf * (128 * 40) + (wn * 64 + (lane & 31)) * 40 + (lane >> 5) * 8;
#pragma unroll
    for (int ks = 0; ks < 2; ++ks) {
      s8v af0 = *(const s8v*)(Ab + ks * 16);
      s8v af1 = *(const s8v*)(Ab + 32 * 40 + ks * 16);
      s8v bf0 = *(const s8v*)(Bb + ks * 16);
      s8v bf1 = *(const s8v*)(Bb + 32 * 40 + ks * 16);
      acc[0][0] = __builtin_amdgcn_mfma_f32_32x32x16_bf16(af0, bf0, acc[0][0], 0, 0, 0);
      acc[0][1] = __builtin_amdgcn_mfma_f32_32x32x16_bf16(af0, bf1, acc[0][1], 0, 0, 0);
      acc[1][0] = __builtin_amdgcn_mfma_f32_32x32x16_bf16(af1, bf0, acc[1][0], 0, 0, 0);
      acc[1][1] = __builtin_amdgcn_mfma_f32_32x32x16_bf16(af1, bf1, acc[1][1], 0, 0, 0);
    }
    if (kt + 1 < nk) stage(buf ^ 1, kt + 1);
    __syncthreads();
  }
}

#define EPI_ROW(mi, reg) (m0 + wm * 64 + (mi) * 32 + ((reg) & 3) + 8 * ((reg) >> 2) + 4 * (lane >> 5))
#define EPI_COL(ni) (n0 + wn * 64 + (ni) * 32 + (lane & 31))

__device__ __forceinline__ void stats_accum(float* stats, int row, float v0, float v1, int lane) {
  float s = v0 + v1, q = v0 * v0 + v1 * v1;
#pragma unroll
  for (int o = 1; o < 32; o <<= 1) {
    s += __shfl_xor(s, o);
    q += __shfl_xor(q, o);
  }
  if ((lane & 31) == 0) {
    atomicAdd(stats + row * 2, s);
    atomicAdd(stats + row * 2 + 1, q);
  }
}

#define P0_ADA 768
#define P0_ROPE 1
#define P0_CACHE 64
#define P0_S0 64
#define P0_S5 128
#define P0_WT_PER_LAYER (16 * 112 + 8 * 8 + 3 * 8 * 16 + 16 * 16 + 16 * 88 + 44 * 16)
#define P0_WT (2 * P0_WT_PER_LAYER)
#define P0_ITEMS (P0_ADA + P0_ROPE + P0_CACHE + P0_S0 + P0_S5 + P0_WT)

__device__ __forceinline__ void wt_tile(const float* __restrict__ src, int N, u16* __restrict__ dst, int ldd, int kt, int nt, char* smem) {
  float* tile = (float*)smem;
  const int tid = ltid();
  __syncthreads();
  {
    const int c4 = (tid & 15) * 4, r0 = tid >> 4;
#pragma unroll
    for (int i = 0; i < 4; ++i) {
      const int k = r0 + 16 * i;
      const float4 v = *(const float4*)(src + (size_t)(kt * 64 + k) * N + nt * 64 + c4);
      tile[k * 65 + c4] = v.x; tile[k * 65 + c4 + 1] = v.y; tile[k * 65 + c4 + 2] = v.z; tile[k * 65 + c4 + 3] = v.w;
    }
  }
  __syncthreads();
  {
    const int n = tid >> 2, k0 = (tid & 3) * 16;
#define WTP(j) pack2(tile[(k0 + 2 * (j)) * 65 + n], tile[(k0 + 2 * (j) + 1) * 65 + n])
    u4v* d = (u4v*)(dst + (size_t)(nt * 64 + n) * ldd + kt * 64 + k0);
    d[0] = (u4v){WTP(0), WTP(1), WTP(2), WTP(3)};
    d[1] = (u4v){WTP(4), WTP(5), WTP(6), WTP(7)};
#undef WTP
  }
}
__device__ __forceinline__ void wt_item(const Params& p, char* smem, int item) {
  const int l = item / P0_WT_PER_LAYER;
  int it = item % P0_WT_PER_LAYER;
  u16* base = WS_Wt + WT_LAYER * l;
  if (it < 16 * 112) { wt_tile(p.w_in + (size_t)l * 1024 * 7168, 7168, base + WT_IN, 1024, it / 112, it % 112, smem); return; }
  it -= 16 * 112;
  if (it < 64) { wt_tile(p.w_glu + (size_t)l * 512 * 512, 512, base + WT_GLU, 512, it / 8, it % 8, smem); return; }
  it -= 64;
  if (it < 384) { const int br = it / 128; it %= 128;
    wt_tile(p.w_branch + ((size_t)l * 3 + br) * 512 * 1024, 1024, base + WT_BR + (size_t)br * 512 * 1024, 512, it / 16, it % 16, smem); return; }
  it -= 384;
  if (it < 256) { wt_tile(p.w_o + (size_t)l * 1024 * 1024, 1024, base + WT_O, 1024, it / 16, it % 16, smem); return; }
  it -= 256;
  if (it < 16 * 88) { wt_tile(p.w_up + (size_t)l * 1024 * 5632, 5632, base + WT_UP, 1024, it / 88, it % 88, smem); return; }
  it -= 16 * 88;
  wt_tile(p.w_down + (size_t)l * 2816 * 1024, 1024, base + WT_DOWN, 2816, it / 16, it % 16, smem);
}

__device__ __forceinline__ void phase0_item(const Params& p, char* smem, int item) {
  const int tid = ltid();
  if (item < P0_ADA) {
    const int ks = item & 3, cg = (item >> 2) % 96, l = item / 384;
    float* scs = (float*)smem;
    float* red = scs + 5 * 256;
    __syncthreads();
    for (int i = tid; i < 5 * 256; i += 256) {
      int ci = i >> 8, k = ks * 256 + (i & 255);
      float v = ci == 0 ? p.c_ctx[k] : p.c[(ci - 1) * 1024 + k];
      scs[i] = siluf_(v);
    }
    __syncthreads();
    const int ct = tid & 15, kg = tid >> 4;
    const float* wp = p.w_ada + (size_t)l * 1024 * 6144 + (size_t)(ks * 256 + kg * 16) * 6144 + cg * 64 + ct * 4;
    float acc[5][4];
#pragma unroll
    for (int i = 0; i < 5; ++i)
#pragma unroll
      for (int j = 0; j < 4; ++j) acc[i][j] = 0.f;
#pragma unroll 4
    for (int k = 0; k < 16; ++k) {
      float4 w = *(const float4*)(wp + (size_t)k * 6144);
#pragma unroll
      for (int ci = 0; ci < 5; ++ci) {
        float s = scs[ci * 256 + kg * 16 + k];
        acc[ci][0] += s * w.x; acc[ci][1] += s * w.y; acc[ci][2] += s * w.z; acc[ci][3] += s * w.w;
      }
    }
#pragma unroll
    for (int ci = 0; ci < 5; ++ci)
#pragma unroll
      for (int j = 0; j < 4; ++j) red[(kg * 5 + ci) * 64 + ct * 4 + j] = acc[ci][j];
    __syncthreads();
    for (int i = tid; i < 320; i += 256) {
      int ci = i >> 6, col = i & 63;
      float s = 0.f;
#pragma unroll
      for (int g = 0; g < 16; ++g) s += red[(g * 5 + ci) * 64 + col];
      if (ks == 0) s += p.b_ada[l * 6144 + cg * 64 + col];
      atomicAdd(WS_mod + (l * 5 + ci) * 6144 + cg * 64 + col, s);
    }
    return;
  }
  item -= P0_ADA;
  if (item < P0_ROPE) {
    for (int i = tid; i < 64 * 32; i += 256) {
      int pos = i >> 5, fi = i & 31;
      float inv = (float)pow(10000.0, -(double)fi / 32.0);
      float ang = (float)pos * inv;
      WS_ropetab[i * 2] = (float)cos((double)ang);
      WS_ropetab[i * 2 + 1] = (float)sin((double)ang);
    }
    return;
  }
  item -= P0_ROPE;
  if (item < P0_CACHE) {
    const int pc = item & 7, b = (item >> 3) & 3, l = item >> 5;
    const float* ksrc = p.cache_k + ((size_t)(b * 2 + l) * 512 + pc * 64) * 512;
    const float* vsrc = p.cache_v + ((size_t)(b * 2 + l) * 512 + pc * 64) * 512;
    u16* kdst = WS_CK + ((size_t)(l * 4 + b) * 512 + pc * 64) * 512;
    for (int i = tid; i < 64 * 512 / 4; i += 256) {
      float4 v = *(const float4*)(ksrc + (size_t)i * 4);
      *(uint2*)(kdst + (size_t)i * 4) = make_uint2(pack2(v.x, v.y), pack2(v.z, v.w));
    }
    for (int cc = 0; cc < 2; ++cc) {
      const int col = tid + cc * 256;
      u16* vdst = WS_CVt + ((size_t)(l * 4 + b) * 512 + col) * 512 + pc * 64;
      for (int j = 0; j < 8; ++j) {
        float v[8];
#pragma unroll
        for (int e = 0; e < 8; ++e) v[e] = vsrc[(size_t)(j * 8 + e) * 512 + col];
        *(uint4*)(vdst + j * 8) = make_uint4(pack2(v[0], v[1]), pack2(v[2], v[3]), pack2(v[4], v[5]), pack2(v[6], v[7]));
      }
    }
    return;
  }
  item -= P0_CACHE;
  if (item < P0_S0) {
    const int hh = item & 3, dir = (item >> 2) & 1, b = (item >> 3) & 3, l = item >> 5;
    const float* src = p.state_ret + ((size_t)(((b * 2 + l) * 2 + dir) * 4 + hh)) * 16384;
    u16* dst = WS_S0t + ((size_t)(((l * 4 + b) * 2 + dir) * 4 + hh)) * 16384;
    const int dv = tid & 127, kh = tid >> 7;
    for (int j = 0; j < 8; ++j) {
      const int dk0 = kh * 64 + j * 8;
      float v[8];
#pragma unroll
      for (int e = 0; e < 8; ++e) v[e] = src[(size_t)(dk0 + e) * 128 + dv];
      *(uint4*)(dst + (size_t)dv * 128 + dk0) = make_uint4(pack2(v[0], v[1]), pack2(v[2], v[3]), pack2(v[4], v[5]), pack2(v[6], v[7]));
    }
    return;
  }
  item -= P0_S0;
  if (item >= P0_S5) { wt_item(p, smem, item - P0_S5); return; }
  {
    const int g = item & 31, dir = (item >> 5) & 1, l = item >> 6;
    if (tid < 64) {
      const int pp = tid;
      const int ai = ((l * 2 + dir) * 32 + g) * 64 + pp;
      double lre = fmin((double)p.a_re[ai], -1e-4), lim = (double)p.a_im[ai];
      double dt = exp((double)p.log_dt[(l * 2 + dir) * 32 + g]);
      double er = exp(lre * dt);
      double abr = er * cos(lim * dt), abi = er * sin(lim * dt);
      WS_abar[ai * 2] = (float)abr;
      WS_abar[ai * 2 + 1] = (float)abi;
      double nr = abr - 1.0, ni = abi;
      double den = lre * lre + lim * lim;
      double cr = (nr * lre + ni * lim) / den, cim = (ni * lre - nr * lim) / den;
      u16* bt = WS_bbarT + (size_t)((l * 2 + dir) * 32 + g) * 128 * 16;
      const float* br = p.b_re + ((size_t)(l * 32 + g) * 64 + pp) * 16;
      const float* bi = p.b_im + ((size_t)(l * 32 + g) * 64 + pp) * 16;
      for (int c = 0; c < 16; ++c) {
        double xr = br[c], xi = bi[c];
        bt[pp * 16 + c] = f2bf((float)(cr * xr - cim * xi));
        bt[(64 + pp) * 16 + c] = f2bf((float)(cr * xi + cim * xr));
      }
      u16* ct = WS_cmT + (size_t)((l * 2 + dir) * 32 + g) * 16 * 128;
      const float* cre = p.c_re + ((size_t)((l * 2 + dir) * 32 + g) * 16) * 64;
      const float* cie = p.c_im + ((size_t)((l * 2 + dir) * 32 + g) * 16) * 64;
      for (int c = 0; c < 16; ++c) {
        ct[c * 128 + pp] = f2bf(cre[c * 64 + pp]);
        ct[c * 128 + 64 + pp] = f2bf(-cie[c * 64 + pp]);
      }
    }
  }
}

__device__ __forceinline__ void p1_item(const Params& p, char* smem, int l, int item) {
  const int mt = item & 63, nt = item >> 6;
  const int m0 = mt * 128, n0 = nt * 128;
  const int tid = ltid(), lane = tid & 63, wave = tid >> 6, wm = wave >> 1, wn = wave & 1;
  AArgs a{};
  const float* mod = WS_mod + l * 5 * 6144;
  if (l == 0) {
    a.A32lo = p.x_prompt; a.A32hi = p.x_sample; a.stats = nullptr; a.lng = nullptr; a.lnb = nullptr;
  } else {
    a.A32lo = p.out; a.A32hi = p.out + (size_t)TCTX * 1024; a.stats = WS_stats + (size_t)(0 * 2 + 1) * TALL * 2;
    a.lng = p.ln2_g; a.lnb = p.ln2_b;
  }
  a.sc = mod + 1024; a.sh = mod;
  f16v acc[2][2];
  gemm_mainloop<1>(smem, a, WS_Wt + WT_LAYER * l + WT_IN, 1024, 1024, m0, n0, acc);

  const bool latent = m0 >= TCTX;
  const int seg = n0 >> 9;
  const int csw = (n0 & 511) + wn * 64;
  const int l31 = lane & 31;
  if (seg >= 8) {
    const int gc = (n0 - 4096) + wn * 64 + l31;
#pragma unroll
    for (int mi = 0; mi < 2; ++mi)
#pragma unroll
      for (int reg = 0; reg < 16; ++reg) {
        const int row = EPI_ROW(mi, reg);
        WS_GT[(size_t)row * 3072 + gc] = f2bf(sigmoidf_(acc[mi][0][reg]));
        WS_GT[(size_t)row * 3072 + gc + 32] = f2bf(sigmoidf_(acc[mi][1][reg]));
      }
    return;
  }
  if (seg <= 1) {
    u16* dst = seg == 0 ? WS_Q : WS_K;
    const float scl = seg == 0 ? 1.f : 0.08838834764831845f;
    const bool colhalf = (csw & 64) != 0;
#pragma unroll
    for (int mi = 0; mi < 2; ++mi)
#pragma unroll
      for (int q = 0; q < 4; ++q) {
        float o0[4], o1[4];
#pragma unroll
        for (int j = 0; j < 4; ++j) {
          const int reg = q * 4 + j;
          const int row = EPI_ROW(mi, reg);
          float x1 = acc[mi][0][reg], x2 = acc[mi][1][reg];
          if (latent) {
            const int pos = (row - TCTX) & 1023;
            const int pidx = colhalf ? (pos & 63) : (pos >> 6);
            const float cs = WS_ropetab[(pidx * 32 + l31) * 2], sn = WS_ropetab[(pidx * 32 + l31) * 2 + 1];
            float t1 = x1 * cs - x2 * sn, t2 = x1 * sn + x2 * cs;
            x1 = t1; x2 = t2;
          }
          x1 *= scl; x2 *= scl;
          o0[j] = x1; o1[j] = x2;
          dst[(size_t)row * 512 + csw + l31] = f2bf(x1);
          dst[(size_t)row * 512 + csw + 32 + l31] = f2bf(x2);
        }
        if (seg == 1 && !latent) {
          const int row0 = EPI_ROW(mi, q * 4);
          const int b = row0 >> 8, pos = row0 & 255;
          const int c0 = csw + l31, c1 = c0 + 32;
          *(uint2*)(WS_KtR + ((size_t)(b * 4 + (c0 >> 7)) * 128 + (c0 & 127)) * 256 + pos) = make_uint2(pack2(o0[0], o0[1]), pack2(o0[2], o0[3]));
          *(uint2*)(WS_KtR + ((size_t)(b * 4 + (c1 >> 7)) * 128 + (c1 & 127)) * 256 + pos) = make_uint2(pack2(o1[0], o1[1]), pack2(o1[2], o1[3]));
        }
      }
    return;
  }
  if (seg == 2 || seg == 7) {
#pragma unroll
    for (int mi = 0; mi < 2; ++mi)
#pragma unroll
      for (int q = 0; q < 4; ++q) {
        const int row0 = EPI_ROW(mi, q * 4);
#pragma unroll
        for (int ni = 0; ni < 2; ++ni) {
          const int col = csw + ni * 32 + l31;
          float v0 = acc[mi][ni][q * 4], v1 = acc[mi][ni][q * 4 + 1], v2 = acc[mi][ni][q * 4 + 2], v3 = acc[mi][ni][q * 4 + 3];
          uint2 pk = make_uint2(pack2(v0, v1), pack2(v2, v3));
          if (seg == 2) {
            const int hh = col >> 7, dd = col & 127;
            if (!latent) {
              const int b = row0 >> 8, pos = row0 & 255;
              *(uint2*)(WS_VtR + ((size_t)(b * 4 + hh) * 128 + dd) * 256 + pos) = pk;
            } else {
              const int b = (row0 - TCTX) >> 10, pos = (row0 - TCTX) & 1023;
              *(uint2*)(WS_VtR + VTR_LAT + ((size_t)(b * 4 + hh) * 128 + dd) * 1024 + pos) = pk;
            }
          } else {
            const int hh = col >> 6, dd = col & 63;
            if (!latent) {
              const int b = row0 >> 8, pos = row0 & 255;
              *(uint2*)(WS_NVt + ((size_t)(b * 8 + hh) * 64 + dd) * 256 + pos) = pk;
              float* o = p.out + OUT_CV + ((size_t)(b * 2 + l) * 256 + pos) * 512 + col;
              o[0] = v0; o[512] = v1; o[1024] = v2; o[1536] = v3;
            } else {
              const int b = (row0 - TCTX) >> 10, pos = (row0 - TCTX) & 1023;
              *(uint2*)(WS_NVt + NVT_LAT + ((size_t)(b * 8 + hh) * 64 + dd) * 1024 + pos) = pk;
            }
          }
        }
      }
    return;
  }
  u16* dst = seg == 3 ? WS_G : seg == 4 ? WS_SU : seg == 5 ? WS_NQ : WS_NK;
#pragma unroll
  for (int mi = 0; mi < 2; ++mi)
#pragma unroll
    for (int reg = 0; reg < 16; ++reg) {
      const int row = EPI_ROW(mi, reg);
#pragma unroll
      for (int ni = 0; ni < 2; ++ni) {
        const int col = csw + ni * 32 + l31;
        float v = acc[mi][ni][reg];
        float w = seg == 3 ? siluf_(v) : (seg == 5 ? v * 0.125f : v);
        dst[(size_t)row * 512 + col] = f2bf(w);
        if (seg == 6 && !latent) {
          const int b = row >> 8, pos = row & 255;
          p.out[OUT_CK + ((size_t)(b * 2 + l) * 256 + pos) * 512 + col] = v;
        }
      }
    }
}

template <int D, int MODE>
__device__ __forceinline__ void attn_item(const Params& p, char* smem, int l, int idx) {
  constexpr int KSTR = D + 8;
  constexpr int NKS = D / 32;
  constexpr int NB = D / 16;
  constexpr int NCH = D / 32;
  u16* Ks = (u16*)smem;
  u16* Vts = Ks + 64 * KSTR;
  float* rpbs = (float*)(Vts + D * 72);
  const int tid = ltid(), lane = tid & 63, wave = tid >> 6;
  const int l15 = lane & 15, g = lane >> 4;

  int b, hh, qt, L, tokbase, nt;
  bool latent = false;
  int kr0 = 0, rrow = 0;
  if constexpr (MODE == 0) {
    if (idx < 256) { latent = true; b = idx >> 6; hh = (idx >> 4) & 3; qt = idx & 15; L = 1024; tokbase = TCTX + b * 1024; nt = 16 + 4; }
    else { idx -= 256; b = idx >> 4; hh = (idx >> 2) & 3; qt = idx & 3; L = 256; tokbase = b * 256; nt = 4; }
  } else if constexpr (MODE == 1) {
    b = idx >> 5; hh = (idx >> 2) & 7; qt = idx & 3; L = 256; tokbase = b * 256; nt = 4;
  } else {
    b = idx >> 7; hh = (idx >> 4) & 7; qt = idx & 15; rrow = qt; L = 1024; tokbase = TCTX + b * 1024; nt = 16; latent = true;
    kr0 = min(max(rrow - 4, 0), 8);
  }
  const int tq = qt * 64 + wave * 16 + l15;
  const int qtok = tokbase + tq;

  float lgf2 = 0.f, lgb2 = 0.f;
  if constexpr (MODE == 0) {
    float xf = p.ret_decay[(l * 2 + 0) * 4 + hh], xb = p.ret_decay[(l * 2 + 1) * 4 + hh];
    lgf2 = -log1pf(expf(-xf)) * 1.4426950408889634f;
    lgb2 = -log1pf(expf(-xb)) * 1.4426950408889634f;
  }

  __syncthreads();
  if constexpr (MODE == 2) {
    for (int i = tid; i < 465; i += 256) rpbs[i] = p.rpb[(size_t)(l * 8 + hh) * 465 + i];
  }

  u4v qf[NKS];
  {
    const u16* qb = (MODE == 0 ? WS_Q : WS_NQ) + (size_t)qtok * 512 + hh * D + g * 8;
#pragma unroll
    for (int ks = 0; ks < NKS; ++ks) qf[ks] = *(const u4v*)(qb + ks * 32);
  }

  f4v ot[NB];
#pragma unroll
  for (int nb = 0; nb < NB; ++nb) ot[nb] = (f4v){0.f, 0.f, 0.f, 0.f};
  float mrun = -1e30f, lsum = 0.f;

  const int ntk = (MODE == 0) ? (L >> 6) : nt;
  u4v kr[NCH], vr[NCH];
#define ATTN_ISSUE(KT)                                                                                   \
  {                                                                                                      \
    const int kt_ = (KT);                                                                                \
    const u16* kp; const u16* vp; int ldv;                                                               \
    if constexpr (MODE == 0) {                                                                           \
      kp = WS_K + (size_t)(tokbase + kt_ * 64) * 512 + hh * 128;                                          \
      if (latent) { vp = WS_VtR + VTR_LAT + ((size_t)(b * 4 + hh) * 128) * 1024 + kt_ * 64; ldv = 1024; } \
      else { vp = WS_VtR + ((size_t)(b * 4 + hh) * 128) * 256 + kt_ * 64; ldv = 256; }                    \
    } else if constexpr (MODE == 1) {                                                                    \
      kp = WS_NK + (size_t)(tokbase + kt_ * 64) * 512 + hh * 64;                                          \
      vp = WS_NVt + ((size_t)(b * 8 + hh) * 64) * 256 + kt_ * 64; ldv = 256;                              \
    } else {                                                                                             \
      if (kt_ < 8) {                                                                                     \
        const int krow = kr0 + kt_;                                                                      \
        kp = WS_NK + (size_t)(tokbase + krow * 64) * 512 + hh * 64;                                       \
        vp = WS_NVt + NVT_LAT + ((size_t)(b * 8 + hh) * 64) * 1024 + krow * 64; ldv = 1024;               \
      } else {                                                                                           \
        kp = WS_CK + ((size_t)(l * 4 + b) * 512 + (kt_ - 8) * 64) * 512 + hh * 64;                        \
        vp = WS_CVt + ((size_t)((l * 4 + b) * 8 + hh) * 64) * 512 + (kt_ - 8) * 64; ldv = 512;            \
      }                                                                                                  \
    }                                                                                                    \
    _Pragma("unroll") for (int i = 0; i < NCH; ++i) {                                                    \
      const int c = tid + 256 * i;                                                                       \
      const int r = c / (D / 8), cc = c % (D / 8);                                                       \
      kr[i] = *(const u4v*)(kp + (size_t)r * 512 + cc * 8);                                              \
      const int vrw = c >> 3, vc = c & 7;                                                                \
      vr[i] = *(const u4v*)(vp + (size_t)vrw * ldv + vc * 8);                                            \
    }                                                                                                    \
  }
#define ATTN_STAGE()                                                                                     \
  {                                                                                                      \
    _Pragma("unroll") for (int i = 0; i < NCH; ++i) {                                                    \
      const int c = tid + 256 * i;                                                                       \
      const int r = c / (D / 8), cc = c % (D / 8);                                                       \
      *(u4v*)(Ks + r * KSTR + cc * 8) = kr[i];                                                           \
      const int vrw = c >> 3, vc = c & 7;                                                                \
      *(u4v*)(Vts + vrw * 72 + vc * 8) = vr[i];                                                          \
    }                                                                                                    \
  }

  ATTN_ISSUE(0)
#pragma unroll 1
  for (int kt = 0; kt < ntk; ++kt) {
    __syncthreads();
    ATTN_STAGE()
    __syncthreads();
    if (kt + 1 < ntk) ATTN_ISSUE(kt + 1)
    f4v st[4];
#pragma unroll
    for (int kb = 0; kb < 4; ++kb) {
      st[kb] = (f4v){0.f, 0.f, 0.f, 0.f};
#pragma unroll
      for (int ks = 0; ks < NKS; ++ks) {
        s8v kf = *(const s8v*)(Ks + (kb * 16 + l15) * KSTR + ks * 32 + g * 8);
        st[kb] = __builtin_amdgcn_mfma_f32_16x16x32_bf16(kf, bc8(qf[ks]), st[kb], 0, 0, 0);
      }
    }
    if constexpr (MODE == 0) {
#pragma unroll
      for (int kb = 0; kb < 4; ++kb)
#pragma unroll
        for (int r = 0; r < 4; ++r) {
          const int ts = kt * 64 + kb * 16 + g * 4 + r;
          const int d = tq - ts;
          float dec = d > 0 ? exp2f(lgf2 * (float)d) : (d < 0 ? exp2f(lgb2 * (float)(-d)) : 2.f);
          st[kb][r] *= dec;
        }
    } else {
      if constexpr (MODE == 2) {
        if (kt < 8) {
          const int qc = wave * 16 + l15;
          const int ws = min(max(qc - 8, 0), 48);
          const int roff = (kr0 + kt) - rrow + 7;
#pragma unroll
          for (int kb = 0; kb < 4; ++kb)
#pragma unroll
            for (int r = 0; r < 4; ++r) {
              const int kc = kb * 16 + g * 4 + r;
              const bool valid = (kc >= ws) && (kc < ws + 16);
              const int coff = min(max(kc - qc + 15, 0), 30);
              const float bias = rpbs[roff * 31 + coff];
              st[kb][r] = valid ? st[kb][r] + bias : -1e30f;
            }
        }
      }
      float tmax = st[0][0];
#pragma unroll
      for (int kb = 0; kb < 4; ++kb)
#pragma unroll
        for (int r = 0; r < 4; ++r) tmax = fmaxf(tmax, st[kb][r]);
      tmax = fmaxf(tmax, __shfl_xor(tmax, 16));
      tmax = fmaxf(tmax, __shfl_xor(tmax, 32));
      const float mnew = fmaxf(mrun, tmax);
      const float alpha = __expf(mrun - mnew);
      float ps = 0.f;
#pragma unroll
      for (int kb = 0; kb < 4; ++kb)
#pragma unroll
        for (int r = 0; r < 4; ++r) {
          float e = __expf(st[kb][r] - mnew);
          st[kb][r] = e;
          ps += e;
        }
      lsum = lsum * alpha + ps;
      mrun = mnew;
#pragma unroll
      for (int nb = 0; nb < NB; ++nb) ot[nb] *= alpha;
    }
    u4v pf[2];
#pragma unroll
    for (int s = 0; s < 2; ++s) {
      pf[s] = (u4v){pack2(st[2 * s][0], st[2 * s][1]), pack2(st[2 * s][2], st[2 * s][3]),
                    pack2(st[2 * s + 1][0], st[2 * s + 1][1]), pack2(st[2 * s + 1][2], st[2 * s + 1][3])};
    }
#pragma unroll
    for (int nb = 0; nb < NB; ++nb)
#pragma unroll
      for (int s = 0; s < 2; ++s) {
        const u16* vb = Vts + (nb * 16 + l15) * 72 + s * 32 + g * 4;
        uint2 lo = *(const uint2*)(vb);
        uint2 hi = *(const uint2*)(vb + 16);
        u4v vf = (u4v){lo.x, lo.y, hi.x, hi.y};
        ot[nb] = __builtin_amdgcn_mfma_f32_16x16x32_bf16(bc8(vf), bc8(pf[s]), ot[nb], 0, 0, 0);
      }
  }

  if constexpr (MODE == 0) {
    if (latent) {
#pragma unroll 1
      for (int dir = 0; dir < 2; ++dir) {
        const float scale = dir == 0 ? exp2f(lgf2 * (float)(tq + 1)) : exp2f(lgb2 * (float)(L - tq));
        const u16* S0 = WS_S0t + ((size_t)(((l * 4 + b) * 2 + dir) * 4 + hh)) * 16384;
#pragma unroll
        for (int s = 0; s < NKS; ++s) {
          u4v pq = (u4v){pack2(bflo(qf[s][0]) * scale, bfhi(qf[s][0]) * scale), pack2(bflo(qf[s][1]) * scale, bfhi(qf[s][1]) * scale),
                         pack2(bflo(qf[s][2]) * scale, bfhi(qf[s][2]) * scale), pack2(bflo(qf[s][3]) * scale, bfhi(qf[s][3]) * scale)};
#pragma unroll
          for (int nb = 0; nb < NB; ++nb) {
            u4v vf = *(const u4v*)(S0 + (size_t)(nb * 16 + l15) * 128 + s * 32 + g * 8);
            ot[nb] = __builtin_amdgcn_mfma_f32_16x16x32_bf16(bc8(vf), bc8(pq), ot[nb], 0, 0, 0);
          }
        }
      }
    }
    float s = 0.f;
#pragma unroll
    for (int nb = 0; nb < NB; ++nb) s += ot[nb][0] + ot[nb][1] + ot[nb][2] + ot[nb][3];
    s += __shfl_xor(s, 16); s += __shfl_xor(s, 32);
    const float mu = s * (1.f / 128.f);
    float q = 0.f;
#pragma unroll
    for (int nb = 0; nb < NB; ++nb)
#pragma unroll
      for (int r = 0; r < 4; ++r) { float dlt = ot[nb][r] - mu; q += dlt * dlt; }
    q += __shfl_xor(q, 16); q += __shfl_xor(q, 32);
    const float rstd = rsqrtf(q * (1.f / 128.f) + LNEPS);
#pragma unroll
    for (int nb = 0; nb < NB; ++nb) {
      const size_t off = (size_t)qtok * 512 + hh * 128 + nb * 16 + g * 4;
      uint2 gg = *(const uint2*)(WS_G + off);
      float o0 = (ot[nb][0] - mu) * rstd * bflo(gg.x);
      float o1 = (ot[nb][1] - mu) * rstd * bfhi(gg.x);
      float o2 = (ot[nb][2] - mu) * rstd * bflo(gg.y);
      float o3 = (ot[nb][3] - mu) * rstd * bfhi(gg.y);
      *(uint2*)(WS_rout + off) = make_uint2(pack2(o0, o1), pack2(o2, o3));
    }
  } else {
    lsum += __shfl_xor(lsum, 16); lsum += __shfl_xor(lsum, 32);
    const float inv = 1.f / lsum;
#pragma unroll
    for (int nb = 0; nb < NB; ++nb) {
      const size_t off = (size_t)qtok * 512 + hh * 64 + nb * 16 + g * 4;
      *(uint2*)(WS_nout + off) = make_uint2(pack2(ot[nb][0] * inv, ot[nb][1] * inv), pack2(ot[nb][2] * inv, ot[nb][3] * inv));
    }
  }
}

__device__ __forceinline__ void retstate_item(const Params& p, int l, int idx) {
  const int dir = idx & 1, hh = (idx >> 1) & 3, b = idx >> 3;
  const int tid = ltid(), lane = tid & 63, wave = tid >> 6;
  const int r = lane & 31, h2 = lane >> 5;
  const float x = p.ret_decay[(l * 2 + dir) * 4 + hh];
  const float lg2 = -log1pf(expf(-x)) * 1.4426950408889634f;
  const u16* Kt = WS_KtR + ((size_t)(b * 4 + hh) * 128) * 256;
  const u16* Vt = WS_VtR + ((size_t)(b * 4 + hh) * 128) * 256;
  f16v acc[4];
#pragma unroll
  for (int i = 0; i < 4; ++i) acc[i] = zero16();
#pragma unroll 2
  for (int ks = 0; ks < 16; ++ks) {
    const int tok0 = ks * 16 + h2 * 8;
    const u4v a = *(const u4v*)(Kt + (size_t)(wave * 32 + r) * 256 + tok0);
    u4v af;
#pragma unroll
    for (int w = 0; w < 4; ++w) {
      const int t0 = tok0 + 2 * w, t1 = t0 + 1;
      float w0 = dir == 0 ? exp2f(lg2 * (float)(255 - t0)) : exp2f(lg2 * (float)t0);
      float w1 = dir == 0 ? exp2f(lg2 * (float)(255 - t1)) : exp2f(lg2 * (float)t1);
      af[w] = pack2(bflo(a[w]) * w0, bfhi(a[w]) * w1);
    }
#pragma unroll
    for (int nt = 0; nt < 4; ++nt) {
      const u4v bfr = *(const u4v*)(Vt + (size_t)(nt * 32 + r) * 256 + tok0);
      acc[nt] = __builtin_amdgcn_mfma_f32_32x32x16_bf16(bc8(af), bc8(bfr), acc[nt], 0, 0, 0);
    }
  }
  float* o = p.out + OUT_SRET + ((size_t)(((b * 2 + l) * 2 + dir) * 4 + hh)) * 16384;
#pragma unroll
  for (int nt = 0; nt < 4; ++nt)
#pragma unroll
    for (int reg = 0; reg < 16; ++reg) {
      const int dk = wave * 32 + (reg & 3) + 8 * (reg >> 2) + 4 * h2;
      o[(size_t)dk * 128 + nt * 32 + r] = acc[nt][reg];
    }
}

__device__ __forceinline__ void s5_item(const Params& p, char* smem, int l, int item) {
  const int tid = ltid(), lane = tid & 63, wave = tid >> 6;
  const int l15 = lane & 15, g4 = lane >> 4;
  int seq = item * 4 + wave;
  int b, dir, g, L, tokbase;
  bool latent;
  if (seq < 256) { latent = true; b = seq >> 6; dir = (seq >> 5) & 1; g = seq & 31; L = 1024; tokbase = TCTX + b * 1024; }
  else { seq -= 256; latent = false; b = seq >> 6; dir = (seq >> 5) & 1; g = seq & 31; L = 256; tokbase = b * 256; }
  float* buf = (float*)smem + wave * (16 * 132);
  const int tg = (l * 2 + dir) * 32 + g;
  const float ar = WS_abar[(tg * 64 + lane) * 2], ai = WS_abar[(tg * 64 + lane) * 2 + 1];
  u4v bfrag[8];
#pragma unroll
  for (int nt = 0; nt < 8; ++nt) {
    if (g4 < 2) bfrag[nt] = *(const u4v*)(WS_bbarT + ((size_t)tg * 128 + nt * 16 + l15) * 16 + g4 * 8);
    else bfrag[nt] = (u4v){0u, 0u, 0u, 0u};
  }
  u4v cfrag[4];
#pragma unroll
  for (int ks = 0; ks < 4; ++ks) cfrag[ks] = *(const u4v*)(WS_cmT + ((size_t)tg * 16 + l15) * 128 + ks * 32 + g4 * 8);
  float xr = 0.f, xi = 0.f;
  if (latent) {
    const float* h0 = p.state_ssm + ((size_t)(((b * 2 + l) * 2 + dir) * 32 + g) * 64 + lane) * 2;
    xr = h0[0]; xi = h0[1];
  }
  u16* yd = WS_YD + (size_t)dir * TALL * 512;
  __syncthreads();
  const int nsub = L >> 4;
#pragma unroll 1
  for (int sub = 0; sub < nsub; ++sub) {
    u4v af;
    {
      const int tau = sub * 16 + l15;
      const int pos = dir == 0 ? tau : L - 1 - tau;
      if (g4 < 2) af = *(const u4v*)(WS_SU + (size_t)(tokbase + pos) * 512 + g * 16 + g4 * 8);
      else af = (u4v){0u, 0u, 0u, 0u};
    }
#pragma unroll
    for (int nt = 0; nt < 8; ++nt) {
      f4v c = (f4v){0.f, 0.f, 0.f, 0.f};
      c = __builtin_amdgcn_mfma_f32_16x16x32_bf16(bc8(af), bc8(bfrag[nt]), c, 0, 0, 0);
#pragma unroll
      for (int r = 0; r < 4; ++r) buf[(g4 * 4 + r) * 132 + nt * 16 + l15] = c[r];
    }
    __syncthreads();
#pragma unroll
    for (int i = 0; i < 16; ++i) {
      const float bur = buf[i * 132 + lane], bui = buf[i * 132 + 64 + lane];
      const float nr = ar * xr - ai * xi + bur;
      const float ni = ar * xi + ai * xr + bui;
      xr = nr; xi = ni;
      buf[i * 132 + lane] = xr;
      buf[i * 132 + 64 + lane] = xi;
    }
    __syncthreads();
    f4v y = (f4v){0.f, 0.f, 0.f, 0.f};
#pragma unroll
    for (int ks = 0; ks < 4; ++ks) {
      const float* bp = buf + l15 * 132 + ks * 32 + g4 * 8;
      float4 v0 = *(const float4*)(bp), v1 = *(const float4*)(bp + 4);
      const u4v xa = (u4v){pack2(v0.x, v0.y), pack2(v0.z, v0.w), pack2(v1.x, v1.y), pack2(v1.z, v1.w)};
      y = __builtin_amdgcn_mfma_f32_16x16x32_bf16(bc8(xa), bc8(cfrag[ks]), y, 0, 0, 0);
    }
#pragma unroll
    for (int r = 0; r < 4; ++r) {
      const int tau = sub * 16 + g4 * 4 + r;
      const int pos = dir == 0 ? tau : L - 1 - tau;
      yd[(size_t)(tokbase + pos) * 512 + g * 16 + l15] = f2bf(y[r]);
    }
    __syncthreads();
  }
  if (!latent) {
    float* o = p.out + OUT_SSSM + ((size_t)(((b * 2 + l) * 2 + dir) * 32 + g) * 64 + lane) * 2;
    o[0] = xr; o[1] = xi;
  }
}

#define MX_S5 320
#define MX_RET 512
#define MX_NA 512
#define MX_CA 512
#define MX_RS 128
#define MX_ITEMS (MX_S5 + MX_RET + MX_NA + MX_CA + MX_RS)
__device__ __forceinline__ void mixer_item(const Params& p, char* smem, int l, int item) {
  if (item < 64) { s5_item(p, smem, l, item); return; }
  item -= 64;
  if (item < 256) { attn_item<128, 0>(p, smem, l, item); return; }
  item -= 256;
  if (item < 512) { attn_item<64, 2>(p, smem, l, item); return; }
  item -= 512;
  if (item < 256) { s5_item(p, smem, l, 64 + item); return; }
  item -= 256;
  if (item < 256) { attn_item<128, 0>(p, smem, l, 256 + item); return; }
  item -= 256;
  if (item < 512) { attn_item<64, 1>(p, smem, l, item); return; }
  item -= 512;
  retstate_item(p, l, item);
}

__device__ __forceinline__ void p3a_item(const Params& p, char* smem, int l, int item) {
  const int mt = item & 63, nt = item >> 6;
  const int m0 = mt * 128, n0 = nt * 128;
  const int tid = ltid(), lane = tid & 63, wave = tid >> 6, wm = wave >> 1, wn = wave & 1;
  AArgs a{};
  a.SU = WS_SU; a.YD0 = WS_YD; a.YD1 = WS_YD + (size_t)TALL * 512; a.dsk = p.ssm_d + l * 512;
  f16v acc[2][2];
  gemm_mainloop<2>(smem, a, WS_Wt + WT_LAYER * l + WT_GLU, 512, 512, m0, n0, acc);
#pragma unroll
  for (int mi = 0; mi < 2; ++mi)
#pragma unroll
    for (int reg = 0; reg < 16; ++reg) {
      const int row = EPI_ROW(mi, reg);
#pragma unroll
      for (int ni = 0; ni < 2; ++ni) {
        const int col = EPI_COL(ni);
        const size_t off = (size_t)row * 512 + col;
        float y = geluf_(a.dsk[col] * bf2f(WS_SU[off]) + bf2f(a.YD0[off]) + bf2f(a.YD1[off]));
        WS_sout[off] = f2bf(y * sigmoidf_(acc[mi][ni][reg]));
      }
    }
}

__device__ __forceinline__ void p3b_item(const Params& p, char* smem, int l, int item) {
  const int mt = item & 63, nt = item >> 6;
  const int m0 = mt * 128, n0 = nt * 128;
  const int tid = ltid(), lane = tid & 63, wave = tid >> 6, wm = wave >> 1, wn = wave & 1;
  int nbr = 3;
  asm volatile("" : "+s"(nbr));
#pragma unroll 1
  for (int br = 0; br < nbr; ++br) {
    AArgs a{};
    a.A16 = br == 0 ? WS_rout : (br == 1 ? WS_sout : WS_nout); a.lda = 512;
    f16v acc[2][2];
    gemm_mainloop<0>(smem, a, WS_Wt + WT_LAYER * l + WT_BR + (size_t)br * 512 * 1024, 512, 512, m0, n0, acc);
    int rbase = m0 + wm * 64 + 4 * (lane >> 5);
    asm volatile("" : "+v"(rbase));
#pragma unroll
    for (int mi = 0; mi < 2; ++mi)
#pragma unroll
      for (int reg = 0; reg < 16; ++reg) {
        const int row = rbase + mi * 32 + (reg & 3) + 8 * (reg >> 2);
        const u16* gp = WS_GT + (size_t)row * 3072 + br * 1024 + EPI_COL(0);
        u16* mp = WS_merged + (size_t)row * 1024 + EPI_COL(0);
        float t0 = bf2f(gp[0]) * acc[mi][0][reg];
        float t1 = bf2f(gp[32]) * acc[mi][1][reg];
        if (br > 0) { t0 += bf2f(mp[0]); t1 += bf2f(mp[32]); }
        mp[0] = f2bf(t0);
        mp[32] = f2bf(t1);
        if ((reg & 3) == 3) __builtin_amdgcn_sched_barrier(0);
      }
  }
}

__device__ __forceinline__ void p3c_item(const Params& p, char* smem, int l, int item) {
  const int mt = item & 63, nt = item >> 6;
  const int m0 = mt * 128, n0 = nt * 128;
  const int tid = ltid(), lane = tid & 63, wave = tid >> 6, wm = wave >> 1, wn = wave & 1;
  AArgs a{};
  a.A16 = WS_merged; a.lda = 1024;
  f16v acc[2][2];
  gemm_mainloop<0>(smem, a, WS_Wt + WT_LAYER * l + WT_O, 1024, 1024, m0, n0, acc);
  const int ci = cond_of_row(m0);
  const float* g1 = WS_mod + (l * 5 + ci) * 6144 + 2048;
  float* st1 = WS_stats + (size_t)(l * 2 + 0) * TALL * 2;
  const float* st2p = WS_stats + (size_t)(0 * 2 + 1) * TALL * 2;
  const int c0 = EPI_COL(0), c1 = EPI_COL(1);
  const float g1a = g1[c0], g1b = g1[c1];
  float lga = 1.f, lgb = 1.f, lba = 0.f, lbb = 0.f;
  if (l == 1) { lga = p.ln2_g[c0]; lgb = p.ln2_g[c1]; lba = p.ln2_b[c0]; lbb = p.ln2_b[c1]; }
#pragma unroll
  for (int mi = 0; mi < 2; ++mi)
#pragma unroll
    for (int reg = 0; reg < 16; ++reg) {
      const int row = EPI_ROW(mi, reg);
      float xa, xb;
      if (l == 0) {
        const float* xr = row < TCTX ? p.x_prompt + (size_t)row * 1024 : p.x_sample + (size_t)(row - TCTX) * 1024;
        xa = xr[c0]; xb = xr[c1];
      } else {
        const float s = st2p[row * 2], q = st2p[row * 2 + 1];
        const float mu = s * (1.f / 1024.f);
        const float rstd = rsqrtf(fmaxf(q * (1.f / 1024.f) - mu * mu, 0.f) + LNEPS);
        xa = (p.out[(size_t)row * 1024 + c0] - mu) * rstd * lga + lba;
        xb = (p.out[(size_t)row * 1024 + c1] - mu) * rstd * lgb + lbb;
      }
      const float va = ALPHA * xa + g1a * acc[mi][0][reg];
      const float vb = ALPHA * xb + g1b * acc[mi][1][reg];
      WS_pre1[(size_t)row * 1024 + c0] = va;
      WS_pre1[(size_t)row * 1024 + c1] = vb;
      stats_accum(st1, row, va, vb, lane);
    }
}

__device__ __forceinline__ void p4_item(const Params& p, char* smem, int l, int item) {
  const int mt = item & 63, nt = item >> 6;
  const int m0 = mt * 128, n0 = nt * 128;
  const int tid = ltid(), lane = tid & 63, wave = tid >> 6, wm = wave >> 1, wn = wave & 1;
  AArgs a{};
  const float* mod = WS_mod + l * 5 * 6144;
  a.A32lo = WS_pre1; a.A32hi = WS_pre1 + (size_t)TCTX * 1024; a.stats = WS_stats + (size_t)(l * 2 + 0) * TALL * 2;
  a.lng = p.ln1_g + l * 1024; a.lnb = p.ln1_b + l * 1024;
  a.sc = mod + 4 * 1024; a.sh = mod + 3 * 1024;
  f16v acc[2][2];
  gemm_mainloop<1>(smem, a, WS_Wt + WT_LAYER * l + WT_UP, 1024, 1024, m0, n0, acc);
#pragma unroll
  for (int mi = 0; mi < 2; ++mi)
#pragma unroll
    for (int reg = 0; reg < 16; ++reg) {
      const int row = EPI_ROW(mi, reg);
#pragma unroll
      for (int ni = 0; ni < 2; ++ni) WS_z2[(size_t)row * 5632 + EPI_COL(ni)] = f2bf(acc[mi][ni][reg]);
    }
}

__device__ __forceinline__ void p4b_item(const Params& p, int l, int item) {
  const float* cw = p.conv_w + (size_t)l * 3 * 5632;
  const float* cb = p.conv_b + (size_t)l * 5632;
  for (int i = ltid(); i < 16 * 352; i += 256) {
    const int row = item * 16 + i / 352, v = i % 352;
    const int j0 = v * 8;
    int pos, L;
    if (row < TCTX) { pos = row & 255; L = 256; } else { pos = (row - TCTX) & 1023; L = 1024; }
    const bool hp = pos > 0, hn = pos < L - 1;
    const u16* zr = WS_z2 + (size_t)row * 5632;
    uint4 zero = make_uint4(0, 0, 0, 0);
    uint4 a0 = hp ? *(const uint4*)(zr - 5632 + j0) : zero;
    uint4 a1 = *(const uint4*)(zr + j0);
    uint4 a2 = hn ? *(const uint4*)(zr + 5632 + j0) : zero;
    uint4 b0 = hp ? *(const uint4*)(zr - 5632 + 2816 + j0) : zero;
    uint4 b1 = *(const uint4*)(zr + 2816 + j0);
    uint4 b2 = hn ? *(const uint4*)(zr + 5632 + 2816 + j0) : zero;
    unsigned aw0[4] = {a0.x, a0.y, a0.z, a0.w}, aw1[4] = {a1.x, a1.y, a1.z, a1.w}, aw2[4] = {a2.x, a2.y, a2.z, a2.w};
    unsigned bw0[4] = {b0.x, b0.y, b0.z, b0.w}, bw1[4] = {b1.x, b1.y, b1.z, b1.w}, bw2[4] = {b2.x, b2.y, b2.z, b2.w};
    unsigned ow[4];
#pragma unroll
    for (int w = 0; w < 4; ++w) {
      const int j = j0 + 2 * w;
      float av0 = cw[j] * bflo(aw0[w]) + cw[5632 + j] * bflo(aw1[w]) + cw[2 * 5632 + j] * bflo(aw2[w]) + cb[j];
      float av1 = cw[j + 1] * bfhi(aw0[w]) + cw[5632 + j + 1] * bfhi(aw1[w]) + cw[2 * 5632 + j + 1] * bfhi(aw2[w]) + cb[j + 1];
      const int jb = j + 2816;
      float bv0 = cw[jb] * bflo(bw0[w]) + cw[5632 + jb] * bflo(bw1[w]) + cw[2 * 5632 + jb] * bflo(bw2[w]) + cb[jb];
      float bv1 = cw[jb + 1] * bfhi(bw0[w]) + cw[5632 + jb + 1] * bfhi(bw1[w]) + cw[2 * 5632 + jb + 1] * bfhi(bw2[w]) + cb[jb + 1];
      ow[w] = pack2(geluf_(av0) * bv0, geluf_(av1) * bv1);
    }
    *(uint4*)(WS_act + (size_t)row * 2816 + j0) = make_uint4(ow[0], ow[1], ow[2], ow[3]);
  }
}

__device__ __forceinline__ void p5_item(const Params& p, char* smem, int l, int item) {
  const int mt = item & 63, nt = item >> 6;
  const int m0 = mt * 128, n0 = nt * 128;
  const int tid = ltid(), lane = tid & 63, wave = tid >> 6, wm = wave >> 1, wn = wave & 1;
  AArgs a{};
  a.A16 = WS_act; a.lda = 2816;
  f16v acc[2][2];
  gemm_mainloop<0>(smem, a, WS_Wt + WT_LAYER * l + WT_DOWN, 2816, 2816, m0, n0, acc);
  const int ci = cond_of_row(m0);
  const float* g2 = WS_mod + (l * 5 + ci) * 6144 + 5 * 1024;
  const float* st1 = WS_stats + (size_t)(l * 2 + 0) * TALL * 2;
  float* st2 = WS_stats + (size_t)(l * 2 + 1) * TALL * 2;
  const int c0 = EPI_COL(0), c1 = EPI_COL(1);
  const float g2a = g2[c0], g2b = g2[c1];
  const float lga = p.ln1_g[l * 1024 + c0], lgb = p.ln1_g[l * 1024 + c1];
  const float lba = p.ln1_b[l * 1024 + c0], lbb = p.ln1_b[l * 1024 + c1];
#pragma unroll
  for (int mi = 0; mi < 2; ++mi)
#pragma unroll
    for (int reg = 0; reg < 16; ++reg) {
      const int row = EPI_ROW(mi, reg);
      const float s = st1[row * 2], q = st1[row * 2 + 1];
      const float mu = s * (1.f / 1024.f);
      const float rstd = rsqrtf(fmaxf(q * (1.f / 1024.f) - mu * mu, 0.f) + LNEPS);
      const float xa = (WS_pre1[(size_t)row * 1024 + c0] - mu) * rstd * lga + lba;
      const float xb = (WS_pre1[(size_t)row * 1024 + c1] - mu) * rstd * lgb + lbb;
      const float va = ALPHA * xa + g2a * acc[mi][0][reg];
      const float vb = ALPHA * xb + g2b * acc[mi][1][reg];
      p.out[(size_t)row * 1024 + c0] = va;
      p.out[(size_t)row * 1024 + c1] = vb;
      stats_accum(st2, row, va, vb, lane);
    }
}

__device__ __forceinline__ void final_item(const Params& p, int item) {
  const float* st = WS_stats + (size_t)(1 * 2 + 1) * TALL * 2;
  const int c = ltid() * 4;
  const float4 g = *(const float4*)(p.ln2_g + 1024 + c);
  const float4 b = *(const float4*)(p.ln2_b + 1024 + c);
  for (int r = 0; r < 8; ++r) {
    const int row = item * 8 + r;
    const float s = st[row * 2], q = st[row * 2 + 1];
    const float mu = s * (1.f / 1024.f);
    const float rstd = rsqrtf(fmaxf(q * (1.f / 1024.f) - mu * mu, 0.f) + LNEPS);
    float4 v = *(float4*)(p.out + (size_t)row * 1024 + c);
    v.x = (v.x - mu) * rstd * g.x + b.x;
    v.y = (v.y - mu) * rstd * g.y + b.y;
    v.z = (v.z - mu) * rstd * g.z + b.z;
    v.w = (v.w - mu) * rstd * g.w + b.w;
    *(float4*)(p.out + (size_t)row * 1024 + c) = v;
  }
}

#define XB_TMO      128
#define XB_XCNT(j)  (256  + 64 * (j))
#define XB_XSUB(j)  (1280 + 64 * (j))
#define XB_XGEN(j)  (2304 + 64 * (j))
#define XB_TOP      3328
#define XB_TOPGEN   3392
#define XCD_BAR_WORDS 3456
#define XB_SPIN_CAP (1u << 18)
#define LAS __attribute__((address_space(3)))

__device__ __forceinline__ unsigned xb_ld(unsigned* p)              { return __hip_atomic_load(p, __ATOMIC_RELAXED, __HIP_MEMORY_SCOPE_AGENT); }
__device__ __forceinline__ unsigned xb_add(unsigned* p, unsigned v) { return __hip_atomic_fetch_add(p, v, __ATOMIC_RELAXED, __HIP_MEMORY_SCOPE_AGENT); }
__device__ __forceinline__ unsigned xb_xcc_id() { return (unsigned)__builtin_amdgcn_s_getreg((3 << 11) | 20) & 0xFu; }
#define XB_SPIN(cond, bar) do { unsigned _sp = 0; while (cond) { __builtin_amdgcn_s_sleep(1); \
    if ((++_sp & 255u) == 0u) { if (xb_ld(&(bar)[XB_TMO])) break; if (_sp > XB_SPIN_CAP) { atomicAdd(&(bar)[XB_TMO], 1u); break; } } } } while (0)

struct XcdBarrier {
    unsigned* bar; unsigned x;
    volatile LAS unsigned* st;
};

__device__ __forceinline__ XcdBarrier xcd_barrier_post(unsigned* bar, volatile LAS unsigned* st) {
    XcdBarrier b; b.bar = bar; b.x = xb_xcc_id(); b.st = st;
    if (threadIdx.x == 0) (void)xb_add(&bar[XB_XCNT(b.x)], 1u);
    return b;
}
__device__ __forceinline__ void xcd_barrier_complete(unsigned* bar, unsigned x, unsigned& nloc, unsigned& nx) {
    const unsigned G = gridDim.x * gridDim.y * gridDim.z;
    unsigned sum, cnt, mine, sp = 0u;
    for (;;) {
        sum = 0u; cnt = 0u; mine = 0u;
#pragma unroll
        for (unsigned j = 0; j < 16; ++j) { const unsigned c = xb_ld(&bar[XB_XCNT(j)]); sum += c; cnt += (c > 0u) ? 1u : 0u; mine = (j == x) ? c : mine; }
        if (sum == G) break;
        __builtin_amdgcn_s_sleep(1);
        if ((++sp & 255u) == 0u) { if (xb_ld(&bar[XB_TMO])) break; if (sp > XB_SPIN_CAP) { atomicAdd(&bar[XB_TMO], 1u); break; } }
    }
    nloc = mine > 0u ? mine : 1u; nx = cnt > 0u ? cnt : 1u;
}

__device__ __forceinline__ void xcd_barrier(const XcdBarrier& b) {
    asm volatile("s_waitcnt vmcnt(0)" ::: "memory");
    __syncthreads();
    if (threadIdx.x == 0) {
        unsigned* bar = b.bar;
        __builtin_amdgcn_s_waitcnt(0);
        unsigned nloc = b.st[0], nx = b.st[1];
        if (nloc == 0u) { xcd_barrier_complete(bar, b.x, nloc, nx); b.st[0] = nloc; b.st[1] = nx; }
        const unsigned old = xb_add(&bar[XB_XSUB(b.x)], 1u);
        const unsigned gen = old / nloc;
        if (old + 1u == (gen + 1u) * nloc) {
            __builtin_amdgcn_fence(__ATOMIC_RELEASE, "agent");
            asm volatile("s_waitcnt vmcnt(0)" ::: "memory");
            const unsigned og = xb_add(&bar[XB_TOP], 1u);
            const unsigned tg = og / nx;
            if (og + 1u == (tg + 1u) * nx) xb_add(&bar[XB_TOPGEN], 1u);
            else XB_SPIN(xb_ld(&bar[XB_TOPGEN]) == tg, bar);
            __builtin_amdgcn_fence(__ATOMIC_ACQUIRE, "agent");
            xb_add(&bar[XB_XGEN(b.x)], 1u);
            asm volatile("s_waitcnt vmcnt(0)" ::: "memory");
        } else {
            XB_SPIN(xb_ld(&bar[XB_XGEN(b.x)]) == gen, bar);
            __builtin_amdgcn_fence(__ATOMIC_ACQUIRE, "agent");
            asm volatile("s_waitcnt vmcnt(0)" ::: "memory");
        }
    }
    __syncthreads();
}


#define NPHASES 18
#ifndef REPMASK
#define REPMASK 0
#endif
#define REPS(PH) (((PH) == 0 ? (REPMASK >> 8) : (PH) == 17 ? (REPMASK >> 9) : (REPMASK >> (((PH) - 1) & 7))) & 1)
#define RUN_PHASE(PH, N, CALL)                                              \
  if (ph_lo <= (PH) && (PH) < ph_hi) {                                      \
    for (int rep_ = 0; rep_ <= REPS(PH); ++rep_)                            \
    for (int it = blockIdx.x; it < (N); it += nb) { CALL; }                 \
    if ((PH) + 1 < ph_hi) xcd_barrier(xb);                                  \
  }
#define RUN_GEMM_PHASE(PH, NT, CALL)                                                          \
  if (ph_lo <= (PH) && (PH) < ph_hi) {                                                        \
    const int xcd_ = blockIdx.x & 7, slot_ = blockIdx.x >> 3, spx_ = (int)gridDim.x >> 3;      \
    const int nsuper_ = 8 * (((NT) + 7) >> 3);                                                \
    for (int rep_ = 0; rep_ <= REPS(PH); ++rep_)                                              \
    for (int s_ = xcd_; s_ < nsuper_; s_ += 8)                                                \
      for (int j_ = slot_; j_ < 64; j_ += spx_) {                                             \
        const int mt_ = (s_ & 7) * 8 + (j_ & 7), nt_ = (s_ >> 3) * 8 + (j_ >> 3);             \
        if (nt_ < (NT)) { const int it = nt_ * 64 + mt_; CALL; }                              \
      }                                                                                       \
    if ((PH) + 1 < ph_hi) xcd_barrier(xb);                                                    \
  }
#define RUN_LAYER(L)                                                        \
  RUN_GEMM_PHASE(1 + 8 * (L) + 0, 56, p1_item(p, smem, (L), it))            \
  RUN_PHASE(1 + 8 * (L) + 1, MX_ITEMS, mixer_item(p, smem, (L), it))        \
  RUN_GEMM_PHASE(1 + 8 * (L) + 2, 4, p3a_item(p, smem, (L), it))            \
  RUN_GEMM_PHASE(1 + 8 * (L) + 3, 8, p3b_item(p, smem, (L), it))            \
  RUN_GEMM_PHASE(1 + 8 * (L) + 4, 8, p3c_item(p, smem, (L), it))            \
  RUN_GEMM_PHASE(1 + 8 * (L) + 5, 44, p4_item(p, smem, (L), it))            \
  RUN_PHASE(1 + 8 * (L) + 6, 512, p4b_item(p, (L), it))                     \
  RUN_GEMM_PHASE(1 + 8 * (L) + 7, 8, p5_item(p, smem, (L), it))

__global__ void __launch_bounds__(256, 2) mega(Params p, int ph_lo, int ph_hi) {
  __shared__ __attribute__((aligned(16))) char smem[49152];
  __shared__ uint4 xb_words;
  const int nb = gridDim.x;
  if (threadIdx.x == 0) xb_words = make_uint4(0u, 0u, 0u, 0u);
  __syncthreads();
  XcdBarrier xb;
  xb.bar = (unsigned*)(p.ws + OFF_bar); xb.x = 0; xb.st = (volatile LAS unsigned*)&xb_words;
  if (ph_hi - ph_lo > 1) xb = xcd_barrier_post((unsigned*)(p.ws + OFF_bar), (volatile LAS unsigned*)&xb_words);
  if (ph_hi > 1000) cg::this_grid().sync();
  RUN_PHASE(0, P0_ITEMS, phase0_item(p, smem, it))
  RUN_LAYER(0)
  RUN_LAYER(1)
  RUN_PHASE(17, 1024, final_item(p, it))
}

extern "C" void kernel_launch(void* const* d_in, const int* in_sizes, int n_in, void* d_out, int out_size, void* d_ws,
                              size_t ws_size, hipStream_t stream) {
  Params p{};
  const float** ins = (const float**)&p;
  for (int i = 0; i < 32; ++i) ins[i] = (const float*)d_in[i];
  p.out = (float*)d_out;
  char* ws = (char*)d_ws;
  p.ws = ws;
  if (WS_TOTAL > ws_size) {
    fprintf(stderr, "kernel_launch: workspace too small (%zu needed, %zu given)\n", (size_t)WS_TOTAL, ws_size);
    return;
  }
  (void)hipMemsetAsync(ws, 0, ZERO_BYTES, stream);
#if SINGLE_LAUNCH
  static int grid_blocks = 0;
  if (!grid_blocks) {
    int dev = 0, cus = 0, per_cu = 0;
    hipGetDevice(&dev);
    hipDeviceGetAttribute(&cus, hipDeviceAttributeMultiprocessorCount, dev);
    hipOccupancyMaxActiveBlocksPerMultiprocessor(&per_cu, mega, 256, 0);
    if (per_cu > 2) per_cu = 2;
    if (per_cu < 1) per_cu = 1;
    grid_blocks = cus * per_cu;
  }
  int lo = 0, hi = NPHASES;
  void* args[] = {&p, &lo, &hi};
  hipError_t e = hipLaunchCooperativeKernel((void*)mega, dim3(grid_blocks), dim3(256), args, 0, stream);
  if (e != hipSuccess) fprintf(stderr, "cooperative launch failed: %s (grid %d)\n", hipGetErrorString(e), grid_blocks);
#else
  for (int ph = 0; ph < NPHASES; ++ph) {
    hipLaunchKernelGGL(mega, dim3(512), dim3(256), 0, stream, p, ph, ph + 1);
  }
#endif
}
```

```cpp
#include <hip/hip_runtime.h>
#include <hip/hip_cooperative_groups.h>
#include <cstdio>
namespace cg = cooperative_groups;

#ifndef SINGLE_LAUNCH
#define SINGLE_LAUNCH 1
#endif

typedef __attribute__((ext_vector_type(8))) short s8v;
typedef __attribute__((ext_vector_type(4))) float f4v;
typedef __attribute__((ext_vector_type(16))) float f16v;
typedef unsigned short u16;
typedef __attribute__((ext_vector_type(4))) unsigned u4v;
__device__ __forceinline__ s8v bc8(u4v x) { return __builtin_bit_cast(s8v, x); }


#define TALL 8192
#define TCTX 4096
#define ALPHA 1.41421356237309515f
#define LNEPS 1e-5f
#define VTR_LAT 2097152
#define NVT_LAT 2097152
#define OUT_SRET 8388608
#define OUT_SSSM 12582912
#define OUT_CK 12845056
#define OUT_CV 17039360
#define WT_IN 0
#define WT_GLU (WT_IN + 7168 * 1024)
#define WT_BR (WT_GLU + 512 * 512)
#define WT_O (WT_BR + 3 * 1024 * 512)
#define WT_UP (WT_O + 1024 * 1024)
#define WT_DOWN (WT_UP + 5632 * 1024)
#define WT_LAYER ((size_t)(WT_DOWN + 1024 * 2816))

struct Params {
  const float *x_prompt, *x_sample, *state_ret, *state_ssm, *cache_k, *cache_v, *c, *c_ctx;
  const float *w_ada, *b_ada, *w_in, *ret_decay, *a_re, *a_im, *log_dt, *b_re, *b_im, *c_re, *c_im;
  const float *ssm_d, *w_glu, *rpb, *w_branch, *w_o, *ln1_g, *ln1_b, *w_up, *conv_w, *conv_b, *w_down, *ln2_g, *ln2_b;
  float* out;
  char* ws;
};

typedef __bf16 bf2v __attribute__((ext_vector_type(2)));
typedef float fl2v __attribute__((ext_vector_type(2)));
__device__ __forceinline__ unsigned pack2(float a, float b) {
  fl2v f = {a, b};
  bf2v h = __builtin_convertvector(f, bf2v);
  return __builtin_bit_cast(unsigned, h);
}
__device__ __forceinline__ u16 f2bf(float f) { return (u16)(pack2(f, 0.f) & 0xffffu); }

constexpr size_t al256(size_t x) { return (x + 255) & ~(size_t)255; }
constexpr size_t EB = (size_t)TALL * 512 * 2;
constexpr size_t OFF_mod = 0;
constexpr size_t OFF_stats = OFF_mod + al256(2 * 5 * 6144 * 4);
constexpr size_t OFF_bar = OFF_stats + al256(2 * 2 * TALL * 2 * 4);
constexpr size_t ZERO_BYTES = OFF_bar + al256(3456 * 4);
constexpr size_t OFF_ropetab = ZERO_BYTES;
constexpr size_t OFF_abar = OFF_ropetab + al256(64 * 32 * 2 * 4);
constexpr size_t OFF_bbarT = OFF_abar + al256(2 * 2 * 32 * 64 * 2 * 4);
constexpr size_t OFF_cmT = OFF_bbarT + al256(2 * 2 * 32 * 128 * 16 * 2);
constexpr size_t OFF_CK = OFF_cmT + al256(2 * 2 * 32 * 16 * 128 * 2);
constexpr size_t OFF_CVt = OFF_CK + al256((size_t)2 * 4 * 512 * 512 * 2);
constexpr size_t OFF_S0t = OFF_CVt + al256((size_t)2 * 4 * 512 * 512 * 2);
constexpr size_t OFF_Wt = OFF_S0t + al256((size_t)2 * 4 * 2 * 4 * 128 * 128 * 2);
constexpr size_t OFF_REGION = OFF_Wt + al256(2 * WT_LAYER * 2);
constexpr size_t OFF_z2 = OFF_REGION;
constexpr size_t OFF_act = OFF_z2 + (size_t)TALL * 5632 * 2;
constexpr size_t OFF_pre1 = OFF_act + (size_t)TALL * 2816 * 2;
constexpr size_t WS_TOTAL = OFF_pre1 + (size_t)TALL * 1024 * 4;
constexpr size_t OFF_K = OFF_pre1;
constexpr size_t OFF_VtR = OFF_K + EB;
constexpr size_t OFF_NQ = OFF_VtR + EB;
constexpr size_t OFF_NK = OFF_NQ + EB;
constexpr size_t OFF_GT = OFF_REGION;
constexpr size_t OFF_rout = OFF_GT + (size_t)TALL * 3072 * 2;
constexpr size_t OFF_nout = OFF_rout + EB;
constexpr size_t OFF_YD = OFF_nout + EB;
constexpr size_t OFF_merged = OFF_YD;
constexpr size_t OFF_Q = OFF_YD + 2 * EB;
constexpr size_t OFF_sout = OFF_Q;
constexpr size_t OFF_KtR = OFF_Q + EB;
constexpr size_t OFF_G = OFF_KtR + EB / 2;
constexpr size_t OFF_SU = OFF_G + EB;
constexpr size_t OFF_NVt = OFF_SU + EB;
constexpr size_t OFF_h1 = OFF_NVt + EB;
constexpr size_t OFF_h2 = OFF_act;
static_assert(OFF_h1 + 2 * EB <= OFF_pre1, "mixer buffers overflow the z2+act area");
#define WS_h1 ((u16*)(p.ws + OFF_h1))
#define WS_h2 ((u16*)(p.ws + OFF_h2))
#define WS_mod ((float*)(p.ws + OFF_mod))
#define WS_stats ((float*)(p.ws + OFF_stats))
#define WS_ropetab ((float*)(p.ws + OFF_ropetab))
#define WS_abar ((float*)(p.ws + OFF_abar))
#define WS_pre1 ((float*)(p.ws + OFF_pre1))
#define WS_bbarT ((u16*)(p.ws + OFF_bbarT))
#define WS_cmT ((u16*)(p.ws + OFF_cmT))
#define WS_CK ((u16*)(p.ws + OFF_CK))
#define WS_CVt ((u16*)(p.ws + OFF_CVt))
#define WS_S0t ((u16*)(p.ws + OFF_S0t))
#define WS_Wt ((u16*)(p.ws + OFF_Wt))
#define WS_Q ((u16*)(p.ws + OFF_Q))
#define WS_K ((u16*)(p.ws + OFF_K))
#define WS_VtR ((u16*)(p.ws + OFF_VtR))
#define WS_KtR ((u16*)(p.ws + OFF_KtR))
#define WS_G ((u16*)(p.ws + OFF_G))
#define WS_SU ((u16*)(p.ws + OFF_SU))
#define WS_NQ ((u16*)(p.ws + OFF_NQ))
#define WS_NK ((u16*)(p.ws + OFF_NK))
#define WS_NVt ((u16*)(p.ws + OFF_NVt))
#define WS_GT ((u16*)(p.ws + OFF_GT))
#define WS_rout ((u16*)(p.ws + OFF_rout))
#define WS_sout ((u16*)(p.ws + OFF_sout))
#define WS_nout ((u16*)(p.ws + OFF_nout))
#define WS_YD ((u16*)(p.ws + OFF_YD))
#define WS_merged ((u16*)(p.ws + OFF_merged))
#define WS_z2 ((u16*)(p.ws + OFF_z2))
#define WS_act ((u16*)(p.ws + OFF_act))

__device__ __forceinline__ float bf2f(unsigned h) { return __uint_as_float((h & 0xffffu) << 16); }
__device__ __forceinline__ float bflo(unsigned w) { return __uint_as_float(w << 16); }
__device__ __forceinline__ float bfhi(unsigned w) { return __uint_as_float(w & 0xffff0000u); }
__device__ __forceinline__ float sigmoidf_(float x) { return 1.f / (1.f + __expf(-x)); }
__device__ __forceinline__ float siluf_(float x) { return x / (1.f + __expf(-x)); }
__device__ __forceinline__ float geluf_(float x) {
  float u = 0.7978845608028654f * (x + 0.044715f * x * x * x);
  float e = __expf(2.f * u);
  float t = 1.f - 2.f / (e + 1.f);
  return 0.5f * x * (1.f + t);
}
__device__ __forceinline__ f16v zero16() {
  return (f16v){0.f, 0.f, 0.f, 0.f, 0.f, 0.f, 0.f, 0.f, 0.f, 0.f, 0.f, 0.f, 0.f, 0.f, 0.f, 0.f};
}
__device__ __forceinline__ int ltid() { int t = threadIdx.x; asm volatile("" : "+v"(t)); return t; }
__device__ __forceinline__ int cond_of_row(int row) { return row < TCTX ? 0 : 1 + ((row - TCTX) >> 10); }

struct AArgs {
  const u16* A16; int lda;
  const float* A32lo; const float* A32hi;
  const float* stats;
  const float* lng; const float* lnb;
  const float* sc; const float* sh;
  const u16* SU; const u16* YD0; const u16* YD1; const float* dsk;
};

#define GST 72
#define LDS_GEMM (2 * 2 * 128 * GST * 2)
#define LDS_BYTES LDS_GEMM

template <int AMODE>
__device__ __forceinline__ void gemm_mainloop(char* smem, const AArgs& a, const u16* __restrict__ Bt, int ldb, int K,
                                              int m0, int n0, f16v (&acc)[2][2]) {
  u16* As = (u16*)smem;
  u16* Bs = As + 2 * 128 * GST;
  const int tid = ltid(), lane = tid & 63, wave = tid >> 6;
  const int wm = wave >> 1, wn = wave & 1;
  const int crow = tid >> 3, cch = tid & 7;
  const int frow = tid >> 4, fch = tid & 15;
  float rs[8], nm[8];
  const float* srow0 = nullptr;
  const float *gsc = nullptr, *gsh = nullptr;
  __syncthreads();
  if constexpr (AMODE == 1) {
    const int ci = cond_of_row(m0);
    gsc = a.sc + ci * 6144; gsh = a.sh + ci * 6144;
#pragma unroll
    for (int i = 0; i < 8; ++i) {
      rs[i] = 1.f; nm[i] = 0.f;
      if (a.stats) {
        const int row = m0 + frow + 16 * i;
        const float s = a.stats[row * 2], q = a.stats[row * 2 + 1];
        const float mu = s * (1.f / 1024.f);
        const float var = q * (1.f / 1024.f) - mu * mu;
        rs[i] = rsqrtf(fmaxf(var, 0.f) + LNEPS);
        nm[i] = -mu * rs[i];
      }
    }
    const int row0 = m0 + frow;
    srow0 = (row0 < TCTX ? a.A32lo + (size_t)row0 * 1024 : a.A32hi + (size_t)(row0 - TCTX) * 1024) + fch * 4;
  }
  acc[0][0] = zero16(); acc[0][1] = zero16(); acc[1][0] = zero16(); acc[1][1] = zero16();

  u4v ra[12], rb[4];
  float4 q0, q1, q2, q3;
  q0 = q1 = q3 = make_float4(0.f, 0.f, 0.f, 0.f); q2 = make_float4(1.f, 1.f, 1.f, 1.f);
  const u16* brow = Bt + (size_t)(n0 + crow) * ldb + cch * 8;
  auto issue = [&](int kt) {
    if constexpr (AMODE == 1) {
      const int k = kt * 64 + fch * 4;
      q0 = *(const float4*)(gsc + k); q1 = *(const float4*)(gsh + k);
      if (a.lng) { q2 = *(const float4*)(a.lng + k); q3 = *(const float4*)(a.lnb + k); }
    } else if constexpr (AMODE == 2) {
      const int k0 = kt * 64 + cch * 8;
      q0 = *(const float4*)(a.dsk + k0); q1 = *(const float4*)(a.dsk + k0 + 4);
    }
    if constexpr (AMODE == 0) {
      const u16* ap = a.A16 + (size_t)(m0 + crow) * a.lda + kt * 64 + cch * 8;
#pragma unroll
      for (int i = 0; i < 4; ++i) ra[i] = *(const u4v*)(ap + (size_t)(32 * i) * a.lda);
    } else if constexpr (AMODE == 1) {
#pragma unroll
      for (int i = 0; i < 8; ++i) ra[i] = *(const u4v*)(srow0 + (size_t)(16 * i) * 1024 + kt * 64);
    } else {
      const size_t o = (size_t)(m0 + crow) * 512 + kt * 64 + cch * 8;
#pragma unroll
      for (int i = 0; i < 4; ++i) {
        ra[i] = *(const u4v*)(a.SU + o + (size_t)(32 * i) * 512);
        ra[4 + i] = *(const u4v*)(a.YD0 + o + (size_t)(32 * i) * 512);
        ra[8 + i] = *(const u4v*)(a.YD1 + o + (size_t)(32 * i) * 512);
      }
    }
#pragma unroll
    for (int i = 0; i < 4; ++i) rb[i] = *(const u4v*)(brow + (size_t)(32 * i) * ldb + kt * 64);
  };
  auto stage = [&](int buf, int kt) {
    u16* Ad = As + buf * (128 * GST);
    if constexpr (AMODE == 0) {
#pragma unroll
      for (int i = 0; i < 4; ++i) *(u4v*)(Ad + (crow + 32 * i) * GST + cch * 8) = ra[i];
    } else if constexpr (AMODE == 1) {
      const float4 sc = q0, sh = q1, g = q2, b = q3;
      const float G0 = g.x * (1.f + sc.x), G1 = g.y * (1.f + sc.y), G2 = g.z * (1.f + sc.z), G3 = g.w * (1.f + sc.w);
      const float B0 = fmaf(b.x, 1.f + sc.x, sh.x), B1 = fmaf(b.y, 1.f + sc.y, sh.y), B2 = fmaf(b.z, 1.f + sc.z, sh.z), B3 = fmaf(b.w, 1.f + sc.w, sh.w);
#pragma unroll
      for (int i = 0; i < 8; ++i) {
        const float h0 = fmaf(fmaf(__uint_as_float(ra[i][0]), rs[i], nm[i]), G0, B0);
        const float h1 = fmaf(fmaf(__uint_as_float(ra[i][1]), rs[i], nm[i]), G1, B1);
        const float h2 = fmaf(fmaf(__uint_as_float(ra[i][2]), rs[i], nm[i]), G2, B2);
        const float h3 = fmaf(fmaf(__uint_as_float(ra[i][3]), rs[i], nm[i]), G3, B3);
        *(uint2*)(Ad + (frow + 16 * i) * GST + fch * 4) = make_uint2(pack2(h0, h1), pack2(h2, h3));
      }
    } else {
      const float4 da = q0, db = q1;
      const float dd[8] = {da.x, da.y, da.z, da.w, db.x, db.y, db.z, db.w};
#pragma unroll
      for (int i = 0; i < 4; ++i) {
        u4v o;
#pragma unroll
        for (int j = 0; j < 4; ++j) {
          const float v0 = geluf_(dd[2 * j] * bflo(ra[i][j]) + bflo(ra[4 + i][j]) + bflo(ra[8 + i][j]));
          const float v1 = geluf_(dd[2 * j + 1] * bfhi(ra[i][j]) + bfhi(ra[4 + i][j]) + bfhi(ra[8 + i][j]));
          o[j] = pack2(v0, v1);
        }
        *(u4v*)(Ad + (crow + 32 * i) * GST + cch * 8) = o;
      }
    }
    u16* Bd = Bs + buf * (128 * GST);
#pragma unroll
    for (int i = 0; i < 4; ++i) *(u4v*)(Bd + (crow + 32 * i) * GST + cch * 8) = rb[i];
  };
  auto compute = [&](int buf) {
    const u16* Ab = As + buf * (128 * GST) + (wm * 64 + (lane & 31)) * GST + (lane >> 5) * 8;
    const u16* Bb = Bs + buf * (128 * GST) + (wn * 64 + (lane & 31)) * GST + (lane >> 5) * 8;
#pragma unroll
    for (int ks = 0; ks < 4; ++ks) {
      s8v af0 = *(const s8v*)(Ab + ks * 16);
      s8v af1 = *(const s8v*)(Ab + 32 * GST + ks * 16);
      s8v bf0 = *(const s8v*)(Bb + ks * 16);
      s8v bf1 = *(const s8v*)(Bb + 32 * GST + ks * 16);
      acc[0][0] = __builtin_amdgcn_mfma_f32_32x32x16_bf16(af0, bf0, acc[0][0], 0, 0, 0);
      acc[0][1] = __builtin_amdgcn_mfma_f32_32x32x16_bf16(af0, bf1, acc[0][1], 0, 0, 0);
      acc[1][0] = __builtin_amdgcn_mfma_f32_32x32x16_bf16(af1, bf0, acc[1][0], 0, 0, 0);
      acc[1][1] = __builtin_amdgcn_mfma_f32_32x32x16_bf16(af1, bf1, acc[1][1], 0, 0, 0);
    }
  };

  const int nk = K >> 6;
  issue(0);
  stage(0, 0);
  __syncthreads();
#pragma unroll 1
  for (int kt = 0; kt < nk; ++kt) {
    const int buf = kt & 1;
    if (kt + 1 < nk) issue(kt + 1);
    compute(buf);
    if (kt + 1 < nk) stage(buf ^ 1, kt + 1);
    __syncthreads();
  }
}

__device__ __forceinline__ void gemm_mainloop0(char* smem, const u16* __restrict__ A, int lda, const u16* __restrict__ Bt, int ldb,
                                               int K, int m0, int n0, f16v (&acc)[2][2]) {
  u16* As = (u16*)smem;
  u16* Bs = As + 2 * 128 * GST;
  const int tid = ltid(), lane = tid & 63, wave = tid >> 6;
  const int wm = wave >> 1, wn = wave & 1;
  const int crow = tid >> 3, cch = tid & 7;
  __syncthreads();
  acc[0][0] = zero16(); acc[0][1] = zero16(); acc[1][0] = zero16(); acc[1][1] = zero16();
  const u16* arow = A + (size_t)(m0 + crow) * lda + cch * 8;
  const u16* brow = Bt + (size_t)(n0 + crow) * ldb + cch * 8;
  const size_t a32 = (size_t)32 * lda, b32 = (size_t)32 * ldb;
  u4v eA0, eA1, eA2, eA3, eB0, eB1, eB2, eB3, oA0, oA1, oA2, oA3, oB0, oB1, oB2, oB3;
#define G0_ISSUE(P, kt)                                                                                   \
  { const u16* ap_ = arow + (kt) * 64; const u16* bp_ = brow + (kt) * 64;                                 \
    P##A0 = *(const u4v*)(ap_); P##A1 = *(const u4v*)(ap_ + a32); P##A2 = *(const u4v*)(ap_ + 2 * a32);   \
    P##A3 = *(const u4v*)(ap_ + 3 * a32);                                                                 \
    P##B0 = *(const u4v*)(bp_); P##B1 = *(const u4v*)(bp_ + b32); P##B2 = *(const u4v*)(bp_ + 2 * b32);   \
    P##B3 = *(const u4v*)(bp_ + 3 * b32); }
#define G0_STAGE(P, buf)                                                                                  \
  { u16* Ad_ = As + (buf) * (128 * GST) + crow * GST + cch * 8; u16* Bd_ = Bs + (buf) * (128 * GST) + crow * GST + cch * 8; \
    *(u4v*)(Ad_) = P##A0; *(u4v*)(Ad_ + 32 * GST) = P##A1; *(u4v*)(Ad_ + 64 * GST) = P##A2; *(u4v*)(Ad_ + 96 * GST) = P##A3; \
    *(u4v*)(Bd_) = P##B0; *(u4v*)(Bd_ + 32 * GST) = P##B1; *(u4v*)(Bd_ + 64 * GST) = P##B2; *(u4v*)(Bd_ + 96 * GST) = P##B3; }
#define G0_COMPUTE(buf)                                                                                   \
  { const u16* Ab = As + (buf) * (128 * GST) + (wm * 64 + (lane & 31)) * GST + (lane >> 5) * 8;           \
    const u16* Bb = Bs + (buf) * (128 * GST) + (wn * 64 + (lane & 31)) * GST + (lane >> 5) * 8;           \
    _Pragma("unroll") for (int ks = 0; ks < 4; ++ks) {                                                    \
      s8v af0 = *(const s8v*)(Ab + ks * 16);                                                              \
      s8v af1 = *(const s8v*)(Ab + 32 * GST + ks * 16);                                                   \
      s8v bf0 = *(const s8v*)(Bb + ks * 16);                                                              \
      s8v bf1 = *(const s8v*)(Bb + 32 * GST + ks * 16);                                                   \
      acc[0][0] = __builtin_amdgcn_mfma_f32_32x32x16_bf16(af0, bf0, acc[0][0], 0, 0, 0);                  \
      acc[0][1] = __builtin_amdgcn_mfma_f32_32x32x16_bf16(af0, bf1, acc[0][1], 0, 0, 0);                  \
      acc[1][0] = __builtin_amdgcn_mfma_f32_32x32x16_bf16(af1, bf0, acc[1][0], 0, 0, 0);                  \
      acc[1][1] = __builtin_amdgcn_mfma_f32_32x32x16_bf16(af1, bf1, acc[1][1], 0, 0, 0);                  \
    } }
  const int nk = K >> 6;
  G0_ISSUE(e, 0)
  G0_ISSUE(o, 1)
  G0_STAGE(e, 0)
  __syncthreads();
  int kt = 0;
#pragma unroll 1
  for (; kt + 3 < nk; kt += 2) {
    G0_ISSUE(e, kt + 2)
    __builtin_amdgcn_sched_barrier(0);
    G0_COMPUTE(0)
    G0_STAGE(o, 1)
    __syncthreads();
    G0_ISSUE(o, kt + 3)
    __builtin_amdgcn_sched_barrier(0);
    G0_COMPUTE(1)
    G0_STAGE(e, 0)
    __syncthreads();
  }
  G0_COMPUTE(0)
  G0_STAGE(o, 1)
  __syncthreads();
  G0_COMPUTE(1)
  __syncthreads();
#undef G0_ISSUE
#undef G0_STAGE
#undef G0_COMPUTE
}

#define EPI_ROW(mi, reg) (m0 + wm * 64 + (mi) * 32 + ((reg) & 3) + 8 * ((reg) >> 2) + 4 * (lane >> 5))
#define EPI_COL(ni) (n0 + wn * 64 + (ni) * 32 + (lane & 31))


#define CST 136
__device__ __forceinline__ void cs_store(const u16* Cs, u16* __restrict__ dst, size_t ld, int tid) {
#pragma unroll
  for (int i = 0; i < 8; ++i) {
    const int c = tid + 256 * i, r = c >> 4, ch = c & 15;
    *(u4v*)(dst + (size_t)r * ld + ch * 8) = *(const u4v*)(Cs + r * CST + ch * 8);
  }
}

__device__ __forceinline__ void stats_accum(float* stats, int row, float v0, float v1, int lane) {
  float s = v0 + v1, q = v0 * v0 + v1 * v1;
#pragma unroll
  for (int o = 1; o < 32; o <<= 1) {
    s += __shfl_xor(s, o);
    q += __shfl_xor(q, o);
  }
  if ((lane & 31) == 0) {
    atomicAdd(stats + row * 2, s);
    atomicAdd(stats + row * 2 + 1, q);
  }
}

#define P0_ADA 768
#define P0_ROPE 1
#define P0_CACHE 64
#define P0_S0 64
#define P0_S5 128
#define P0_WT_PER_LAYER (16 * 112 + 8 * 8 + 3 * 8 * 16 + 16 * 16 + 16 * 88 + 44 * 16)
#define P0_WT (2 * P0_WT_PER_LAYER)
#define P0_ITEMS (P0_ADA + P0_ROPE + P0_CACHE + P0_S0 + P0_S5 + P0_WT)

__device__ __forceinline__ void wt_tile(const float* __restrict__ src, int N, u16* __restrict__ dst, int ldd, int kt, int nt, char* smem) {
  float* tile = (float*)smem;
  const int tid = ltid();
  __syncthreads();
  {
    const int c4 = (tid & 15) * 4, r0 = tid >> 4;
#pragma unroll
    for (int i = 0; i < 4; ++i) {
      const int k = r0 + 16 * i;
      const float4 v = *(const float4*)(src + (size_t)(kt * 64 + k) * N + nt * 64 + c4);
      tile[k * 65 + c4] = v.x; tile[k * 65 + c4 + 1] = v.y; tile[k * 65 + c4 + 2] = v.z; tile[k * 65 + c4 + 3] = v.w;
    }
  }
  __syncthreads();
  {
    const int n = tid >> 2, k0 = (tid & 3) * 16;
#define WTP(j) pack2(tile[(k0 + 2 * (j)) * 65 + n], tile[(k0 + 2 * (j) + 1) * 65 + n])
    u4v* d = (u4v*)(dst + (size_t)(nt * 64 + n) * ldd + kt * 64 + k0);
    d[0] = (u4v){WTP(0), WTP(1), WTP(2), WTP(3)};
    d[1] = (u4v){WTP(4), WTP(5), WTP(6), WTP(7)};
#undef WTP
  }
}
__device__ __forceinline__ void wt_item(const Params& p, char* smem, int item) {
  const int l = item / P0_WT_PER_LAYER;
  int it = item % P0_WT_PER_LAYER;
  u16* base = WS_Wt + WT_LAYER * l;
  if (it < 16 * 112) { wt_tile(p.w_in + (size_t)l * 1024 * 7168, 7168, base + WT_IN, 1024, it / 112, it % 112, smem); return; }
  it -= 16 * 112;
  if (it < 64) { wt_tile(p.w_glu + (size_t)l * 512 * 512, 512, base + WT_GLU, 512, it / 8, it % 8, smem); return; }
  it -= 64;
  if (it < 384) { const int br = it / 128; it %= 128;
    wt_tile(p.w_branch + ((size_t)l * 3 + br) * 512 * 1024, 1024, base + WT_BR + (size_t)br * 512 * 1024, 512, it / 16, it % 16, smem); return; }
  it -= 384;
  if (it < 256) { wt_tile(p.w_o + (size_t)l * 1024 * 1024, 1024, base + WT_O, 1024, it / 16, it % 16, smem); return; }
  it -= 256;
  if (it < 16 * 88) { wt_tile(p.w_up + (size_t)l * 1024 * 5632, 5632, base + WT_UP, 1024, it / 88, it % 88, smem); return; }
  it -= 16 * 88;
  wt_tile(p.w_down + (size_t)l * 2816 * 1024, 1024, base + WT_DOWN, 2816, it / 16, it % 16, smem);
}

__device__ __forceinline__ void phase0_item(const Params& p, char* smem, int item) {
  const int tid = ltid();
  if (item < P0_ADA) {
    const int ks = item & 3, cg = (item >> 2) % 96, l = item / 384;
    float* scs = (float*)smem;
    float* red = scs + 5 * 256;
    __syncthreads();
    for (int i = tid; i < 5 * 256; i += 256) {
      int ci = i >> 8, k = ks * 256 + (i & 255);
      float v = ci == 0 ? p.c_ctx[k] : p.c[(ci - 1) * 1024 + k];
      scs[i] = siluf_(v);
    }
    __syncthreads();
    const int ct = tid & 15, kg = tid >> 4;
    const float* wp = p.w_ada + (size_t)l * 1024 * 6144 + (size_t)(ks * 256 + kg * 16) * 6144 + cg * 64 + ct * 4;
    float acc[5][4];
#pragma unroll
    for (int i = 0; i < 5; ++i)
#pragma unroll
      for (int j = 0; j < 4; ++j) acc[i][j] = 0.f;
#pragma unroll 4
    for (int k = 0; k < 16; ++k) {
      float4 w = *(const float4*)(wp + (size_t)k * 6144);
#pragma unroll
      for (int ci = 0; ci < 5; ++ci) {
        float s = scs[ci * 256 + kg * 16 + k];
        acc[ci][0] += s * w.x; acc[ci][1] += s * w.y; acc[ci][2] += s * w.z; acc[ci][3] += s * w.w;
      }
    }
#pragma unroll
    for (int ci = 0; ci < 5; ++ci)
#pragma unroll
      for (int j = 0; j < 4; ++j) red[(kg * 5 + ci) * 64 + ct * 4 + j] = acc[ci][j];
    __syncthreads();
    for (int i = tid; i < 320; i += 256) {
      int ci = i >> 6, col = i & 63;
      float s = 0.f;
#pragma unroll
      for (int g = 0; g < 16; ++g) s += red[(g * 5 + ci) * 64 + col];
      if (ks == 0) s += p.b_ada[l * 6144 + cg * 64 + col];
      atomicAdd(WS_mod + (l * 5 + ci) * 6144 + cg * 64 + col, s);
    }
    return;
  }
  item -= P0_ADA;
  if (item < P0_ROPE) {
    for (int i = tid; i < 64 * 32; i += 256) {
      int pos = i >> 5, fi = i & 31;
      float inv = (float)pow(10000.0, -(double)fi / 32.0);
      float ang = (float)pos * inv;
      WS_ropetab[i * 2] = (float)cos((double)ang);
      WS_ropetab[i * 2 + 1] = (float)sin((double)ang);
    }
    return;
  }
  item -= P0_ROPE;
  if (item < P0_CACHE) {
    const int pc = item & 7, b = (item >> 3) & 3, l = item >> 5;
    const float* ksrc = p.cache_k + ((size_t)(b * 2 + l) * 512 + pc * 64) * 512;
    const float* vsrc = p.cache_v + ((size_t)(b * 2 + l) * 512 + pc * 64) * 512;
    u16* kdst = WS_CK + ((size_t)(l * 4 + b) * 512 + pc * 64) * 512;
    for (int i = tid; i < 64 * 512 / 4; i += 256) {
      float4 v = *(const float4*)(ksrc + (size_t)i * 4);
      *(uint2*)(kdst + (size_t)i * 4) = make_uint2(pack2(v.x, v.y), pack2(v.z, v.w));
    }
    for (int cc = 0; cc < 2; ++cc) {
      const int col = tid + cc * 256;
      u16* vdst = WS_CVt + ((size_t)(l * 4 + b) * 512 + col) * 512 + pc * 64;
      for (int j = 0; j < 8; ++j) {
        float v[8];
#pragma unroll
        for (int e = 0; e < 8; ++e) v[e] = vsrc[(size_t)(j * 8 + e) * 512 + col];
        *(uint4*)(vdst + j * 8) = make_uint4(pack2(v[0], v[1]), pack2(v[2], v[3]), pack2(v[4], v[5]), pack2(v[6], v[7]));
      }
    }
    return;
  }
  item -= P0_CACHE;
  if (item < P0_S0) {
    const int hh = item & 3, dir = (item >> 2) & 1, b = (item >> 3) & 3, l = item >> 5;
    const float* src = p.state_ret + ((size_t)(((b * 2 + l) * 2 + dir) * 4 + hh)) * 16384;
    u16* dst = WS_S0t + ((size_t)(((l * 4 + b) * 2 + dir) * 4 + hh)) * 16384;
    const int dv = tid & 127, kh = tid >> 7;
    for (int j = 0; j < 8; ++j) {
      const int dk0 = kh * 64 + j * 8;
      float v[8];
#pragma unroll
      for (int e = 0; e < 8; ++e) v[e] = src[(size_t)(dk0 + e) * 128 + dv];
      *(uint4*)(dst + (size_t)dv * 128 + dk0) = make_uint4(pack2(v[0], v[1]), pack2(v[2], v[3]), pack2(v[4], v[5]), pack2(v[6], v[7]));
    }
    return;
  }
  item -= P0_S0;
  if (item >= P0_S5) { wt_item(p, smem, item - P0_S5); return; }
  {
    const int g = item & 31, dir = (item >> 5) & 1, l = item >> 6;
    if (tid < 64) {
      const int pp = tid;
      const int ai = ((l * 2 + dir) * 32 + g) * 64 + pp;
      double lre = fmin((double)p.a_re[ai], -1e-4), lim = (double)p.a_im[ai];
      double dt = exp((double)p.log_dt[(l * 2 + dir) * 32 + g]);
      double er = exp(lre * dt);
      double abr = er * cos(lim * dt), abi = er * sin(lim * dt);
      WS_abar[ai * 2] = (float)abr;
      WS_abar[ai * 2 + 1] = (float)abi;
      double nr = abr - 1.0, ni = abi;
      double den = lre * lre + lim * lim;
      double cr = (nr * lre + ni * lim) / den, cim = (ni * lre - nr * lim) / den;
      u16* bt = WS_bbarT + (size_t)((l * 2 + dir) * 32 + g) * 128 * 16;
      const float* br = p.b_re + ((size_t)(l * 32 + g) * 64 + pp) * 16;
      const float* bi = p.b_im + ((size_t)(l * 32 + g) * 64 + pp) * 16;
      for (int c = 0; c < 16; ++c) {
        double xr = br[c], xi = bi[c];
        bt[pp * 16 + c] = f2bf((float)(cr * xr - cim * xi));
        bt[(64 + pp) * 16 + c] = f2bf((float)(cr * xi + cim * xr));
      }
      u16* ct = WS_cmT + (size_t)((l * 2 + dir) * 32 + g) * 16 * 128;
      const float* cre = p.c_re + ((size_t)((l * 2 + dir) * 32 + g) * 16) * 64;
      const float* cie = p.c_im + ((size_t)((l * 2 + dir) * 32 + g) * 16) * 64;
      for (int c = 0; c < 16; ++c) {
        ct[c * 128 + pp] = f2bf(cre[c * 64 + pp]);
        ct[c * 128 + 64 + pp] = f2bf(-cie[c * 64 + pp]);
      }
    }
  }
}


__device__ __forceinline__ void hmat_item(const Params& p, int l, int which, int item) {
  const int c = ltid() * 4;
  const int row0 = item * 8;
  const int ci = cond_of_row(row0);
  const float* mod = WS_mod + (l * 5 + ci) * 6144;
  const float4 sc = *(const float4*)(mod + (which ? 4 : 1) * 1024 + c);
  const float4 sh = *(const float4*)(mod + (which ? 3 : 0) * 1024 + c);
  float4 g = make_float4(1.f, 1.f, 1.f, 1.f), b = make_float4(0.f, 0.f, 0.f, 0.f);
  const float* st = nullptr;
  if (which == 1) { g = *(const float4*)(p.ln1_g + l * 1024 + c); b = *(const float4*)(p.ln1_b + l * 1024 + c); st = WS_stats + (size_t)(l * 2 + 0) * TALL * 2; }
  else if (l == 1) { g = *(const float4*)(p.ln2_g + c); b = *(const float4*)(p.ln2_b + c); st = WS_stats + (size_t)(0 * 2 + 1) * TALL * 2; }
  const float G0 = g.x * (1.f + sc.x), G1 = g.y * (1.f + sc.y), G2 = g.z * (1.f + sc.z), G3 = g.w * (1.f + sc.w);
  const float B0 = fmaf(b.x, 1.f + sc.x, sh.x), B1 = fmaf(b.y, 1.f + sc.y, sh.y), B2 = fmaf(b.z, 1.f + sc.z, sh.z), B3 = fmaf(b.w, 1.f + sc.w, sh.w);
  u16* dst = which ? WS_h2 : WS_h1;
#pragma unroll
  for (int r = 0; r < 8; ++r) {
    const int row = row0 + r;
    const float* src;
    if (which == 1) src = WS_pre1 + (size_t)row * 1024;
    else if (l == 1) src = p.out + (size_t)row * 1024;
    else src = row < TCTX ? p.x_prompt + (size_t)row * 1024 : p.x_sample + (size_t)(row - TCTX) * 1024;
    float rs = 1.f, nm = 0.f;
    if (st) {
      const float s = st[row * 2], q = st[row * 2 + 1];
      const float mu = s * (1.f / 1024.f);
      rs = rsqrtf(fmaxf(q * (1.f / 1024.f) - mu * mu, 0.f) + LNEPS);
      nm = -mu * rs;
    }
    const float4 x = *(const float4*)(src + c);
    const float h0 = fmaf(fmaf(x.x, rs, nm), G0, B0), h1 = fmaf(fmaf(x.y, rs, nm), G1, B1);
    const float h2 = fmaf(fmaf(x.z, rs, nm), G2, B2), h3 = fmaf(fmaf(x.w, rs, nm), G3, B3);
    *(uint2*)(dst + (size_t)row * 1024 + c) = make_uint2(pack2(h0, h1), pack2(h2, h3));
  }
}

__device__ __forceinline__ void p1_item(const Params& p, char* smem, int l, int item) {
  const int mt = item & 63, nt = item >> 6;
  const int m0 = mt * 128, n0 = nt * 128;
  const int tid = ltid(), lane = tid & 63, wave = tid >> 6, wm = wave >> 1, wn = wave & 1;
  f16v acc[2][2];
  gemm_mainloop0(smem, WS_h1, 1024, WS_Wt + WT_LAYER * l + WT_IN, 1024, 1024, m0, n0, acc);

  const bool latent = m0 >= TCTX;
  const int seg = n0 >> 9;
  const int cs0 = n0 & 511;
  const int l31 = lane & 31;
  u16* Cs = (u16*)smem;
  u16* CsT = Cs + 128 * CST;
  const int rl0 = wm * 64 + 4 * (lane >> 5);
  const int cl0 = wn * 64 + l31;
  const bool want_rm = !(seg == 2 || seg == 7);
  const bool want_t = (seg == 2 || seg == 7 || (seg == 1 && !latent));
#pragma unroll
  for (int mi = 0; mi < 2; ++mi)
#pragma unroll
    for (int q = 0; q < 4; ++q) {
      float o0[4], o1[4];
#pragma unroll
      for (int j = 0; j < 4; ++j) {
        const int reg = q * 4 + j;
        float x1 = acc[mi][0][reg], x2 = acc[mi][1][reg];
        if (seg <= 1) {
          if (latent) {
            const int pos = (m0 - TCTX + rl0 + mi * 32 + q * 8 + j) & 1023;
            const int pidx = ((cs0 + wn * 64) & 64) ? (pos & 63) : (pos >> 6);
            const float cs = WS_ropetab[(pidx * 32 + l31) * 2], sn = WS_ropetab[(pidx * 32 + l31) * 2 + 1];
            const float t1 = x1 * cs - x2 * sn, t2 = x1 * sn + x2 * cs;
            x1 = t1; x2 = t2;
          }
          if (seg == 1) { x1 *= 0.08838834764831845f; x2 *= 0.08838834764831845f; }
        } else if (seg == 3) { x1 = siluf_(x1); x2 = siluf_(x2); }
        else if (seg == 5) { x1 *= 0.125f; x2 *= 0.125f; }
        else if (seg >= 8) { x1 = sigmoidf_(x1); x2 = sigmoidf_(x2); }
        o0[j] = x1; o1[j] = x2;
        if (want_rm) {
          const int rl = rl0 + mi * 32 + q * 8 + j;
          Cs[rl * CST + cl0] = f2bf(x1);
          Cs[rl * CST + cl0 + 32] = f2bf(x2);
        }
        if ((seg == 6 || seg == 7) && !latent) {
          const int row = m0 + rl0 + mi * 32 + q * 8 + j;
          float* o = p.out + (seg == 6 ? OUT_CK : OUT_CV) + ((size_t)((row >> 8) * 2 + l) * 256 + (row & 255)) * 512 + cs0 + cl0;
          o[0] = acc[mi][0][reg]; o[32] = acc[mi][1][reg];
        }
      }
      if (want_t) {
        const int rl = rl0 + mi * 32 + q * 8;
        *(uint2*)(CsT + cl0 * CST + rl) = make_uint2(pack2(o0[0], o0[1]), pack2(o0[2], o0[3]));
        *(uint2*)(CsT + (cl0 + 32) * CST + rl) = make_uint2(pack2(o1[0], o1[1]), pack2(o1[2], o1[3]));
      }
    }
  __syncthreads();
  if (want_rm) {
    u16* dst;
    size_t ld = 512;
    if (seg >= 8) { dst = WS_GT + (size_t)m0 * 3072 + (n0 - 4096); ld = 3072; }
    else {
      u16* base = seg == 0 ? WS_Q : seg == 1 ? WS_K : seg == 3 ? WS_G : seg == 4 ? WS_SU : seg == 5 ? WS_NQ : WS_NK;
      dst = base + (size_t)m0 * 512 + cs0;
    }
    cs_store(Cs, dst, ld, tid);
  }
  if (want_t) {
    u16* base = seg == 2 ? WS_VtR : seg == 7 ? WS_NVt : WS_KtR;
    u16* dst;
    size_t ld;
    if (!latent) { dst = base + ((size_t)(m0 >> 8) * 512 + cs0) * 256 + (m0 & 255); ld = 256; }
    else { dst = base + VTR_LAT + ((size_t)((m0 - TCTX) >> 10) * 512 + cs0) * 1024 + ((m0 - TCTX) & 1023); ld = 1024; }
    cs_store(CsT, dst, ld, tid);
  }
}

template <int D, int MODE>
__device__ __forceinline__ void attn_item(const Params& p, char* smem, int l, int idx) {
  constexpr int KSTR = D + 8;
  constexpr int NKS = D / 32;
  constexpr int NB = D / 16;
  constexpr int NCH = D / 32;
  u16* Ks = (u16*)smem;
  u16* Vts = Ks + 64 * KSTR;
  float* rpbs = (float*)(Vts + D * 72);
  const int tid = ltid(), lane = tid & 63, wave = tid >> 6;
  const int l15 = lane & 15, g = lane >> 4;

  int b, hh, qt, L, tokbase, nt;
  bool latent = false;
  int kr0 = 0, rrow = 0;
  if constexpr (MODE == 0) {
    if (idx < 256) { latent = true; b = idx >> 6; hh = (idx >> 4) & 3; qt = idx & 15; L = 1024; tokbase = TCTX + b * 1024; nt = 16 + 4; }
    else { idx -= 256; b = idx >> 4; hh = (idx >> 2) & 3; qt = idx & 3; L = 256; tokbase = b * 256; nt = 4; }
  } else if constexpr (MODE == 1) {
    b = idx >> 5; hh = (idx >> 2) & 7; qt = idx & 3; L = 256; tokbase = b * 256; nt = 4;
  } else {
    b = idx >> 7; hh = (idx >> 4) & 7; qt = idx & 15; rrow = qt; L = 1024; tokbase = TCTX + b * 1024; nt = 16; latent = true;
    kr0 = min(max(rrow - 4, 0), 8);
  }
  const int tq = qt * 64 + wave * 16 + l15;
  const int qtok = tokbase + tq;

  float lgf2 = 0.f, lgb2 = 0.f;
  if constexpr (MODE == 0) {
    float xf = p.ret_decay[(l * 2 + 0) * 4 + hh], xb = p.ret_decay[(l * 2 + 1) * 4 + hh];
    lgf2 = -log1pf(expf(-xf)) * 1.4426950408889634f;
    lgb2 = -log1pf(expf(-xb)) * 1.4426950408889634f;
  }

  __syncthreads();
  if constexpr (MODE == 2) {
    for (int i = tid; i < 465; i += 256) rpbs[i] = p.rpb[(size_t)(l * 8 + hh) * 465 + i];
  }

  u4v qf[NKS];
  {
    const u16* qb = (MODE == 0 ? WS_Q : WS_NQ) + (size_t)qtok * 512 + hh * D + g * 8;
#pragma unroll
    for (int ks = 0; ks < NKS; ++ks) qf[ks] = *(const u4v*)(qb + ks * 32);
  }

  f4v ot[NB];
#pragma unroll
  for (int nb = 0; nb < NB; ++nb) ot[nb] = (f4v){0.f, 0.f, 0.f, 0.f};
  float mrun = -1e30f, lsum = 0.f;

  const int ntk = (MODE == 0) ? (L >> 6) : nt;
  u4v kr[NCH], vr[NCH];
#define ATTN_ISSUE(KT)                                                                                   \
  {                                                                                                      \
    const int kt_ = (KT);                                                                                \
    const u16* kp; const u16* vp; int ldv;                                                               \
    if constexpr (MODE == 0) {                                                                           \
      kp = WS_K + (size_t)(tokbase + kt_ * 64) * 512 + hh * 128;                                          \
      if (latent) { vp = WS_VtR + VTR_LAT + ((size_t)(b * 4 + hh) * 128) * 1024 + kt_ * 64; ldv = 1024; } \
      else { vp = WS_VtR + ((size_t)(b * 4 + hh) * 128) * 256 + kt_ * 64; ldv = 256; }                    \
    } else if constexpr (MODE == 1) {                                                                    \
      kp = WS_NK + (size_t)(tokbase + kt_ * 64) * 512 + hh * 64;                                          \
      vp = WS_NVt + ((size_t)(b * 8 + hh) * 64) * 256 + kt_ * 64; ldv = 256;                              \
    } else {                                                                                             \
      if (kt_ < 8) {                                                                                     \
        const int krow = kr0 + kt_;                                                                      \
        kp = WS_NK + (size_t)(tokbase + krow * 64) * 512 + hh * 64;                                       \
        vp = WS_NVt + NVT_LAT + ((size_t)(b * 8 + hh) * 64) * 1024 + krow * 64; ldv = 1024;               \
      } else {                                                                                           \
        kp = WS_CK + ((size_t)(l * 4 + b) * 512 + (kt_ - 8) * 64) * 512 + hh * 64;                        \
        vp = WS_CVt + ((size_t)((l * 4 + b) * 8 + hh) * 64) * 512 + (kt_ - 8) * 64; ldv = 512;            \
      }                                                                                                  \
    }                                                                                                    \
    _Pragma("unroll") for (int i = 0; i < NCH; ++i) {                                                    \
      const int c = tid + 256 * i;                                                                       \
      const int r = c / (D / 8), cc = c % (D / 8);                                                       \
      kr[i] = *(const u4v*)(kp + (size_t)r * 512 + cc * 8);                                              \
      const int vrw = c >> 3, vc = c & 7;                                                                \
      vr[i] = *(const u4v*)(vp + (size_t)vrw * ldv + vc * 8);                                            \
    }                                                                                                    \
  }
#define ATTN_STAGE()                                                                                     \
  {                                                                                                      \
    _Pragma("unroll") for (int i = 0; i < NCH; ++i) {                                                    \
      const int c = tid + 256 * i;                                                                       \
      const int r = c / (D / 8), cc = c % (D / 8);                                                       \
      *(u4v*)(Ks + r * KSTR + cc * 8) = kr[i];                                                           \
      const int vrw = c >> 3, vc = c & 7;                                                                \
      *(u4v*)(Vts + vrw * 72 + vc * 8) = vr[i];                                                          \
    }                                                                                                    \
  }

  ATTN_ISSUE(0)
#pragma unroll 1
  for (int kt = 0; kt < ntk; ++kt) {
    __syncthreads();
    ATTN_STAGE()
    __syncthreads();
    if (kt + 1 < ntk) ATTN_ISSUE(kt + 1)
    f4v st[4];
#pragma unroll
    for (int kb = 0; kb < 4; ++kb) {
      st[kb] = (f4v){0.f, 0.f, 0.f, 0.f};
#pragma unroll
      for (int ks = 0; ks < NKS; ++ks) {
        s8v kf = *(const s8v*)(Ks + (kb * 16 + l15) * KSTR + ks * 32 + g * 8);
        st[kb] = __builtin_amdgcn_mfma_f32_16x16x32_bf16(kf, bc8(qf[ks]), st[kb], 0, 0, 0);
      }
    }
    if constexpr (MODE == 0) {
#pragma unroll
      for (int kb = 0; kb < 4; ++kb)
#pragma unroll
        for (int r = 0; r < 4; ++r) {
          const int ts = kt * 64 + kb * 16 + g * 4 + r;
          const int d = tq - ts;
          float dec = d > 0 ? exp2f(lgf2 * (float)d) : (d < 0 ? exp2f(lgb2 * (float)(-d)) : 2.f);
          st[kb][r] *= dec;
        }
    } else {
      if constexpr (MODE == 2) {
        if (kt < 8) {
          const int qc = wave * 16 + l15;
          const int ws = min(max(qc - 8, 0), 48);
          const int roff = (kr0 + kt) - rrow + 7;
#pragma unroll
          for (int kb = 0; kb < 4; ++kb)
#pragma unroll
            for (int r = 0; r < 4; ++r) {
              const int kc = kb * 16 + g * 4 + r;
              const bool valid = (kc >= ws) && (kc < ws + 16);
              const int coff = min(max(kc - qc + 15, 0), 30);
              const float bias = rpbs[roff * 31 + coff];
              st[kb][r] = valid ? st[kb][r] + bias : -1e30f;
            }
        }
      }
      float tmax = st[0][0];
#pragma unroll
      for (int kb = 0; kb < 4; ++kb)
#pragma unroll
        for (int r = 0; r < 4; ++r) tmax = fmaxf(tmax, st[kb][r]);
      tmax = fmaxf(tmax, __shfl_xor(tmax, 16));
      tmax = fmaxf(tmax, __shfl_xor(tmax, 32));
      const float mnew = fmaxf(mrun, tmax);
      const float alpha = __expf(mrun - mnew);
      float ps = 0.f;
#pragma unroll
      for (int kb = 0; kb < 4; ++kb)
#pragma unroll
        for (int r = 0; r < 4; ++r) {
          float e = __expf(st[kb][r] - mnew);
          st[kb][r] = e;
          ps += e;
        }
      lsum = lsum * alpha + ps;
      mrun = mnew;
#pragma unroll
      for (int nb = 0; nb < NB; ++nb) ot[nb] *= alpha;
    }
    u4v pf[2];
#pragma unroll
    for (int s = 0; s < 2; ++s) {
      pf[s] = (u4v){pack2(st[2 * s][0], st[2 * s][1]), pack2(st[2 * s][2], st[2 * s][3]),
                    pack2(st[2 * s + 1][0], st[2 * s + 1][1]), pack2(st[2 * s + 1][2], st[2 * s + 1][3])};
    }
#pragma unroll
    for (int nb = 0; nb < NB; ++nb)
#pragma unroll
      for (int s = 0; s < 2; ++s) {
        const u16* vb = Vts + (nb * 16 + l15) * 72 + s * 32 + g * 4;
        uint2 lo = *(const uint2*)(vb);
        uint2 hi = *(const uint2*)(vb + 16);
        u4v vf = (u4v){lo.x, lo.y, hi.x, hi.y};
        ot[nb] = __builtin_amdgcn_mfma_f32_16x16x32_bf16(bc8(vf), bc8(pf[s]), ot[nb], 0, 0, 0);
      }
  }

  if constexpr (MODE == 0) {
    if (latent) {
#pragma unroll 1
      for (int dir = 0; dir < 2; ++dir) {
        const float scale = dir == 0 ? exp2f(lgf2 * (float)(tq + 1)) : exp2f(lgb2 * (float)(L - tq));
        const u16* S0 = WS_S0t + ((size_t)(((l * 4 + b) * 2 + dir) * 4 + hh)) * 16384;
#pragma unroll
        for (int s = 0; s < NKS; ++s) {
          u4v pq = (u4v){pack2(bflo(qf[s][0]) * scale, bfhi(qf[s][0]) * scale), pack2(bflo(qf[s][1]) * scale, bfhi(qf[s][1]) * scale),
                         pack2(bflo(qf[s][2]) * scale, bfhi(qf[s][2]) * scale), pack2(bflo(qf[s][3]) * scale, bfhi(qf[s][3]) * scale)};
#pragma unroll
          for (int nb = 0; nb < NB; ++nb) {
            u4v vf = *(const u4v*)(S0 + (size_t)(nb * 16 + l15) * 128 + s * 32 + g * 8);
            ot[nb] = __builtin_amdgcn_mfma_f32_16x16x32_bf16(bc8(vf), bc8(pq), ot[nb], 0, 0, 0);
          }
        }
      }
    }
    float s = 0.f;
#pragma unroll
    for (int nb = 0; nb < NB; ++nb) s += ot[nb][0] + ot[nb][1] + ot[nb][2] + ot[nb][3];
    s += __shfl_xor(s, 16); s += __shfl_xor(s, 32);
    const float mu = s * (1.f / 128.f);
    float q = 0.f;
#pragma unroll
    for (int nb = 0; nb < NB; ++nb)
#pragma unroll
      for (int r = 0; r < 4; ++r) { float dlt = ot[nb][r] - mu; q += dlt * dlt; }
    q += __shfl_xor(q, 16); q += __shfl_xor(q, 32);
    const float rstd = rsqrtf(q * (1.f / 128.f) + LNEPS);
#pragma unroll
    for (int nb = 0; nb < NB; ++nb) {
      const size_t off = (size_t)qtok * 512 + hh * 128 + nb * 16 + g * 4;
      uint2 gg = *(const uint2*)(WS_G + off);
      float o0 = (ot[nb][0] - mu) * rstd * bflo(gg.x);
      float o1 = (ot[nb][1] - mu) * rstd * bfhi(gg.x);
      float o2 = (ot[nb][2] - mu) * rstd * bflo(gg.y);
      float o3 = (ot[nb][3] - mu) * rstd * bfhi(gg.y);
      *(uint2*)(WS_rout + off) = make_uint2(pack2(o0, o1), pack2(o2, o3));
    }
  } else {
    lsum += __shfl_xor(lsum, 16); lsum += __shfl_xor(lsum, 32);
    const float inv = 1.f / lsum;
#pragma unroll
    for (int nb = 0; nb < NB; ++nb) {
      const size_t off = (size_t)qtok * 512 + hh * 64 + nb * 16 + g * 4;
      *(uint2*)(WS_nout + off) = make_uint2(pack2(ot[nb][0] * inv, ot[nb][1] * inv), pack2(ot[nb][2] * inv, ot[nb][3] * inv));
    }
  }
}

__device__ __forceinline__ void retstate_item(const Params& p, int l, int idx) {
  const int dir = idx & 1, hh = (idx >> 1) & 3, b = idx >> 3;
  const int tid = ltid(), lane = tid & 63, wave = tid >> 6;
  const int r = lane & 31, h2 = lane >> 5;
  const float x = p.ret_decay[(l * 2 + dir) * 4 + hh];
  const float lg2 = -log1pf(expf(-x)) * 1.4426950408889634f;
  const u16* Kt = WS_KtR + ((size_t)(b * 4 + hh) * 128) * 256;
  const u16* Vt = WS_VtR + ((size_t)(b * 4 + hh) * 128) * 256;
  f16v acc[4];
#pragma unroll
  for (int i = 0; i < 4; ++i) acc[i] = zero16();
#pragma unroll 2
  for (int ks = 0; ks < 16; ++ks) {
    const int tok0 = ks * 16 + h2 * 8;
    const u4v a = *(const u4v*)(Kt + (size_t)(wave * 32 + r) * 256 + tok0);
    u4v af;
#pragma unroll
    for (int w = 0; w < 4; ++w) {
      const int t0 = tok0 + 2 * w, t1 = t0 + 1;
      float w0 = dir == 0 ? exp2f(lg2 * (float)(255 - t0)) : exp2f(lg2 * (float)t0);
      float w1 = dir == 0 ? exp2f(lg2 * (float)(255 - t1)) : exp2f(lg2 * (float)t1);
      af[w] = pack2(bflo(a[w]) * w0, bfhi(a[w]) * w1);
    }
#pragma unroll
    for (int nt = 0; nt < 4; ++nt) {
      const u4v bfr = *(const u4v*)(Vt + (size_t)(nt * 32 + r) * 256 + tok0);
      acc[nt] = __builtin_amdgcn_mfma_f32_32x32x16_bf16(bc8(af), bc8(bfr), acc[nt], 0, 0, 0);
    }
  }
  float* o = p.out + OUT_SRET + ((size_t)(((b * 2 + l) * 2 + dir) * 4 + hh)) * 16384;
#pragma unroll
  for (int nt = 0; nt < 4; ++nt)
#pragma unroll
    for (int reg = 0; reg < 16; ++reg) {
      const int dk = wave * 32 + (reg & 3) + 8 * (reg >> 2) + 4 * h2;
      o[(size_t)dk * 128 + nt * 32 + r] = acc[nt][reg];
    }
}

__device__ __forceinline__ void s5_item(const Params& p, char* smem, int l, int item) {
  const int tid = ltid(), lane = tid & 63, wave = tid >> 6;
  const int l15 = lane & 15, g4 = lane >> 4;
  int seq = item * 4 + wave;
  int b, dir, g, L, tokbase;
  bool latent;
  if (seq < 256) { latent = true; b = seq >> 6; dir = (seq >> 5) & 1; g = seq & 31; L = 1024; tokbase = TCTX + b * 1024; }
  else { seq -= 256; latent = false; b = seq >> 6; dir = (seq >> 5) & 1; g = seq & 31; L = 256; tokbase = b * 256; }
  float* buf = (float*)smem + wave * (16 * 132);
  const int tg = (l * 2 + dir) * 32 + g;
  const float ar = WS_abar[(tg * 64 + lane) * 2], ai = WS_abar[(tg * 64 + lane) * 2 + 1];
  u4v bfrag[8];
#pragma unroll
  for (int nt = 0; nt < 8; ++nt) {
    if (g4 < 2) bfrag[nt] = *(const u4v*)(WS_bbarT + ((size_t)tg * 128 + nt * 16 + l15) * 16 + g4 * 8);
    else bfrag[nt] = (u4v){0u, 0u, 0u, 0u};
  }
  u4v cfrag[4];
#pragma unroll
  for (int ks = 0; ks < 4; ++ks) cfrag[ks] = *(const u4v*)(WS_cmT + ((size_t)tg * 16 + l15) * 128 + ks * 32 + g4 * 8);
  float xr = 0.f, xi = 0.f;
  if (latent) {
    const float* h0 = p.state_ssm + ((size_t)(((b * 2 + l) * 2 + dir) * 32 + g) * 64 + lane) * 2;
    xr = h0[0]; xi = h0[1];
  }
  u16* yd = WS_YD + (size_t)dir * TALL * 512;
  __syncthreads();
  const int nsub = L >> 4;
#pragma unroll 1
  for (int sub = 0; sub < nsub; ++sub) {
    u4v af;
    {
      const int tau = sub * 16 + l15;
      const int pos = dir == 0 ? tau : L - 1 - tau;
      if (g4 < 2) af = *(const u4v*)(WS_SU + (size_t)(tokbase + pos) * 512 + g * 16 + g4 * 8);
      else af = (u4v){0u, 0u, 0u, 0u};
    }
#pragma unroll
    for (int nt = 0; nt < 8; ++nt) {
      f4v c = (f4v){0.f, 0.f, 0.f, 0.f};
      c = __builtin_amdgcn_mfma_f32_16x16x32_bf16(bc8(af), bc8(bfrag[nt]), c, 0, 0, 0);
#pragma unroll
      for (int r = 0; r < 4; ++r) buf[(g4 * 4 + r) * 132 + nt * 16 + l15] = c[r];
    }
    __syncthreads();
#pragma unroll
    for (int i = 0; i < 16; ++i) {
      const float bur = buf[i * 132 + lane], bui = buf[i * 132 + 64 + lane];
      const float nr = ar * xr - ai * xi + bur;
      const float ni = ar * xi + ai * xr + bui;
      xr = nr; xi = ni;
      buf[i * 132 + lane] = xr;
      buf[i * 132 + 64 + lane] = xi;
    }
    __syncthreads();
    f4v y = (f4v){0.f, 0.f, 0.f, 0.f};
#pragma unroll
    for (int ks = 0; ks < 4; ++ks) {
      const float* bp = buf + l15 * 132 + ks * 32 + g4 * 8;
      float4 v0 = *(const float4*)(bp), v1 = *(const float4*)(bp + 4);
      const u4v xa = (u4v){pack2(v0.x, v0.y), pack2(v0.z, v0.w), pack2(v1.x, v1.y), pack2(v1.z, v1.w)};
      y = __builtin_amdgcn_mfma_f32_16x16x32_bf16(bc8(xa), bc8(cfrag[ks]), y, 0, 0, 0);
    }
#pragma unroll
    for (int r = 0; r < 4; ++r) {
      const int tau = sub * 16 + g4 * 4 + r;
      const int pos = dir == 0 ? tau : L - 1 - tau;
      yd[(size_t)(tokbase + pos) * 512 + g * 16 + l15] = f2bf(y[r]);
    }
    __syncthreads();
  }
  if (!latent) {
    float* o = p.out + OUT_SSSM + ((size_t)(((b * 2 + l) * 2 + dir) * 32 + g) * 64 + lane) * 2;
    o[0] = xr; o[1] = xi;
  }
}

#define MX_S5 320
#define MX_RET 512
#define MX_NA 512
#define MX_CA 512
#define MX_RS 128
#define MX_ITEMS (MX_S5 + MX_RET + MX_NA + MX_CA + MX_RS)
__device__ __forceinline__ void mixer_item(const Params& p, char* smem, int l, int item) {
  if (item < 64) { s5_item(p, smem, l, item); return; }
  item -= 64;
  if (item < 256) { attn_item<128, 0>(p, smem, l, item); return; }
  item -= 256;
  if (item < 512) { attn_item<64, 2>(p, smem, l, item); return; }
  item -= 512;
  if (item < 256) { s5_item(p, smem, l, 64 + item); return; }
  item -= 256;
  if (item < 256) { attn_item<128, 0>(p, smem, l, 256 + item); return; }
  item -= 256;
  if (item < 512) { attn_item<64, 1>(p, smem, l, item); return; }
  item -= 512;
  retstate_item(p, l, item);
}

__device__ __forceinline__ void p3a_item(const Params& p, char* smem, int l, int item) {
  const int mt = item & 63, nt = item >> 6;
  const int m0 = mt * 128, n0 = nt * 128;
  const int tid = ltid(), lane = tid & 63, wave = tid >> 6, wm = wave >> 1, wn = wave & 1;
  AArgs a{};
  a.SU = WS_SU; a.YD0 = WS_YD; a.YD1 = WS_YD + (size_t)TALL * 512; a.dsk = p.ssm_d + l * 512;
  f16v acc[2][2];
  gemm_mainloop<2>(smem, a, WS_Wt + WT_LAYER * l + WT_GLU, 512, 512, m0, n0, acc);
#pragma unroll
  for (int mi = 0; mi < 2; ++mi)
#pragma unroll
    for (int reg = 0; reg < 16; ++reg) {
      const int row = EPI_ROW(mi, reg);
#pragma unroll
      for (int ni = 0; ni < 2; ++ni) {
        const int col = EPI_COL(ni);
        const size_t off = (size_t)row * 512 + col;
        float y = geluf_(a.dsk[col] * bf2f(WS_SU[off]) + bf2f(a.YD0[off]) + bf2f(a.YD1[off]));
        WS_sout[off] = f2bf(y * sigmoidf_(acc[mi][ni][reg]));
      }
    }
}

__device__ __forceinline__ void p3b_item(const Params& p, char* smem, int l, int item) {
  const int mt = item & 63, nt = item >> 6;
  const int m0 = mt * 128, n0 = nt * 128;
  const int tid = ltid(), lane = tid & 63, wave = tid >> 6, wm = wave >> 1, wn = wave & 1;
  int nbr = 3;
  asm volatile("" : "+s"(nbr));
#pragma unroll 1
  for (int br = 0; br < nbr; ++br) {
    const u16* Abr = br == 0 ? WS_rout : (br == 1 ? WS_sout : WS_nout);
    f16v acc[2][2];
    gemm_mainloop0(smem, Abr, 512, WS_Wt + WT_LAYER * l + WT_BR + (size_t)br * 512 * 1024, 512, 512, m0, n0, acc);
    u16* Cs = (u16*)smem;
    {
      const int rl0 = wm * 64 + 4 * (lane >> 5), cl0 = wn * 64 + (lane & 31);
#pragma unroll
      for (int mi = 0; mi < 2; ++mi)
#pragma unroll
        for (int reg = 0; reg < 16; ++reg) {
          const int rl = rl0 + mi * 32 + (reg & 3) + 8 * (reg >> 2);
          Cs[rl * CST + cl0] = f2bf(acc[mi][0][reg]);
          Cs[rl * CST + cl0 + 32] = f2bf(acc[mi][1][reg]);
        }
    }
    __syncthreads();
    int tl = tid;
    asm volatile("" : "+v"(tl));
#pragma unroll
    for (int i = 0; i < 8; ++i) {
      const int c = tl + 256 * i, r = c >> 4, ch = c & 15;
      const u4v av = *(const u4v*)(Cs + r * CST + ch * 8);
      const u4v gv = *(const u4v*)(WS_GT + (size_t)(m0 + r) * 3072 + br * 1024 + n0 + ch * 8);
      u16* mp = WS_merged + (size_t)(m0 + r) * 1024 + n0 + ch * 8;
      u4v mv = (u4v){0u, 0u, 0u, 0u};
      if (br > 0) mv = *(const u4v*)mp;
      u4v ov;
#pragma unroll
      for (int j = 0; j < 4; ++j)
        ov[j] = pack2(fmaf(bflo(gv[j]), bflo(av[j]), bflo(mv[j])), fmaf(bfhi(gv[j]), bfhi(av[j]), bfhi(mv[j])));
      *(u4v*)mp = ov;
    }
  }
}

__device__ __forceinline__ void p3c_item(const Params& p, char* smem, int l, int item, bool do_stats = true) {
  const int mt = item & 63, nt = item >> 6;
  const int m0 = mt * 128, n0 = nt * 128;
  const int tid = ltid(), lane = tid & 63, wave = tid >> 6, wm = wave >> 1, wn = wave & 1;
  f16v acc[2][2];
  gemm_mainloop0(smem, WS_merged, 1024, WS_Wt + WT_LAYER * l + WT_O, 1024, 1024, m0, n0, acc);
  const int ci = cond_of_row(m0);
  const float* g1 = WS_mod + (l * 5 + ci) * 6144 + 2048;
  float* st1 = WS_stats + (size_t)(l * 2 + 0) * TALL * 2;
  const float* st2p = WS_stats + (size_t)(0 * 2 + 1) * TALL * 2;
  const int c0 = EPI_COL(0), c1 = EPI_COL(1);
  const float g1a = g1[c0], g1b = g1[c1];
  float lga = 1.f, lgb = 1.f, lba = 0.f, lbb = 0.f;
  if (l == 1) { lga = p.ln2_g[c0]; lgb = p.ln2_g[c1]; lba = p.ln2_b[c0]; lbb = p.ln2_b[c1]; }
#pragma unroll
  for (int mi = 0; mi < 2; ++mi)
#pragma unroll
    for (int reg = 0; reg < 16; ++reg) {
      const int row = EPI_ROW(mi, reg);
      float xa, xb;
      if (l == 0) {
        const float* xr = row < TCTX ? p.x_prompt + (size_t)row * 1024 : p.x_sample + (size_t)(row - TCTX) * 1024;
        xa = xr[c0]; xb = xr[c1];
      } else {
        const float s = st2p[row * 2], q = st2p[row * 2 + 1];
        const float mu = s * (1.f / 1024.f);
        const float rstd = rsqrtf(fmaxf(q * (1.f / 1024.f) - mu * mu, 0.f) + LNEPS);
        xa = (p.out[(size_t)row * 1024 + c0] - mu) * rstd * lga + lba;
        xb = (p.out[(size_t)row * 1024 + c1] - mu) * rstd * lgb + lbb;
      }
      const float va = ALPHA * xa + g1a * acc[mi][0][reg];
      const float vb = ALPHA * xb + g1b * acc[mi][1][reg];
      WS_pre1[(size_t)row * 1024 + c0] = va;
      WS_pre1[(size_t)row * 1024 + c1] = vb;
      if (do_stats) stats_accum(st1, row, va, vb, lane);
    }
}

__device__ __forceinline__ void p4_item(const Params& p, char* smem, int l, int item) {
  const int mt = item & 63, nt = item >> 6;
  const int m0 = mt * 128, n0 = nt * 128;
  const int tid = ltid(), lane = tid & 63, wave = tid >> 6, wm = wave >> 1, wn = wave & 1;
  f16v acc[2][2];
  gemm_mainloop0(smem, WS_h2, 1024, WS_Wt + WT_LAYER * l + WT_UP, 1024, 1024, m0, n0, acc);
  u16* Cs = (u16*)smem;
  const int rl0 = wm * 64 + 4 * (lane >> 5), cl0 = wn * 64 + (lane & 31);
#pragma unroll
  for (int mi = 0; mi < 2; ++mi)
#pragma unroll
    for (int reg = 0; reg < 16; ++reg) {
      const int rl = rl0 + mi * 32 + (reg & 3) + 8 * (reg >> 2);
      Cs[rl * CST + cl0] = f2bf(acc[mi][0][reg]);
      Cs[rl * CST + cl0 + 32] = f2bf(acc[mi][1][reg]);
    }
  __syncthreads();
  cs_store(Cs, WS_z2 + (size_t)m0 * 5632 + n0, 5632, tid);
}

__device__ __forceinline__ void p4b_item(const Params& p, int l, int item) {
  const int tid = ltid();
  if (tid >= 176) return;
  const int rb = item >> 1, hf = item & 1;
  const int j0 = (hf * 176 + tid) * 8;
  const float* cw = p.conv_w + (size_t)l * 3 * 5632;
  const float* cb = p.conv_b + (size_t)l * 5632;
  float wa[3][8], wb[3][8], ba[8], bb[8];
#pragma unroll
  for (int t = 0; t < 3; ++t)
#pragma unroll
    for (int h = 0; h < 2; ++h) {
      const float4 x = *(const float4*)(cw + t * 5632 + j0 + 4 * h), y = *(const float4*)(cw + t * 5632 + 2816 + j0 + 4 * h);
      wa[t][4 * h] = x.x; wa[t][4 * h + 1] = x.y; wa[t][4 * h + 2] = x.z; wa[t][4 * h + 3] = x.w;
      wb[t][4 * h] = y.x; wb[t][4 * h + 1] = y.y; wb[t][4 * h + 2] = y.z; wb[t][4 * h + 3] = y.w;
    }
#pragma unroll
  for (int h = 0; h < 2; ++h) {
    const float4 x = *(const float4*)(cb + j0 + 4 * h), y = *(const float4*)(cb + 2816 + j0 + 4 * h);
    ba[4 * h] = x.x; ba[4 * h + 1] = x.y; ba[4 * h + 2] = x.z; ba[4 * h + 3] = x.w;
    bb[4 * h] = y.x; bb[4 * h + 1] = y.y; bb[4 * h + 2] = y.z; bb[4 * h + 3] = y.w;
  }
  const int row0 = rb * 32;
  int pos0, L;
  if (row0 < TCTX) { pos0 = row0 & 255; L = 256; } else { pos0 = (row0 - TCTX) & 1023; L = 1024; }
  const u16* zr = WS_z2 + (size_t)row0 * 5632 + j0;
  const u4v zero = (u4v){0u, 0u, 0u, 0u};
  u4v pa = zero, pb = zero;
  if (pos0 > 0) { pa = *(const u4v*)(zr - 5632); pb = *(const u4v*)(zr - 5632 + 2816); }
  u4v ca = *(const u4v*)(zr), cb2 = *(const u4v*)(zr + 2816);
#pragma unroll 2
  for (int r = 0; r < 32; ++r) {
    u4v na = zero, nb = zero;
    if (pos0 + r < L - 1) { na = *(const u4v*)(zr + (size_t)(r + 1) * 5632); nb = *(const u4v*)(zr + (size_t)(r + 1) * 5632 + 2816); }
    u4v ov;
#pragma unroll
    for (int w = 0; w < 4; ++w) {
      const float a0 = wa[0][2 * w] * bflo(pa[w]) + wa[1][2 * w] * bflo(ca[w]) + wa[2][2 * w] * bflo(na[w]) + ba[2 * w];
      const float a1 = wa[0][2 * w + 1] * bfhi(pa[w]) + wa[1][2 * w + 1] * bfhi(ca[w]) + wa[2][2 * w + 1] * bfhi(na[w]) + ba[2 * w + 1];
      const float b0 = wb[0][2 * w] * bflo(pb[w]) + wb[1][2 * w] * bflo(cb2[w]) + wb[2][2 * w] * bflo(nb[w]) + bb[2 * w];
      const float b1 = wb[0][2 * w + 1] * bfhi(pb[w]) + wb[1][2 * w + 1] * bfhi(cb2[w]) + wb[2][2 * w + 1] * bfhi(nb[w]) + bb[2 * w + 1];
      ov[w] = pack2(geluf_(a0) * b0, geluf_(a1) * b1);
    }
    *(u4v*)(WS_act + (size_t)(row0 + r) * 2816 + j0) = ov;
    pa = ca; pb = cb2; ca = na; cb2 = nb;
  }
}

__device__ __forceinline__ void p5_item(const Params& p, char* smem, int l, int item, bool do_stats = true) {
  const int mt = item & 63, nt = item >> 6;
  const int m0 = mt * 128, n0 = nt * 128;
  const int tid = ltid(), lane = tid & 63, wave = tid >> 6, wm = wave >> 1, wn = wave & 1;
  f16v acc[2][2];
  gemm_mainloop0(smem, WS_act, 2816, WS_Wt + WT_LAYER * l + WT_DOWN, 2816, 2816, m0, n0, acc);
  const int ci = cond_of_row(m0);
  const float* g2 = WS_mod + (l * 5 + ci) * 6144 + 5 * 1024;
  const float* st1 = WS_stats + (size_t)(l * 2 + 0) * TALL * 2;
  float* st2 = WS_stats + (size_t)(l * 2 + 1) * TALL * 2;
  const int c0 = EPI_COL(0), c1 = EPI_COL(1);
  const float g2a = g2[c0], g2b = g2[c1];
  const float lga = p.ln1_g[l * 1024 + c0], lgb = p.ln1_g[l * 1024 + c1];
  const float lba = p.ln1_b[l * 1024 + c0], lbb = p.ln1_b[l * 1024 + c1];
#pragma unroll
  for (int mi = 0; mi < 2; ++mi)
#pragma unroll
    for (int reg = 0; reg < 16; ++reg) {
      const int row = EPI_ROW(mi, reg);
      const float s = st1[row * 2], q = st1[row * 2 + 1];
      const float mu = s * (1.f / 1024.f);
      const float rstd = rsqrtf(fmaxf(q * (1.f / 1024.f) - mu * mu, 0.f) + LNEPS);
      const float xa = (WS_pre1[(size_t)row * 1024 + c0] - mu) * rstd * lga + lba;
      const float xb = (WS_pre1[(size_t)row * 1024 + c1] - mu) * rstd * lgb + lbb;
      const float va = ALPHA * xa + g2a * acc[mi][0][reg];
      const float vb = ALPHA * xb + g2b * acc[mi][1][reg];
      p.out[(size_t)row * 1024 + c0] = va;
      p.out[(size_t)row * 1024 + c1] = vb;
      if (do_stats) stats_accum(st2, row, va, vb, lane);
    }
}

__device__ __forceinline__ void final_item(const Params& p, int item) {
  const float* st = WS_stats + (size_t)(1 * 2 + 1) * TALL * 2;
  const int c = ltid() * 4;
  const float4 g = *(const float4*)(p.ln2_g + 1024 + c);
  const float4 b = *(const float4*)(p.ln2_b + 1024 + c);
  for (int r = 0; r < 8; ++r) {
    const int row = item * 8 + r;
    const float s = st[row * 2], q = st[row * 2 + 1];
    const float mu = s * (1.f / 1024.f);
    const float rstd = rsqrtf(fmaxf(q * (1.f / 1024.f) - mu * mu, 0.f) + LNEPS);
    float4 v = *(float4*)(p.out + (size_t)row * 1024 + c);
    v.x = (v.x - mu) * rstd * g.x + b.x;
    v.y = (v.y - mu) * rstd * g.y + b.y;
    v.z = (v.z - mu) * rstd * g.z + b.z;
    v.w = (v.w - mu) * rstd * g.w + b.w;
    *(float4*)(p.out + (size_t)row * 1024 + c) = v;
  }
}

#define XB_TMO      128
#define XB_XCNT(j)  (256  + 64 * (j))
#define XB_XSUB(j)  (1280 + 64 * (j))
#define XB_XGEN(j)  (2304 + 64 * (j))
#define XB_TOP      3328
#define XB_TOPGEN   3392
#define XCD_BAR_WORDS 3456
#define XB_SPIN_CAP (1u << 18)
#define LAS __attribute__((address_space(3)))

__device__ __forceinline__ unsigned xb_ld(unsigned* p)              { return __hip_atomic_load(p, __ATOMIC_RELAXED, __HIP_MEMORY_SCOPE_AGENT); }
__device__ __forceinline__ unsigned xb_add(unsigned* p, unsigned v) { return __hip_atomic_fetch_add(p, v, __ATOMIC_RELAXED, __HIP_MEMORY_SCOPE_AGENT); }
__device__ __forceinline__ unsigned xb_xcc_id() { return (unsigned)__builtin_amdgcn_s_getreg((3 << 11) | 20) & 0xFu; }
#define XB_SPIN(cond, bar) do { unsigned _sp = 0; while (cond) { __builtin_amdgcn_s_sleep(1); \
    if ((++_sp & 255u) == 0u) { if (xb_ld(&(bar)[XB_TMO])) break; if (_sp > XB_SPIN_CAP) { atomicAdd(&(bar)[XB_TMO], 1u); break; } } } } while (0)

struct XcdBarrier {
    unsigned* bar; unsigned x;
    volatile LAS unsigned* st;
};

__device__ __forceinline__ XcdBarrier xcd_barrier_post(unsigned* bar, volatile LAS unsigned* st) {
    XcdBarrier b; b.bar = bar; b.x = xb_xcc_id(); b.st = st;
    if (threadIdx.x == 0) (void)xb_add(&bar[XB_XCNT(b.x)], 1u);
    return b;
}
__device__ __forceinline__ void xcd_barrier_complete(unsigned* bar, unsigned x, unsigned& nloc, unsigned& nx) {
    const unsigned G = gridDim.x * gridDim.y * gridDim.z;
    unsigned sum, cnt, mine, sp = 0u;
    for (;;) {
        sum = 0u; cnt = 0u; mine = 0u;
#pragma unroll
        for (unsigned j = 0; j < 16; ++j) { const unsigned c = xb_ld(&bar[XB_XCNT(j)]); sum += c; cnt += (c > 0u) ? 1u : 0u; mine = (j == x) ? c : mine; }
        if (sum == G) break;
        __builtin_amdgcn_s_sleep(1);
        if ((++sp & 255u) == 0u) { if (xb_ld(&bar[XB_TMO])) break; if (sp > XB_SPIN_CAP) { atomicAdd(&bar[XB_TMO], 1u); break; } }
    }
    nloc = mine > 0u ? mine : 1u; nx = cnt > 0u ? cnt : 1u;
}

__device__ __forceinline__ void xcd_barrier(const XcdBarrier& b) {
    asm volatile("s_waitcnt vmcnt(0)" ::: "memory");
    __syncthreads();
    if (threadIdx.x == 0) {
        unsigned* bar = b.bar;
        __builtin_amdgcn_s_waitcnt(0);
        unsigned nloc = b.st[0], nx = b.st[1];
        if (nloc == 0u) { xcd_barrier_complete(bar, b.x, nloc, nx); b.st[0] = nloc; b.st[1] = nx; }
        const unsigned old = xb_add(&bar[XB_XSUB(b.x)], 1u);
        const unsigned gen = old / nloc;
        if (old + 1u == (gen + 1u) * nloc) {
            __builtin_amdgcn_fence(__ATOMIC_RELEASE, "agent");
            asm volatile("s_waitcnt vmcnt(0)" ::: "memory");
            const unsigned og = xb_add(&bar[XB_TOP], 1u);
            const unsigned tg = og / nx;
            if (og + 1u == (tg + 1u) * nx) xb_add(&bar[XB_TOPGEN], 1u);
            else XB_SPIN(xb_ld(&bar[XB_TOPGEN]) == tg, bar);
            __builtin_amdgcn_fence(__ATOMIC_ACQUIRE, "agent");
            xb_add(&bar[XB_XGEN(b.x)], 1u);
            asm volatile("s_waitcnt vmcnt(0)" ::: "memory");
        } else {
            XB_SPIN(xb_ld(&bar[XB_XGEN(b.x)]) == gen, bar);
            __builtin_amdgcn_fence(__ATOMIC_ACQUIRE, "agent");
            asm volatile("s_waitcnt vmcnt(0)" ::: "memory");
        }
    }
    __syncthreads();
}


#define NPHASES 22
#ifndef REPMASK
#define REPMASK 0
#endif
#define REPS(PH) (((PH) == 0 ? (REPMASK >> 10) : (PH) == 21 ? (REPMASK >> 11) : (REPMASK >> (((PH) - 1) % 10))) & 1)
#define RUN_PHASE(PH, N, CALL)                                              \
  if (ph_lo <= (PH) && (PH) < ph_hi) {                                      \
    for (int rep_ = 0; rep_ <= REPS(PH); ++rep_)                            \
    for (int it = blockIdx.x; it < (N); it += nb) { CALL; }                 \
    if ((PH) + 1 < ph_hi) xcd_barrier(xb);                                  \
  }
#define RUN_GEMM_PHASE(PH, NT, CALL)                                                          \
  if (ph_lo <= (PH) && (PH) < ph_hi) {                                                        \
    const int xcd_ = blockIdx.x & 7, slot_ = blockIdx.x >> 3, spx_ = (int)gridDim.x >> 3;      \
    const int nsuper_ = 8 * (((NT) + 7) >> 3);                                                \
    for (int rep_ = 0; rep_ <= REPS(PH); ++rep_)                                              \
    for (int s_ = xcd_; s_ < nsuper_; s_ += 8)                                                \
      for (int j_ = slot_; j_ < 64; j_ += spx_) {                                             \
        const int mt_ = (s_ & 7) * 8 + (j_ & 7), nt_ = (s_ >> 3) * 8 + (j_ >> 3);             \
        if (nt_ < (NT)) { const int it = nt_ * 64 + mt_; CALL; }                              \
      }                                                                                       \
    if ((PH) + 1 < ph_hi) xcd_barrier(xb);                                                    \
  }
#define RUN_LAYER(L)                                                         \
  RUN_PHASE(1 + 10 * (L) + 0, 1024, hmat_item(p, (L), 0, it))                \
  RUN_GEMM_PHASE(1 + 10 * (L) + 1, 56, p1_item(p, smem, (L), it))            \
  RUN_PHASE(1 + 10 * (L) + 2, MX_ITEMS, mixer_item(p, smem, (L), it))        \
  RUN_GEMM_PHASE(1 + 10 * (L) + 3, 4, p3a_item(p, smem, (L), it))            \
  RUN_GEMM_PHASE(1 + 10 * (L) + 4, 8, p3b_item(p, smem, (L), it))            \
  RUN_GEMM_PHASE(1 + 10 * (L) + 5, 8, p3c_item(p, smem, (L), it, rep_ == 0)) \
  RUN_PHASE(1 + 10 * (L) + 6, 1024, hmat_item(p, (L), 1, it))                \
  RUN_GEMM_PHASE(1 + 10 * (L) + 7, 44, p4_item(p, smem, (L), it))            \
  RUN_PHASE(1 + 10 * (L) + 8, 512, p4b_item(p, (L), it))                     \
  RUN_GEMM_PHASE(1 + 10 * (L) + 9, 8, p5_item(p, smem, (L), it, rep_ == 0))

__global__ void __launch_bounds__(256, 2) mega(Params p, int ph_lo, int ph_hi) {
  extern __shared__ __attribute__((aligned(16))) char smem[];
  __shared__ uint4 xb_words;
  const int nb = gridDim.x;
  if (threadIdx.x == 0) xb_words = make_uint4(0u, 0u, 0u, 0u);
  __syncthreads();
  XcdBarrier xb;
  xb.bar = (unsigned*)(p.ws + OFF_bar); xb.x = 0; xb.st = (volatile LAS unsigned*)&xb_words;
  if (ph_hi - ph_lo > 1) xb = xcd_barrier_post((unsigned*)(p.ws + OFF_bar), (volatile LAS unsigned*)&xb_words);
  if (ph_hi > 1000) cg::this_grid().sync();
  RUN_PHASE(0, P0_ITEMS, phase0_item(p, smem, it))
  RUN_LAYER(0)
  RUN_LAYER(1)
  RUN_PHASE(21, 1024, final_item(p, it))
}

extern "C" void kernel_launch(void* const* d_in, const int* in_sizes, int n_in, void* d_out, int out_size, void* d_ws,
                              size_t ws_size, hipStream_t stream) {
  Params p{};
  const float** ins = (const float**)&p;
  for (int i = 0; i < 32; ++i) ins[i] = (const float*)d_in[i];
  p.out = (float*)d_out;
  char* ws = (char*)d_ws;
  p.ws = ws;
  if (WS_TOTAL > ws_size) {
    fprintf(stderr, "kernel_launch: workspace too small (%zu needed, %zu given)\n", (size_t)WS_TOTAL, ws_size);
    return;
  }
  (void)hipMemsetAsync(ws, 0, ZERO_BYTES, stream);
#if SINGLE_LAUNCH
  static int grid_blocks = 0;
  if (!grid_blocks) {
    int dev = 0, cus = 0, per_cu = 0;
    (void)hipGetDevice(&dev);
    (void)hipDeviceGetAttribute(&cus, hipDeviceAttributeMultiprocessorCount, dev);
    (void)hipFuncSetAttribute((const void*)mega, hipFuncAttributeMaxDynamicSharedMemorySize, LDS_BYTES);
    (void)hipOccupancyMaxActiveBlocksPerMultiprocessor(&per_cu, mega, 256, LDS_BYTES);
    if (per_cu > 2) per_cu = 2;
    if (per_cu < 1) per_cu = 1;
    grid_blocks = cus * per_cu;
  }
  int lo = 0, hi = NPHASES;
  void* args[] = {&p, &lo, &hi};
  hipError_t e = hipLaunchCooperativeKernel((void*)mega, dim3(grid_blocks), dim3(256), args, LDS_BYTES, stream);
  if (e != hipSuccess) fprintf(stderr, "cooperative launch failed: %s (grid %d)\n", hipGetErrorString(e), grid_blocks);
#else
  for (int ph = 0; ph < NPHASES; ++ph) {
    hipLaunchKernelGGL(mega, dim3(512), dim3(256), LDS_BYTES, stream, p, ph, ph + 1);
  }
#endif
}
```

```cpp
#include <hip/hip_runtime.h>
#include <hip/hip_cooperative_groups.h>
#include <cstdio>
namespace cg = cooperative_groups;

#ifndef SINGLE_LAUNCH
#define SINGLE_LAUNCH 1
#endif

typedef __attribute__((ext_vector_type(8))) short s8v;
typedef __attribute__((ext_vector_type(4))) float f4v;
typedef __attribute__((ext_vector_type(16))) float f16v;
typedef unsigned short u16;
typedef __attribute__((ext_vector_type(4))) unsigned u4v;
__device__ __forceinline__ s8v bc8(u4v x) { return __builtin_bit_cast(s8v, x); }


#define TALL 8192
#define TCTX 4096
#define ALPHA 1.41421356237309515f
#define LNEPS 1e-5f
#define VTR_LAT 2097152
#define NVT_LAT 2097152
#define OUT_SRET 8388608
#define OUT_SSSM 12582912
#define OUT_CK 12845056
#define OUT_CV 17039360
#define WT_IN 0
#define WT_GLU (WT_IN + 7168 * 1024)
#define WT_BR (WT_GLU + 512 * 512)
#define WT_O (WT_BR + 3 * 1024 * 512)
#define WT_UP (WT_O + 1024 * 1024)
#define WT_DOWN (WT_UP + 5632 * 1024)
#define WT_LAYER ((size_t)(WT_DOWN + 1024 * 2816))

struct Params {
  const float *x_prompt, *x_sample, *state_ret, *state_ssm, *cache_k, *cache_v, *c, *c_ctx;
  const float *w_ada, *b_ada, *w_in, *ret_decay, *a_re, *a_im, *log_dt, *b_re, *b_im, *c_re, *c_im;
  const float *ssm_d, *w_glu, *rpb, *w_branch, *w_o, *ln1_g, *ln1_b, *w_up, *conv_w, *conv_b, *w_down, *ln2_g, *ln2_b;
  float* out;
  char* ws;
};

typedef __bf16 bf2v __attribute__((ext_vector_type(2)));
typedef float fl2v __attribute__((ext_vector_type(2)));
__device__ __forceinline__ unsigned pack2(float a, float b) {
  fl2v f = {a, b};
  bf2v h = __builtin_convertvector(f, bf2v);
  return __builtin_bit_cast(unsigned, h);
}
__device__ __forceinline__ u16 f2bf(float f) { return (u16)(pack2(f, 0.f) & 0xffffu); }

constexpr size_t al256(size_t x) { return (x + 255) & ~(size_t)255; }
constexpr size_t EB = (size_t)TALL * 512 * 2;
constexpr size_t OFF_mod = 0;
constexpr size_t OFF_stats = OFF_mod + al256(2 * 5 * 6144 * 4);
constexpr size_t OFF_bar = OFF_stats + al256(2 * 2 * TALL * 2 * 4);
constexpr size_t ZERO_BYTES = OFF_bar + al256(3456 * 4);
constexpr size_t OFF_ropetab = ZERO_BYTES;
constexpr size_t OFF_abar = OFF_ropetab + al256(64 * 32 * 2 * 4);
constexpr size_t OFF_bbarT = OFF_abar + al256(2 * 2 * 32 * 64 * 2 * 4);
constexpr size_t OFF_cmT = OFF_bbarT + al256(2 * 2 * 32 * 128 * 16 * 2);
constexpr size_t OFF_CK = OFF_cmT + al256(2 * 2 * 32 * 16 * 128 * 2);
constexpr size_t OFF_CVt = OFF_CK + al256((size_t)2 * 4 * 512 * 512 * 2);
constexpr size_t OFF_S0t = OFF_CVt + al256((size_t)2 * 4 * 512 * 512 * 2);
constexpr size_t OFF_Wt = OFF_S0t + al256((size_t)2 * 4 * 2 * 4 * 128 * 128 * 2);
constexpr size_t OFF_REGION = OFF_Wt + al256(2 * WT_LAYER * 2);
constexpr size_t OFF_z2 = OFF_REGION;
constexpr size_t OFF_act = OFF_z2 + (size_t)TALL * 5632 * 2;
constexpr size_t OFF_pre1 = OFF_act + (size_t)TALL * 2816 * 2;
constexpr size_t WS_TOTAL = OFF_pre1 + (size_t)TALL * 1024 * 4;
constexpr size_t OFF_K = OFF_pre1;
constexpr size_t OFF_VtR = OFF_K + EB;
constexpr size_t OFF_NQ = OFF_VtR + EB;
constexpr size_t OFF_NK = OFF_NQ + EB;
constexpr size_t OFF_GT = OFF_REGION;
constexpr size_t OFF_rout = OFF_GT + (size_t)TALL * 3072 * 2;
constexpr size_t OFF_nout = OFF_rout + EB;
constexpr size_t OFF_YD = OFF_nout + EB;
constexpr size_t OFF_merged = OFF_YD;
constexpr size_t OFF_Q = OFF_YD + 2 * EB;
constexpr size_t OFF_sout = OFF_Q;
constexpr size_t OFF_KtR = OFF_Q + EB;
constexpr size_t OFF_G = OFF_KtR + EB / 2;
constexpr size_t OFF_SU = OFF_G + EB;
constexpr size_t OFF_NVt = OFF_SU + EB;
constexpr size_t OFF_h1 = OFF_NVt + EB;
constexpr size_t OFF_h2 = OFF_act;
static_assert(OFF_h1 + 2 * EB <= OFF_pre1, "mixer buffers overflow the z2+act area");
#define WS_h1 ((u16*)(p.ws + OFF_h1))
#define WS_h2 ((u16*)(p.ws + OFF_h2))
#define WS_mod ((float*)(p.ws + OFF_mod))
#define WS_stats ((float*)(p.ws + OFF_stats))
#define WS_ropetab ((float*)(p.ws + OFF_ropetab))
#define WS_abar ((float*)(p.ws + OFF_abar))
#define WS_pre1 ((float*)(p.ws + OFF_pre1))
#define WS_bbarT ((u16*)(p.ws + OFF_bbarT))
#define WS_cmT ((u16*)(p.ws + OFF_cmT))
#define WS_CK ((u16*)(p.ws + OFF_CK))
#define WS_CVt ((u16*)(p.ws + OFF_CVt))
#define WS_S0t ((u16*)(p.ws + OFF_S0t))
#define WS_Wt ((u16*)(p.ws + OFF_Wt))
#define WS_Q ((u16*)(p.ws + OFF_Q))
#define WS_K ((u16*)(p.ws + OFF_K))
#define WS_VtR ((u16*)(p.ws + OFF_VtR))
#define WS_KtR ((u16*)(p.ws + OFF_KtR))
#define WS_G ((u16*)(p.ws + OFF_G))
#define WS_SU ((u16*)(p.ws + OFF_SU))
#define WS_NQ ((u16*)(p.ws + OFF_NQ))
#define WS_NK ((u16*)(p.ws + OFF_NK))
#define WS_NVt ((u16*)(p.ws + OFF_NVt))
#define WS_GT ((u16*)(p.ws + OFF_GT))
#define WS_rout ((u16*)(p.ws + OFF_rout))
#define WS_sout ((u16*)(p.ws + OFF_sout))
#define WS_nout ((u16*)(p.ws + OFF_nout))
#define WS_YD ((u16*)(p.ws + OFF_YD))
#define WS_merged ((u16*)(p.ws + OFF_merged))
#define WS_z2 ((u16*)(p.ws + OFF_z2))
#define WS_act ((u16*)(p.ws + OFF_act))

__device__ __forceinline__ float bf2f(unsigned h) { return __uint_as_float((h & 0xffffu) << 16); }
__device__ __forceinline__ float bflo(unsigned w) { return __uint_as_float(w << 16); }
__device__ __forceinline__ float bfhi(unsigned w) { return __uint_as_float(w & 0xffff0000u); }
__device__ __forceinline__ float sigmoidf_(float x) { return 1.f / (1.f + __expf(-x)); }
__device__ __forceinline__ float siluf_(float x) { return x / (1.f + __expf(-x)); }
__device__ __forceinline__ float geluf_(float x) {
  float u = 0.7978845608028654f * (x + 0.044715f * x * x * x);
  float e = __expf(2.f * u);
  float t = 1.f - 2.f / (e + 1.f);
  return 0.5f * x * (1.f + t);
}
__device__ __forceinline__ f16v zero16() {
  return (f16v){0.f, 0.f, 0.f, 0.f, 0.f, 0.f, 0.f, 0.f, 0.f, 0.f, 0.f, 0.f, 0.f, 0.f, 0.f, 0.f};
}
__device__ __forceinline__ int ltid() { int t = threadIdx.x; asm volatile("" : "+v"(t)); return t; }
__device__ __forceinline__ int cond_of_row(int row) { return row < TCTX ? 0 : 1 + ((row - TCTX) >> 10); }

struct AArgs {
  const u16* A16; int lda;
  const float* A32lo; const float* A32hi;
  const float* stats;
  const float* lng; const float* lnb;
  const float* sc; const float* sh;
  const u16* SU; const u16* YD0; const u16* YD1; const float* dsk;
};

#define GST 72
#define LDS_GEMM (2 * 2 * 128 * GST * 2)
#define LDS_BYTES LDS_GEMM

template <int AMODE>
__device__ __forceinline__ void gemm_mainloop(char* smem, const AArgs& a, const u16* __restrict__ Bt, int ldb, int K,
                                              int m0, int n0, f16v (&acc)[2][2]) {
  u16* As = (u16*)smem;
  u16* Bs = As + 2 * 128 * GST;
  const int tid = ltid(), lane = tid & 63, wave = tid >> 6;
  const int wm = wave >> 1, wn = wave & 1;
  const int crow = tid >> 3, cch = tid & 7;
  const int frow = tid >> 4, fch = tid & 15;
  float rs[8], nm[8];
  const float* srow0 = nullptr;
  const float *gsc = nullptr, *gsh = nullptr;
  __syncthreads();
  if constexpr (AMODE == 1) {
    const int ci = cond_of_row(m0);
    gsc = a.sc + ci * 6144; gsh = a.sh + ci * 6144;
#pragma unroll
    for (int i = 0; i < 8; ++i) {
      rs[i] = 1.f; nm[i] = 0.f;
      if (a.stats) {
        const int row = m0 + frow + 16 * i;
        const float s = a.stats[row * 2], q = a.stats[row * 2 + 1];
        const float mu = s * (1.f / 1024.f);
        const float var = q * (1.f / 1024.f) - mu * mu;
        rs[i] = rsqrtf(fmaxf(var, 0.f) + LNEPS);
        nm[i] = -mu * rs[i];
      }
    }
    const int row0 = m0 + frow;
    srow0 = (row0 < TCTX ? a.A32lo + (size_t)row0 * 1024 : a.A32hi + (size_t)(row0 - TCTX) * 1024) + fch * 4;
  }
  acc[0][0] = zero16(); acc[0][1] = zero16(); acc[1][0] = zero16(); acc[1][1] = zero16();

  u4v ra[12], rb[4];
  float4 q0, q1, q2, q3;
  q0 = q1 = q3 = make_float4(0.f, 0.f, 0.f, 0.f); q2 = make_float4(1.f, 1.f, 1.f, 1.f);
  const u16* brow = Bt + (size_t)(n0 + crow) * ldb + cch * 8;
  auto issue = [&](int kt) {
    if constexpr (AMODE == 1) {
      const int k = kt * 64 + fch * 4;
      q0 = *(const float4*)(gsc + k); q1 = *(const float4*)(gsh + k);
      if (a.lng) { q2 = *(const float4*)(a.lng + k); q3 = *(const float4*)(a.lnb + k); }
    } else if constexpr (AMODE == 2) {
      const int k0 = kt * 64 + cch * 8;
      q0 = *(const float4*)(a.dsk + k0); q1 = *(const float4*)(a.dsk + k0 + 4);
    }
    if constexpr (AMODE == 0) {
      const u16* ap = a.A16 + (size_t)(m0 + crow) * a.lda + kt * 64 + cch * 8;
#pragma unroll
      for (int i = 0; i < 4; ++i) ra[i] = *(const u4v*)(ap + (size_t)(32 * i) * a.lda);
    } else if constexpr (AMODE == 1) {
#pragma unroll
      for (int i = 0; i < 8; ++i) ra[i] = *(const u4v*)(srow0 + (size_t)(16 * i) * 1024 + kt * 64);
    } else {
      const size_t o = (size_t)(m0 + crow) * 512 + kt * 64 + cch * 8;
#pragma unroll
      for (int i = 0; i < 4; ++i) {
        ra[i] = *(const u4v*)(a.SU + o + (size_t)(32 * i) * 512);
        ra[4 + i] = *(const u4v*)(a.YD0 + o + (size_t)(32 * i) * 512);
        ra[8 + i] = *(const u4v*)(a.YD1 + o + (size_t)(32 * i) * 512);
      }
    }
#pragma unroll
    for (int i = 0; i < 4; ++i) rb[i] = *(const u4v*)(brow + (size_t)(32 * i) * ldb + kt * 64);
  };
  auto stage = [&](int buf, int kt) {
    u16* Ad = As + buf * (128 * GST);
    if constexpr (AMODE == 0) {
#pragma unroll
      for (int i = 0; i < 4; ++i) *(u4v*)(Ad + (crow + 32 * i) * GST + cch * 8) = ra[i];
    } else if constexpr (AMODE == 1) {
      const float4 sc = q0, sh = q1, g = q2, b = q3;
      const float G0 = g.x * (1.f + sc.x), G1 = g.y * (1.f + sc.y), G2 = g.z * (1.f + sc.z), G3 = g.w * (1.f + sc.w);
      const float B0 = fmaf(b.x, 1.f + sc.x, sh.x), B1 = fmaf(b.y, 1.f + sc.y, sh.y), B2 = fmaf(b.z, 1.f + sc.z, sh.z), B3 = fmaf(b.w, 1.f + sc.w, sh.w);
#pragma unroll
      for (int i = 0; i < 8; ++i) {
        const float h0 = fmaf(fmaf(__uint_as_float(ra[i][0]), rs[i], nm[i]), G0, B0);
        const float h1 = fmaf(fmaf(__uint_as_float(ra[i][1]), rs[i], nm[i]), G1, B1);
        const float h2 = fmaf(fmaf(__uint_as_float(ra[i][2]), rs[i], nm[i]), G2, B2);
        const float h3 = fmaf(fmaf(__uint_as_float(ra[i][3]), rs[i], nm[i]), G3, B3);
        *(uint2*)(Ad + (frow + 16 * i) * GST + fch * 4) = make_uint2(pack2(h0, h1), pack2(h2, h3));
      }
    } else {
      const float4 da = q0, db = q1;
      const float dd[8] = {da.x, da.y, da.z, da.w, db.x, db.y, db.z, db.w};
#pragma unroll
      for (int i = 0; i < 4; ++i) {
        u4v o;
#pragma unroll
        for (int j = 0; j < 4; ++j) {
          const float v0 = geluf_(dd[2 * j] * bflo(ra[i][j]) + bflo(ra[4 + i][j]) + bflo(ra[8 + i][j]));
          const float v1 = geluf_(dd[2 * j + 1] * bfhi(ra[i][j]) + bfhi(ra[4 + i][j]) + bfhi(ra[8 + i][j]));
          o[j] = pack2(v0, v1);
        }
        *(u4v*)(Ad + (crow + 32 * i) * GST + cch * 8) = o;
      }
    }
    u16* Bd = Bs + buf * (128 * GST);
#pragma unroll
    for (int i = 0; i < 4; ++i) *(u4v*)(Bd + (crow + 32 * i) * GST + cch * 8) = rb[i];
  };
  auto compute = [&](int buf) {
    const u16* Ab = As + buf * (128 * GST) + (wm * 64 + (lane & 31)) * GST + (lane >> 5) * 8;
    const u16* Bb = Bs + buf * (128 * GST) + (wn * 64 + (lane & 31)) * GST + (lane >> 5) * 8;
#pragma unroll
    for (int ks = 0; ks < 4; ++ks) {
      s8v af0 = *(const s8v*)(Ab + ks * 16);
      s8v af1 = *(const s8v*)(Ab + 32 * GST + ks * 16);
      s8v bf0 = *(const s8v*)(Bb + ks * 16);
      s8v bf1 = *(const s8v*)(Bb + 32 * GST + ks * 16);
      acc[0][0] = __builtin_amdgcn_mfma_f32_32x32x16_bf16(af0, bf0, acc[0][0], 0, 0, 0);
      acc[0][1] = __builtin_amdgcn_mfma_f32_32x32x16_bf16(af0, bf1, acc[0][1], 0, 0, 0);
      acc[1][0] = __builtin_amdgcn_mfma_f32_32x32x16_bf16(af1, bf0, acc[1][0], 0, 0, 0);
      acc[1][1] = __builtin_amdgcn_mfma_f32_32x32x16_bf16(af1, bf1, acc[1][1], 0, 0, 0);
    }
  };

  const int nk = K >> 6;
  issue(0);
  stage(0, 0);
  __syncthreads();
#pragma unroll 1
  for (int kt = 0; kt < nk; ++kt) {
    const int buf = kt & 1;
    if (kt + 1 < nk) issue(kt + 1);
    compute(buf);
    if (kt + 1 < nk) stage(buf ^ 1, kt + 1);
    __syncthreads();
  }
}

__device__ __forceinline__ void gemm_mainloop0(char* smem, const u16* __restrict__ A, int lda, const u16* __restrict__ Bt, int ldb,
                                               int K, int m0, int n0, f16v (&acc)[2][2]) {
  u16* As = (u16*)smem;
  u16* Bs = As + 2 * 128 * GST;
  const int tid = ltid(), lane = tid & 63, wave = tid >> 6;
  const int wm = wave >> 1, wn = wave & 1;
  const int crow = tid >> 3, cch = tid & 7;
  __syncthreads();
  acc[0][0] = zero16(); acc[0][1] = zero16(); acc[1][0] = zero16(); acc[1][1] = zero16();
  const u16* arow = A + (size_t)(m0 + crow) * lda + cch * 8;
  const u16* brow = Bt + (size_t)(n0 + crow) * ldb + cch * 8;
  const size_t a32 = (size_t)32 * lda, b32 = (size_t)32 * ldb;
  u4v eA0, eA1, eA2, eA3, eB0, eB1, eB2, eB3, oA0, oA1, oA2, oA3, oB0, oB1, oB2, oB3;
#define G0_ISSUE(P, kt)                                                                                   \
  { const u16* ap_ = arow + (kt) * 64; const u16* bp_ = brow + (kt) * 64;                                 \
    P##A0 = *(const u4v*)(ap_); P##A1 = *(const u4v*)(ap_ + a32); P##A2 = *(const u4v*)(ap_ + 2 * a32);   \
    P##A3 = *(const u4v*)(ap_ + 3 * a32);                                                                 \
    P##B0 = *(const u4v*)(bp_); P##B1 = *(const u4v*)(bp_ + b32); P##B2 = *(const u4v*)(bp_ + 2 * b32);   \
    P##B3 = *(const u4v*)(bp_ + 3 * b32); }
#define G0_STAGE(P, buf)                                                                                  \
  { u16* Ad_ = As + (buf) * (128 * GST) + crow * GST + cch * 8; u16* Bd_ = Bs + (buf) * (128 * GST) + crow * GST + cch * 8; \
    *(u4v*)(Ad_) = P##A0; *(u4v*)(Ad_ + 32 * GST) = P##A1; *(u4v*)(Ad_ + 64 * GST) = P##A2; *(u4v*)(Ad_ + 96 * GST) = P##A3; \
    *(u4v*)(Bd_) = P##B0; *(u4v*)(Bd_ + 32 * GST) = P##B1; *(u4v*)(Bd_ + 64 * GST) = P##B2; *(u4v*)(Bd_ + 96 * GST) = P##B3; }
#define G0_COMPUTE(buf)                                                                                   \
  { const u16* Ab = As + (buf) * (128 * GST) + (wm * 64 + (lane & 31)) * GST + (lane >> 5) * 8;           \
    const u16* Bb = Bs + (buf) * (128 * GST) + (wn * 64 + (lane & 31)) * GST + (lane >> 5) * 8;           \
    _Pragma("unroll") for (int ks = 0; ks < 4; ++ks) {                                                    \
      s8v af0 = *(const s8v*)(Ab + ks * 16);                                                              \
      s8v af1 = *(const s8v*)(Ab + 32 * GST + ks * 16);                                                   \
      s8v bf0 = *(const s8v*)(Bb + ks * 16);                                                              \
      s8v bf1 = *(const s8v*)(Bb + 32 * GST + ks * 16);                                                   \
      acc[0][0] = __builtin_amdgcn_mfma_f32_32x32x16_bf16(af0, bf0, acc[0][0], 0, 0, 0);                  \
      acc[0][1] = __builtin_amdgcn_mfma_f32_32x32x16_bf16(af0, bf1, acc[0][1], 0, 0, 0);                  \
      acc[1][0] = __builtin_amdgcn_mfma_f32_32x32x16_bf16(af1, bf0, acc[1][0], 0, 0, 0);                  \
      acc[1][1] = __builtin_amdgcn_mfma_f32_32x32x16_bf16(af1, bf1, acc[1][1], 0, 0, 0);                  \
    } }
  const int nk = K >> 6;
  G0_ISSUE(e, 0)
  G0_ISSUE(o, 1)
  G0_STAGE(e, 0)
  __syncthreads();
  int kt = 0;
#pragma unroll 1
  for (; kt + 3 < nk; kt += 2) {
    G0_ISSUE(e, kt + 2)
    __builtin_amdgcn_sched_barrier(0);
    G0_COMPUTE(0)
    G0_STAGE(o, 1)
    __syncthreads();
    G0_ISSUE(o, kt + 3)
    __builtin_amdgcn_sched_barrier(0);
    G0_COMPUTE(1)
    G0_STAGE(e, 0)
    __syncthreads();
  }
  G0_COMPUTE(0)
  G0_STAGE(o, 1)
  __syncthreads();
  G0_COMPUTE(1)
  __syncthreads();
#undef G0_ISSUE
#undef G0_STAGE
#undef G0_COMPUTE
}

#define EPI_ROW(mi, reg) (m0 + wm * 64 + (mi) * 32 + ((reg) & 3) + 8 * ((reg) >> 2) + 4 * (lane >> 5))
#define EPI_COL(ni) (n0 + wn * 64 + (ni) * 32 + (lane & 31))


#define CST 136
__device__ __forceinline__ void cs_store(const u16* Cs, u16* __restrict__ dst, size_t ld, int tid) {
#pragma unroll
  for (int i = 0; i < 8; ++i) {
    const int c = tid + 256 * i, r = c >> 4, ch = c & 15;
    *(u4v*)(dst + (size_t)r * ld + ch * 8) = *(const u4v*)(Cs + r * CST + ch * 8);
  }
}

__device__ __forceinline__ void stats_accum(float* stats, int row, float v0, float v1, int lane) {
  float s = v0 + v1, q = v0 * v0 + v1 * v1;
#pragma unroll
  for (int o = 1; o < 32; o <<= 1) {
    s += __shfl_xor(s, o);
    q += __shfl_xor(q, o);
  }
  if ((lane & 31) == 0) {
    atomicAdd(stats + row * 2, s);
    atomicAdd(stats + row * 2 + 1, q);
  }
}

#define P0_ADA 768
#define P0_ROPE 1
#define P0_CACHE 64
#define P0_S0 64
#define P0_S5 128
#define P0_WT_PER_LAYER (16 * 112 + 8 * 8 + 3 * 8 * 16 + 16 * 16 + 16 * 88 + 44 * 16)
#define P0_WT (2 * P0_WT_PER_LAYER)
#define P0_ITEMS (P0_ADA + P0_ROPE + P0_CACHE + P0_S0 + P0_S5 + P0_WT)

__device__ __forceinline__ void wt_tile(const float* __restrict__ src, int N, u16* __restrict__ dst, int ldd, int kt, int nt, char* smem) {
  float* tile = (float*)smem;
  const int tid = ltid();
  __syncthreads();
  {
    const int c4 = (tid & 15) * 4, r0 = tid >> 4;
#pragma unroll
    for (int i = 0; i < 4; ++i) {
      const int k = r0 + 16 * i;
      const float4 v = *(const float4*)(src + (size_t)(kt * 64 + k) * N + nt * 64 + c4);
      tile[k * 65 + c4] = v.x; tile[k * 65 + c4 + 1] = v.y; tile[k * 65 + c4 + 2] = v.z; tile[k * 65 + c4 + 3] = v.w;
    }
  }
  __syncthreads();
  {
    const int n = tid >> 2, k0 = (tid & 3) * 16;
#define WTP(j) pack2(tile[(k0 + 2 * (j)) * 65 + n], tile[(k0 + 2 * (j) + 1) * 65 + n])
    u4v* d = (u4v*)(dst + (size_t)(nt * 64 + n) * ldd + kt * 64 + k0);
    d[0] = (u4v){WTP(0), WTP(1), WTP(2), WTP(3)};
    d[1] = (u4v){WTP(4), WTP(5), WTP(6), WTP(7)};
#undef WTP
  }
}
__device__ __forceinline__ void wt_item(const Params& p, char* smem, int item) {
  const int l = item / P0_WT_PER_LAYER;
  int it = item % P0_WT_PER_LAYER;
  u16* base = WS_Wt + WT_LAYER * l;
  if (it < 16 * 112) { wt_tile(p.w_in + (size_t)l * 1024 * 7168, 7168, base + WT_IN, 1024, it / 112, it % 112, smem); return; }
  it -= 16 * 112;
  if (it < 64) { wt_tile(p.w_glu + (size_t)l * 512 * 512, 512, base + WT_GLU, 512, it / 8, it % 8, smem); return; }
  it -= 64;
  if (it < 384) { const int br = it / 128; it %= 128;
    wt_tile(p.w_branch + ((size_t)l * 3 + br) * 512 * 1024, 1024, base + WT_BR + (size_t)br * 512 * 1024, 512, it / 16, it % 16, smem); return; }
  it -= 384;
  if (it < 256) { wt_tile(p.w_o + (size_t)l * 1024 * 1024, 1024, base + WT_O, 1024, it / 16, it % 16, smem); return; }
  it -= 256;
  if (it < 16 * 88) { wt_tile(p.w_up + (size_t)l * 1024 * 5632, 5632, base + WT_UP, 1024, it / 88, it % 88, smem); return; }
  it -= 16 * 88;
  wt_tile(p.w_down + (size_t)l * 2816 * 1024, 1024, base + WT_DOWN, 2816, it / 16, it % 16, smem);
}

__device__ __forceinline__ void phase0_item(const Params& p, char* smem, int item) {
  const int tid = ltid();
  if (item < P0_ADA) {
    const int ks = item & 3, cg = (item >> 2) % 96, l = item / 384;
    float* scs = (float*)smem;
    float* red = scs + 5 * 256;
    __syncthreads();
    for (int i = tid; i < 5 * 256; i += 256) {
      int ci = i >> 8, k = ks * 256 + (i & 255);
      float v = ci == 0 ? p.c_ctx[k] : p.c[(ci - 1) * 1024 + k];
      scs[i] = siluf_(v);
    }
    __syncthreads();
    const int ct = tid & 15, kg = tid >> 4;
    const float* wp = p.w_ada + (size_t)l * 1024 * 6144 + (size_t)(ks * 256 + kg * 16) * 6144 + cg * 64 + ct * 4;
    float acc[5][4];
#pragma unroll
    for (int i = 0; i < 5; ++i)
#pragma unroll
      for (int j = 0; j < 4; ++j) acc[i][j] = 0.f;
#pragma unroll 4
    for (int k = 0; k < 16; ++k) {
      float4 w = *(const float4*)(wp + (size_t)k * 6144);
#pragma unroll
      for (int ci = 0; ci < 5; ++ci) {
        float s = scs[ci * 256 + kg * 16 + k];
        acc[ci][0] += s * w.x; acc[ci][1] += s * w.y; acc[ci][2] += s * w.z; acc[ci][3] += s * w.w;
      }
    }
#pragma unroll
    for (int ci = 0; ci < 5; ++ci)
#pragma unroll
      for (int j = 0; j < 4; ++j) red[(kg * 5 + ci) * 64 + ct * 4 + j] = acc[ci][j];
    __syncthreads();
    for (int i = tid; i < 320; i += 256) {
      int ci = i >> 6, col = i & 63;
      float s = 0.f;
#pragma unroll
      for (int g = 0; g < 16; ++g) s += red[(g * 5 + ci) * 64 + col];
      if (ks == 0) s += p.b_ada[l * 6144 + cg * 64 + col];
      atomicAdd(WS_mod + (l * 5 + ci) * 6144 + cg * 64 + col, s);
    }
    return;
  }
  item -= P0_ADA;
  if (item < P0_ROPE) {
    for (int i = tid; i < 64 * 32; i += 256) {
      int pos = i >> 5, fi = i & 31;
      float inv = (float)pow(10000.0, -(double)fi / 32.0);
      float ang = (float)pos * inv;
      WS_ropetab[i * 2] = (float)cos((double)ang);
      WS_ropetab[i * 2 + 1] = (float)sin((double)ang);
    }
    return;
  }
  item -= P0_ROPE;
  if (item < P0_CACHE) {
    const int pc = item & 7, b = (item >> 3) & 3, l = item >> 5;
    const float* ksrc = p.cache_k + ((size_t)(b * 2 + l) * 512 + pc * 64) * 512;
    const float* vsrc = p.cache_v + ((size_t)(b * 2 + l) * 512 + pc * 64) * 512;
    u16* kdst = WS_CK + ((size_t)(l * 4 + b) * 512 + pc * 64) * 512;
    for (int i = tid; i < 64 * 512 / 4; i += 256) {
      float4 v = *(const float4*)(ksrc + (size_t)i * 4);
      *(uint2*)(kdst + (size_t)i * 4) = make_uint2(pack2(v.x, v.y), pack2(v.z, v.w));
    }
    for (int cc = 0; cc < 2; ++cc) {
      const int col = tid + cc * 256;
      u16* vdst = WS_CVt + ((size_t)(l * 4 + b) * 512 + col) * 512 + pc * 64;
      for (int j = 0; j < 8; ++j) {
        float v[8];
#pragma unroll
        for (int e = 0; e < 8; ++e) v[e] = vsrc[(size_t)(j * 8 + e) * 512 + col];
        *(uint4*)(vdst + j * 8) = make_uint4(pack2(v[0], v[1]), pack2(v[2], v[3]), pack2(v[4], v[5]), pack2(v[6], v[7]));
      }
    }
    return;
  }
  item -= P0_CACHE;
  if (item < P0_S0) {
    const int hh = item & 3, dir = (item >> 2) & 1, b = (item >> 3) & 3, l = item >> 5;
    const float* src = p.state_ret + ((size_t)(((b * 2 + l) * 2 + dir) * 4 + hh)) * 16384;
    u16* dst = WS_S0t + ((size_t)(((l * 4 + b) * 2 + dir) * 4 + hh)) * 16384;
    const int dv = tid & 127, kh = tid >> 7;
    for (int j = 0; j < 8; ++j) {
      const int dk0 = kh * 64 + j * 8;
      float v[8];
#pragma unroll
      for (int e = 0; e < 8; ++e) v[e] = src[(size_t)(dk0 + e) * 128 + dv];
      *(uint4*)(dst + (size_t)dv * 128 + dk0) = make_uint4(pack2(v[0], v[1]), pack2(v[2], v[3]), pack2(v[4], v[5]), pack2(v[6], v[7]));
    }
    return;
  }
  item -= P0_S0;
  if (item >= P0_S5) { wt_item(p, smem, item - P0_S5); return; }
  {
    const int g = item & 31, dir = (item >> 5) & 1, l = item >> 6;
    if (tid < 64) {
      const int pp = tid;
      const int ai = ((l * 2 + dir) * 32 + g) * 64 + pp;
      double lre = fmin((double)p.a_re[ai], -1e-4), lim = (double)p.a_im[ai];
      double dt = exp((double)p.log_dt[(l * 2 + dir) * 32 + g]);
      double er = exp(lre * dt);
      double abr = er * cos(lim * dt), abi = er * sin(lim * dt);
      WS_abar[ai * 2] = (float)abr;
      WS_abar[ai * 2 + 1] = (float)abi;
      double nr = abr - 1.0, ni = abi;
      double den = lre * lre + lim * lim;
      double cr = (nr * lre + ni * lim) / den, cim = (ni * lre - nr * lim) / den;
      u16* bt = WS_bbarT + (size_t)((l * 2 + dir) * 32 + g) * 128 * 16;
      const float* br = p.b_re + ((size_t)(l * 32 + g) * 64 + pp) * 16;
      const float* bi = p.b_im + ((size_t)(l * 32 + g) * 64 + pp) * 16;
      for (int c = 0; c < 16; ++c) {
        double xr = br[c], xi = bi[c];
        bt[pp * 16 + c] = f2bf((float)(cr * xr - cim * xi));
        bt[(64 + pp) * 16 + c] = f2bf((float)(cr * xi + cim * xr));
      }
      u16* ct = WS_cmT + (size_t)((l * 2 + dir) * 32 + g) * 16 * 128;
      const float* cre = p.c_re + ((size_t)((l * 2 + dir) * 32 + g) * 16) * 64;
      const float* cie = p.c_im + ((size_t)((l * 2 + dir) * 32 + g) * 16) * 64;
      for (int c = 0; c < 16; ++c) {
        ct[c * 128 + pp] = f2bf(cre[c * 64 + pp]);
        ct[c * 128 + 64 + pp] = f2bf(-cie[c * 64 + pp]);
      }
    }
  }
}


__device__ __forceinline__ void hmat_item(const Params& p, int l, int which, int item) {
  const int c = ltid() * 4;
  const int row0 = item * 8;
  const int ci = cond_of_row(row0);
  const float* mod = WS_mod + (l * 5 + ci) * 6144;
  const float4 sc = *(const float4*)(mod + (which ? 4 : 1) * 1024 + c);
  const float4 sh = *(const float4*)(mod + (which ? 3 : 0) * 1024 + c);
  float4 g = make_float4(1.f, 1.f, 1.f, 1.f), b = make_float4(0.f, 0.f, 0.f, 0.f);
  const float* st = nullptr;
  if (which == 1) { g = *(const float4*)(p.ln1_g + l * 1024 + c); b = *(const float4*)(p.ln1_b + l * 1024 + c); st = WS_stats + (size_t)(l * 2 + 0) * TALL * 2; }
  else if (l == 1) { g = *(const float4*)(p.ln2_g + c); b = *(const float4*)(p.ln2_b + c); st = WS_stats + (size_t)(0 * 2 + 1) * TALL * 2; }
  const float G0 = g.x * (1.f + sc.x), G1 = g.y * (1.f + sc.y), G2 = g.z * (1.f + sc.z), G3 = g.w * (1.f + sc.w);
  const float B0 = fmaf(b.x, 1.f + sc.x, sh.x), B1 = fmaf(b.y, 1.f + sc.y, sh.y), B2 = fmaf(b.z, 1.f + sc.z, sh.z), B3 = fmaf(b.w, 1.f + sc.w, sh.w);
  u16* dst = which ? WS_h2 : WS_h1;
#pragma unroll
  for (int r = 0; r < 8; ++r) {
    const int row = row0 + r;
    const float* src;
    if (which == 1) src = WS_pre1 + (size_t)row * 1024;
    else if (l == 1) src = p.out + (size_t)row * 1024;
    else src = row < TCTX ? p.x_prompt + (size_t)row * 1024 : p.x_sample + (size_t)(row - TCTX) * 1024;
    float rs = 1.f, nm = 0.f;
    if (st) {
      const float s = st[row * 2], q = st[row * 2 + 1];
      const float mu = s * (1.f / 1024.f);
      rs = rsqrtf(fmaxf(q * (1.f / 1024.f) - mu * mu, 0.f) + LNEPS);
      nm = -mu * rs;
    }
    const float4 x = *(const float4*)(src + c);
    const float h0 = fmaf(fmaf(x.x, rs, nm), G0, B0), h1 = fmaf(fmaf(x.y, rs, nm), G1, B1);
    const float h2 = fmaf(fmaf(x.z, rs, nm), G2, B2), h3 = fmaf(fmaf(x.w, rs, nm), G3, B3);
    *(uint2*)(dst + (size_t)row * 1024 + c) = make_uint2(pack2(h0, h1), pack2(h2, h3));
  }
}

__device__ __forceinline__ void p1_item(const Params& p, char* smem, int l, int item) {
  const int mt = item & 63, nt = item >> 6;
  const int m0 = mt * 128, n0 = nt * 128;
  const int tid = ltid(), lane = tid & 63, wave = tid >> 6, wm = wave >> 1, wn = wave & 1;
  f16v acc[2][2];
  gemm_mainloop0(smem, WS_h1, 1024, WS_Wt + WT_LAYER * l + WT_IN, 1024, 1024, m0, n0, acc);

  const bool latent = m0 >= TCTX;
  const int seg = n0 >> 9;
  const int cs0 = n0 & 511;
  const int l31 = lane & 31;
  u16* Cs = (u16*)smem;
  u16* CsT = Cs + 128 * CST;
  const int rl0 = wm * 64 + 4 * (lane >> 5);
  const int cl0 = wn * 64 + l31;
  const bool want_rm = !(seg == 2 || seg == 7);
  const bool want_t = (seg == 2 || seg == 7 || (seg == 1 && !latent));
#pragma unroll
  for (int mi = 0; mi < 2; ++mi)
#pragma unroll
    for (int q = 0; q < 4; ++q) {
      float o0[4], o1[4];
#pragma unroll
      for (int j = 0; j < 4; ++j) {
        const int reg = q * 4 + j;
        float x1 = acc[mi][0][reg], x2 = acc[mi][1][reg];
        if (seg <= 1) {
          if (latent) {
            const int pos = (m0 - TCTX + rl0 + mi * 32 + q * 8 + j) & 1023;
            const int pidx = ((cs0 + wn * 64) & 64) ? (pos & 63) : (pos >> 6);
            const float cs = WS_ropetab[(pidx * 32 + l31) * 2], sn = WS_ropetab[(pidx * 32 + l31) * 2 + 1];
            const float t1 = x1 * cs - x2 * sn, t2 = x1 * sn + x2 * cs;
            x1 = t1; x2 = t2;
          }
          if (seg == 1) { x1 *= 0.08838834764831845f; x2 *= 0.08838834764831845f; }
        } else if (seg == 3) { x1 = siluf_(x1); x2 = siluf_(x2); }
        else if (seg == 5) { x1 *= 0.125f; x2 *= 0.125f; }
        else if (seg >= 8) { x1 = sigmoidf_(x1); x2 = sigmoidf_(x2); }
        o0[j] = x1; o1[j] = x2;
        if (want_rm) {
          const int rl = rl0 + mi * 32 + q * 8 + j;
          Cs[rl * CST + cl0] = f2bf(x1);
          Cs[rl * CST + cl0 + 32] = f2bf(x2);
        }
        if ((seg == 6 || seg == 7) && !latent) {
          const int row = m0 + rl0 + mi * 32 + q * 8 + j;
          float* o = p.out + (seg == 6 ? OUT_CK : OUT_CV) + ((size_t)((row >> 8) * 2 + l) * 256 + (row & 255)) * 512 + cs0 + cl0;
          o[0] = acc[mi][0][reg]; o[32] = acc[mi][1][reg];
        }
      }
      if (want_t) {
        const int rl = rl0 + mi * 32 + q * 8;
        *(uint2*)(CsT + cl0 * CST + rl) = make_uint2(pack2(o0[0], o0[1]), pack2(o0[2], o0[3]));
        *(uint2*)(CsT + (cl0 + 32) * CST + rl) = make_uint2(pack2(o1[0], o1[1]), pack2(o1[2], o1[3]));
      }
    }
  __syncthreads();
  if (want_rm) {
    u16* dst;
    size_t ld = 512;
    if (seg >= 8) { dst = WS_GT + (size_t)m0 * 3072 + (n0 - 4096); ld = 3072; }
    else {
      u16* base = seg == 0 ? WS_Q : seg == 1 ? WS_K : seg == 3 ? WS_G : seg == 4 ? WS_SU : seg == 5 ? WS_NQ : WS_NK;
      dst = base + (size_t)m0 * 512 + cs0;
    }
    cs_store(Cs, dst, ld, tid);
  }
  if (want_t) {
    u16* base = seg == 2 ? WS_VtR : seg == 7 ? WS_NVt : WS_KtR;
    u16* dst;
    size_t ld;
    if (!latent) { dst = base + ((size_t)(m0 >> 8) * 512 + cs0) * 256 + (m0 & 255); ld = 256; }
    else { dst = base + VTR_LAT + ((size_t)((m0 - TCTX) >> 10) * 512 + cs0) * 1024 + ((m0 - TCTX) & 1023); ld = 1024; }
    cs_store(CsT, dst, ld, tid);
  }
}

template <int D, int MODE>
__device__ __forceinline__ void attn_item(const Params& p, char* smem, int l, int idx) {
  constexpr int KSTR = D + 8;
  constexpr int NKS = D / 32;
  constexpr int NB = D / 16;
  constexpr int NCH = D / 32;
  u16* Ks = (u16*)smem;
  u16* Vts = Ks + 64 * KSTR;
  float* rpbs = (float*)(Vts + D * 72);
  const int tid = ltid(), lane = tid & 63, wave = tid >> 6;
  const int l15 = lane & 15, g = lane >> 4;

  int b, hh, qt, L, tokbase, nt;
  bool latent = false;
  int kr0 = 0, rrow = 0;
  if constexpr (MODE == 0) {
    if (idx < 256) { latent = true; b = idx >> 6; hh = (idx >> 4) & 3; qt = idx & 15; L = 1024; tokbase = TCTX + b * 1024; nt = 16 + 4; }
    else { idx -= 256; b = idx >> 4; hh = (idx >> 2) & 3; qt = idx & 3; L = 256; tokbase = b * 256; nt = 4; }
  } else if constexpr (MODE == 1) {
    b = idx >> 5; hh = (idx >> 2) & 7; qt = idx & 3; L = 256; tokbase = b * 256; nt = 4;
  } else {
    b = idx >> 7; hh = (idx >> 4) & 7; qt = idx & 15; rrow = qt; L = 1024; tokbase = TCTX + b * 1024; nt = 16; latent = true;
    kr0 = min(max(rrow - 4, 0), 8);
  }
  const int tq = qt * 64 + wave * 16 + l15;
  const int qtok = tokbase + tq;

  float lgf2 = 0.f, lgb2 = 0.f;
  if constexpr (MODE == 0) {
    float xf = p.ret_decay[(l * 2 + 0) * 4 + hh], xb = p.ret_decay[(l * 2 + 1) * 4 + hh];
    lgf2 = -log1pf(expf(-xf)) * 1.4426950408889634f;
    lgb2 = -log1pf(expf(-xb)) * 1.4426950408889634f;
  }

  __syncthreads();
  if constexpr (MODE == 2) {
    for (int i = tid; i < 465; i += 256) rpbs[i] = p.rpb[(size_t)(l * 8 + hh) * 465 + i];
  }

  u4v qf[NKS];
  {
    const u16* qb = (MODE == 0 ? WS_Q : WS_NQ) + (size_t)qtok * 512 + hh * D + g * 8;
#pragma unroll
    for (int ks = 0; ks < NKS; ++ks) qf[ks] = *(const u4v*)(qb + ks * 32);
  }

  f4v ot[NB];
#pragma unroll
  for (int nb = 0; nb < NB; ++nb) ot[nb] = (f4v){0.f, 0.f, 0.f, 0.f};
  float mrun = -1e30f, lsum = 0.f;

  const int ntk = (MODE == 0) ? (L >> 6) : nt;
  u4v kr[NCH], vr[NCH];
#define ATTN_ISSUE(KT)                                                                                   \
  {                                                                                                      \
    const int kt_ = (KT);                                                                                \
    const u16* kp; const u16* vp; int ldv;                                                               \
    if constexpr (MODE == 0) {                                                                           \
      kp = WS_K + (size_t)(tokbase + kt_ * 64) * 512 + hh * 128;                                          \
      if (latent) { vp = WS_VtR + VTR_LAT + ((size_t)(b * 4 + hh) * 128) * 1024 + kt_ * 64; ldv = 1024; } \
      else { vp = WS_VtR + ((size_t)(b * 4 + hh) * 128) * 256 + kt_ * 64; ldv = 256; }                    \
    } else if constexpr (MODE == 1) {                                                                    \
      kp = WS_NK + (size_t)(tokbase + kt_ * 64) * 512 + hh * 64;                                          \
      vp = WS_NVt + ((size_t)(b * 8 + hh) * 64) * 256 + kt_ * 64; ldv = 256;                              \
    } else {                                                                                             \
      if (kt_ < 8) {                                                                                     \
        const int krow = kr0 + kt_;                                                                      \
        kp = WS_NK + (size_t)(tokbase + krow * 64) * 512 + hh * 64;                                       \
        vp = WS_NVt + NVT_LAT + ((size_t)(b * 8 + hh) * 64) * 1024 + krow * 64; ldv = 1024;               \
      } else {                                                                                           \
        kp = WS_CK + ((size_t)(l * 4 + b) * 512 + (kt_ - 8) * 64) * 512 + hh * 64;                        \
        vp = WS_CVt + ((size_t)((l * 4 + b) * 8 + hh) * 64) * 512 + (kt_ - 8) * 64; ldv = 512;            \
      }                                                                                                  \
    }                                                                                                    \
    _Pragma("unroll") for (int i = 0; i < NCH; ++i) {                                                    \
      const int c = tid + 256 * i;                                                                       \
      const int r = c / (D / 8), cc = c % (D / 8);                                                       \
      kr[i] = *(const u4v*)(kp + (size_t)r * 512 + cc * 8);                                              \
      const int vrw = c >> 3, vc = c & 7;                                                                \
      vr[i] = *(const u4v*)(vp + (size_t)vrw * ldv + vc * 8);                                            \
    }                                                                                                    \
  }
#define ATTN_STAGE()                                                                                     \
  {                                                                                                      \
    _Pragma("unroll") for (int i = 0; i < NCH; ++i) {                                                    \
      const int c = tid + 256 * i;                                                                       \
      const int r = c / (D / 8), cc = c % (D / 8);                                                       \
      *(u4v*)(Ks + r * KSTR + cc * 8) = kr[i];                                                           \
      const int vrw = c >> 3, vc = c & 7;                                                                \
      *(u4v*)(Vts + vrw * 72 + vc * 8) = vr[i];                                                          \
    }                                                                                                    \
  }

  ATTN_ISSUE(0)
#pragma unroll 1
  for (int kt = 0; kt < ntk; ++kt) {
    __syncthreads();
    ATTN_STAGE()
    __syncthreads();
    if (kt + 1 < ntk) ATTN_ISSUE(kt + 1)
    f4v st[4];
#pragma unroll
    for (int kb = 0; kb < 4; ++kb) {
      st[kb] = (f4v){0.f, 0.f, 0.f, 0.f};
#pragma unroll
      for (int ks = 0; ks < NKS; ++ks) {
        s8v kf = *(const s8v*)(Ks + (kb * 16 + l15) * KSTR + ks * 32 + g * 8);
        st[kb] = __builtin_amdgcn_mfma_f32_16x16x32_bf16(kf, bc8(qf[ks]), st[kb], 0, 0, 0);
      }
    }
    if constexpr (MODE == 0) {
#pragma unroll
      for (int kb = 0; kb < 4; ++kb)
#pragma unroll
        for (int r = 0; r < 4; ++r) {
          const int ts = kt * 64 + kb * 16 + g * 4 + r;
          const int d = tq - ts;
          float dec = d > 0 ? exp2f(lgf2 * (float)d) : (d < 0 ? exp2f(lgb2 * (float)(-d)) : 2.f);
          st[kb][r] *= dec;
        }
    } else {
      if constexpr (MODE == 2) {
        if (kt < 8) {
          const int qc = wave * 16 + l15;
          const int ws = min(max(qc - 8, 0), 48);
          const int roff = (kr0 + kt) - rrow + 7;
#pragma unroll
          for (int kb = 0; kb < 4; ++kb)
#pragma unroll
            for (int r = 0; r < 4; ++r) {
              const int kc = kb * 16 + g * 4 + r;
              const bool valid = (kc >= ws) && (kc < ws + 16);
              const int coff = min(max(kc - qc + 15, 0), 30);
              const float bias = rpbs[roff * 31 + coff];
              st[kb][r] = valid ? st[kb][r] + bias : -1e30f;
            }
        }
      }
      float tmax = st[0][0];
#pragma unroll
      for (int kb = 0; kb < 4; ++kb)
#pragma unroll
        for (int r = 0; r < 4; ++r) tmax = fmaxf(tmax, st[kb][r]);
      tmax = fmaxf(tmax, __shfl_xor(tmax, 16));
      tmax = fmaxf(tmax, __shfl_xor(tmax, 32));
      const float mnew = fmaxf(mrun, tmax);
      const float alpha = __expf(mrun - mnew);
      float ps = 0.f;
#pragma unroll
      for (int kb = 0; kb < 4; ++kb)
#pragma unroll
        for (int r = 0; r < 4; ++r) {
          float e = __expf(st[kb][r] - mnew);
          st[kb][r] = e;
          ps += e;
        }
      lsum = lsum * alpha + ps;
      mrun = mnew;
#pragma unroll
      for (int nb = 0; nb < NB; ++nb) ot[nb] *= alpha;
    }
    u4v pf[2];
#pragma unroll
    for (int s = 0; s < 2; ++s) {
      pf[s] = (u4v){pack2(st[2 * s][0], st[2 * s][1]), pack2(st[2 * s][2], st[2 * s][3]),
                    pack2(st[2 * s + 1][0], st[2 * s + 1][1]), pack2(st[2 * s + 1][2], st[2 * s + 1][3])};
    }
#pragma unroll
    for (int nb = 0; nb < NB; ++nb)
#pragma unroll
      for (int s = 0; s < 2; ++s) {
        const u16* vb = Vts + (nb * 16 + l15) * 72 + s * 32 + g * 4;
        uint2 lo = *(const uint2*)(vb);
        uint2 hi = *(const uint2*)(vb + 16);
        u4v vf = (u4v){lo.x, lo.y, hi.x, hi.y};
        ot[nb] = __builtin_amdgcn_mfma_f32_16x16x32_bf16(bc8(vf), bc8(pf[s]), ot[nb], 0, 0, 0);
      }
  }

  if constexpr (MODE == 0) {
    if (latent) {
#pragma unroll 1
      for (int dir = 0; dir < 2; ++dir) {
        const float scale = dir == 0 ? exp2f(lgf2 * (float)(tq + 1)) : exp2f(lgb2 * (float)(L - tq));
        const u16* S0 = WS_S0t + ((size_t)(((l * 4 + b) * 2 + dir) * 4 + hh)) * 16384;
#pragma unroll
        for (int s = 0; s < NKS; ++s) {
          u4v pq = (u4v){pack2(bflo(qf[s][0]) * scale, bfhi(qf[s][0]) * scale), pack2(bflo(qf[s][1]) * scale, bfhi(qf[s][1]) * scale),
                         pack2(bflo(qf[s][2]) * scale, bfhi(qf[s][2]) * scale), pack2(bflo(qf[s][3]) * scale, bfhi(qf[s][3]) * scale)};
#pragma unroll
          for (int nb = 0; nb < NB; ++nb) {
            u4v vf = *(const u4v*)(S0 + (size_t)(nb * 16 + l15) * 128 + s * 32 + g * 8);
            ot[nb] = __builtin_amdgcn_mfma_f32_16x16x32_bf16(bc8(vf), bc8(pq), ot[nb], 0, 0, 0);
          }
        }
      }
    }
    float s = 0.f;
#pragma unroll
    for (int nb = 0; nb < NB; ++nb) s += ot[nb][0] + ot[nb][1] + ot[nb][2] + ot[nb][3];
    s += __shfl_xor(s, 16); s += __shfl_xor(s, 32);
    const float mu = s * (1.f / 128.f);
    float q = 0.f;
#pragma unroll
    for (int nb = 0; nb < NB; ++nb)
#pragma unroll
      for (int r = 0; r < 4; ++r) { float dlt = ot[nb][r] - mu; q += dlt * dlt; }
    q += __shfl_xor(q, 16); q += __shfl_xor(q, 32);
    const float rstd = rsqrtf(q * (1.f / 128.f) + LNEPS);
#pragma unroll
    for (int nb = 0; nb < NB; ++nb) {
      const size_t off = (size_t)qtok * 512 + hh * 128 + nb * 16 + g * 4;
      uint2 gg = *(const uint2*)(WS_G + off);
      float o0 = (ot[nb][0] - mu) * rstd * bflo(gg.x);
      float o1 = (ot[nb][1] - mu) * rstd * bfhi(gg.x);
      float o2 = (ot[nb][2] - mu) * rstd * bflo(gg.y);
      float o3 = (ot[nb][3] - mu) * rstd * bfhi(gg.y);
      *(uint2*)(WS_rout + off) = make_uint2(pack2(o0, o1), pack2(o2, o3));
    }
  } else {
    lsum += __shfl_xor(lsum, 16); lsum += __shfl_xor(lsum, 32);
    const float inv = 1.f / lsum;
#pragma unroll
    for (int nb = 0; nb < NB; ++nb) {
      const size_t off = (size_t)qtok * 512 + hh * 64 + nb * 16 + g * 4;
      *(uint2*)(WS_nout + off) = make_uint2(pack2(ot[nb][0] * inv, ot[nb][1] * inv), pack2(ot[nb][2] * inv, ot[nb][3] * inv));
    }
  }
}

__device__ __forceinline__ void retstate_item(const Params& p, int l, int idx) {
  const int dir = idx & 1, hh = (idx >> 1) & 3, b = idx >> 3;
  const int tid = ltid(), lane = tid & 63, wave = tid >> 6;
  const int r = lane & 31, h2 = lane >> 5;
  const float x = p.ret_decay[(l * 2 + dir) * 4 + hh];
  const float lg2 = -log1pf(expf(-x)) * 1.4426950408889634f;
  const u16* Kt = WS_KtR + ((size_t)(b * 4 + hh) * 128) * 256;
  const u16* Vt = WS_VtR + ((size_t)(b * 4 + hh) * 128) * 256;
  f16v acc[4];
#pragma unroll
  for (int i = 0; i < 4; ++i) acc[i] = zero16();
#pragma unroll 2
  for (int ks = 0; ks < 16; ++ks) {
    const int tok0 = ks * 16 + h2 * 8;
    const u4v a = *(const u4v*)(Kt + (size_t)(wave * 32 + r) * 256 + tok0);
    u4v af;
#pragma unroll
    for (int w = 0; w < 4; ++w) {
      const int t0 = tok0 + 2 * w, t1 = t0 + 1;
      float w0 = dir == 0 ? exp2f(lg2 * (float)(255 - t0)) : exp2f(lg2 * (float)t0);
      float w1 = dir == 0 ? exp2f(lg2 * (float)(255 - t1)) : exp2f(lg2 * (float)t1);
      af[w] = pack2(bflo(a[w]) * w0, bfhi(a[w]) * w1);
    }
#pragma unroll
    for (int nt = 0; nt < 4; ++nt) {
      const u4v bfr = *(const u4v*)(Vt + (size_t)(nt * 32 + r) * 256 + tok0);
      acc[nt] = __builtin_amdgcn_mfma_f32_32x32x16_bf16(bc8(af), bc8(bfr), acc[nt], 0, 0, 0);
    }
  }
  float* o = p.out + OUT_SRET + ((size_t)(((b * 2 + l) * 2 + dir) * 4 + hh)) * 16384;
#pragma unroll
  for (int nt = 0; nt < 4; ++nt)
#pragma unroll
    for (int reg = 0; reg < 16; ++reg) {
      const int dk = wave * 32 + (reg & 3) + 8 * (reg >> 2) + 4 * h2;
      o[(size_t)dk * 128 + nt * 32 + r] = acc[nt][reg];
    }
}

__device__ __forceinline__ void s5_item(const Params& p, char* smem, int l, int item) {
  const int tid = ltid(), lane = tid & 63, wave = tid >> 6;
  const int l15 = lane & 15, g4 = lane >> 4;
  int seq = item * 4 + wave;
  int b, dir, g, L, tokbase;
  bool latent;
  if (seq < 256) { latent = true; b = seq >> 6; dir = (seq >> 5) & 1; g = seq & 31; L = 1024; tokbase = TCTX + b * 1024; }
  else { seq -= 256; latent = false; b = seq >> 6; dir = (seq >> 5) & 1; g = seq & 31; L = 256; tokbase = b * 256; }
  float* buf = (float*)smem + wave * (16 * 132);
  const int tg = (l * 2 + dir) * 32 + g;
  const float ar = WS_abar[(tg * 64 + lane) * 2], ai = WS_abar[(tg * 64 + lane) * 2 + 1];
  u4v bfrag[8];
#pragma unroll
  for (int nt = 0; nt < 8; ++nt) {
    if (g4 < 2) bfrag[nt] = *(const u4v*)(WS_bbarT + ((size_t)tg * 128 + nt * 16 + l15) * 16 + g4 * 8);
    else bfrag[nt] = (u4v){0u, 0u, 0u, 0u};
  }
  u4v cfrag[4];
#pragma unroll
  for (int ks = 0; ks < 4; ++ks) cfrag[ks] = *(const u4v*)(WS_cmT + ((size_t)tg * 16 + l15) * 128 + ks * 32 + g4 * 8);
  float xr = 0.f, xi = 0.f;
  if (latent) {
    const float* h0 = p.state_ssm + ((size_t)(((b * 2 + l) * 2 + dir) * 32 + g) * 64 + lane) * 2;
    xr = h0[0]; xi = h0[1];
  }
  u16* yd = WS_YD + (size_t)dir * TALL * 512;
  __syncthreads();
  const int nsub = L >> 4;
  u4v afn = (u4v){0u, 0u, 0u, 0u};
  if (g4 < 2) {
    const int pos = dir == 0 ? l15 : L - 1 - l15;
    afn = *(const u4v*)(WS_SU + (size_t)(tokbase + pos) * 512 + g * 16 + g4 * 8);
  }
#pragma unroll 1
  for (int sub = 0; sub < nsub; ++sub) {
    const u4v af = afn;
    if (g4 < 2 && sub + 1 < nsub) {
      const int tau = (sub + 1) * 16 + l15;
      const int pos = dir == 0 ? tau : L - 1 - tau;
      afn = *(const u4v*)(WS_SU + (size_t)(tokbase + pos) * 512 + g * 16 + g4 * 8);
    }
#pragma unroll
    for (int nt = 0; nt < 8; ++nt) {
      f4v c = (f4v){0.f, 0.f, 0.f, 0.f};
      c = __builtin_amdgcn_mfma_f32_16x16x32_bf16(bc8(af), bc8(bfrag[nt]), c, 0, 0, 0);
#pragma unroll
      for (int r = 0; r < 4; ++r) buf[(g4 * 4 + r) * 132 + nt * 16 + l15] = c[r];
    }
    __builtin_amdgcn_wave_barrier();
#pragma unroll
    for (int i = 0; i < 16; ++i) {
      const float bur = buf[i * 132 + lane], bui = buf[i * 132 + 64 + lane];
      const float nr = ar * xr - ai * xi + bur;
      const float ni = ar * xi + ai * xr + bui;
      xr = nr; xi = ni;
      buf[i * 132 + lane] = xr;
      buf[i * 132 + 64 + lane] = xi;
    }
    __builtin_amdgcn_wave_barrier();
    f4v y = (f4v){0.f, 0.f, 0.f, 0.f};
#pragma unroll
    for (int ks = 0; ks < 4; ++ks) {
      const float* bp = buf + l15 * 132 + ks * 32 + g4 * 8;
      float4 v0 = *(const float4*)(bp), v1 = *(const float4*)(bp + 4);
      const u4v xa = (u4v){pack2(v0.x, v0.y), pack2(v0.z, v0.w), pack2(v1.x, v1.y), pack2(v1.z, v1.w)};
      y = __builtin_amdgcn_mfma_f32_16x16x32_bf16(bc8(xa), bc8(cfrag[ks]), y, 0, 0, 0);
    }
#pragma unroll
    for (int r = 0; r < 4; ++r) {
      const int tau = sub * 16 + g4 * 4 + r;
      const int pos = dir == 0 ? tau : L - 1 - tau;
      yd[(size_t)(tokbase + pos) * 512 + g * 16 + l15] = f2bf(y[r]);
    }
    __builtin_amdgcn_wave_barrier();
  }
  if (!latent) {
    float* o = p.out + OUT_SSSM + ((size_t)(((b * 2 + l) * 2 + dir) * 32 + g) * 64 + lane) * 2;
    o[0] = xr; o[1] = xi;
  }
}

#define MX_S5 320
#define MX_RET 512
#define MX_NA 512
#define MX_CA 512
#define MX_RS 128
#define MX_ITEMS (MX_S5 + MX_RET + MX_NA + MX_CA + MX_RS)
__device__ __forceinline__ void mixer_item(const Params& p, char* smem, int l, int item) {
  if (item < 64) { s5_item(p, smem, l, item); return; }
  item -= 64;
  if (item < 256) { attn_item<128, 0>(p, smem, l, item); return; }
  item -= 256;
  if (item < 512) { attn_item<64, 2>(p, smem, l, item); return; }
  item -= 512;
  if (item < 256) { s5_item(p, smem, l, 64 + item); return; }
  item -= 256;
  if (item < 256) { attn_item<128, 0>(p, smem, l, 256 + item); return; }
  item -= 256;
  if (item < 512) { attn_item<64, 1>(p, smem, l, item); return; }
  item -= 512;
  retstate_item(p, l, item);
}

__device__ __forceinline__ void p3a_item(const Params& p, char* smem, int l, int item) {
  const int mt = item & 63, nt = item >> 6;
  const int m0 = mt * 128, n0 = nt * 128;
  const int tid = ltid(), lane = tid & 63, wave = tid >> 6, wm = wave >> 1, wn = wave & 1;
  AArgs a{};
  a.SU = WS_SU; a.YD0 = WS_YD; a.YD1 = WS_YD + (size_t)TALL * 512; a.dsk = p.ssm_d + l * 512;
  f16v acc[2][2];
  gemm_mainloop<2>(smem, a, WS_Wt + WT_LAYER * l + WT_GLU, 512, 512, m0, n0, acc);
#pragma unroll
  for (int mi = 0; mi < 2; ++mi)
#pragma unroll
    for (int reg = 0; reg < 16; ++reg) {
      const int row = EPI_ROW(mi, reg);
#pragma unroll
      for (int ni = 0; ni < 2; ++ni) {
        const int col = EPI_COL(ni);
        const size_t off = (size_t)row * 512 + col;
        float y = geluf_(a.dsk[col] * bf2f(WS_SU[off]) + bf2f(a.YD0[off]) + bf2f(a.YD1[off]));
        WS_sout[off] = f2bf(y * sigmoidf_(acc[mi][ni][reg]));
      }
    }
}

__device__ __forceinline__ void p3b_item(const Params& p, char* smem, int l, int item) {
  const int mt = item & 63, nt = item >> 6;
  const int m0 = mt * 128, n0 = nt * 128;
  const int tid = ltid(), lane = tid & 63, wave = tid >> 6, wm = wave >> 1, wn = wave & 1;
  int nbr = 3;
  asm volatile("" : "+s"(nbr));
#pragma unroll 1
  for (int br = 0; br < nbr; ++br) {
    const u16* Abr = br == 0 ? WS_rout : (br == 1 ? WS_sout : WS_nout);
    f16v acc[2][2];
    gemm_mainloop0(smem, Abr, 512, WS_Wt + WT_LAYER * l + WT_BR + (size_t)br * 512 * 1024, 512, 512, m0, n0, acc);
    u16* Cs = (u16*)smem;
    {
      const int rl0 = wm * 64 + 4 * (lane >> 5), cl0 = wn * 64 + (lane & 31);
#pragma unroll
      for (int mi = 0; mi < 2; ++mi)
#pragma unroll
        for (int reg = 0; reg < 16; ++reg) {
          const int rl = rl0 + mi * 32 + (reg & 3) + 8 * (reg >> 2);
          Cs[rl * CST + cl0] = f2bf(acc[mi][0][reg]);
          Cs[rl * CST + cl0 + 32] = f2bf(acc[mi][1][reg]);
        }
    }
    __syncthreads();
    int tl = tid;
    asm volatile("" : "+v"(tl));
#pragma unroll
    for (int i = 0; i < 8; ++i) {
      const int c = tl + 256 * i, r = c >> 4, ch = c & 15;
      const u4v av = *(const u4v*)(Cs + r * CST + ch * 8);
      const u4v gv = *(const u4v*)(WS_GT + (size_t)(m0 + r) * 3072 + br * 1024 + n0 + ch * 8);
      u16* mp = WS_merged + (size_t)(m0 + r) * 1024 + n0 + ch * 8;
      u4v mv = (u4v){0u, 0u, 0u, 0u};
      if (br > 0) mv = *(const u4v*)mp;
      u4v ov;
#pragma unroll
      for (int j = 0; j < 4; ++j)
        ov[j] = pack2(fmaf(bflo(gv[j]), bflo(av[j]), bflo(mv[j])), fmaf(bfhi(gv[j]), bfhi(av[j]), bfhi(mv[j])));
      *(u4v*)mp = ov;
    }
  }
}

__device__ __forceinline__ void p3c_item(const Params& p, char* smem, int l, int item, bool do_stats = true) {
  const int mt = item & 63, nt = item >> 6;
  const int m0 = mt * 128, n0 = nt * 128;
  const int tid = ltid(), lane = tid & 63, wave = tid >> 6, wm = wave >> 1, wn = wave & 1;
  f16v acc[2][2];
  gemm_mainloop0(smem, WS_merged, 1024, WS_Wt + WT_LAYER * l + WT_O, 1024, 1024, m0, n0, acc);
  const int ci = cond_of_row(m0);
  const float* g1 = WS_mod + (l * 5 + ci) * 6144 + 2048;
  float* st1 = WS_stats + (size_t)(l * 2 + 0) * TALL * 2;
  const float* st2p = WS_stats + (size_t)(0 * 2 + 1) * TALL * 2;
  const int c0 = EPI_COL(0), c1 = EPI_COL(1);
  const float g1a = g1[c0], g1b = g1[c1];
  float lga = 1.f, lgb = 1.f, lba = 0.f, lbb = 0.f;
  if (l == 1) { lga = p.ln2_g[c0]; lgb = p.ln2_g[c1]; lba = p.ln2_b[c0]; lbb = p.ln2_b[c1]; }
#pragma unroll
  for (int mi = 0; mi < 2; ++mi)
#pragma unroll
    for (int reg = 0; reg < 16; ++reg) {
      const int row = EPI_ROW(mi, reg);
      float xa, xb;
      if (l == 0) {
        const float* xr = row < TCTX ? p.x_prompt + (size_t)row * 1024 : p.x_sample + (size_t)(row - TCTX) * 1024;
        xa = xr[c0]; xb = xr[c1];
      } else {
        const float s = st2p[row * 2], q = st2p[row * 2 + 1];
        const float mu = s * (1.f / 1024.f);
        const float rstd = rsqrtf(fmaxf(q * (1.f / 1024.f) - mu * mu, 0.f) + LNEPS);
        xa = (p.out[(size_t)row * 1024 + c0] - mu) * rstd * lga + lba;
        xb = (p.out[(size_t)row * 1024 + c1] - mu) * rstd * lgb + lbb;
      }
      const float va = ALPHA * xa + g1a * acc[mi][0][reg];
      const float vb = ALPHA * xb + g1b * acc[mi][1][reg];
      WS_pre1[(size_t)row * 1024 + c0] = va;
      WS_pre1[(size_t)row * 1024 + c1] = vb;
      if (do_stats) stats_accum(st1, row, va, vb, lane);
    }
}

__device__ __forceinline__ void p4_item(const Params& p, char* smem, int l, int item) {
  const int mt = item & 63, nt = item >> 6;
  const int m0 = mt * 128, n0 = nt * 128;
  const int tid = ltid(), lane = tid & 63, wave = tid >> 6, wm = wave >> 1, wn = wave & 1;
  f16v acc[2][2];
  gemm_mainloop0(smem, WS_h2, 1024, WS_Wt + WT_LAYER * l + WT_UP, 1024, 1024, m0, n0, acc);
  u16* Cs = (u16*)smem;
  const int rl0 = wm * 64 + 4 * (lane >> 5), cl0 = wn * 64 + (lane & 31);
#pragma unroll
  for (int mi = 0; mi < 2; ++mi)
#pragma unroll
    for (int reg = 0; reg < 16; ++reg) {
      const int rl = rl0 + mi * 32 + (reg & 3) + 8 * (reg >> 2);
      Cs[rl * CST + cl0] = f2bf(acc[mi][0][reg]);
      Cs[rl * CST + cl0 + 32] = f2bf(acc[mi][1][reg]);
    }
  __syncthreads();
  cs_store(Cs, WS_z2 + (size_t)m0 * 5632 + n0, 5632, tid);
}

__device__ __forceinline__ void p4b_item(const Params& p, int l, int item) {
  const int tid = ltid();
  if (tid >= 176) return;
  const int rb = item >> 1, hf = item & 1;
  const int j0 = (hf * 176 + tid) * 8;
  const float* cw = p.conv_w + (size_t)l * 3 * 5632;
  const float* cb = p.conv_b + (size_t)l * 5632;
  float wa[3][8], wb[3][8], ba[8], bb[8];
#pragma unroll
  for (int t = 0; t < 3; ++t)
#pragma unroll
    for (int h = 0; h < 2; ++h) {
      const float4 x = *(const float4*)(cw + t * 5632 + j0 + 4 * h), y = *(const float4*)(cw + t * 5632 + 2816 + j0 + 4 * h);
      wa[t][4 * h] = x.x; wa[t][4 * h + 1] = x.y; wa[t][4 * h + 2] = x.z; wa[t][4 * h + 3] = x.w;
      wb[t][4 * h] = y.x; wb[t][4 * h + 1] = y.y; wb[t][4 * h + 2] = y.z; wb[t][4 * h + 3] = y.w;
    }
#pragma unroll
  for (int h = 0; h < 2; ++h) {
    const float4 x = *(const float4*)(cb + j0 + 4 * h), y = *(const float4*)(cb + 2816 + j0 + 4 * h);
    ba[4 * h] = x.x; ba[4 * h + 1] = x.y; ba[4 * h + 2] = x.z; ba[4 * h + 3] = x.w;
    bb[4 * h] = y.x; bb[4 * h + 1] = y.y; bb[4 * h + 2] = y.z; bb[4 * h + 3] = y.w;
  }
  const int row0 = rb * 32;
  int pos0, L;
  if (row0 < TCTX) { pos0 = row0 & 255; L = 256; } else { pos0 = (row0 - TCTX) & 1023; L = 1024; }
  const u16* zr = WS_z2 + (size_t)row0 * 5632 + j0;
  const u4v zero = (u4v){0u, 0u, 0u, 0u};
  u4v pa = zero, pb = zero;
  if (pos0 > 0) { pa = *(const u4v*)(zr - 5632); pb = *(const u4v*)(zr - 5632 + 2816); }
  u4v ca = *(const u4v*)(zr), cb2 = *(const u4v*)(zr + 2816);
#pragma unroll 2
  for (int r = 0; r < 32; ++r) {
    u4v na = zero, nb = zero;
    if (pos0 + r < L - 1) { na = *(const u4v*)(zr + (size_t)(r + 1) * 5632); nb = *(const u4v*)(zr + (size_t)(r + 1) * 5632 + 2816); }
    u4v ov;
#pragma unroll
    for (int w = 0; w < 4; ++w) {
      const float a0 = wa[0][2 * w] * bflo(pa[w]) + wa[1][2 * w] * bflo(ca[w]) + wa[2][2 * w] * bflo(na[w]) + ba[2 * w];
      const float a1 = wa[0][2 * w + 1] * bfhi(pa[w]) + wa[1][2 * w + 1] * bfhi(ca[w]) + wa[2][2 * w + 1] * bfhi(na[w]) + ba[2 * w + 1];
      const float b0 = wb[0][2 * w] * bflo(pb[w]) + wb[1][2 * w] * bflo(cb2[w]) + wb[2][2 * w] * bflo(nb[w]) + bb[2 * w];
      const float b1 = wb[0][2 * w + 1] * bfhi(pb[w]) + wb[1][2 * w + 1] * bfhi(cb2[w]) + wb[2][2 * w + 1] * bfhi(nb[w]) + bb[2 * w + 1];
      ov[w] = pack2(geluf_(a0) * b0, geluf_(a1) * b1);
    }
    *(u4v*)(WS_act + (size_t)(row0 + r) * 2816 + j0) = ov;
    pa = ca; pb = cb2; ca = na; cb2 = nb;
  }
}

__device__ __forceinline__ void p5_item(const Params& p, char* smem, int l, int item, bool do_stats = true) {
  const int mt = item & 63, nt = item >> 6;
  const int m0 = mt * 128, n0 = nt * 128;
  const int tid = ltid(), lane = tid & 63, wave = tid >> 6, wm = wave >> 1, wn = wave & 1;
  f16v acc[2][2];
  gemm_mainloop0(smem, WS_act, 2816, WS_Wt + WT_LAYER * l + WT_DOWN, 2816, 2816, m0, n0, acc);
  const int ci = cond_of_row(m0);
  const float* g2 = WS_mod + (l * 5 + ci) * 6144 + 5 * 1024;
  const float* st1 = WS_stats + (size_t)(l * 2 + 0) * TALL * 2;
  float* st2 = WS_stats + (size_t)(l * 2 + 1) * TALL * 2;
  const int c0 = EPI_COL(0), c1 = EPI_COL(1);
  const float g2a = g2[c0], g2b = g2[c1];
  const float lga = p.ln1_g[l * 1024 + c0], lgb = p.ln1_g[l * 1024 + c1];
  const float lba = p.ln1_b[l * 1024 + c0], lbb = p.ln1_b[l * 1024 + c1];
#pragma unroll
  for (int mi = 0; mi < 2; ++mi)
#pragma unroll
    for (int reg = 0; reg < 16; ++reg) {
      const int row = EPI_ROW(mi, reg);
      const float s = st1[row * 2], q = st1[row * 2 + 1];
      const float mu = s * (1.f / 1024.f);
      const float rstd = rsqrtf(fmaxf(q * (1.f / 1024.f) - mu * mu, 0.f) + LNEPS);
      const float xa = (WS_pre1[(size_t)row * 1024 + c0] - mu) * rstd * lga + lba;
      const float xb = (WS_pre1[(size_t)row * 1024 + c1] - mu) * rstd * lgb + lbb;
      const float va = ALPHA * xa + g2a * acc[mi][0][reg];
      const float vb = ALPHA * xb + g2b * acc[mi][1][reg];
      p.out[(size_t)row * 1024 + c0] = va;
      p.out[(size_t)row * 1024 + c1] = vb;
      if (do_stats) stats_accum(st2, row, va, vb, lane);
    }
}

__device__ __forceinline__ void final_item(const Params& p, int item) {
  const float* st = WS_stats + (size_t)(1 * 2 + 1) * TALL * 2;
  const int c = ltid() * 4;
  const float4 g = *(const float4*)(p.ln2_g + 1024 + c);
  const float4 b = *(const float4*)(p.ln2_b + 1024 + c);
  for (int r = 0; r < 8; ++r) {
    const int row = item * 8 + r;
    const float s = st[row * 2], q = st[row * 2 + 1];
    const float mu = s * (1.f / 1024.f);
    const float rstd = rsqrtf(fmaxf(q * (1.f / 1024.f) - mu * mu, 0.f) + LNEPS);
    float4 v = *(float4*)(p.out + (size_t)row * 1024 + c);
    v.x = (v.x - mu) * rstd * g.x + b.x;
    v.y = (v.y - mu) * rstd * g.y + b.y;
    v.z = (v.z - mu) * rstd * g.z + b.z;
    v.w = (v.w - mu) * rstd * g.w + b.w;
    *(float4*)(p.out + (size_t)row * 1024 + c) = v;
  }
}

#define XB_TMO      128
#define XB_XCNT(j)  (256  + 64 * (j))
#define XB_XSUB(j)  (1280 + 64 * (j))
#define XB_XGEN(j)  (2304 + 64 * (j))
#define XB_TOP      3328
#define XB_TOPGEN   3392
#define XCD_BAR_WORDS 3456
#define XB_SPIN_CAP (1u << 18)
#define LAS __attribute__((address_space(3)))

__device__ __forceinline__ unsigned xb_ld(unsigned* p)              { return __hip_atomic_load(p, __ATOMIC_RELAXED, __HIP_MEMORY_SCOPE_AGENT); }
__device__ __forceinline__ unsigned xb_add(unsigned* p, unsigned v) { return __hip_atomic_fetch_add(p, v, __ATOMIC_RELAXED, __HIP_MEMORY_SCOPE_AGENT); }
__device__ __forceinline__ unsigned xb_xcc_id() { return (unsigned)__builtin_amdgcn_s_getreg((3 << 11) | 20) & 0xFu; }
#define XB_SPIN(cond, bar) do { unsigned _sp = 0; while (cond) { __builtin_amdgcn_s_sleep(1); \
    if ((++_sp & 255u) == 0u) { if (xb_ld(&(bar)[XB_TMO])) break; if (_sp > XB_SPIN_CAP) { atomicAdd(&(bar)[XB_TMO], 1u); break; } } } } while (0)

struct XcdBarrier {
    unsigned* bar; unsigned x;
    volatile LAS unsigned* st;
};

__device__ __forceinline__ XcdBarrier xcd_barrier_post(unsigned* bar, volatile LAS unsigned* st) {
    XcdBarrier b; b.bar = bar; b.x = xb_xcc_id(); b.st = st;
    if (threadIdx.x == 0) (void)xb_add(&bar[XB_XCNT(b.x)], 1u);
    return b;
}
__device__ __forceinline__ void xcd_barrier_complete(unsigned* bar, unsigned x, unsigned& nloc, unsigned& nx) {
    const unsigned G = gridDim.x * gridDim.y * gridDim.z;
    unsigned sum, cnt, mine, sp = 0u;
    for (;;) {
        sum = 0u; cnt = 0u; mine = 0u;
#pragma unroll
        for (unsigned j = 0; j < 16; ++j) { const unsigned c = xb_ld(&bar[XB_XCNT(j)]); sum += c; cnt += (c > 0u) ? 1u : 0u; mine = (j == x) ? c : mine; }
        if (sum == G) break;
        __builtin_amdgcn_s_sleep(1);
        if ((++sp & 255u) == 0u) { if (xb_ld(&bar[XB_TMO])) break; if (sp > XB_SPIN_CAP) { atomicAdd(&bar[XB_TMO], 1u); break; } }
    }
    nloc = mine > 0u ? mine : 1u; nx = cnt > 0u ? cnt : 1u;
}

__device__ __forceinline__ void xcd_barrier(const XcdBarrier& b) {
    asm volatile("s_waitcnt vmcnt(0)" ::: "memory");
    __syncthreads();
    if (threadIdx.x == 0) {
        unsigned* bar = b.bar;
        __builtin_amdgcn_s_waitcnt(0);
        unsigned nloc = b.st[0], nx = b.st[1];
        if (nloc == 0u) { xcd_barrier_complete(bar, b.x, nloc, nx); b.st[0] = nloc; b.st[1] = nx; }
        const unsigned old = xb_add(&bar[XB_XSUB(b.x)], 1u);
        const unsigned gen = old / nloc;
        if (old + 1u == (gen + 1u) * nloc) {
            __builtin_amdgcn_fence(__ATOMIC_RELEASE, "agent");
            asm volatile("s_waitcnt vmcnt(0)" ::: "memory");
            const unsigned og = xb_add(&bar[XB_TOP], 1u);
            const unsigned tg = og / nx;
            if (og + 1u == (tg + 1u) * nx) xb_add(&bar[XB_TOPGEN], 1u);
            else XB_SPIN(xb_ld(&bar[XB_TOPGEN]) == tg, bar);
            __builtin_amdgcn_fence(__ATOMIC_ACQUIRE, "agent");
            xb_add(&bar[XB_XGEN(b.x)], 1u);
            asm volatile("s_waitcnt vmcnt(0)" ::: "memory");
        } else {
            XB_SPIN(xb_ld(&bar[XB_XGEN(b.x)]) == gen, bar);
            __builtin_amdgcn_fence(__ATOMIC_ACQUIRE, "agent");
            asm volatile("s_waitcnt vmcnt(0)" ::: "memory");
        }
    }
    __syncthreads();
}


#define NPHASES 22
#ifndef REPMASK
#define REPMASK 0
#endif
#define REPS(PH) (((PH) == 0 ? (REPMASK >> 10) : (PH) == 21 ? (REPMASK >> 11) : (REPMASK >> (((PH) - 1) % 10))) & 1)
#define RUN_PHASE(PH, N, CALL)                                              \
  if (ph_lo <= (PH) && (PH) < ph_hi) {                                      \
    for (int rep_ = 0; rep_ <= REPS(PH); ++rep_)                            \
    for (int it = blockIdx.x; it < (N); it += nb) { CALL; }                 \
    if ((PH) + 1 < ph_hi) xcd_barrier(xb);                                  \
  }
#define RUN_GEMM_PHASE(PH, NT, CALL)                                                          \
  if (ph_lo <= (PH) && (PH) < ph_hi) {                                                        \
    const int xcd_ = blockIdx.x & 7, slot_ = blockIdx.x >> 3, spx_ = (int)gridDim.x >> 3;      \
    const int nsuper_ = 8 * (((NT) + 7) >> 3);                                                \
    for (int rep_ = 0; rep_ <= REPS(PH); ++rep_)                                              \
    for (int s_ = xcd_; s_ < nsuper_; s_ += 8)                                                \
      for (int j_ = slot_; j_ < 64; j_ += spx_) {                                             \
        const int mt_ = (s_ & 7) * 8 + (j_ & 7), nt_ = (s_ >> 3) * 8 + (j_ >> 3);             \
        if (nt_ < (NT)) { const int it = nt_ * 64 + mt_; CALL; }                              \
      }                                                                                       \
    if ((PH) + 1 < ph_hi) xcd_barrier(xb);                                                    \
  }
#define RUN_LAYER(L)                                                         \
  RUN_PHASE(1 + 10 * (L) + 0, 1024, hmat_item(p, (L), 0, it))                \
  RUN_GEMM_PHASE(1 + 10 * (L) + 1, 56, p1_item(p, smem, (L), it))            \
  RUN_PHASE(1 + 10 * (L) + 2, MX_ITEMS, mixer_item(p, smem, (L), it))        \
  RUN_GEMM_PHASE(1 + 10 * (L) + 3, 4, p3a_item(p, smem, (L), it))            \
  RUN_GEMM_PHASE(1 + 10 * (L) + 4, 8, p3b_item(p, smem, (L), it))            \
  RUN_GEMM_PHASE(1 + 10 * (L) + 5, 8, p3c_item(p, smem, (L), it, rep_ == 0)) \
  RUN_PHASE(1 + 10 * (L) + 6, 1024, hmat_item(p, (L), 1, it))                \
  RUN_GEMM_PHASE(1 + 10 * (L) + 7, 44, p4_item(p, smem, (L), it))            \
  RUN_PHASE(1 + 10 * (L) + 8, 512, p4b_item(p, (L), it))                     \
  RUN_GEMM_PHASE(1 + 10 * (L) + 9, 8, p5_item(p, smem, (L), it, rep_ == 0))

__global__ void __launch_bounds__(256, 2) mega(Params p, int ph_lo, int ph_hi) {
  extern __shared__ __attribute__((aligned(16))) char smem[];
  __shared__ uint4 xb_words;
  const int nb = gridDim.x;
  if (threadIdx.x == 0) xb_words = make_uint4(0u, 0u, 0u, 0u);
  __syncthreads();
  XcdBarrier xb;
  xb.bar = (unsigned*)(p.ws + OFF_bar); xb.x = 0; xb.st = (volatile LAS unsigned*)&xb_words;
  if (ph_hi - ph_lo > 1) xb = xcd_barrier_post((unsigned*)(p.ws + OFF_bar), (volatile LAS unsigned*)&xb_words);
  if (ph_hi > 1000) cg::this_grid().sync();
  RUN_PHASE(0, P0_ITEMS, phase0_item(p, smem, it))
  RUN_LAYER(0)
  RUN_LAYER(1)
  RUN_PHASE(21, 1024, final_item(p, it))
}

extern "C" void kernel_launch(void* const* d_in, const int* in_sizes, int n_in, void* d_out, int out_size, void* d_ws,
                              size_t ws_size, hipStream_t stream) {
  Params p{};
  const float** ins = (const float**)&p;
  for (int i = 0; i < 32; ++i) ins[i] = (const float*)d_in[i];
  p.out = (float*)d_out;
  char* ws = (char*)d_ws;
  p.ws = ws;
  if (WS_TOTAL > ws_size) {
    fprintf(stderr, "kernel_launch: workspace too small (%zu needed, %zu given)\n", (size_t)WS_TOTAL, ws_size);
    return;
  }
  (void)hipMemsetAsync(ws, 0, ZERO_BYTES, stream);
#if SINGLE_LAUNCH
  static int grid_blocks = 0;
  if (!grid_blocks) {
    int dev = 0, cus = 0, per_cu = 0;
    (void)hipGetDevice(&dev);
    (void)hipDeviceGetAttribute(&cus, hipDeviceAttributeMultiprocessorCount, dev);
    (void)hipFuncSetAttribute((const void*)mega, hipFuncAttributeMaxDynamicSharedMemorySize, LDS_BYTES);
    (void)hipOccupancyMaxActiveBlocksPerMultiprocessor(&per_cu, mega, 256, LDS_BYTES);
    if (per_cu > 2) per_cu = 2;
    if (per_cu < 1) per_cu = 1;
    grid_blocks = cus * per_cu;
  }
  int lo = 0, hi = NPHASES;
  void* args[] = {&p, &lo, &hi};
  hipError_t e = hipLaunchCooperativeKernel((void*)mega, dim3(grid_blocks), dim3(256), args, LDS_BYTES, stream);
  if (e != hipSuccess) fprintf(stderr, "cooperative launch failed: %s (grid %d)\n", hipGetErrorString(e), grid_blocks);
#else
  for (int ph = 0; ph < NPHASES; ++ph) {
    hipLaunchKernelGGL(mega, dim3(512), dim3(256), LDS_BYTES, stream, p, ph, ph + 1);
  }
#endif
}
```

```cpp
#include <hip/hip_runtime.h>
#include <hip/hip_cooperative_groups.h>
#include <cstdio>
namespace cg = cooperative_groups;

#ifndef SINGLE_LAUNCH
#define SINGLE_LAUNCH 1
#endif

typedef __attribute__((ext_vector_type(8))) short s8v;
typedef __attribute__((ext_vector_type(4))) float f4v;
typedef __attribute__((ext_vector_type(16))) float f16v;
typedef unsigned short u16;
typedef __attribute__((ext_vector_type(4))) unsigned u4v;
__device__ __forceinline__ s8v bc8(u4v x) { return __builtin_bit_cast(s8v, x); }


#define TALL 8192
#define TCTX 4096
#define ALPHA 1.41421356237309515f
#define LNEPS 1e-5f
#define VTR_LAT 2097152
#define NVT_LAT 2097152
#define OUT_SRET 8388608
#define OUT_SSSM 12582912
#define OUT_CK 12845056
#define OUT_CV 17039360
#define WT_IN 0
#define WT_GLU (WT_IN + 7168 * 1024)
#define WT_BR (WT_GLU + 512 * 512)
#define WT_O (WT_BR + 3 * 1024 * 512)
#define WT_UP (WT_O + 1024 * 1024)
#define WT_DOWN (WT_UP + 5632 * 1024)
#define WT_LAYER ((size_t)(WT_DOWN + 1024 * 2816))

struct Params {
  const float *x_prompt, *x_sample, *state_ret, *state_ssm, *cache_k, *cache_v, *c, *c_ctx;
  const float *w_ada, *b_ada, *w_in, *ret_decay, *a_re, *a_im, *log_dt, *b_re, *b_im, *c_re, *c_im;
  const float *ssm_d, *w_glu, *rpb, *w_branch, *w_o, *ln1_g, *ln1_b, *w_up, *conv_w, *conv_b, *w_down, *ln2_g, *ln2_b;
  float* out;
  char* ws;
};

typedef __bf16 bf2v __attribute__((ext_vector_type(2)));
typedef float fl2v __attribute__((ext_vector_type(2)));
__device__ __forceinline__ unsigned pack2(float a, float b) {
  fl2v f = {a, b};
  bf2v h = __builtin_convertvector(f, bf2v);
  return __builtin_bit_cast(unsigned, h);
}
__device__ __forceinline__ u16 f2bf(float f) { return (u16)(pack2(f, 0.f) & 0xffffu); }

constexpr size_t al256(size_t x) { return (x + 255) & ~(size_t)255; }
constexpr size_t EB = (size_t)TALL * 512 * 2;
constexpr size_t OFF_mod = 0;
constexpr size_t OFF_stats = OFF_mod + al256(2 * 5 * 6144 * 4);
constexpr size_t OFF_bar = OFF_stats + al256(2 * 2 * TALL * 2 * 4);
constexpr size_t OFF_ctr = OFF_bar + al256(3456 * 4);
constexpr size_t ZERO_BYTES = OFF_ctr + al256(8 * 256);
constexpr size_t OFF_ropetab = ZERO_BYTES;
constexpr size_t OFF_abar = OFF_ropetab + al256(64 * 32 * 2 * 4);
constexpr size_t OFF_bbarT = OFF_abar + al256(2 * 2 * 32 * 64 * 2 * 4);
constexpr size_t OFF_cmT = OFF_bbarT + al256(2 * 2 * 32 * 128 * 16 * 2);
constexpr size_t OFF_CK = OFF_cmT + al256(2 * 2 * 32 * 16 * 128 * 2);
constexpr size_t OFF_CVt = OFF_CK + al256((size_t)2 * 4 * 512 * 512 * 2);
constexpr size_t OFF_S0t = OFF_CVt + al256((size_t)2 * 4 * 512 * 512 * 2);
constexpr size_t OFF_Wt = OFF_S0t + al256((size_t)2 * 4 * 2 * 4 * 128 * 128 * 2);
constexpr size_t OFF_REGION = OFF_Wt + al256(2 * WT_LAYER * 2);
constexpr size_t OFF_z2 = OFF_REGION;
constexpr size_t OFF_act = OFF_z2 + (size_t)TALL * 5632 * 2;
constexpr size_t OFF_pre1 = OFF_act + (size_t)TALL * 2816 * 2;
constexpr size_t WS_TOTAL = OFF_pre1 + (size_t)TALL * 1024 * 4;
constexpr size_t OFF_K = OFF_pre1;
constexpr size_t OFF_VtR = OFF_K + EB;
constexpr size_t OFF_NQ = OFF_VtR + EB;
constexpr size_t OFF_NK = OFF_NQ + EB;
constexpr size_t OFF_GT = OFF_REGION;
constexpr size_t OFF_rout = OFF_GT + (size_t)TALL * 3072 * 2;
constexpr size_t OFF_nout = OFF_rout + EB;
constexpr size_t OFF_YD = OFF_nout + EB;
constexpr size_t OFF_merged = OFF_YD;
constexpr size_t OFF_Q = OFF_YD + 2 * EB;
constexpr size_t OFF_sout = OFF_Q;
constexpr size_t OFF_KtR = OFF_Q + EB;
constexpr size_t OFF_G = OFF_KtR + EB / 2;
constexpr size_t OFF_SU = OFF_G + EB;
constexpr size_t OFF_NVt = OFF_SU + EB;
constexpr size_t OFF_h1 = OFF_NVt + EB;
constexpr size_t OFF_h2 = OFF_act;
static_assert(OFF_h1 + 2 * EB <= OFF_pre1, "mixer buffers overflow the z2+act area");
#define WS_h1 ((u16*)(p.ws + OFF_h1))
#define WS_h2 ((u16*)(p.ws + OFF_h2))
#define WS_mod ((float*)(p.ws + OFF_mod))
#define WS_stats ((float*)(p.ws + OFF_stats))
#define WS_ropetab ((float*)(p.ws + OFF_ropetab))
#define WS_abar ((float*)(p.ws + OFF_abar))
#define WS_pre1 ((float*)(p.ws + OFF_pre1))
#define WS_bbarT ((u16*)(p.ws + OFF_bbarT))
#define WS_cmT ((u16*)(p.ws + OFF_cmT))
#define WS_CK ((u16*)(p.ws + OFF_CK))
#define WS_CVt ((u16*)(p.ws + OFF_CVt))
#define WS_S0t ((u16*)(p.ws + OFF_S0t))
#define WS_Wt ((u16*)(p.ws + OFF_Wt))
#define WS_Q ((u16*)(p.ws + OFF_Q))
#define WS_K ((u16*)(p.ws + OFF_K))
#define WS_VtR ((u16*)(p.ws + OFF_VtR))
#define WS_KtR ((u16*)(p.ws + OFF_KtR))
#define WS_G ((u16*)(p.ws + OFF_G))
#define WS_SU ((u16*)(p.ws + OFF_SU))
#define WS_NQ ((u16*)(p.ws + OFF_NQ))
#define WS_NK ((u16*)(p.ws + OFF_NK))
#define WS_NVt ((u16*)(p.ws + OFF_NVt))
#define WS_GT ((u16*)(p.ws + OFF_GT))
#define WS_rout ((u16*)(p.ws + OFF_rout))
#define WS_sout ((u16*)(p.ws + OFF_sout))
#define WS_nout ((u16*)(p.ws + OFF_nout))
#define WS_YD ((u16*)(p.ws + OFF_YD))
#define WS_merged ((u16*)(p.ws + OFF_merged))
#define WS_z2 ((u16*)(p.ws + OFF_z2))
#define WS_act ((u16*)(p.ws + OFF_act))

__device__ __forceinline__ float bf2f(unsigned h) { return __uint_as_float((h & 0xffffu) << 16); }
__device__ __forceinline__ float bflo(unsigned w) { return __uint_as_float(w << 16); }
__device__ __forceinline__ float bfhi(unsigned w) { return __uint_as_float(w & 0xffff0000u); }
__device__ __forceinline__ float sigmoidf_(float x) { return 1.f / (1.f + __expf(-x)); }
__device__ __forceinline__ float siluf_(float x) { return x / (1.f + __expf(-x)); }
__device__ __forceinline__ float geluf_(float x) {
  float u = 0.7978845608028654f * (x + 0.044715f * x * x * x);
  float e = __expf(2.f * u);
  float t = 1.f - 2.f / (e + 1.f);
  return 0.5f * x * (1.f + t);
}
__device__ __forceinline__ f16v zero16() {
  return (f16v){0.f, 0.f, 0.f, 0.f, 0.f, 0.f, 0.f, 0.f, 0.f, 0.f, 0.f, 0.f, 0.f, 0.f, 0.f, 0.f};
}
__device__ __forceinline__ int ltid() { int t = threadIdx.x; asm volatile("" : "+v"(t)); return t; }
__device__ __forceinline__ int cond_of_row(int row) { return row < TCTX ? 0 : 1 + ((row - TCTX) >> 10); }

struct AArgs {
  const u16* A16; int lda;
  const float* A32lo; const float* A32hi;
  const float* stats;
  const float* lng; const float* lnb;
  const float* sc; const float* sh;
  const u16* SU; const u16* YD0; const u16* YD1; const float* dsk;
};

#define GST 72
#define LDS_GEMM (2 * 2 * 128 * GST * 2)
#define LDS_BYTES LDS_GEMM

template <int AMODE>
__device__ __forceinline__ void gemm_mainloop(char* smem, const AArgs& a, const u16* __restrict__ Bt, int ldb, int K,
                                              int m0, int n0, f16v (&acc)[2][2]) {
  u16* As = (u16*)smem;
  u16* Bs = As + 2 * 128 * GST;
  const int tid = ltid(), lane = tid & 63, wave = tid >> 6;
  const int wm = wave >> 1, wn = wave & 1;
  const int crow = tid >> 3, cch = tid & 7;
  const int frow = tid >> 4, fch = tid & 15;
  float rs[8], nm[8];
  const float* srow0 = nullptr;
  const float *gsc = nullptr, *gsh = nullptr;
  __syncthreads();
  if constexpr (AMODE == 1) {
    const int ci = cond_of_row(m0);
    gsc = a.sc + ci * 6144; gsh = a.sh + ci * 6144;
#pragma unroll
    for (int i = 0; i < 8; ++i) {
      rs[i] = 1.f; nm[i] = 0.f;
      if (a.stats) {
        const int row = m0 + frow + 16 * i;
        const float s = a.stats[row * 2], q = a.stats[row * 2 + 1];
        const float mu = s * (1.f / 1024.f);
        const float var = q * (1.f / 1024.f) - mu * mu;
        rs[i] = rsqrtf(fmaxf(var, 0.f) + LNEPS);
        nm[i] = -mu * rs[i];
      }
    }
    const int row0 = m0 + frow;
    srow0 = (row0 < TCTX ? a.A32lo + (size_t)row0 * 1024 : a.A32hi + (size_t)(row0 - TCTX) * 1024) + fch * 4;
  }
  acc[0][0] = zero16(); acc[0][1] = zero16(); acc[1][0] = zero16(); acc[1][1] = zero16();

  u4v ra[12], rb[4];
  float4 q0, q1, q2, q3;
  q0 = q1 = q3 = make_float4(0.f, 0.f, 0.f, 0.f); q2 = make_float4(1.f, 1.f, 1.f, 1.f);
  const u16* brow = Bt + (size_t)(n0 + crow) * ldb + cch * 8;
  auto issue = [&](int kt) {
    if constexpr (AMODE == 1) {
      const int k = kt * 64 + fch * 4;
      q0 = *(const float4*)(gsc + k); q1 = *(const float4*)(gsh + k);
      if (a.lng) { q2 = *(const float4*)(a.lng + k); q3 = *(const float4*)(a.lnb + k); }
    } else if constexpr (AMODE == 2) {
      const int k0 = kt * 64 + cch * 8;
      q0 = *(const float4*)(a.dsk + k0); q1 = *(const float4*)(a.dsk + k0 + 4);
    }
    if constexpr (AMODE == 0) {
      const u16* ap = a.A16 + (size_t)(m0 + crow) * a.lda + kt * 64 + cch * 8;
#pragma unroll
      for (int i = 0; i < 4; ++i) ra[i] = *(const u4v*)(ap + (size_t)(32 * i) * a.lda);
    } else if constexpr (AMODE == 1) {
#pragma unroll
      for (int i = 0; i < 8; ++i) ra[i] = *(const u4v*)(srow0 + (size_t)(16 * i) * 1024 + kt * 64);
    } else {
      const size_t o = (size_t)(m0 + crow) * 512 + kt * 64 + cch * 8;
#pragma unroll
      for (int i = 0; i < 4; ++i) {
        ra[i] = *(const u4v*)(a.SU + o + (size_t)(32 * i) * 512);
        ra[4 + i] = *(const u4v*)(a.YD0 + o + (size_t)(32 * i) * 512);
        ra[8 + i] = *(const u4v*)(a.YD1 + o + (size_t)(32 * i) * 512);
      }
    }
#pragma unroll
    for (int i = 0; i < 4; ++i) rb[i] = *(const u4v*)(brow + (size_t)(32 * i) * ldb + kt * 64);
  };
  auto stage = [&](int buf, int kt) {
    u16* Ad = As + buf * (128 * GST);
    if constexpr (AMODE == 0) {
#pragma unroll
      for (int i = 0; i < 4; ++i) *(u4v*)(Ad + (crow + 32 * i) * GST + cch * 8) = ra[i];
    } else if constexpr (AMODE == 1) {
      const float4 sc = q0, sh = q1, g = q2, b = q3;
      const float G0 = g.x * (1.f + sc.x), G1 = g.y * (1.f + sc.y), G2 = g.z * (1.f + sc.z), G3 = g.w * (1.f + sc.w);
      const float B0 = fmaf(b.x, 1.f + sc.x, sh.x), B1 = fmaf(b.y, 1.f + sc.y, sh.y), B2 = fmaf(b.z, 1.f + sc.z, sh.z), B3 = fmaf(b.w, 1.f + sc.w, sh.w);
#pragma unroll
      for (int i = 0; i < 8; ++i) {
        const float h0 = fmaf(fmaf(__uint_as_float(ra[i][0]), rs[i], nm[i]), G0, B0);
        const float h1 = fmaf(fmaf(__uint_as_float(ra[i][1]), rs[i], nm[i]), G1, B1);
        const float h2 = fmaf(fmaf(__uint_as_float(ra[i][2]), rs[i], nm[i]), G2, B2);
        const float h3 = fmaf(fmaf(__uint_as_float(ra[i][3]), rs[i], nm[i]), G3, B3);
        *(uint2*)(Ad + (frow + 16 * i) * GST + fch * 4) = make_uint2(pack2(h0, h1), pack2(h2, h3));
      }
    } else {
      const float4 da = q0, db = q1;
      const float dd[8] = {da.x, da.y, da.z, da.w, db.x, db.y, db.z, db.w};
#pragma unroll
      for (int i = 0; i < 4; ++i) {
        u4v o;
#pragma unroll
        for (int j = 0; j < 4; ++j) {
          const float v0 = geluf_(dd[2 * j] * bflo(ra[i][j]) + bflo(ra[4 + i][j]) + bflo(ra[8 + i][j]));
          const float v1 = geluf_(dd[2 * j + 1] * bfhi(ra[i][j]) + bfhi(ra[4 + i][j]) + bfhi(ra[8 + i][j]));
          o[j] = pack2(v0, v1);
        }
        *(u4v*)(Ad + (crow + 32 * i) * GST + cch * 8) = o;
      }
    }
    u16* Bd = Bs + buf * (128 * GST);
#pragma unroll
    for (int i = 0; i < 4; ++i) *(u4v*)(Bd + (crow + 32 * i) * GST + cch * 8) = rb[i];
  };
  auto compute = [&](int buf) {
    const u16* Ab = As + buf * (128 * GST) + (wm * 64 + (lane & 31)) * GST + (lane >> 5) * 8;
    const u16* Bb = Bs + buf * (128 * GST) + (wn * 64 + (lane & 31)) * GST + (lane >> 5) * 8;
#pragma unroll
    for (int ks = 0; ks < 4; ++ks) {
      s8v af0 = *(const s8v*)(Ab + ks * 16);
      s8v af1 = *(const s8v*)(Ab + 32 * GST + ks * 16);
      s8v bf0 = *(const s8v*)(Bb + ks * 16);
      s8v bf1 = *(const s8v*)(Bb + 32 * GST + ks * 16);
      acc[0][0] = __builtin_amdgcn_mfma_f32_32x32x16_bf16(af0, bf0, acc[0][0], 0, 0, 0);
      acc[0][1] = __builtin_amdgcn_mfma_f32_32x32x16_bf16(af0, bf1, acc[0][1], 0, 0, 0);
      acc[1][0] = __builtin_amdgcn_mfma_f32_32x32x16_bf16(af1, bf0, acc[1][0], 0, 0, 0);
      acc[1][1] = __builtin_amdgcn_mfma_f32_32x32x16_bf16(af1, bf1, acc[1][1], 0, 0, 0);
    }
  };

  const int nk = K >> 6;
  issue(0);
  stage(0, 0);
  __syncthreads();
#pragma unroll 1
  for (int kt = 0; kt < nk; ++kt) {
    const int buf = kt & 1;
    if (kt + 1 < nk) issue(kt + 1);
    compute(buf);
    if (kt + 1 < nk) stage(buf ^ 1, kt + 1);
    __syncthreads();
  }
}

__device__ __forceinline__ void gemm_mainloop0(char* smem, const u16* __restrict__ A, int lda, const u16* __restrict__ Bt, int ldb,
                                               int K, int m0, int n0, f16v (&acc)[2][2]) {
  u16* As = (u16*)smem;
  u16* Bs = As + 2 * 128 * GST;
  const int tid = ltid(), lane = tid & 63, wave = tid >> 6;
  const int wm = wave >> 1, wn = wave & 1;
  const int crow = tid >> 3, cch = tid & 7;
  __syncthreads();
  acc[0][0] = zero16(); acc[0][1] = zero16(); acc[1][0] = zero16(); acc[1][1] = zero16();
  const u16* arow = A + (size_t)(m0 + crow) * lda + cch * 8;
  const u16* brow = Bt + (size_t)(n0 + crow) * ldb + cch * 8;
  const size_t a32 = (size_t)32 * lda, b32 = (size_t)32 * ldb;
  u4v eA0, eA1, eA2, eA3, eB0, eB1, eB2, eB3, oA0, oA1, oA2, oA3, oB0, oB1, oB2, oB3;
#define G0_ISSUE(P, kt)                                                                                   \
  { const u16* ap_ = arow + (kt) * 64; const u16* bp_ = brow + (kt) * 64;                                 \
    P##A0 = *(const u4v*)(ap_); P##A1 = *(const u4v*)(ap_ + a32); P##A2 = *(const u4v*)(ap_ + 2 * a32);   \
    P##A3 = *(const u4v*)(ap_ + 3 * a32);                                                                 \
    P##B0 = *(const u4v*)(bp_); P##B1 = *(const u4v*)(bp_ + b32); P##B2 = *(const u4v*)(bp_ + 2 * b32);   \
    P##B3 = *(const u4v*)(bp_ + 3 * b32); }
#define G0_STAGE(P, buf)                                                                                  \
  { u16* Ad_ = As + (buf) * (128 * GST) + crow * GST + cch * 8; u16* Bd_ = Bs + (buf) * (128 * GST) + crow * GST + cch * 8; \
    *(u4v*)(Ad_) = P##A0; *(u4v*)(Ad_ + 32 * GST) = P##A1; *(u4v*)(Ad_ + 64 * GST) = P##A2; *(u4v*)(Ad_ + 96 * GST) = P##A3; \
    *(u4v*)(Bd_) = P##B0; *(u4v*)(Bd_ + 32 * GST) = P##B1; *(u4v*)(Bd_ + 64 * GST) = P##B2; *(u4v*)(Bd_ + 96 * GST) = P##B3; }
#define G0_COMPUTE(buf)                                                                                   \
  { const u16* Ab = As + (buf) * (128 * GST) + (wm * 64 + (lane & 31)) * GST + (lane >> 5) * 8;           \
    const u16* Bb = Bs + (buf) * (128 * GST) + (wn * 64 + (lane & 31)) * GST + (lane >> 5) * 8;           \
    _Pragma("unroll") for (int ks = 0; ks < 4; ++ks) {                                                    \
      s8v af0 = *(const s8v*)(Ab + ks * 16);                                                              \
      s8v af1 = *(const s8v*)(Ab + 32 * GST + ks * 16);                                                   \
      s8v bf0 = *(const s8v*)(Bb + ks * 16);                                                              \
      s8v bf1 = *(const s8v*)(Bb + 32 * GST + ks * 16);                                                   \
      acc[0][0] = __builtin_amdgcn_mfma_f32_32x32x16_bf16(af0, bf0, acc[0][0], 0, 0, 0);                  \
      acc[0][1] = __builtin_amdgcn_mfma_f32_32x32x16_bf16(af0, bf1, acc[0][1], 0, 0, 0);                  \
      acc[1][0] = __builtin_amdgcn_mfma_f32_32x32x16_bf16(af1, bf0, acc[1][0], 0, 0, 0);                  \
      acc[1][1] = __builtin_amdgcn_mfma_f32_32x32x16_bf16(af1, bf1, acc[1][1], 0, 0, 0);                  \
    } }
  const int nk = K >> 6;
  G0_ISSUE(e, 0)
  G0_ISSUE(o, 1)
  G0_STAGE(e, 0)
  __syncthreads();
  int kt = 0;
#pragma unroll 1
  for (; kt + 3 < nk; kt += 2) {
    G0_ISSUE(e, kt + 2)
    __builtin_amdgcn_sched_barrier(0);
    G0_COMPUTE(0)
    G0_STAGE(o, 1)
    __syncthreads();
    G0_ISSUE(o, kt + 3)
    __builtin_amdgcn_sched_barrier(0);
    G0_COMPUTE(1)
    G0_STAGE(e, 0)
    __syncthreads();
  }
  G0_COMPUTE(0)
  G0_STAGE(o, 1)
  __syncthreads();
  G0_COMPUTE(1)
  __syncthreads();
#undef G0_ISSUE
#undef G0_STAGE
#undef G0_COMPUTE
}

#define EPI_ROW(mi, reg) (m0 + wm * 64 + (mi) * 32 + ((reg) & 3) + 8 * ((reg) >> 2) + 4 * (lane >> 5))
#define EPI_COL(ni) (n0 + wn * 64 + (ni) * 32 + (lane & 31))


#define CST 136
__device__ __forceinline__ void cs_store(const u16* Cs, u16* __restrict__ dst, size_t ld, int tid) {
#pragma unroll
  for (int i = 0; i < 8; ++i) {
    const int c = tid + 256 * i, r = c >> 4, ch = c & 15;
    *(u4v*)(dst + (size_t)r * ld + ch * 8) = *(const u4v*)(Cs + r * CST + ch * 8);
  }
}

__device__ __forceinline__ void stats_accum(float* stats, int row, float v0, float v1, int lane) {
  float s = v0 + v1, q = v0 * v0 + v1 * v1;
#pragma unroll
  for (int o = 1; o < 32; o <<= 1) {
    s += __shfl_xor(s, o);
    q += __shfl_xor(q, o);
  }
  if ((lane & 31) == 0) {
    atomicAdd(stats + row * 2, s);
    atomicAdd(stats + row * 2 + 1, q);
  }
}

#define P0_ADA 768
#define P0_ROPE 1
#define P0_CACHE 64
#define P0_S0 64
#define P0_S5 128
#define P0_WT_PER_LAYER (16 * 112 + 8 * 8 + 3 * 8 * 16 + 16 * 16 + 16 * 88 + 44 * 16)
#define P0_WT (2 * P0_WT_PER_LAYER)
#define P0_ITEMS (P0_ADA + P0_ROPE + P0_CACHE + P0_S0 + P0_S5 + P0_WT)

__device__ __forceinline__ void wt_tile(const float* __restrict__ src, int N, u16* __restrict__ dst, int ldd, int kt, int nt, char* smem) {
  float* tile = (float*)smem;
  const int tid = ltid();
  __syncthreads();
  {
    const int c4 = (tid & 15) * 4, r0 = tid >> 4;
#pragma unroll
    for (int i = 0; i < 4; ++i) {
      const int k = r0 + 16 * i;
      const float4 v = *(const float4*)(src + (size_t)(kt * 64 + k) * N + nt * 64 + c4);
      tile[k * 65 + c4] = v.x; tile[k * 65 + c4 + 1] = v.y; tile[k * 65 + c4 + 2] = v.z; tile[k * 65 + c4 + 3] = v.w;
    }
  }
  __syncthreads();
  {
    const int n = tid >> 2, k0 = (tid & 3) * 16;
#define WTP(j) pack2(tile[(k0 + 2 * (j)) * 65 + n], tile[(k0 + 2 * (j) + 1) * 65 + n])
    u4v* d = (u4v*)(dst + (size_t)(nt * 64 + n) * ldd + kt * 64 + k0);
    d[0] = (u4v){WTP(0), WTP(1), WTP(2), WTP(3)};
    d[1] = (u4v){WTP(4), WTP(5), WTP(6), WTP(7)};
#undef WTP
  }
}
__device__ __forceinline__ void wt_item(const Params& p, char* smem, int item) {
  const int l = item / P0_WT_PER_LAYER;
  int it = item % P0_WT_PER_LAYER;
  u16* base = WS_Wt + WT_LAYER * l;
  if (it < 16 * 112) { wt_tile(p.w_in + (size_t)l * 1024 * 7168, 7168, base + WT_IN, 1024, it / 112, it % 112, smem); return; }
  it -= 16 * 112;
  if (it < 64) { wt_tile(p.w_glu + (size_t)l * 512 * 512, 512, base + WT_GLU, 512, it / 8, it % 8, smem); return; }
  it -= 64;
  if (it < 384) { const int br = it / 128; it %= 128;
    wt_tile(p.w_branch + ((size_t)l * 3 + br) * 512 * 1024, 1024, base + WT_BR + (size_t)br * 512 * 1024, 512, it / 16, it % 16, smem); return; }
  it -= 384;
  if (it < 256) { wt_tile(p.w_o + (size_t)l * 1024 * 1024, 1024, base + WT_O, 1024, it / 16, it % 16, smem); return; }
  it -= 256;
  if (it < 16 * 88) { wt_tile(p.w_up + (size_t)l * 1024 * 5632, 5632, base + WT_UP, 1024, it / 88, it % 88, smem); return; }
  it -= 16 * 88;
  wt_tile(p.w_down + (size_t)l * 2816 * 1024, 1024, base + WT_DOWN, 2816, it / 16, it % 16, smem);
}

__device__ __forceinline__ void phase0_item(const Params& p, char* smem, int item) {
  const int tid = ltid();
  if (item < P0_ADA) {
    const int ks = item & 3, cg = (item >> 2) % 96, l = item / 384;
    float* scs = (float*)smem;
    float* red = scs + 5 * 256;
    __syncthreads();
    for (int i = tid; i < 5 * 256; i += 256) {
      int ci = i >> 8, k = ks * 256 + (i & 255);
      float v = ci == 0 ? p.c_ctx[k] : p.c[(ci - 1) * 1024 + k];
      scs[i] = siluf_(v);
    }
    __syncthreads();
    const int ct = tid & 15, kg = tid >> 4;
    const float* wp = p.w_ada + (size_t)l * 1024 * 6144 + (size_t)(ks * 256 + kg * 16) * 6144 + cg * 64 + ct * 4;
    float acc[5][4];
#pragma unroll
    for (int i = 0; i < 5; ++i)
#pragma unroll
      for (int j = 0; j < 4; ++j) acc[i][j] = 0.f;
#pragma unroll 4
    for (int k = 0; k < 16; ++k) {
      float4 w = *(const float4*)(wp + (size_t)k * 6144);
#pragma unroll
      for (int ci = 0; ci < 5; ++ci) {
        float s = scs[ci * 256 + kg * 16 + k];
        acc[ci][0] += s * w.x; acc[ci][1] += s * w.y; acc[ci][2] += s * w.z; acc[ci][3] += s * w.w;
      }
    }
#pragma unroll
    for (int ci = 0; ci < 5; ++ci)
#pragma unroll
      for (int j = 0; j < 4; ++j) red[(kg * 5 + ci) * 64 + ct * 4 + j] = acc[ci][j];
    __syncthreads();
    for (int i = tid; i < 320; i += 256) {
      int ci = i >> 6, col = i & 63;
      float s = 0.f;
#pragma unroll
      for (int g = 0; g < 16; ++g) s += red[(g * 5 + ci) * 64 + col];
      if (ks == 0) s += p.b_ada[l * 6144 + cg * 64 + col];
      atomicAdd(WS_mod + (l * 5 + ci) * 6144 + cg * 64 + col, s);
    }
    return;
  }
  item -= P0_ADA;
  if (item < P0_ROPE) {
    for (int i = tid; i < 64 * 32; i += 256) {
      int pos = i >> 5, fi = i & 31;
      float inv = (float)pow(10000.0, -(double)fi / 32.0);
      float ang = (float)pos * inv;
      WS_ropetab[i * 2] = (float)cos((double)ang);
      WS_ropetab[i * 2 + 1] = (float)sin((double)ang);
    }
    return;
  }
  item -= P0_ROPE;
  if (item < P0_CACHE) {
    const int pc = item & 7, b = (item >> 3) & 3, l = item >> 5;
    const float* ksrc = p.cache_k + ((size_t)(b * 2 + l) * 512 + pc * 64) * 512;
    const float* vsrc = p.cache_v + ((size_t)(b * 2 + l) * 512 + pc * 64) * 512;
    u16* kdst = WS_CK + ((size_t)(l * 4 + b) * 512 + pc * 64) * 512;
    for (int i = tid; i < 64 * 512 / 4; i += 256) {
      float4 v = *(const float4*)(ksrc + (size_t)i * 4);
      *(uint2*)(kdst + (size_t)i * 4) = make_uint2(pack2(v.x, v.y), pack2(v.z, v.w));
    }
    for (int cc = 0; cc < 2; ++cc) {
      const int col = tid + cc * 256;
      u16* vdst = WS_CVt + ((size_t)(l * 4 + b) * 512 + col) * 512 + pc * 64;
      for (int j = 0; j < 8; ++j) {
        float v[8];
#pragma unroll
        for (int e = 0; e < 8; ++e) v[e] = vsrc[(size_t)(j * 8 + e) * 512 + col];
        *(uint4*)(vdst + j * 8) = make_uint4(pack2(v[0], v[1]), pack2(v[2], v[3]), pack2(v[4], v[5]), pack2(v[6], v[7]));
      }
    }
    return;
  }
  item -= P0_CACHE;
  if (item < P0_S0) {
    const int hh = item & 3, dir = (item >> 2) & 1, b = (item >> 3) & 3, l = item >> 5;
    const float* src = p.state_ret + ((size_t)(((b * 2 + l) * 2 + dir) * 4 + hh)) * 16384;
    u16* dst = WS_S0t + ((size_t)(((l * 4 + b) * 2 + dir) * 4 + hh)) * 16384;
    const int dv = tid & 127, kh = tid >> 7;
    for (int j = 0; j < 8; ++j) {
      const int dk0 = kh * 64 + j * 8;
      float v[8];
#pragma unroll
      for (int e = 0; e < 8; ++e) v[e] = src[(size_t)(dk0 + e) * 128 + dv];
      *(uint4*)(dst + (size_t)dv * 128 + dk0) = make_uint4(pack2(v[0], v[1]), pack2(v[2], v[3]), pack2(v[4], v[5]), pack2(v[6], v[7]));
    }
    return;
  }
  item -= P0_S0;
  if (item >= P0_S5) { wt_item(p, smem, item - P0_S5); return; }
  {
    const int g = item & 31, dir = (item >> 5) & 1, l = item >> 6;
    if (tid < 64) {
      const int pp = tid;
      const int ai = ((l * 2 + dir) * 32 + g) * 64 + pp;
      double lre = fmin((double)p.a_re[ai], -1e-4), lim = (double)p.a_im[ai];
      double dt = exp((double)p.log_dt[(l * 2 + dir) * 32 + g]);
      double er = exp(lre * dt);
      double abr = er * cos(lim * dt), abi = er * sin(lim * dt);
      WS_abar[ai * 2] = (float)abr;
      WS_abar[ai * 2 + 1] = (float)abi;
      double nr = abr - 1.0, ni = abi;
      double den = lre * lre + lim * lim;
      double cr = (nr * lre + ni * lim) / den, cim = (ni * lre - nr * lim) / den;
      u16* bt = WS_bbarT + (size_t)((l * 2 + dir) * 32 + g) * 128 * 16;
      const float* br = p.b_re + ((size_t)(l * 32 + g) * 64 + pp) * 16;
      const float* bi = p.b_im + ((size_t)(l * 32 + g) * 64 + pp) * 16;
      for (int c = 0; c < 16; ++c) {
        double xr = br[c], xi = bi[c];
        bt[pp * 16 + c] = f2bf((float)(cr * xr - cim * xi));
        bt[(64 + pp) * 16 + c] = f2bf((float)(cr * xi + cim * xr));
      }
      u16* ct = WS_cmT + (size_t)((l * 2 + dir) * 32 + g) * 16 * 128;
      const float* cre = p.c_re + ((size_t)((l * 2 + dir) * 32 + g) * 16) * 64;
      const float* cie = p.c_im + ((size_t)((l * 2 + dir) * 32 + g) * 16) * 64;
      for (int c = 0; c < 16; ++c) {
        ct[c * 128 + pp] = f2bf(cre[c * 64 + pp]);
        ct[c * 128 + 64 + pp] = f2bf(-cie[c * 64 + pp]);
      }
    }
  }
}


__device__ __forceinline__ void hmat_item(const Params& p, int l, int which, int item) {
  const int c = ltid() * 4;
  const int row0 = item * 8;
  const int ci = cond_of_row(row0);
  const float* mod = WS_mod + (l * 5 + ci) * 6144;
  const float4 sc = *(const float4*)(mod + (which ? 4 : 1) * 1024 + c);
  const float4 sh = *(const float4*)(mod + (which ? 3 : 0) * 1024 + c);
  float4 g = make_float4(1.f, 1.f, 1.f, 1.f), b = make_float4(0.f, 0.f, 0.f, 0.f);
  const float* st = nullptr;
  if (which == 1) { g = *(const float4*)(p.ln1_g + l * 1024 + c); b = *(const float4*)(p.ln1_b + l * 1024 + c); st = WS_stats + (size_t)(l * 2 + 0) * TALL * 2; }
  else if (l == 1) { g = *(const float4*)(p.ln2_g + c); b = *(const float4*)(p.ln2_b + c); st = WS_stats + (size_t)(0 * 2 + 1) * TALL * 2; }
  const float G0 = g.x * (1.f + sc.x), G1 = g.y * (1.f + sc.y), G2 = g.z * (1.f + sc.z), G3 = g.w * (1.f + sc.w);
  const float B0 = fmaf(b.x, 1.f + sc.x, sh.x), B1 = fmaf(b.y, 1.f + sc.y, sh.y), B2 = fmaf(b.z, 1.f + sc.z, sh.z), B3 = fmaf(b.w, 1.f + sc.w, sh.w);
  u16* dst = which ? WS_h2 : WS_h1;
#pragma unroll
  for (int r = 0; r < 8; ++r) {
    const int row = row0 + r;
    const float* src;
    if (which == 1) src = WS_pre1 + (size_t)row * 1024;
    else if (l == 1) src = p.out + (size_t)row * 1024;
    else src = row < TCTX ? p.x_prompt + (size_t)row * 1024 : p.x_sample + (size_t)(row - TCTX) * 1024;
    float rs = 1.f, nm = 0.f;
    if (st) {
      const float s = st[row * 2], q = st[row * 2 + 1];
      const float mu = s * (1.f / 1024.f);
      rs = rsqrtf(fmaxf(q * (1.f / 1024.f) - mu * mu, 0.f) + LNEPS);
      nm = -mu * rs;
    }
    const float4 x = *(const float4*)(src + c);
    const float h0 = fmaf(fmaf(x.x, rs, nm), G0, B0), h1 = fmaf(fmaf(x.y, rs, nm), G1, B1);
    const float h2 = fmaf(fmaf(x.z, rs, nm), G2, B2), h3 = fmaf(fmaf(x.w, rs, nm), G3, B3);
    *(uint2*)(dst + (size_t)row * 1024 + c) = make_uint2(pack2(h0, h1), pack2(h2, h3));
  }
}

__device__ __forceinline__ void p1_item(const Params& p, char* smem, int l, int item) {
  const int mt = item & 63, nt = item >> 6;
  const int m0 = mt * 128, n0 = nt * 128;
  const int tid = ltid(), lane = tid & 63, wave = tid >> 6, wm = wave >> 1, wn = wave & 1;
  f16v acc[2][2];
  gemm_mainloop0(smem, WS_h1, 1024, WS_Wt + WT_LAYER * l + WT_IN, 1024, 1024, m0, n0, acc);

  const bool latent = m0 >= TCTX;
  const int seg = n0 >> 9;
  const int cs0 = n0 & 511;
  const int l31 = lane & 31;
  u16* Cs = (u16*)smem;
  u16* CsT = Cs + 128 * CST;
  const int rl0 = wm * 64 + 4 * (lane >> 5);
  const int cl0 = wn * 64 + l31;
  const bool want_rm = !(seg == 2 || seg == 7);
  const bool want_t = (seg == 2 || seg == 7 || (seg == 1 && !latent));
#pragma unroll
  for (int mi = 0; mi < 2; ++mi)
#pragma unroll
    for (int q = 0; q < 4; ++q) {
      float o0[4], o1[4];
#pragma unroll
      for (int j = 0; j < 4; ++j) {
        const int reg = q * 4 + j;
        float x1 = acc[mi][0][reg], x2 = acc[mi][1][reg];
        if (seg <= 1) {
          if (latent) {
            const int pos = (m0 - TCTX + rl0 + mi * 32 + q * 8 + j) & 1023;
            const int pidx = ((cs0 + wn * 64) & 64) ? (pos & 63) : (pos >> 6);
            const float cs = WS_ropetab[(pidx * 32 + l31) * 2], sn = WS_ropetab[(pidx * 32 + l31) * 2 + 1];
            const float t1 = x1 * cs - x2 * sn, t2 = x1 * sn + x2 * cs;
            x1 = t1; x2 = t2;
          }
          if (seg == 1) { x1 *= 0.08838834764831845f; x2 *= 0.08838834764831845f; }
        } else if (seg == 3) { x1 = siluf_(x1); x2 = siluf_(x2); }
        else if (seg == 5) { x1 *= 0.125f; x2 *= 0.125f; }
        else if (seg >= 8) { x1 = sigmoidf_(x1); x2 = sigmoidf_(x2); }
        o0[j] = x1; o1[j] = x2;
        if (want_rm) {
          const int rl = rl0 + mi * 32 + q * 8 + j;
          Cs[rl * CST + cl0] = f2bf(x1);
          Cs[rl * CST + cl0 + 32] = f2bf(x2);
        }
        if ((seg == 6 || seg == 7) && !latent) {
          const int row = m0 + rl0 + mi * 32 + q * 8 + j;
          float* o = p.out + (seg == 6 ? OUT_CK : OUT_CV) + ((size_t)((row >> 8) * 2 + l) * 256 + (row & 255)) * 512 + cs0 + cl0;
          o[0] = acc[mi][0][reg]; o[32] = acc[mi][1][reg];
        }
      }
      if (want_t) {
        const int rl = rl0 + mi * 32 + q * 8;
        *(uint2*)(CsT + cl0 * CST + rl) = make_uint2(pack2(o0[0], o0[1]), pack2(o0[2], o0[3]));
        *(uint2*)(CsT + (cl0 + 32) * CST + rl) = make_uint2(pack2(o1[0], o1[1]), pack2(o1[2], o1[3]));
      }
    }
  __syncthreads();
  if (want_rm) {
    u16* dst;
    size_t ld = 512;
    if (seg >= 8) { dst = WS_GT + (size_t)m0 * 3072 + (n0 - 4096); ld = 3072; }
    else {
      u16* base = seg == 0 ? WS_Q : seg == 1 ? WS_K : seg == 3 ? WS_G : seg == 4 ? WS_SU : seg == 5 ? WS_NQ : WS_NK;
      dst = base + (size_t)m0 * 512 + cs0;
    }
    cs_store(Cs, dst, ld, tid);
  }
  if (want_t) {
    u16* base = seg == 2 ? WS_VtR : seg == 7 ? WS_NVt : WS_KtR;
    u16* dst;
    size_t ld;
    if (!latent) { dst = base + ((size_t)(m0 >> 8) * 512 + cs0) * 256 + (m0 & 255); ld = 256; }
    else { dst = base + VTR_LAT + ((size_t)((m0 - TCTX) >> 10) * 512 + cs0) * 1024 + ((m0 - TCTX) & 1023); ld = 1024; }
    cs_store(CsT, dst, ld, tid);
  }
}

template <int D, int MODE>
__device__ __forceinline__ void attn_item(const Params& p, char* smem, int l, int idx) {
  constexpr int KSTR = D + 8;
  constexpr int NKS = D / 32;
  constexpr int NB = D / 16;
  constexpr int NCH = D / 32;
  u16* Ks = (u16*)smem;
  u16* Vts = Ks + 64 * KSTR;
  float* rpbs = (float*)(Vts + D * 72);
  const int tid = ltid(), lane = tid & 63, wave = tid >> 6;
  const int l15 = lane & 15, g = lane >> 4;

  int b, hh, qt, L, tokbase, nt;
  bool latent = false;
  int kr0 = 0, rrow = 0;
  if constexpr (MODE == 0) {
    if (idx < 256) { latent = true; b = idx >> 6; hh = (idx >> 4) & 3; qt = idx & 15; L = 1024; tokbase = TCTX + b * 1024; nt = 16 + 4; }
    else { idx -= 256; b = idx >> 4; hh = (idx >> 2) & 3; qt = idx & 3; L = 256; tokbase = b * 256; nt = 4; }
  } else if constexpr (MODE == 1) {
    b = idx >> 5; hh = (idx >> 2) & 7; qt = idx & 3; L = 256; tokbase = b * 256; nt = 4;
  } else {
    b = idx >> 7; hh = (idx >> 4) & 7; qt = idx & 15; rrow = qt; L = 1024; tokbase = TCTX + b * 1024; nt = 16; latent = true;
    kr0 = min(max(rrow - 4, 0), 8);
  }
  const int tq = qt * 64 + wave * 16 + l15;
  const int qtok = tokbase + tq;

  float lgf2 = 0.f, lgb2 = 0.f;
  if constexpr (MODE == 0) {
    float xf = p.ret_decay[(l * 2 + 0) * 4 + hh], xb = p.ret_decay[(l * 2 + 1) * 4 + hh];
    lgf2 = -log1pf(expf(-xf)) * 1.4426950408889634f;
    lgb2 = -log1pf(expf(-xb)) * 1.4426950408889634f;
  }

  __syncthreads();
  if constexpr (MODE == 2) {
    for (int i = tid; i < 465; i += 256) rpbs[i] = p.rpb[(size_t)(l * 8 + hh) * 465 + i];
  }

  u4v qf[NKS];
  {
    const u16* qb = (MODE == 0 ? WS_Q : WS_NQ) + (size_t)qtok * 512 + hh * D + g * 8;
#pragma unroll
    for (int ks = 0; ks < NKS; ++ks) qf[ks] = *(const u4v*)(qb + ks * 32);
  }

  f4v ot[NB];
#pragma unroll
  for (int nb = 0; nb < NB; ++nb) ot[nb] = (f4v){0.f, 0.f, 0.f, 0.f};
  float mrun = -1e30f, lsum = 0.f;

  const int ntk = (MODE == 0) ? (L >> 6) : nt;
  u4v kr[NCH], vr[NCH];
#define ATTN_ISSUE(KT)                                                                                   \
  {                                                                                                      \
    const int kt_ = (KT);                                                                                \
    const u16* kp; const u16* vp; int ldv;                                                               \
    if constexpr (MODE == 0) {                                                                           \
      kp = WS_K + (size_t)(tokbase + kt_ * 64) * 512 + hh * 128;                                          \
      if (latent) { vp = WS_VtR + VTR_LAT + ((size_t)(b * 4 + hh) * 128) * 1024 + kt_ * 64; ldv = 1024; } \
      else { vp = WS_VtR + ((size_t)(b * 4 + hh) * 128) * 256 + kt_ * 64; ldv = 256; }                    \
    } else if constexpr (MODE == 1) {                                                                    \
      kp = WS_NK + (size_t)(tokbase + kt_ * 64) * 512 + hh * 64;                                          \
      vp = WS_NVt + ((size_t)(b * 8 + hh) * 64) * 256 + kt_ * 64; ldv = 256;                              \
    } else {                                                                                             \
      if (kt_ < 8) {                                                                                     \
        const int krow = kr0 + kt_;                                                                      \
        kp = WS_NK + (size_t)(tokbase + krow * 64) * 512 + hh * 64;                                       \
        vp = WS_NVt + NVT_LAT + ((size_t)(b * 8 + hh) * 64) * 1024 + krow * 64; ldv = 1024;               \
      } else {                                                                                           \
        kp = WS_CK + ((size_t)(l * 4 + b) * 512 + (kt_ - 8) * 64) * 512 + hh * 64;                        \
        vp = WS_CVt + ((size_t)((l * 4 + b) * 8 + hh) * 64) * 512 + (kt_ - 8) * 64; ldv = 512;            \
      }                                                                                                  \
    }                                                                                                    \
    _Pragma("unroll") for (int i = 0; i < NCH; ++i) {                                                    \
      const int c = tid + 256 * i;                                                                       \
      const int r = c / (D / 8), cc = c % (D / 8);                                                       \
      kr[i] = *(const u4v*)(kp + (size_t)r * 512 + cc * 8);                                              \
      const int vrw = c >> 3, vc = c & 7;                                                                \
      vr[i] = *(const u4v*)(vp + (size_t)vrw * ldv + vc * 8);                                            \
    }                                                                                                    \
  }
#define ATTN_STAGE()                                                                                     \
  {                                                                                                      \
    _Pragma("unroll") for (int i = 0; i < NCH; ++i) {                                                    \
      const int c = tid + 256 * i;                                                                       \
      const int r = c / (D / 8), cc = c % (D / 8);                                                       \
      *(u4v*)(Ks + r * KSTR + cc * 8) = kr[i];                                                           \
      const int vrw = c >> 3, vc = c & 7;                                                                \
      *(u4v*)(Vts + vrw * 72 + vc * 8) = vr[i];                                                          \
    }                                                                                                    \
  }

  ATTN_ISSUE(0)
#pragma unroll 1
  for (int kt = 0; kt < ntk; ++kt) {
    __syncthreads();
    ATTN_STAGE()
    __syncthreads();
    if (kt + 1 < ntk) ATTN_ISSUE(kt + 1)
    f4v st[4];
#pragma unroll
    for (int kb = 0; kb < 4; ++kb) {
      st[kb] = (f4v){0.f, 0.f, 0.f, 0.f};
#pragma unroll
      for (int ks = 0; ks < NKS; ++ks) {
        s8v kf = *(const s8v*)(Ks + (kb * 16 + l15) * KSTR + ks * 32 + g * 8);
        st[kb] = __builtin_amdgcn_mfma_f32_16x16x32_bf16(kf, bc8(qf[ks]), st[kb], 0, 0, 0);
      }
    }
    if constexpr (MODE == 0) {
#pragma unroll
      for (int kb = 0; kb < 4; ++kb)
#pragma unroll
        for (int r = 0; r < 4; ++r) {
          const int ts = kt * 64 + kb * 16 + g * 4 + r;
          const int d = tq - ts;
          float dec = d > 0 ? exp2f(lgf2 * (float)d) : (d < 0 ? exp2f(lgb2 * (float)(-d)) : 2.f);
          st[kb][r] *= dec;
        }
    } else {
      if constexpr (MODE == 2) {
        if (kt < 8) {
          const int qc = wave * 16 + l15;
          const int ws = min(max(qc - 8, 0), 48);
          const int roff = (kr0 + kt) - rrow + 7;
#pragma unroll
          for (int kb = 0; kb < 4; ++kb)
#pragma unroll
            for (int r = 0; r < 4; ++r) {
              const int kc = kb * 16 + g * 4 + r;
              const bool valid = (kc >= ws) && (kc < ws + 16);
              const int coff = min(max(kc - qc + 15, 0), 30);
              const float bias = rpbs[roff * 31 + coff];
              st[kb][r] = valid ? st[kb][r] + bias : -1e30f;
            }
        }
      }
      float tmax = st[0][0];
#pragma unroll
      for (int kb = 0; kb < 4; ++kb)
#pragma unroll
        for (int r = 0; r < 4; ++r) tmax = fmaxf(tmax, st[kb][r]);
      tmax = fmaxf(tmax, __shfl_xor(tmax, 16));
      tmax = fmaxf(tmax, __shfl_xor(tmax, 32));
      const float mnew = fmaxf(mrun, tmax);
      const float alpha = __expf(mrun - mnew);
      float ps = 0.f;
#pragma unroll
      for (int kb = 0; kb < 4; ++kb)
#pragma unroll
        for (int r = 0; r < 4; ++r) {
          float e = __expf(st[kb][r] - mnew);
          st[kb][r] = e;
          ps += e;
        }
      lsum = lsum * alpha + ps;
      mrun = mnew;
#pragma unroll
      for (int nb = 0; nb < NB; ++nb) ot[nb] *= alpha;
    }
    u4v pf[2];
#pragma unroll
    for (int s = 0; s < 2; ++s) {
      pf[s] = (u4v){pack2(st[2 * s][0], st[2 * s][1]), pack2(st[2 * s][2], st[2 * s][3]),
                    pack2(st[2 * s + 1][0], st[2 * s + 1][1]), pack2(st[2 * s + 1][2], st[2 * s + 1][3])};
    }
#pragma unroll
    for (int nb = 0; nb < NB; ++nb)
#pragma unroll
      for (int s = 0; s < 2; ++s) {
        const u16* vb = Vts + (nb * 16 + l15) * 72 + s * 32 + g * 4;
        uint2 lo = *(const uint2*)(vb);
        uint2 hi = *(const uint2*)(vb + 16);
        u4v vf = (u4v){lo.x, lo.y, hi.x, hi.y};
        ot[nb] = __builtin_amdgcn_mfma_f32_16x16x32_bf16(bc8(vf), bc8(pf[s]), ot[nb], 0, 0, 0);
      }
  }

  if constexpr (MODE == 0) {
    if (latent) {
#pragma unroll 1
      for (int dir = 0; dir < 2; ++dir) {
        const float scale = dir == 0 ? exp2f(lgf2 * (float)(tq + 1)) : exp2f(lgb2 * (float)(L - tq));
        const u16* S0 = WS_S0t + ((size_t)(((l * 4 + b) * 2 + dir) * 4 + hh)) * 16384;
#pragma unroll
        for (int s = 0; s < NKS; ++s) {
          u4v pq = (u4v){pack2(bflo(qf[s][0]) * scale, bfhi(qf[s][0]) * scale), pack2(bflo(qf[s][1]) * scale, bfhi(qf[s][1]) * scale),
                         pack2(bflo(qf[s][2]) * scale, bfhi(qf[s][2]) * scale), pack2(bflo(qf[s][3]) * scale, bfhi(qf[s][3]) * scale)};
#pragma unroll
          for (int nb = 0; nb < NB; ++nb) {
            u4v vf = *(const u4v*)(S0 + (size_t)(nb * 16 + l15) * 128 + s * 32 + g * 8);
            ot[nb] = __builtin_amdgcn_mfma_f32_16x16x32_bf16(bc8(vf), bc8(pq), ot[nb], 0, 0, 0);
          }
        }
      }
    }
    float s = 0.f;
#pragma unroll
    for (int nb = 0; nb < NB; ++nb) s += ot[nb][0] + ot[nb][1] + ot[nb][2] + ot[nb][3];
    s += __shfl_xor(s, 16); s += __shfl_xor(s, 32);
    const float mu = s * (1.f / 128.f);
    float q = 0.f;
#pragma unroll
    for (int nb = 0; nb < NB; ++nb)
#pragma unroll
      for (int r = 0; r < 4; ++r) { float dlt = ot[nb][r] - mu; q += dlt * dlt; }
    q += __shfl_xor(q, 16); q += __shfl_xor(q, 32);
    const float rstd = rsqrtf(q * (1.f / 128.f) + LNEPS);
#pragma unroll
    for (int nb = 0; nb < NB; ++nb) {
      const size_t off = (size_t)qtok * 512 + hh * 128 + nb * 16 + g * 4;
      uint2 gg = *(const uint2*)(WS_G + off);
      float o0 = (ot[nb][0] - mu) * rstd * bflo(gg.x);
      float o1 = (ot[nb][1] - mu) * rstd * bfhi(gg.x);
      float o2 = (ot[nb][2] - mu) * rstd * bflo(gg.y);
      float o3 = (ot[nb][3] - mu) * rstd * bfhi(gg.y);
      *(uint2*)(WS_rout + off) = make_uint2(pack2(o0, o1), pack2(o2, o3));
    }
  } else {
    lsum += __shfl_xor(lsum, 16); lsum += __shfl_xor(lsum, 32);
    const float inv = 1.f / lsum;
#pragma unroll
    for (int nb = 0; nb < NB; ++nb) {
      const size_t off = (size_t)qtok * 512 + hh * 64 + nb * 16 + g * 4;
      *(uint2*)(WS_nout + off) = make_uint2(pack2(ot[nb][0] * inv, ot[nb][1] * inv), pack2(ot[nb][2] * inv, ot[nb][3] * inv));
    }
  }
}

__device__ __forceinline__ void retstate_item(const Params& p, int l, int idx) {
  const int dir = idx & 1, hh = (idx >> 1) & 3, b = idx >> 3;
  const int tid = ltid(), lane = tid & 63, wave = tid >> 6;
  const int r = lane & 31, h2 = lane >> 5;
  const float x = p.ret_decay[(l * 2 + dir) * 4 + hh];
  const float lg2 = -log1pf(expf(-x)) * 1.4426950408889634f;
  const u16* Kt = WS_KtR + ((size_t)(b * 4 + hh) * 128) * 256;
  const u16* Vt = WS_VtR + ((size_t)(b * 4 + hh) * 128) * 256;
  f16v acc[4];
#pragma unroll
  for (int i = 0; i < 4; ++i) acc[i] = zero16();
#pragma unroll 2
  for (int ks = 0; ks < 16; ++ks) {
    const int tok0 = ks * 16 + h2 * 8;
    const u4v a = *(const u4v*)(Kt + (size_t)(wave * 32 + r) * 256 + tok0);
    u4v af;
#pragma unroll
    for (int w = 0; w < 4; ++w) {
      const int t0 = tok0 + 2 * w, t1 = t0 + 1;
      float w0 = dir == 0 ? exp2f(lg2 * (float)(255 - t0)) : exp2f(lg2 * (float)t0);
      float w1 = dir == 0 ? exp2f(lg2 * (float)(255 - t1)) : exp2f(lg2 * (float)t1);
      af[w] = pack2(bflo(a[w]) * w0, bfhi(a[w]) * w1);
    }
#pragma unroll
    for (int nt = 0; nt < 4; ++nt) {
      const u4v bfr = *(const u4v*)(Vt + (size_t)(nt * 32 + r) * 256 + tok0);
      acc[nt] = __builtin_amdgcn_mfma_f32_32x32x16_bf16(bc8(af), bc8(bfr), acc[nt], 0, 0, 0);
    }
  }
  float* o = p.out + OUT_SRET + ((size_t)(((b * 2 + l) * 2 + dir) * 4 + hh)) * 16384;
#pragma unroll
  for (int nt = 0; nt < 4; ++nt)
#pragma unroll
    for (int reg = 0; reg < 16; ++reg) {
      const int dk = wave * 32 + (reg & 3) + 8 * (reg >> 2) + 4 * h2;
      o[(size_t)dk * 128 + nt * 32 + r] = acc[nt][reg];
    }
}

__device__ __forceinline__ void s5_item(const Params& p, char* smem, int l, int item) {
  const int tid = ltid(), lane = tid & 63, wave = tid >> 6;
  const int l15 = lane & 15, g4 = lane >> 4;
  int seq = item * 4 + wave;
  int b, dir, g, L, tokbase;
  bool latent;
  if (seq < 256) { latent = true; b = seq >> 6; dir = (seq >> 5) & 1; g = seq & 31; L = 1024; tokbase = TCTX + b * 1024; }
  else { seq -= 256; latent = false; b = seq >> 6; dir = (seq >> 5) & 1; g = seq & 31; L = 256; tokbase = b * 256; }
  float* buf = (float*)smem + wave * (16 * 132);
  const int tg = (l * 2 + dir) * 32 + g;
  const float ar = WS_abar[(tg * 64 + lane) * 2], ai = WS_abar[(tg * 64 + lane) * 2 + 1];
  u4v bfrag[8];
#pragma unroll
  for (int nt = 0; nt < 8; ++nt) {
    if (g4 < 2) bfrag[nt] = *(const u4v*)(WS_bbarT + ((size_t)tg * 128 + nt * 16 + l15) * 16 + g4 * 8);
    else bfrag[nt] = (u4v){0u, 0u, 0u, 0u};
  }
  u4v cfrag[4];
#pragma unroll
  for (int ks = 0; ks < 4; ++ks) cfrag[ks] = *(const u4v*)(WS_cmT + ((size_t)tg * 16 + l15) * 128 + ks * 32 + g4 * 8);
  float xr = 0.f, xi = 0.f;
  if (latent) {
    const float* h0 = p.state_ssm + ((size_t)(((b * 2 + l) * 2 + dir) * 32 + g) * 64 + lane) * 2;
    xr = h0[0]; xi = h0[1];
  }
  u16* yd = WS_YD + (size_t)dir * TALL * 512;
  __syncthreads();
  const int nsub = L >> 4;
  u4v afn = (u4v){0u, 0u, 0u, 0u};
  if (g4 < 2) {
    const int pos = dir == 0 ? l15 : L - 1 - l15;
    afn = *(const u4v*)(WS_SU + (size_t)(tokbase + pos) * 512 + g * 16 + g4 * 8);
  }
#pragma unroll 1
  for (int sub = 0; sub < nsub; ++sub) {
    const u4v af = afn;
    if (g4 < 2 && sub + 1 < nsub) {
      const int tau = (sub + 1) * 16 + l15;
      const int pos = dir == 0 ? tau : L - 1 - tau;
      afn = *(const u4v*)(WS_SU + (size_t)(tokbase + pos) * 512 + g * 16 + g4 * 8);
    }
#pragma unroll
    for (int nt = 0; nt < 8; ++nt) {
      f4v c = (f4v){0.f, 0.f, 0.f, 0.f};
      c = __builtin_amdgcn_mfma_f32_16x16x32_bf16(bc8(af), bc8(bfrag[nt]), c, 0, 0, 0);
#pragma unroll
      for (int r = 0; r < 4; ++r) buf[(g4 * 4 + r) * 132 + nt * 16 + l15] = c[r];
    }
    __builtin_amdgcn_wave_barrier();
#pragma unroll
    for (int i = 0; i < 16; ++i) {
      const float bur = buf[i * 132 + lane], bui = buf[i * 132 + 64 + lane];
      const float nr = ar * xr - ai * xi + bur;
      const float ni = ar * xi + ai * xr + bui;
      xr = nr; xi = ni;
      buf[i * 132 + lane] = xr;
      buf[i * 132 + 64 + lane] = xi;
    }
    __builtin_amdgcn_wave_barrier();
    f4v y = (f4v){0.f, 0.f, 0.f, 0.f};
#pragma unroll
    for (int ks = 0; ks < 4; ++ks) {
      const float* bp = buf + l15 * 132 + ks * 32 + g4 * 8;
      float4 v0 = *(const float4*)(bp), v1 = *(const float4*)(bp + 4);
      const u4v xa = (u4v){pack2(v0.x, v0.y), pack2(v0.z, v0.w), pack2(v1.x, v1.y), pack2(v1.z, v1.w)};
      y = __builtin_amdgcn_mfma_f32_16x16x32_bf16(bc8(xa), bc8(cfrag[ks]), y, 0, 0, 0);
    }
#pragma unroll
    for (int r = 0; r < 4; ++r) {
      const int tau = sub * 16 + g4 * 4 + r;
      const int pos = dir == 0 ? tau : L - 1 - tau;
      yd[(size_t)(tokbase + pos) * 512 + g * 16 + l15] = f2bf(y[r]);
    }
    __builtin_amdgcn_wave_barrier();
  }
  if (!latent) {
    float* o = p.out + OUT_SSSM + ((size_t)(((b * 2 + l) * 2 + dir) * 32 + g) * 64 + lane) * 2;
    o[0] = xr; o[1] = xi;
  }
}

#define MX_S5 320
#define MX_RET 512
#define MX_NA 512
#define MX_CA 512
#define MX_RS 128
#define MX_ITEMS (MX_S5 + MX_RET + MX_NA + MX_CA + MX_RS)
__device__ __forceinline__ void mixer_item(const Params& p, char* smem, int l, int item) {
  if (item < 64) { s5_item(p, smem, l, item); return; }
  item -= 64;
  if (item < 256) { attn_item<128, 0>(p, smem, l, item); return; }
  item -= 256;
  if (item < 512) { attn_item<64, 2>(p, smem, l, item); return; }
  item -= 512;
  if (item < 256) { s5_item(p, smem, l, 64 + item); return; }
  item -= 256;
  if (item < 256) { attn_item<128, 0>(p, smem, l, 256 + item); return; }
  item -= 256;
  if (item < 512) { attn_item<64, 1>(p, smem, l, item); return; }
  item -= 512;
  retstate_item(p, l, item);
}

__device__ __forceinline__ void p3a_item(const Params& p, char* smem, int l, int item) {
  const int mt = item & 63, nt = item >> 6;
  const int m0 = mt * 128, n0 = nt * 128;
  const int tid = ltid(), lane = tid & 63, wave = tid >> 6, wm = wave >> 1, wn = wave & 1;
  AArgs a{};
  a.SU = WS_SU; a.YD0 = WS_YD; a.YD1 = WS_YD + (size_t)TALL * 512; a.dsk = p.ssm_d + l * 512;
  f16v acc[2][2];
  gemm_mainloop<2>(smem, a, WS_Wt + WT_LAYER * l + WT_GLU, 512, 512, m0, n0, acc);
#pragma unroll
  for (int mi = 0; mi < 2; ++mi)
#pragma unroll
    for (int reg = 0; reg < 16; ++reg) {
      const int row = EPI_ROW(mi, reg);
#pragma unroll
      for (int ni = 0; ni < 2; ++ni) {
        const int col = EPI_COL(ni);
        const size_t off = (size_t)row * 512 + col;
        float y = geluf_(a.dsk[col] * bf2f(WS_SU[off]) + bf2f(a.YD0[off]) + bf2f(a.YD1[off]));
        WS_sout[off] = f2bf(y * sigmoidf_(acc[mi][ni][reg]));
      }
    }
}

__device__ __forceinline__ void p3b_item(const Params& p, char* smem, int l, int item) {
  const int mt = item & 63, nt = item >> 6;
  const int m0 = mt * 128, n0 = nt * 128;
  const int tid = ltid(), lane = tid & 63, wave = tid >> 6, wm = wave >> 1, wn = wave & 1;
  int nbr = 3;
  asm volatile("" : "+s"(nbr));
#pragma unroll 1
  for (int br = 0; br < nbr; ++br) {
    const u16* Abr = br == 0 ? WS_rout : (br == 1 ? WS_sout : WS_nout);
    f16v acc[2][2];
    gemm_mainloop0(smem, Abr, 512, WS_Wt + WT_LAYER * l + WT_BR + (size_t)br * 512 * 1024, 512, 512, m0, n0, acc);
    u16* Cs = (u16*)smem;
    {
      const int rl0 = wm * 64 + 4 * (lane >> 5), cl0 = wn * 64 + (lane & 31);
#pragma unroll
      for (int mi = 0; mi < 2; ++mi)
#pragma unroll
        for (int reg = 0; reg < 16; ++reg) {
          const int rl = rl0 + mi * 32 + (reg & 3) + 8 * (reg >> 2);
          Cs[rl * CST + cl0] = f2bf(acc[mi][0][reg]);
          Cs[rl * CST + cl0 + 32] = f2bf(acc[mi][1][reg]);
        }
    }
    __syncthreads();
    int tl = tid;
    asm volatile("" : "+v"(tl));
#pragma unroll
    for (int i = 0; i < 8; ++i) {
      const int c = tl + 256 * i, r = c >> 4, ch = c & 15;
      const u4v av = *(const u4v*)(Cs + r * CST + ch * 8);
      const u4v gv = *(const u4v*)(WS_GT + (size_t)(m0 + r) * 3072 + br * 1024 + n0 + ch * 8);
      u16* mp = WS_merged + (size_t)(m0 + r) * 1024 + n0 + ch * 8;
      u4v mv = (u4v){0u, 0u, 0u, 0u};
      if (br > 0) mv = *(const u4v*)mp;
      u4v ov;
#pragma unroll
      for (int j = 0; j < 4; ++j)
        ov[j] = pack2(fmaf(bflo(gv[j]), bflo(av[j]), bflo(mv[j])), fmaf(bfhi(gv[j]), bfhi(av[j]), bfhi(mv[j])));
      *(u4v*)mp = ov;
    }
  }
}


#define CFS 132
__device__ __forceinline__ void epi_resid(char* smem, f16v (&acc)[2][2], int m0, int n0, const float* __restrict__ gvec,
                                          const float* __restrict__ xlo, const float* __restrict__ xhi,
                                          const float* __restrict__ xstats, const float* __restrict__ lng,
                                          const float* __restrict__ lnb, float* __restrict__ dst,
                                          float* __restrict__ stats_out, bool do_stats) {
  float* Cf = (float*)smem;
  const int tid = ltid(), lane = tid & 63, wave = tid >> 6, wm = wave >> 1, wn = wave & 1;
  {
    const int rl0 = wm * 64 + 4 * (lane >> 5), cl0 = wn * 64 + (lane & 31);
    const float ga = gvec[n0 + cl0], gb = gvec[n0 + cl0 + 32];
#pragma unroll
    for (int mi = 0; mi < 2; ++mi)
#pragma unroll
      for (int reg = 0; reg < 16; ++reg) {
        const int rl = rl0 + mi * 32 + (reg & 3) + 8 * (reg >> 2);
        Cf[rl * CFS + cl0] = ga * acc[mi][0][reg];
        Cf[rl * CFS + cl0 + 32] = gb * acc[mi][1][reg];
      }
  }
  __syncthreads();
  const int ch = tid & 31, r0 = tid >> 5;
  const int col = n0 + ch * 4;
  float4 g4 = make_float4(1.f, 1.f, 1.f, 1.f), b4 = make_float4(0.f, 0.f, 0.f, 0.f);
  if (xstats) { g4 = *(const float4*)(lng + col); b4 = *(const float4*)(lnb + col); }
  const float* xbase = (m0 < TCTX ? xlo + (size_t)m0 * 1024 : xhi + (size_t)(m0 - TCTX) * 1024) + col;
#pragma unroll 4
  for (int i = 0; i < 16; ++i) {
    const int r = r0 + 8 * i;
    const int row = m0 + r;
    const float4 v = *(const float4*)(Cf + r * CFS + ch * 4);
    float4 x = *(const float4*)(xbase + (size_t)r * 1024);
    if (xstats) {
      const float s = xstats[row * 2], q = xstats[row * 2 + 1];
      const float mu = s * (1.f / 1024.f);
      const float rstd = rsqrtf(fmaxf(q * (1.f / 1024.f) - mu * mu, 0.f) + LNEPS);
      x.x = (x.x - mu) * rstd * g4.x + b4.x; x.y = (x.y - mu) * rstd * g4.y + b4.y;
      x.z = (x.z - mu) * rstd * g4.z + b4.z; x.w = (x.w - mu) * rstd * g4.w + b4.w;
    }
    float4 o;
    o.x = ALPHA * x.x + v.x; o.y = ALPHA * x.y + v.y; o.z = ALPHA * x.z + v.z; o.w = ALPHA * x.w + v.w;
    *(float4*)(dst + (size_t)row * 1024 + col) = o;
    if (do_stats) {
      float ss = o.x + o.y + o.z + o.w, qq = o.x * o.x + o.y * o.y + o.z * o.z + o.w * o.w;
#pragma unroll
      for (int sh = 1; sh < 32; sh <<= 1) { ss += __shfl_xor(ss, sh); qq += __shfl_xor(qq, sh); }
      if (ch == 0) { atomicAdd(stats_out + row * 2, ss); atomicAdd(stats_out + row * 2 + 1, qq); }
    }
  }
}

__device__ __forceinline__ void p3c_item(const Params& p, char* smem, int l, int item, bool do_stats = true) {
  const int mt = item & 63, nt = item >> 6;
  const int m0 = mt * 128, n0 = nt * 128;
  const int tid = ltid(), lane = tid & 63, wave = tid >> 6, wm = wave >> 1, wn = wave & 1;
  f16v acc[2][2];
  gemm_mainloop0(smem, WS_merged, 1024, WS_Wt + WT_LAYER * l + WT_O, 1024, 1024, m0, n0, acc);
  const int ci = cond_of_row(m0);
  const float* g1 = WS_mod + (l * 5 + ci) * 6144 + 2048;
  float* st1 = WS_stats + (size_t)(l * 2 + 0) * TALL * 2;
  if (l == 0)
    epi_resid(smem, acc, m0, n0, g1, p.x_prompt, p.x_sample, nullptr, nullptr, nullptr, WS_pre1, st1, do_stats);
  else
    epi_resid(smem, acc, m0, n0, g1, p.out, p.out + (size_t)TCTX * 1024, WS_stats + (size_t)(0 * 2 + 1) * TALL * 2, p.ln2_g, p.ln2_b,
              WS_pre1, st1, do_stats);
}

__device__ __forceinline__ void p4_item(const Params& p, char* smem, int l, int item) {
  const int mt = item & 63, nt = item >> 6;
  const int m0 = mt * 128, n0 = nt * 128;
  const int tid = ltid(), lane = tid & 63, wave = tid >> 6, wm = wave >> 1, wn = wave & 1;
  f16v acc[2][2];
  gemm_mainloop0(smem, WS_h2, 1024, WS_Wt + WT_LAYER * l + WT_UP, 1024, 1024, m0, n0, acc);
  u16* Cs = (u16*)smem;
  const int rl0 = wm * 64 + 4 * (lane >> 5), cl0 = wn * 64 + (lane & 31);
#pragma unroll
  for (int mi = 0; mi < 2; ++mi)
#pragma unroll
    for (int reg = 0; reg < 16; ++reg) {
      const int rl = rl0 + mi * 32 + (reg & 3) + 8 * (reg >> 2);
      Cs[rl * CST + cl0] = f2bf(acc[mi][0][reg]);
      Cs[rl * CST + cl0 + 32] = f2bf(acc[mi][1][reg]);
    }
  __syncthreads();
  cs_store(Cs, WS_z2 + (size_t)m0 * 5632 + n0, 5632, tid);
}

__device__ __forceinline__ void p4b_item(const Params& p, int l, int item) {
  const int tid = ltid();
  if (tid >= 176) return;
  const int rb = item >> 1, hf = item & 1;
  const int j0 = (hf * 176 + tid) * 8;
  const float* cw = p.conv_w + (size_t)l * 3 * 5632;
  const float* cb = p.conv_b + (size_t)l * 5632;
  float wa[3][8], wb[3][8], ba[8], bb[8];
#pragma unroll
  for (int t = 0; t < 3; ++t)
#pragma unroll
    for (int h = 0; h < 2; ++h) {
      const float4 x = *(const float4*)(cw + t * 5632 + j0 + 4 * h), y = *(const float4*)(cw + t * 5632 + 2816 + j0 + 4 * h);
      wa[t][4 * h] = x.x; wa[t][4 * h + 1] = x.y; wa[t][4 * h + 2] = x.z; wa[t][4 * h + 3] = x.w;
      wb[t][4 * h] = y.x; wb[t][4 * h + 1] = y.y; wb[t][4 * h + 2] = y.z; wb[t][4 * h + 3] = y.w;
    }
#pragma unroll
  for (int h = 0; h < 2; ++h) {
    const float4 x = *(const float4*)(cb + j0 + 4 * h), y = *(const float4*)(cb + 2816 + j0 + 4 * h);
    ba[4 * h] = x.x; ba[4 * h + 1] = x.y; ba[4 * h + 2] = x.z; ba[4 * h + 3] = x.w;
    bb[4 * h] = y.x; bb[4 * h + 1] = y.y; bb[4 * h + 2] = y.z; bb[4 * h + 3] = y.w;
  }
  const int row0 = rb * 32;
  int pos0, L;
  if (row0 < TCTX) { pos0 = row0 & 255; L = 256; } else { pos0 = (row0 - TCTX) & 1023; L = 1024; }
  const u16* zr = WS_z2 + (size_t)row0 * 5632 + j0;
  const u4v zero = (u4v){0u, 0u, 0u, 0u};
  u4v pa = zero, pb = zero;
  if (pos0 > 0) { pa = *(const u4v*)(zr - 5632); pb = *(const u4v*)(zr - 5632 + 2816); }
  u4v ca = *(const u4v*)(zr), cb2 = *(const u4v*)(zr + 2816);
#pragma unroll 2
  for (int r = 0; r < 32; ++r) {
    u4v na = zero, nb = zero;
    if (pos0 + r < L - 1) { na = *(const u4v*)(zr + (size_t)(r + 1) * 5632); nb = *(const u4v*)(zr + (size_t)(r + 1) * 5632 + 2816); }
    u4v ov;
#pragma unroll
    for (int w = 0; w < 4; ++w) {
      const float a0 = wa[0][2 * w] * bflo(pa[w]) + wa[1][2 * w] * bflo(ca[w]) + wa[2][2 * w] * bflo(na[w]) + ba[2 * w];
      const float a1 = wa[0][2 * w + 1] * bfhi(pa[w]) + wa[1][2 * w + 1] * bfhi(ca[w]) + wa[2][2 * w + 1] * bfhi(na[w]) + ba[2 * w + 1];
      const float b0 = wb[0][2 * w] * bflo(pb[w]) + wb[1][2 * w] * bflo(cb2[w]) + wb[2][2 * w] * bflo(nb[w]) + bb[2 * w];
      const float b1 = wb[0][2 * w + 1] * bfhi(pb[w]) + wb[1][2 * w + 1] * bfhi(cb2[w]) + wb[2][2 * w + 1] * bfhi(nb[w]) + bb[2 * w + 1];
      ov[w] = pack2(geluf_(a0) * b0, geluf_(a1) * b1);
    }
    *(u4v*)(WS_act + (size_t)(row0 + r) * 2816 + j0) = ov;
    pa = ca; pb = cb2; ca = na; cb2 = nb;
  }
}

__device__ __forceinline__ void p5_item(const Params& p, char* smem, int l, int item, bool do_stats = true) {
  const int mt = item & 63, nt = item >> 6;
  const int m0 = mt * 128, n0 = nt * 128;
  const int tid = ltid(), lane = tid & 63, wave = tid >> 6, wm = wave >> 1, wn = wave & 1;
  f16v acc[2][2];
  gemm_mainloop0(smem, WS_act, 2816, WS_Wt + WT_LAYER * l + WT_DOWN, 2816, 2816, m0, n0, acc);
  const int ci = cond_of_row(m0);
  const float* g2 = WS_mod + (l * 5 + ci) * 6144 + 5 * 1024;
  epi_resid(smem, acc, m0, n0, g2, WS_pre1, WS_pre1 + (size_t)TCTX * 1024, WS_stats + (size_t)(l * 2 + 0) * TALL * 2,
            p.ln1_g + l * 1024, p.ln1_b + l * 1024, p.out, WS_stats + (size_t)(l * 2 + 1) * TALL * 2, do_stats);
}

__device__ __forceinline__ void final_item(const Params& p, int item) {
  const float* st = WS_stats + (size_t)(1 * 2 + 1) * TALL * 2;
  const int c = ltid() * 4;
  const float4 g = *(const float4*)(p.ln2_g + 1024 + c);
  const float4 b = *(const float4*)(p.ln2_b + 1024 + c);
  for (int r = 0; r < 8; ++r) {
    const int row = item * 8 + r;
    const float s = st[row * 2], q = st[row * 2 + 1];
    const float mu = s * (1.f / 1024.f);
    const float rstd = rsqrtf(fmaxf(q * (1.f / 1024.f) - mu * mu, 0.f) + LNEPS);
    float4 v = *(float4*)(p.out + (size_t)row * 1024 + c);
    v.x = (v.x - mu) * rstd * g.x + b.x;
    v.y = (v.y - mu) * rstd * g.y + b.y;
    v.z = (v.z - mu) * rstd * g.z + b.z;
    v.w = (v.w - mu) * rstd * g.w + b.w;
    *(float4*)(p.out + (size_t)row * 1024 + c) = v;
  }
}

#define XB_TMO      128
#define XB_XCNT(j)  (256  + 64 * (j))
#define XB_XSUB(j)  (1280 + 64 * (j))
#define XB_XGEN(j)  (2304 + 64 * (j))
#define XB_TOP      3328
#define XB_TOPGEN   3392
#define XCD_BAR_WORDS 3456
#define XB_SPIN_CAP (1u << 18)
#define LAS __attribute__((address_space(3)))

__device__ __forceinline__ unsigned xb_ld(unsigned* p)              { return __hip_atomic_load(p, __ATOMIC_RELAXED, __HIP_MEMORY_SCOPE_AGENT); }
__device__ __forceinline__ unsigned xb_add(unsigned* p, unsigned v) { return __hip_atomic_fetch_add(p, v, __ATOMIC_RELAXED, __HIP_MEMORY_SCOPE_AGENT); }
__device__ __forceinline__ unsigned xb_xcc_id() { return (unsigned)__builtin_amdgcn_s_getreg((3 << 11) | 20) & 0xFu; }
#define XB_SPIN(cond, bar) do { unsigned _sp = 0; while (cond) { __builtin_amdgcn_s_sleep(1); \
    if ((++_sp & 255u) == 0u) { if (xb_ld(&(bar)[XB_TMO])) break; if (_sp > XB_SPIN_CAP) { atomicAdd(&(bar)[XB_TMO], 1u); break; } } } } while (0)

struct XcdBarrier {
    unsigned* bar; unsigned x;
    volatile LAS unsigned* st;
};

__device__ __forceinline__ XcdBarrier xcd_barrier_post(unsigned* bar, volatile LAS unsigned* st) {
    XcdBarrier b; b.bar = bar; b.x = xb_xcc_id(); b.st = st;
    if (threadIdx.x == 0) (void)xb_add(&bar[XB_XCNT(b.x)], 1u);
    return b;
}
__device__ __forceinline__ void xcd_barrier_complete(unsigned* bar, unsigned x, unsigned& nloc, unsigned& nx) {
    const unsigned G = gridDim.x * gridDim.y * gridDim.z;
    unsigned sum, cnt, mine, sp = 0u;
    for (;;) {
        sum = 0u; cnt = 0u; mine = 0u;
#pragma unroll
        for (unsigned j = 0; j < 16; ++j) { const unsigned c = xb_ld(&bar[XB_XCNT(j)]); sum += c; cnt += (c > 0u) ? 1u : 0u; mine = (j == x) ? c : mine; }
        if (sum == G) break;
        __builtin_amdgcn_s_sleep(1);
        if ((++sp & 255u) == 0u) { if (xb_ld(&bar[XB_TMO])) break; if (sp > XB_SPIN_CAP) { atomicAdd(&bar[XB_TMO], 1u); break; } }
    }
    nloc = mine > 0u ? mine : 1u; nx = cnt > 0u ? cnt : 1u;
}

__device__ __forceinline__ void xcd_barrier(const XcdBarrier& b) {
    asm volatile("s_waitcnt vmcnt(0)" ::: "memory");
    __syncthreads();
    if (threadIdx.x == 0) {
        unsigned* bar = b.bar;
        __builtin_amdgcn_s_waitcnt(0);
        unsigned nloc = b.st[0], nx = b.st[1];
        if (nloc == 0u) { xcd_barrier_complete(bar, b.x, nloc, nx); b.st[0] = nloc; b.st[1] = nx; }
        const unsigned old = xb_add(&bar[XB_XSUB(b.x)], 1u);
        const unsigned gen = old / nloc;
        if (old + 1u == (gen + 1u) * nloc) {
            __builtin_amdgcn_fence(__ATOMIC_RELEASE, "agent");
            asm volatile("s_waitcnt vmcnt(0)" ::: "memory");
            const unsigned og = xb_add(&bar[XB_TOP], 1u);
            const unsigned tg = og / nx;
            if (og + 1u == (tg + 1u) * nx) xb_add(&bar[XB_TOPGEN], 1u);
            else XB_SPIN(xb_ld(&bar[XB_TOPGEN]) == tg, bar);
            __builtin_amdgcn_fence(__ATOMIC_ACQUIRE, "agent");
            xb_add(&bar[XB_XGEN(b.x)], 1u);
            asm volatile("s_waitcnt vmcnt(0)" ::: "memory");
        } else {
            XB_SPIN(xb_ld(&bar[XB_XGEN(b.x)]) == gen, bar);
            __builtin_amdgcn_fence(__ATOMIC_ACQUIRE, "agent");
            asm volatile("s_waitcnt vmcnt(0)" ::: "memory");
        }
    }
    __syncthreads();
}


#define NPHASES 22
#ifndef REPMASK
#define REPMASK 0
#endif
#define REPS(PH) (((PH) == 0 ? (REPMASK >> 10) : (PH) == 21 ? (REPMASK >> 11) : (REPMASK >> (((PH) - 1) % 10))) & 1)
#define RUN_PHASE(PH, N, CALL)                                              \
  if (ph_lo <= (PH) && (PH) < ph_hi) {                                      \
    for (int rep_ = 0; rep_ <= REPS(PH); ++rep_)                            \
    for (int it = blockIdx.x; it < (N); it += nb) { CALL; }                 \
    if ((PH) + 1 < ph_hi) xcd_barrier(xb);                                  \
  }
#define RUN_GEMM_PHASE(PH, NT, CALL)                                                          \
  if (ph_lo <= (PH) && (PH) < ph_hi) {                                                        \
    const int xcd_ = blockIdx.x & 7, slot_ = blockIdx.x >> 3, spx_ = (int)gridDim.x >> 3;      \
    const int nsuper_ = 8 * (((NT) + 7) >> 3);                                                \
    for (int rep_ = 0; rep_ <= REPS(PH); ++rep_)                                              \
    for (int s_ = xcd_; s_ < nsuper_; s_ += 8)                                                \
      for (int j_ = slot_; j_ < 64; j_ += spx_) {                                             \
        const int mt_ = (s_ & 7) * 8 + (j_ & 7), nt_ = (s_ >> 3) * 8 + (j_ >> 3);             \
        if (nt_ < (NT)) { const int it = nt_ * 64 + mt_; CALL; }                              \
      }                                                                                       \
    if ((PH) + 1 < ph_hi) xcd_barrier(xb);                                                    \
  }
#define RUN_MIXER_PHASE(PH, L)                                                                \
  if (ph_lo <= (PH) && (PH) < ph_hi) {                                                        \
    for (int rep_ = 0; rep_ <= REPS(PH); ++rep_) {                                            \
      unsigned* ctr_ = (unsigned*)(p.ws + OFF_ctr) + 64 * (2 * (L) + rep_);                   \
      for (;;) {                                                                              \
        __syncthreads();                                                                      \
        if (threadIdx.x == 0) wq_item = (int)atomicAdd(ctr_, 1u);                             \
        __syncthreads();                                                                      \
        const int it = wq_item;                                                               \
        if (it >= MX_ITEMS) break;                                                            \
        mixer_item(p, smem, (L), it);                                                         \
      }                                                                                       \
    }                                                                                         \
    if ((PH) + 1 < ph_hi) xcd_barrier(xb);                                                    \
  }
#define RUN_LAYER(L)                                                         \
  RUN_PHASE(1 + 10 * (L) + 0, 1024, hmat_item(p, (L), 0, it))                \
  RUN_GEMM_PHASE(1 + 10 * (L) + 1, 56, p1_item(p, smem, (L), it))            \
  RUN_MIXER_PHASE(1 + 10 * (L) + 2, (L))                                     \
  RUN_GEMM_PHASE(1 + 10 * (L) + 3, 4, p3a_item(p, smem, (L), it))            \
  RUN_GEMM_PHASE(1 + 10 * (L) + 4, 8, p3b_item(p, smem, (L), it))            \
  RUN_GEMM_PHASE(1 + 10 * (L) + 5, 8, p3c_item(p, smem, (L), it, rep_ == 0)) \
  RUN_PHASE(1 + 10 * (L) + 6, 1024, hmat_item(p, (L), 1, it))                \
  RUN_GEMM_PHASE(1 + 10 * (L) + 7, 44, p4_item(p, smem, (L), it))            \
  RUN_PHASE(1 + 10 * (L) + 8, 512, p4b_item(p, (L), it))                     \
  RUN_GEMM_PHASE(1 + 10 * (L) + 9, 8, p5_item(p, smem, (L), it, rep_ == 0))

__global__ void __launch_bounds__(256, 2) mega(Params p, int ph_lo, int ph_hi) {
  extern __shared__ __attribute__((aligned(16))) char smem[];
  __shared__ uint4 xb_words;
  __shared__ int wq_item;
  const int nb = gridDim.x;
  if (threadIdx.x == 0) xb_words = make_uint4(0u, 0u, 0u, 0u);
  __syncthreads();
  XcdBarrier xb;
  xb.bar = (unsigned*)(p.ws + OFF_bar); xb.x = 0; xb.st = (volatile LAS unsigned*)&xb_words;
  if (ph_hi - ph_lo > 1) xb = xcd_barrier_post((unsigned*)(p.ws + OFF_bar), (volatile LAS unsigned*)&xb_words);
  if (ph_hi > 1000) cg::this_grid().sync();
  RUN_PHASE(0, P0_ITEMS, phase0_item(p, smem, it))
  RUN_LAYER(0)
  RUN_LAYER(1)
  RUN_PHASE(21, 1024, final_item(p, it))
}

extern "C" void kernel_launch(void* const* d_in, const int* in_sizes, int n_in, void* d_out, int out_size, void* d_ws,
                              size_t ws_size, hipStream_t stream) {
  Params p{};
  const float** ins = (const float**)&p;
  for (int i = 0; i < 32; ++i) ins[i] = (const float*)d_in[i];
  p.out = (float*)d_out;
  char* ws = (char*)d_ws;
  p.ws = ws;
  if (WS_TOTAL > ws_size) {
    fprintf(stderr, "kernel_launch: workspace too small (%zu needed, %zu given)\n", (size_t)WS_TOTAL, ws_size);
    return;
  }
  (void)hipMemsetAsync(ws, 0, ZERO_BYTES, stream);
#if SINGLE_LAUNCH
  static int grid_blocks = 0;
  if (!grid_blocks) {
    int dev = 0, cus = 0, per_cu = 0;
    (void)hipGetDevice(&dev);
    (void)hipDeviceGetAttribute(&cus, hipDeviceAttributeMultiprocessorCount, dev);
    (void)hipFuncSetAttribute((const void*)mega, hipFuncAttributeMaxDynamicSharedMemorySize, LDS_BYTES);
    (void)hipOccupancyMaxActiveBlocksPerMultiprocessor(&per_cu, mega, 256, LDS_BYTES);
    if (per_cu > 2) per_cu = 2;
    if (per_cu < 1) per_cu = 1;
    grid_blocks = cus * per_cu;
  }
  int lo = 0, hi = NPHASES;
  void* args[] = {&p, &lo, &hi};
  hipError_t e = hipLaunchCooperativeKernel((void*)mega, dim3(grid_blocks), dim3(256), args, LDS_BYTES, stream);
  if (e != hipSuccess) fprintf(stderr, "cooperative launch failed: %s (grid %d)\n", hipGetErrorString(e), grid_blocks);
#else
  for (int ph = 0; ph < NPHASES; ++ph) {
    hipLaunchKernelGGL(mega, dim3(512), dim3(256), LDS_BYTES, stream, p, ph, ph + 1);
  }
#endif
}
```

```cpp
#include <hip/hip_runtime.h>
#include <hip/hip_cooperative_groups.h>
#include <cstdio>
namespace cg = cooperative_groups;

#ifndef SINGLE_LAUNCH
#define SINGLE_LAUNCH 1
#endif

typedef __attribute__((ext_vector_type(8))) short s8v;
typedef __attribute__((ext_vector_type(4))) float f4v;
typedef __attribute__((ext_vector_type(16))) float f16v;
typedef unsigned short u16;
typedef __attribute__((ext_vector_type(4))) unsigned u4v;
__device__ __forceinline__ s8v bc8(u4v x) { return __builtin_bit_cast(s8v, x); }


#define TALL 8192
#define TCTX 4096
#define ALPHA 1.41421356237309515f
#define LNEPS 1e-5f
#define VTR_LAT 2097152
#define NVT_LAT 2097152
#define OUT_SRET 8388608
#define OUT_SSSM 12582912
#define OUT_CK 12845056
#define OUT_CV 17039360
#define WT_IN 0
#define WT_GLU (WT_IN + 7168 * 1024)
#define WT_BR (WT_GLU + 512 * 512)
#define WT_O (WT_BR + 3 * 1024 * 512)
#define WT_UP (WT_O + 1024 * 1024)
#define WT_DOWN (WT_UP + 5632 * 1024)
#define WT_LAYER ((size_t)(WT_DOWN + 1024 * 2816))

struct Params {
  const float *x_prompt, *x_sample, *state_ret, *state_ssm, *cache_k, *cache_v, *c, *c_ctx;
  const float *w_ada, *b_ada, *w_in, *ret_decay, *a_re, *a_im, *log_dt, *b_re, *b_im, *c_re, *c_im;
  const float *ssm_d, *w_glu, *rpb, *w_branch, *w_o, *ln1_g, *ln1_b, *w_up, *conv_w, *conv_b, *w_down, *ln2_g, *ln2_b;
  float* out;
  char* ws;
};

typedef __bf16 bf2v __attribute__((ext_vector_type(2)));
typedef float fl2v __attribute__((ext_vector_type(2)));
__device__ __forceinline__ unsigned pack2(float a, float b) {
  fl2v f = {a, b};
  bf2v h = __builtin_convertvector(f, bf2v);
  return __builtin_bit_cast(unsigned, h);
}
__device__ __forceinline__ u16 f2bf(float f) { return (u16)(pack2(f, 0.f) & 0xffffu); }

constexpr size_t al256(size_t x) { return (x + 255) & ~(size_t)255; }
constexpr size_t EB = (size_t)TALL * 512 * 2;
constexpr size_t OFF_mod = 0;
constexpr size_t OFF_stats = OFF_mod + al256(2 * 5 * 6144 * 4);
constexpr size_t OFF_bar = OFF_stats + al256(2 * 2 * TALL * 2 * 4);
constexpr size_t OFF_ctr = OFF_bar + al256(3456 * 4);
constexpr size_t ZERO_BYTES = OFF_ctr + al256(8 * 256);
constexpr size_t OFF_ropetab = ZERO_BYTES;
constexpr size_t OFF_abar = OFF_ropetab + al256(64 * 32 * 2 * 4);
constexpr size_t OFF_bbarT = OFF_abar + al256(2 * 2 * 32 * 64 * 2 * 4);
constexpr size_t OFF_cmT = OFF_bbarT + al256(2 * 2 * 32 * 128 * 16 * 2);
constexpr size_t OFF_CK = OFF_cmT + al256(2 * 2 * 32 * 16 * 128 * 2);
constexpr size_t OFF_CVt = OFF_CK + al256((size_t)2 * 4 * 512 * 512 * 2);
constexpr size_t OFF_S0t = OFF_CVt + al256((size_t)2 * 4 * 512 * 512 * 2);
constexpr size_t OFF_Wt = OFF_S0t + al256((size_t)2 * 4 * 2 * 4 * 128 * 128 * 2);
constexpr size_t OFF_REGION = OFF_Wt + al256(2 * WT_LAYER * 2);
constexpr size_t OFF_z2 = OFF_REGION;
constexpr size_t OFF_act = OFF_z2 + (size_t)TALL * 5632 * 2;
constexpr size_t OFF_pre1 = OFF_act + (size_t)TALL * 2816 * 2;
constexpr size_t WS_TOTAL = OFF_pre1 + (size_t)TALL * 1024 * 4;
constexpr size_t OFF_K = OFF_pre1;
constexpr size_t OFF_VtR = OFF_K + EB;
constexpr size_t OFF_NQ = OFF_VtR + EB;
constexpr size_t OFF_NK = OFF_NQ + EB;
constexpr size_t OFF_GT = OFF_REGION;
constexpr size_t OFF_rout = OFF_GT + (size_t)TALL * 3072 * 2;
constexpr size_t OFF_nout = OFF_rout + EB;
constexpr size_t OFF_YD = OFF_nout + EB;
constexpr size_t OFF_merged = OFF_YD;
constexpr size_t OFF_Q = OFF_YD + 2 * EB;
constexpr size_t OFF_sout = OFF_Q;
constexpr size_t OFF_KtR = OFF_Q + EB;
constexpr size_t OFF_G = OFF_KtR + EB / 2;
constexpr size_t OFF_SU = OFF_G + EB;
constexpr size_t OFF_NVt = OFF_SU + EB;
constexpr size_t OFF_h1 = OFF_NVt + EB;
constexpr size_t OFF_h2 = OFF_act;
static_assert(OFF_h1 + 2 * EB <= OFF_pre1, "mixer buffers overflow the z2+act area");
#define WS_h1 ((u16*)(p.ws + OFF_h1))
#define WS_h2 ((u16*)(p.ws + OFF_h2))
#define WS_mod ((float*)(p.ws + OFF_mod))
#define WS_stats ((float*)(p.ws + OFF_stats))
#define WS_ropetab ((float*)(p.ws + OFF_ropetab))
#define WS_abar ((float*)(p.ws + OFF_abar))
#define WS_pre1 ((float*)(p.ws + OFF_pre1))
#define WS_bbarT ((u16*)(p.ws + OFF_bbarT))
#define WS_cmT ((u16*)(p.ws + OFF_cmT))
#define WS_CK ((u16*)(p.ws + OFF_CK))
#define WS_CVt ((u16*)(p.ws + OFF_CVt))
#define WS_S0t ((u16*)(p.ws + OFF_S0t))
#define WS_Wt ((u16*)(p.ws + OFF_Wt))
#define WS_Q ((u16*)(p.ws + OFF_Q))
#define WS_K ((u16*)(p.ws + OFF_K))
#define WS_VtR ((u16*)(p.ws + OFF_VtR))
#define WS_KtR ((u16*)(p.ws + OFF_KtR))
#define WS_G ((u16*)(p.ws + OFF_G))
#define WS_SU ((u16*)(p.ws + OFF_SU))
#define WS_NQ ((u16*)(p.ws + OFF_NQ))
#define WS_NK ((u16*)(p.ws + OFF_NK))
#define WS_NVt ((u16*)(p.ws + OFF_NVt))
#define WS_GT ((u16*)(p.ws + OFF_GT))
#define WS_rout ((u16*)(p.ws + OFF_rout))
#define WS_sout ((u16*)(p.ws + OFF_sout))
#define WS_nout ((u16*)(p.ws + OFF_nout))
#define WS_YD ((u16*)(p.ws + OFF_YD))
#define WS_merged ((u16*)(p.ws + OFF_merged))
#define WS_z2 ((u16*)(p.ws + OFF_z2))
#define WS_act ((u16*)(p.ws + OFF_act))

__device__ __forceinline__ float bf2f(unsigned h) { return __uint_as_float((h & 0xffffu) << 16); }
__device__ __forceinline__ float bflo(unsigned w) { return __uint_as_float(w << 16); }
__device__ __forceinline__ float bfhi(unsigned w) { return __uint_as_float(w & 0xffff0000u); }
__device__ __forceinline__ float sigmoidf_(float x) { return 1.f / (1.f + __expf(-x)); }
__device__ __forceinline__ float siluf_(float x) { return x / (1.f + __expf(-x)); }
__device__ __forceinline__ float geluf_(float x) {
  float u = 0.7978845608028654f * (x + 0.044715f * x * x * x);
  float e = __expf(2.f * u);
  float t = 1.f - 2.f / (e + 1.f);
  return 0.5f * x * (1.f + t);
}
__device__ __forceinline__ f16v zero16() {
  return (f16v){0.f, 0.f, 0.f, 0.f, 0.f, 0.f, 0.f, 0.f, 0.f, 0.f, 0.f, 0.f, 0.f, 0.f, 0.f, 0.f};
}
__device__ __forceinline__ int ltid() { int t = threadIdx.x; asm volatile("" : "+v"(t)); return t; }
__device__ __forceinline__ int cond_of_row(int row) { return row < TCTX ? 0 : 1 + ((row - TCTX) >> 10); }

struct AArgs {
  const u16* A16; int lda;
  const float* A32lo; const float* A32hi;
  const float* stats;
  const float* lng; const float* lnb;
  const float* sc; const float* sh;
  const u16* SU; const u16* YD0; const u16* YD1; const float* dsk;
};

#define GST 72
#define LDS_GEMM (2 * 2 * 128 * GST * 2)
#define LDS_BYTES LDS_GEMM

template <int AMODE>
__device__ __forceinline__ void gemm_mainloop(char* smem, const AArgs& a, const u16* __restrict__ Bt, int ldb, int K,
                                              int m0, int n0, f16v (&acc)[2][2]) {
  u16* As = (u16*)smem;
  u16* Bs = As + 2 * 128 * GST;
  const int tid = ltid(), lane = tid & 63, wave = tid >> 6;
  const int wm = wave >> 1, wn = wave & 1;
  const int crow = tid >> 3, cch = tid & 7;
  const int frow = tid >> 4, fch = tid & 15;
  float rs[8], nm[8];
  const float* srow0 = nullptr;
  const float *gsc = nullptr, *gsh = nullptr;
  __syncthreads();
  if constexpr (AMODE == 1) {
    const int ci = cond_of_row(m0);
    gsc = a.sc + ci * 6144; gsh = a.sh + ci * 6144;
#pragma unroll
    for (int i = 0; i < 8; ++i) {
      rs[i] = 1.f; nm[i] = 0.f;
      if (a.stats) {
        const int row = m0 + frow + 16 * i;
        const float s = a.stats[row * 2], q = a.stats[row * 2 + 1];
        const float mu = s * (1.f / 1024.f);
        const float var = q * (1.f / 1024.f) - mu * mu;
        rs[i] = rsqrtf(fmaxf(var, 0.f) + LNEPS);
        nm[i] = -mu * rs[i];
      }
    }
    const int row0 = m0 + frow;
    srow0 = (row0 < TCTX ? a.A32lo + (size_t)row0 * 1024 : a.A32hi + (size_t)(row0 - TCTX) * 1024) + fch * 4;
  }
  acc[0][0] = zero16(); acc[0][1] = zero16(); acc[1][0] = zero16(); acc[1][1] = zero16();

  u4v ra[12], rb[4];
  float4 q0, q1, q2, q3;
  q0 = q1 = q3 = make_float4(0.f, 0.f, 0.f, 0.f); q2 = make_float4(1.f, 1.f, 1.f, 1.f);
  const u16* brow = Bt + (size_t)(n0 + crow) * ldb + cch * 8;
  auto issue = [&](int kt) {
    if constexpr (AMODE == 1) {
      const int k = kt * 64 + fch * 4;
      q0 = *(const float4*)(gsc + k); q1 = *(const float4*)(gsh + k);
      if (a.lng) { q2 = *(const float4*)(a.lng + k); q3 = *(const float4*)(a.lnb + k); }
    } else if constexpr (AMODE == 2) {
      const int k0 = kt * 64 + cch * 8;
      q0 = *(const float4*)(a.dsk + k0); q1 = *(const float4*)(a.dsk + k0 + 4);
    }
    if constexpr (AMODE == 0) {
      const u16* ap = a.A16 + (size_t)(m0 + crow) * a.lda + kt * 64 + cch * 8;
#pragma unroll
      for (int i = 0; i < 4; ++i) ra[i] = *(const u4v*)(ap + (size_t)(32 * i) * a.lda);
    } else if constexpr (AMODE == 1) {
#pragma unroll
      for (int i = 0; i < 8; ++i) ra[i] = *(const u4v*)(srow0 + (size_t)(16 * i) * 1024 + kt * 64);
    } else {
      const size_t o = (size_t)(m0 + crow) * 512 + kt * 64 + cch * 8;
#pragma unroll
      for (int i = 0; i < 4; ++i) {
        ra[i] = *(const u4v*)(a.SU + o + (size_t)(32 * i) * 512);
        ra[4 + i] = *(const u4v*)(a.YD0 + o + (size_t)(32 * i) * 512);
        ra[8 + i] = *(const u4v*)(a.YD1 + o + (size_t)(32 * i) * 512);
      }
    }
#pragma unroll
    for (int i = 0; i < 4; ++i) rb[i] = *(const u4v*)(brow + (size_t)(32 * i) * ldb + kt * 64);
  };
  auto stage = [&](int buf, int kt) {
    u16* Ad = As + buf * (128 * GST);
    if constexpr (AMODE == 0) {
#pragma unroll
      for (int i = 0; i < 4; ++i) *(u4v*)(Ad + (crow + 32 * i) * GST + cch * 8) = ra[i];
    } else if constexpr (AMODE == 1) {
      const float4 sc = q0, sh = q1, g = q2, b = q3;
      const float G0 = g.x * (1.f + sc.x), G1 = g.y * (1.f + sc.y), G2 = g.z * (1.f + sc.z), G3 = g.w * (1.f + sc.w);
      const float B0 = fmaf(b.x, 1.f + sc.x, sh.x), B1 = fmaf(b.y, 1.f + sc.y, sh.y), B2 = fmaf(b.z, 1.f + sc.z, sh.z), B3 = fmaf(b.w, 1.f + sc.w, sh.w);
#pragma unroll
      for (int i = 0; i < 8; ++i) {
        const float h0 = fmaf(fmaf(__uint_as_float(ra[i][0]), rs[i], nm[i]), G0, B0);
        const float h1 = fmaf(fmaf(__uint_as_float(ra[i][1]), rs[i], nm[i]), G1, B1);
        const float h2 = fmaf(fmaf(__uint_as_float(ra[i][2]), rs[i], nm[i]), G2, B2);
        const float h3 = fmaf(fmaf(__uint_as_float(ra[i][3]), rs[i], nm[i]), G3, B3);
        *(uint2*)(Ad + (frow + 16 * i) * GST + fch * 4) = make_uint2(pack2(h0, h1), pack2(h2, h3));
      }
    } else {
      const float4 da = q0, db = q1;
      const float dd[8] = {da.x, da.y, da.z, da.w, db.x, db.y, db.z, db.w};
#pragma unroll
      for (int i = 0; i < 4; ++i) {
        u4v o;
#pragma unroll
        for (int j = 0; j < 4; ++j) {
          const float v0 = geluf_(dd[2 * j] * bflo(ra[i][j]) + bflo(ra[4 + i][j]) + bflo(ra[8 + i][j]));
          const float v1 = geluf_(dd[2 * j + 1] * bfhi(ra[i][j]) + bfhi(ra[4 + i][j]) + bfhi(ra[8 + i][j]));
          o[j] = pack2(v0, v1);
        }
        *(u4v*)(Ad + (crow + 32 * i) * GST + cch * 8) = o;
      }
    }
    u16* Bd = Bs + buf * (128 * GST);
#pragma unroll
    for (int i = 0; i < 4; ++i) *(u4v*)(Bd + (crow + 32 * i) * GST + cch * 8) = rb[i];
  };
  auto compute = [&](int buf) {
    const u16* Ab = As + buf * (128 * GST) + (wm * 64 + (lane & 31)) * GST + (lane >> 5) * 8;
    const u16* Bb = Bs + buf * (128 * GST) + (wn * 64 + (lane & 31)) * GST + (lane >> 5) * 8;
#pragma unroll
    for (int ks = 0; ks < 4; ++ks) {
      s8v af0 = *(const s8v*)(Ab + ks * 16);
      s8v af1 = *(const s8v*)(Ab + 32 * GST + ks * 16);
      s8v bf0 = *(const s8v*)(Bb + ks * 16);
      s8v bf1 = *(const s8v*)(Bb + 32 * GST + ks * 16);
      acc[0][0] = __builtin_amdgcn_mfma_f32_32x32x16_bf16(af0, bf0, acc[0][0], 0, 0, 0);
      acc[0][1] = __builtin_amdgcn_mfma_f32_32x32x16_bf16(af0, bf1, acc[0][1], 0, 0, 0);
      acc[1][0] = __builtin_amdgcn_mfma_f32_32x32x16_bf16(af1, bf0, acc[1][0], 0, 0, 0);
      acc[1][1] = __builtin_amdgcn_mfma_f32_32x32x16_bf16(af1, bf1, acc[1][1], 0, 0, 0);
    }
  };

  const int nk = K >> 6;
  issue(0);
  stage(0, 0);
  __syncthreads();
#pragma unroll 1
  for (int kt = 0; kt < nk; ++kt) {
    const int buf = kt & 1;
    if (kt + 1 < nk) issue(kt + 1);
    compute(buf);
    if (kt + 1 < nk) stage(buf ^ 1, kt + 1);
    __syncthreads();
  }
}

__device__ __forceinline__ void gemm_mainloop0(char* smem, const u16* __restrict__ A, int lda, const u16* __restrict__ Bt, int ldb,
                                               int K, int m0, int n0, f16v (&acc)[2][2]) {
  u16* As = (u16*)smem;
  u16* Bs = As + 2 * 128 * GST;
  const int tid = ltid(), lane = tid & 63, wave = tid >> 6;
  const int wm = wave >> 1, wn = wave & 1;
  const int crow = tid >> 3, cch = tid & 7;
  __syncthreads();
  acc[0][0] = zero16(); acc[0][1] = zero16(); acc[1][0] = zero16(); acc[1][1] = zero16();
  const u16* arow = A + (size_t)(m0 + crow) * lda + cch * 8;
  const u16* brow = Bt + (size_t)(n0 + crow) * ldb + cch * 8;
  const size_t a32 = (size_t)32 * lda, b32 = (size_t)32 * ldb;
  u4v eA0, eA1, eA2, eA3, eB0, eB1, eB2, eB3, oA0, oA1, oA2, oA3, oB0, oB1, oB2, oB3;
#define G0_ISSUE(P, kt)                                                                                   \
  { const u16* ap_ = arow + (kt) * 64; const u16* bp_ = brow + (kt) * 64;                                 \
    P##A0 = *(const u4v*)(ap_); P##A1 = *(const u4v*)(ap_ + a32); P##A2 = *(const u4v*)(ap_ + 2 * a32);   \
    P##A3 = *(const u4v*)(ap_ + 3 * a32);                                                                 \
    P##B0 = *(const u4v*)(bp_); P##B1 = *(const u4v*)(bp_ + b32); P##B2 = *(const u4v*)(bp_ + 2 * b32);   \
    P##B3 = *(const u4v*)(bp_ + 3 * b32); }
#define G0_STAGE(P, buf)                                                                                  \
  { u16* Ad_ = As + (buf) * (128 * GST) + crow * GST + cch * 8; u16* Bd_ = Bs + (buf) * (128 * GST) + crow * GST + cch * 8; \
    *(u4v*)(Ad_) = P##A0; *(u4v*)(Ad_ + 32 * GST) = P##A1; *(u4v*)(Ad_ + 64 * GST) = P##A2; *(u4v*)(Ad_ + 96 * GST) = P##A3; \
    *(u4v*)(Bd_) = P##B0; *(u4v*)(Bd_ + 32 * GST) = P##B1; *(u4v*)(Bd_ + 64 * GST) = P##B2; *(u4v*)(Bd_ + 96 * GST) = P##B3; }
#define G0_COMPUTE(buf)                                                                                   \
  { const u16* Ab = As + (buf) * (128 * GST) + (wm * 64 + (lane & 31)) * GST + (lane >> 5) * 8;           \
    const u16* Bb = Bs + (buf) * (128 * GST) + (wn * 64 + (lane & 31)) * GST + (lane >> 5) * 8;           \
    _Pragma("unroll") for (int ks = 0; ks < 4; ++ks) {                                                    \
      s8v af0 = *(const s8v*)(Ab + ks * 16);                                                              \
      s8v af1 = *(const s8v*)(Ab + 32 * GST + ks * 16);                                                   \
      s8v bf0 = *(const s8v*)(Bb + ks * 16);                                                              \
      s8v bf1 = *(const s8v*)(Bb + 32 * GST + ks * 16);                                                   \
      acc[0][0] = __builtin_amdgcn_mfma_f32_32x32x16_bf16(af0, bf0, acc[0][0], 0, 0, 0);                  \
      acc[0][1] = __builtin_amdgcn_mfma_f32_32x32x16_bf16(af0, bf1, acc[0][1], 0, 0, 0);                  \
      acc[1][0] = __builtin_amdgcn_mfma_f32_32x32x16_bf16(af1, bf0, acc[1][0], 0, 0, 0);                  \
      acc[1][1] = __builtin_amdgcn_mfma_f32_32x32x16_bf16(af1, bf1, acc[1][1], 0, 0, 0);                  \
    } }
  const int nk = K >> 6;
  G0_ISSUE(e, 0)
  G0_ISSUE(o, 1)
  G0_STAGE(e, 0)
  __syncthreads();
  int kt = 0;
#pragma unroll 1
  for (; kt + 3 < nk; kt += 2) {
    G0_ISSUE(e, kt + 2)
    __builtin_amdgcn_sched_barrier(0);
    G0_COMPUTE(0)
    G0_STAGE(o, 1)
    __syncthreads();
    G0_ISSUE(o, kt + 3)
    __builtin_amdgcn_sched_barrier(0);
    G0_COMPUTE(1)
    G0_STAGE(e, 0)
    __syncthreads();
  }
  G0_COMPUTE(0)
  G0_STAGE(o, 1)
  __syncthreads();
  G0_COMPUTE(1)
  __syncthreads();
#undef G0_ISSUE
#undef G0_STAGE
#undef G0_COMPUTE
}

#define EPI_ROW(mi, reg) (m0 + wm * 64 + (mi) * 32 + ((reg) & 3) + 8 * ((reg) >> 2) + 4 * (lane >> 5))
#define EPI_COL(ni) (n0 + wn * 64 + (ni) * 32 + (lane & 31))


#define CST 136
__device__ __forceinline__ void cs_store(const u16* Cs, u16* __restrict__ dst, size_t ld, int tid) {
#pragma unroll
  for (int i = 0; i < 8; ++i) {
    const int c = tid + 256 * i, r = c >> 4, ch = c & 15;
    *(u4v*)(dst + (size_t)r * ld + ch * 8) = *(const u4v*)(Cs + r * CST + ch * 8);
  }
}

__device__ __forceinline__ void stats_accum(float* stats, int row, float v0, float v1, int lane) {
  float s = v0 + v1, q = v0 * v0 + v1 * v1;
#pragma unroll
  for (int o = 1; o < 32; o <<= 1) {
    s += __shfl_xor(s, o);
    q += __shfl_xor(q, o);
  }
  if ((lane & 31) == 0) {
    atomicAdd(stats + row * 2, s);
    atomicAdd(stats + row * 2 + 1, q);
  }
}

#define P0_ADA 768
#define P0_ROPE 1
#define P0_CACHE 64
#define P0_S0 64
#define P0_S5 128
#define P0_WT_PER_LAYER (16 * 112 + 8 * 8 + 3 * 8 * 16 + 16 * 16 + 16 * 88 + 44 * 16)
#define P0_WT (2 * P0_WT_PER_LAYER)
#define P0_ITEMS (P0_ADA + P0_ROPE + P0_CACHE + P0_S0 + P0_S5 + P0_WT)

__device__ __forceinline__ void wt_tile(const float* __restrict__ src, int N, u16* __restrict__ dst, int ldd, int kt, int nt, char* smem) {
  float* tile = (float*)smem;
  const int tid = ltid();
  __syncthreads();
  {
    const int c4 = (tid & 15) * 4, r0 = tid >> 4;
#pragma unroll
    for (int i = 0; i < 4; ++i) {
      const int k = r0 + 16 * i;
      const float4 v = *(const float4*)(src + (size_t)(kt * 64 + k) * N + nt * 64 + c4);
      tile[k * 65 + c4] = v.x; tile[k * 65 + c4 + 1] = v.y; tile[k * 65 + c4 + 2] = v.z; tile[k * 65 + c4 + 3] = v.w;
    }
  }
  __syncthreads();
  {
    const int n = tid >> 2, k0 = (tid & 3) * 16;
#define WTP(j) pack2(tile[(k0 + 2 * (j)) * 65 + n], tile[(k0 + 2 * (j) + 1) * 65 + n])
    u4v* d = (u4v*)(dst + (size_t)(nt * 64 + n) * ldd + kt * 64 + k0);
    d[0] = (u4v){WTP(0), WTP(1), WTP(2), WTP(3)};
    d[1] = (u4v){WTP(4), WTP(5), WTP(6), WTP(7)};
#undef WTP
  }
}
__device__ __forceinline__ void wt_item(const Params& p, char* smem, int item) {
  const int l = item / P0_WT_PER_LAYER;
  int it = item % P0_WT_PER_LAYER;
  u16* base = WS_Wt + WT_LAYER * l;
  if (it < 16 * 112) { wt_tile(p.w_in + (size_t)l * 1024 * 7168, 7168, base + WT_IN, 1024, it / 112, it % 112, smem); return; }
  it -= 16 * 112;
  if (it < 64) { wt_tile(p.w_glu + (size_t)l * 512 * 512, 512, base + WT_GLU, 512, it / 8, it % 8, smem); return; }
  it -= 64;
  if (it < 384) { const int br = it / 128; it %= 128;
    wt_tile(p.w_branch + ((size_t)l * 3 + br) * 512 * 1024, 1024, base + WT_BR + (size_t)br * 512 * 1024, 512, it / 16, it % 16, smem); return; }
  it -= 384;
  if (it < 256) { wt_tile(p.w_o + (size_t)l * 1024 * 1024, 1024, base + WT_O, 1024, it / 16, it % 16, smem); return; }
  it -= 256;
  if (it < 16 * 88) { wt_tile(p.w_up + (size_t)l * 1024 * 5632, 5632, base + WT_UP, 1024, it / 88, it % 88, smem); return; }
  it -= 16 * 88;
  wt_tile(p.w_down + (size_t)l * 2816 * 1024, 1024, base + WT_DOWN, 2816, it / 16, it % 16, smem);
}

__device__ __forceinline__ void phase0_item(const Params& p, char* smem, int item) {
  const int tid = ltid();
  if (item < P0_ADA) {
    const int ks = item & 3, cg = (item >> 2) % 96, l = item / 384;
    float* scs = (float*)smem;
    float* red = scs + 5 * 256;
    __syncthreads();
    for (int i = tid; i < 5 * 256; i += 256) {
      int ci = i >> 8, k = ks * 256 + (i & 255);
      float v = ci == 0 ? p.c_ctx[k] : p.c[(ci - 1) * 1024 + k];
      scs[i] = siluf_(v);
    }
    __syncthreads();
    const int ct = tid & 15, kg = tid >> 4;
    const float* wp = p.w_ada + (size_t)l * 1024 * 6144 + (size_t)(ks * 256 + kg * 16) * 6144 + cg * 64 + ct * 4;
    float acc[5][4];
#pragma unroll
    for (int i = 0; i < 5; ++i)
#pragma unroll
      for (int j = 0; j < 4; ++j) acc[i][j] = 0.f;
#pragma unroll 4
    for (int k = 0; k < 16; ++k) {
      float4 w = *(const float4*)(wp + (size_t)k * 6144);
#pragma unroll
      for (int ci = 0; ci < 5; ++ci) {
        float s = scs[ci * 256 + kg * 16 + k];
        acc[ci][0] += s * w.x; acc[ci][1] += s * w.y; acc[ci][2] += s * w.z; acc[ci][3] += s * w.w;
      }
    }
#pragma unroll
    for (int ci = 0; ci < 5; ++ci)
#pragma unroll
      for (int j = 0; j < 4; ++j) red[(kg * 5 + ci) * 64 + ct * 4 + j] = acc[ci][j];
    __syncthreads();
    for (int i = tid; i < 320; i += 256) {
      int ci = i >> 6, col = i & 63;
      float s = 0.f;
#pragma unroll
      for (int g = 0; g < 16; ++g) s += red[(g * 5 + ci) * 64 + col];
      if (ks == 0) s += p.b_ada[l * 6144 + cg * 64 + col];
      atomicAdd(WS_mod + (l * 5 + ci) * 6144 + cg * 64 + col, s);
    }
    return;
  }
  item -= P0_ADA;
  if (item < P0_ROPE) {
    for (int i = tid; i < 64 * 32; i += 256) {
      int pos = i >> 5, fi = i & 31;
      float inv = (float)pow(10000.0, -(double)fi / 32.0);
      float ang = (float)pos * inv;
      WS_ropetab[i * 2] = (float)cos((double)ang);
      WS_ropetab[i * 2 + 1] = (float)sin((double)ang);
    }
    return;
  }
  item -= P0_ROPE;
  if (item < P0_CACHE) {
    const int pc = item & 7, b = (item >> 3) & 3, l = item >> 5;
    const float* ksrc = p.cache_k + ((size_t)(b * 2 + l) * 512 + pc * 64) * 512;
    const float* vsrc = p.cache_v + ((size_t)(b * 2 + l) * 512 + pc * 64) * 512;
    u16* kdst = WS_CK + ((size_t)(l * 4 + b) * 512 + pc * 64) * 512;
    for (int i = tid; i < 64 * 512 / 4; i += 256) {
      float4 v = *(const float4*)(ksrc + (size_t)i * 4);
      *(uint2*)(kdst + (size_t)i * 4) = make_uint2(pack2(v.x, v.y), pack2(v.z, v.w));
    }
    for (int cc = 0; cc < 2; ++cc) {
      const int col = tid + cc * 256;
      u16* vdst = WS_CVt + ((size_t)(l * 4 + b) * 512 + col) * 512 + pc * 64;
      for (int j = 0; j < 8; ++j) {
        float v[8];
#pragma unroll
        for (int e = 0; e < 8; ++e) v[e] = vsrc[(size_t)(j * 8 + e) * 512 + col];
        *(uint4*)(vdst + j * 8) = make_uint4(pack2(v[0], v[1]), pack2(v[2], v[3]), pack2(v[4], v[5]), pack2(v[6], v[7]));
      }
    }
    return;
  }
  item -= P0_CACHE;
  if (item < P0_S0) {
    const int hh = item & 3, dir = (item >> 2) & 1, b = (item >> 3) & 3, l = item >> 5;
    const float* src = p.state_ret + ((size_t)(((b * 2 + l) * 2 + dir) * 4 + hh)) * 16384;
    u16* dst = WS_S0t + ((size_t)(((l * 4 + b) * 2 + dir) * 4 + hh)) * 16384;
    const int dv = tid & 127, kh = tid >> 7;
    for (int j = 0; j < 8; ++j) {
      const int dk0 = kh * 64 + j * 8;
      float v[8];
#pragma unroll
      for (int e = 0; e < 8; ++e) v[e] = src[(size_t)(dk0 + e) * 128 + dv];
      *(uint4*)(dst + (size_t)dv * 128 + dk0) = make_uint4(pack2(v[0], v[1]), pack2(v[2], v[3]), pack2(v[4], v[5]), pack2(v[6], v[7]));
    }
    return;
  }
  item -= P0_S0;
  if (item >= P0_S5) { wt_item(p, smem, item - P0_S5); return; }
  {
    const int g = item & 31, dir = (item >> 5) & 1, l = item >> 6;
    if (tid < 64) {
      const int pp = tid;
      const int ai = ((l * 2 + dir) * 32 + g) * 64 + pp;
      double lre = fmin((double)p.a_re[ai], -1e-4), lim = (double)p.a_im[ai];
      double dt = exp((double)p.log_dt[(l * 2 + dir) * 32 + g]);
      double er = exp(lre * dt);
      double abr = er * cos(lim * dt), abi = er * sin(lim * dt);
      WS_abar[ai * 2] = (float)abr;
      WS_abar[ai * 2 + 1] = (float)abi;
      double nr = abr - 1.0, ni = abi;
      double den = lre * lre + lim * lim;
      double cr = (nr * lre + ni * lim) / den, cim = (ni * lre - nr * lim) / den;
      u16* bt = WS_bbarT + (size_t)((l * 2 + dir) * 32 + g) * 128 * 16;
      const float* br = p.b_re + ((size_t)(l * 32 + g) * 64 + pp) * 16;
      const float* bi = p.b_im + ((size_t)(l * 32 + g) * 64 + pp) * 16;
      for (int c = 0; c < 16; ++c) {
        double xr = br[c], xi = bi[c];
        bt[pp * 16 + c] = f2bf((float)(cr * xr - cim * xi));
        bt[(64 + pp) * 16 + c] = f2bf((float)(cr * xi + cim * xr));
      }
      u16* ct = WS_cmT + (size_t)((l * 2 + dir) * 32 + g) * 16 * 128;
      const float* cre = p.c_re + ((size_t)((l * 2 + dir) * 32 + g) * 16) * 64;
      const float* cie = p.c_im + ((size_t)((l * 2 + dir) * 32 + g) * 16) * 64;
      for (int c = 0; c < 16; ++c) {
        ct[c * 128 + pp] = f2bf(cre[c * 64 + pp]);
        ct[c * 128 + 64 + pp] = f2bf(-cie[c * 64 + pp]);
      }
    }
  }
}


__device__ __forceinline__ void hmat_item(const Params& p, int l, int which, int item) {
  const int c = ltid() * 4;
  const int row0 = item * 8;
  const int ci = cond_of_row(row0);
  const float* mod = WS_mod + (l * 5 + ci) * 6144;
  const float4 sc = *(const float4*)(mod + (which ? 4 : 1) * 1024 + c);
  const float4 sh = *(const float4*)(mod + (which ? 3 : 0) * 1024 + c);
  float4 g = make_float4(1.f, 1.f, 1.f, 1.f), b = make_float4(0.f, 0.f, 0.f, 0.f);
  const float* st = nullptr;
  if (which == 1) { g = *(const float4*)(p.ln1_g + l * 1024 + c); b = *(const float4*)(p.ln1_b + l * 1024 + c); st = WS_stats + (size_t)(l * 2 + 0) * TALL * 2; }
  else if (l == 1) { g = *(const float4*)(p.ln2_g + c); b = *(const float4*)(p.ln2_b + c); st = WS_stats + (size_t)(0 * 2 + 1) * TALL * 2; }
  const float G0 = g.x * (1.f + sc.x), G1 = g.y * (1.f + sc.y), G2 = g.z * (1.f + sc.z), G3 = g.w * (1.f + sc.w);
  const float B0 = fmaf(b.x, 1.f + sc.x, sh.x), B1 = fmaf(b.y, 1.f + sc.y, sh.y), B2 = fmaf(b.z, 1.f + sc.z, sh.z), B3 = fmaf(b.w, 1.f + sc.w, sh.w);
  u16* dst = which ? WS_h2 : WS_h1;
#pragma unroll
  for (int r = 0; r < 8; ++r) {
    const int row = row0 + r;
    const float* src;
    if (which == 1) src = WS_pre1 + (size_t)row * 1024;
    else if (l == 1) src = p.out + (size_t)row * 1024;
    else src = row < TCTX ? p.x_prompt + (size_t)row * 1024 : p.x_sample + (size_t)(row - TCTX) * 1024;
    float rs = 1.f, nm = 0.f;
    if (st) {
      const float s = st[row * 2], q = st[row * 2 + 1];
      const float mu = s * (1.f / 1024.f);
      rs = rsqrtf(fmaxf(q * (1.f / 1024.f) - mu * mu, 0.f) + LNEPS);
      nm = -mu * rs;
    }
    const float4 x = *(const float4*)(src + c);
    const float h0 = fmaf(fmaf(x.x, rs, nm), G0, B0), h1 = fmaf(fmaf(x.y, rs, nm), G1, B1);
    const float h2 = fmaf(fmaf(x.z, rs, nm), G2, B2), h3 = fmaf(fmaf(x.w, rs, nm), G3, B3);
    *(uint2*)(dst + (size_t)row * 1024 + c) = make_uint2(pack2(h0, h1), pack2(h2, h3));
  }
}

__device__ __forceinline__ void p1_item(const Params& p, char* smem, int l, int item) {
  const int mt = item & 63, nt = item >> 6;
  const int m0 = mt * 128, n0 = nt * 128;
  const int tid = ltid(), lane = tid & 63, wave = tid >> 6, wm = wave >> 1, wn = wave & 1;
  f16v acc[2][2];
  gemm_mainloop0(smem, WS_h1, 1024, WS_Wt + WT_LAYER * l + WT_IN, 1024, 1024, m0, n0, acc);

  const bool latent = m0 >= TCTX;
  const int seg = n0 >> 9;
  const int cs0 = n0 & 511;
  const int l31 = lane & 31;
  u16* Cs = (u16*)smem;
  u16* CsT = Cs + 128 * CST;
  const int rl0 = wm * 64 + 4 * (lane >> 5);
  const int cl0 = wn * 64 + l31;
  const bool want_rm = !(seg == 2 || seg == 7);
  const bool want_t = (seg == 2 || seg == 7 || (seg == 1 && !latent));
#pragma unroll
  for (int mi = 0; mi < 2; ++mi)
#pragma unroll
    for (int q = 0; q < 4; ++q) {
      float o0[4], o1[4];
#pragma unroll
      for (int j = 0; j < 4; ++j) {
        const int reg = q * 4 + j;
        float x1 = acc[mi][0][reg], x2 = acc[mi][1][reg];
        if (seg <= 1) {
          if (latent) {
            const int pos = (m0 - TCTX + rl0 + mi * 32 + q * 8 + j) & 1023;
            const int pidx = ((cs0 + wn * 64) & 64) ? (pos & 63) : (pos >> 6);
            const float cs = WS_ropetab[(pidx * 32 + l31) * 2], sn = WS_ropetab[(pidx * 32 + l31) * 2 + 1];
            const float t1 = x1 * cs - x2 * sn, t2 = x1 * sn + x2 * cs;
            x1 = t1; x2 = t2;
          }
          if (seg == 1) { x1 *= 0.08838834764831845f; x2 *= 0.08838834764831845f; }
        } else if (seg == 3) { x1 = siluf_(x1); x2 = siluf_(x2); }
        else if (seg == 5) { x1 *= 0.125f; x2 *= 0.125f; }
        else if (seg >= 8) { x1 = sigmoidf_(x1); x2 = sigmoidf_(x2); }
        o0[j] = x1; o1[j] = x2;
        if (want_rm) {
          const int rl = rl0 + mi * 32 + q * 8 + j;
          Cs[rl * CST + cl0] = f2bf(x1);
          Cs[rl * CST + cl0 + 32] = f2bf(x2);
        }
        if ((seg == 6 || seg == 7) && !latent) {
          const int row = m0 + rl0 + mi * 32 + q * 8 + j;
          float* o = p.out + (seg == 6 ? OUT_CK : OUT_CV) + ((size_t)((row >> 8) * 2 + l) * 256 + (row & 255)) * 512 + cs0 + cl0;
          o[0] = acc[mi][0][reg]; o[32] = acc[mi][1][reg];
        }
      }
      if (want_t) {
        const int rl = rl0 + mi * 32 + q * 8;
        *(uint2*)(CsT + cl0 * CST + rl) = make_uint2(pack2(o0[0], o0[1]), pack2(o0[2], o0[3]));
        *(uint2*)(CsT + (cl0 + 32) * CST + rl) = make_uint2(pack2(o1[0], o1[1]), pack2(o1[2], o1[3]));
      }
    }
  __syncthreads();
  if (want_rm) {
    u16* dst;
    size_t ld = 512;
    if (seg >= 8) { dst = WS_GT + (size_t)m0 * 3072 + (n0 - 4096); ld = 3072; }
    else {
      u16* base = seg == 0 ? WS_Q : seg == 1 ? WS_K : seg == 3 ? WS_G : seg == 4 ? WS_SU : seg == 5 ? WS_NQ : WS_NK;
      dst = base + (size_t)m0 * 512 + cs0;
    }
    cs_store(Cs, dst, ld, tid);
  }
  if (want_t) {
    u16* base = seg == 2 ? WS_VtR : seg == 7 ? WS_NVt : WS_KtR;
    u16* dst;
    size_t ld;
    if (!latent) { dst = base + ((size_t)(m0 >> 8) * 512 + cs0) * 256 + (m0 & 255); ld = 256; }
    else { dst = base + VTR_LAT + ((size_t)((m0 - TCTX) >> 10) * 512 + cs0) * 1024 + ((m0 - TCTX) & 1023); ld = 1024; }
    cs_store(CsT, dst, ld, tid);
  }
}

template <int D, int MODE>
__device__ __forceinline__ void attn_item(const Params& p, char* smem, int l, int idx) {
  constexpr int KSTR = D + 8;
  constexpr int NKS = D / 32;
  constexpr int NB = D / 16;
  constexpr int NCH = D / 32;
  u16* Ks = (u16*)smem;
  u16* Vts = Ks + 64 * KSTR;
  float* rpbs = (float*)(Vts + D * 72);
  const int tid = ltid(), lane = tid & 63, wave = tid >> 6;
  const int l15 = lane & 15, g = lane >> 4;
  const int wave_u = __builtin_amdgcn_readfirstlane(wave);

  int b, hh, qt, L, tokbase, nt;
  bool latent = false;
  int kr0 = 0, rrow = 0;
  if constexpr (MODE == 0) {
    if (idx < 256) { latent = true; b = idx >> 6; hh = (idx >> 4) & 3; qt = idx & 15; L = 1024; tokbase = TCTX + b * 1024; nt = 16 + 4; }
    else { idx -= 256; b = idx >> 4; hh = (idx >> 2) & 3; qt = idx & 3; L = 256; tokbase = b * 256; nt = 4; }
  } else if constexpr (MODE == 1) {
    b = idx >> 5; hh = (idx >> 2) & 7; qt = idx & 3; L = 256; tokbase = b * 256; nt = 4;
  } else {
    b = idx >> 7; hh = (idx >> 4) & 7; qt = idx & 15; rrow = qt; L = 1024; tokbase = TCTX + b * 1024; nt = 16; latent = true;
    kr0 = min(max(rrow - 4, 0), 8);
  }
  const int tq = qt * 64 + wave * 16 + l15;
  const int qtok = tokbase + tq;

  float lgf2 = 0.f, lgb2 = 0.f;
  if constexpr (MODE == 0) {
    float xf = p.ret_decay[(l * 2 + 0) * 4 + hh], xb = p.ret_decay[(l * 2 + 1) * 4 + hh];
    lgf2 = -log1pf(expf(-xf)) * 1.4426950408889634f;
    lgb2 = -log1pf(expf(-xb)) * 1.4426950408889634f;
  }
  float cfw[4][4], cbw[4][4];
  if constexpr (MODE == 0) {
#pragma unroll
    for (int kb = 0; kb < 4; ++kb)
#pragma unroll
      for (int r = 0; r < 4; ++r) {
        const float off = (float)(kb * 16 + g * 4 + r);
        cfw[kb][r] = __builtin_amdgcn_exp2f(-lgf2 * off);
        cbw[kb][r] = __builtin_amdgcn_exp2f(lgb2 * off);
      }
  }

  __syncthreads();
  if constexpr (MODE == 2) {
    for (int i = tid; i < 465; i += 256) rpbs[i] = p.rpb[(size_t)(l * 8 + hh) * 465 + i];
  }

  u4v qf[NKS];
  {
    const u16* qb = (MODE == 0 ? WS_Q : WS_NQ) + (size_t)qtok * 512 + hh * D + g * 8;
#pragma unroll
    for (int ks = 0; ks < NKS; ++ks) qf[ks] = *(const u4v*)(qb + ks * 32);
  }

  f4v ot[NB];
#pragma unroll
  for (int nb = 0; nb < NB; ++nb) ot[nb] = (f4v){0.f, 0.f, 0.f, 0.f};
  float mrun = -1e30f, lsum = 0.f;

  const int ntk = (MODE == 0) ? (L >> 6) : nt;
  u4v kr[NCH], vr[NCH];
#define ATTN_ISSUE(KT)                                                                                   \
  {                                                                                                      \
    const int kt_ = (KT);                                                                                \
    const u16* kp; const u16* vp; int ldv;                                                               \
    if constexpr (MODE == 0) {                                                                           \
      kp = WS_K + (size_t)(tokbase + kt_ * 64) * 512 + hh * 128;                                          \
      if (latent) { vp = WS_VtR + VTR_LAT + ((size_t)(b * 4 + hh) * 128) * 1024 + kt_ * 64; ldv = 1024; } \
      else { vp = WS_VtR + ((size_t)(b * 4 + hh) * 128) * 256 + kt_ * 64; ldv = 256; }                    \
    } else if constexpr (MODE == 1) {                                                                    \
      kp = WS_NK + (size_t)(tokbase + kt_ * 64) * 512 + hh * 64;                                          \
      vp = WS_NVt + ((size_t)(b * 8 + hh) * 64) * 256 + kt_ * 64; ldv = 256;                              \
    } else {                                                                                             \
      if (kt_ < 8) {                                                                                     \
        const int krow = kr0 + kt_;                                                                      \
        kp = WS_NK + (size_t)(tokbase + krow * 64) * 512 + hh * 64;                                       \
        vp = WS_NVt + NVT_LAT + ((size_t)(b * 8 + hh) * 64) * 1024 + krow * 64; ldv = 1024;               \
      } else {                                                                                           \
        kp = WS_CK + ((size_t)(l * 4 + b) * 512 + (kt_ - 8) * 64) * 512 + hh * 64;                        \
        vp = WS_CVt + ((size_t)((l * 4 + b) * 8 + hh) * 64) * 512 + (kt_ - 8) * 64; ldv = 512;            \
      }                                                                                                  \
    }                                                                                                    \
    _Pragma("unroll") for (int i = 0; i < NCH; ++i) {                                                    \
      const int c = tid + 256 * i;                                                                       \
      const int r = c / (D / 8), cc = c % (D / 8);                                                       \
      kr[i] = *(const u4v*)(kp + (size_t)r * 512 + cc * 8);                                              \
      const int vrw = c >> 3, vc = c & 7;                                                                \
      vr[i] = *(const u4v*)(vp + (size_t)vrw * ldv + vc * 8);                                            \
    }                                                                                                    \
  }
#define ATTN_STAGE()                                                                                     \
  {                                                                                                      \
    _Pragma("unroll") for (int i = 0; i < NCH; ++i) {                                                    \
      const int c = tid + 256 * i;                                                                       \
      const int r = c / (D / 8), cc = c % (D / 8);                                                       \
      *(u4v*)(Ks + r * KSTR + cc * 8) = kr[i];                                                           \
      const int vrw = c >> 3, vc = c & 7;                                                                \
      *(u4v*)(Vts + vrw * 72 + vc * 8) = vr[i];                                                          \
    }                                                                                                    \
  }

  ATTN_ISSUE(0)
#pragma unroll 1
  for (int kt = 0; kt < ntk; ++kt) {
    __syncthreads();
    ATTN_STAGE()
    __syncthreads();
    if (kt + 1 < ntk) ATTN_ISSUE(kt + 1)
    f4v st[4];
    int kb_lo = 0, kb_hi = 3;
    if constexpr (MODE == 2) {
      if (kt < 8) { kb_lo = wave_u >= 2 ? wave_u - 1 : 0; kb_hi = wave_u <= 1 ? wave_u + 1 : 3; }
    }
#pragma unroll
    for (int kb = 0; kb < 4; ++kb) {
      st[kb] = (f4v){0.f, 0.f, 0.f, 0.f};
      if (MODE != 2 || (kb >= kb_lo && kb <= kb_hi)) {
#pragma unroll
        for (int ks = 0; ks < NKS; ++ks) {
          s8v kf = *(const s8v*)(Ks + (kb * 16 + l15) * KSTR + ks * 32 + g * 8);
          st[kb] = __builtin_amdgcn_mfma_f32_16x16x32_bf16(kf, bc8(qf[ks]), st[kb], 0, 0, 0);
        }
      }
    }
    if constexpr (MODE == 0) {
      if (kt < qt) {
        const float rowf = __builtin_amdgcn_exp2f(lgf2 * (float)(tq - kt * 64));
#pragma unroll
        for (int kb = 0; kb < 4; ++kb)
#pragma unroll
          for (int r = 0; r < 4; ++r) st[kb][r] *= rowf * cfw[kb][r];
      } else if (kt > qt) {
        const float rowb = __builtin_amdgcn_exp2f(lgb2 * (float)(kt * 64 - tq));
#pragma unroll
        for (int kb = 0; kb < 4; ++kb)
#pragma unroll
          for (int r = 0; r < 4; ++r) st[kb][r] *= rowb * cbw[kb][r];
      } else {
#pragma unroll
        for (int kb = 0; kb < 4; ++kb)
#pragma unroll
          for (int r = 0; r < 4; ++r) {
            const int ts = kt * 64 + kb * 16 + g * 4 + r;
            const int d = tq - ts;
            float dec = d > 0 ? exp2f(lgf2 * (float)d) : (d < 0 ? exp2f(lgb2 * (float)(-d)) : 2.f);
            st[kb][r] *= dec;
          }
      }
    } else {
      if constexpr (MODE == 2) {
        if (kt < 8) {
          const int qc = wave * 16 + l15;
          const int ws = min(max(qc - 8, 0), 48);
          const int roff = (kr0 + kt) - rrow + 7;
#pragma unroll
          for (int kb = 0; kb < 4; ++kb) {
            if (kb >= kb_lo && kb <= kb_hi) {
#pragma unroll
              for (int r = 0; r < 4; ++r) {
                const int kc = kb * 16 + g * 4 + r;
                const bool valid = (kc >= ws) && (kc < ws + 16);
                const int coff = min(max(kc - qc + 15, 0), 30);
                const float bias = rpbs[roff * 31 + coff];
                st[kb][r] = valid ? st[kb][r] + bias : -1e30f;
              }
            } else {
              st[kb] = (f4v){-1e30f, -1e30f, -1e30f, -1e30f};
            }
          }
        }
      }
      float tmax = st[0][0];
#pragma unroll
      for (int kb = 0; kb < 4; ++kb)
#pragma unroll
        for (int r = 0; r < 4; ++r) tmax = fmaxf(tmax, st[kb][r]);
      tmax = fmaxf(tmax, __shfl_xor(tmax, 16));
      tmax = fmaxf(tmax, __shfl_xor(tmax, 32));
      const float mnew = fmaxf(mrun, tmax);
      const float alpha = __expf(mrun - mnew);
      float ps = 0.f;
#pragma unroll
      for (int kb = 0; kb < 4; ++kb) {
        if (MODE != 2 || (kb >= kb_lo && kb <= kb_hi)) {
#pragma unroll
          for (int r = 0; r < 4; ++r) {
            float e = __expf(st[kb][r] - mnew);
            st[kb][r] = e;
            ps += e;
          }
        } else {
          st[kb] = (f4v){0.f, 0.f, 0.f, 0.f};
        }
      }
      lsum = lsum * alpha + ps;
      mrun = mnew;
#pragma unroll
      for (int nb = 0; nb < NB; ++nb) ot[nb] *= alpha;
    }
    u4v pf[2];
#pragma unroll
    for (int s = 0; s < 2; ++s) {
      pf[s] = (u4v){pack2(st[2 * s][0], st[2 * s][1]), pack2(st[2 * s][2], st[2 * s][3]),
                    pack2(st[2 * s + 1][0], st[2 * s + 1][1]), pack2(st[2 * s + 1][2], st[2 * s + 1][3])};
    }
#pragma unroll
    for (int s = 0; s < 2; ++s) {
      if (MODE == 2 && (2 * s + 1 < kb_lo || 2 * s > kb_hi)) continue;
#pragma unroll
      for (int nb = 0; nb < NB; ++nb) {
        const u16* vb = Vts + (nb * 16 + l15) * 72 + s * 32 + g * 4;
        uint2 lo = *(const uint2*)(vb);
        uint2 hi = *(const uint2*)(vb + 16);
        u4v vf = (u4v){lo.x, lo.y, hi.x, hi.y};
        ot[nb] = __builtin_amdgcn_mfma_f32_16x16x32_bf16(bc8(vf), bc8(pf[s]), ot[nb], 0, 0, 0);
      }
    }
  }

  if constexpr (MODE == 0) {
    if (latent) {
#pragma unroll 1
      for (int dir = 0; dir < 2; ++dir) {
        const float scale = dir == 0 ? exp2f(lgf2 * (float)(tq + 1)) : exp2f(lgb2 * (float)(L - tq));
        const u16* S0 = WS_S0t + ((size_t)(((l * 4 + b) * 2 + dir) * 4 + hh)) * 16384;
#pragma unroll
        for (int s = 0; s < NKS; ++s) {
          u4v pq = (u4v){pack2(bflo(qf[s][0]) * scale, bfhi(qf[s][0]) * scale), pack2(bflo(qf[s][1]) * scale, bfhi(qf[s][1]) * scale),
                         pack2(bflo(qf[s][2]) * scale, bfhi(qf[s][2]) * scale), pack2(bflo(qf[s][3]) * scale, bfhi(qf[s][3]) * scale)};
#pragma unroll
          for (int nb = 0; nb < NB; ++nb) {
            u4v vf = *(const u4v*)(S0 + (size_t)(nb * 16 + l15) * 128 + s * 32 + g * 8);
            ot[nb] = __builtin_amdgcn_mfma_f32_16x16x32_bf16(bc8(vf), bc8(pq), ot[nb], 0, 0, 0);
          }
        }
      }
    }
    float s = 0.f;
#pragma unroll
    for (int nb = 0; nb < NB; ++nb) s += ot[nb][0] + ot[nb][1] + ot[nb][2] + ot[nb][3];
    s += __shfl_xor(s, 16); s += __shfl_xor(s, 32);
    const float mu = s * (1.f / 128.f);
    float q = 0.f;
#pragma unroll
    for (int nb = 0; nb < NB; ++nb)
#pragma unroll
      for (int r = 0; r < 4; ++r) { float dlt = ot[nb][r] - mu; q += dlt * dlt; }
    q += __shfl_xor(q, 16); q += __shfl_xor(q, 32);
    const float rstd = rsqrtf(q * (1.f / 128.f) + LNEPS);
#pragma unroll
    for (int nb = 0; nb < NB; ++nb) {
      const size_t off = (size_t)qtok * 512 + hh * 128 + nb * 16 + g * 4;
      uint2 gg = *(const uint2*)(WS_G + off);
      float o0 = (ot[nb][0] - mu) * rstd * bflo(gg.x);
      float o1 = (ot[nb][1] - mu) * rstd * bfhi(gg.x);
      float o2 = (ot[nb][2] - mu) * rstd * bflo(gg.y);
      float o3 = (ot[nb][3] - mu) * rstd * bfhi(gg.y);
      *(uint2*)(WS_rout + off) = make_uint2(pack2(o0, o1), pack2(o2, o3));
    }
  } else {
    lsum += __shfl_xor(lsum, 16); lsum += __shfl_xor(lsum, 32);
    const float inv = 1.f / lsum;
#pragma unroll
    for (int nb = 0; nb < NB; ++nb) {
      const size_t off = (size_t)qtok * 512 + hh * 64 + nb * 16 + g * 4;
      *(uint2*)(WS_nout + off) = make_uint2(pack2(ot[nb][0] * inv, ot[nb][1] * inv), pack2(ot[nb][2] * inv, ot[nb][3] * inv));
    }
  }
}

__device__ __forceinline__ void retstate_item(const Params& p, int l, int idx) {
  const int dir = idx & 1, hh = (idx >> 1) & 3, b = idx >> 3;
  const int tid = ltid(), lane = tid & 63, wave = tid >> 6;
  const int r = lane & 31, h2 = lane >> 5;
  const float x = p.ret_decay[(l * 2 + dir) * 4 + hh];
  const float lg2 = -log1pf(expf(-x)) * 1.4426950408889634f;
  const u16* Kt = WS_KtR + ((size_t)(b * 4 + hh) * 128) * 256;
  const u16* Vt = WS_VtR + ((size_t)(b * 4 + hh) * 128) * 256;
  f16v acc[4];
#pragma unroll
  for (int i = 0; i < 4; ++i) acc[i] = zero16();
#pragma unroll 2
  for (int ks = 0; ks < 16; ++ks) {
    const int tok0 = ks * 16 + h2 * 8;
    const u4v a = *(const u4v*)(Kt + (size_t)(wave * 32 + r) * 256 + tok0);
    u4v af;
#pragma unroll
    for (int w = 0; w < 4; ++w) {
      const int t0 = tok0 + 2 * w, t1 = t0 + 1;
      float w0 = dir == 0 ? exp2f(lg2 * (float)(255 - t0)) : exp2f(lg2 * (float)t0);
      float w1 = dir == 0 ? exp2f(lg2 * (float)(255 - t1)) : exp2f(lg2 * (float)t1);
      af[w] = pack2(bflo(a[w]) * w0, bfhi(a[w]) * w1);
    }
#pragma unroll
    for (int nt = 0; nt < 4; ++nt) {
      const u4v bfr = *(const u4v*)(Vt + (size_t)(nt * 32 + r) * 256 + tok0);
      acc[nt] = __builtin_amdgcn_mfma_f32_32x32x16_bf16(bc8(af), bc8(bfr), acc[nt], 0, 0, 0);
    }
  }
  float* o = p.out + OUT_SRET + ((size_t)(((b * 2 + l) * 2 + dir) * 4 + hh)) * 16384;
#pragma unroll
  for (int nt = 0; nt < 4; ++nt)
#pragma unroll
    for (int reg = 0; reg < 16; ++reg) {
      const int dk = wave * 32 + (reg & 3) + 8 * (reg >> 2) + 4 * h2;
      o[(size_t)dk * 128 + nt * 32 + r] = acc[nt][reg];
    }
}

__device__ __forceinline__ void s5_item(const Params& p, char* smem, int l, int item) {
  const int tid = ltid(), lane = tid & 63, wave = tid >> 6;
  const int l15 = lane & 15, g4 = lane >> 4;
  int seq = item * 4 + wave;
  int b, dir, g, L, tokbase;
  bool latent;
  if (seq < 256) { latent = true; b = seq >> 6; dir = (seq >> 5) & 1; g = seq & 31; L = 1024; tokbase = TCTX + b * 1024; }
  else { seq -= 256; latent = false; b = seq >> 6; dir = (seq >> 5) & 1; g = seq & 31; L = 256; tokbase = b * 256; }
  float* buf = (float*)smem + wave * (16 * 132);
  const int tg = (l * 2 + dir) * 32 + g;
  const float ar = WS_abar[(tg * 64 + lane) * 2], ai = WS_abar[(tg * 64 + lane) * 2 + 1];
  u4v bfrag[8];
#pragma unroll
  for (int nt = 0; nt < 8; ++nt) {
    if (g4 < 2) bfrag[nt] = *(const u4v*)(WS_bbarT + ((size_t)tg * 128 + nt * 16 + l15) * 16 + g4 * 8);
    else bfrag[nt] = (u4v){0u, 0u, 0u, 0u};
  }
  u4v cfrag[4];
#pragma unroll
  for (int ks = 0; ks < 4; ++ks) cfrag[ks] = *(const u4v*)(WS_cmT + ((size_t)tg * 16 + l15) * 128 + ks * 32 + g4 * 8);
  float xr = 0.f, xi = 0.f;
  if (latent) {
    const float* h0 = p.state_ssm + ((size_t)(((b * 2 + l) * 2 + dir) * 32 + g) * 64 + lane) * 2;
    xr = h0[0]; xi = h0[1];
  }
  u16* yd = WS_YD + (size_t)dir * TALL * 512;
  __syncthreads();
  const int nsub = L >> 4;
  u4v afn = (u4v){0u, 0u, 0u, 0u};
  if (g4 < 2) {
    const int pos = dir == 0 ? l15 : L - 1 - l15;
    afn = *(const u4v*)(WS_SU + (size_t)(tokbase + pos) * 512 + g * 16 + g4 * 8);
  }
#pragma unroll 1
  for (int sub = 0; sub < nsub; ++sub) {
    const u4v af = afn;
    if (g4 < 2 && sub + 1 < nsub) {
      const int tau = (sub + 1) * 16 + l15;
      const int pos = dir == 0 ? tau : L - 1 - tau;
      afn = *(const u4v*)(WS_SU + (size_t)(tokbase + pos) * 512 + g * 16 + g4 * 8);
    }
#pragma unroll
    for (int nt = 0; nt < 8; ++nt) {
      f4v c = (f4v){0.f, 0.f, 0.f, 0.f};
      c = __builtin_amdgcn_mfma_f32_16x16x32_bf16(bc8(af), bc8(bfrag[nt]), c, 0, 0, 0);
#pragma unroll
      for (int r = 0; r < 4; ++r) buf[(g4 * 4 + r) * 132 + nt * 16 + l15] = c[r];
    }
    __builtin_amdgcn_wave_barrier();
#pragma unroll
    for (int i = 0; i < 16; ++i) {
      const float bur = buf[i * 132 + lane], bui = buf[i * 132 + 64 + lane];
      const float nr = ar * xr - ai * xi + bur;
      const float ni = ar * xi + ai * xr + bui;
      xr = nr; xi = ni;
      buf[i * 132 + lane] = xr;
      buf[i * 132 + 64 + lane] = xi;
    }
    __builtin_amdgcn_wave_barrier();
    f4v y = (f4v){0.f, 0.f, 0.f, 0.f};
#pragma unroll
    for (int ks = 0; ks < 4; ++ks) {
      const float* bp = buf + l15 * 132 + ks * 32 + g4 * 8;
      float4 v0 = *(const float4*)(bp), v1 = *(const float4*)(bp + 4);
      const u4v xa = (u4v){pack2(v0.x, v0.y), pack2(v0.z, v0.w), pack2(v1.x, v1.y), pack2(v1.z, v1.w)};
      y = __builtin_amdgcn_mfma_f32_16x16x32_bf16(bc8(xa), bc8(cfrag[ks]), y, 0, 0, 0);
    }
#pragma unroll
    for (int r = 0; r < 4; ++r) {
      const int tau = sub * 16 + g4 * 4 + r;
      const int pos = dir == 0 ? tau : L - 1 - tau;
      yd[(size_t)(tokbase + pos) * 512 + g * 16 + l15] = f2bf(y[r]);
    }
    __builtin_amdgcn_wave_barrier();
  }
  if (!latent) {
    float* o = p.out + OUT_SSSM + ((size_t)(((b * 2 + l) * 2 + dir) * 32 + g) * 64 + lane) * 2;
    o[0] = xr; o[1] = xi;
  }
}

#define MX_S5 320
#define MX_RET 512
#define MX_NA 512
#define MX_CA 512
#define MX_RS 128
#define MX_ITEMS (MX_S5 + MX_RET + MX_NA + MX_CA + MX_RS)
__device__ __forceinline__ void mixer_item(const Params& p, char* smem, int l, int item) {
  if (item < 64) { s5_item(p, smem, l, item); return; }
  item -= 64;
  if (item < 256) { attn_item<128, 0>(p, smem, l, item); return; }
  item -= 256;
  if (item < 512) { attn_item<64, 2>(p, smem, l, item); return; }
  item -= 512;
  if (item < 256) { s5_item(p, smem, l, 64 + item); return; }
  item -= 256;
  if (item < 256) { attn_item<128, 0>(p, smem, l, 256 + item); return; }
  item -= 256;
  if (item < 512) { attn_item<64, 1>(p, smem, l, item); return; }
  item -= 512;
  retstate_item(p, l, item);
}

__device__ __forceinline__ void p3a_item(const Params& p, char* smem, int l, int item) {
  const int mt = item & 63, nt = item >> 6;
  const int m0 = mt * 128, n0 = nt * 128;
  const int tid = ltid(), lane = tid & 63, wave = tid >> 6, wm = wave >> 1, wn = wave & 1;
  AArgs a{};
  a.SU = WS_SU; a.YD0 = WS_YD; a.YD1 = WS_YD + (size_t)TALL * 512; a.dsk = p.ssm_d + l * 512;
  f16v acc[2][2];
  gemm_mainloop<2>(smem, a, WS_Wt + WT_LAYER * l + WT_GLU, 512, 512, m0, n0, acc);
#pragma unroll
  for (int mi = 0; mi < 2; ++mi)
#pragma unroll
    for (int reg = 0; reg < 16; ++reg) {
      const int row = EPI_ROW(mi, reg);
#pragma unroll
      for (int ni = 0; ni < 2; ++ni) {
        const int col = EPI_COL(ni);
        const size_t off = (size_t)row * 512 + col;
        float y = geluf_(a.dsk[col] * bf2f(WS_SU[off]) + bf2f(a.YD0[off]) + bf2f(a.YD1[off]));
        WS_sout[off] = f2bf(y * sigmoidf_(acc[mi][ni][reg]));
      }
    }
}

__device__ __forceinline__ void p3b_item(const Params& p, char* smem, int l, int item) {
  const int mt = item & 63, nt = item >> 6;
  const int m0 = mt * 128, n0 = nt * 128;
  const int tid = ltid(), lane = tid & 63, wave = tid >> 6, wm = wave >> 1, wn = wave & 1;
  int nbr = 3;
  asm volatile("" : "+s"(nbr));
#pragma unroll 1
  for (int br = 0; br < nbr; ++br) {
    const u16* Abr = br == 0 ? WS_rout : (br == 1 ? WS_sout : WS_nout);
    f16v acc[2][2];
    gemm_mainloop0(smem, Abr, 512, WS_Wt + WT_LAYER * l + WT_BR + (size_t)br * 512 * 1024, 512, 512, m0, n0, acc);
    u16* Cs = (u16*)smem;
    {
      const int rl0 = wm * 64 + 4 * (lane >> 5), cl0 = wn * 64 + (lane & 31);
#pragma unroll
      for (int mi = 0; mi < 2; ++mi)
#pragma unroll
        for (int reg = 0; reg < 16; ++reg) {
          const int rl = rl0 + mi * 32 + (reg & 3) + 8 * (reg >> 2);
          Cs[rl * CST + cl0] = f2bf(acc[mi][0][reg]);
          Cs[rl * CST + cl0 + 32] = f2bf(acc[mi][1][reg]);
        }
    }
    __syncthreads();
    int tl = tid;
    asm volatile("" : "+v"(tl));
#pragma unroll
    for (int i = 0; i < 8; ++i) {
      const int c = tl + 256 * i, r = c >> 4, ch = c & 15;
      const u4v av = *(const u4v*)(Cs + r * CST + ch * 8);
      const u4v gv = *(const u4v*)(WS_GT + (size_t)(m0 + r) * 3072 + br * 1024 + n0 + ch * 8);
      u16* mp = WS_merged + (size_t)(m0 + r) * 1024 + n0 + ch * 8;
      u4v mv = (u4v){0u, 0u, 0u, 0u};
      if (br > 0) mv = *(const u4v*)mp;
      u4v ov;
#pragma unroll
      for (int j = 0; j < 4; ++j)
        ov[j] = pack2(fmaf(bflo(gv[j]), bflo(av[j]), bflo(mv[j])), fmaf(bfhi(gv[j]), bfhi(av[j]), bfhi(mv[j])));
      *(u4v*)mp = ov;
    }
  }
}


#define CFS 132
__device__ __forceinline__ void epi_resid(char* smem, f16v (&acc)[2][2], int m0, int n0, const float* __restrict__ gvec,
                                          const float* __restrict__ xlo, const float* __restrict__ xhi,
                                          const float* __restrict__ xstats, const float* __restrict__ lng,
                                          const float* __restrict__ lnb, float* __restrict__ dst,
                                          float* __restrict__ stats_out, bool do_stats) {
  float* Cf = (float*)smem;
  const int tid = ltid(), lane = tid & 63, wave = tid >> 6, wm = wave >> 1, wn = wave & 1;
  {
    const int rl0 = wm * 64 + 4 * (lane >> 5), cl0 = wn * 64 + (lane & 31);
    const float ga = gvec[n0 + cl0], gb = gvec[n0 + cl0 + 32];
#pragma unroll
    for (int mi = 0; mi < 2; ++mi)
#pragma unroll
      for (int reg = 0; reg < 16; ++reg) {
        const int rl = rl0 + mi * 32 + (reg & 3) + 8 * (reg >> 2);
        Cf[rl * CFS + cl0] = ga * acc[mi][0][reg];
        Cf[rl * CFS + cl0 + 32] = gb * acc[mi][1][reg];
      }
  }
  __syncthreads();
  const int ch = tid & 31, r0 = tid >> 5;
  const int col = n0 + ch * 4;
  float4 g4 = make_float4(1.f, 1.f, 1.f, 1.f), b4 = make_float4(0.f, 0.f, 0.f, 0.f);
  if (xstats) { g4 = *(const float4*)(lng + col); b4 = *(const float4*)(lnb + col); }
  const float* xbase = (m0 < TCTX ? xlo + (size_t)m0 * 1024 : xhi + (size_t)(m0 - TCTX) * 1024) + col;
#pragma unroll 4
  for (int i = 0; i < 16; ++i) {
    const int r = r0 + 8 * i;
    const int row = m0 + r;
    const float4 v = *(const float4*)(Cf + r * CFS + ch * 4);
    float4 x = *(const float4*)(xbase + (size_t)r * 1024);
    if (xstats) {
      const float s = xstats[row * 2], q = xstats[row * 2 + 1];
      const float mu = s * (1.f / 1024.f);
      const float rstd = rsqrtf(fmaxf(q * (1.f / 1024.f) - mu * mu, 0.f) + LNEPS);
      x.x = (x.x - mu) * rstd * g4.x + b4.x; x.y = (x.y - mu) * rstd * g4.y + b4.y;
      x.z = (x.z - mu) * rstd * g4.z + b4.z; x.w = (x.w - mu) * rstd * g4.w + b4.w;
    }
    float4 o;
    o.x = ALPHA * x.x + v.x; o.y = ALPHA * x.y + v.y; o.z = ALPHA * x.z + v.z; o.w = ALPHA * x.w + v.w;
    *(float4*)(dst + (size_t)row * 1024 + col) = o;
    if (do_stats) {
      float ss = o.x + o.y + o.z + o.w, qq = o.x * o.x + o.y * o.y + o.z * o.z + o.w * o.w;
#pragma unroll
      for (int sh = 1; sh < 32; sh <<= 1) { ss += __shfl_xor(ss, sh); qq += __shfl_xor(qq, sh); }
      if (ch == 0) { atomicAdd(stats_out + row * 2, ss); atomicAdd(stats_out + row * 2 + 1, qq); }
    }
  }
}

__device__ __forceinline__ void p3c_item(const Params& p, char* smem, int l, int item, bool do_stats = true) {
  const int mt = item & 63, nt = item >> 6;
  const int m0 = mt * 128, n0 = nt * 128;
  const int tid = ltid(), lane = tid & 63, wave = tid >> 6, wm = wave >> 1, wn = wave & 1;
  f16v acc[2][2];
  gemm_mainloop0(smem, WS_merged, 1024, WS_Wt + WT_LAYER * l + WT_O, 1024, 1024, m0, n0, acc);
  const int ci = cond_of_row(m0);
  const float* g1 = WS_mod + (l * 5 + ci) * 6144 + 2048;
  float* st1 = WS_stats + (size_t)(l * 2 + 0) * TALL * 2;
  if (l == 0)
    epi_resid(smem, acc, m0, n0, g1, p.x_prompt, p.x_sample, nullptr, nullptr, nullptr, WS_pre1, st1, do_stats);
  else
    epi_resid(smem, acc, m0, n0, g1, p.out, p.out + (size_t)TCTX * 1024, WS_stats + (size_t)(0 * 2 + 1) * TALL * 2, p.ln2_g, p.ln2_b,
              WS_pre1, st1, do_stats);
}

__device__ __forceinline__ void p4_item(const Params& p, char* smem, int l, int item) {
  const int mt = item & 63, nt = item >> 6;
  const int m0 = mt * 128, n0 = nt * 128;
  const int tid = ltid(), lane = tid & 63, wave = tid >> 6, wm = wave >> 1, wn = wave & 1;
  f16v acc[2][2];
  gemm_mainloop0(smem, WS_h2, 1024, WS_Wt + WT_LAYER * l + WT_UP, 1024, 1024, m0, n0, acc);
  u16* Cs = (u16*)smem;
  const int rl0 = wm * 64 + 4 * (lane >> 5), cl0 = wn * 64 + (lane & 31);
#pragma unroll
  for (int mi = 0; mi < 2; ++mi)
#pragma unroll
    for (int reg = 0; reg < 16; ++reg) {
      const int rl = rl0 + mi * 32 + (reg & 3) + 8 * (reg >> 2);
      Cs[rl * CST + cl0] = f2bf(acc[mi][0][reg]);
      Cs[rl * CST + cl0 + 32] = f2bf(acc[mi][1][reg]);
    }
  __syncthreads();
  cs_store(Cs, WS_z2 + (size_t)m0 * 5632 + n0, 5632, tid);
}

__device__ __forceinline__ void p4b_item(const Params& p, int l, int item) {
  const int tid = ltid();
  if (tid >= 176) return;
  const int rb = item >> 1, hf = item & 1;
  const int j0 = (hf * 176 + tid) * 8;
  const float* cw = p.conv_w + (size_t)l * 3 * 5632;
  const float* cb = p.conv_b + (size_t)l * 5632;
  float wa[3][8], wb[3][8], ba[8], bb[8];
#pragma unroll
  for (int t = 0; t < 3; ++t)
#pragma unroll
    for (int h = 0; h < 2; ++h) {
      const float4 x = *(const float4*)(cw + t * 5632 + j0 + 4 * h), y = *(const float4*)(cw + t * 5632 + 2816 + j0 + 4 * h);
      wa[t][4 * h] = x.x; wa[t][4 * h + 1] = x.y; wa[t][4 * h + 2] = x.z; wa[t][4 * h + 3] = x.w;
      wb[t][4 * h] = y.x; wb[t][4 * h + 1] = y.y; wb[t][4 * h + 2] = y.z; wb[t][4 * h + 3] = y.w;
    }
#pragma unroll
  for (int h = 0; h < 2; ++h) {
    const float4 x = *(const float4*)(cb + j0 + 4 * h), y = *(const float4*)(cb + 2816 + j0 + 4 * h);
    ba[4 * h] = x.x; ba[4 * h + 1] = x.y; ba[4 * h + 2] = x.z; ba[4 * h + 3] = x.w;
    bb[4 * h] = y.x; bb[4 * h + 1] = y.y; bb[4 * h + 2] = y.z; bb[4 * h + 3] = y.w;
  }
  const int row0 = rb * 32;
  int pos0, L;
  if (row0 < TCTX) { pos0 = row0 & 255; L = 256; } else { pos0 = (row0 - TCTX) & 1023; L = 1024; }
  const u16* zr = WS_z2 + (size_t)row0 * 5632 + j0;
  const u4v zero = (u4v){0u, 0u, 0u, 0u};
  u4v pa = zero, pb = zero;
  if (pos0 > 0) { pa = *(const u4v*)(zr - 5632); pb = *(const u4v*)(zr - 5632 + 2816); }
  u4v ca = *(const u4v*)(zr), cb2 = *(const u4v*)(zr + 2816);
#pragma unroll 2
  for (int r = 0; r < 32; ++r) {
    u4v na = zero, nb = zero;
    if (pos0 + r < L - 1) { na = *(const u4v*)(zr + (size_t)(r + 1) * 5632); nb = *(const u4v*)(zr + (size_t)(r + 1) * 5632 + 2816); }
    u4v ov;
#pragma unroll
    for (int w = 0; w < 4; ++w) {
      const float a0 = wa[0][2 * w] * bflo(pa[w]) + wa[1][2 * w] * bflo(ca[w]) + wa[2][2 * w] * bflo(na[w]) + ba[2 * w];
      const float a1 = wa[0][2 * w + 1] * bfhi(pa[w]) + wa[1][2 * w + 1] * bfhi(ca[w]) + wa[2][2 * w + 1] * bfhi(na[w]) + ba[2 * w + 1];
      const float b0 = wb[0][2 * w] * bflo(pb[w]) + wb[1][2 * w] * bflo(cb2[w]) + wb[2][2 * w] * bflo(nb[w]) + bb[2 * w];
      const float b1 = wb[0][2 * w + 1] * bfhi(pb[w]) + wb[1][2 * w + 1] * bfhi(cb2[w]) + wb[2][2 * w + 1] * bfhi(nb[w]) + bb[2 * w + 1];
      ov[w] = pack2(geluf_(a0) * b0, geluf_(a1) * b1);
    }
    *(u4v*)(WS_act + (size_t)(row0 + r) * 2816 + j0) = ov;
    pa = ca; pb = cb2; ca = na; cb2 = nb;
  }
}

__device__ __forceinline__ void p5_item(const Params& p, char* smem, int l, int item, bool do_stats = true) {
  const int mt = item & 63, nt = item >> 6;
  const int m0 = mt * 128, n0 = nt * 128;
  const int tid = ltid(), lane = tid & 63, wave = tid >> 6, wm = wave >> 1, wn = wave & 1;
  f16v acc[2][2];
  gemm_mainloop0(smem, WS_act, 2816, WS_Wt + WT_LAYER * l + WT_DOWN, 2816, 2816, m0, n0, acc);
  const int ci = cond_of_row(m0);
  const float* g2 = WS_mod + (l * 5 + ci) * 6144 + 5 * 1024;
  epi_resid(smem, acc, m0, n0, g2, WS_pre1, WS_pre1 + (size_t)TCTX * 1024, WS_stats + (size_t)(l * 2 + 0) * TALL * 2,
            p.ln1_g + l * 1024, p.ln1_b + l * 1024, p.out, WS_stats + (size_t)(l * 2 + 1) * TALL * 2, do_stats);
}

__device__ __forceinline__ void final_item(const Params& p, int item) {
  const float* st = WS_stats + (size_t)(1 * 2 + 1) * TALL * 2;
  const int c = ltid() * 4;
  const float4 g = *(const float4*)(p.ln2_g + 1024 + c);
  const float4 b = *(const float4*)(p.ln2_b + 1024 + c);
  for (int r = 0; r < 8; ++r) {
    const int row = item * 8 + r;
    const float s = st[row * 2], q = st[row * 2 + 1];
    const float mu = s * (1.f / 1024.f);
    const float rstd = rsqrtf(fmaxf(q * (1.f / 1024.f) - mu * mu, 0.f) + LNEPS);
    float4 v = *(float4*)(p.out + (size_t)row * 1024 + c);
    v.x = (v.x - mu) * rstd * g.x + b.x;
    v.y = (v.y - mu) * rstd * g.y + b.y;
    v.z = (v.z - mu) * rstd * g.z + b.z;
    v.w = (v.w - mu) * rstd * g.w + b.w;
    *(float4*)(p.out + (size_t)row * 1024 + c) = v;
  }
}

#define XB_TMO      128
#define XB_XCNT(j)  (256  + 64 * (j))
#define XB_XSUB(j)  (1280 + 64 * (j))
#define XB_XGEN(j)  (2304 + 64 * (j))
#define XB_TOP      3328
#define XB_TOPGEN   3392
#define XCD_BAR_WORDS 3456
#define XB_SPIN_CAP (1u << 18)
#define LAS __attribute__((address_space(3)))

__device__ __forceinline__ unsigned xb_ld(unsigned* p)              { return __hip_atomic_load(p, __ATOMIC_RELAXED, __HIP_MEMORY_SCOPE_AGENT); }
__device__ __forceinline__ unsigned xb_add(unsigned* p, unsigned v) { return __hip_atomic_fetch_add(p, v, __ATOMIC_RELAXED, __HIP_MEMORY_SCOPE_AGENT); }
__device__ __forceinline__ unsigned xb_xcc_id() { return (unsigned)__builtin_amdgcn_s_getreg((3 << 11) | 20) & 0xFu; }
#define XB_SPIN(cond, bar) do { unsigned _sp = 0; while (cond) { __builtin_amdgcn_s_sleep(1); \
    if ((++_sp & 255u) == 0u) { if (xb_ld(&(bar)[XB_TMO])) break; if (_sp > XB_SPIN_CAP) { atomicAdd(&(bar)[XB_TMO], 1u); break; } } } } while (0)

struct XcdBarrier {
    unsigned* bar; unsigned x;
    volatile LAS unsigned* st;
};

__device__ __forceinline__ XcdBarrier xcd_barrier_post(unsigned* bar, volatile LAS unsigned* st) {
    XcdBarrier b; b.bar = bar; b.x = xb_xcc_id(); b.st = st;
    if (threadIdx.x == 0) (void)xb_add(&bar[XB_XCNT(b.x)], 1u);
    return b;
}
__device__ __forceinline__ void xcd_barrier_complete(unsigned* bar, unsigned x, unsigned& nloc, unsigned& nx) {
    const unsigned G = gridDim.x * gridDim.y * gridDim.z;
    unsigned sum, cnt, mine, sp = 0u;
    for (;;) {
        sum = 0u; cnt = 0u; mine = 0u;
#pragma unroll
        for (unsigned j = 0; j < 16; ++j) { const unsigned c = xb_ld(&bar[XB_XCNT(j)]); sum += c; cnt += (c > 0u) ? 1u : 0u; mine = (j == x) ? c : mine; }
        if (sum == G) break;
        __builtin_amdgcn_s_sleep(1);
        if ((++sp & 255u) == 0u) { if (xb_ld(&bar[XB_TMO])) break; if (sp > XB_SPIN_CAP) { atomicAdd(&bar[XB_TMO], 1u); break; } }
    }
    nloc = mine > 0u ? mine : 1u; nx = cnt > 0u ? cnt : 1u;
}

__device__ __forceinline__ void xcd_barrier(const XcdBarrier& b) {
    asm volatile("s_waitcnt vmcnt(0)" ::: "memory");
    __syncthreads();
    if (threadIdx.x == 0) {
        unsigned* bar = b.bar;
        __builtin_amdgcn_s_waitcnt(0);
        unsigned nloc = b.st[0], nx = b.st[1];
        if (nloc == 0u) { xcd_barrier_complete(bar, b.x, nloc, nx); b.st[0] = nloc; b.st[1] = nx; }
        const unsigned old = xb_add(&bar[XB_XSUB(b.x)], 1u);
        const unsigned gen = old / nloc;
        if (old + 1u == (gen + 1u) * nloc) {
            __builtin_amdgcn_fence(__ATOMIC_RELEASE, "agent");
            asm volatile("s_waitcnt vmcnt(0)" ::: "memory");
            const unsigned og = xb_add(&bar[XB_TOP], 1u);
            const unsigned tg = og / nx;
            if (og + 1u == (tg + 1u) * nx) xb_add(&bar[XB_TOPGEN], 1u);
            else XB_SPIN(xb_ld(&bar[XB_TOPGEN]) == tg, bar);
            __builtin_amdgcn_fence(__ATOMIC_ACQUIRE, "agent");
            xb_add(&bar[XB_XGEN(b.x)], 1u);
            asm volatile("s_waitcnt vmcnt(0)" ::: "memory");
        } else {
            XB_SPIN(xb_ld(&bar[XB_XGEN(b.x)]) == gen, bar);
            __builtin_amdgcn_fence(__ATOMIC_ACQUIRE, "agent");
            asm volatile("s_waitcnt vmcnt(0)" ::: "memory");
        }
    }
    __syncthreads();
}


#define NPHASES 22
#ifndef REPMASK
#define REPMASK 0
#endif
#define REPS(PH) (((PH) == 0 ? (REPMASK >> 10) : (PH) == 21 ? (REPMASK >> 11) : (REPMASK >> (((PH) - 1) % 10))) & 1)
#define RUN_PHASE(PH, N, CALL)                                              \
  if (ph_lo <= (PH) && (PH) < ph_hi) {                                      \
    for (int rep_ = 0; rep_ <= REPS(PH); ++rep_)                            \
    for (int it = blockIdx.x; it < (N); it += nb) { CALL; }                 \
    if ((PH) + 1 < ph_hi) xcd_barrier(xb);                                  \
  }
#define RUN_GEMM_PHASE(PH, NT, CALL)                                                          \
  if (ph_lo <= (PH) && (PH) < ph_hi) {                                                        \
    const int xcd_ = blockIdx.x & 7, slot_ = blockIdx.x >> 3, spx_ = (int)gridDim.x >> 3;      \
    const int nsuper_ = 8 * (((NT) + 7) >> 3);                                                \
    for (int rep_ = 0; rep_ <= REPS(PH); ++rep_)                                              \
    for (int s_ = xcd_; s_ < nsuper_; s_ += 8)                                                \
      for (int j_ = slot_; j_ < 64; j_ += spx_) {                                             \
        const int mt_ = (s_ & 7) * 8 + (j_ & 7), nt_ = (s_ >> 3) * 8 + (j_ >> 3);             \
        if (nt_ < (NT)) { const int it = nt_ * 64 + mt_; CALL; }                              \
      }                                                                                       \
    if ((PH) + 1 < ph_hi) xcd_barrier(xb);                                                    \
  }
#define RUN_MIXER_PHASE(PH, L)                                                                \
  if (ph_lo <= (PH) && (PH) < ph_hi) {                                                        \
    for (int rep_ = 0; rep_ <= REPS(PH); ++rep_) {                                            \
      unsigned* ctr_ = (unsigned*)(p.ws + OFF_ctr) + 64 * (2 * (L) + rep_);                   \
      for (;;) {                                                                              \
        __syncthreads();                                                                      \
        if (threadIdx.x == 0) wq_item = (int)atomicAdd(ctr_, 1u);                             \
        __syncthreads();                                                                      \
        const int it = wq_item;                                                               \
        if (it >= MX_ITEMS) break;                                                            \
        mixer_item(p, smem, (L), it);                                                         \
      }                                                                                       \
    }                                                                                         \
    if ((PH) + 1 < ph_hi) xcd_barrier(xb);                                                    \
  }
#define RUN_LAYER(L)                                                         \
  RUN_PHASE(1 + 10 * (L) + 0, 1024, hmat_item(p, (L), 0, it))                \
  RUN_GEMM_PHASE(1 + 10 * (L) + 1, 56, p1_item(p, smem, (L), it))            \
  RUN_MIXER_PHASE(1 + 10 * (L) + 2, (L))                                     \
  RUN_GEMM_PHASE(1 + 10 * (L) + 3, 4, p3a_item(p, smem, (L), it))            \
  RUN_GEMM_PHASE(1 + 10 * (L) + 4, 8, p3b_item(p, smem, (L), it))            \
  RUN_GEMM_PHASE(1 + 10 * (L) + 5, 8, p3c_item(p, smem, (L), it, rep_ == 0)) \
  RUN_PHASE(1 + 10 * (L) + 6, 1024, hmat_item(p, (L), 1, it))                \
  RUN_GEMM_PHASE(1 + 10 * (L) + 7, 44, p4_item(p, smem, (L), it))            \
  RUN_PHASE(1 + 10 * (L) + 8, 512, p4b_item(p, (L), it))                     \
  RUN_GEMM_PHASE(1 + 10 * (L) + 9, 8, p5_item(p, smem, (L), it, rep_ == 0))

__global__ void __launch_bounds__(256, 2) mega(Params p, int ph_lo, int ph_hi) {
  extern __shared__ __attribute__((aligned(16))) char smem[];
  __shared__ uint4 xb_words;
  __shared__ int wq_item;
  const int nb = gridDim.x;
  if (threadIdx.x == 0) xb_words = make_uint4(0u, 0u, 0u, 0u);
  __syncthreads();
  XcdBarrier xb;
  xb.bar = (unsigned*)(p.ws + OFF_bar); xb.x = 0; xb.st = (volatile LAS unsigned*)&xb_words;
  if (ph_hi - ph_lo > 1) xb = xcd_barrier_post((unsigned*)(p.ws + OFF_bar), (volatile LAS unsigned*)&xb_words);
  if (ph_hi > 1000) cg::this_grid().sync();
  RUN_PHASE(0, P0_ITEMS, phase0_item(p, smem, it))
  RUN_LAYER(0)
  RUN_LAYER(1)
  RUN_PHASE(21, 1024, final_item(p, it))
}

extern "C" void kernel_launch(void* const* d_in, const int* in_sizes, int n_in, void* d_out, int out_size, void* d_ws,
                              size_t ws_size, hipStream_t stream) {
  Params p{};
  const float** ins = (const float**)&p;
  for (int i = 0; i < 32; ++i) ins[i] = (const float*)d_in[i];
  p.out = (float*)d_out;
  char* ws = (char*)d_ws;
  p.ws = ws;
  if (WS_TOTAL > ws_size) {
    fprintf(stderr, "kernel_launch: workspace too small (%zu needed, %zu given)\n", (size_t)WS_TOTAL, ws_size);
    return;
  }
  (void)hipMemsetAsync(ws, 0, ZERO_BYTES, stream);
#if SINGLE_LAUNCH
  static int grid_blocks = 0;
  if (!grid_blocks) {
    int dev = 0, cus = 0, per_cu = 0;
    (void)hipGetDevice(&dev);
    (void)hipDeviceGetAttribute(&cus, hipDeviceAttributeMultiprocessorCount, dev);
    (void)hipFuncSetAttribute((const void*)mega, hipFuncAttributeMaxDynamicSharedMemorySize, LDS_BYTES);
    (void)hipOccupancyMaxActiveBlocksPerMultiprocessor(&per_cu, mega, 256, LDS_BYTES);
    if (per_cu > 2) per_cu = 2;
    if (per_cu < 1) per_cu = 1;
    grid_blocks = (cus * per_cu) & ~7;
  }
  int lo = 0, hi = NPHASES;
  void* args[] = {&p, &lo, &hi};
  hipError_t e = hipLaunchCooperativeKernel((void*)mega, dim3(grid_blocks), dim3(256), args, LDS_BYTES, stream);
  if (e != hipSuccess) fprintf(stderr, "cooperative launch failed: %s (grid %d)\n", hipGetErrorString(e), grid_blocks);
#else
  for (int ph = 0; ph < NPHASES; ++ph) {
    hipLaunchKernelGGL(mega, dim3(512), dim3(256), LDS_BYTES, stream, p, ph, ph + 1);
  }
#endif
}
```

```cpp
#include <hip/hip_runtime.h>
#include <hip/hip_cooperative_groups.h>
#include <cstdio>
namespace cg = cooperative_groups;

#ifndef SINGLE_LAUNCH
#define SINGLE_LAUNCH 1
#endif

typedef __attribute__((ext_vector_type(8))) short s8v;
typedef __attribute__((ext_vector_type(4))) float f4v;
typedef __attribute__((ext_vector_type(16))) float f16v;
typedef unsigned short u16;
typedef __attribute__((ext_vector_type(4))) unsigned u4v;
__device__ __forceinline__ s8v bc8(u4v x) { return __builtin_bit_cast(s8v, x); }


#define TALL 8192
#define TCTX 4096
#define ALPHA 1.41421356237309515f
#define LNEPS 1e-5f
#define VTR_LAT 2097152
#define NVT_LAT 2097152
#define OUT_SRET 8388608
#define OUT_SSSM 12582912
#define OUT_CK 12845056
#define OUT_CV 17039360
#define WT_IN 0
#define WT_GLU (WT_IN + 7168 * 1024)
#define WT_BR (WT_GLU + 512 * 512)
#define WT_O (WT_BR + 3 * 1024 * 512)
#define WT_UP (WT_O + 1024 * 1024)
#define WT_DOWN (WT_UP + 5632 * 1024)
#define WT_LAYER ((size_t)(WT_DOWN + 1024 * 2816))

struct Params {
  const float *x_prompt, *x_sample, *state_ret, *state_ssm, *cache_k, *cache_v, *c, *c_ctx;
  const float *w_ada, *b_ada, *w_in, *ret_decay, *a_re, *a_im, *log_dt, *b_re, *b_im, *c_re, *c_im;
  const float *ssm_d, *w_glu, *rpb, *w_branch, *w_o, *ln1_g, *ln1_b, *w_up, *conv_w, *conv_b, *w_down, *ln2_g, *ln2_b;
  float* out;
  char* ws;
};

typedef __bf16 bf2v __attribute__((ext_vector_type(2)));
typedef float fl2v __attribute__((ext_vector_type(2)));
__device__ __forceinline__ unsigned pack2(float a, float b) {
  fl2v f = {a, b};
  bf2v h = __builtin_convertvector(f, bf2v);
  return __builtin_bit_cast(unsigned, h);
}
__device__ __forceinline__ u16 f2bf(float f) { return (u16)(pack2(f, 0.f) & 0xffffu); }

constexpr size_t al256(size_t x) { return (x + 255) & ~(size_t)255; }
constexpr size_t EB = (size_t)TALL * 512 * 2;
constexpr size_t OFF_mod = 0;
constexpr size_t OFF_stats = OFF_mod + al256(2 * 5 * 6144 * 4);
constexpr size_t OFF_bar = OFF_stats + al256(2 * 2 * TALL * 2 * 4);
constexpr size_t OFF_ctr = OFF_bar + al256(3456 * 4);
constexpr size_t ZERO_BYTES = OFF_ctr + al256(8 * 256);
constexpr size_t OFF_ropetab = ZERO_BYTES;
constexpr size_t OFF_abar = OFF_ropetab + al256(64 * 32 * 2 * 4);
constexpr size_t OFF_bbarT = OFF_abar + al256(2 * 2 * 32 * 64 * 2 * 4);
constexpr size_t OFF_cmT = OFF_bbarT + al256(2 * 2 * 32 * 128 * 16 * 2);
constexpr size_t OFF_CK = OFF_cmT + al256(2 * 2 * 32 * 16 * 128 * 2);
constexpr size_t OFF_CVt = OFF_CK + al256((size_t)2 * 4 * 512 * 512 * 2);
constexpr size_t OFF_S0t = OFF_CVt + al256((size_t)2 * 4 * 512 * 512 * 2);
constexpr size_t OFF_Wt = OFF_S0t + al256((size_t)2 * 4 * 2 * 4 * 128 * 128 * 2);
constexpr size_t OFF_REGION = OFF_Wt + al256(2 * WT_LAYER * 2);
constexpr size_t OFF_z2 = OFF_REGION;
constexpr size_t OFF_act = OFF_z2 + (size_t)TALL * 5632 * 2;
constexpr size_t OFF_pre1 = OFF_act + (size_t)TALL * 2816 * 2;
constexpr size_t WS_TOTAL = OFF_pre1 + (size_t)TALL * 1024 * 4;
constexpr size_t OFF_K = OFF_pre1;
constexpr size_t OFF_VtR = OFF_K + EB;
constexpr size_t OFF_NQ = OFF_VtR + EB;
constexpr size_t OFF_NK = OFF_NQ + EB;
constexpr size_t OFF_GT = OFF_REGION;
constexpr size_t OFF_rout = OFF_GT + (size_t)TALL * 3072 * 2;
constexpr size_t OFF_nout = OFF_rout + EB;
constexpr size_t OFF_YD = OFF_nout + EB;
constexpr size_t OFF_merged = OFF_YD;
constexpr size_t OFF_Q = OFF_YD + 2 * EB;
constexpr size_t OFF_sout = OFF_Q;
constexpr size_t OFF_KtR = OFF_Q + EB;
constexpr size_t OFF_G = OFF_KtR + EB / 2;
constexpr size_t OFF_SU = OFF_G + EB;
constexpr size_t OFF_NVt = OFF_SU + EB;
constexpr size_t OFF_h1 = OFF_NVt + EB;
constexpr size_t OFF_h2 = OFF_act;
static_assert(OFF_h1 + 2 * EB <= OFF_pre1, "mixer buffers overflow the z2+act area");
#define WS_h1 ((u16*)(p.ws + OFF_h1))
#define WS_h2 ((u16*)(p.ws + OFF_h2))
#define WS_mod ((float*)(p.ws + OFF_mod))
#define WS_stats ((float*)(p.ws + OFF_stats))
#define WS_ropetab ((float*)(p.ws + OFF_ropetab))
#define WS_abar ((float*)(p.ws + OFF_abar))
#define WS_pre1 ((float*)(p.ws + OFF_pre1))
#define WS_bbarT ((u16*)(p.ws + OFF_bbarT))
#define WS_cmT ((u16*)(p.ws + OFF_cmT))
#define WS_CK ((u16*)(p.ws + OFF_CK))
#define WS_CVt ((u16*)(p.ws + OFF_CVt))
#define WS_S0t ((u16*)(p.ws + OFF_S0t))
#define WS_Wt ((u16*)(p.ws + OFF_Wt))
#define WS_Q ((u16*)(p.ws + OFF_Q))
#define WS_K ((u16*)(p.ws + OFF_K))
#define WS_VtR ((u16*)(p.ws + OFF_VtR))
#define WS_KtR ((u16*)(p.ws + OFF_KtR))
#define WS_G ((u16*)(p.ws + OFF_G))
#define WS_SU ((u16*)(p.ws + OFF_SU))
#define WS_NQ ((u16*)(p.ws + OFF_NQ))
#define WS_NK ((u16*)(p.ws + OFF_NK))
#define WS_NVt ((u16*)(p.ws + OFF_NVt))
#define WS_GT ((u16*)(p.ws + OFF_GT))
#define WS_rout ((u16*)(p.ws + OFF_rout))
#define WS_sout ((u16*)(p.ws + OFF_sout))
#define WS_nout ((u16*)(p.ws + OFF_nout))
#define WS_YD ((u16*)(p.ws + OFF_YD))
#define WS_merged ((u16*)(p.ws + OFF_merged))
#define WS_z2 ((u16*)(p.ws + OFF_z2))
#define WS_act ((u16*)(p.ws + OFF_act))

__device__ __forceinline__ float bf2f(unsigned h) { return __uint_as_float((h & 0xffffu) << 16); }
__device__ __forceinline__ float bflo(unsigned w) { return __uint_as_float(w << 16); }
__device__ __forceinline__ float bfhi(unsigned w) { return __uint_as_float(w & 0xffff0000u); }
__device__ __forceinline__ float sigmoidf_(float x) { return 1.f / (1.f + __expf(-x)); }
__device__ __forceinline__ float siluf_(float x) { return x / (1.f + __expf(-x)); }
__device__ __forceinline__ float geluf_(float x) {
  float u = 0.7978845608028654f * (x + 0.044715f * x * x * x);
  float e = __expf(2.f * u);
  float t = 1.f - 2.f / (e + 1.f);
  return 0.5f * x * (1.f + t);
}
__device__ __forceinline__ f16v zero16() {
  return (f16v){0.f, 0.f, 0.f, 0.f, 0.f, 0.f, 0.f, 0.f, 0.f, 0.f, 0.f, 0.f, 0.f, 0.f, 0.f, 0.f};
}
__device__ __forceinline__ int ltid() { int t = threadIdx.x; asm volatile("" : "+v"(t)); return t; }
__device__ __forceinline__ int cond_of_row(int row) { return row < TCTX ? 0 : 1 + ((row - TCTX) >> 10); }

struct AArgs {
  const u16* A16; int lda;
  const float* A32lo; const float* A32hi;
  const float* stats;
  const float* lng; const float* lnb;
  const float* sc; const float* sh;
  const u16* SU; const u16* YD0; const u16* YD1; const float* dsk;
};

#define GST 72
#define LDS_GEMM (2 * 2 * 128 * GST * 2)
#define LDS_BYTES LDS_GEMM

template <int AMODE>
__device__ __forceinline__ void gemm_mainloop(char* smem, const AArgs& a, const u16* __restrict__ Bt, int ldb, int K,
                                              int m0, int n0, f16v (&acc)[2][2]) {
  u16* As = (u16*)smem;
  u16* Bs = As + 2 * 128 * GST;
  const int tid = ltid(), lane = tid & 63, wave = tid >> 6;
  const int wm = wave >> 1, wn = wave & 1;
  const int crow = tid >> 3, cch = tid & 7;
  const int frow = tid >> 4, fch = tid & 15;
  float rs[8], nm[8];
  const float* srow0 = nullptr;
  const float *gsc = nullptr, *gsh = nullptr;
  __syncthreads();
  if constexpr (AMODE == 1) {
    const int ci = cond_of_row(m0);
    gsc = a.sc + ci * 6144; gsh = a.sh + ci * 6144;
#pragma unroll
    for (int i = 0; i < 8; ++i) {
      rs[i] = 1.f; nm[i] = 0.f;
      if (a.stats) {
        const int row = m0 + frow + 16 * i;
        const float s = a.stats[row * 2], q = a.stats[row * 2 + 1];
        const float mu = s * (1.f / 1024.f);
        const float var = q * (1.f / 1024.f) - mu * mu;
        rs[i] = rsqrtf(fmaxf(var, 0.f) + LNEPS);
        nm[i] = -mu * rs[i];
      }
    }
    const int row0 = m0 + frow;
    srow0 = (row0 < TCTX ? a.A32lo + (size_t)row0 * 1024 : a.A32hi + (size_t)(row0 - TCTX) * 1024) + fch * 4;
  }
  acc[0][0] = zero16(); acc[0][1] = zero16(); acc[1][0] = zero16(); acc[1][1] = zero16();

  u4v ra[12], rb[4];
  float4 q0, q1, q2, q3;
  q0 = q1 = q3 = make_float4(0.f, 0.f, 0.f, 0.f); q2 = make_float4(1.f, 1.f, 1.f, 1.f);
  const u16* brow = Bt + (size_t)(n0 + crow) * ldb + cch * 8;
  auto issue = [&](int kt) {
    if constexpr (AMODE == 1) {
      const int k = kt * 64 + fch * 4;
      q0 = *(const float4*)(gsc + k); q1 = *(const float4*)(gsh + k);
      if (a.lng) { q2 = *(const float4*)(a.lng + k); q3 = *(const float4*)(a.lnb + k); }
    } else if constexpr (AMODE == 2) {
      const int k0 = kt * 64 + cch * 8;
      q0 = *(const float4*)(a.dsk + k0); q1 = *(const float4*)(a.dsk + k0 + 4);
    }
    if constexpr (AMODE == 0) {
      const u16* ap = a.A16 + (size_t)(m0 + crow) * a.lda + kt * 64 + cch * 8;
#pragma unroll
      for (int i = 0; i < 4; ++i) ra[i] = *(const u4v*)(ap + (size_t)(32 * i) * a.lda);
    } else if constexpr (AMODE == 1) {
#pragma unroll
      for (int i = 0; i < 8; ++i) ra[i] = *(const u4v*)(srow0 + (size_t)(16 * i) * 1024 + kt * 64);
    } else {
      const size_t o = (size_t)(m0 + crow) * 512 + kt * 64 + cch * 8;
#pragma unroll
      for (int i = 0; i < 4; ++i) {
        ra[i] = *(const u4v*)(a.SU + o + (size_t)(32 * i) * 512);
        ra[4 + i] = *(const u4v*)(a.YD0 + o + (size_t)(32 * i) * 512);
        ra[8 + i] = *(const u4v*)(a.YD1 + o + (size_t)(32 * i) * 512);
      }
    }
#pragma unroll
    for (int i = 0; i < 4; ++i) rb[i] = *(const u4v*)(brow + (size_t)(32 * i) * ldb + kt * 64);
  };
  auto stage = [&](int buf, int kt) {
    u16* Ad = As + buf * (128 * GST);
    if constexpr (AMODE == 0) {
#pragma unroll
      for (int i = 0; i < 4; ++i) *(u4v*)(Ad + (crow + 32 * i) * GST + cch * 8) = ra[i];
    } else if constexpr (AMODE == 1) {
      const float4 sc = q0, sh = q1, g = q2, b = q3;
      const float G0 = g.x * (1.f + sc.x), G1 = g.y * (1.f + sc.y), G2 = g.z * (1.f + sc.z), G3 = g.w * (1.f + sc.w);
      const float B0 = fmaf(b.x, 1.f + sc.x, sh.x), B1 = fmaf(b.y, 1.f + sc.y, sh.y), B2 = fmaf(b.z, 1.f + sc.z, sh.z), B3 = fmaf(b.w, 1.f + sc.w, sh.w);
#pragma unroll
      for (int i = 0; i < 8; ++i) {
        const float h0 = fmaf(fmaf(__uint_as_float(ra[i][0]), rs[i], nm[i]), G0, B0);
        const float h1 = fmaf(fmaf(__uint_as_float(ra[i][1]), rs[i], nm[i]), G1, B1);
        const float h2 = fmaf(fmaf(__uint_as_float(ra[i][2]), rs[i], nm[i]), G2, B2);
        const float h3 = fmaf(fmaf(__uint_as_float(ra[i][3]), rs[i], nm[i]), G3, B3);
        *(uint2*)(Ad + (frow + 16 * i) * GST + fch * 4) = make_uint2(pack2(h0, h1), pack2(h2, h3));
      }
    } else {
      const float4 da = q0, db = q1;
      const float dd[8] = {da.x, da.y, da.z, da.w, db.x, db.y, db.z, db.w};
#pragma unroll
      for (int i = 0; i < 4; ++i) {
        u4v o;
#pragma unroll
        for (int j = 0; j < 4; ++j) {
          const float v0 = geluf_(dd[2 * j] * bflo(ra[i][j]) + bflo(ra[4 + i][j]) + bflo(ra[8 + i][j]));
          const float v1 = geluf_(dd[2 * j + 1] * bfhi(ra[i][j]) + bfhi(ra[4 + i][j]) + bfhi(ra[8 + i][j]));
          o[j] = pack2(v0, v1);
        }
        *(u4v*)(Ad + (crow + 32 * i) * GST + cch * 8) = o;
      }
    }
    u16* Bd = Bs + buf * (128 * GST);
#pragma unroll
    for (int i = 0; i < 4; ++i) *(u4v*)(Bd + (crow + 32 * i) * GST + cch * 8) = rb[i];
  };
  auto compute = [&](int buf) {
    const u16* Ab = As + buf * (128 * GST) + (wm * 64 + (lane & 31)) * GST + (lane >> 5) * 8;
    const u16* Bb = Bs + buf * (128 * GST) + (wn * 64 + (lane & 31)) * GST + (lane >> 5) * 8;
#pragma unroll
    for (int ks = 0; ks < 4; ++ks) {
      s8v af0 = *(const s8v*)(Ab + ks * 16);
      s8v af1 = *(const s8v*)(Ab + 32 * GST + ks * 16);
      s8v bf0 = *(const s8v*)(Bb + ks * 16);
      s8v bf1 = *(const s8v*)(Bb + 32 * GST + ks * 16);
      acc[0][0] = __builtin_amdgcn_mfma_f32_32x32x16_bf16(af0, bf0, acc[0][0], 0, 0, 0);
      acc[0][1] = __builtin_amdgcn_mfma_f32_32x32x16_bf16(af0, bf1, acc[0][1], 0, 0, 0);
      acc[1][0] = __builtin_amdgcn_mfma_f32_32x32x16_bf16(af1, bf0, acc[1][0], 0, 0, 0);
      acc[1][1] = __builtin_amdgcn_mfma_f32_32x32x16_bf16(af1, bf1, acc[1][1], 0, 0, 0);
    }
  };

  const int nk = K >> 6;
  issue(0);
  stage(0, 0);
  __syncthreads();
#pragma unroll 1
  for (int kt = 0; kt < nk; ++kt) {
    const int buf = kt & 1;
    if (kt + 1 < nk) issue(kt + 1);
    compute(buf);
    if (kt + 1 < nk) stage(buf ^ 1, kt + 1);
    __syncthreads();
  }
}

__device__ __forceinline__ void gemm_mainloop0(char* smem, const u16* __restrict__ A, int lda, const u16* __restrict__ Bt, int ldb,
                                               int K, int m0, int n0, f16v (&acc)[2][2]) {
  u16* As = (u16*)smem;
  u16* Bs = As + 2 * 128 * GST;
  const int tid = ltid(), lane = tid & 63, wave = tid >> 6;
  const int wm = wave >> 1, wn = wave & 1;
  const int crow = tid >> 3, cch = tid & 7;
  __syncthreads();
  acc[0][0] = zero16(); acc[0][1] = zero16(); acc[1][0] = zero16(); acc[1][1] = zero16();
  const u16* arow = A + (size_t)(m0 + crow) * lda + cch * 8;
  const u16* brow = Bt + (size_t)(n0 + crow) * ldb + cch * 8;
  const size_t a32 = (size_t)32 * lda, b32 = (size_t)32 * ldb;
  u4v eA0, eA1, eA2, eA3, eB0, eB1, eB2, eB3, oA0, oA1, oA2, oA3, oB0, oB1, oB2, oB3;
#define G0_ISSUE(P, kt)                                                                                   \
  { const u16* ap_ = arow + (kt) * 64; const u16* bp_ = brow + (kt) * 64;                                 \
    P##A0 = *(const u4v*)(ap_); P##A1 = *(const u4v*)(ap_ + a32); P##A2 = *(const u4v*)(ap_ + 2 * a32);   \
    P##A3 = *(const u4v*)(ap_ + 3 * a32);                                                                 \
    P##B0 = *(const u4v*)(bp_); P##B1 = *(const u4v*)(bp_ + b32); P##B2 = *(const u4v*)(bp_ + 2 * b32);   \
    P##B3 = *(const u4v*)(bp_ + 3 * b32); }
#define G0_STAGE(P, buf)                                                                                  \
  { u16* Ad_ = As + (buf) * (128 * GST) + crow * GST + cch * 8; u16* Bd_ = Bs + (buf) * (128 * GST) + crow * GST + cch * 8; \
    *(u4v*)(Ad_) = P##A0; *(u4v*)(Ad_ + 32 * GST) = P##A1; *(u4v*)(Ad_ + 64 * GST) = P##A2; *(u4v*)(Ad_ + 96 * GST) = P##A3; \
    *(u4v*)(Bd_) = P##B0; *(u4v*)(Bd_ + 32 * GST) = P##B1; *(u4v*)(Bd_ + 64 * GST) = P##B2; *(u4v*)(Bd_ + 96 * GST) = P##B3; }
#define G0_COMPUTE(buf)                                                                                   \
  { const u16* Ab = As + (buf) * (128 * GST) + (wm * 64 + (lane & 31)) * GST + (lane >> 5) * 8;           \
    const u16* Bb = Bs + (buf) * (128 * GST) + (wn * 64 + (lane & 31)) * GST + (lane >> 5) * 8;           \
    __builtin_amdgcn_s_setprio(1);                                                                        \
    _Pragma("unroll") for (int ks = 0; ks < 4; ++ks) {                                                    \
      s8v af0 = *(const s8v*)(Ab + ks * 16);                                                              \
      s8v af1 = *(const s8v*)(Ab + 32 * GST + ks * 16);                                                   \
      s8v bf0 = *(const s8v*)(Bb + ks * 16);                                                              \
      s8v bf1 = *(const s8v*)(Bb + 32 * GST + ks * 16);                                                   \
      acc[0][0] = __builtin_amdgcn_mfma_f32_32x32x16_bf16(af0, bf0, acc[0][0], 0, 0, 0);                  \
      acc[0][1] = __builtin_amdgcn_mfma_f32_32x32x16_bf16(af0, bf1, acc[0][1], 0, 0, 0);                  \
      acc[1][0] = __builtin_amdgcn_mfma_f32_32x32x16_bf16(af1, bf0, acc[1][0], 0, 0, 0);                  \
      acc[1][1] = __builtin_amdgcn_mfma_f32_32x32x16_bf16(af1, bf1, acc[1][1], 0, 0, 0);                  \
    }                                                                                                     \
    __builtin_amdgcn_s_setprio(0); }
  const int nk = K >> 6;
  G0_ISSUE(e, 0)
  G0_ISSUE(o, 1)
  G0_STAGE(e, 0)
  __syncthreads();
  int kt = 0;
#pragma unroll 1
  for (; kt + 3 < nk; kt += 2) {
    G0_ISSUE(e, kt + 2)
    __builtin_amdgcn_sched_barrier(0);
    G0_COMPUTE(0)
    G0_STAGE(o, 1)
    __syncthreads();
    G0_ISSUE(o, kt + 3)
    __builtin_amdgcn_sched_barrier(0);
    G0_COMPUTE(1)
    G0_STAGE(e, 0)
    __syncthreads();
  }
  G0_COMPUTE(0)
  G0_STAGE(o, 1)
  __syncthreads();
  G0_COMPUTE(1)
  __syncthreads();
#undef G0_ISSUE
#undef G0_STAGE
#undef G0_COMPUTE
}

#define EPI_ROW(mi, reg) (m0 + wm * 64 + (mi) * 32 + ((reg) & 3) + 8 * ((reg) >> 2) + 4 * (lane >> 5))
#define EPI_COL(ni) (n0 + wn * 64 + (ni) * 32 + (lane & 31))


#define CST 136
__device__ __forceinline__ void cs_store(const u16* Cs, u16* __restrict__ dst, size_t ld, int tid) {
#pragma unroll
  for (int i = 0; i < 8; ++i) {
    const int c = tid + 256 * i, r = c >> 4, ch = c & 15;
    *(u4v*)(dst + (size_t)r * ld + ch * 8) = *(const u4v*)(Cs + r * CST + ch * 8);
  }
}

__device__ __forceinline__ void stats_accum(float* stats, int row, float v0, float v1, int lane) {
  float s = v0 + v1, q = v0 * v0 + v1 * v1;
#pragma unroll
  for (int o = 1; o < 32; o <<= 1) {
    s += __shfl_xor(s, o);
    q += __shfl_xor(q, o);
  }
  if ((lane & 31) == 0) {
    atomicAdd(stats + row * 2, s);
    atomicAdd(stats + row * 2 + 1, q);
  }
}

#define P0_ADA 768
#define P0_ROPE 1
#define P0_CACHE 64
#define P0_S0 64
#define P0_S5 128
#define P0_WT_PER_LAYER (16 * 112 + 8 * 8 + 3 * 8 * 16 + 16 * 16 + 16 * 88 + 44 * 16)
#define P0_WT (2 * P0_WT_PER_LAYER)
#define P0_ITEMS (P0_ADA + P0_ROPE + P0_CACHE + P0_S0 + P0_S5 + P0_WT)

__device__ __forceinline__ void wt_tile(const float* __restrict__ src, int N, u16* __restrict__ dst, int ldd, int kt, int nt, char* smem) {
  float* tile = (float*)smem;
  const int tid = ltid();
  __syncthreads();
  {
    const int c4 = (tid & 15) * 4, r0 = tid >> 4;
#pragma unroll
    for (int i = 0; i < 4; ++i) {
      const int k = r0 + 16 * i;
      const float4 v = *(const float4*)(src + (size_t)(kt * 64 + k) * N + nt * 64 + c4);
      tile[k * 65 + c4] = v.x; tile[k * 65 + c4 + 1] = v.y; tile[k * 65 + c4 + 2] = v.z; tile[k * 65 + c4 + 3] = v.w;
    }
  }
  __syncthreads();
  {
    const int n = tid >> 2, k0 = (tid & 3) * 16;
#define WTP(j) pack2(tile[(k0 + 2 * (j)) * 65 + n], tile[(k0 + 2 * (j) + 1) * 65 + n])
    u4v* d = (u4v*)(dst + (size_t)(nt * 64 + n) * ldd + kt * 64 + k0);
    d[0] = (u4v){WTP(0), WTP(1), WTP(2), WTP(3)};
    d[1] = (u4v){WTP(4), WTP(5), WTP(6), WTP(7)};
#undef WTP
  }
}
__device__ __forceinline__ void wt_item(const Params& p, char* smem, int item) {
  const int l = item / P0_WT_PER_LAYER;
  int it = item % P0_WT_PER_LAYER;
  u16* base = WS_Wt + WT_LAYER * l;
  if (it < 16 * 112) { wt_tile(p.w_in + (size_t)l * 1024 * 7168, 7168, base + WT_IN, 1024, it / 112, it % 112, smem); return; }
  it -= 16 * 112;
  if (it < 64) { wt_tile(p.w_glu + (size_t)l * 512 * 512, 512, base + WT_GLU, 512, it / 8, it % 8, smem); return; }
  it -= 64;
  if (it < 384) { const int br = it / 128; it %= 128;
    wt_tile(p.w_branch + ((size_t)l * 3 + br) * 512 * 1024, 1024, base + WT_BR + (size_t)br * 512 * 1024, 512, it / 16, it % 16, smem); return; }
  it -= 384;
  if (it < 256) { wt_tile(p.w_o + (size_t)l * 1024 * 1024, 1024, base + WT_O, 1024, it / 16, it % 16, smem); return; }
  it -= 256;
  if (it < 16 * 88) { wt_tile(p.w_up + (size_t)l * 1024 * 5632, 5632, base + WT_UP, 1024, it / 88, it % 88, smem); return; }
  it -= 16 * 88;
  wt_tile(p.w_down + (size_t)l * 2816 * 1024, 1024, base + WT_DOWN, 2816, it / 16, it % 16, smem);
}

__device__ __forceinline__ void phase0_item(const Params& p, char* smem, int item) {
  const int tid = ltid();
  if (item < P0_ADA) {
    const int ks = item & 3, cg = (item >> 2) % 96, l = item / 384;
    float* scs = (float*)smem;
    float* red = scs + 5 * 256;
    __syncthreads();
    for (int i = tid; i < 5 * 256; i += 256) {
      int ci = i >> 8, k = ks * 256 + (i & 255);
      float v = ci == 0 ? p.c_ctx[k] : p.c[(ci - 1) * 1024 + k];
      scs[i] = siluf_(v);
    }
    __syncthreads();
    const int ct = tid & 15, kg = tid >> 4;
    const float* wp = p.w_ada + (size_t)l * 1024 * 6144 + (size_t)(ks * 256 + kg * 16) * 6144 + cg * 64 + ct * 4;
    float acc[5][4];
#pragma unroll
    for (int i = 0; i < 5; ++i)
#pragma unroll
      for (int j = 0; j < 4; ++j) acc[i][j] = 0.f;
#pragma unroll 4
    for (int k = 0; k < 16; ++k) {
      float4 w = *(const float4*)(wp + (size_t)k * 6144);
#pragma unroll
      for (int ci = 0; ci < 5; ++ci) {
        float s = scs[ci * 256 + kg * 16 + k];
        acc[ci][0] += s * w.x; acc[ci][1] += s * w.y; acc[ci][2] += s * w.z; acc[ci][3] += s * w.w;
      }
    }
#pragma unroll
    for (int ci = 0; ci < 5; ++ci)
#pragma unroll
      for (int j = 0; j < 4; ++j) red[(kg * 5 + ci) * 64 + ct * 4 + j] = acc[ci][j];
    __syncthreads();
    for (int i = tid; i < 320; i += 256) {
      int ci = i >> 6, col = i & 63;
      float s = 0.f;
#pragma unroll
      for (int g = 0; g < 16; ++g) s += red[(g * 5 + ci) * 64 + col];
      if (ks == 0) s += p.b_ada[l * 6144 + cg * 64 + col];
      atomicAdd(WS_mod + (l * 5 + ci) * 6144 + cg * 64 + col, s);
    }
    return;
  }
  item -= P0_ADA;
  if (item < P0_ROPE) {
    for (int i = tid; i < 64 * 32; i += 256) {
      int pos = i >> 5, fi = i & 31;
      float inv = (float)pow(10000.0, -(double)fi / 32.0);
      float ang = (float)pos * inv;
      WS_ropetab[i * 2] = (float)cos((double)ang);
      WS_ropetab[i * 2 + 1] = (float)sin((double)ang);
    }
    return;
  }
  item -= P0_ROPE;
  if (item < P0_CACHE) {
    const int pc = item & 7, b = (item >> 3) & 3, l = item >> 5;
    const float* ksrc = p.cache_k + ((size_t)(b * 2 + l) * 512 + pc * 64) * 512;
    const float* vsrc = p.cache_v + ((size_t)(b * 2 + l) * 512 + pc * 64) * 512;
    u16* kdst = WS_CK + ((size_t)(l * 4 + b) * 512 + pc * 64) * 512;
    for (int i = tid; i < 64 * 512 / 4; i += 256) {
      float4 v = *(const float4*)(ksrc + (size_t)i * 4);
      *(uint2*)(kdst + (size_t)i * 4) = make_uint2(pack2(v.x, v.y), pack2(v.z, v.w));
    }
    for (int cc = 0; cc < 2; ++cc) {
      const int col = tid + cc * 256;
      u16* vdst = WS_CVt + ((size_t)(l * 4 + b) * 512 + col) * 512 + pc * 64;
      for (int j = 0; j < 8; ++j) {
        float v[8];
#pragma unroll
        for (int e = 0; e < 8; ++e) v[e] = vsrc[(size_t)(j * 8 + e) * 512 + col];
        *(uint4*)(vdst + j * 8) = make_uint4(pack2(v[0], v[1]), pack2(v[2], v[3]), pack2(v[4], v[5]), pack2(v[6], v[7]));
      }
    }
    return;
  }
  item -= P0_CACHE;
  if (item < P0_S0) {
    const int hh = item & 3, dir = (item >> 2) & 1, b = (item >> 3) & 3, l = item >> 5;
    const float* src = p.state_ret + ((size_t)(((b * 2 + l) * 2 + dir) * 4 + hh)) * 16384;
    u16* dst = WS_S0t + ((size_t)(((l * 4 + b) * 2 + dir) * 4 + hh)) * 16384;
    const int dv = tid & 127, kh = tid >> 7;
    for (int j = 0; j < 8; ++j) {
      const int dk0 = kh * 64 + j * 8;
      float v[8];
#pragma unroll
      for (int e = 0; e < 8; ++e) v[e] = src[(size_t)(dk0 + e) * 128 + dv];
      *(uint4*)(dst + (size_t)dv * 128 + dk0) = make_uint4(pack2(v[0], v[1]), pack2(v[2], v[3]), pack2(v[4], v[5]), pack2(v[6], v[7]));
    }
    return;
  }
  item -= P0_S0;
  if (item >= P0_S5) { wt_item(p, smem, item - P0_S5); return; }
  {
    const int g = item & 31, dir = (item >> 5) & 1, l = item >> 6;
    if (tid < 64) {
      const int pp = tid;
      const int ai = ((l * 2 + dir) * 32 + g) * 64 + pp;
      double lre = fmin((double)p.a_re[ai], -1e-4), lim = (double)p.a_im[ai];
      double dt = exp((double)p.log_dt[(l * 2 + dir) * 32 + g]);
      double er = exp(lre * dt);
      double abr = er * cos(lim * dt), abi = er * sin(lim * dt);
      WS_abar[ai * 2] = (float)abr;
      WS_abar[ai * 2 + 1] = (float)abi;
      double nr = abr - 1.0, ni = abi;
      double den = lre * lre + lim * lim;
      double cr = (nr * lre + ni * lim) / den, cim = (ni * lre - nr * lim) / den;
      u16* bt = WS_bbarT + (size_t)((l * 2 + dir) * 32 + g) * 128 * 16;
      const float* br = p.b_re + ((size_t)(l * 32 + g) * 64 + pp) * 16;
      const float* bi = p.b_im + ((size_t)(l * 32 + g) * 64 + pp) * 16;
      for (int c = 0; c < 16; ++c) {
        double xr = br[c], xi = bi[c];
        bt[pp * 16 + c] = f2bf((float)(cr * xr - cim * xi));
        bt[(64 + pp) * 16 + c] = f2bf((float)(cr * xi + cim * xr));
      }
      u16* ct = WS_cmT + (size_t)((l * 2 + dir) * 32 + g) * 16 * 128;
      const float* cre = p.c_re + ((size_t)((l * 2 + dir) * 32 + g) * 16) * 64;
      const float* cie = p.c_im + ((size_t)((l * 2 + dir) * 32 + g) * 16) * 64;
      for (int c = 0; c < 16; ++c) {
        ct[c * 128 + pp] = f2bf(cre[c * 64 + pp]);
        ct[c * 128 + 64 + pp] = f2bf(-cie[c * 64 + pp]);
      }
    }
  }
}


__device__ __forceinline__ void hmat_item(const Params& p, int l, int which, int item) {
  const int c = ltid() * 4;
  const int row0 = item * 8;
  const int ci = cond_of_row(row0);
  const float* mod = WS_mod + (l * 5 + ci) * 6144;
  const float4 sc = *(const float4*)(mod + (which ? 4 : 1) * 1024 + c);
  const float4 sh = *(const float4*)(mod + (which ? 3 : 0) * 1024 + c);
  float4 g = make_float4(1.f, 1.f, 1.f, 1.f), b = make_float4(0.f, 0.f, 0.f, 0.f);
  const float* st = nullptr;
  if (which == 1) { g = *(const float4*)(p.ln1_g + l * 1024 + c); b = *(const float4*)(p.ln1_b + l * 1024 + c); st = WS_stats + (size_t)(l * 2 + 0) * TALL * 2; }
  else if (l == 1) { g = *(const float4*)(p.ln2_g + c); b = *(const float4*)(p.ln2_b + c); st = WS_stats + (size_t)(0 * 2 + 1) * TALL * 2; }
  const float G0 = g.x * (1.f + sc.x), G1 = g.y * (1.f + sc.y), G2 = g.z * (1.f + sc.z), G3 = g.w * (1.f + sc.w);
  const float B0 = fmaf(b.x, 1.f + sc.x, sh.x), B1 = fmaf(b.y, 1.f + sc.y, sh.y), B2 = fmaf(b.z, 1.f + sc.z, sh.z), B3 = fmaf(b.w, 1.f + sc.w, sh.w);
  u16* dst = which ? WS_h2 : WS_h1;
#pragma unroll
  for (int r = 0; r < 8; ++r) {
    const int row = row0 + r;
    const float* src;
    if (which == 1) src = WS_pre1 + (size_t)row * 1024;
    else if (l == 1) src = p.out + (size_t)row * 1024;
    else src = row < TCTX ? p.x_prompt + (size_t)row * 1024 : p.x_sample + (size_t)(row - TCTX) * 1024;
    float rs = 1.f, nm = 0.f;
    if (st) {
      const float s = st[row * 2], q = st[row * 2 + 1];
      const float mu = s * (1.f / 1024.f);
      rs = rsqrtf(fmaxf(q * (1.f / 1024.f) - mu * mu, 0.f) + LNEPS);
      nm = -mu * rs;
    }
    const float4 x = *(const float4*)(src + c);
    const float h0 = fmaf(fmaf(x.x, rs, nm), G0, B0), h1 = fmaf(fmaf(x.y, rs, nm), G1, B1);
    const float h2 = fmaf(fmaf(x.z, rs, nm), G2, B2), h3 = fmaf(fmaf(x.w, rs, nm), G3, B3);
    *(uint2*)(dst + (size_t)row * 1024 + c) = make_uint2(pack2(h0, h1), pack2(h2, h3));
  }
}

__device__ __forceinline__ void p1_item(const Params& p, char* smem, int l, int item) {
  const int mt = item & 63, nt = item >> 6;
  const int m0 = mt * 128, n0 = nt * 128;
  const int tid = ltid(), lane = tid & 63, wave = tid >> 6, wm = wave >> 1, wn = wave & 1;
  f16v acc[2][2];
  gemm_mainloop0(smem, WS_h1, 1024, WS_Wt + WT_LAYER * l + WT_IN, 1024, 1024, m0, n0, acc);

  const bool latent = m0 >= TCTX;
  const int seg = n0 >> 9;
  const int cs0 = n0 & 511;
  const int l31 = lane & 31;
  u16* Cs = (u16*)smem;
  u16* CsT = Cs + 128 * CST;
  const int rl0 = wm * 64 + 4 * (lane >> 5);
  const int cl0 = wn * 64 + l31;
  const bool want_rm = !(seg == 2 || seg == 7);
  const bool want_t = (seg == 2 || seg == 7 || (seg == 1 && !latent));
#pragma unroll
  for (int mi = 0; mi < 2; ++mi)
#pragma unroll
    for (int q = 0; q < 4; ++q) {
      float o0[4], o1[4];
#pragma unroll
      for (int j = 0; j < 4; ++j) {
        const int reg = q * 4 + j;
        float x1 = acc[mi][0][reg], x2 = acc[mi][1][reg];
        if (seg <= 1) {
          if (latent) {
            const int pos = (m0 - TCTX + rl0 + mi * 32 + q * 8 + j) & 1023;
            const int pidx = ((cs0 + wn * 64) & 64) ? (pos & 63) : (pos >> 6);
            const float cs = WS_ropetab[(pidx * 32 + l31) * 2], sn = WS_ropetab[(pidx * 32 + l31) * 2 + 1];
            const float t1 = x1 * cs - x2 * sn, t2 = x1 * sn + x2 * cs;
            x1 = t1; x2 = t2;
          }
          if (seg == 1) { x1 *= 0.08838834764831845f; x2 *= 0.08838834764831845f; }
        } else if (seg == 3) { x1 = siluf_(x1); x2 = siluf_(x2); }
        else if (seg == 5) { x1 *= 0.125f; x2 *= 0.125f; }
        else if (seg >= 8) { x1 = sigmoidf_(x1); x2 = sigmoidf_(x2); }
        o0[j] = x1; o1[j] = x2;
        if (want_rm) {
          const int rl = rl0 + mi * 32 + q * 8 + j;
          Cs[rl * CST + cl0] = f2bf(x1);
          Cs[rl * CST + cl0 + 32] = f2bf(x2);
        }
        if ((seg == 6 || seg == 7) && !latent) {
          const int row = m0 + rl0 + mi * 32 + q * 8 + j;
          float* o = p.out + (seg == 6 ? OUT_CK : OUT_CV) + ((size_t)((row >> 8) * 2 + l) * 256 + (row & 255)) * 512 + cs0 + cl0;
          o[0] = acc[mi][0][reg]; o[32] = acc[mi][1][reg];
        }
      }
      if (want_t) {
        const int rl = rl0 + mi * 32 + q * 8;
        *(uint2*)(CsT + cl0 * CST + rl) = make_uint2(pack2(o0[0], o0[1]), pack2(o0[2], o0[3]));
        *(uint2*)(CsT + (cl0 + 32) * CST + rl) = make_uint2(pack2(o1[0], o1[1]), pack2(o1[2], o1[3]));
      }
    }
  __syncthreads();
  if (want_rm) {
    u16* dst;
    size_t ld = 512;
    if (seg >= 8) { dst = WS_GT + (size_t)m0 * 3072 + (n0 - 4096); ld = 3072; }
    else {
      u16* base = seg == 0 ? WS_Q : seg == 1 ? WS_K : seg == 3 ? WS_G : seg == 4 ? WS_SU : seg == 5 ? WS_NQ : WS_NK;
      dst = base + (size_t)m0 * 512 + cs0;
    }
    cs_store(Cs, dst, ld, tid);
  }
  if (want_t) {
    u16* base = seg == 2 ? WS_VtR : seg == 7 ? WS_NVt : WS_KtR;
    u16* dst;
    size_t ld;
    if (!latent) { dst = base + ((size_t)(m0 >> 8) * 512 + cs0) * 256 + (m0 & 255); ld = 256; }
    else { dst = base + VTR_LAT + ((size_t)((m0 - TCTX) >> 10) * 512 + cs0) * 1024 + ((m0 - TCTX) & 1023); ld = 1024; }
    cs_store(CsT, dst, ld, tid);
  }
}

template <int D, int MODE>
__device__ __forceinline__ void attn_item(const Params& p, char* smem, int l, int idx) {
  constexpr int KSTR = D + 8;
  constexpr int NKS = D / 32;
  constexpr int NB = D / 16;
  constexpr int NCH = D / 32;
  u16* Ks = (u16*)smem;
  u16* Vts = Ks + 64 * KSTR;
  float* rpbs = (float*)(Vts + D * 72);
  const int tid = ltid(), lane = tid & 63, wave = tid >> 6;
  const int l15 = lane & 15, g = lane >> 4;
  const int wave_u = __builtin_amdgcn_readfirstlane(wave);

  int b, hh, qt, L, tokbase, nt;
  bool latent = false;
  int kr0 = 0, rrow = 0;
  if constexpr (MODE == 0) {
    if (idx < 256) { latent = true; b = idx >> 6; hh = (idx >> 4) & 3; qt = idx & 15; L = 1024; tokbase = TCTX + b * 1024; nt = 16 + 4; }
    else { idx -= 256; b = idx >> 4; hh = (idx >> 2) & 3; qt = idx & 3; L = 256; tokbase = b * 256; nt = 4; }
  } else if constexpr (MODE == 1) {
    b = idx >> 5; hh = (idx >> 2) & 7; qt = idx & 3; L = 256; tokbase = b * 256; nt = 4;
  } else {
    b = idx >> 7; hh = (idx >> 4) & 7; qt = idx & 15; rrow = qt; L = 1024; tokbase = TCTX + b * 1024; nt = 16; latent = true;
    kr0 = min(max(rrow - 4, 0), 8);
  }
  const int tq = qt * 64 + wave * 16 + l15;
  const int qtok = tokbase + tq;

  float lgf2 = 0.f, lgb2 = 0.f;
  if constexpr (MODE == 0) {
    float xf = p.ret_decay[(l * 2 + 0) * 4 + hh], xb = p.ret_decay[(l * 2 + 1) * 4 + hh];
    lgf2 = -log1pf(expf(-xf)) * 1.4426950408889634f;
    lgb2 = -log1pf(expf(-xb)) * 1.4426950408889634f;
  }
  float cfw[4][4], cbw[4][4];
  if constexpr (MODE == 0) {
#pragma unroll
    for (int kb = 0; kb < 4; ++kb)
#pragma unroll
      for (int r = 0; r < 4; ++r) {
        const float off = (float)(kb * 16 + g * 4 + r);
        cfw[kb][r] = __builtin_amdgcn_exp2f(-lgf2 * off);
        cbw[kb][r] = __builtin_amdgcn_exp2f(lgb2 * off);
      }
  }

  __syncthreads();
  if constexpr (MODE == 2) {
    for (int i = tid; i < 465; i += 256) rpbs[i] = p.rpb[(size_t)(l * 8 + hh) * 465 + i];
  }

  u4v qf[NKS];
  {
    const u16* qb = (MODE == 0 ? WS_Q : WS_NQ) + (size_t)qtok * 512 + hh * D + g * 8;
#pragma unroll
    for (int ks = 0; ks < NKS; ++ks) qf[ks] = *(const u4v*)(qb + ks * 32);
  }

  f4v ot[NB];
#pragma unroll
  for (int nb = 0; nb < NB; ++nb) ot[nb] = (f4v){0.f, 0.f, 0.f, 0.f};
  float mrun = -1e30f, lsum = 0.f;

  const int ntk = (MODE == 0) ? (L >> 6) : nt;
  u4v kr[NCH], vr[NCH];
#define ATTN_ISSUE(KT)                                                                                   \
  {                                                                                                      \
    const int kt_ = (KT);                                                                                \
    const u16* kp; const u16* vp; int ldv;                                                               \
    if constexpr (MODE == 0) {                                                                           \
      kp = WS_K + (size_t)(tokbase + kt_ * 64) * 512 + hh * 128;                                          \
      if (latent) { vp = WS_VtR + VTR_LAT + ((size_t)(b * 4 + hh) * 128) * 1024 + kt_ * 64; ldv = 1024; } \
      else { vp = WS_VtR + ((size_t)(b * 4 + hh) * 128) * 256 + kt_ * 64; ldv = 256; }                    \
    } else if constexpr (MODE == 1) {                                                                    \
      kp = WS_NK + (size_t)(tokbase + kt_ * 64) * 512 + hh * 64;                                          \
      vp = WS_NVt + ((size_t)(b * 8 + hh) * 64) * 256 + kt_ * 64; ldv = 256;                              \
    } else {                                                                                             \
      if (kt_ < 8) {                                                                                     \
        const int krow = kr0 + kt_;                                                                      \
        kp = WS_NK + (size_t)(tokbase + krow * 64) * 512 + hh * 64;                                       \
        vp = WS_NVt + NVT_LAT + ((size_t)(b * 8 + hh) * 64) * 1024 + krow * 64; ldv = 1024;               \
      } else {                                                                                           \
        kp = WS_CK + ((size_t)(l * 4 + b) * 512 + (kt_ - 8) * 64) * 512 + hh * 64;                        \
        vp = WS_CVt + ((size_t)((l * 4 + b) * 8 + hh) * 64) * 512 + (kt_ - 8) * 64; ldv = 512;            \
      }                                                                                                  \
    }                                                                                                    \
    _Pragma("unroll") for (int i = 0; i < NCH; ++i) {                                                    \
      const int c = tid + 256 * i;                                                                       \
      const int r = c / (D / 8), cc = c % (D / 8);                                                       \
      kr[i] = *(const u4v*)(kp + (size_t)r * 512 + cc * 8);                                              \
      const int vrw = c >> 3, vc = c & 7;                                                                \
      vr[i] = *(const u4v*)(vp + (size_t)vrw * ldv + vc * 8);                                            \
    }                                                                                                    \
  }
#define ATTN_STAGE()                                                                                     \
  {                                                                                                      \
    _Pragma("unroll") for (int i = 0; i < NCH; ++i) {                                                    \
      const int c = tid + 256 * i;                                                                       \
      const int r = c / (D / 8), cc = c % (D / 8);                                                       \
      *(u4v*)(Ks + r * KSTR + cc * 8) = kr[i];                                                           \
      const int vrw = c >> 3, vc = c & 7;                                                                \
      *(u4v*)(Vts + vrw * 72 + vc * 8) = vr[i];                                                          \
    }                                                                                                    \
  }

  ATTN_ISSUE(0)
#pragma unroll 1
  for (int kt = 0; kt < ntk; ++kt) {
    __syncthreads();
    ATTN_STAGE()
    __syncthreads();
    if (kt + 1 < ntk) ATTN_ISSUE(kt + 1)
    f4v st[4];
    int kb_lo = 0, kb_hi = 3;
    if constexpr (MODE == 2) {
      if (kt < 8) { kb_lo = wave_u >= 2 ? wave_u - 1 : 0; kb_hi = wave_u <= 1 ? wave_u + 1 : 3; }
    }
#pragma unroll
    for (int kb = 0; kb < 4; ++kb) {
      st[kb] = (f4v){0.f, 0.f, 0.f, 0.f};
      if (MODE != 2 || (kb >= kb_lo && kb <= kb_hi)) {
#pragma unroll
        for (int ks = 0; ks < NKS; ++ks) {
          s8v kf = *(const s8v*)(Ks + (kb * 16 + l15) * KSTR + ks * 32 + g * 8);
          st[kb] = __builtin_amdgcn_mfma_f32_16x16x32_bf16(kf, bc8(qf[ks]), st[kb], 0, 0, 0);
        }
      }
    }
    if constexpr (MODE == 0) {
      if (kt < qt) {
        const float rowf = __builtin_amdgcn_exp2f(lgf2 * (float)(tq - kt * 64));
#pragma unroll
        for (int kb = 0; kb < 4; ++kb)
#pragma unroll
          for (int r = 0; r < 4; ++r) st[kb][r] *= rowf * cfw[kb][r];
      } else if (kt > qt) {
        const float rowb = __builtin_amdgcn_exp2f(lgb2 * (float)(kt * 64 - tq));
#pragma unroll
        for (int kb = 0; kb < 4; ++kb)
#pragma unroll
          for (int r = 0; r < 4; ++r) st[kb][r] *= rowb * cbw[kb][r];
      } else {
#pragma unroll
        for (int kb = 0; kb < 4; ++kb)
#pragma unroll
          for (int r = 0; r < 4; ++r) {
            const int ts = kt * 64 + kb * 16 + g * 4 + r;
            const int d = tq - ts;
            float dec = d > 0 ? exp2f(lgf2 * (float)d) : (d < 0 ? exp2f(lgb2 * (float)(-d)) : 2.f);
            st[kb][r] *= dec;
          }
      }
    } else {
      if constexpr (MODE == 2) {
        if (kt < 8) {
          const int qc = wave * 16 + l15;
          const int ws = min(max(qc - 8, 0), 48);
          const int roff = (kr0 + kt) - rrow + 7;
#pragma unroll
          for (int kb = 0; kb < 4; ++kb) {
            if (kb >= kb_lo && kb <= kb_hi) {
#pragma unroll
              for (int r = 0; r < 4; ++r) {
                const int kc = kb * 16 + g * 4 + r;
                const bool valid = (kc >= ws) && (kc < ws + 16);
                const int coff = min(max(kc - qc + 15, 0), 30);
                const float bias = rpbs[roff * 31 + coff];
                st[kb][r] = valid ? st[kb][r] + bias : -1e30f;
              }
            } else {
              st[kb] = (f4v){-1e30f, -1e30f, -1e30f, -1e30f};
            }
          }
        }
      }
      float tmax = st[0][0];
#pragma unroll
      for (int kb = 0; kb < 4; ++kb)
#pragma unroll
        for (int r = 0; r < 4; ++r) tmax = fmaxf(tmax, st[kb][r]);
      tmax = fmaxf(tmax, __shfl_xor(tmax, 16));
      tmax = fmaxf(tmax, __shfl_xor(tmax, 32));
      const float mnew = fmaxf(mrun, tmax);
      const float alpha = __expf(mrun - mnew);
      float ps = 0.f;
#pragma unroll
      for (int kb = 0; kb < 4; ++kb) {
        if (MODE != 2 || (kb >= kb_lo && kb <= kb_hi)) {
#pragma unroll
          for (int r = 0; r < 4; ++r) {
            float e = __expf(st[kb][r] - mnew);
            st[kb][r] = e;
            ps += e;
          }
        } else {
          st[kb] = (f4v){0.f, 0.f, 0.f, 0.f};
        }
      }
      lsum = lsum * alpha + ps;
      mrun = mnew;
#pragma unroll
      for (int nb = 0; nb < NB; ++nb) ot[nb] *= alpha;
    }
    u4v pf[2];
#pragma unroll
    for (int s = 0; s < 2; ++s) {
      pf[s] = (u4v){pack2(st[2 * s][0], st[2 * s][1]), pack2(st[2 * s][2], st[2 * s][3]),
                    pack2(st[2 * s + 1][0], st[2 * s + 1][1]), pack2(st[2 * s + 1][2], st[2 * s + 1][3])};
    }
#pragma unroll
    for (int s = 0; s < 2; ++s) {
      if (MODE == 2 && (2 * s + 1 < kb_lo || 2 * s > kb_hi)) continue;
#pragma unroll
      for (int nb = 0; nb < NB; ++nb) {
        const u16* vb = Vts + (nb * 16 + l15) * 72 + s * 32 + g * 4;
        uint2 lo = *(const uint2*)(vb);
        uint2 hi = *(const uint2*)(vb + 16);
        u4v vf = (u4v){lo.x, lo.y, hi.x, hi.y};
        ot[nb] = __builtin_amdgcn_mfma_f32_16x16x32_bf16(bc8(vf), bc8(pf[s]), ot[nb], 0, 0, 0);
      }
    }
  }

  if constexpr (MODE == 0) {
    if (latent) {
#pragma unroll 1
      for (int dir = 0; dir < 2; ++dir) {
        const float scale = dir == 0 ? exp2f(lgf2 * (float)(tq + 1)) : exp2f(lgb2 * (float)(L - tq));
        const u16* S0 = WS_S0t + ((size_t)(((l * 4 + b) * 2 + dir) * 4 + hh)) * 16384;
#pragma unroll
        for (int s = 0; s < NKS; ++s) {
          u4v pq = (u4v){pack2(bflo(qf[s][0]) * scale, bfhi(qf[s][0]) * scale), pack2(bflo(qf[s][1]) * scale, bfhi(qf[s][1]) * scale),
                         pack2(bflo(qf[s][2]) * scale, bfhi(qf[s][2]) * scale), pack2(bflo(qf[s][3]) * scale, bfhi(qf[s][3]) * scale)};
#pragma unroll
          for (int nb = 0; nb < NB; ++nb) {
            u4v vf = *(const u4v*)(S0 + (size_t)(nb * 16 + l15) * 128 + s * 32 + g * 8);
            ot[nb] = __builtin_amdgcn_mfma_f32_16x16x32_bf16(bc8(vf), bc8(pq), ot[nb], 0, 0, 0);
          }
        }
      }
    }
    float s = 0.f;
#pragma unroll
    for (int nb = 0; nb < NB; ++nb) s += ot[nb][0] + ot[nb][1] + ot[nb][2] + ot[nb][3];
    s += __shfl_xor(s, 16); s += __shfl_xor(s, 32);
    const float mu = s * (1.f / 128.f);
    float q = 0.f;
#pragma unroll
    for (int nb = 0; nb < NB; ++nb)
#pragma unroll
      for (int r = 0; r < 4; ++r) { float dlt = ot[nb][r] - mu; q += dlt * dlt; }
    q += __shfl_xor(q, 16); q += __shfl_xor(q, 32);
    const float rstd = rsqrtf(q * (1.f / 128.f) + LNEPS);
#pragma unroll
    for (int nb = 0; nb < NB; ++nb) {
      const size_t off = (size_t)qtok * 512 + hh * 128 + nb * 16 + g * 4;
      uint2 gg = *(const uint2*)(WS_G + off);
      float o0 = (ot[nb][0] - mu) * rstd * bflo(gg.x);
      float o1 = (ot[nb][1] - mu) * rstd * bfhi(gg.x);
      float o2 = (ot[nb][2] - mu) * rstd * bflo(gg.y);
      float o3 = (ot[nb][3] - mu) * rstd * bfhi(gg.y);
      *(uint2*)(WS_rout + off) = make_uint2(pack2(o0, o1), pack2(o2, o3));
    }
  } else {
    lsum += __shfl_xor(lsum, 16); lsum += __shfl_xor(lsum, 32);
    const float inv = 1.f / lsum;
#pragma unroll
    for (int nb = 0; nb < NB; ++nb) {
      const size_t off = (size_t)qtok * 512 + hh * 64 + nb * 16 + g * 4;
      *(uint2*)(WS_nout + off) = make_uint2(pack2(ot[nb][0] * inv, ot[nb][1] * inv), pack2(ot[nb][2] * inv, ot[nb][3] * inv));
    }
  }
}

__device__ __forceinline__ void retstate_item(const Params& p, int l, int idx) {
  const int dir = idx & 1, hh = (idx >> 1) & 3, b = idx >> 3;
  const int tid = ltid(), lane = tid & 63, wave = tid >> 6;
  const int r = lane & 31, h2 = lane >> 5;
  const float x = p.ret_decay[(l * 2 + dir) * 4 + hh];
  const float lg2 = -log1pf(expf(-x)) * 1.4426950408889634f;
  const u16* Kt = WS_KtR + ((size_t)(b * 4 + hh) * 128) * 256;
  const u16* Vt = WS_VtR + ((size_t)(b * 4 + hh) * 128) * 256;
  f16v acc[4];
#pragma unroll
  for (int i = 0; i < 4; ++i) acc[i] = zero16();
#pragma unroll 2
  for (int ks = 0; ks < 16; ++ks) {
    const int tok0 = ks * 16 + h2 * 8;
    const u4v a = *(const u4v*)(Kt + (size_t)(wave * 32 + r) * 256 + tok0);
    u4v af;
#pragma unroll
    for (int w = 0; w < 4; ++w) {
      const int t0 = tok0 + 2 * w, t1 = t0 + 1;
      float w0 = dir == 0 ? exp2f(lg2 * (float)(255 - t0)) : exp2f(lg2 * (float)t0);
      float w1 = dir == 0 ? exp2f(lg2 * (float)(255 - t1)) : exp2f(lg2 * (float)t1);
      af[w] = pack2(bflo(a[w]) * w0, bfhi(a[w]) * w1);
    }
#pragma unroll
    for (int nt = 0; nt < 4; ++nt) {
      const u4v bfr = *(const u4v*)(Vt + (size_t)(nt * 32 + r) * 256 + tok0);
      acc[nt] = __builtin_amdgcn_mfma_f32_32x32x16_bf16(bc8(af), bc8(bfr), acc[nt], 0, 0, 0);
    }
  }
  float* o = p.out + OUT_SRET + ((size_t)(((b * 2 + l) * 2 + dir) * 4 + hh)) * 16384;
#pragma unroll
  for (int nt = 0; nt < 4; ++nt)
#pragma unroll
    for (int reg = 0; reg < 16; ++reg) {
      const int dk = wave * 32 + (reg & 3) + 8 * (reg >> 2) + 4 * h2;
      o[(size_t)dk * 128 + nt * 32 + r] = acc[nt][reg];
    }
}

__device__ __forceinline__ void s5_item(const Params& p, char* smem, int l, int item) {
  const int tid = ltid(), lane = tid & 63, wave = tid >> 6;
  const int l15 = lane & 15, g4 = lane >> 4;
  int seq = item * 4 + wave;
  int b, dir, g, L, tokbase;
  bool latent;
  if (seq < 256) { latent = true; b = seq >> 6; dir = (seq >> 5) & 1; g = seq & 31; L = 1024; tokbase = TCTX + b * 1024; }
  else { seq -= 256; latent = false; b = seq >> 6; dir = (seq >> 5) & 1; g = seq & 31; L = 256; tokbase = b * 256; }
  float* buf = (float*)smem + wave * (16 * 132);
  const int tg = (l * 2 + dir) * 32 + g;
  const float ar = WS_abar[(tg * 64 + lane) * 2], ai = WS_abar[(tg * 64 + lane) * 2 + 1];
  u4v bfrag[8];
#pragma unroll
  for (int nt = 0; nt < 8; ++nt) {
    if (g4 < 2) bfrag[nt] = *(const u4v*)(WS_bbarT + ((size_t)tg * 128 + nt * 16 + l15) * 16 + g4 * 8);
    else bfrag[nt] = (u4v){0u, 0u, 0u, 0u};
  }
  u4v cfrag[4];
#pragma unroll
  for (int ks = 0; ks < 4; ++ks) cfrag[ks] = *(const u4v*)(WS_cmT + ((size_t)tg * 16 + l15) * 128 + ks * 32 + g4 * 8);
  float xr = 0.f, xi = 0.f;
  if (latent) {
    const float* h0 = p.state_ssm + ((size_t)(((b * 2 + l) * 2 + dir) * 32 + g) * 64 + lane) * 2;
    xr = h0[0]; xi = h0[1];
  }
  u16* yd = WS_YD + (size_t)dir * TALL * 512;
  __syncthreads();
  const int nsub = L >> 4;
  u4v afn = (u4v){0u, 0u, 0u, 0u};
  if (g4 < 2) {
    const int pos = dir == 0 ? l15 : L - 1 - l15;
    afn = *(const u4v*)(WS_SU + (size_t)(tokbase + pos) * 512 + g * 16 + g4 * 8);
  }
#pragma unroll 1
  for (int sub = 0; sub < nsub; ++sub) {
    const u4v af = afn;
    if (g4 < 2 && sub + 1 < nsub) {
      const int tau = (sub + 1) * 16 + l15;
      const int pos = dir == 0 ? tau : L - 1 - tau;
      afn = *(const u4v*)(WS_SU + (size_t)(tokbase + pos) * 512 + g * 16 + g4 * 8);
    }
#pragma unroll
    for (int nt = 0; nt < 8; ++nt) {
      f4v c = (f4v){0.f, 0.f, 0.f, 0.f};
      c = __builtin_amdgcn_mfma_f32_16x16x32_bf16(bc8(af), bc8(bfrag[nt]), c, 0, 0, 0);
#pragma unroll
      for (int r = 0; r < 4; ++r) buf[(g4 * 4 + r) * 132 + nt * 16 + l15] = c[r];
    }
    __builtin_amdgcn_wave_barrier();
#pragma unroll
    for (int i = 0; i < 16; ++i) {
      const float bur = buf[i * 132 + lane], bui = buf[i * 132 + 64 + lane];
      const float nr = ar * xr - ai * xi + bur;
      const float ni = ar * xi + ai * xr + bui;
      xr = nr; xi = ni;
      buf[i * 132 + lane] = xr;
      buf[i * 132 + 64 + lane] = xi;
    }
    __builtin_amdgcn_wave_barrier();
    f4v y = (f4v){0.f, 0.f, 0.f, 0.f};
#pragma unroll
    for (int ks = 0; ks < 4; ++ks) {
      const float* bp = buf + l15 * 132 + ks * 32 + g4 * 8;
      float4 v0 = *(const float4*)(bp), v1 = *(const float4*)(bp + 4);
      const u4v xa = (u4v){pack2(v0.x, v0.y), pack2(v0.z, v0.w), pack2(v1.x, v1.y), pack2(v1.z, v1.w)};
      y = __builtin_amdgcn_mfma_f32_16x16x32_bf16(bc8(xa), bc8(cfrag[ks]), y, 0, 0, 0);
    }
#pragma unroll
    for (int r = 0; r < 4; ++r) {
      const int tau = sub * 16 + g4 * 4 + r;
      const int pos = dir == 0 ? tau : L - 1 - tau;
      yd[(size_t)(tokbase + pos) * 512 + g * 16 + l15] = f2bf(y[r]);
    }
    __builtin_amdgcn_wave_barrier();
  }
  if (!latent) {
    float* o = p.out + OUT_SSSM + ((size_t)(((b * 2 + l) * 2 + dir) * 32 + g) * 64 + lane) * 2;
    o[0] = xr; o[1] = xi;
  }
}

#define MX_S5 320
#define MX_RET 512
#define MX_NA 512
#define MX_CA 512
#define MX_RS 128
#define MX_ITEMS (MX_S5 + MX_RET + MX_NA + MX_CA + MX_RS)
__device__ __forceinline__ void mixer_item(const Params& p, char* smem, int l, int item) {
  if (item < 64) { s5_item(p, smem, l, item); return; }
  item -= 64;
  if (item < 256) { attn_item<128, 0>(p, smem, l, item); return; }
  item -= 256;
  if (item < 512) { attn_item<64, 2>(p, smem, l, item); return; }
  item -= 512;
  if (item < 256) { s5_item(p, smem, l, 64 + item); return; }
  item -= 256;
  if (item < 256) { attn_item<128, 0>(p, smem, l, 256 + item); return; }
  item -= 256;
  if (item < 512) { attn_item<64, 1>(p, smem, l, item); return; }
  item -= 512;
  retstate_item(p, l, item);
}

__device__ __forceinline__ void p3a_item(const Params& p, char* smem, int l, int item) {
  const int mt = item & 63, nt = item >> 6;
  const int m0 = mt * 128, n0 = nt * 128;
  const int tid = ltid(), lane = tid & 63, wave = tid >> 6, wm = wave >> 1, wn = wave & 1;
  AArgs a{};
  a.SU = WS_SU; a.YD0 = WS_YD; a.YD1 = WS_YD + (size_t)TALL * 512; a.dsk = p.ssm_d + l * 512;
  f16v acc[2][2];
  gemm_mainloop<2>(smem, a, WS_Wt + WT_LAYER * l + WT_GLU, 512, 512, m0, n0, acc);
#pragma unroll
  for (int mi = 0; mi < 2; ++mi)
#pragma unroll
    for (int reg = 0; reg < 16; ++reg) {
      const int row = EPI_ROW(mi, reg);
#pragma unroll
      for (int ni = 0; ni < 2; ++ni) {
        const int col = EPI_COL(ni);
        const size_t off = (size_t)row * 512 + col;
        float y = geluf_(a.dsk[col] * bf2f(WS_SU[off]) + bf2f(a.YD0[off]) + bf2f(a.YD1[off]));
        WS_sout[off] = f2bf(y * sigmoidf_(acc[mi][ni][reg]));
      }
    }
}

__device__ __forceinline__ void p3b_item(const Params& p, char* smem, int l, int item) {
  const int mt = item & 63, nt = item >> 6;
  const int m0 = mt * 128, n0 = nt * 128;
  const int tid = ltid(), lane = tid & 63, wave = tid >> 6, wm = wave >> 1, wn = wave & 1;
  int nbr = 3;
  asm volatile("" : "+s"(nbr));
#pragma unroll 1
  for (int br = 0; br < nbr; ++br) {
    const u16* Abr = br == 0 ? WS_rout : (br == 1 ? WS_sout : WS_nout);
    f16v acc[2][2];
    gemm_mainloop0(smem, Abr, 512, WS_Wt + WT_LAYER * l + WT_BR + (size_t)br * 512 * 1024, 512, 512, m0, n0, acc);
    u16* Cs = (u16*)smem;
    {
      const int rl0 = wm * 64 + 4 * (lane >> 5), cl0 = wn * 64 + (lane & 31);
#pragma unroll
      for (int mi = 0; mi < 2; ++mi)
#pragma unroll
        for (int reg = 0; reg < 16; ++reg) {
          const int rl = rl0 + mi * 32 + (reg & 3) + 8 * (reg >> 2);
          Cs[rl * CST + cl0] = f2bf(acc[mi][0][reg]);
          Cs[rl * CST + cl0 + 32] = f2bf(acc[mi][1][reg]);
        }
    }
    __syncthreads();
    int tl = tid;
    asm volatile("" : "+v"(tl));
#pragma unroll
    for (int i = 0; i < 8; ++i) {
      const int c = tl + 256 * i, r = c >> 4, ch = c & 15;
      const u4v av = *(const u4v*)(Cs + r * CST + ch * 8);
      const u4v gv = *(const u4v*)(WS_GT + (size_t)(m0 + r) * 3072 + br * 1024 + n0 + ch * 8);
      u16* mp = WS_merged + (size_t)(m0 + r) * 1024 + n0 + ch * 8;
      u4v mv = (u4v){0u, 0u, 0u, 0u};
      if (br > 0) mv = *(const u4v*)mp;
      u4v ov;
#pragma unroll
      for (int j = 0; j < 4; ++j)
        ov[j] = pack2(fmaf(bflo(gv[j]), bflo(av[j]), bflo(mv[j])), fmaf(bfhi(gv[j]), bfhi(av[j]), bfhi(mv[j])));
      *(u4v*)mp = ov;
    }
  }
}


#define CFS 132
__device__ __forceinline__ void epi_resid(char* smem, f16v (&acc)[2][2], int m0, int n0, const float* __restrict__ gvec,
                                          const float* __restrict__ xlo, const float* __restrict__ xhi,
                                          const float* __restrict__ xstats, const float* __restrict__ lng,
                                          const float* __restrict__ lnb, float* __restrict__ dst,
                                          float* __restrict__ stats_out, bool do_stats) {
  float* Cf = (float*)smem;
  const int tid = ltid(), lane = tid & 63, wave = tid >> 6, wm = wave >> 1, wn = wave & 1;
  {
    const int rl0 = wm * 64 + 4 * (lane >> 5), cl0 = wn * 64 + (lane & 31);
    const float ga = gvec[n0 + cl0], gb = gvec[n0 + cl0 + 32];
#pragma unroll
    for (int mi = 0; mi < 2; ++mi)
#pragma unroll
      for (int reg = 0; reg < 16; ++reg) {
        const int rl = rl0 + mi * 32 + (reg & 3) + 8 * (reg >> 2);
        Cf[rl * CFS + cl0] = ga * acc[mi][0][reg];
        Cf[rl * CFS + cl0 + 32] = gb * acc[mi][1][reg];
      }
  }
  __syncthreads();
  const int ch = tid & 31, r0 = tid >> 5;
  const int col = n0 + ch * 4;
  float4 g4 = make_float4(1.f, 1.f, 1.f, 1.f), b4 = make_float4(0.f, 0.f, 0.f, 0.f);
  if (xstats) { g4 = *(const float4*)(lng + col); b4 = *(const float4*)(lnb + col); }
  const float* xbase = (m0 < TCTX ? xlo + (size_t)m0 * 1024 : xhi + (size_t)(m0 - TCTX) * 1024) + col;
#pragma unroll 4
  for (int i = 0; i < 16; ++i) {
    const int r = r0 + 8 * i;
    const int row = m0 + r;
    const float4 v = *(const float4*)(Cf + r * CFS + ch * 4);
    float4 x = *(const float4*)(xbase + (size_t)r * 1024);
    if (xstats) {
      const float s = xstats[row * 2], q = xstats[row * 2 + 1];
      const float mu = s * (1.f / 1024.f);
      const float rstd = rsqrtf(fmaxf(q * (1.f / 1024.f) - mu * mu, 0.f) + LNEPS);
      x.x = (x.x - mu) * rstd * g4.x + b4.x; x.y = (x.y - mu) * rstd * g4.y + b4.y;
      x.z = (x.z - mu) * rstd * g4.z + b4.z; x.w = (x.w - mu) * rstd * g4.w + b4.w;
    }
    float4 o;
    o.x = ALPHA * x.x + v.x; o.y = ALPHA * x.y + v.y; o.z = ALPHA * x.z + v.z; o.w = ALPHA * x.w + v.w;
    *(float4*)(dst + (size_t)row * 1024 + col) = o;
    if (do_stats) {
      float ss = o.x + o.y + o.z + o.w, qq = o.x * o.x + o.y * o.y + o.z * o.z + o.w * o.w;
#pragma unroll
      for (int sh = 1; sh < 32; sh <<= 1) { ss += __shfl_xor(ss, sh); qq += __shfl_xor(qq, sh); }
      if (ch == 0) { atomicAdd(stats_out + row * 2, ss); atomicAdd(stats_out + row * 2 + 1, qq); }
    }
  }
}

__device__ __forceinline__ void p3c_item(const Params& p, char* smem, int l, int item, bool do_stats = true) {
  const int mt = item & 63, nt = item >> 6;
  const int m0 = mt * 128, n0 = nt * 128;
  const int tid = ltid(), lane = tid & 63, wave = tid >> 6, wm = wave >> 1, wn = wave & 1;
  f16v acc[2][2];
  gemm_mainloop0(smem, WS_merged, 1024, WS_Wt + WT_LAYER * l + WT_O, 1024, 1024, m0, n0, acc);
  const int ci = cond_of_row(m0);
  const float* g1 = WS_mod + (l * 5 + ci) * 6144 + 2048;
  float* st1 = WS_stats + (size_t)(l * 2 + 0) * TALL * 2;
  if (l == 0)
    epi_resid(smem, acc, m0, n0, g1, p.x_prompt, p.x_sample, nullptr, nullptr, nullptr, WS_pre1, st1, do_stats);
  else
    epi_resid(smem, acc, m0, n0, g1, p.out, p.out + (size_t)TCTX * 1024, WS_stats + (size_t)(0 * 2 + 1) * TALL * 2, p.ln2_g, p.ln2_b,
              WS_pre1, st1, do_stats);
}

__device__ __forceinline__ void p4_item(const Params& p, char* smem, int l, int item) {
  const int mt = item & 63, nt = item >> 6;
  const int m0 = mt * 128, n0 = nt * 128;
  const int tid = ltid(), lane = tid & 63, wave = tid >> 6, wm = wave >> 1, wn = wave & 1;
  f16v acc[2][2];
  gemm_mainloop0(smem, WS_h2, 1024, WS_Wt + WT_LAYER * l + WT_UP, 1024, 1024, m0, n0, acc);
  u16* Cs = (u16*)smem;
  const int rl0 = wm * 64 + 4 * (lane >> 5), cl0 = wn * 64 + (lane & 31);
#pragma unroll
  for (int mi = 0; mi < 2; ++mi)
#pragma unroll
    for (int reg = 0; reg < 16; ++reg) {
      const int rl = rl0 + mi * 32 + (reg & 3) + 8 * (reg >> 2);
      Cs[rl * CST + cl0] = f2bf(acc[mi][0][reg]);
      Cs[rl * CST + cl0 + 32] = f2bf(acc[mi][1][reg]);
    }
  __syncthreads();
  cs_store(Cs, WS_z2 + (size_t)m0 * 5632 + n0, 5632, tid);
}

__device__ __forceinline__ void p4b_item(const Params& p, int l, int item) {
  const int tid = ltid();
  if (tid >= 176) return;
  const int rb = item >> 1, hf = item & 1;
  const int j0 = (hf * 176 + tid) * 8;
  const float* cw = p.conv_w + (size_t)l * 3 * 5632;
  const float* cb = p.conv_b + (size_t)l * 5632;
  float wa[3][8], wb[3][8], ba[8], bb[8];
#pragma unroll
  for (int t = 0; t < 3; ++t)
#pragma unroll
    for (int h = 0; h < 2; ++h) {
      const float4 x = *(const float4*)(cw + t * 5632 + j0 + 4 * h), y = *(const float4*)(cw + t * 5632 + 2816 + j0 + 4 * h);
      wa[t][4 * h] = x.x; wa[t][4 * h + 1] = x.y; wa[t][4 * h + 2] = x.z; wa[t][4 * h + 3] = x.w;
      wb[t][4 * h] = y.x; wb[t][4 * h + 1] = y.y; wb[t][4 * h + 2] = y.z; wb[t][4 * h + 3] = y.w;
    }
#pragma unroll
  for (int h = 0; h < 2; ++h) {
    const float4 x = *(const float4*)(cb + j0 + 4 * h), y = *(const float4*)(cb + 2816 + j0 + 4 * h);
    ba[4 * h] = x.x; ba[4 * h + 1] = x.y; ba[4 * h + 2] = x.z; ba[4 * h + 3] = x.w;
    bb[4 * h] = y.x; bb[4 * h + 1] = y.y; bb[4 * h + 2] = y.z; bb[4 * h + 3] = y.w;
  }
  const int row0 = rb * 32;
  int pos0, L;
  if (row0 < TCTX) { pos0 = row0 & 255; L = 256; } else { pos0 = (row0 - TCTX) & 1023; L = 1024; }
  const u16* zr = WS_z2 + (size_t)row0 * 5632 + j0;
  const u4v zero = (u4v){0u, 0u, 0u, 0u};
  u4v pa = zero, pb = zero;
  if (pos0 > 0) { pa = *(const u4v*)(zr - 5632); pb = *(const u4v*)(zr - 5632 + 2816); }
  u4v ca = *(const u4v*)(zr), cb2 = *(const u4v*)(zr + 2816);
#pragma unroll 2
  for (int r = 0; r < 32; ++r) {
    u4v na = zero, nb = zero;
    if (pos0 + r < L - 1) { na = *(const u4v*)(zr + (size_t)(r + 1) * 5632); nb = *(const u4v*)(zr + (size_t)(r + 1) * 5632 + 2816); }
    u4v ov;
#pragma unroll
    for (int w = 0; w < 4; ++w) {
      const float a0 = wa[0][2 * w] * bflo(pa[w]) + wa[1][2 * w] * bflo(ca[w]) + wa[2][2 * w] * bflo(na[w]) + ba[2 * w];
      const float a1 = wa[0][2 * w + 1] * bfhi(pa[w]) + wa[1][2 * w + 1] * bfhi(ca[w]) + wa[2][2 * w + 1] * bfhi(na[w]) + ba[2 * w + 1];
      const float b0 = wb[0][2 * w] * bflo(pb[w]) + wb[1][2 * w] * bflo(cb2[w]) + wb[2][2 * w] * bflo(nb[w]) + bb[2 * w];
      const float b1 = wb[0][2 * w + 1] * bfhi(pb[w]) + wb[1][2 * w + 1] * bfhi(cb2[w]) + wb[2][2 * w + 1] * bfhi(nb[w]) + bb[2 * w + 1];
      ov[w] = pack2(geluf_(a0) * b0, geluf_(a1) * b1);
    }
    *(u4v*)(WS_act + (size_t)(row0 + r) * 2816 + j0) = ov;
    pa = ca; pb = cb2; ca = na; cb2 = nb;
  }
}

__device__ __forceinline__ void p5_item(const Params& p, char* smem, int l, int item, bool do_stats = true) {
  const int mt = item & 63, nt = item >> 6;
  const int m0 = mt * 128, n0 = nt * 128;
  const int tid = ltid(), lane = tid & 63, wave = tid >> 6, wm = wave >> 1, wn = wave & 1;
  f16v acc[2][2];
  gemm_mainloop0(smem, WS_act, 2816, WS_Wt + WT_LAYER * l + WT_DOWN, 2816, 2816, m0, n0, acc);
  const int ci = cond_of_row(m0);
  const float* g2 = WS_mod + (l * 5 + ci) * 6144 + 5 * 1024;
  epi_resid(smem, acc, m0, n0, g2, WS_pre1, WS_pre1 + (size_t)TCTX * 1024, WS_stats + (size_t)(l * 2 + 0) * TALL * 2,
            p.ln1_g + l * 1024, p.ln1_b + l * 1024, p.out, WS_stats + (size_t)(l * 2 + 1) * TALL * 2, do_stats);
}

__device__ __forceinline__ void final_item(const Params& p, int item) {
  const float* st = WS_stats + (size_t)(1 * 2 + 1) * TALL * 2;
  const int c = ltid() * 4;
  const float4 g = *(const float4*)(p.ln2_g + 1024 + c);
  const float4 b = *(const float4*)(p.ln2_b + 1024 + c);
  for (int r = 0; r < 8; ++r) {
    const int row = item * 8 + r;
    const float s = st[row * 2], q = st[row * 2 + 1];
    const float mu = s * (1.f / 1024.f);
    const float rstd = rsqrtf(fmaxf(q * (1.f / 1024.f) - mu * mu, 0.f) + LNEPS);
    float4 v = *(float4*)(p.out + (size_t)row * 1024 + c);
    v.x = (v.x - mu) * rstd * g.x + b.x;
    v.y = (v.y - mu) * rstd * g.y + b.y;
    v.z = (v.z - mu) * rstd * g.z + b.z;
    v.w = (v.w - mu) * rstd * g.w + b.w;
    *(float4*)(p.out + (size_t)row * 1024 + c) = v;
  }
}

#define XB_TMO      128
#define XB_XCNT(j)  (256  + 64 * (j))
#define XB_XSUB(j)  (1280 + 64 * (j))
#define XB_XGEN(j)  (2304 + 64 * (j))
#define XB_TOP      3328
#define XB_TOPGEN   3392
#define XCD_BAR_WORDS 3456
#define XB_SPIN_CAP (1u << 18)
#define LAS __attribute__((address_space(3)))

__device__ __forceinline__ unsigned xb_ld(unsigned* p)              { return __hip_atomic_load(p, __ATOMIC_RELAXED, __HIP_MEMORY_SCOPE_AGENT); }
__device__ __forceinline__ unsigned xb_add(unsigned* p, unsigned v) { return __hip_atomic_fetch_add(p, v, __ATOMIC_RELAXED, __HIP_MEMORY_SCOPE_AGENT); }
__device__ __forceinline__ unsigned xb_xcc_id() { return (unsigned)__builtin_amdgcn_s_getreg((3 << 11) | 20) & 0xFu; }
#define XB_SPIN(cond, bar) do { unsigned _sp = 0; while (cond) { __builtin_amdgcn_s_sleep(1); \
    if ((++_sp & 255u) == 0u) { if (xb_ld(&(bar)[XB_TMO])) break; if (_sp > XB_SPIN_CAP) { atomicAdd(&(bar)[XB_TMO], 1u); break; } } } } while (0)

struct XcdBarrier {
    unsigned* bar; unsigned x;
    volatile LAS unsigned* st;
};

__device__ __forceinline__ XcdBarrier xcd_barrier_post(unsigned* bar, volatile LAS unsigned* st) {
    XcdBarrier b; b.bar = bar; b.x = xb_xcc_id(); b.st = st;
    if (threadIdx.x == 0) (void)xb_add(&bar[XB_XCNT(b.x)], 1u);
    return b;
}
__device__ __forceinline__ void xcd_barrier_complete(unsigned* bar, unsigned x, unsigned& nloc, unsigned& nx) {
    const unsigned G = gridDim.x * gridDim.y * gridDim.z;
    unsigned sum, cnt, mine, sp = 0u;
    for (;;) {
        sum = 0u; cnt = 0u; mine = 0u;
#pragma unroll
        for (unsigned j = 0; j < 16; ++j) { const unsigned c = xb_ld(&bar[XB_XCNT(j)]); sum += c; cnt += (c > 0u) ? 1u : 0u; mine = (j == x) ? c : mine; }
        if (sum == G) break;
        __builtin_amdgcn_s_sleep(1);
        if ((++sp & 255u) == 0u) { if (xb_ld(&bar[XB_TMO])) break; if (sp > XB_SPIN_CAP) { atomicAdd(&bar[XB_TMO], 1u); break; } }
    }
    nloc = mine > 0u ? mine : 1u; nx = cnt > 0u ? cnt : 1u;
}

__device__ __forceinline__ void xcd_barrier(const XcdBarrier& b) {
    asm volatile("s_waitcnt vmcnt(0)" ::: "memory");
    __syncthreads();
    if (threadIdx.x == 0) {
        unsigned* bar = b.bar;
        __builtin_amdgcn_s_waitcnt(0);
        unsigned nloc = b.st[0], nx = b.st[1];
        if (nloc == 0u) { xcd_barrier_complete(bar, b.x, nloc, nx); b.st[0] = nloc; b.st[1] = nx; }
        const unsigned old = xb_add(&bar[XB_XSUB(b.x)], 1u);
        const unsigned gen = old / nloc;
        if (old + 1u == (gen + 1u) * nloc) {
            __builtin_amdgcn_fence(__ATOMIC_RELEASE, "agent");
            asm volatile("s_waitcnt vmcnt(0)" ::: "memory");
            const unsigned og = xb_add(&bar[XB_TOP], 1u);
            const unsigned tg = og / nx;
            if (og + 1u == (tg + 1u) * nx) xb_add(&bar[XB_TOPGEN], 1u);
            else XB_SPIN(xb_ld(&bar[XB_TOPGEN]) == tg, bar);
            __builtin_amdgcn_fence(__ATOMIC_ACQUIRE, "agent");
            xb_add(&bar[XB_XGEN(b.x)], 1u);
            asm volatile("s_waitcnt vmcnt(0)" ::: "memory");
        } else {
            XB_SPIN(xb_ld(&bar[XB_XGEN(b.x)]) == gen, bar);
            __builtin_amdgcn_fence(__ATOMIC_ACQUIRE, "agent");
            asm volatile("s_waitcnt vmcnt(0)" ::: "memory");
        }
    }
    __syncthreads();
}


#define NPHASES 22
#ifndef REPMASK
#define REPMASK 0
#endif
#define REPS(PH) (((PH) == 0 ? (REPMASK >> 10) : (PH) == 21 ? (REPMASK >> 11) : (REPMASK >> (((PH) - 1) % 10))) & 1)
#define RUN_PHASE(PH, N, CALL)                                              \
  if (ph_lo <= (PH) && (PH) < ph_hi) {                                      \
    for (int rep_ = 0; rep_ <= REPS(PH); ++rep_)                            \
    for (int it = blockIdx.x; it < (N); it += nb) { CALL; }                 \
    if ((PH) + 1 < ph_hi) xcd_barrier(xb);                                  \
  }
#define RUN_GEMM_PHASE(PH, NT, CALL)                                                          \
  if (ph_lo <= (PH) && (PH) < ph_hi) {                                                        \
    const int xcd_ = blockIdx.x & 7, slot_ = blockIdx.x >> 3, spx_ = (int)gridDim.x >> 3;      \
    const int nsuper_ = 8 * (((NT) + 7) >> 3);                                                \
    for (int rep_ = 0; rep_ <= REPS(PH); ++rep_)                                              \
    for (int s_ = xcd_; s_ < nsuper_; s_ += 8)                                                \
      for (int j_ = slot_; j_ < 64; j_ += spx_) {                                             \
        const int mt_ = (s_ & 7) * 8 + (j_ & 7), nt_ = (s_ >> 3) * 8 + (j_ >> 3);             \
        if (nt_ < (NT)) { const int it = nt_ * 64 + mt_; CALL; }                              \
      }                                                                                       \
    if ((PH) + 1 < ph_hi) xcd_barrier(xb);                                                    \
  }
#define RUN_MIXER_PHASE(PH, L)                                                                \
  if (ph_lo <= (PH) && (PH) < ph_hi) {                                                        \
    for (int rep_ = 0; rep_ <= REPS(PH); ++rep_) {                                            \
      unsigned* ctr_ = (unsigned*)(p.ws + OFF_ctr) + 64 * (2 * (L) + rep_);                   \
      for (;;) {                                                                              \
        __syncthreads();                                                                      \
        if (threadIdx.x == 0) wq_item = (int)atomicAdd(ctr_, 1u);                             \
        __syncthreads();                                                                      \
        const int it = wq_item;                                                               \
        if (it >= MX_ITEMS) break;                                                            \
        mixer_item(p, smem, (L), it);                                                         \
      }                                                                                       \
    }                                                                                         \
    if ((PH) + 1 < ph_hi) xcd_barrier(xb);                                                    \
  }
#define RUN_LAYER(L)                                                         \
  RUN_PHASE(1 + 10 * (L) + 0, 1024, hmat_item(p, (L), 0, it))                \
  RUN_GEMM_PHASE(1 + 10 * (L) + 1, 56, p1_item(p, smem, (L), it))            \
  RUN_MIXER_PHASE(1 + 10 * (L) + 2, (L))                                     \
  RUN_GEMM_PHASE(1 + 10 * (L) + 3, 4, p3a_item(p, smem, (L), it))            \
  RUN_GEMM_PHASE(1 + 10 * (L) + 4, 8, p3b_item(p, smem, (L), it))            \
  RUN_GEMM_PHASE(1 + 10 * (L) + 5, 8, p3c_item(p, smem, (L), it, rep_ == 0)) \
  RUN_PHASE(1 + 10 * (L) + 6, 1024, hmat_item(p, (L), 1, it))                \
  RUN_GEMM_PHASE(1 + 10 * (L) + 7, 44, p4_item(p, smem, (L), it))            \
  RUN_PHASE(1 + 10 * (L) + 8, 512, p4b_item(p, (L), it))                     \
  RUN_GEMM_PHASE(1 + 10 * (L) + 9, 8, p5_item(p, smem, (L), it, rep_ == 0))

__global__ void __launch_bounds__(256, 2) mega(Params p, int ph_lo, int ph_hi) {
  extern __shared__ __attribute__((aligned(16))) char smem[];
  __shared__ uint4 xb_words;
  __shared__ int wq_item;
  const int nb = gridDim.x;
  if (threadIdx.x == 0) xb_words = make_uint4(0u, 0u, 0u, 0u);
  __syncthreads();
  XcdBarrier xb;
  xb.bar = (unsigned*)(p.ws + OFF_bar); xb.x = 0; xb.st = (volatile LAS unsigned*)&xb_words;
  if (ph_hi - ph_lo > 1) xb = xcd_barrier_post((unsigned*)(p.ws + OFF_bar), (volatile LAS unsigned*)&xb_words);
  if (ph_hi > 1000) cg::this_grid().sync();
  RUN_PHASE(0, P0_ITEMS, phase0_item(p, smem, it))
  RUN_LAYER(0)
  RUN_LAYER(1)
  RUN_PHASE(21, 1024, final_item(p, it))
}

extern "C" void kernel_launch(void* const* d_in, const int* in_sizes, int n_in, void* d_out, int out_size, void* d_ws,
                              size_t ws_size, hipStream_t stream) {
  Params p{};
  const float** ins = (const float**)&p;
  for (int i = 0; i < 32; ++i) ins[i] = (const float*)d_in[i];
  p.out = (float*)d_out;
  char* ws = (char*)d_ws;
  p.ws = ws;
  if (WS_TOTAL > ws_size) {
    fprintf(stderr, "kernel_launch: workspace too small (%zu needed, %zu given)\n", (size_t)WS_TOTAL, ws_size);
    return;
  }
  (void)hipMemsetAsync(ws, 0, ZERO_BYTES, stream);
#if SINGLE_LAUNCH
  static int grid_blocks = 0;
  if (!grid_blocks) {
    int dev = 0, cus = 0, per_cu = 0;
    (void)hipGetDevice(&dev);
    (void)hipDeviceGetAttribute(&cus, hipDeviceAttributeMultiprocessorCount, dev);
    (void)hipFuncSetAttribute((const void*)mega, hipFuncAttributeMaxDynamicSharedMemorySize, LDS_BYTES);
    (void)hipOccupancyMaxActiveBlocksPerMultiprocessor(&per_cu, mega, 256, LDS_BYTES);
    if (per_cu > 2) per_cu = 2;
    if (per_cu < 1) per_cu = 1;
    grid_blocks = (cus * per_cu) & ~7;
  }
  int lo = 0, hi = NPHASES;
  void* args[] = {&p, &lo, &hi};
  hipError_t e = hipLaunchCooperativeKernel((void*)mega, dim3(grid_blocks), dim3(256), args, LDS_BYTES, stream);
  if (e != hipSuccess) fprintf(stderr, "cooperative launch failed: %s (grid %d)\n", hipGetErrorString(e), grid_blocks);
#else
  for (int ph = 0; ph < NPHASES; ++ph) {
    hipLaunchKernelGGL(mega, dim3(512), dim3(256), LDS_BYTES, stream, p, ph, ph + 1);
  }
#endif
}
```

```cpp
#include <hip/hip_runtime.h>
#include <hip/hip_cooperative_groups.h>
#include <cstdio>
namespace cg = cooperative_groups;

#ifndef SINGLE_LAUNCH
#define SINGLE_LAUNCH 1
#endif

typedef __attribute__((ext_vector_type(8))) short s8v;
typedef __attribute__((ext_vector_type(4))) float f4v;
typedef __attribute__((ext_vector_type(16))) float f16v;
typedef unsigned short u16;
typedef __attribute__((ext_vector_type(4))) unsigned u4v;
__device__ __forceinline__ s8v bc8(u4v x) { return __builtin_bit_cast(s8v, x); }


#define TALL 8192
#define TCTX 4096
#define ALPHA 1.41421356237309515f
#define LNEPS 1e-5f
#define VTR_LAT 2097152
#define NVT_LAT 2097152
#define OUT_SRET 8388608
#define OUT_SSSM 12582912
#define OUT_CK 12845056
#define OUT_CV 17039360
#define WT_IN 0
#define WT_GLU (WT_IN + 7168 * 1024)
#define WT_BR (WT_GLU + 512 * 512)
#define WT_O (WT_BR + 3 * 1024 * 512)
#define WT_UP (WT_O + 1024 * 1024)
#define WT_DOWN (WT_UP + 5632 * 1024)
#define WT_LAYER ((size_t)(WT_DOWN + 1024 * 2816))

struct Params {
  const float *x_prompt, *x_sample, *state_ret, *state_ssm, *cache_k, *cache_v, *c, *c_ctx;
  const float *w_ada, *b_ada, *w_in, *ret_decay, *a_re, *a_im, *log_dt, *b_re, *b_im, *c_re, *c_im;
  const float *ssm_d, *w_glu, *rpb, *w_branch, *w_o, *ln1_g, *ln1_b, *w_up, *conv_w, *conv_b, *w_down, *ln2_g, *ln2_b;
  float* out;
  char* ws;
};

typedef __bf16 bf2v __attribute__((ext_vector_type(2)));
typedef float fl2v __attribute__((ext_vector_type(2)));
__device__ __forceinline__ unsigned pack2(float a, float b) {
  fl2v f = {a, b};
  bf2v h = __builtin_convertvector(f, bf2v);
  return __builtin_bit_cast(unsigned, h);
}
__device__ __forceinline__ u16 f2bf(float f) { return (u16)(pack2(f, 0.f) & 0xffffu); }

constexpr size_t al256(size_t x) { return (x + 255) & ~(size_t)255; }
constexpr size_t EB = (size_t)TALL * 512 * 2;
constexpr size_t OFF_mod = 0;
constexpr size_t OFF_stats = OFF_mod + al256(2 * 5 * 6144 * 4);
constexpr size_t OFF_bar = OFF_stats + al256(2 * 2 * TALL * 2 * 4);
constexpr size_t OFF_ctr = OFF_bar + al256(3456 * 4);
constexpr size_t ZERO_BYTES = OFF_ctr + al256(8 * 256);
constexpr size_t OFF_ropetab = ZERO_BYTES;
constexpr size_t OFF_abar = OFF_ropetab + al256(64 * 32 * 2 * 4);
constexpr size_t OFF_bbarT = OFF_abar + al256(2 * 2 * 32 * 64 * 2 * 4);
constexpr size_t OFF_cmT = OFF_bbarT + al256(2 * 2 * 32 * 128 * 16 * 2);
constexpr size_t OFF_CK = OFF_cmT + al256(2 * 2 * 32 * 16 * 128 * 2);
constexpr size_t OFF_CVt = OFF_CK + al256((size_t)2 * 4 * 512 * 512 * 2);
constexpr size_t OFF_S0t = OFF_CVt + al256((size_t)2 * 4 * 512 * 512 * 2);
constexpr size_t OFF_Wt = OFF_S0t + al256((size_t)2 * 4 * 2 * 4 * 128 * 128 * 2);
constexpr size_t OFF_REGION = OFF_Wt + al256(2 * WT_LAYER * 2);
constexpr size_t OFF_z2 = OFF_REGION;
constexpr size_t OFF_act = OFF_z2 + (size_t)TALL * 5632 * 2;
constexpr size_t OFF_pre1 = OFF_act + (size_t)TALL * 2816 * 2;
constexpr size_t WS_TOTAL = OFF_pre1 + (size_t)TALL * 1024 * 4;
constexpr size_t OFF_K = OFF_pre1;
constexpr size_t OFF_VtR = OFF_K + EB;
constexpr size_t OFF_NQ = OFF_VtR + EB;
constexpr size_t OFF_NK = OFF_NQ + EB;
constexpr size_t OFF_GT = OFF_REGION;
constexpr size_t OFF_rout = OFF_GT + (size_t)TALL * 3072 * 2;
constexpr size_t OFF_nout = OFF_rout + EB;
constexpr size_t OFF_YD = OFF_nout + EB;
constexpr size_t OFF_merged = OFF_YD;
constexpr size_t OFF_Q = OFF_YD + 2 * EB;
constexpr size_t OFF_sout = OFF_Q;
constexpr size_t OFF_KtR = OFF_Q + EB;
constexpr size_t OFF_G = OFF_KtR + EB / 2;
constexpr size_t OFF_SU = OFF_G + EB;
constexpr size_t OFF_NVt = OFF_SU + EB;
constexpr size_t OFF_h1 = OFF_NVt + EB;
constexpr size_t OFF_h2 = OFF_act;
static_assert(OFF_h1 + 2 * EB <= OFF_pre1, "mixer buffers overflow the z2+act area");
#define WS_h1 ((u16*)(p.ws + OFF_h1))
#define WS_h2 ((u16*)(p.ws + OFF_h2))
#define WS_mod ((float*)(p.ws + OFF_mod))
#define WS_stats ((float*)(p.ws + OFF_stats))
#define WS_ropetab ((float*)(p.ws + OFF_ropetab))
#define WS_abar ((float*)(p.ws + OFF_abar))
#define WS_pre1 ((float*)(p.ws + OFF_pre1))
#define WS_bbarT ((u16*)(p.ws + OFF_bbarT))
#define WS_cmT ((u16*)(p.ws + OFF_cmT))
#define WS_CK ((u16*)(p.ws + OFF_CK))
#define WS_CVt ((u16*)(p.ws + OFF_CVt))
#define WS_S0t ((u16*)(p.ws + OFF_S0t))
#define WS_Wt ((u16*)(p.ws + OFF_Wt))
#define WS_Q ((u16*)(p.ws + OFF_Q))
#define WS_K ((u16*)(p.ws + OFF_K))
#define WS_VtR ((u16*)(p.ws + OFF_VtR))
#define WS_KtR ((u16*)(p.ws + OFF_KtR))
#define WS_G ((u16*)(p.ws + OFF_G))
#define WS_SU ((u16*)(p.ws + OFF_SU))
#define WS_NQ ((u16*)(p.ws + OFF_NQ))
#define WS_NK ((u16*)(p.ws + OFF_NK))
#define WS_NVt ((u16*)(p.ws + OFF_NVt))
#define WS_GT ((u16*)(p.ws + OFF_GT))
#define WS_rout ((u16*)(p.ws + OFF_rout))
#define WS_sout ((u16*)(p.ws + OFF_sout))
#define WS_nout ((u16*)(p.ws + OFF_nout))
#define WS_YD ((u16*)(p.ws + OFF_YD))
#define WS_merged ((u16*)(p.ws + OFF_merged))
#define WS_z2 ((u16*)(p.ws + OFF_z2))
#define WS_act ((u16*)(p.ws + OFF_act))

__device__ __forceinline__ float bf2f(unsigned h) { return __uint_as_float((h & 0xffffu) << 16); }
__device__ __forceinline__ float bflo(unsigned w) { return __uint_as_float(w << 16); }
__device__ __forceinline__ float bfhi(unsigned w) { return __uint_as_float(w & 0xffff0000u); }
__device__ __forceinline__ float sigmoidf_(float x) { return 1.f / (1.f + __expf(-x)); }
__device__ __forceinline__ float siluf_(float x) { return x / (1.f + __expf(-x)); }
__device__ __forceinline__ float geluf_(float x) {
  float u = 0.7978845608028654f * (x + 0.044715f * x * x * x);
  float e = __expf(2.f * u);
  float t = 1.f - 2.f / (e + 1.f);
  return 0.5f * x * (1.f + t);
}
__device__ __forceinline__ f16v zero16() {
  return (f16v){0.f, 0.f, 0.f, 0.f, 0.f, 0.f, 0.f, 0.f, 0.f, 0.f, 0.f, 0.f, 0.f, 0.f, 0.f, 0.f};
}
__device__ __forceinline__ int ltid() { int t = threadIdx.x; asm volatile("" : "+v"(t)); return t; }
__device__ __forceinline__ int cond_of_row(int row) { return row < TCTX ? 0 : 1 + ((row - TCTX) >> 10); }

struct AArgs {
  const u16* A16; int lda;
  const float* A32lo; const float* A32hi;
  const float* stats;
  const float* lng; const float* lnb;
  const float* sc; const float* sh;
  const u16* SU; const u16* YD0; const u16* YD1; const float* dsk;
};

#define GST 72
#define LDS_GEMM (2 * 2 * 128 * GST * 2)
#define LDS_BYTES LDS_GEMM

template <int AMODE>
__device__ __forceinline__ void gemm_mainloop(char* smem, const AArgs& a, const u16* __restrict__ Bt, int ldb, int K,
                                              int m0, int n0, f16v (&acc)[2][2]) {
  u16* As = (u16*)smem;
  u16* Bs = As + 2 * 128 * GST;
  const int tid = ltid(), lane = tid & 63, wave = tid >> 6;
  const int wm = wave >> 1, wn = wave & 1;
  const int crow = tid >> 3, cch = tid & 7;
  const int frow = tid >> 4, fch = tid & 15;
  float rs[8], nm[8];
  const float* srow0 = nullptr;
  const float *gsc = nullptr, *gsh = nullptr;
  __syncthreads();
  if constexpr (AMODE == 1) {
    const int ci = cond_of_row(m0);
    gsc = a.sc + ci * 6144; gsh = a.sh + ci * 6144;
#pragma unroll
    for (int i = 0; i < 8; ++i) {
      rs[i] = 1.f; nm[i] = 0.f;
      if (a.stats) {
        const int row = m0 + frow + 16 * i;
        const float s = a.stats[row * 2], q = a.stats[row * 2 + 1];
        const float mu = s * (1.f / 1024.f);
        const float var = q * (1.f / 1024.f) - mu * mu;
        rs[i] = rsqrtf(fmaxf(var, 0.f) + LNEPS);
        nm[i] = -mu * rs[i];
      }
    }
    const int row0 = m0 + frow;
    srow0 = (row0 < TCTX ? a.A32lo + (size_t)row0 * 1024 : a.A32hi + (size_t)(row0 - TCTX) * 1024) + fch * 4;
  }
  acc[0][0] = zero16(); acc[0][1] = zero16(); acc[1][0] = zero16(); acc[1][1] = zero16();

  u4v ra[12], rb[4];
  float4 q0, q1, q2, q3;
  q0 = q1 = q3 = make_float4(0.f, 0.f, 0.f, 0.f); q2 = make_float4(1.f, 1.f, 1.f, 1.f);
  const u16* brow = Bt + (size_t)(n0 + crow) * ldb + cch * 8;
  auto issue = [&](int kt) {
    if constexpr (AMODE == 1) {
      const int k = kt * 64 + fch * 4;
      q0 = *(const float4*)(gsc + k); q1 = *(const float4*)(gsh + k);
      if (a.lng) { q2 = *(const float4*)(a.lng + k); q3 = *(const float4*)(a.lnb + k); }
    } else if constexpr (AMODE == 2) {
      const int k0 = kt * 64 + cch * 8;
      q0 = *(const float4*)(a.dsk + k0); q1 = *(const float4*)(a.dsk + k0 + 4);
    }
    if constexpr (AMODE == 0) {
      const u16* ap = a.A16 + (size_t)(m0 + crow) * a.lda + kt * 64 + cch * 8;
#pragma unroll
      for (int i = 0; i < 4; ++i) ra[i] = *(const u4v*)(ap + (size_t)(32 * i) * a.lda);
    } else if constexpr (AMODE == 1) {
#pragma unroll
      for (int i = 0; i < 8; ++i) ra[i] = *(const u4v*)(srow0 + (size_t)(16 * i) * 1024 + kt * 64);
    } else {
      const size_t o = (size_t)(m0 + crow) * 512 + kt * 64 + cch * 8;
#pragma unroll
      for (int i = 0; i < 4; ++i) {
        ra[i] = *(const u4v*)(a.SU + o + (size_t)(32 * i) * 512);
        ra[4 + i] = *(const u4v*)(a.YD0 + o + (size_t)(32 * i) * 512);
        ra[8 + i] = *(const u4v*)(a.YD1 + o + (size_t)(32 * i) * 512);
      }
    }
#pragma unroll
    for (int i = 0; i < 4; ++i) rb[i] = *(const u4v*)(brow + (size_t)(32 * i) * ldb + kt * 64);
  };
  auto stage = [&](int buf, int kt) {
    u16* Ad = As + buf * (128 * GST);
    if constexpr (AMODE == 0) {
#pragma unroll
      for (int i = 0; i < 4; ++i) *(u4v*)(Ad + (crow + 32 * i) * GST + cch * 8) = ra[i];
    } else if constexpr (AMODE == 1) {
      const float4 sc = q0, sh = q1, g = q2, b = q3;
      const float G0 = g.x * (1.f + sc.x), G1 = g.y * (1.f + sc.y), G2 = g.z * (1.f + sc.z), G3 = g.w * (1.f + sc.w);
      const float B0 = fmaf(b.x, 1.f + sc.x, sh.x), B1 = fmaf(b.y, 1.f + sc.y, sh.y), B2 = fmaf(b.z, 1.f + sc.z, sh.z), B3 = fmaf(b.w, 1.f + sc.w, sh.w);
#pragma unroll
      for (int i = 0; i < 8; ++i) {
        const float h0 = fmaf(fmaf(__uint_as_float(ra[i][0]), rs[i], nm[i]), G0, B0);
        const float h1 = fmaf(fmaf(__uint_as_float(ra[i][1]), rs[i], nm[i]), G1, B1);
        const float h2 = fmaf(fmaf(__uint_as_float(ra[i][2]), rs[i], nm[i]), G2, B2);
        const float h3 = fmaf(fmaf(__uint_as_float(ra[i][3]), rs[i], nm[i]), G3, B3);
        *(uint2*)(Ad + (frow + 16 * i) * GST + fch * 4) = make_uint2(pack2(h0, h1), pack2(h2, h3));
      }
    } else {
      const float4 da = q0, db = q1;
      const float dd[8] = {da.x, da.y, da.z, da.w, db.x, db.y, db.z, db.w};
#pragma unroll
      for (int i = 0; i < 4; ++i) {
        u4v o;
#pragma unroll
        for (int j = 0; j < 4; ++j) {
          const float v0 = geluf_(dd[2 * j] * bflo(ra[i][j]) + bflo(ra[4 + i][j]) + bflo(ra[8 + i][j]));
          const float v1 = geluf_(dd[2 * j + 1] * bfhi(ra[i][j]) + bfhi(ra[4 + i][j]) + bfhi(ra[8 + i][j]));
          o[j] = pack2(v0, v1);
        }
        *(u4v*)(Ad + (crow + 32 * i) * GST + cch * 8) = o;
      }
    }
    u16* Bd = Bs + buf * (128 * GST);
#pragma unroll
    for (int i = 0; i < 4; ++i) *(u4v*)(Bd + (crow + 32 * i) * GST + cch * 8) = rb[i];
  };
  auto compute = [&](int buf) {
    const u16* Ab = As + buf * (128 * GST) + (wm * 64 + (lane & 31)) * GST + (lane >> 5) * 8;
    const u16* Bb = Bs + buf * (128 * GST) + (wn * 64 + (lane & 31)) * GST + (lane >> 5) * 8;
#pragma unroll
    for (int ks = 0; ks < 4; ++ks) {
      s8v af0 = *(const s8v*)(Ab + ks * 16);
      s8v af1 = *(const s8v*)(Ab + 32 * GST + ks * 16);
      s8v bf0 = *(const s8v*)(Bb + ks * 16);
      s8v bf1 = *(const s8v*)(Bb + 32 * GST + ks * 16);
      acc[0][0] = __builtin_amdgcn_mfma_f32_32x32x16_bf16(af0, bf0, acc[0][0], 0, 0, 0);
      acc[0][1] = __builtin_amdgcn_mfma_f32_32x32x16_bf16(af0, bf1, acc[0][1], 0, 0, 0);
      acc[1][0] = __builtin_amdgcn_mfma_f32_32x32x16_bf16(af1, bf0, acc[1][0], 0, 0, 0);
      acc[1][1] = __builtin_amdgcn_mfma_f32_32x32x16_bf16(af1, bf1, acc[1][1], 0, 0, 0);
    }
  };

  const int nk = K >> 6;
  issue(0);
  stage(0, 0);
  __syncthreads();
#pragma unroll 1
  for (int kt = 0; kt < nk; ++kt) {
    const int buf = kt & 1;
    if (kt + 1 < nk) issue(kt + 1);
    compute(buf);
    if (kt + 1 < nk) stage(buf ^ 1, kt + 1);
    __syncthreads();
  }
}

__device__ __forceinline__ void gemm_mainloop0(char* smem, const u16* __restrict__ A, int lda, const u16* __restrict__ Bt, int ldb,
                                               int K, int m0, int n0, f16v (&acc)[2][2]) {
  u16* As = (u16*)smem;
  u16* Bs = As + 2 * 128 * GST;
  const int tid = ltid(), lane = tid & 63, wave = tid >> 6;
  const int wm = wave >> 1, wn = wave & 1;
  const int crow = tid >> 3, cch = tid & 7;
  __syncthreads();
  acc[0][0] = zero16(); acc[0][1] = zero16(); acc[1][0] = zero16(); acc[1][1] = zero16();
  const u16* arow = A + (size_t)(m0 + crow) * lda + cch * 8;
  const u16* brow = Bt + (size_t)(n0 + crow) * ldb + cch * 8;
  const size_t a32 = (size_t)32 * lda, b32 = (size_t)32 * ldb;
  u4v eA0, eA1, eA2, eA3, eB0, eB1, eB2, eB3, oA0, oA1, oA2, oA3, oB0, oB1, oB2, oB3;
#define G0_ISSUE(P, kt)                                                                                   \
  { const u16* ap_ = arow + (kt) * 64; const u16* bp_ = brow + (kt) * 64;                                 \
    P##A0 = *(const u4v*)(ap_); P##A1 = *(const u4v*)(ap_ + a32); P##A2 = *(const u4v*)(ap_ + 2 * a32);   \
    P##A3 = *(const u4v*)(ap_ + 3 * a32);                                                                 \
    P##B0 = *(const u4v*)(bp_); P##B1 = *(const u4v*)(bp_ + b32); P##B2 = *(const u4v*)(bp_ + 2 * b32);   \
    P##B3 = *(const u4v*)(bp_ + 3 * b32); }
#define G0_STAGE(P, buf)                                                                                  \
  { u16* Ad_ = As + (buf) * (128 * GST) + crow * GST + cch * 8; u16* Bd_ = Bs + (buf) * (128 * GST) + crow * GST + cch * 8; \
    *(u4v*)(Ad_) = P##A0; *(u4v*)(Ad_ + 32 * GST) = P##A1; *(u4v*)(Ad_ + 64 * GST) = P##A2; *(u4v*)(Ad_ + 96 * GST) = P##A3; \
    *(u4v*)(Bd_) = P##B0; *(u4v*)(Bd_ + 32 * GST) = P##B1; *(u4v*)(Bd_ + 64 * GST) = P##B2; *(u4v*)(Bd_ + 96 * GST) = P##B3; }
#define G0_COMPUTE(buf)                                                                                   \
  { const u16* Ab = As + (buf) * (128 * GST) + (wm * 64 + (lane & 31)) * GST + (lane >> 5) * 8;           \
    const u16* Bb = Bs + (buf) * (128 * GST) + (wn * 64 + (lane & 31)) * GST + (lane >> 5) * 8;           \
    __builtin_amdgcn_s_setprio(1);                                                                        \
    _Pragma("unroll") for (int ks = 0; ks < 4; ++ks) {                                                    \
      s8v af0 = *(const s8v*)(Ab + ks * 16);                                                              \
      s8v af1 = *(const s8v*)(Ab + 32 * GST + ks * 16);                                                   \
      s8v bf0 = *(const s8v*)(Bb + ks * 16);                                                              \
      s8v bf1 = *(const s8v*)(Bb + 32 * GST + ks * 16);                                                   \
      acc[0][0] = __builtin_amdgcn_mfma_f32_32x32x16_bf16(af0, bf0, acc[0][0], 0, 0, 0);                  \
      acc[0][1] = __builtin_amdgcn_mfma_f32_32x32x16_bf16(af0, bf1, acc[0][1], 0, 0, 0);                  \
      acc[1][0] = __builtin_amdgcn_mfma_f32_32x32x16_bf16(af1, bf0, acc[1][0], 0, 0, 0);                  \
      acc[1][1] = __builtin_amdgcn_mfma_f32_32x32x16_bf16(af1, bf1, acc[1][1], 0, 0, 0);                  \
    }                                                                                                     \
    __builtin_amdgcn_s_setprio(0); }
  const int nk = K >> 6;
  G0_ISSUE(e, 0)
  G0_ISSUE(o, 1)
  G0_STAGE(e, 0)
  __syncthreads();
  int kt = 0;
#pragma unroll 1
  for (; kt + 3 < nk; kt += 2) {
    G0_ISSUE(e, kt + 2)
    __builtin_amdgcn_sched_barrier(0);
    G0_COMPUTE(0)
    G0_STAGE(o, 1)
    __syncthreads();
    G0_ISSUE(o, kt + 3)
    __builtin_amdgcn_sched_barrier(0);
    G0_COMPUTE(1)
    G0_STAGE(e, 0)
    __syncthreads();
  }
  G0_COMPUTE(0)
  G0_STAGE(o, 1)
  __syncthreads();
  G0_COMPUTE(1)
  __syncthreads();
#undef G0_ISSUE
#undef G0_STAGE
#undef G0_COMPUTE
}

#define EPI_ROW(mi, reg) (m0 + wm * 64 + (mi) * 32 + ((reg) & 3) + 8 * ((reg) >> 2) + 4 * (lane >> 5))
#define EPI_COL(ni) (n0 + wn * 64 + (ni) * 32 + (lane & 31))


#define CST 136
__device__ __forceinline__ void cs_store(const u16* Cs, u16* __restrict__ dst, size_t ld, int tid) {
#pragma unroll
  for (int i = 0; i < 8; ++i) {
    const int c = tid + 256 * i, r = c >> 4, ch = c & 15;
    *(u4v*)(dst + (size_t)r * ld + ch * 8) = *(const u4v*)(Cs + r * CST + ch * 8);
  }
}

__device__ __forceinline__ void stats_accum(float* stats, int row, float v0, float v1, int lane) {
  float s = v0 + v1, q = v0 * v0 + v1 * v1;
#pragma unroll
  for (int o = 1; o < 32; o <<= 1) {
    s += __shfl_xor(s, o);
    q += __shfl_xor(q, o);
  }
  if ((lane & 31) == 0) {
    atomicAdd(stats + row * 2, s);
    atomicAdd(stats + row * 2 + 1, q);
  }
}

#define P0_ADA 768
#define P0_ROPE 1
#define P0_CACHE 64
#define P0_S0 64
#define P0_S5 128
#define P0_WT_PER_LAYER (16 * 112 + 8 * 8 + 3 * 8 * 16 + 16 * 16 + 16 * 88 + 44 * 16)
#define P0_WT (2 * P0_WT_PER_LAYER)
#define P0_ITEMS (P0_ADA + P0_ROPE + P0_CACHE + P0_S0 + P0_S5 + P0_WT)

__device__ __forceinline__ void wt_tile(const float* __restrict__ src, int N, u16* __restrict__ dst, int ldd, int kt, int nt, char* smem) {
  float* tile = (float*)smem;
  const int tid = ltid();
  __syncthreads();
  {
    const int c4 = (tid & 15) * 4, r0 = tid >> 4;
#pragma unroll
    for (int i = 0; i < 4; ++i) {
      const int k = r0 + 16 * i;
      const float4 v = *(const float4*)(src + (size_t)(kt * 64 + k) * N + nt * 64 + c4);
      tile[k * 65 + c4] = v.x; tile[k * 65 + c4 + 1] = v.y; tile[k * 65 + c4 + 2] = v.z; tile[k * 65 + c4 + 3] = v.w;
    }
  }
  __syncthreads();
  {
    const int n = tid >> 2, k0 = (tid & 3) * 16;
#define WTP(j) pack2(tile[(k0 + 2 * (j)) * 65 + n], tile[(k0 + 2 * (j) + 1) * 65 + n])
    u4v* d = (u4v*)(dst + (size_t)(nt * 64 + n) * ldd + kt * 64 + k0);
    d[0] = (u4v){WTP(0), WTP(1), WTP(2), WTP(3)};
    d[1] = (u4v){WTP(4), WTP(5), WTP(6), WTP(7)};
#undef WTP
  }
}
__device__ __forceinline__ void wt_item(const Params& p, char* smem, int item) {
  const int l = item / P0_WT_PER_LAYER;
  int it = item % P0_WT_PER_LAYER;
  u16* base = WS_Wt + WT_LAYER * l;
  if (it < 16 * 112) { wt_tile(p.w_in + (size_t)l * 1024 * 7168, 7168, base + WT_IN, 1024, it / 112, it % 112, smem); return; }
  it -= 16 * 112;
  if (it < 64) { wt_tile(p.w_glu + (size_t)l * 512 * 512, 512, base + WT_GLU, 512, it / 8, it % 8, smem); return; }
  it -= 64;
  if (it < 384) { const int br = it / 128; it %= 128;
    wt_tile(p.w_branch + ((size_t)l * 3 + br) * 512 * 1024, 1024, base + WT_BR + (size_t)br * 512 * 1024, 512, it / 16, it % 16, smem); return; }
  it -= 384;
  if (it < 256) { wt_tile(p.w_o + (size_t)l * 1024 * 1024, 1024, base + WT_O, 1024, it / 16, it % 16, smem); return; }
  it -= 256;
  if (it < 16 * 88) { wt_tile(p.w_up + (size_t)l * 1024 * 5632, 5632, base + WT_UP, 1024, it / 88, it % 88, smem); return; }
  it -= 16 * 88;
  wt_tile(p.w_down + (size_t)l * 2816 * 1024, 1024, base + WT_DOWN, 2816, it / 16, it % 16, smem);
}

__device__ __forceinline__ void phase0_item(const Params& p, char* smem, int item) {
  const int tid = ltid();
  if (item < P0_ADA) {
    const int ks = item & 3, cg = (item >> 2) % 96, l = item / 384;
    float* scs = (float*)smem;
    float* red = scs + 5 * 256;
    __syncthreads();
    for (int i = tid; i < 5 * 256; i += 256) {
      int ci = i >> 8, k = ks * 256 + (i & 255);
      float v = ci == 0 ? p.c_ctx[k] : p.c[(ci - 1) * 1024 + k];
      scs[i] = siluf_(v);
    }
    __syncthreads();
    const int ct = tid & 15, kg = tid >> 4;
    const float* wp = p.w_ada + (size_t)l * 1024 * 6144 + (size_t)(ks * 256 + kg * 16) * 6144 + cg * 64 + ct * 4;
    float acc[5][4];
#pragma unroll
    for (int i = 0; i < 5; ++i)
#pragma unroll
      for (int j = 0; j < 4; ++j) acc[i][j] = 0.f;
#pragma unroll 4
    for (int k = 0; k < 16; ++k) {
      float4 w = *(const float4*)(wp + (size_t)k * 6144);
#pragma unroll
      for (int ci = 0; ci < 5; ++ci) {
        float s = scs[ci * 256 + kg * 16 + k];
        acc[ci][0] += s * w.x; acc[ci][1] += s * w.y; acc[ci][2] += s * w.z; acc[ci][3] += s * w.w;
      }
    }
#pragma unroll
    for (int ci = 0; ci < 5; ++ci)
#pragma unroll
      for (int j = 0; j < 4; ++j) red[(kg * 5 + ci) * 64 + ct * 4 + j] = acc[ci][j];
    __syncthreads();
    for (int i = tid; i < 320; i += 256) {
      int ci = i >> 6, col = i & 63;
      float s = 0.f;
#pragma unroll
      for (int g = 0; g < 16; ++g) s += red[(g * 5 + ci) * 64 + col];
      if (ks == 0) s += p.b_ada[l * 6144 + cg * 64 + col];
      atomicAdd(WS_mod + (l * 5 + ci) * 6144 + cg * 64 + col, s);
    }
    return;
  }
  item -= P0_ADA;
  if (item < P0_ROPE) {
    for (int i = tid; i < 64 * 32; i += 256) {
      int pos = i >> 5, fi = i & 31;
      float inv = (float)pow(10000.0, -(double)fi / 32.0);
      float ang = (float)pos * inv;
      WS_ropetab[i * 2] = (float)cos((double)ang);
      WS_ropetab[i * 2 + 1] = (float)sin((double)ang);
    }
    return;
  }
  item -= P0_ROPE;
  if (item < P0_CACHE) {
    const int pc = item & 7, b = (item >> 3) & 3, l = item >> 5;
    const float* ksrc = p.cache_k + ((size_t)(b * 2 + l) * 512 + pc * 64) * 512;
    const float* vsrc = p.cache_v + ((size_t)(b * 2 + l) * 512 + pc * 64) * 512;
    u16* kdst = WS_CK + ((size_t)(l * 4 + b) * 512 + pc * 64) * 512;
    for (int i = tid; i < 64 * 512 / 4; i += 256) {
      float4 v = *(const float4*)(ksrc + (size_t)i * 4);
      *(uint2*)(kdst + (size_t)i * 4) = make_uint2(pack2(v.x, v.y), pack2(v.z, v.w));
    }
    for (int cc = 0; cc < 2; ++cc) {
      const int col = tid + cc * 256;
      u16* vdst = WS_CVt + ((size_t)(l * 4 + b) * 512 + col) * 512 + pc * 64;
      for (int j = 0; j < 8; ++j) {
        float v[8];
#pragma unroll
        for (int e = 0; e < 8; ++e) v[e] = vsrc[(size_t)(j * 8 + e) * 512 + col];
        *(uint4*)(vdst + j * 8) = make_uint4(pack2(v[0], v[1]), pack2(v[2], v[3]), pack2(v[4], v[5]), pack2(v[6], v[7]));
      }
    }
    return;
  }
  item -= P0_CACHE;
  if (item < P0_S0) {
    const int hh = item & 3, dir = (item >> 2) & 1, b = (item >> 3) & 3, l = item >> 5;
    const float* src = p.state_ret + ((size_t)(((b * 2 + l) * 2 + dir) * 4 + hh)) * 16384;
    u16* dst = WS_S0t + ((size_t)(((l * 4 + b) * 2 + dir) * 4 + hh)) * 16384;
    const int dv = tid & 127, kh = tid >> 7;
    for (int j = 0; j < 8; ++j) {
      const int dk0 = kh * 64 + j * 8;
      float v[8];
#pragma unroll
      for (int e = 0; e < 8; ++e) v[e] = src[(size_t)(dk0 + e) * 128 + dv];
      *(uint4*)(dst + (size_t)dv * 128 + dk0) = make_uint4(pack2(v[0], v[1]), pack2(v[2], v[3]), pack2(v[4], v[5]), pack2(v[6], v[7]));
    }
    return;
  }
  item -= P0_S0;
  if (item >= P0_S5) { wt_item(p, smem, item - P0_S5); return; }
  {
    const int g = item & 31, dir = (item >> 5) & 1, l = item >> 6;
    if (tid < 64) {
      const int pp = tid;
      const int ai = ((l * 2 + dir) * 32 + g) * 64 + pp;
      double lre = fmin((double)p.a_re[ai], -1e-4), lim = (double)p.a_im[ai];
      double dt = exp((double)p.log_dt[(l * 2 + dir) * 32 + g]);
      double er = exp(lre * dt);
      double abr = er * cos(lim * dt), abi = er * sin(lim * dt);
      WS_abar[ai * 2] = (float)abr;
      WS_abar[ai * 2 + 1] = (float)abi;
      double nr = abr - 1.0, ni = abi;
      double den = lre * lre + lim * lim;
      double cr = (nr * lre + ni * lim) / den, cim = (ni * lre - nr * lim) / den;
      u16* bt = WS_bbarT + (size_t)((l * 2 + dir) * 32 + g) * 128 * 16;
      const float* br = p.b_re + ((size_t)(l * 32 + g) * 64 + pp) * 16;
      const float* bi = p.b_im + ((size_t)(l * 32 + g) * 64 + pp) * 16;
      for (int c = 0; c < 16; ++c) {
        double xr = br[c], xi = bi[c];
        bt[pp * 16 + c] = f2bf((float)(cr * xr - cim * xi));
        bt[(64 + pp) * 16 + c] = f2bf((float)(cr * xi + cim * xr));
      }
      u16* ct = WS_cmT + (size_t)((l * 2 + dir) * 32 + g) * 16 * 128;
      const float* cre = p.c_re + ((size_t)((l * 2 + dir) * 32 + g) * 16) * 64;
      const float* cie = p.c_im + ((size_t)((l * 2 + dir) * 32 + g) * 16) * 64;
      for (int c = 0; c < 16; ++c) {
        ct[c * 128 + pp] = f2bf(cre[c * 64 + pp]);
        ct[c * 128 + 64 + pp] = f2bf(-cie[c * 64 + pp]);
      }
    }
  }
}


__device__ __forceinline__ void hmat_item(const Params& p, int l, int which, int item) {
  const int c = ltid() * 4;
  const int row0 = item * 8;
  const int ci = cond_of_row(row0);
  const float* mod = WS_mod + (l * 5 + ci) * 6144;
  const float4 sc = *(const float4*)(mod + (which ? 4 : 1) * 1024 + c);
  const float4 sh = *(const float4*)(mod + (which ? 3 : 0) * 1024 + c);
  float4 g = make_float4(1.f, 1.f, 1.f, 1.f), b = make_float4(0.f, 0.f, 0.f, 0.f);
  const float* st = nullptr;
  if (which == 1) { g = *(const float4*)(p.ln1_g + l * 1024 + c); b = *(const float4*)(p.ln1_b + l * 1024 + c); st = WS_stats + (size_t)(l * 2 + 0) * TALL * 2; }
  else if (l == 1) { g = *(const float4*)(p.ln2_g + c); b = *(const float4*)(p.ln2_b + c); st = WS_stats + (size_t)(0 * 2 + 1) * TALL * 2; }
  const float G0 = g.x * (1.f + sc.x), G1 = g.y * (1.f + sc.y), G2 = g.z * (1.f + sc.z), G3 = g.w * (1.f + sc.w);
  const float B0 = fmaf(b.x, 1.f + sc.x, sh.x), B1 = fmaf(b.y, 1.f + sc.y, sh.y), B2 = fmaf(b.z, 1.f + sc.z, sh.z), B3 = fmaf(b.w, 1.f + sc.w, sh.w);
  u16* dst = which ? WS_h2 : WS_h1;
#pragma unroll
  for (int r = 0; r < 8; ++r) {
    const int row = row0 + r;
    const float* src;
    if (which == 1) src = WS_pre1 + (size_t)row * 1024;
    else if (l == 1) src = p.out + (size_t)row * 1024;
    else src = row < TCTX ? p.x_prompt + (size_t)row * 1024 : p.x_sample + (size_t)(row - TCTX) * 1024;
    float rs = 1.f, nm = 0.f;
    if (st) {
      const float s = st[row * 2], q = st[row * 2 + 1];
      const float mu = s * (1.f / 1024.f);
      rs = rsqrtf(fmaxf(q * (1.f / 1024.f) - mu * mu, 0.f) + LNEPS);
      nm = -mu * rs;
    }
    const float4 x = *(const float4*)(src + c);
    const float h0 = fmaf(fmaf(x.x, rs, nm), G0, B0), h1 = fmaf(fmaf(x.y, rs, nm), G1, B1);
    const float h2 = fmaf(fmaf(x.z, rs, nm), G2, B2), h3 = fmaf(fmaf(x.w, rs, nm), G3, B3);
    *(uint2*)(dst + (size_t)row * 1024 + c) = make_uint2(pack2(h0, h1), pack2(h2, h3));
  }
}

__device__ __forceinline__ void p1_item(const Params& p, char* smem, int l, int item) {
  const int mt = item & 63, nt = item >> 6;
  const int m0 = mt * 128, n0 = nt * 128;
  const int tid = ltid(), lane = tid & 63, wave = tid >> 6, wm = wave >> 1, wn = wave & 1;
  f16v acc[2][2];
  gemm_mainloop0(smem, WS_h1, 1024, WS_Wt + WT_LAYER * l + WT_IN, 1024, 1024, m0, n0, acc);

  const bool latent = m0 >= TCTX;
  const int seg = n0 >> 9;
  const int cs0 = n0 & 511;
  const int l31 = lane & 31;
  u16* Cs = (u16*)smem;
  u16* CsT = Cs + 128 * CST;
  const int rl0 = wm * 64 + 4 * (lane >> 5);
  const int cl0 = wn * 64 + l31;
  const bool want_rm = !(seg == 2 || seg == 7);
  const bool want_t = (seg == 2 || seg == 7 || (seg == 1 && !latent));
#pragma unroll
  for (int mi = 0; mi < 2; ++mi)
#pragma unroll
    for (int q = 0; q < 4; ++q) {
      float o0[4], o1[4];
#pragma unroll
      for (int j = 0; j < 4; ++j) {
        const int reg = q * 4 + j;
        float x1 = acc[mi][0][reg], x2 = acc[mi][1][reg];
        if (seg <= 1) {
          if (latent) {
            const int pos = (m0 - TCTX + rl0 + mi * 32 + q * 8 + j) & 1023;
            const int pidx = ((cs0 + wn * 64) & 64) ? (pos & 63) : (pos >> 6);
            const float cs = WS_ropetab[(pidx * 32 + l31) * 2], sn = WS_ropetab[(pidx * 32 + l31) * 2 + 1];
            const float t1 = x1 * cs - x2 * sn, t2 = x1 * sn + x2 * cs;
            x1 = t1; x2 = t2;
          }
          if (seg == 1) { x1 *= 0.08838834764831845f; x2 *= 0.08838834764831845f; }
        } else if (seg == 3) { x1 = siluf_(x1); x2 = siluf_(x2); }
        else if (seg == 5) { x1 *= 0.125f; x2 *= 0.125f; }
        else if (seg >= 8) { x1 = sigmoidf_(x1); x2 = sigmoidf_(x2); }
        o0[j] = x1; o1[j] = x2;
        if (want_rm) {
          const int rl = rl0 + mi * 32 + q * 8 + j;
          Cs[rl * CST + cl0] = f2bf(x1);
          Cs[rl * CST + cl0 + 32] = f2bf(x2);
        }
        if ((seg == 6 || seg == 7) && !latent) {
          const int row = m0 + rl0 + mi * 32 + q * 8 + j;
          float* o = p.out + (seg == 6 ? OUT_CK : OUT_CV) + ((size_t)((row >> 8) * 2 + l) * 256 + (row & 255)) * 512 + cs0 + cl0;
          o[0] = acc[mi][0][reg]; o[32] = acc[mi][1][reg];
        }
      }
      if (want_t) {
        const int rl = rl0 + mi * 32 + q * 8;
        *(uint2*)(CsT + cl0 * CST + rl) = make_uint2(pack2(o0[0], o0[1]), pack2(o0[2], o0[3]));
        *(uint2*)(CsT + (cl0 + 32) * CST + rl) = make_uint2(pack2(o1[0], o1[1]), pack2(o1[2], o1[3]));
      }
    }
  __syncthreads();
  if (want_rm) {
    u16* dst;
    size_t ld = 512;
    if (seg >= 8) { dst = WS_GT + (size_t)m0 * 3072 + (n0 - 4096); ld = 3072; }
    else {
      u16* base = seg == 0 ? WS_Q : seg == 1 ? WS_K : seg == 3 ? WS_G : seg == 4 ? WS_SU : seg == 5 ? WS_NQ : WS_NK;
      dst = base + (size_t)m0 * 512 + cs0;
    }
    cs_store(Cs, dst, ld, tid);
  }
  if (want_t) {
    u16* base = seg == 2 ? WS_VtR : seg == 7 ? WS_NVt : WS_KtR;
    u16* dst;
    size_t ld;
    if (!latent) { dst = base + ((size_t)(m0 >> 8) * 512 + cs0) * 256 + (m0 & 255); ld = 256; }
    else { dst = base + VTR_LAT + ((size_t)((m0 - TCTX) >> 10) * 512 + cs0) * 1024 + ((m0 - TCTX) & 1023); ld = 1024; }
    cs_store(CsT, dst, ld, tid);
  }
}

template <int D, int MODE>
__device__ __forceinline__ void attn_item(const Params& p, char* smem, int l, int idx) {
  constexpr int KSTR = D + 8;
  constexpr int NKS = D / 32;
  constexpr int NB = D / 16;
  constexpr int NCH = D / 32;
  u16* Ks = (u16*)smem;
  u16* Vts = Ks + 64 * KSTR;
  float* rpbs = (float*)(Vts + D * 72);
  const int tid = ltid(), lane = tid & 63, wave = tid >> 6;
  const int l15 = lane & 15, g = lane >> 4;
  const int wave_u = __builtin_amdgcn_readfirstlane(wave);

  int b, hh, qt, L, tokbase, nt;
  bool latent = false;
  int kr0 = 0, rrow = 0;
  if constexpr (MODE == 0) {
    if (idx < 256) { latent = true; b = idx >> 6; hh = (idx >> 4) & 3; qt = idx & 15; L = 1024; tokbase = TCTX + b * 1024; nt = 16 + 4; }
    else { idx -= 256; b = idx >> 4; hh = (idx >> 2) & 3; qt = idx & 3; L = 256; tokbase = b * 256; nt = 4; }
  } else if constexpr (MODE == 1) {
    b = idx >> 5; hh = (idx >> 2) & 7; qt = idx & 3; L = 256; tokbase = b * 256; nt = 4;
  } else {
    b = idx >> 7; hh = (idx >> 4) & 7; qt = idx & 15; rrow = qt; L = 1024; tokbase = TCTX + b * 1024; nt = 16; latent = true;
    kr0 = min(max(rrow - 4, 0), 8);
  }
  const int tq = qt * 64 + wave * 16 + l15;
  const int qtok = tokbase + tq;

  float lgf2 = 0.f, lgb2 = 0.f;
  if constexpr (MODE == 0) {
    float xf = p.ret_decay[(l * 2 + 0) * 4 + hh], xb = p.ret_decay[(l * 2 + 1) * 4 + hh];
    lgf2 = -log1pf(expf(-xf)) * 1.4426950408889634f;
    lgb2 = -log1pf(expf(-xb)) * 1.4426950408889634f;
  }
  float cfw[4][4], cbw[4][4];
  if constexpr (MODE == 0) {
#pragma unroll
    for (int kb = 0; kb < 4; ++kb)
#pragma unroll
      for (int r = 0; r < 4; ++r) {
        const float off = (float)(kb * 16 + g * 4 + r);
        cfw[kb][r] = __builtin_amdgcn_exp2f(-lgf2 * off);
        cbw[kb][r] = __builtin_amdgcn_exp2f(lgb2 * off);
      }
  }

  __syncthreads();
  if constexpr (MODE == 2) {
    for (int i = tid; i < 465; i += 256) rpbs[i] = p.rpb[(size_t)(l * 8 + hh) * 465 + i];
  }

  u4v qf[NKS];
  {
    const u16* qb = (MODE == 0 ? WS_Q : WS_NQ) + (size_t)qtok * 512 + hh * D + g * 8;
#pragma unroll
    for (int ks = 0; ks < NKS; ++ks) qf[ks] = *(const u4v*)(qb + ks * 32);
  }

  f4v ot[NB];
#pragma unroll
  for (int nb = 0; nb < NB; ++nb) ot[nb] = (f4v){0.f, 0.f, 0.f, 0.f};
  float mrun = -1e30f, lsum = 0.f;

  const int ntk = (MODE == 0) ? (L >> 6) : nt;
  u4v kr[NCH], vr[NCH];
#define ATTN_ISSUE(KT)                                                                                   \
  {                                                                                                      \
    const int kt_ = (KT);                                                                                \
    const u16* kp; const u16* vp; int ldv;                                                               \
    if constexpr (MODE == 0) {                                                                           \
      kp = WS_K + (size_t)(tokbase + kt_ * 64) * 512 + hh * 128;                                          \
      if (latent) { vp = WS_VtR + VTR_LAT + ((size_t)(b * 4 + hh) * 128) * 1024 + kt_ * 64; ldv = 1024; } \
      else { vp = WS_VtR + ((size_t)(b * 4 + hh) * 128) * 256 + kt_ * 64; ldv = 256; }                    \
    } else if constexpr (MODE == 1) {                                                                    \
      kp = WS_NK + (size_t)(tokbase + kt_ * 64) * 512 + hh * 64;                                          \
      vp = WS_NVt + ((size_t)(b * 8 + hh) * 64) * 256 + kt_ * 64; ldv = 256;                              \
    } else {                                                                                             \
      if (kt_ < 8) {                                                                                     \
        const int krow = kr0 + kt_;                                                                      \
        kp = WS_NK + (size_t)(tokbase + krow * 64) * 512 + hh * 64;                                       \
        vp = WS_NVt + NVT_LAT + ((size_t)(b * 8 + hh) * 64) * 1024 + krow * 64; ldv = 1024;               \
      } else {                                                                                           \
        kp = WS_CK + ((size_t)(l * 4 + b) * 512 + (kt_ - 8) * 64) * 512 + hh * 64;                        \
        vp = WS_CVt + ((size_t)((l * 4 + b) * 8 + hh) * 64) * 512 + (kt_ - 8) * 64; ldv = 512;            \
      }                                                                                                  \
    }                                                                                                    \
    _Pragma("unroll") for (int i = 0; i < NCH; ++i) {                                                    \
      const int c = tid + 256 * i;                                                                       \
      const int r = c / (D / 8), cc = c % (D / 8);                                                       \
      kr[i] = *(const u4v*)(kp + (size_t)r * 512 + cc * 8);                                              \
      const int vrw = c >> 3, vc = c & 7;                                                                \
      vr[i] = *(const u4v*)(vp + (size_t)vrw * ldv + vc * 8);                                            \
    }                                                                                                    \
  }
#define ATTN_STAGE()                                                                                     \
  {                                                                                                      \
    _Pragma("unroll") for (int i = 0; i < NCH; ++i) {                                                    \
      const int c = tid + 256 * i;                                                                       \
      const int r = c / (D / 8), cc = c % (D / 8);                                                       \
      *(u4v*)(Ks + r * KSTR + cc * 8) = kr[i];                                                           \
      const int vrw = c >> 3, vc = c & 7;                                                                \
      *(u4v*)(Vts + vrw * 72 + vc * 8) = vr[i];                                                          \
    }                                                                                                    \
  }

  ATTN_ISSUE(0)
#pragma unroll 1
  for (int kt = 0; kt < ntk; ++kt) {
    __syncthreads();
    ATTN_STAGE()
    __syncthreads();
    if (kt + 1 < ntk) ATTN_ISSUE(kt + 1)
    f4v st[4];
    int kb_lo = 0, kb_hi = 3;
    if constexpr (MODE == 2) {
      if (kt < 8) { kb_lo = wave_u >= 2 ? wave_u - 1 : 0; kb_hi = wave_u <= 1 ? wave_u + 1 : 3; }
    }
#pragma unroll
    for (int kb = 0; kb < 4; ++kb) {
      st[kb] = (f4v){0.f, 0.f, 0.f, 0.f};
      if (MODE != 2 || (kb >= kb_lo && kb <= kb_hi)) {
#pragma unroll
        for (int ks = 0; ks < NKS; ++ks) {
          s8v kf = *(const s8v*)(Ks + (kb * 16 + l15) * KSTR + ks * 32 + g * 8);
          st[kb] = __builtin_amdgcn_mfma_f32_16x16x32_bf16(kf, bc8(qf[ks]), st[kb], 0, 0, 0);
        }
      }
    }
    if constexpr (MODE == 0) {
      if (kt < qt) {
        const float rowf = __builtin_amdgcn_exp2f(lgf2 * (float)(tq - kt * 64));
#pragma unroll
        for (int kb = 0; kb < 4; ++kb)
#pragma unroll
          for (int r = 0; r < 4; ++r) st[kb][r] *= rowf * cfw[kb][r];
      } else if (kt > qt) {
        const float rowb = __builtin_amdgcn_exp2f(lgb2 * (float)(kt * 64 - tq));
#pragma unroll
        for (int kb = 0; kb < 4; ++kb)
#pragma unroll
          for (int r = 0; r < 4; ++r) st[kb][r] *= rowb * cbw[kb][r];
      } else {
#pragma unroll
        for (int kb = 0; kb < 4; ++kb)
#pragma unroll
          for (int r = 0; r < 4; ++r) {
            const int ts = kt * 64 + kb * 16 + g * 4 + r;
            const int d = tq - ts;
            float dec = d > 0 ? exp2f(lgf2 * (float)d) : (d < 0 ? exp2f(lgb2 * (float)(-d)) : 2.f);
            st[kb][r] *= dec;
          }
      }
    } else {
      if constexpr (MODE == 2) {
        if (kt < 8) {
          const int qc = wave * 16 + l15;
          const int ws = min(max(qc - 8, 0), 48);
          const int roff = (kr0 + kt) - rrow + 7;
#pragma unroll
          for (int kb = 0; kb < 4; ++kb) {
            if (kb >= kb_lo && kb <= kb_hi) {
#pragma unroll
              for (int r = 0; r < 4; ++r) {
                const int kc = kb * 16 + g * 4 + r;
                const bool valid = (kc >= ws) && (kc < ws + 16);
                const int coff = min(max(kc - qc + 15, 0), 30);
                const float bias = rpbs[roff * 31 + coff];
                st[kb][r] = valid ? st[kb][r] + bias : -1e30f;
              }
            } else {
              st[kb] = (f4v){-1e30f, -1e30f, -1e30f, -1e30f};
            }
          }
        }
      }
      float tmax = st[0][0];
#pragma unroll
      for (int kb = 0; kb < 4; ++kb)
#pragma unroll
        for (int r = 0; r < 4; ++r) tmax = fmaxf(tmax, st[kb][r]);
      tmax = fmaxf(tmax, __shfl_xor(tmax, 16));
      tmax = fmaxf(tmax, __shfl_xor(tmax, 32));
      const float mnew = fmaxf(mrun, tmax);
      const float alpha = __expf(mrun - mnew);
      float ps = 0.f;
#pragma unroll
      for (int kb = 0; kb < 4; ++kb) {
        if (MODE != 2 || (kb >= kb_lo && kb <= kb_hi)) {
#pragma unroll
          for (int r = 0; r < 4; ++r) {
            float e = __expf(st[kb][r] - mnew);
            st[kb][r] = e;
            ps += e;
          }
        } else {
          st[kb] = (f4v){0.f, 0.f, 0.f, 0.f};
        }
      }
      lsum = lsum * alpha + ps;
      mrun = mnew;
#pragma unroll
      for (int nb = 0; nb < NB; ++nb) ot[nb] *= alpha;
    }
    u4v pf[2];
#pragma unroll
    for (int s = 0; s < 2; ++s) {
      pf[s] = (u4v){pack2(st[2 * s][0], st[2 * s][1]), pack2(st[2 * s][2], st[2 * s][3]),
                    pack2(st[2 * s + 1][0], st[2 * s + 1][1]), pack2(st[2 * s + 1][2], st[2 * s + 1][3])};
    }
#pragma unroll
    for (int s = 0; s < 2; ++s) {
      if (MODE == 2 && (2 * s + 1 < kb_lo || 2 * s > kb_hi)) continue;
#pragma unroll
      for (int nb = 0; nb < NB; ++nb) {
        const u16* vb = Vts + (nb * 16 + l15) * 72 + s * 32 + g * 4;
        uint2 lo = *(const uint2*)(vb);
        uint2 hi = *(const uint2*)(vb + 16);
        u4v vf = (u4v){lo.x, lo.y, hi.x, hi.y};
        ot[nb] = __builtin_amdgcn_mfma_f32_16x16x32_bf16(bc8(vf), bc8(pf[s]), ot[nb], 0, 0, 0);
      }
    }
  }

  if constexpr (MODE == 0) {
    if (latent) {
#pragma unroll 1
      for (int dir = 0; dir < 2; ++dir) {
        const float scale = dir == 0 ? exp2f(lgf2 * (float)(tq + 1)) : exp2f(lgb2 * (float)(L - tq));
        const u16* S0 = WS_S0t + ((size_t)(((l * 4 + b) * 2 + dir) * 4 + hh)) * 16384;
#pragma unroll
        for (int s = 0; s < NKS; ++s) {
          u4v pq = (u4v){pack2(bflo(qf[s][0]) * scale, bfhi(qf[s][0]) * scale), pack2(bflo(qf[s][1]) * scale, bfhi(qf[s][1]) * scale),
                         pack2(bflo(qf[s][2]) * scale, bfhi(qf[s][2]) * scale), pack2(bflo(qf[s][3]) * scale, bfhi(qf[s][3]) * scale)};
#pragma unroll
          for (int nb = 0; nb < NB; ++nb) {
            u4v vf = *(const u4v*)(S0 + (size_t)(nb * 16 + l15) * 128 + s * 32 + g * 8);
            ot[nb] = __builtin_amdgcn_mfma_f32_16x16x32_bf16(bc8(vf), bc8(pq), ot[nb], 0, 0, 0);
          }
        }
      }
    }
    float s = 0.f;
#pragma unroll
    for (int nb = 0; nb < NB; ++nb) s += ot[nb][0] + ot[nb][1] + ot[nb][2] + ot[nb][3];
    s += __shfl_xor(s, 16); s += __shfl_xor(s, 32);
    const float mu = s * (1.f / 128.f);
    float q = 0.f;
#pragma unroll
    for (int nb = 0; nb < NB; ++nb)
#pragma unroll
      for (int r = 0; r < 4; ++r) { float dlt = ot[nb][r] - mu; q += dlt * dlt; }
    q += __shfl_xor(q, 16); q += __shfl_xor(q, 32);
    const float rstd = rsqrtf(q * (1.f / 128.f) + LNEPS);
#pragma unroll
    for (int nb = 0; nb < NB; ++nb) {
      const size_t off = (size_t)qtok * 512 + hh * 128 + nb * 16 + g * 4;
      uint2 gg = *(const uint2*)(WS_G + off);
      float o0 = (ot[nb][0] - mu) * rstd * bflo(gg.x);
      float o1 = (ot[nb][1] - mu) * rstd * bfhi(gg.x);
      float o2 = (ot[nb][2] - mu) * rstd * bflo(gg.y);
      float o3 = (ot[nb][3] - mu) * rstd * bfhi(gg.y);
      *(uint2*)(WS_rout + off) = make_uint2(pack2(o0, o1), pack2(o2, o3));
    }
  } else {
    lsum += __shfl_xor(lsum, 16); lsum += __shfl_xor(lsum, 32);
    const float inv = 1.f / lsum;
#pragma unroll
    for (int nb = 0; nb < NB; ++nb) {
      const size_t off = (size_t)qtok * 512 + hh * 64 + nb * 16 + g * 4;
      *(uint2*)(WS_nout + off) = make_uint2(pack2(ot[nb][0] * inv, ot[nb][1] * inv), pack2(ot[nb][2] * inv, ot[nb][3] * inv));
    }
  }
}

__device__ __forceinline__ void retstate_item(const Params& p, int l, int idx) {
  const int dir = idx & 1, hh = (idx >> 1) & 3, b = idx >> 3;
  const int tid = ltid(), lane = tid & 63, wave = tid >> 6;
  const int r = lane & 31, h2 = lane >> 5;
  const float x = p.ret_decay[(l * 2 + dir) * 4 + hh];
  const float lg2 = -log1pf(expf(-x)) * 1.4426950408889634f;
  const u16* Kt = WS_KtR + ((size_t)(b * 4 + hh) * 128) * 256;
  const u16* Vt = WS_VtR + ((size_t)(b * 4 + hh) * 128) * 256;
  f16v acc[4];
#pragma unroll
  for (int i = 0; i < 4; ++i) acc[i] = zero16();
#pragma unroll 2
  for (int ks = 0; ks < 16; ++ks) {
    const int tok0 = ks * 16 + h2 * 8;
    const u4v a = *(const u4v*)(Kt + (size_t)(wave * 32 + r) * 256 + tok0);
    u4v af;
#pragma unroll
    for (int w = 0; w < 4; ++w) {
      const int t0 = tok0 + 2 * w, t1 = t0 + 1;
      float w0 = dir == 0 ? exp2f(lg2 * (float)(255 - t0)) : exp2f(lg2 * (float)t0);
      float w1 = dir == 0 ? exp2f(lg2 * (float)(255 - t1)) : exp2f(lg2 * (float)t1);
      af[w] = pack2(bflo(a[w]) * w0, bfhi(a[w]) * w1);
    }
#pragma unroll
    for (int nt = 0; nt < 4; ++nt) {
      const u4v bfr = *(const u4v*)(Vt + (size_t)(nt * 32 + r) * 256 + tok0);
      acc[nt] = __builtin_amdgcn_mfma_f32_32x32x16_bf16(bc8(af), bc8(bfr), acc[nt], 0, 0, 0);
    }
  }
  float* o = p.out + OUT_SRET + ((size_t)(((b * 2 + l) * 2 + dir) * 4 + hh)) * 16384;
#pragma unroll
  for (int nt = 0; nt < 4; ++nt)
#pragma unroll
    for (int reg = 0; reg < 16; ++reg) {
      const int dk = wave * 32 + (reg & 3) + 8 * (reg >> 2) + 4 * h2;
      o[(size_t)dk * 128 + nt * 32 + r] = acc[nt][reg];
    }
}

__device__ __forceinline__ void s5_item(const Params& p, char* smem, int l, int item) {
  const int tid = ltid(), lane = tid & 63, wave = tid >> 6;
  const int l15 = lane & 15, g4 = lane >> 4;
  int seq = item * 4 + wave;
  int b, dir, g, L, tokbase;
  bool latent;
  if (seq < 256) { latent = true; b = seq >> 6; dir = (seq >> 5) & 1; g = seq & 31; L = 1024; tokbase = TCTX + b * 1024; }
  else { seq -= 256; latent = false; b = seq >> 6; dir = (seq >> 5) & 1; g = seq & 31; L = 256; tokbase = b * 256; }
  float* buf = (float*)smem + wave * (16 * 132);
  const int tg = (l * 2 + dir) * 32 + g;
  const float ar = WS_abar[(tg * 64 + lane) * 2], ai = WS_abar[(tg * 64 + lane) * 2 + 1];
  u4v bfrag[8];
#pragma unroll
  for (int nt = 0; nt < 8; ++nt) {
    if (g4 < 2) bfrag[nt] = *(const u4v*)(WS_bbarT + ((size_t)tg * 128 + nt * 16 + l15) * 16 + g4 * 8);
    else bfrag[nt] = (u4v){0u, 0u, 0u, 0u};
  }
  u4v cfrag[4];
#pragma unroll
  for (int ks = 0; ks < 4; ++ks) cfrag[ks] = *(const u4v*)(WS_cmT + ((size_t)tg * 16 + l15) * 128 + ks * 32 + g4 * 8);
  float xr = 0.f, xi = 0.f;
  if (latent) {
    const float* h0 = p.state_ssm + ((size_t)(((b * 2 + l) * 2 + dir) * 32 + g) * 64 + lane) * 2;
    xr = h0[0]; xi = h0[1];
  }
  u16* yd = WS_YD + (size_t)dir * TALL * 512;
  __syncthreads();
  const int nsub = L >> 4;
  u4v afn = (u4v){0u, 0u, 0u, 0u};
  if (g4 < 2) {
    const int pos = dir == 0 ? l15 : L - 1 - l15;
    afn = *(const u4v*)(WS_SU + (size_t)(tokbase + pos) * 512 + g * 16 + g4 * 8);
  }
#pragma unroll 1
  for (int sub = 0; sub < nsub; ++sub) {
    const u4v af = afn;
    if (g4 < 2 && sub + 1 < nsub) {
      const int tau = (sub + 1) * 16 + l15;
      const int pos = dir == 0 ? tau : L - 1 - tau;
      afn = *(const u4v*)(WS_SU + (size_t)(tokbase + pos) * 512 + g * 16 + g4 * 8);
    }
#pragma unroll
    for (int nt = 0; nt < 8; ++nt) {
      f4v c = (f4v){0.f, 0.f, 0.f, 0.f};
      c = __builtin_amdgcn_mfma_f32_16x16x32_bf16(bc8(af), bc8(bfrag[nt]), c, 0, 0, 0);
#pragma unroll
      for (int r = 0; r < 4; ++r) buf[(g4 * 4 + r) * 132 + nt * 16 + l15] = c[r];
    }
    __builtin_amdgcn_wave_barrier();
#pragma unroll
    for (int i = 0; i < 16; ++i) {
      const float bur = buf[i * 132 + lane], bui = buf[i * 132 + 64 + lane];
      const float nr = ar * xr - ai * xi + bur;
      const float ni = ar * xi + ai * xr + bui;
      xr = nr; xi = ni;
      buf[i * 132 + lane] = xr;
      buf[i * 132 + 64 + lane] = xi;
    }
    __builtin_amdgcn_wave_barrier();
    f4v y = (f4v){0.f, 0.f, 0.f, 0.f};
#pragma unroll
    for (int ks = 0; ks < 4; ++ks) {
      const float* bp = buf + l15 * 132 + ks * 32 + g4 * 8;
      float4 v0 = *(const float4*)(bp), v1 = *(const float4*)(bp + 4);
      const u4v xa = (u4v){pack2(v0.x, v0.y), pack2(v0.z, v0.w), pack2(v1.x, v1.y), pack2(v1.z, v1.w)};
      y = __builtin_amdgcn_mfma_f32_16x16x32_bf16(bc8(xa), bc8(cfrag[ks]), y, 0, 0, 0);
    }
#pragma unroll
    for (int r = 0; r < 4; ++r) {
      const int tau = sub * 16 + g4 * 4 + r;
      const int pos = dir == 0 ? tau : L - 1 - tau;
      yd[(size_t)(tokbase + pos) * 512 + g * 16 + l15] = f2bf(y[r]);
    }
    __builtin_amdgcn_wave_barrier();
  }
  if (!latent) {
    float* o = p.out + OUT_SSSM + ((size_t)(((b * 2 + l) * 2 + dir) * 32 + g) * 64 + lane) * 2;
    o[0] = xr; o[1] = xi;
  }
}

#define MX_S5 320
#define MX_RET 512
#define MX_NA 512
#define MX_CA 512
#define MX_RS 128
#define MX_ITEMS (MX_S5 + MX_RET + MX_NA + MX_CA + MX_RS)
__device__ __forceinline__ void mixer_item(const Params& p, char* smem, int l, int item) {
  if (item < 64) { s5_item(p, smem, l, item); return; }
  item -= 64;
  if (item < 256) { attn_item<128, 0>(p, smem, l, item); return; }
  item -= 256;
  if (item < 512) { attn_item<64, 2>(p, smem, l, item); return; }
  item -= 512;
  if (item < 256) { s5_item(p, smem, l, 64 + item); return; }
  item -= 256;
  if (item < 256) { attn_item<128, 0>(p, smem, l, 256 + item); return; }
  item -= 256;
  if (item < 512) { attn_item<64, 1>(p, smem, l, item); return; }
  item -= 512;
  retstate_item(p, l, item);
}

__device__ __forceinline__ void p3a_item(const Params& p, char* smem, int l, int item) {
  const int mt = item & 63, nt = item >> 6;
  const int m0 = mt * 128, n0 = nt * 128;
  const int tid = ltid(), lane = tid & 63, wave = tid >> 6, wm = wave >> 1, wn = wave & 1;
  AArgs a{};
  a.SU = WS_SU; a.YD0 = WS_YD; a.YD1 = WS_YD + (size_t)TALL * 512; a.dsk = p.ssm_d + l * 512;
  f16v acc[2][2];
  gemm_mainloop<2>(smem, a, WS_Wt + WT_LAYER * l + WT_GLU, 512, 512, m0, n0, acc);
#pragma unroll
  for (int mi = 0; mi < 2; ++mi)
#pragma unroll
    for (int reg = 0; reg < 16; ++reg) {
      const int row = EPI_ROW(mi, reg);
#pragma unroll
      for (int ni = 0; ni < 2; ++ni) {
        const int col = EPI_COL(ni);
        const size_t off = (size_t)row * 512 + col;
        float y = geluf_(a.dsk[col] * bf2f(WS_SU[off]) + bf2f(a.YD0[off]) + bf2f(a.YD1[off]));
        WS_sout[off] = f2bf(y * sigmoidf_(acc[mi][ni][reg]));
      }
    }
}

__device__ __forceinline__ void p3b_item(const Params& p, char* smem, int l, int item) {
  const int mt = item & 63, nt = item >> 6;
  const int m0 = mt * 128, n0 = nt * 128;
  const int tid = ltid(), lane = tid & 63, wave = tid >> 6, wm = wave >> 1, wn = wave & 1;
  int nbr = 3;
  asm volatile("" : "+s"(nbr));
#pragma unroll 1
  for (int br = 0; br < nbr; ++br) {
    const u16* Abr = br == 0 ? WS_rout : (br == 1 ? WS_sout : WS_nout);
    f16v acc[2][2];
    gemm_mainloop0(smem, Abr, 512, WS_Wt + WT_LAYER * l + WT_BR + (size_t)br * 512 * 1024, 512, 512, m0, n0, acc);
    u16* Cs = (u16*)smem;
    {
      const int rl0 = wm * 64 + 4 * (lane >> 5), cl0 = wn * 64 + (lane & 31);
#pragma unroll
      for (int mi = 0; mi < 2; ++mi)
#pragma unroll
        for (int reg = 0; reg < 16; ++reg) {
          const int rl = rl0 + mi * 32 + (reg & 3) + 8 * (reg >> 2);
          Cs[rl * CST + cl0] = f2bf(acc[mi][0][reg]);
          Cs[rl * CST + cl0 + 32] = f2bf(acc[mi][1][reg]);
        }
    }
    __syncthreads();
    int tl = tid;
    asm volatile("" : "+v"(tl));
#pragma unroll
    for (int i = 0; i < 8; ++i) {
      const int c = tl + 256 * i, r = c >> 4, ch = c & 15;
      const u4v av = *(const u4v*)(Cs + r * CST + ch * 8);
      const u4v gv = *(const u4v*)(WS_GT + (size_t)(m0 + r) * 3072 + br * 1024 + n0 + ch * 8);
      u16* mp = WS_merged + (size_t)(m0 + r) * 1024 + n0 + ch * 8;
      u4v mv = (u4v){0u, 0u, 0u, 0u};
      if (br > 0) mv = *(const u4v*)mp;
      u4v ov;
#pragma unroll
      for (int j = 0; j < 4; ++j)
        ov[j] = pack2(fmaf(bflo(gv[j]), bflo(av[j]), bflo(mv[j])), fmaf(bfhi(gv[j]), bfhi(av[j]), bfhi(mv[j])));
      *(u4v*)mp = ov;
    }
  }
}


#define CFS 132
__device__ __forceinline__ void epi_resid(char* smem, f16v (&acc)[2][2], int m0, int n0, const float* __restrict__ gvec,
                                          const float* __restrict__ xlo, const float* __restrict__ xhi,
                                          const float* __restrict__ xstats, const float* __restrict__ lng,
                                          const float* __restrict__ lnb, float* __restrict__ dst,
                                          float* __restrict__ stats_out, bool do_stats) {
  float* Cf = (float*)smem;
  const int tid = ltid(), lane = tid & 63, wave = tid >> 6, wm = wave >> 1, wn = wave & 1;
  {
    const int rl0 = wm * 64 + 4 * (lane >> 5), cl0 = wn * 64 + (lane & 31);
    const float ga = gvec[n0 + cl0], gb = gvec[n0 + cl0 + 32];
#pragma unroll
    for (int mi = 0; mi < 2; ++mi)
#pragma unroll
      for (int reg = 0; reg < 16; ++reg) {
        const int rl = rl0 + mi * 32 + (reg & 3) + 8 * (reg >> 2);
        Cf[rl * CFS + cl0] = ga * acc[mi][0][reg];
        Cf[rl * CFS + cl0 + 32] = gb * acc[mi][1][reg];
      }
  }
  __syncthreads();
  const int ch = tid & 31, r0 = tid >> 5;
  const int col = n0 + ch * 4;
  float4 g4 = make_float4(1.f, 1.f, 1.f, 1.f), b4 = make_float4(0.f, 0.f, 0.f, 0.f);
  if (xstats) { g4 = *(const float4*)(lng + col); b4 = *(const float4*)(lnb + col); }
  const float* xbase = (m0 < TCTX ? xlo + (size_t)m0 * 1024 : xhi + (size_t)(m0 - TCTX) * 1024) + col;
#pragma unroll 4
  for (int i = 0; i < 16; ++i) {
    const int r = r0 + 8 * i;
    const int row = m0 + r;
    const float4 v = *(const float4*)(Cf + r * CFS + ch * 4);
    float4 x = *(const float4*)(xbase + (size_t)r * 1024);
    if (xstats) {
      const float s = xstats[row * 2], q = xstats[row * 2 + 1];
      const float mu = s * (1.f / 1024.f);
      const float rstd = rsqrtf(fmaxf(q * (1.f / 1024.f) - mu * mu, 0.f) + LNEPS);
      x.x = (x.x - mu) * rstd * g4.x + b4.x; x.y = (x.y - mu) * rstd * g4.y + b4.y;
      x.z = (x.z - mu) * rstd * g4.z + b4.z; x.w = (x.w - mu) * rstd * g4.w + b4.w;
    }
    float4 o;
    o.x = ALPHA * x.x + v.x; o.y = ALPHA * x.y + v.y; o.z = ALPHA * x.z + v.z; o.w = ALPHA * x.w + v.w;
    *(float4*)(dst + (size_t)row * 1024 + col) = o;
    if (do_stats) {
      float ss = o.x + o.y + o.z + o.w, qq = o.x * o.x + o.y * o.y + o.z * o.z + o.w * o.w;
#pragma unroll
      for (int sh = 1; sh < 32; sh <<= 1) { ss += __shfl_xor(ss, sh); qq += __shfl_xor(qq, sh); }
      if (ch == 0) { atomicAdd(stats_out + row * 2, ss); atomicAdd(stats_out + row * 2 + 1, qq); }
    }
  }
}

__device__ __forceinline__ void p3c_item(const Params& p, char* smem, int l, int item, bool do_stats = true) {
  const int mt = item & 63, nt = item >> 6;
  const int m0 = mt * 128, n0 = nt * 128;
  const int tid = ltid(), lane = tid & 63, wave = tid >> 6, wm = wave >> 1, wn = wave & 1;
  f16v acc[2][2];
  gemm_mainloop0(smem, WS_merged, 1024, WS_Wt + WT_LAYER * l + WT_O, 1024, 1024, m0, n0, acc);
  const int ci = cond_of_row(m0);
  const float* g1 = WS_mod + (l * 5 + ci) * 6144 + 2048;
  float* st1 = WS_stats + (size_t)(l * 2 + 0) * TALL * 2;
  if (l == 0)
    epi_resid(smem, acc, m0, n0, g1, p.x_prompt, p.x_sample, nullptr, nullptr, nullptr, WS_pre1, st1, do_stats);
  else
    epi_resid(smem, acc, m0, n0, g1, p.out, p.out + (size_t)TCTX * 1024, WS_stats + (size_t)(0 * 2 + 1) * TALL * 2, p.ln2_g, p.ln2_b,
              WS_pre1, st1, do_stats);
}

__device__ __forceinline__ void p4_item(const Params& p, char* smem, int l, int item) {
  const int mt = item & 63, nt = item >> 6;
  const int m0 = mt * 128, n0 = nt * 128;
  const int tid = ltid(), lane = tid & 63, wave = tid >> 6, wm = wave >> 1, wn = wave & 1;
  f16v acc[2][2];
  gemm_mainloop0(smem, WS_h2, 1024, WS_Wt + WT_LAYER * l + WT_UP, 1024, 1024, m0, n0, acc);
  u16* Cs = (u16*)smem;
  const int rl0 = wm * 64 + 4 * (lane >> 5), cl0 = wn * 64 + (lane & 31);
#pragma unroll
  for (int mi = 0; mi < 2; ++mi)
#pragma unroll
    for (int reg = 0; reg < 16; ++reg) {
      const int rl = rl0 + mi * 32 + (reg & 3) + 8 * (reg >> 2);
      Cs[rl * CST + cl0] = f2bf(acc[mi][0][reg]);
      Cs[rl * CST + cl0 + 32] = f2bf(acc[mi][1][reg]);
    }
  __syncthreads();
  cs_store(Cs, WS_z2 + (size_t)m0 * 5632 + n0, 5632, tid);
}

__device__ __forceinline__ void p4b_item(const Params& p, int l, int item) {
  const int tid = ltid();
  if (tid >= 176) return;
  const int rb = item >> 1, hf = item & 1;
  const int j0 = (hf * 176 + tid) * 8;
  const float* cw = p.conv_w + (size_t)l * 3 * 5632;
  const float* cb = p.conv_b + (size_t)l * 5632;
  float wa[3][8], wb[3][8], ba[8], bb[8];
#pragma unroll
  for (int t = 0; t < 3; ++t)
#pragma unroll
    for (int h = 0; h < 2; ++h) {
      const float4 x = *(const float4*)(cw + t * 5632 + j0 + 4 * h), y = *(const float4*)(cw + t * 5632 + 2816 + j0 + 4 * h);
      wa[t][4 * h] = x.x; wa[t][4 * h + 1] = x.y; wa[t][4 * h + 2] = x.z; wa[t][4 * h + 3] = x.w;
      wb[t][4 * h] = y.x; wb[t][4 * h + 1] = y.y; wb[t][4 * h + 2] = y.z; wb[t][4 * h + 3] = y.w;
    }
#pragma unroll
  for (int h = 0; h < 2; ++h) {
    const float4 x = *(const float4*)(cb + j0 + 4 * h), y = *(const float4*)(cb + 2816 + j0 + 4 * h);
    ba[4 * h] = x.x; ba[4 * h + 1] = x.y; ba[4 * h + 2] = x.z; ba[4 * h + 3] = x.w;
    bb[4 * h] = y.x; bb[4 * h + 1] = y.y; bb[4 * h + 2] = y.z; bb[4 * h + 3] = y.w;
  }
  const int row0 = rb * 32;
  int pos0, L;
  if (row0 < TCTX) { pos0 = row0 & 255; L = 256; } else { pos0 = (row0 - TCTX) & 1023; L = 1024; }
  const u16* zr = WS_z2 + (size_t)row0 * 5632 + j0;
  const u4v zero = (u4v){0u, 0u, 0u, 0u};
  u4v pa = zero, pb = zero;
  if (pos0 > 0) { pa = *(const u4v*)(zr - 5632); pb = *(const u4v*)(zr - 5632 + 2816); }
  u4v ca = *(const u4v*)(zr), cb2 = *(const u4v*)(zr + 2816);
#pragma unroll 2
  for (int r = 0; r < 32; ++r) {
    u4v na = zero, nb = zero;
    if (pos0 + r < L - 1) { na = *(const u4v*)(zr + (size_t)(r + 1) * 5632); nb = *(const u4v*)(zr + (size_t)(r + 1) * 5632 + 2816); }
    u4v ov;
#pragma unroll
    for (int w = 0; w < 4; ++w) {
      const float a0 = wa[0][2 * w] * bflo(pa[w]) + wa[1][2 * w] * bflo(ca[w]) + wa[2][2 * w] * bflo(na[w]) + ba[2 * w];
      const float a1 = wa[0][2 * w + 1] * bfhi(pa[w]) + wa[1][2 * w + 1] * bfhi(ca[w]) + wa[2][2 * w + 1] * bfhi(na[w]) + ba[2 * w + 1];
      const float b0 = wb[0][2 * w] * bflo(pb[w]) + wb[1][2 * w] * bflo(cb2[w]) + wb[2][2 * w] * bflo(nb[w]) + bb[2 * w];
      const float b1 = wb[0][2 * w + 1] * bfhi(pb[w]) + wb[1][2 * w + 1] * bfhi(cb2[w]) + wb[2][2 * w + 1] * bfhi(nb[w]) + bb[2 * w + 1];
      ov[w] = pack2(geluf_(a0) * b0, geluf_(a1) * b1);
    }
    *(u4v*)(WS_act + (size_t)(row0 + r) * 2816 + j0) = ov;
    pa = ca; pb = cb2; ca = na; cb2 = nb;
  }
}

__device__ __forceinline__ void p5_item(const Params& p, char* smem, int l, int item, bool do_stats = true) {
  const int mt = item & 63, nt = item >> 6;
  const int m0 = mt * 128, n0 = nt * 128;
  const int tid = ltid(), lane = tid & 63, wave = tid >> 6, wm = wave >> 1, wn = wave & 1;
  f16v acc[2][2];
  gemm_mainloop0(smem, WS_act, 2816, WS_Wt + WT_LAYER * l + WT_DOWN, 2816, 2816, m0, n0, acc);
  const int ci = cond_of_row(m0);
  const float* g2 = WS_mod + (l * 5 + ci) * 6144 + 5 * 1024;
  epi_resid(smem, acc, m0, n0, g2, WS_pre1, WS_pre1 + (size_t)TCTX * 1024, WS_stats + (size_t)(l * 2 + 0) * TALL * 2,
            p.ln1_g + l * 1024, p.ln1_b + l * 1024, p.out, WS_stats + (size_t)(l * 2 + 1) * TALL * 2, do_stats);
}

__device__ __forceinline__ void final_item(const Params& p, int item) {
  const float* st = WS_stats + (size_t)(1 * 2 + 1) * TALL * 2;
  const int c = ltid() * 4;
  const float4 g = *(const float4*)(p.ln2_g + 1024 + c);
  const float4 b = *(const float4*)(p.ln2_b + 1024 + c);
  for (int r = 0; r < 8; ++r) {
    const int row = item * 8 + r;
    const float s = st[row * 2], q = st[row * 2 + 1];
    const float mu = s * (1.f / 1024.f);
    const float rstd = rsqrtf(fmaxf(q * (1.f / 1024.f) - mu * mu, 0.f) + LNEPS);
    float4 v = *(float4*)(p.out + (size_t)row * 1024 + c);
    v.x = (v.x - mu) * rstd * g.x + b.x;
    v.y = (v.y - mu) * rstd * g.y + b.y;
    v.z = (v.z - mu) * rstd * g.z + b.z;
    v.w = (v.w - mu) * rstd * g.w + b.w;
    *(float4*)(p.out + (size_t)row * 1024 + c) = v;
  }
}

#define XB_TMO      128
#define XB_XCNT(j)  (256  + 64 * (j))
#define XB_XSUB(j)  (1280 + 64 * (j))
#define XB_XGEN(j)  (2304 + 64 * (j))
#define XB_TOP      3328
#define XB_TOPGEN   3392
#define XCD_BAR_WORDS 3456
#define XB_SPIN_CAP (1u << 18)
#define LAS __attribute__((address_space(3)))

__device__ __forceinline__ unsigned xb_ld(unsigned* p)              { return __hip_atomic_load(p, __ATOMIC_RELAXED, __HIP_MEMORY_SCOPE_AGENT); }
__device__ __forceinline__ unsigned xb_add(unsigned* p, unsigned v) { return __hip_atomic_fetch_add(p, v, __ATOMIC_RELAXED, __HIP_MEMORY_SCOPE_AGENT); }
__device__ __forceinline__ unsigned xb_xcc_id() { return (unsigned)__builtin_amdgcn_s_getreg((3 << 11) | 20) & 0xFu; }
#define XB_SPIN(cond, bar) do { unsigned _sp = 0; while (cond) { __builtin_amdgcn_s_sleep(1); \
    if ((++_sp & 255u) == 0u) { if (xb_ld(&(bar)[XB_TMO])) break; if (_sp > XB_SPIN_CAP) { atomicAdd(&(bar)[XB_TMO], 1u); break; } } } } while (0)

struct XcdBarrier {
    unsigned* bar; unsigned x;
    volatile LAS unsigned* st;
};

__device__ __forceinline__ XcdBarrier xcd_barrier_post(unsigned* bar, volatile LAS unsigned* st) {
    XcdBarrier b; b.bar = bar; b.x = xb_xcc_id(); b.st = st;
    if (threadIdx.x == 0) (void)xb_add(&bar[XB_XCNT(b.x)], 1u);
    return b;
}
__device__ __forceinline__ void xcd_barrier_complete(unsigned* bar, unsigned x, unsigned& nloc, unsigned& nx) {
    const unsigned G = gridDim.x * gridDim.y * gridDim.z;
    unsigned sum, cnt, mine, sp = 0u;
    for (;;) {
        sum = 0u; cnt = 0u; mine = 0u;
#pragma unroll
        for (unsigned j = 0; j < 16; ++j) { const unsigned c = xb_ld(&bar[XB_XCNT(j)]); sum += c; cnt += (c > 0u) ? 1u : 0u; mine = (j == x) ? c : mine; }
        if (sum == G) break;
        __builtin_amdgcn_s_sleep(1);
        if ((++sp & 255u) == 0u) { if (xb_ld(&bar[XB_TMO])) break; if (sp > XB_SPIN_CAP) { atomicAdd(&bar[XB_TMO], 1u); break; } }
    }
    nloc = mine > 0u ? mine : 1u; nx = cnt > 0u ? cnt : 1u;
}

__device__ __forceinline__ void xcd_barrier(const XcdBarrier& b) {
    asm volatile("s_waitcnt vmcnt(0)" ::: "memory");
    __syncthreads();
    if (threadIdx.x == 0) {
        unsigned* bar = b.bar;
        __builtin_amdgcn_s_waitcnt(0);
        unsigned nloc = b.st[0], nx = b.st[1];
        if (nloc == 0u) { xcd_barrier_complete(bar, b.x, nloc, nx); b.st[0] = nloc; b.st[1] = nx; }
        const unsigned old = xb_add(&bar[XB_XSUB(b.x)], 1u);
        const unsigned gen = old / nloc;
        const unsigned top_target = (gen + 1u) * nx;
        if (old + 1u == (gen + 1u) * nloc) {
            __builtin_amdgcn_fence(__ATOMIC_RELEASE, "agent");
            asm volatile("s_waitcnt vmcnt(0)" ::: "memory");
            (void)xb_add(&bar[XB_TOP], 1u);
        }
        XB_SPIN(xb_ld(&bar[XB_TOP]) < top_target, bar);
        __builtin_amdgcn_fence(__ATOMIC_ACQUIRE, "agent");
        asm volatile("s_waitcnt vmcnt(0)" ::: "memory");
    }
    __syncthreads();
}


#define NPHASES 22
#ifndef REPMASK
#define REPMASK 0
#endif
#define REPS(PH) (((PH) == 0 ? (REPMASK >> 10) : (PH) == 21 ? (REPMASK >> 11) : (REPMASK >> (((PH) - 1) % 10))) & 1)
#define RUN_PHASE(PH, N, CALL)                                              \
  if (ph_lo <= (PH) && (PH) < ph_hi) {                                      \
    for (int rep_ = 0; rep_ <= REPS(PH); ++rep_)                            \
    for (int it = blockIdx.x; it < (N); it += nb) { CALL; }                 \
    if ((PH) + 1 < ph_hi) xcd_barrier(xb);                                  \
  }
#define RUN_GEMM_PHASE(PH, NT, CALL)                                                          \
  if (ph_lo <= (PH) && (PH) < ph_hi) {                                                        \
    const int xcd_ = blockIdx.x & 7, slot_ = blockIdx.x >> 3, spx_ = (int)gridDim.x >> 3;      \
    const int nsuper_ = 8 * (((NT) + 7) >> 3);                                                \
    for (int rep_ = 0; rep_ <= REPS(PH); ++rep_)                                              \
    for (int s_ = xcd_; s_ < nsuper_; s_ += 8)                                                \
      for (int j_ = slot_; j_ < 64; j_ += spx_) {                                             \
        const int mt_ = (s_ & 7) * 8 + (j_ & 7), nt_ = (s_ >> 3) * 8 + (j_ >> 3);             \
        if (nt_ < (NT)) { const int it = nt_ * 64 + mt_; CALL; }                              \
      }                                                                                       \
    if ((PH) + 1 < ph_hi) xcd_barrier(xb);                                                    \
  }
#define RUN_MIXER_PHASE(PH, L)                                                                \
  if (ph_lo <= (PH) && (PH) < ph_hi) {                                                        \
    for (int rep_ = 0; rep_ <= REPS(PH); ++rep_) {                                            \
      unsigned* ctr_ = (unsigned*)(p.ws + OFF_ctr) + 64 * (2 * (L) + rep_);                   \
      for (;;) {                                                                              \
        __syncthreads();                                                                      \
        if (threadIdx.x == 0) wq_item = (int)atomicAdd(ctr_, 1u);                             \
        __syncthreads();                                                                      \
        const int it = wq_item;                                                               \
        if (it >= MX_ITEMS) break;                                                            \
        mixer_item(p, smem, (L), it);                                                         \
      }                                                                                       \
    }                                                                                         \
    if ((PH) + 1 < ph_hi) xcd_barrier(xb);                                                    \
  }
#define RUN_LAYER(L)                                                         \
  RUN_PHASE(1 + 10 * (L) + 0, 1024, hmat_item(p, (L), 0, it))                \
  RUN_GEMM_PHASE(1 + 10 * (L) + 1, 56, p1_item(p, smem, (L), it))            \
  RUN_MIXER_PHASE(1 + 10 * (L) + 2, (L))                                     \
  RUN_GEMM_PHASE(1 + 10 * (L) + 3, 4, p3a_item(p, smem, (L), it))            \
  RUN_GEMM_PHASE(1 + 10 * (L) + 4, 8, p3b_item(p, smem, (L), it))            \
  RUN_GEMM_PHASE(1 + 10 * (L) + 5, 8, p3c_item(p, smem, (L), it, rep_ == 0)) \
  RUN_PHASE(1 + 10 * (L) + 6, 1024, hmat_item(p, (L), 1, it))                \
  RUN_GEMM_PHASE(1 + 10 * (L) + 7, 44, p4_item(p, smem, (L), it))            \
  RUN_PHASE(1 + 10 * (L) + 8, 512, p4b_item(p, (L), it))                     \
  RUN_GEMM_PHASE(1 + 10 * (L) + 9, 8, p5_item(p, smem, (L), it, rep_ == 0))

__global__ void __launch_bounds__(256, 2) mega(Params p, int ph_lo, int ph_hi) {
  extern __shared__ __attribute__((aligned(16))) char smem[];
  __shared__ uint4 xb_words;
  __shared__ int wq_item;
  const int nb = gridDim.x;
  if (threadIdx.x == 0) xb_words = make_uint4(0u, 0u, 0u, 0u);
  __syncthreads();
  XcdBarrier xb;
  xb.bar = (unsigned*)(p.ws + OFF_bar); xb.x = 0; xb.st = (volatile LAS unsigned*)&xb_words;
  if (ph_hi - ph_lo > 1) xb = xcd_barrier_post((unsigned*)(p.ws + OFF_bar), (volatile LAS unsigned*)&xb_words);
  if (ph_hi > 1000) cg::this_grid().sync();
  RUN_PHASE(0, P0_ITEMS, phase0_item(p, smem, it))
  RUN_LAYER(0)
  RUN_LAYER(1)
  RUN_PHASE(21, 1024, final_item(p, it))
}

extern "C" void kernel_launch(void* const* d_in, const int* in_sizes, int n_in, void* d_out, int out_size, void* d_ws,
                              size_t ws_size, hipStream_t stream) {
  Params p{};
  const float** ins = (const float**)&p;
  for (int i = 0; i < 32; ++i) ins[i] = (const float*)d_in[i];
  p.out = (float*)d_out;
  char* ws = (char*)d_ws;
  p.ws = ws;
  if (WS_TOTAL > ws_size) {
    fprintf(stderr, "kernel_launch: workspace too small (%zu needed, %zu given)\n", (size_t)WS_TOTAL, ws_size);
    return;
  }
  (void)hipMemsetAsync(ws, 0, ZERO_BYTES, stream);
#if SINGLE_LAUNCH
  static int grid_blocks = 0;
  if (!grid_blocks) {
    int dev = 0, cus = 0, per_cu = 0;
    (void)hipGetDevice(&dev);
    (void)hipDeviceGetAttribute(&cus, hipDeviceAttributeMultiprocessorCount, dev);
    (void)hipFuncSetAttribute((const void*)mega, hipFuncAttributeMaxDynamicSharedMemorySize, LDS_BYTES);
    (void)hipOccupancyMaxActiveBlocksPerMultiprocessor(&per_cu, mega, 256, LDS_BYTES);
    if (per_cu > 2) per_cu = 2;
    if (per_cu < 1) per_cu = 1;
    grid_blocks = (cus * per_cu) & ~7;
  }
  int lo = 0, hi = NPHASES;
  void* args[] = {&p, &lo, &hi};
  hipError_t e = hipLaunchCooperativeKernel((void*)mega, dim3(grid_blocks), dim3(256), args, LDS_BYTES, stream);
  if (e != hipSuccess) fprintf(stderr, "cooperative launch failed: %s (grid %d)\n", hipGetErrorString(e), grid_blocks);
#else
  for (int ph = 0; ph < NPHASES; ++ph) {
    hipLaunchKernelGGL(mega, dim3(512), dim3(256), LDS_BYTES, stream, p, ph, ph + 1);
  }
#endif
}
```

```cpp
#include <hip/hip_runtime.h>
#include <hip/hip_cooperative_groups.h>
#include <cstdio>
namespace cg = cooperative_groups;

#ifndef SINGLE_LAUNCH
#define SINGLE_LAUNCH 1
#endif

typedef __attribute__((ext_vector_type(8))) short s8v;
typedef __attribute__((ext_vector_type(4))) float f4v;
typedef __attribute__((ext_vector_type(16))) float f16v;
typedef unsigned short u16;
typedef __attribute__((ext_vector_type(4))) unsigned u4v;
__device__ __forceinline__ s8v bc8(u4v x) { return __builtin_bit_cast(s8v, x); }


#define TALL 8192
#define TCTX 4096
#define ALPHA 1.41421356237309515f
#define LNEPS 1e-5f
#define VTR_LAT 2097152
#define NVT_LAT 2097152
#define OUT_SRET 8388608
#define OUT_SSSM 12582912
#define OUT_CK 12845056
#define OUT_CV 17039360
#define WT_IN 0
#define WT_GLU (WT_IN + 7168 * 1024)
#define WT_BR (WT_GLU + 512 * 512)
#define WT_O (WT_BR + 3 * 1024 * 512)
#define WT_UP (WT_O + 1024 * 1024)
#define WT_DOWN (WT_UP + 5632 * 1024)
#define WT_LAYER ((size_t)(WT_DOWN + 1024 * 2816))

struct Params {
  const float *x_prompt, *x_sample, *state_ret, *state_ssm, *cache_k, *cache_v, *c, *c_ctx;
  const float *w_ada, *b_ada, *w_in, *ret_decay, *a_re, *a_im, *log_dt, *b_re, *b_im, *c_re, *c_im;
  const float *ssm_d, *w_glu, *rpb, *w_branch, *w_o, *ln1_g, *ln1_b, *w_up, *conv_w, *conv_b, *w_down, *ln2_g, *ln2_b;
  float* out;
  char* ws;
};

typedef __bf16 bf2v __attribute__((ext_vector_type(2)));
typedef float fl2v __attribute__((ext_vector_type(2)));
__device__ __forceinline__ unsigned pack2(float a, float b) {
  fl2v f = {a, b};
  bf2v h = __builtin_convertvector(f, bf2v);
  return __builtin_bit_cast(unsigned, h);
}
__device__ __forceinline__ u16 f2bf(float f) { return (u16)(pack2(f, 0.f) & 0xffffu); }

constexpr size_t al256(size_t x) { return (x + 255) & ~(size_t)255; }
constexpr size_t EB = (size_t)TALL * 512 * 2;
constexpr size_t OFF_mod = 0;
constexpr size_t OFF_stats = OFF_mod + al256(2 * 5 * 6144 * 4);
constexpr size_t OFF_bar = OFF_stats + al256(2 * 2 * TALL * 2 * 4);
constexpr size_t OFF_ctr = OFF_bar + al256(3456 * 4);
constexpr size_t ZERO_BYTES = OFF_ctr + al256(8 * 256);
constexpr size_t OFF_ropetab = ZERO_BYTES;
constexpr size_t OFF_abar = OFF_ropetab + al256(64 * 32 * 2 * 4);
constexpr size_t OFF_bbarT = OFF_abar + al256(2 * 2 * 32 * 64 * 2 * 4);
constexpr size_t OFF_cmT = OFF_bbarT + al256(2 * 2 * 32 * 128 * 16 * 2);
constexpr size_t OFF_CK = OFF_cmT + al256(2 * 2 * 32 * 16 * 128 * 2);
constexpr size_t OFF_CVt = OFF_CK + al256((size_t)2 * 4 * 512 * 512 * 2);
constexpr size_t OFF_S0t = OFF_CVt + al256((size_t)2 * 4 * 512 * 512 * 2);
constexpr size_t OFF_Wt = OFF_S0t + al256((size_t)2 * 4 * 2 * 4 * 128 * 128 * 2);
constexpr size_t OFF_REGION = OFF_Wt + al256(2 * WT_LAYER * 2);
constexpr size_t OFF_z2 = OFF_REGION;
constexpr size_t OFF_act = OFF_z2 + (size_t)TALL * 5632 * 2;
constexpr size_t OFF_pre1 = OFF_act + (size_t)TALL * 2816 * 2;
constexpr size_t WS_TOTAL = OFF_pre1 + (size_t)TALL * 1024 * 4;
constexpr size_t OFF_K = OFF_pre1;
constexpr size_t OFF_VtR = OFF_K + EB;
constexpr size_t OFF_NQ = OFF_VtR + EB;
constexpr size_t OFF_NK = OFF_NQ + EB;
constexpr size_t OFF_GT = OFF_REGION;
constexpr size_t OFF_rout = OFF_GT + (size_t)TALL * 3072 * 2;
constexpr size_t OFF_nout = OFF_rout + EB;
constexpr size_t OFF_YD = OFF_nout + EB;
constexpr size_t OFF_merged = OFF_YD;
constexpr size_t OFF_Q = OFF_YD + 2 * EB;
constexpr size_t OFF_sout = OFF_Q;
constexpr size_t OFF_KtR = OFF_Q + EB;
constexpr size_t OFF_G = OFF_KtR + EB / 2;
constexpr size_t OFF_SU = OFF_G + EB;
constexpr size_t OFF_NVt = OFF_SU + EB;
constexpr size_t OFF_h1 = OFF_NVt + EB;
constexpr size_t OFF_h2 = OFF_act;
static_assert(OFF_h1 + 2 * EB <= OFF_pre1, "mixer buffers overflow the z2+act area");
#define WS_h1 ((u16*)(p.ws + OFF_h1))
#define WS_h2 ((u16*)(p.ws + OFF_h2))
#define WS_mod ((float*)(p.ws + OFF_mod))
#define WS_stats ((float*)(p.ws + OFF_stats))
#define WS_ropetab ((float*)(p.ws + OFF_ropetab))
#define WS_abar ((float*)(p.ws + OFF_abar))
#define WS_pre1 ((float*)(p.ws + OFF_pre1))
#define WS_bbarT ((u16*)(p.ws + OFF_bbarT))
#define WS_cmT ((u16*)(p.ws + OFF_cmT))
#define WS_CK ((u16*)(p.ws + OFF_CK))
#define WS_CVt ((u16*)(p.ws + OFF_CVt))
#define WS_S0t ((u16*)(p.ws + OFF_S0t))
#define WS_Wt ((u16*)(p.ws + OFF_Wt))
#define WS_Q ((u16*)(p.ws + OFF_Q))
#define WS_K ((u16*)(p.ws + OFF_K))
#define WS_VtR ((u16*)(p.ws + OFF_VtR))
#define WS_KtR ((u16*)(p.ws + OFF_KtR))
#define WS_G ((u16*)(p.ws + OFF_G))
#define WS_SU ((u16*)(p.ws + OFF_SU))
#define WS_NQ ((u16*)(p.ws + OFF_NQ))
#define WS_NK ((u16*)(p.ws + OFF_NK))
#define WS_NVt ((u16*)(p.ws + OFF_NVt))
#define WS_GT ((u16*)(p.ws + OFF_GT))
#define WS_rout ((u16*)(p.ws + OFF_rout))
#define WS_sout ((u16*)(p.ws + OFF_sout))
#define WS_nout ((u16*)(p.ws + OFF_nout))
#define WS_YD ((u16*)(p.ws + OFF_YD))
#define WS_merged ((u16*)(p.ws + OFF_merged))
#define WS_z2 ((u16*)(p.ws + OFF_z2))
#define WS_act ((u16*)(p.ws + OFF_act))

__device__ __forceinline__ float bf2f(unsigned h) { return __uint_as_float((h & 0xffffu) << 16); }
__device__ __forceinline__ float bflo(unsigned w) { return __uint_as_float(w << 16); }
__device__ __forceinline__ float bfhi(unsigned w) { return __uint_as_float(w & 0xffff0000u); }
__device__ __forceinline__ float fexp_(float x) { return __builtin_amdgcn_exp2f(x * 1.4426950408889634f); }
__device__ __forceinline__ float sigmoidf_(float x) { return __builtin_amdgcn_rcpf(1.f + fexp_(-x)); }
__device__ __forceinline__ float siluf_(float x) { return x * __builtin_amdgcn_rcpf(1.f + fexp_(-x)); }
__device__ __forceinline__ float geluf_(float x) {
  const float u2 = 1.5957691216057308f * (x + 0.044715f * x * x * x);
  return x * __builtin_amdgcn_rcpf(1.f + fexp_(-u2));
}
__device__ __forceinline__ f16v zero16() {
  return (f16v){0.f, 0.f, 0.f, 0.f, 0.f, 0.f, 0.f, 0.f, 0.f, 0.f, 0.f, 0.f, 0.f, 0.f, 0.f, 0.f};
}
__device__ __forceinline__ int ltid() { int t = threadIdx.x; asm volatile("" : "+v"(t)); return t; }
__device__ __forceinline__ int cond_of_row(int row) { return row < TCTX ? 0 : 1 + ((row - TCTX) >> 10); }

struct AArgs {
  const u16* A16; int lda;
  const float* A32lo; const float* A32hi;
  const float* stats;
  const float* lng; const float* lnb;
  const float* sc; const float* sh;
  const u16* SU; const u16* YD0; const u16* YD1; const float* dsk;
};

#define GST 72
#define LDS_GEMM (2 * 2 * 128 * GST * 2)
#define LDS_BYTES LDS_GEMM

template <int AMODE>
__device__ __forceinline__ void gemm_mainloop(char* smem, const AArgs& a, const u16* __restrict__ Bt, int ldb, int K,
                                              int m0, int n0, f16v (&acc)[2][2]) {
  u16* As = (u16*)smem;
  u16* Bs = As + 2 * 128 * GST;
  const int tid = ltid(), lane = tid & 63, wave = tid >> 6;
  const int wm = wave >> 1, wn = wave & 1;
  const int crow = tid >> 3, cch = tid & 7;
  const int frow = tid >> 4, fch = tid & 15;
  float rs[8], nm[8];
  const float* srow0 = nullptr;
  const float *gsc = nullptr, *gsh = nullptr;
  __syncthreads();
  if constexpr (AMODE == 1) {
    const int ci = cond_of_row(m0);
    gsc = a.sc + ci * 6144; gsh = a.sh + ci * 6144;
#pragma unroll
    for (int i = 0; i < 8; ++i) {
      rs[i] = 1.f; nm[i] = 0.f;
      if (a.stats) {
        const int row = m0 + frow + 16 * i;
        const float s = a.stats[row * 2], q = a.stats[row * 2 + 1];
        const float mu = s * (1.f / 1024.f);
        const float var = q * (1.f / 1024.f) - mu * mu;
        rs[i] = rsqrtf(fmaxf(var, 0.f) + LNEPS);
        nm[i] = -mu * rs[i];
      }
    }
    const int row0 = m0 + frow;
    srow0 = (row0 < TCTX ? a.A32lo + (size_t)row0 * 1024 : a.A32hi + (size_t)(row0 - TCTX) * 1024) + fch * 4;
  }
  acc[0][0] = zero16(); acc[0][1] = zero16(); acc[1][0] = zero16(); acc[1][1] = zero16();

  u4v ra[12], rb[4];
  float4 q0, q1, q2, q3;
  q0 = q1 = q3 = make_float4(0.f, 0.f, 0.f, 0.f); q2 = make_float4(1.f, 1.f, 1.f, 1.f);
  const u16* brow = Bt + (size_t)(n0 + crow) * ldb + cch * 8;
  auto issue = [&](int kt) {
    if constexpr (AMODE == 1) {
      const int k = kt * 64 + fch * 4;
      q0 = *(const float4*)(gsc + k); q1 = *(const float4*)(gsh + k);
      if (a.lng) { q2 = *(const float4*)(a.lng + k); q3 = *(const float4*)(a.lnb + k); }
    } else if constexpr (AMODE == 2) {
      const int k0 = kt * 64 + cch * 8;
      q0 = *(const float4*)(a.dsk + k0); q1 = *(const float4*)(a.dsk + k0 + 4);
    }
    if constexpr (AMODE == 0) {
      const u16* ap = a.A16 + (size_t)(m0 + crow) * a.lda + kt * 64 + cch * 8;
#pragma unroll
      for (int i = 0; i < 4; ++i) ra[i] = *(const u4v*)(ap + (size_t)(32 * i) * a.lda);
    } else if constexpr (AMODE == 1) {
#pragma unroll
      for (int i = 0; i < 8; ++i) ra[i] = *(const u4v*)(srow0 + (size_t)(16 * i) * 1024 + kt * 64);
    } else {
      const size_t o = (size_t)(m0 + crow) * 512 + kt * 64 + cch * 8;
#pragma unroll
      for (int i = 0; i < 4; ++i) {
        ra[i] = *(const u4v*)(a.SU + o + (size_t)(32 * i) * 512);
        ra[4 + i] = *(const u4v*)(a.YD0 + o + (size_t)(32 * i) * 512);
        ra[8 + i] = *(const u4v*)(a.YD1 + o + (size_t)(32 * i) * 512);
      }
    }
#pragma unroll
    for (int i = 0; i < 4; ++i) rb[i] = *(const u4v*)(brow + (size_t)(32 * i) * ldb + kt * 64);
  };
  auto stage = [&](int buf, int kt) {
    u16* Ad = As + buf * (128 * GST);
    if constexpr (AMODE == 0) {
#pragma unroll
      for (int i = 0; i < 4; ++i) *(u4v*)(Ad + (crow + 32 * i) * GST + cch * 8) = ra[i];
    } else if constexpr (AMODE == 1) {
      const float4 sc = q0, sh = q1, g = q2, b = q3;
      const float G0 = g.x * (1.f + sc.x), G1 = g.y * (1.f + sc.y), G2 = g.z * (1.f + sc.z), G3 = g.w * (1.f + sc.w);
      const float B0 = fmaf(b.x, 1.f + sc.x, sh.x), B1 = fmaf(b.y, 1.f + sc.y, sh.y), B2 = fmaf(b.z, 1.f + sc.z, sh.z), B3 = fmaf(b.w, 1.f + sc.w, sh.w);
#pragma unroll
      for (int i = 0; i < 8; ++i) {
        const float h0 = fmaf(fmaf(__uint_as_float(ra[i][0]), rs[i], nm[i]), G0, B0);
        const float h1 = fmaf(fmaf(__uint_as_float(ra[i][1]), rs[i], nm[i]), G1, B1);
        const float h2 = fmaf(fmaf(__uint_as_float(ra[i][2]), rs[i], nm[i]), G2, B2);
        const float h3 = fmaf(fmaf(__uint_as_float(ra[i][3]), rs[i], nm[i]), G3, B3);
        *(uint2*)(Ad + (frow + 16 * i) * GST + fch * 4) = make_uint2(pack2(h0, h1), pack2(h2, h3));
      }
    } else {
      const float4 da = q0, db = q1;
      const float dd[8] = {da.x, da.y, da.z, da.w, db.x, db.y, db.z, db.w};
#pragma unroll
      for (int i = 0; i < 4; ++i) {
        u4v o;
#pragma unroll
        for (int j = 0; j < 4; ++j) {
          const float v0 = geluf_(dd[2 * j] * bflo(ra[i][j]) + bflo(ra[4 + i][j]) + bflo(ra[8 + i][j]));
          const float v1 = geluf_(dd[2 * j + 1] * bfhi(ra[i][j]) + bfhi(ra[4 + i][j]) + bfhi(ra[8 + i][j]));
          o[j] = pack2(v0, v1);
        }
        *(u4v*)(Ad + (crow + 32 * i) * GST + cch * 8) = o;
      }
    }
    u16* Bd = Bs + buf * (128 * GST);
#pragma unroll
    for (int i = 0; i < 4; ++i) *(u4v*)(Bd + (crow + 32 * i) * GST + cch * 8) = rb[i];
  };
  auto compute = [&](int buf) {
    const u16* Ab = As + buf * (128 * GST) + (wm * 64 + (lane & 31)) * GST + (lane >> 5) * 8;
    const u16* Bb = Bs + buf * (128 * GST) + (wn * 64 + (lane & 31)) * GST + (lane >> 5) * 8;
#pragma unroll
    for (int ks = 0; ks < 4; ++ks) {
      s8v af0 = *(const s8v*)(Ab + ks * 16);
      s8v af1 = *(const s8v*)(Ab + 32 * GST + ks * 16);
      s8v bf0 = *(const s8v*)(Bb + ks * 16);
      s8v bf1 = *(const s8v*)(Bb + 32 * GST + ks * 16);
      acc[0][0] = __builtin_amdgcn_mfma_f32_32x32x16_bf16(af0, bf0, acc[0][0], 0, 0, 0);
      acc[0][1] = __builtin_amdgcn_mfma_f32_32x32x16_bf16(af0, bf1, acc[0][1], 0, 0, 0);
      acc[1][0] = __builtin_amdgcn_mfma_f32_32x32x16_bf16(af1, bf0, acc[1][0], 0, 0, 0);
      acc[1][1] = __builtin_amdgcn_mfma_f32_32x32x16_bf16(af1, bf1, acc[1][1], 0, 0, 0);
    }
  };

  const int nk = K >> 6;
  issue(0);
  stage(0, 0);
  __syncthreads();
#pragma unroll 1
  for (int kt = 0; kt < nk; ++kt) {
    const int buf = kt & 1;
    if (kt + 1 < nk) issue(kt + 1);
    compute(buf);
    if (kt + 1 < nk) stage(buf ^ 1, kt + 1);
    __syncthreads();
  }
}

__device__ __forceinline__ void gemm_mainloop0(char* smem, const u16* __restrict__ A, int lda, const u16* __restrict__ Bt, int ldb,
                                               int K, int m0, int n0, f16v (&acc)[2][2]) {
  u16* As = (u16*)smem;
  u16* Bs = As + 2 * 128 * GST;
  const int tid = ltid(), lane = tid & 63, wave = tid >> 6;
  const int wm = wave >> 1, wn = wave & 1;
  const int crow = tid >> 3, cch = tid & 7;
  __syncthreads();
  acc[0][0] = zero16(); acc[0][1] = zero16(); acc[1][0] = zero16(); acc[1][1] = zero16();
  const u16* arow = A + (size_t)(m0 + crow) * lda + cch * 8;
  const u16* brow = Bt + (size_t)(n0 + crow) * ldb + cch * 8;
  const size_t a32 = (size_t)32 * lda, b32 = (size_t)32 * ldb;
  u4v eA0, eA1, eA2, eA3, eB0, eB1, eB2, eB3, oA0, oA1, oA2, oA3, oB0, oB1, oB2, oB3;
#define G0_ISSUE(P, kt)                                                                                   \
  { const u16* ap_ = arow + (kt) * 64; const u16* bp_ = brow + (kt) * 64;                                 \
    P##A0 = *(const u4v*)(ap_); P##A1 = *(const u4v*)(ap_ + a32); P##A2 = *(const u4v*)(ap_ + 2 * a32);   \
    P##A3 = *(const u4v*)(ap_ + 3 * a32);                                                                 \
    P##B0 = *(const u4v*)(bp_); P##B1 = *(const u4v*)(bp_ + b32); P##B2 = *(const u4v*)(bp_ + 2 * b32);   \
    P##B3 = *(const u4v*)(bp_ + 3 * b32); }
#define G0_STAGE(P, buf)                                                                                  \
  { u16* Ad_ = As + (buf) * (128 * GST) + crow * GST + cch * 8; u16* Bd_ = Bs + (buf) * (128 * GST) + crow * GST + cch * 8; \
    *(u4v*)(Ad_) = P##A0; *(u4v*)(Ad_ + 32 * GST) = P##A1; *(u4v*)(Ad_ + 64 * GST) = P##A2; *(u4v*)(Ad_ + 96 * GST) = P##A3; \
    *(u4v*)(Bd_) = P##B0; *(u4v*)(Bd_ + 32 * GST) = P##B1; *(u4v*)(Bd_ + 64 * GST) = P##B2; *(u4v*)(Bd_ + 96 * GST) = P##B3; }
#define G0_COMPUTE(buf)                                                                                   \
  { const u16* Ab = As + (buf) * (128 * GST) + (wm * 64 + (lane & 31)) * GST + (lane >> 5) * 8;           \
    const u16* Bb = Bs + (buf) * (128 * GST) + (wn * 64 + (lane & 31)) * GST + (lane >> 5) * 8;           \
    __builtin_amdgcn_s_setprio(1);                                                                        \
    _Pragma("unroll") for (int ks = 0; ks < 4; ++ks) {                                                    \
      s8v af0 = *(const s8v*)(Ab + ks * 16);                                                              \
      s8v af1 = *(const s8v*)(Ab + 32 * GST + ks * 16);                                                   \
      s8v bf0 = *(const s8v*)(Bb + ks * 16);                                                              \
      s8v bf1 = *(const s8v*)(Bb + 32 * GST + ks * 16);                                                   \
      acc[0][0] = __builtin_amdgcn_mfma_f32_32x32x16_bf16(af0, bf0, acc[0][0], 0, 0, 0);                  \
      acc[0][1] = __builtin_amdgcn_mfma_f32_32x32x16_bf16(af0, bf1, acc[0][1], 0, 0, 0);                  \
      acc[1][0] = __builtin_amdgcn_mfma_f32_32x32x16_bf16(af1, bf0, acc[1][0], 0, 0, 0);                  \
      acc[1][1] = __builtin_amdgcn_mfma_f32_32x32x16_bf16(af1, bf1, acc[1][1], 0, 0, 0);                  \
    }                                                                                                     \
    __builtin_amdgcn_s_setprio(0); }
  const int nk = K >> 6;
  G0_ISSUE(e, 0)
  G0_ISSUE(o, 1)
  G0_STAGE(e, 0)
  __syncthreads();
  int kt = 0;
#pragma unroll 1
  for (; kt + 3 < nk; kt += 2) {
    G0_ISSUE(e, kt + 2)
    __builtin_amdgcn_sched_barrier(0);
    G0_COMPUTE(0)
    G0_STAGE(o, 1)
    __syncthreads();
    G0_ISSUE(o, kt + 3)
    __builtin_amdgcn_sched_barrier(0);
    G0_COMPUTE(1)
    G0_STAGE(e, 0)
    __syncthreads();
  }
  G0_COMPUTE(0)
  G0_STAGE(o, 1)
  __syncthreads();
  G0_COMPUTE(1)
  __syncthreads();
#undef G0_ISSUE
#undef G0_STAGE
#undef G0_COMPUTE
}

#define EPI_ROW(mi, reg) (m0 + wm * 64 + (mi) * 32 + ((reg) & 3) + 8 * ((reg) >> 2) + 4 * (lane >> 5))
#define EPI_COL(ni) (n0 + wn * 64 + (ni) * 32 + (lane & 31))


#define CST 136
__device__ __forceinline__ void cs_store(const u16* Cs, u16* __restrict__ dst, size_t ld, int tid) {
#pragma unroll
  for (int i = 0; i < 8; ++i) {
    const int c = tid + 256 * i, r = c >> 4, ch = c & 15;
    *(u4v*)(dst + (size_t)r * ld + ch * 8) = *(const u4v*)(Cs + r * CST + ch * 8);
  }
}

__device__ __forceinline__ void stats_accum(float* stats, int row, float v0, float v1, int lane) {
  float s = v0 + v1, q = v0 * v0 + v1 * v1;
#pragma unroll
  for (int o = 1; o < 32; o <<= 1) {
    s += __shfl_xor(s, o);
    q += __shfl_xor(q, o);
  }
  if ((lane & 31) == 0) {
    atomicAdd(stats + row * 2, s);
    atomicAdd(stats + row * 2 + 1, q);
  }
}

#define P0_ADA 768
#define P0_ROPE 1
#define P0_CACHE 64
#define P0_S0 64
#define P0_S5 128
#define P0_WT_PER_LAYER (16 * 112 + 8 * 8 + 3 * 8 * 16 + 16 * 16 + 16 * 88 + 44 * 16)
#define P0_WT (2 * P0_WT_PER_LAYER)
#define P0_ITEMS (P0_ADA + P0_ROPE + P0_CACHE + P0_S0 + P0_S5 + P0_WT)

__device__ __forceinline__ void wt_tile(const float* __restrict__ src, int N, u16* __restrict__ dst, int ldd, int kt, int nt, char* smem) {
  float* tile = (float*)smem;
  const int tid = ltid();
  __syncthreads();
  {
    const int c4 = (tid & 15) * 4, r0 = tid >> 4;
#pragma unroll
    for (int i = 0; i < 4; ++i) {
      const int k = r0 + 16 * i;
      const float4 v = *(const float4*)(src + (size_t)(kt * 64 + k) * N + nt * 64 + c4);
      tile[k * 65 + c4] = v.x; tile[k * 65 + c4 + 1] = v.y; tile[k * 65 + c4 + 2] = v.z; tile[k * 65 + c4 + 3] = v.w;
    }
  }
  __syncthreads();
  {
    const int n = tid >> 2, k0 = (tid & 3) * 16;
#define WTP(j) pack2(tile[(k0 + 2 * (j)) * 65 + n], tile[(k0 + 2 * (j) + 1) * 65 + n])
    u4v* d = (u4v*)(dst + (size_t)(nt * 64 + n) * ldd + kt * 64 + k0);
    d[0] = (u4v){WTP(0), WTP(1), WTP(2), WTP(3)};
    d[1] = (u4v){WTP(4), WTP(5), WTP(6), WTP(7)};
#undef WTP
  }
}
__device__ __forceinline__ void wt_item(const Params& p, char* smem, int item) {
  const int l = item / P0_WT_PER_LAYER;
  int it = item % P0_WT_PER_LAYER;
  u16* base = WS_Wt + WT_LAYER * l;
  if (it < 16 * 112) { wt_tile(p.w_in + (size_t)l * 1024 * 7168, 7168, base + WT_IN, 1024, it / 112, it % 112, smem); return; }
  it -= 16 * 112;
  if (it < 64) { wt_tile(p.w_glu + (size_t)l * 512 * 512, 512, base + WT_GLU, 512, it / 8, it % 8, smem); return; }
  it -= 64;
  if (it < 384) { const int br = it / 128; it %= 128;
    wt_tile(p.w_branch + ((size_t)l * 3 + br) * 512 * 1024, 1024, base + WT_BR + (size_t)br * 512 * 1024, 512, it / 16, it % 16, smem); return; }
  it -= 384;
  if (it < 256) { wt_tile(p.w_o + (size_t)l * 1024 * 1024, 1024, base + WT_O, 1024, it / 16, it % 16, smem); return; }
  it -= 256;
  if (it < 16 * 88) { wt_tile(p.w_up + (size_t)l * 1024 * 5632, 5632, base + WT_UP, 1024, it / 88, it % 88, smem); return; }
  it -= 16 * 88;
  wt_tile(p.w_down + (size_t)l * 2816 * 1024, 1024, base + WT_DOWN, 2816, it / 16, it % 16, smem);
}

__device__ __forceinline__ void phase0_item(const Params& p, char* smem, int item) {
  const int tid = ltid();
  if (item < P0_ADA) {
    const int ks = item & 3, cg = (item >> 2) % 96, l = item / 384;
    float* scs = (float*)smem;
    float* red = scs + 5 * 256;
    __syncthreads();
    for (int i = tid; i < 5 * 256; i += 256) {
      int ci = i >> 8, k = ks * 256 + (i & 255);
      float v = ci == 0 ? p.c_ctx[k] : p.c[(ci - 1) * 1024 + k];
      scs[i] = siluf_(v);
    }
    __syncthreads();
    const int ct = tid & 15, kg = tid >> 4;
    const float* wp = p.w_ada + (size_t)l * 1024 * 6144 + (size_t)(ks * 256 + kg * 16) * 6144 + cg * 64 + ct * 4;
    float acc[5][4];
#pragma unroll
    for (int i = 0; i < 5; ++i)
#pragma unroll
      for (int j = 0; j < 4; ++j) acc[i][j] = 0.f;
#pragma unroll 4
    for (int k = 0; k < 16; ++k) {
      float4 w = *(const float4*)(wp + (size_t)k * 6144);
#pragma unroll
      for (int ci = 0; ci < 5; ++ci) {
        float s = scs[ci * 256 + kg * 16 + k];
        acc[ci][0] += s * w.x; acc[ci][1] += s * w.y; acc[ci][2] += s * w.z; acc[ci][3] += s * w.w;
      }
    }
#pragma unroll
    for (int ci = 0; ci < 5; ++ci)
#pragma unroll
      for (int j = 0; j < 4; ++j) red[(kg * 5 + ci) * 64 + ct * 4 + j] = acc[ci][j];
    __syncthreads();
    for (int i = tid; i < 320; i += 256) {
      int ci = i >> 6, col = i & 63;
      float s = 0.f;
#pragma unroll
      for (int g = 0; g < 16; ++g) s += red[(g * 5 + ci) * 64 + col];
      if (ks == 0) s += p.b_ada[l * 6144 + cg * 64 + col];
      atomicAdd(WS_mod + (l * 5 + ci) * 6144 + cg * 64 + col, s);
    }
    return;
  }
  item -= P0_ADA;
  if (item < P0_ROPE) {
    for (int i = tid; i < 64 * 32; i += 256) {
      int pos = i >> 5, fi = i & 31;
      float inv = (float)pow(10000.0, -(double)fi / 32.0);
      float ang = (float)pos * inv;
      WS_ropetab[i * 2] = (float)cos((double)ang);
      WS_ropetab[i * 2 + 1] = (float)sin((double)ang);
    }
    return;
  }
  item -= P0_ROPE;
  if (item < P0_CACHE) {
    const int pc = item & 7, b = (item >> 3) & 3, l = item >> 5;
    const float* ksrc = p.cache_k + ((size_t)(b * 2 + l) * 512 + pc * 64) * 512;
    const float* vsrc = p.cache_v + ((size_t)(b * 2 + l) * 512 + pc * 64) * 512;
    u16* kdst = WS_CK + ((size_t)(l * 4 + b) * 512 + pc * 64) * 512;
    for (int i = tid; i < 64 * 512 / 4; i += 256) {
      float4 v = *(const float4*)(ksrc + (size_t)i * 4);
      *(uint2*)(kdst + (size_t)i * 4) = make_uint2(pack2(v.x, v.y), pack2(v.z, v.w));
    }
    for (int cc = 0; cc < 2; ++cc) {
      const int col = tid + cc * 256;
      u16* vdst = WS_CVt + ((size_t)(l * 4 + b) * 512 + col) * 512 + pc * 64;
      for (int j = 0; j < 8; ++j) {
        float v[8];
#pragma unroll
        for (int e = 0; e < 8; ++e) v[e] = vsrc[(size_t)(j * 8 + e) * 512 + col];
        *(uint4*)(vdst + j * 8) = make_uint4(pack2(v[0], v[1]), pack2(v[2], v[3]), pack2(v[4], v[5]), pack2(v[6], v[7]));
      }
    }
    return;
  }
  item -= P0_CACHE;
  if (item < P0_S0) {
    const int hh = item & 3, dir = (item >> 2) & 1, b = (item >> 3) & 3, l = item >> 5;
    const float* src = p.state_ret + ((size_t)(((b * 2 + l) * 2 + dir) * 4 + hh)) * 16384;
    u16* dst = WS_S0t + ((size_t)(((l * 4 + b) * 2 + dir) * 4 + hh)) * 16384;
    const int dv = tid & 127, kh = tid >> 7;
    for (int j = 0; j < 8; ++j) {
      const int dk0 = kh * 64 + j * 8;
      float v[8];
#pragma unroll
      for (int e = 0; e < 8; ++e) v[e] = src[(size_t)(dk0 + e) * 128 + dv];
      *(uint4*)(dst + (size_t)dv * 128 + dk0) = make_uint4(pack2(v[0], v[1]), pack2(v[2], v[3]), pack2(v[4], v[5]), pack2(v[6], v[7]));
    }
    return;
  }
  item -= P0_S0;
  if (item >= P0_S5) { wt_item(p, smem, item - P0_S5); return; }
  {
    const int g = item & 31, dir = (item >> 5) & 1, l = item >> 6;
    if (tid < 64) {
      const int pp = tid;
      const int ai = ((l * 2 + dir) * 32 + g) * 64 + pp;
      double lre = fmin((double)p.a_re[ai], -1e-4), lim = (double)p.a_im[ai];
      double dt = exp((double)p.log_dt[(l * 2 + dir) * 32 + g]);
      double er = exp(lre * dt);
      double abr = er * cos(lim * dt), abi = er * sin(lim * dt);
      WS_abar[ai * 2] = (float)abr;
      WS_abar[ai * 2 + 1] = (float)abi;
      double nr = abr - 1.0, ni = abi;
      double den = lre * lre + lim * lim;
      double cr = (nr * lre + ni * lim) / den, cim = (ni * lre - nr * lim) / den;
      u16* bt = WS_bbarT + (size_t)((l * 2 + dir) * 32 + g) * 128 * 16;
      const float* br = p.b_re + ((size_t)(l * 32 + g) * 64 + pp) * 16;
      const float* bi = p.b_im + ((size_t)(l * 32 + g) * 64 + pp) * 16;
      for (int c = 0; c < 16; ++c) {
        double xr = br[c], xi = bi[c];
        bt[pp * 16 + c] = f2bf((float)(cr * xr - cim * xi));
        bt[(64 + pp) * 16 + c] = f2bf((float)(cr * xi + cim * xr));
      }
      u16* ct = WS_cmT + (size_t)((l * 2 + dir) * 32 + g) * 16 * 128;
      const float* cre = p.c_re + ((size_t)((l * 2 + dir) * 32 + g) * 16) * 64;
      const float* cie = p.c_im + ((size_t)((l * 2 + dir) * 32 + g) * 16) * 64;
      for (int c = 0; c < 16; ++c) {
        ct[c * 128 + pp] = f2bf(cre[c * 64 + pp]);
        ct[c * 128 + 64 + pp] = f2bf(-cie[c * 64 + pp]);
      }
    }
  }
}


__device__ __forceinline__ void hmat_item(const Params& p, int l, int which, int item) {
  const int c = ltid() * 4;
  const int row0 = item * 8;
  const int ci = cond_of_row(row0);
  const float* mod = WS_mod + (l * 5 + ci) * 6144;
  const float4 sc = *(const float4*)(mod + (which ? 4 : 1) * 1024 + c);
  const float4 sh = *(const float4*)(mod + (which ? 3 : 0) * 1024 + c);
  float4 g = make_float4(1.f, 1.f, 1.f, 1.f), b = make_float4(0.f, 0.f, 0.f, 0.f);
  const float* st = nullptr;
  if (which == 1) { g = *(const float4*)(p.ln1_g + l * 1024 + c); b = *(const float4*)(p.ln1_b + l * 1024 + c); st = WS_stats + (size_t)(l * 2 + 0) * TALL * 2; }
  else if (l == 1) { g = *(const float4*)(p.ln2_g + c); b = *(const float4*)(p.ln2_b + c); st = WS_stats + (size_t)(0 * 2 + 1) * TALL * 2; }
  const float G0 = g.x * (1.f + sc.x), G1 = g.y * (1.f + sc.y), G2 = g.z * (1.f + sc.z), G3 = g.w * (1.f + sc.w);
  const float B0 = fmaf(b.x, 1.f + sc.x, sh.x), B1 = fmaf(b.y, 1.f + sc.y, sh.y), B2 = fmaf(b.z, 1.f + sc.z, sh.z), B3 = fmaf(b.w, 1.f + sc.w, sh.w);
  u16* dst = which ? WS_h2 : WS_h1;
#pragma unroll
  for (int r = 0; r < 8; ++r) {
    const int row = row0 + r;
    const float* src;
    if (which == 1) src = WS_pre1 + (size_t)row * 1024;
    else if (l == 1) src = p.out + (size_t)row * 1024;
    else src = row < TCTX ? p.x_prompt + (size_t)row * 1024 : p.x_sample + (size_t)(row - TCTX) * 1024;
    float rs = 1.f, nm = 0.f;
    if (st) {
      const float s = st[row * 2], q = st[row * 2 + 1];
      const float mu = s * (1.f / 1024.f);
      rs = rsqrtf(fmaxf(q * (1.f / 1024.f) - mu * mu, 0.f) + LNEPS);
      nm = -mu * rs;
    }
    const float4 x = *(const float4*)(src + c);
    const float h0 = fmaf(fmaf(x.x, rs, nm), G0, B0), h1 = fmaf(fmaf(x.y, rs, nm), G1, B1);
    const float h2 = fmaf(fmaf(x.z, rs, nm), G2, B2), h3 = fmaf(fmaf(x.w, rs, nm), G3, B3);
    *(uint2*)(dst + (size_t)row * 1024 + c) = make_uint2(pack2(h0, h1), pack2(h2, h3));
  }
}

__device__ __forceinline__ void p1_item(const Params& p, char* smem, int l, int item) {
  const int mt = item & 63, nt = item >> 6;
  const int m0 = mt * 128, n0 = nt * 128;
  const int tid = ltid(), lane = tid & 63, wave = tid >> 6, wm = wave >> 1, wn = wave & 1;
  f16v acc[2][2];
  gemm_mainloop0(smem, WS_h1, 1024, WS_Wt + WT_LAYER * l + WT_IN, 1024, 1024, m0, n0, acc);

  const bool latent = m0 >= TCTX;
  const int seg = n0 >> 9;
  const int cs0 = n0 & 511;
  const int l31 = lane & 31;
  u16* Cs = (u16*)smem;
  u16* CsT = Cs + 128 * CST;
  const int rl0 = wm * 64 + 4 * (lane >> 5);
  const int cl0 = wn * 64 + l31;
  const bool want_rm = !(seg == 2 || seg == 7);
  const bool want_t = (seg == 2 || seg == 7 || (seg == 1 && !latent));
#pragma unroll
  for (int mi = 0; mi < 2; ++mi)
#pragma unroll
    for (int q = 0; q < 4; ++q) {
      float o0[4], o1[4];
#pragma unroll
      for (int j = 0; j < 4; ++j) {
        const int reg = q * 4 + j;
        float x1 = acc[mi][0][reg], x2 = acc[mi][1][reg];
        if (seg <= 1) {
          if (latent) {
            const int pos = (m0 - TCTX + rl0 + mi * 32 + q * 8 + j) & 1023;
            const int pidx = ((cs0 + wn * 64) & 64) ? (pos & 63) : (pos >> 6);
            const float cs = WS_ropetab[(pidx * 32 + l31) * 2], sn = WS_ropetab[(pidx * 32 + l31) * 2 + 1];
            const float t1 = x1 * cs - x2 * sn, t2 = x1 * sn + x2 * cs;
            x1 = t1; x2 = t2;
          }
          if (seg == 1) { x1 *= 0.08838834764831845f; x2 *= 0.08838834764831845f; }
        } else if (seg == 3) { x1 = siluf_(x1); x2 = siluf_(x2); }
        else if (seg == 5) { x1 *= 0.125f; x2 *= 0.125f; }
        else if (seg >= 8) { x1 = sigmoidf_(x1); x2 = sigmoidf_(x2); }
        o0[j] = x1; o1[j] = x2;
        if (want_rm) {
          const int rl = rl0 + mi * 32 + q * 8 + j;
          Cs[rl * CST + cl0] = f2bf(x1);
          Cs[rl * CST + cl0 + 32] = f2bf(x2);
        }
        if ((seg == 6 || seg == 7) && !latent) {
          const int row = m0 + rl0 + mi * 32 + q * 8 + j;
          float* o = p.out + (seg == 6 ? OUT_CK : OUT_CV) + ((size_t)((row >> 8) * 2 + l) * 256 + (row & 255)) * 512 + cs0 + cl0;
          o[0] = acc[mi][0][reg]; o[32] = acc[mi][1][reg];
        }
      }
      if (want_t) {
        const int rl = rl0 + mi * 32 + q * 8;
        *(uint2*)(CsT + cl0 * CST + rl) = make_uint2(pack2(o0[0], o0[1]), pack2(o0[2], o0[3]));
        *(uint2*)(CsT + (cl0 + 32) * CST + rl) = make_uint2(pack2(o1[0], o1[1]), pack2(o1[2], o1[3]));
      }
    }
  __syncthreads();
  if (want_rm) {
    u16* dst;
    size_t ld = 512;
    if (seg >= 8) { dst = WS_GT + (size_t)m0 * 3072 + (n0 - 4096); ld = 3072; }
    else {
      u16* base = seg == 0 ? WS_Q : seg == 1 ? WS_K : seg == 3 ? WS_G : seg == 4 ? WS_SU : seg == 5 ? WS_NQ : WS_NK;
      dst = base + (size_t)m0 * 512 + cs0;
    }
    cs_store(Cs, dst, ld, tid);
  }
  if (want_t) {
    u16* base = seg == 2 ? WS_VtR : seg == 7 ? WS_NVt : WS_KtR;
    u16* dst;
    size_t ld;
    if (!latent) { dst = base + ((size_t)(m0 >> 8) * 512 + cs0) * 256 + (m0 & 255); ld = 256; }
    else { dst = base + VTR_LAT + ((size_t)((m0 - TCTX) >> 10) * 512 + cs0) * 1024 + ((m0 - TCTX) & 1023); ld = 1024; }
    cs_store(CsT, dst, ld, tid);
  }
}

template <int D, int MODE>
__device__ __forceinline__ void attn_item(const Params& p, char* smem, int l, int idx) {
  constexpr int KSTR = D + 8;
  constexpr int NKS = D / 32;
  constexpr int NB = D / 16;
  constexpr int NCH = D / 32;
  u16* Ks = (u16*)smem;
  u16* Vts = Ks + 64 * KSTR;
  float* rpbs = (float*)(Vts + D * 72);
  const int tid = ltid(), lane = tid & 63, wave = tid >> 6;
  const int l15 = lane & 15, g = lane >> 4;
  const int wave_u = __builtin_amdgcn_readfirstlane(wave);

  int b, hh, qt, L, tokbase, nt;
  bool latent = false;
  int kr0 = 0, rrow = 0;
  if constexpr (MODE == 0) {
    if (idx < 256) { latent = true; b = idx >> 6; hh = (idx >> 4) & 3; qt = idx & 15; L = 1024; tokbase = TCTX + b * 1024; nt = 16 + 4; }
    else { idx -= 256; b = idx >> 4; hh = (idx >> 2) & 3; qt = idx & 3; L = 256; tokbase = b * 256; nt = 4; }
  } else if constexpr (MODE == 1) {
    b = idx >> 5; hh = (idx >> 2) & 7; qt = idx & 3; L = 256; tokbase = b * 256; nt = 4;
  } else {
    b = idx >> 7; hh = (idx >> 4) & 7; qt = idx & 15; rrow = qt; L = 1024; tokbase = TCTX + b * 1024; nt = 16; latent = true;
    kr0 = min(max(rrow - 4, 0), 8);
  }
  const int tq = qt * 64 + wave * 16 + l15;
  const int qtok = tokbase + tq;

  float lgf2 = 0.f, lgb2 = 0.f;
  if constexpr (MODE == 0) {
    float xf = p.ret_decay[(l * 2 + 0) * 4 + hh], xb = p.ret_decay[(l * 2 + 1) * 4 + hh];
    lgf2 = -log1pf(expf(-xf)) * 1.4426950408889634f;
    lgb2 = -log1pf(expf(-xb)) * 1.4426950408889634f;
  }
  float cfw[4][4], cbw[4][4];
  if constexpr (MODE == 0) {
#pragma unroll
    for (int kb = 0; kb < 4; ++kb)
#pragma unroll
      for (int r = 0; r < 4; ++r) {
        const float off = (float)(kb * 16 + g * 4 + r);
        cfw[kb][r] = __builtin_amdgcn_exp2f(-lgf2 * off);
        cbw[kb][r] = __builtin_amdgcn_exp2f(lgb2 * off);
      }
  }

  __syncthreads();
  if constexpr (MODE == 2) {
    for (int i = tid; i < 465; i += 256) rpbs[i] = p.rpb[(size_t)(l * 8 + hh) * 465 + i];
  }

  u4v qf[NKS];
  {
    const u16* qb = (MODE == 0 ? WS_Q : WS_NQ) + (size_t)qtok * 512 + hh * D + g * 8;
#pragma unroll
    for (int ks = 0; ks < NKS; ++ks) qf[ks] = *(const u4v*)(qb + ks * 32);
  }

  f4v ot[NB];
#pragma unroll
  for (int nb = 0; nb < NB; ++nb) ot[nb] = (f4v){0.f, 0.f, 0.f, 0.f};
  float mrun = -1e30f, lsum = 0.f;

  const int ntk = (MODE == 0) ? (L >> 6) : nt;
  u4v kr[NCH], vr[NCH];
#define ATTN_ISSUE(KT)                                                                                   \
  {                                                                                                      \
    const int kt_ = (KT);                                                                                \
    const u16* kp; const u16* vp; int ldv;                                                               \
    if constexpr (MODE == 0) {                                                                           \
      kp = WS_K + (size_t)(tokbase + kt_ * 64) * 512 + hh * 128;                                          \
      if (latent) { vp = WS_VtR + VTR_LAT + ((size_t)(b * 4 + hh) * 128) * 1024 + kt_ * 64; ldv = 1024; } \
      else { vp = WS_VtR + ((size_t)(b * 4 + hh) * 128) * 256 + kt_ * 64; ldv = 256; }                    \
    } else if constexpr (MODE == 1) {                                                                    \
      kp = WS_NK + (size_t)(tokbase + kt_ * 64) * 512 + hh * 64;                                          \
      vp = WS_NVt + ((size_t)(b * 8 + hh) * 64) * 256 + kt_ * 64; ldv = 256;                              \
    } else {                                                                                             \
      if (kt_ < 8) {                                                                                     \
        const int krow = kr0 + kt_;                                                                      \
        kp = WS_NK + (size_t)(tokbase + krow * 64) * 512 + hh * 64;                                       \
        vp = WS_NVt + NVT_LAT + ((size_t)(b * 8 + hh) * 64) * 1024 + krow * 64; ldv = 1024;               \
      } else {                                                                                           \
        kp = WS_CK + ((size_t)(l * 4 + b) * 512 + (kt_ - 8) * 64) * 512 + hh * 64;                        \
        vp = WS_CVt + ((size_t)((l * 4 + b) * 8 + hh) * 64) * 512 + (kt_ - 8) * 64; ldv = 512;            \
      }                                                                                                  \
    }                                                                                                    \
    _Pragma("unroll") for (int i = 0; i < NCH; ++i) {                                                    \
      const int c = tid + 256 * i;                                                                       \
      const int r = c / (D / 8), cc = c % (D / 8);                                                       \
      kr[i] = *(const u4v*)(kp + (size_t)r * 512 + cc * 8);                                              \
      const int vrw = c >> 3, vc = c & 7;                                                                \
      vr[i] = *(const u4v*)(vp + (size_t)vrw * ldv + vc * 8);                                            \
    }                                                                                                    \
  }
#define ATTN_STAGE()                                                                                     \
  {                                                                                                      \
    _Pragma("unroll") for (int i = 0; i < NCH; ++i) {                                                    \
      const int c = tid + 256 * i;                                                                       \
      const int r = c / (D / 8), cc = c % (D / 8);                                                       \
      *(u4v*)(Ks + r * KSTR + cc * 8) = kr[i];                                                           \
      const int vrw = c >> 3, vc = c & 7;                                                                \
      *(u4v*)(Vts + vrw * 72 + vc * 8) = vr[i];                                                          \
    }                                                                                                    \
  }

  ATTN_ISSUE(0)
#pragma unroll 1
  for (int kt = 0; kt < ntk; ++kt) {
    __syncthreads();
    ATTN_STAGE()
    __syncthreads();
    if (kt + 1 < ntk) ATTN_ISSUE(kt + 1)
    f4v st[4];
    int kb_lo = 0, kb_hi = 3;
    if constexpr (MODE == 2) {
      if (kt < 8) { kb_lo = wave_u >= 2 ? wave_u - 1 : 0; kb_hi = wave_u <= 1 ? wave_u + 1 : 3; }
    }
#pragma unroll
    for (int kb = 0; kb < 4; ++kb) {
      st[kb] = (f4v){0.f, 0.f, 0.f, 0.f};
      if (MODE != 2 || (kb >= kb_lo && kb <= kb_hi)) {
#pragma unroll
        for (int ks = 0; ks < NKS; ++ks) {
          s8v kf = *(const s8v*)(Ks + (kb * 16 + l15) * KSTR + ks * 32 + g * 8);
          st[kb] = __builtin_amdgcn_mfma_f32_16x16x32_bf16(kf, bc8(qf[ks]), st[kb], 0, 0, 0);
        }
      }
    }
    if constexpr (MODE == 0) {
      if (kt < qt) {
        const float rowf = __builtin_amdgcn_exp2f(lgf2 * (float)(tq - kt * 64));
#pragma unroll
        for (int kb = 0; kb < 4; ++kb)
#pragma unroll
          for (int r = 0; r < 4; ++r) st[kb][r] *= rowf * cfw[kb][r];
      } else if (kt > qt) {
        const float rowb = __builtin_amdgcn_exp2f(lgb2 * (float)(kt * 64 - tq));
#pragma unroll
        for (int kb = 0; kb < 4; ++kb)
#pragma unroll
          for (int r = 0; r < 4; ++r) st[kb][r] *= rowb * cbw[kb][r];
      } else {
#pragma unroll
        for (int kb = 0; kb < 4; ++kb)
#pragma unroll
          for (int r = 0; r < 4; ++r) {
            const int ts = kt * 64 + kb * 16 + g * 4 + r;
            const int d = tq - ts;
            float dec = d > 0 ? __builtin_amdgcn_exp2f(lgf2 * (float)d) : (d < 0 ? __builtin_amdgcn_exp2f(lgb2 * (float)(-d)) : 2.f);
            st[kb][r] *= dec;
          }
      }
    } else {
      if constexpr (MODE == 2) {
        if (kt < 8) {
          const int qc = wave * 16 + l15;
          const int ws = min(max(qc - 8, 0), 48);
          const int roff = (kr0 + kt) - rrow + 7;
#pragma unroll
          for (int kb = 0; kb < 4; ++kb) {
            if (kb >= kb_lo && kb <= kb_hi) {
#pragma unroll
              for (int r = 0; r < 4; ++r) {
                const int kc = kb * 16 + g * 4 + r;
                const bool valid = (kc >= ws) && (kc < ws + 16);
                const int coff = min(max(kc - qc + 15, 0), 30);
                const float bias = rpbs[roff * 31 + coff];
                st[kb][r] = valid ? st[kb][r] + bias : -1e30f;
              }
            } else {
              st[kb] = (f4v){-1e30f, -1e30f, -1e30f, -1e30f};
            }
          }
        }
      }
      float tmax = st[0][0];
#pragma unroll
      for (int kb = 0; kb < 4; ++kb)
#pragma unroll
        for (int r = 0; r < 4; ++r) tmax = fmaxf(tmax, st[kb][r]);
      tmax = fmaxf(tmax, __shfl_xor(tmax, 16));
      tmax = fmaxf(tmax, __shfl_xor(tmax, 32));
      const float mnew = fmaxf(mrun, tmax);
      const float alpha = __expf(mrun - mnew);
      float ps = 0.f;
#pragma unroll
      for (int kb = 0; kb < 4; ++kb) {
        if (MODE != 2 || (kb >= kb_lo && kb <= kb_hi)) {
#pragma unroll
          for (int r = 0; r < 4; ++r) {
            float e = __expf(st[kb][r] - mnew);
            st[kb][r] = e;
            ps += e;
          }
        } else {
          st[kb] = (f4v){0.f, 0.f, 0.f, 0.f};
        }
      }
      lsum = lsum * alpha + ps;
      mrun = mnew;
#pragma unroll
      for (int nb = 0; nb < NB; ++nb) ot[nb] *= alpha;
    }
    u4v pf[2];
#pragma unroll
    for (int s = 0; s < 2; ++s) {
      pf[s] = (u4v){pack2(st[2 * s][0], st[2 * s][1]), pack2(st[2 * s][2], st[2 * s][3]),
                    pack2(st[2 * s + 1][0], st[2 * s + 1][1]), pack2(st[2 * s + 1][2], st[2 * s + 1][3])};
    }
#pragma unroll
    for (int s = 0; s < 2; ++s) {
      if (MODE == 2 && (2 * s + 1 < kb_lo || 2 * s > kb_hi)) continue;
#pragma unroll
      for (int nb = 0; nb < NB; ++nb) {
        const u16* vb = Vts + (nb * 16 + l15) * 72 + s * 32 + g * 4;
        uint2 lo = *(const uint2*)(vb);
        uint2 hi = *(const uint2*)(vb + 16);
        u4v vf = (u4v){lo.x, lo.y, hi.x, hi.y};
        ot[nb] = __builtin_amdgcn_mfma_f32_16x16x32_bf16(bc8(vf), bc8(pf[s]), ot[nb], 0, 0, 0);
      }
    }
  }

  if constexpr (MODE == 0) {
    if (latent) {
#pragma unroll 1
      for (int dir = 0; dir < 2; ++dir) {
        const float scale = dir == 0 ? __builtin_amdgcn_exp2f(lgf2 * (float)(tq + 1)) : __builtin_amdgcn_exp2f(lgb2 * (float)(L - tq));
        const u16* S0 = WS_S0t + ((size_t)(((l * 4 + b) * 2 + dir) * 4 + hh)) * 16384;
#pragma unroll
        for (int s = 0; s < NKS; ++s) {
          u4v pq = (u4v){pack2(bflo(qf[s][0]) * scale, bfhi(qf[s][0]) * scale), pack2(bflo(qf[s][1]) * scale, bfhi(qf[s][1]) * scale),
                         pack2(bflo(qf[s][2]) * scale, bfhi(qf[s][2]) * scale), pack2(bflo(qf[s][3]) * scale, bfhi(qf[s][3]) * scale)};
#pragma unroll
          for (int nb = 0; nb < NB; ++nb) {
            u4v vf = *(const u4v*)(S0 + (size_t)(nb * 16 + l15) * 128 + s * 32 + g * 8);
            ot[nb] = __builtin_amdgcn_mfma_f32_16x16x32_bf16(bc8(vf), bc8(pq), ot[nb], 0, 0, 0);
          }
        }
      }
    }
    float s = 0.f;
#pragma unroll
    for (int nb = 0; nb < NB; ++nb) s += ot[nb][0] + ot[nb][1] + ot[nb][2] + ot[nb][3];
    s += __shfl_xor(s, 16); s += __shfl_xor(s, 32);
    const float mu = s * (1.f / 128.f);
    float q = 0.f;
#pragma unroll
    for (int nb = 0; nb < NB; ++nb)
#pragma unroll
      for (int r = 0; r < 4; ++r) { float dlt = ot[nb][r] - mu; q += dlt * dlt; }
    q += __shfl_xor(q, 16); q += __shfl_xor(q, 32);
    const float rstd = rsqrtf(q * (1.f / 128.f) + LNEPS);
#pragma unroll
    for (int nb = 0; nb < NB; ++nb) {
      const size_t off = (size_t)qtok * 512 + hh * 128 + nb * 16 + g * 4;
      uint2 gg = *(const uint2*)(WS_G + off);
      float o0 = (ot[nb][0] - mu) * rstd * bflo(gg.x);
      float o1 = (ot[nb][1] - mu) * rstd * bfhi(gg.x);
      float o2 = (ot[nb][2] - mu) * rstd * bflo(gg.y);
      float o3 = (ot[nb][3] - mu) * rstd * bfhi(gg.y);
      *(uint2*)(WS_rout + off) = make_uint2(pack2(o0, o1), pack2(o2, o3));
    }
  } else {
    lsum += __shfl_xor(lsum, 16); lsum += __shfl_xor(lsum, 32);
    const float inv = __builtin_amdgcn_rcpf(lsum);
#pragma unroll
    for (int nb = 0; nb < NB; ++nb) {
      const size_t off = (size_t)qtok * 512 + hh * 64 + nb * 16 + g * 4;
      *(uint2*)(WS_nout + off) = make_uint2(pack2(ot[nb][0] * inv, ot[nb][1] * inv), pack2(ot[nb][2] * inv, ot[nb][3] * inv));
    }
  }
}

__device__ __forceinline__ void retstate_item(const Params& p, int l, int idx) {
  const int dir = idx & 1, hh = (idx >> 1) & 3, b = idx >> 3;
  const int tid = ltid(), lane = tid & 63, wave = tid >> 6;
  const int r = lane & 31, h2 = lane >> 5;
  const float x = p.ret_decay[(l * 2 + dir) * 4 + hh];
  const float lg2 = -log1pf(expf(-x)) * 1.4426950408889634f;
  const u16* Kt = WS_KtR + ((size_t)(b * 4 + hh) * 128) * 256;
  const u16* Vt = WS_VtR + ((size_t)(b * 4 + hh) * 128) * 256;
  f16v acc[4];
#pragma unroll
  for (int i = 0; i < 4; ++i) acc[i] = zero16();
#pragma unroll 2
  for (int ks = 0; ks < 16; ++ks) {
    const int tok0 = ks * 16 + h2 * 8;
    const u4v a = *(const u4v*)(Kt + (size_t)(wave * 32 + r) * 256 + tok0);
    u4v af;
#pragma unroll
    for (int w = 0; w < 4; ++w) {
      const int t0 = tok0 + 2 * w, t1 = t0 + 1;
      float w0 = __builtin_amdgcn_exp2f(lg2 * (float)(dir == 0 ? 255 - t0 : t0));
      float w1 = __builtin_amdgcn_exp2f(lg2 * (float)(dir == 0 ? 255 - t1 : t1));
      af[w] = pack2(bflo(a[w]) * w0, bfhi(a[w]) * w1);
    }
#pragma unroll
    for (int nt = 0; nt < 4; ++nt) {
      const u4v bfr = *(const u4v*)(Vt + (size_t)(nt * 32 + r) * 256 + tok0);
      acc[nt] = __builtin_amdgcn_mfma_f32_32x32x16_bf16(bc8(af), bc8(bfr), acc[nt], 0, 0, 0);
    }
  }
  float* o = p.out + OUT_SRET + ((size_t)(((b * 2 + l) * 2 + dir) * 4 + hh)) * 16384;
#pragma unroll
  for (int nt = 0; nt < 4; ++nt)
#pragma unroll
    for (int reg = 0; reg < 16; ++reg) {
      const int dk = wave * 32 + (reg & 3) + 8 * (reg >> 2) + 4 * h2;
      o[(size_t)dk * 128 + nt * 32 + r] = acc[nt][reg];
    }
}

__device__ __forceinline__ void s5_item(const Params& p, char* smem, int l, int item) {
  const int tid = ltid(), lane = tid & 63, wave = tid >> 6;
  const int l15 = lane & 15, g4 = lane >> 4;
  int seq = item * 4 + wave;
  int b, dir, g, L, tokbase;
  bool latent;
  if (seq < 256) { latent = true; b = seq >> 6; dir = (seq >> 5) & 1; g = seq & 31; L = 1024; tokbase = TCTX + b * 1024; }
  else { seq -= 256; latent = false; b = seq >> 6; dir = (seq >> 5) & 1; g = seq & 31; L = 256; tokbase = b * 256; }
  float* buf = (float*)smem + wave * (16 * 132);
  const int tg = (l * 2 + dir) * 32 + g;
  const float ar = WS_abar[(tg * 64 + lane) * 2], ai = WS_abar[(tg * 64 + lane) * 2 + 1];
  u4v bfrag[8];
#pragma unroll
  for (int nt = 0; nt < 8; ++nt) {
    if (g4 < 2) bfrag[nt] = *(const u4v*)(WS_bbarT + ((size_t)tg * 128 + nt * 16 + l15) * 16 + g4 * 8);
    else bfrag[nt] = (u4v){0u, 0u, 0u, 0u};
  }
  u4v cfrag[4];
#pragma unroll
  for (int ks = 0; ks < 4; ++ks) cfrag[ks] = *(const u4v*)(WS_cmT + ((size_t)tg * 16 + l15) * 128 + ks * 32 + g4 * 8);
  float xr = 0.f, xi = 0.f;
  if (latent) {
    const float* h0 = p.state_ssm + ((size_t)(((b * 2 + l) * 2 + dir) * 32 + g) * 64 + lane) * 2;
    xr = h0[0]; xi = h0[1];
  }
  u16* yd = WS_YD + (size_t)dir * TALL * 512;
  __syncthreads();
  const int nsub = L >> 4;
  u4v afn = (u4v){0u, 0u, 0u, 0u};
  if (g4 < 2) {
    const int pos = dir == 0 ? l15 : L - 1 - l15;
    afn = *(const u4v*)(WS_SU + (size_t)(tokbase + pos) * 512 + g * 16 + g4 * 8);
  }
#pragma unroll 1
  for (int sub = 0; sub < nsub; ++sub) {
    const u4v af = afn;
    if (g4 < 2 && sub + 1 < nsub) {
      const int tau = (sub + 1) * 16 + l15;
      const int pos = dir == 0 ? tau : L - 1 - tau;
      afn = *(const u4v*)(WS_SU + (size_t)(tokbase + pos) * 512 + g * 16 + g4 * 8);
    }
#pragma unroll
    for (int nt = 0; nt < 8; ++nt) {
      f4v c = (f4v){0.f, 0.f, 0.f, 0.f};
      c = __builtin_amdgcn_mfma_f32_16x16x32_bf16(bc8(af), bc8(bfrag[nt]), c, 0, 0, 0);
#pragma unroll
      for (int r = 0; r < 4; ++r) buf[(g4 * 4 + r) * 132 + nt * 16 + l15] = c[r];
    }
    __builtin_amdgcn_wave_barrier();
#pragma unroll
    for (int i = 0; i < 16; ++i) {
      const float bur = buf[i * 132 + lane], bui = buf[i * 132 + 64 + lane];
      const float nr = ar * xr - ai * xi + bur;
      const float ni = ar * xi + ai * xr + bui;
      xr = nr; xi = ni;
      buf[i * 132 + lane] = xr;
      buf[i * 132 + 64 + lane] = xi;
    }
    __builtin_amdgcn_wave_barrier();
    f4v y = (f4v){0.f, 0.f, 0.f, 0.f};
#pragma unroll
    for (int ks = 0; ks < 4; ++ks) {
      const float* bp = buf + l15 * 132 + ks * 32 + g4 * 8;
      float4 v0 = *(const float4*)(bp), v1 = *(const float4*)(bp + 4);
      const u4v xa = (u4v){pack2(v0.x, v0.y), pack2(v0.z, v0.w), pack2(v1.x, v1.y), pack2(v1.z, v1.w)};
      y = __builtin_amdgcn_mfma_f32_16x16x32_bf16(bc8(xa), bc8(cfrag[ks]), y, 0, 0, 0);
    }
#pragma unroll
    for (int r = 0; r < 4; ++r) {
      const int tau = sub * 16 + g4 * 4 + r;
      const int pos = dir == 0 ? tau : L - 1 - tau;
      yd[(size_t)(tokbase + pos) * 512 + g * 16 + l15] = f2bf(y[r]);
    }
    __builtin_amdgcn_wave_barrier();
  }
  if (!latent) {
    float* o = p.out + OUT_SSSM + ((size_t)(((b * 2 + l) * 2 + dir) * 32 + g) * 64 + lane) * 2;
    o[0] = xr; o[1] = xi;
  }
}

#define MX_S5 320
#define MX_RET 512
#define MX_NA 512
#define MX_CA 512
#define MX_RS 128
#define MX_ITEMS (MX_S5 + MX_RET + MX_NA + MX_CA + MX_RS)
__device__ __forceinline__ void mixer_item(const Params& p, char* smem, int l, int item) {
  if (item < 64) { s5_item(p, smem, l, item); return; }
  item -= 64;
  if (item < 256) { attn_item<128, 0>(p, smem, l, item); return; }
  item -= 256;
  if (item < 512) { attn_item<64, 2>(p, smem, l, item); return; }
  item -= 512;
  if (item < 256) { s5_item(p, smem, l, 64 + item); return; }
  item -= 256;
  if (item < 256) { attn_item<128, 0>(p, smem, l, 256 + item); return; }
  item -= 256;
  if (item < 512) { attn_item<64, 1>(p, smem, l, item); return; }
  item -= 512;
  retstate_item(p, l, item);
}

__device__ __forceinline__ void p3a_item(const Params& p, char* smem, int l, int item) {
  const int mt = item & 63, nt = item >> 6;
  const int m0 = mt * 128, n0 = nt * 128;
  const int tid = ltid(), lane = tid & 63, wave = tid >> 6, wm = wave >> 1, wn = wave & 1;
  AArgs a{};
  a.SU = WS_SU; a.YD0 = WS_YD; a.YD1 = WS_YD + (size_t)TALL * 512; a.dsk = p.ssm_d + l * 512;
  f16v acc[2][2];
  gemm_mainloop<2>(smem, a, WS_Wt + WT_LAYER * l + WT_GLU, 512, 512, m0, n0, acc);
#pragma unroll
  for (int mi = 0; mi < 2; ++mi)
#pragma unroll
    for (int reg = 0; reg < 16; ++reg) {
      const int row = EPI_ROW(mi, reg);
#pragma unroll
      for (int ni = 0; ni < 2; ++ni) {
        const int col = EPI_COL(ni);
        const size_t off = (size_t)row * 512 + col;
        float y = geluf_(a.dsk[col] * bf2f(WS_SU[off]) + bf2f(a.YD0[off]) + bf2f(a.YD1[off]));
        WS_sout[off] = f2bf(y * sigmoidf_(acc[mi][ni][reg]));
      }
    }
}

__device__ __forceinline__ void p3b_item(const Params& p, char* smem, int l, int item) {
  const int mt = item & 63, nt = item >> 6;
  const int m0 = mt * 128, n0 = nt * 128;
  const int tid = ltid(), lane = tid & 63, wave = tid >> 6, wm = wave >> 1, wn = wave & 1;
  int nbr = 3;
  asm volatile("" : "+s"(nbr));
#pragma unroll 1
  for (int br = 0; br < nbr; ++br) {
    const u16* Abr = br == 0 ? WS_rout : (br == 1 ? WS_sout : WS_nout);
    f16v acc[2][2];
    gemm_mainloop0(smem, Abr, 512, WS_Wt + WT_LAYER * l + WT_BR + (size_t)br * 512 * 1024, 512, 512, m0, n0, acc);
    u16* Cs = (u16*)smem;
    {
      const int rl0 = wm * 64 + 4 * (lane >> 5), cl0 = wn * 64 + (lane & 31);
#pragma unroll
      for (int mi = 0; mi < 2; ++mi)
#pragma unroll
        for (int reg = 0; reg < 16; ++reg) {
          const int rl = rl0 + mi * 32 + (reg & 3) + 8 * (reg >> 2);
          Cs[rl * CST + cl0] = f2bf(acc[mi][0][reg]);
          Cs[rl * CST + cl0 + 32] = f2bf(acc[mi][1][reg]);
        }
    }
    __syncthreads();
    int tl = tid;
    asm volatile("" : "+v"(tl));
#pragma unroll
    for (int i = 0; i < 8; ++i) {
      const int c = tl + 256 * i, r = c >> 4, ch = c & 15;
      const u4v av = *(const u4v*)(Cs + r * CST + ch * 8);
      const u4v gv = *(const u4v*)(WS_GT + (size_t)(m0 + r) * 3072 + br * 1024 + n0 + ch * 8);
      u16* mp = WS_merged + (size_t)(m0 + r) * 1024 + n0 + ch * 8;
      u4v mv = (u4v){0u, 0u, 0u, 0u};
      if (br > 0) mv = *(const u4v*)mp;
      u4v ov;
#pragma unroll
      for (int j = 0; j < 4; ++j)
        ov[j] = pack2(fmaf(bflo(gv[j]), bflo(av[j]), bflo(mv[j])), fmaf(bfhi(gv[j]), bfhi(av[j]), bfhi(mv[j])));
      *(u4v*)mp = ov;
    }
  }
}


#define CFS 132
__device__ __forceinline__ void epi_resid(char* smem, f16v (&acc)[2][2], int m0, int n0, const float* __restrict__ gvec,
                                          const float* __restrict__ xlo, const float* __restrict__ xhi,
                                          const float* __restrict__ xstats, const float* __restrict__ lng,
                                          const float* __restrict__ lnb, float* __restrict__ dst,
                                          float* __restrict__ stats_out, bool do_stats) {
  float* Cf = (float*)smem;
  const int tid = ltid(), lane = tid & 63, wave = tid >> 6, wm = wave >> 1, wn = wave & 1;
  {
    const int rl0 = wm * 64 + 4 * (lane >> 5), cl0 = wn * 64 + (lane & 31);
    const float ga = gvec[n0 + cl0], gb = gvec[n0 + cl0 + 32];
#pragma unroll
    for (int mi = 0; mi < 2; ++mi)
#pragma unroll
      for (int reg = 0; reg < 16; ++reg) {
        const int rl = rl0 + mi * 32 + (reg & 3) + 8 * (reg >> 2);
        Cf[rl * CFS + cl0] = ga * acc[mi][0][reg];
        Cf[rl * CFS + cl0 + 32] = gb * acc[mi][1][reg];
      }
  }
  __syncthreads();
  const int ch = tid & 31, r0 = tid >> 5;
  const int col = n0 + ch * 4;
  float4 g4 = make_float4(1.f, 1.f, 1.f, 1.f), b4 = make_float4(0.f, 0.f, 0.f, 0.f);
  if (xstats) { g4 = *(const float4*)(lng + col); b4 = *(const float4*)(lnb + col); }
  const float* xbase = (m0 < TCTX ? xlo + (size_t)m0 * 1024 : xhi + (size_t)(m0 - TCTX) * 1024) + col;
#pragma unroll 4
  for (int i = 0; i < 16; ++i) {
    const int r = r0 + 8 * i;
    const int row = m0 + r;
    const float4 v = *(const float4*)(Cf + r * CFS + ch * 4);
    float4 x = *(const float4*)(xbase + (size_t)r * 1024);
    if (xstats) {
      const float s = xstats[row * 2], q = xstats[row * 2 + 1];
      const float mu = s * (1.f / 1024.f);
      const float rstd = rsqrtf(fmaxf(q * (1.f / 1024.f) - mu * mu, 0.f) + LNEPS);
      x.x = (x.x - mu) * rstd * g4.x + b4.x; x.y = (x.y - mu) * rstd * g4.y + b4.y;
      x.z = (x.z - mu) * rstd * g4.z + b4.z; x.w = (x.w - mu) * rstd * g4.w + b4.w;
    }
    float4 o;
    o.x = ALPHA * x.x + v.x; o.y = ALPHA * x.y + v.y; o.z = ALPHA * x.z + v.z; o.w = ALPHA * x.w + v.w;
    *(float4*)(dst + (size_t)row * 1024 + col) = o;
    if (do_stats) {
      float ss = o.x + o.y + o.z + o.w, qq = o.x * o.x + o.y * o.y + o.z * o.z + o.w * o.w;
#pragma unroll
      for (int sh = 1; sh < 32; sh <<= 1) { ss += __shfl_xor(ss, sh); qq += __shfl_xor(qq, sh); }
      if (ch == 0) { atomicAdd(stats_out + row * 2, ss); atomicAdd(stats_out + row * 2 + 1, qq); }
    }
  }
}

__device__ __forceinline__ void p3c_item(const Params& p, char* smem, int l, int item, bool do_stats = true) {
  const int mt = item & 63, nt = item >> 6;
  const int m0 = mt * 128, n0 = nt * 128;
  const int tid = ltid(), lane = tid & 63, wave = tid >> 6, wm = wave >> 1, wn = wave & 1;
  f16v acc[2][2];
  gemm_mainloop0(smem, WS_merged, 1024, WS_Wt + WT_LAYER * l + WT_O, 1024, 1024, m0, n0, acc);
  const int ci = cond_of_row(m0);
  const float* g1 = WS_mod + (l * 5 + ci) * 6144 + 2048;
  float* st1 = WS_stats + (size_t)(l * 2 + 0) * TALL * 2;
  if (l == 0)
    epi_resid(smem, acc, m0, n0, g1, p.x_prompt, p.x_sample, nullptr, nullptr, nullptr, WS_pre1, st1, do_stats);
  else
    epi_resid(smem, acc, m0, n0, g1, p.out, p.out + (size_t)TCTX * 1024, WS_stats + (size_t)(0 * 2 + 1) * TALL * 2, p.ln2_g, p.ln2_b,
              WS_pre1, st1, do_stats);
}

__device__ __forceinline__ void p4_item(const Params& p, char* smem, int l, int item) {
  const int mt = item & 63, nt = item >> 6;
  const int m0 = mt * 128, n0 = nt * 128;
  const int tid = ltid(), lane = tid & 63, wave = tid >> 6, wm = wave >> 1, wn = wave & 1;
  f16v acc[2][2];
  gemm_mainloop0(smem, WS_h2, 1024, WS_Wt + WT_LAYER * l + WT_UP, 1024, 1024, m0, n0, acc);
  u16* Cs = (u16*)smem;
  const int rl0 = wm * 64 + 4 * (lane >> 5), cl0 = wn * 64 + (lane & 31);
#pragma unroll
  for (int mi = 0; mi < 2; ++mi)
#pragma unroll
    for (int reg = 0; reg < 16; ++reg) {
      const int rl = rl0 + mi * 32 + (reg & 3) + 8 * (reg >> 2);
      Cs[rl * CST + cl0] = f2bf(acc[mi][0][reg]);
      Cs[rl * CST + cl0 + 32] = f2bf(acc[mi][1][reg]);
    }
  __syncthreads();
  cs_store(Cs, WS_z2 + (size_t)m0 * 5632 + n0, 5632, tid);
}

__device__ __forceinline__ void p4b_item(const Params& p, int l, int item) {
  const int tid = ltid();
  if (tid >= 176) return;
  const int rb = item >> 1, hf = item & 1;
  const int j0 = (hf * 176 + tid) * 8;
  const float* cw = p.conv_w + (size_t)l * 3 * 5632;
  const float* cb = p.conv_b + (size_t)l * 5632;
  float wa[3][8], wb[3][8], ba[8], bb[8];
#pragma unroll
  for (int t = 0; t < 3; ++t)
#pragma unroll
    for (int h = 0; h < 2; ++h) {
      const float4 x = *(const float4*)(cw + t * 5632 + j0 + 4 * h), y = *(const float4*)(cw + t * 5632 + 2816 + j0 + 4 * h);
      wa[t][4 * h] = x.x; wa[t][4 * h + 1] = x.y; wa[t][4 * h + 2] = x.z; wa[t][4 * h + 3] = x.w;
      wb[t][4 * h] = y.x; wb[t][4 * h + 1] = y.y; wb[t][4 * h + 2] = y.z; wb[t][4 * h + 3] = y.w;
    }
#pragma unroll
  for (int h = 0; h < 2; ++h) {
    const float4 x = *(const float4*)(cb + j0 + 4 * h), y = *(const float4*)(cb + 2816 + j0 + 4 * h);
    ba[4 * h] = x.x; ba[4 * h + 1] = x.y; ba[4 * h + 2] = x.z; ba[4 * h + 3] = x.w;
    bb[4 * h] = y.x; bb[4 * h + 1] = y.y; bb[4 * h + 2] = y.z; bb[4 * h + 3] = y.w;
  }
  const int row0 = rb * 32;
  int pos0, L;
  if (row0 < TCTX) { pos0 = row0 & 255; L = 256; } else { pos0 = (row0 - TCTX) & 1023; L = 1024; }
  const u16* zr = WS_z2 + (size_t)row0 * 5632 + j0;
  const u4v zero = (u4v){0u, 0u, 0u, 0u};
  u4v pa = zero, pb = zero;
  if (pos0 > 0) { pa = *(const u4v*)(zr - 5632); pb = *(const u4v*)(zr - 5632 + 2816); }
  u4v ca = *(const u4v*)(zr), cb2 = *(const u4v*)(zr + 2816);
#pragma unroll 2
  for (int r = 0; r < 32; ++r) {
    u4v na = zero, nb = zero;
    if (pos0 + r < L - 1) { na = *(const u4v*)(zr + (size_t)(r + 1) * 5632); nb = *(const u4v*)(zr + (size_t)(r + 1) * 5632 + 2816); }
    u4v ov;
#pragma unroll
    for (int w = 0; w < 4; ++w) {
      const float a0 = wa[0][2 * w] * bflo(pa[w]) + wa[1][2 * w] * bflo(ca[w]) + wa[2][2 * w] * bflo(na[w]) + ba[2 * w];
      const float a1 = wa[0][2 * w + 1] * bfhi(pa[w]) + wa[1][2 * w + 1] * bfhi(ca[w]) + wa[2][2 * w + 1] * bfhi(na[w]) + ba[2 * w + 1];
      const float b0 = wb[0][2 * w] * bflo(pb[w]) + wb[1][2 * w] * bflo(cb2[w]) + wb[2][2 * w] * bflo(nb[w]) + bb[2 * w];
      const float b1 = wb[0][2 * w + 1] * bfhi(pb[w]) + wb[1][2 * w + 1] * bfhi(cb2[w]) + wb[2][2 * w + 1] * bfhi(nb[w]) + bb[2 * w + 1];
      ov[w] = pack2(geluf_(a0) * b0, geluf_(a1) * b1);
    }
    *(u4v*)(WS_act + (size_t)(row0 + r) * 2816 + j0) = ov;
    pa = ca; pb = cb2; ca = na; cb2 = nb;
  }
}

__device__ __forceinline__ void p5_item(const Params& p, char* smem, int l, int item, bool do_stats = true) {
  const int mt = item & 63, nt = item >> 6;
  const int m0 = mt * 128, n0 = nt * 128;
  const int tid = ltid(), lane = tid & 63, wave = tid >> 6, wm = wave >> 1, wn = wave & 1;
  f16v acc[2][2];
  gemm_mainloop0(smem, WS_act, 2816, WS_Wt + WT_LAYER * l + WT_DOWN, 2816, 2816, m0, n0, acc);
  const int ci = cond_of_row(m0);
  const float* g2 = WS_mod + (l * 5 + ci) * 6144 + 5 * 1024;
  epi_resid(smem, acc, m0, n0, g2, WS_pre1, WS_pre1 + (size_t)TCTX * 1024, WS_stats + (size_t)(l * 2 + 0) * TALL * 2,
            p.ln1_g + l * 1024, p.ln1_b + l * 1024, p.out, WS_stats + (size_t)(l * 2 + 1) * TALL * 2, do_stats);
}

__device__ __forceinline__ void final_item(const Params& p, int item) {
  const float* st = WS_stats + (size_t)(1 * 2 + 1) * TALL * 2;
  const int c = ltid() * 4;
  const float4 g = *(const float4*)(p.ln2_g + 1024 + c);
  const float4 b = *(const float4*)(p.ln2_b + 1024 + c);
  for (int r = 0; r < 8; ++r) {
    const int row = item * 8 + r;
    const float s = st[row * 2], q = st[row * 2 + 1];
    const float mu = s * (1.f / 1024.f);
    const float rstd = rsqrtf(fmaxf(q * (1.f / 1024.f) - mu * mu, 0.f) + LNEPS);
    float4 v = *(float4*)(p.out + (size_t)row * 1024 + c);
    v.x = (v.x - mu) * rstd * g.x + b.x;
    v.y = (v.y - mu) * rstd * g.y + b.y;
    v.z = (v.z - mu) * rstd * g.z + b.z;
    v.w = (v.w - mu) * rstd * g.w + b.w;
    *(float4*)(p.out + (size_t)row * 1024 + c) = v;
  }
}

#define XB_TMO      128
#define XB_XCNT(j)  (256  + 64 * (j))
#define XB_XSUB(j)  (1280 + 64 * (j))
#define XB_XGEN(j)  (2304 + 64 * (j))
#define XB_TOP      3328
#define XB_TOPGEN   3392
#define XCD_BAR_WORDS 3456
#define XB_SPIN_CAP (1u << 18)
#define LAS __attribute__((address_space(3)))

__device__ __forceinline__ unsigned xb_ld(unsigned* p)              { return __hip_atomic_load(p, __ATOMIC_RELAXED, __HIP_MEMORY_SCOPE_AGENT); }
__device__ __forceinline__ unsigned xb_add(unsigned* p, unsigned v) { return __hip_atomic_fetch_add(p, v, __ATOMIC_RELAXED, __HIP_MEMORY_SCOPE_AGENT); }
__device__ __forceinline__ unsigned xb_xcc_id() { return (unsigned)__builtin_amdgcn_s_getreg((3 << 11) | 20) & 0xFu; }
#define XB_SPIN(cond, bar) do { unsigned _sp = 0; while (cond) { __builtin_amdgcn_s_sleep(1); \
    if ((++_sp & 255u) == 0u) { if (xb_ld(&(bar)[XB_TMO])) break; if (_sp > XB_SPIN_CAP) { atomicAdd(&(bar)[XB_TMO], 1u); break; } } } } while (0)

struct XcdBarrier {
    unsigned* bar; unsigned x;
    volatile LAS unsigned* st;
};

__device__ __forceinline__ XcdBarrier xcd_barrier_post(unsigned* bar, volatile LAS unsigned* st) {
    XcdBarrier b; b.bar = bar; b.x = xb_xcc_id(); b.st = st;
    if (threadIdx.x == 0) (void)xb_add(&bar[XB_XCNT(b.x)], 1u);
    return b;
}
__device__ __forceinline__ void xcd_barrier_complete(unsigned* bar, unsigned x, unsigned& nloc, unsigned& nx) {
    const unsigned G = gridDim.x * gridDim.y * gridDim.z;
    unsigned sum, cnt, mine, sp = 0u;
    for (;;) {
        sum = 0u; cnt = 0u; mine = 0u;
#pragma unroll
        for (unsigned j = 0; j < 16; ++j) { const unsigned c = xb_ld(&bar[XB_XCNT(j)]); sum += c; cnt += (c > 0u) ? 1u : 0u; mine = (j == x) ? c : mine; }
        if (sum == G) break;
        __builtin_amdgcn_s_sleep(1);
        if ((++sp & 255u) == 0u) { if (xb_ld(&bar[XB_TMO])) break; if (sp > XB_SPIN_CAP) { atomicAdd(&bar[XB_TMO], 1u); break; } }
    }
    nloc = mine > 0u ? mine : 1u; nx = cnt > 0u ? cnt : 1u;
}

__device__ __forceinline__ void xcd_barrier(const XcdBarrier& b) {
    asm volatile("s_waitcnt vmcnt(0)" ::: "memory");
    __syncthreads();
    if (threadIdx.x == 0) {
        unsigned* bar = b.bar;
        __builtin_amdgcn_s_waitcnt(0);
        unsigned nloc = b.st[0], nx = b.st[1];
        if (nloc == 0u) { xcd_barrier_complete(bar, b.x, nloc, nx); b.st[0] = nloc; b.st[1] = nx; }
        const unsigned old = xb_add(&bar[XB_XSUB(b.x)], 1u);
        const unsigned gen = old / nloc;
        if (old + 1u == (gen + 1u) * nloc) {
            __builtin_amdgcn_fence(__ATOMIC_RELEASE, "agent");
            asm volatile("s_waitcnt vmcnt(0)" ::: "memory");
            const unsigned og = xb_add(&bar[XB_TOP], 1u);
            const unsigned tg = og / nx;
            if (og + 1u == (tg + 1u) * nx) xb_add(&bar[XB_TOPGEN], 1u);
            else XB_SPIN(xb_ld(&bar[XB_TOPGEN]) == tg, bar);
            __builtin_amdgcn_fence(__ATOMIC_ACQUIRE, "agent");
            xb_add(&bar[XB_XGEN(b.x)], 1u);
            asm volatile("s_waitcnt vmcnt(0)" ::: "memory");
        } else {
            XB_SPIN(xb_ld(&bar[XB_XGEN(b.x)]) == gen, bar);
            __builtin_amdgcn_fence(__ATOMIC_ACQUIRE, "agent");
            asm volatile("s_waitcnt vmcnt(0)" ::: "memory");
        }
    }
    __syncthreads();
}


#define NPHASES 22
#ifndef REPMASK
#define REPMASK 0
#endif
#define REPS(PH) (((PH) == 0 ? (REPMASK >> 10) : (PH) == 21 ? (REPMASK >> 11) : (REPMASK >> (((PH) - 1) % 10))) & 1)
#define RUN_PHASE(PH, N, CALL)                                              \
  if (ph_lo <= (PH) && (PH) < ph_hi) {                                      \
    for (int rep_ = 0; rep_ <= REPS(PH); ++rep_)                            \
    for (int it = blockIdx.x; it < (N); it += nb) { CALL; }                 \
    if ((PH) + 1 < ph_hi) xcd_barrier(xb);                                  \
  }
#define RUN_GEMM_PHASE(PH, NT, CALL)                                                          \
  if (ph_lo <= (PH) && (PH) < ph_hi) {                                                        \
    const int xcd_ = blockIdx.x & 7, slot_ = blockIdx.x >> 3, spx_ = (int)gridDim.x >> 3;      \
    const int nsuper_ = 8 * (((NT) + 7) >> 3);                                                \
    for (int rep_ = 0; rep_ <= REPS(PH); ++rep_)                                              \
    for (int s_ = xcd_; s_ < nsuper_; s_ += 8)                                                \
      for (int j_ = slot_; j_ < 64; j_ += spx_) {                                             \
        const int mt_ = (s_ & 7) * 8 + (j_ & 7), nt_ = (s_ >> 3) * 8 + (j_ >> 3);             \
        if (nt_ < (NT)) { const int it = nt_ * 64 + mt_; CALL; }                              \
      }                                                                                       \
    if ((PH) + 1 < ph_hi) xcd_barrier(xb);                                                    \
  }
#define RUN_MIXER_PHASE(PH, L)                                                                \
  if (ph_lo <= (PH) && (PH) < ph_hi) {                                                        \
    for (int rep_ = 0; rep_ <= REPS(PH); ++rep_) {                                            \
      unsigned* ctr_ = (unsigned*)(p.ws + OFF_ctr) + 64 * (2 * (L) + rep_);                   \
      for (;;) {                                                                              \
        __syncthreads();                                                                      \
        if (threadIdx.x == 0) wq_item = (int)atomicAdd(ctr_, 1u);                             \
        __syncthreads();                                                                      \
        const int it = wq_item;                                                               \
        if (it >= MX_ITEMS) break;                                                            \
        mixer_item(p, smem, (L), it);                                                         \
      }                                                                                       \
    }                                                                                         \
    if ((PH) + 1 < ph_hi) xcd_barrier(xb);                                                    \
  }
#define RUN_LAYER(L)                                                         \
  RUN_PHASE(1 + 10 * (L) + 0, 1024, hmat_item(p, (L), 0, it))                \
  RUN_GEMM_PHASE(1 + 10 * (L) + 1, 56, p1_item(p, smem, (L), it))            \
  RUN_MIXER_PHASE(1 + 10 * (L) + 2, (L))                                     \
  RUN_GEMM_PHASE(1 + 10 * (L) + 3, 4, p3a_item(p, smem, (L), it))            \
  RUN_GEMM_PHASE(1 + 10 * (L) + 4, 8, p3b_item(p, smem, (L), it))            \
  RUN_GEMM_PHASE(1 + 10 * (L) + 5, 8, p3c_item(p, smem, (L), it, rep_ == 0)) \
  RUN_PHASE(1 + 10 * (L) + 6, 1024, hmat_item(p, (L), 1, it))                \
  RUN_GEMM_PHASE(1 + 10 * (L) + 7, 44, p4_item(p, smem, (L), it))            \
  RUN_PHASE(1 + 10 * (L) + 8, 512, p4b_item(p, (L), it))                     \
  RUN_GEMM_PHASE(1 + 10 * (L) + 9, 8, p5_item(p, smem, (L), it, rep_ == 0))

__global__ void __launch_bounds__(256, 2) mega(Params p, int ph_lo, int ph_hi) {
  extern __shared__ __attribute__((aligned(16))) char smem[];
  __shared__ uint4 xb_words;
  __shared__ int wq_item;
  const int nb = gridDim.x;
  if (threadIdx.x == 0) xb_words = make_uint4(0u, 0u, 0u, 0u);
  __syncthreads();
  XcdBarrier xb;
  xb.bar = (unsigned*)(p.ws + OFF_bar); xb.x = 0; xb.st = (volatile LAS unsigned*)&xb_words;
  if (ph_hi - ph_lo > 1) xb = xcd_barrier_post((unsigned*)(p.ws + OFF_bar), (volatile LAS unsigned*)&xb_words);
  if (ph_hi > 1000) cg::this_grid().sync();
  RUN_PHASE(0, P0_ITEMS, phase0_item(p, smem, it))
  RUN_LAYER(0)
  RUN_LAYER(1)
  RUN_PHASE(21, 1024, final_item(p, it))
}

extern "C" void kernel_launch(void* const* d_in, const int* in_sizes, int n_in, void* d_out, int out_size, void* d_ws,
                              size_t ws_size, hipStream_t stream) {
  Params p{};
  const float** ins = (const float**)&p;
  for (int i = 0; i < 32; ++i) ins[i] = (const float*)d_in[i];
  p.out = (float*)d_out;
  char* ws = (char*)d_ws;
  p.ws = ws;
  if (WS_TOTAL > ws_size) {
    fprintf(stderr, "kernel_launch: workspace too small (%zu needed, %zu given)\n", (size_t)WS_TOTAL, ws_size);
    return;
  }
  (void)hipMemsetAsync(ws, 0, ZERO_BYTES, stream);
#if SINGLE_LAUNCH
  static int grid_blocks = 0;
  if (!grid_blocks) {
    int dev = 0, cus = 0, per_cu = 0;
    (void)hipGetDevice(&dev);
    (void)hipDeviceGetAttribute(&cus, hipDeviceAttributeMultiprocessorCount, dev);
    (void)hipFuncSetAttribute((const void*)mega, hipFuncAttributeMaxDynamicSharedMemorySize, LDS_BYTES);
    (void)hipOccupancyMaxActiveBlocksPerMultiprocessor(&per_cu, mega, 256, LDS_BYTES);
    if (per_cu > 2) per_cu = 2;
    if (per_cu < 1) per_cu = 1;
    grid_blocks = (cus * per_cu) & ~7;
  }
  int lo = 0, hi = NPHASES;
  void* args[] = {&p, &lo, &hi};
  hipError_t e = hipLaunchCooperativeKernel((void*)mega, dim3(grid_blocks), dim3(256), args, LDS_BYTES, stream);
  if (e != hipSuccess) fprintf(stderr, "cooperative launch failed: %s (grid %d)\n", hipGetErrorString(e), grid_blocks);
#else
  for (int ph = 0; ph < NPHASES; ++ph) {
    hipLaunchKernelGGL(mega, dim3(512), dim3(256), LDS_BYTES, stream, p, ph, ph + 1);
  }
#endif
}
```

```cpp
#include <hip/hip_runtime.h>
#include <hip/hip_cooperative_groups.h>
#include <cstdio>
namespace cg = cooperative_groups;

#ifndef SINGLE_LAUNCH
#define SINGLE_LAUNCH 1
#endif

typedef __attribute__((ext_vector_type(8))) short s8v;
typedef __attribute__((ext_vector_type(4))) float f4v;
typedef __attribute__((ext_vector_type(16))) float f16v;
typedef unsigned short u16;
typedef __attribute__((ext_vector_type(4))) unsigned u4v;
__device__ __forceinline__ s8v bc8(u4v x) { return __builtin_bit_cast(s8v, x); }


#define TALL 8192
#define TCTX 4096
#define ALPHA 1.41421356237309515f
#define LNEPS 1e-5f
#define VTR_LAT 2097152
#define NVT_LAT 2097152
#define OUT_SRET 8388608
#define OUT_SSSM 12582912
#define OUT_CK 12845056
#define OUT_CV 17039360
#define WT_IN 0
#define WT_GLU (WT_IN + 7168 * 1024)
#define WT_BR (WT_GLU + 512 * 512)
#define WT_O (WT_BR + 3 * 1024 * 512)
#define WT_UP (WT_O + 1024 * 1024)
#define WT_DOWN (WT_UP + 5632 * 1024)
#define WT_LAYER ((size_t)(WT_DOWN + 1024 * 2816))

struct Params {
  const float *x_prompt, *x_sample, *state_ret, *state_ssm, *cache_k, *cache_v, *c, *c_ctx;
  const float *w_ada, *b_ada, *w_in, *ret_decay, *a_re, *a_im, *log_dt, *b_re, *b_im, *c_re, *c_im;
  const float *ssm_d, *w_glu, *rpb, *w_branch, *w_o, *ln1_g, *ln1_b, *w_up, *conv_w, *conv_b, *w_down, *ln2_g, *ln2_b;
  float* out;
  char* ws;
};

typedef __bf16 bf2v __attribute__((ext_vector_type(2)));
typedef float fl2v __attribute__((ext_vector_type(2)));
__device__ __forceinline__ unsigned pack2(float a, float b) {
  fl2v f = {a, b};
  bf2v h = __builtin_convertvector(f, bf2v);
  return __builtin_bit_cast(unsigned, h);
}
__device__ __forceinline__ u16 f2bf(float f) { return (u16)(pack2(f, 0.f) & 0xffffu); }

constexpr size_t al256(size_t x) { return (x + 255) & ~(size_t)255; }
constexpr size_t EB = (size_t)TALL * 512 * 2;
constexpr size_t OFF_mod = 0;
constexpr size_t OFF_stats = OFF_mod + al256(2 * 5 * 6144 * 4);
constexpr size_t OFF_bar = OFF_stats + al256(2 * 2 * TALL * 2 * 4);
constexpr size_t OFF_ctr = OFF_bar + al256(3456 * 4);
constexpr size_t ZERO_BYTES = OFF_ctr + al256(8 * 256);
constexpr size_t OFF_ropetab = ZERO_BYTES;
constexpr size_t OFF_abar = OFF_ropetab + al256(64 * 32 * 2 * 4);
constexpr size_t OFF_bbarT = OFF_abar + al256(2 * 2 * 32 * 64 * 2 * 4);
constexpr size_t OFF_cmT = OFF_bbarT + al256(2 * 2 * 32 * 128 * 16 * 2);
constexpr size_t OFF_CK = OFF_cmT + al256(2 * 2 * 32 * 16 * 128 * 2);
constexpr size_t OFF_CVt = OFF_CK + al256((size_t)2 * 4 * 512 * 512 * 2);
constexpr size_t OFF_S0t = OFF_CVt + al256((size_t)2 * 4 * 512 * 512 * 2);
constexpr size_t OFF_Wt = OFF_S0t + al256((size_t)2 * 4 * 2 * 4 * 128 * 128 * 2);
constexpr size_t OFF_REGION = OFF_Wt + al256(2 * WT_LAYER * 2);
constexpr size_t OFF_z2 = OFF_REGION;
constexpr size_t OFF_act = OFF_z2 + (size_t)TALL * 5632 * 2;
constexpr size_t OFF_pre1 = OFF_act + (size_t)TALL * 2816 * 2;
constexpr size_t WS_TOTAL = OFF_pre1 + (size_t)TALL * 1024 * 4;
constexpr size_t OFF_K = OFF_pre1;
constexpr size_t OFF_VtR = OFF_K + EB;
constexpr size_t OFF_NQ = OFF_VtR + EB;
constexpr size_t OFF_NK = OFF_NQ + EB;
constexpr size_t OFF_GT = OFF_REGION;
constexpr size_t OFF_rout = OFF_GT + (size_t)TALL * 3072 * 2;
constexpr size_t OFF_nout = OFF_rout + EB;
constexpr size_t OFF_YD = OFF_nout + EB;
constexpr size_t OFF_merged = OFF_YD;
constexpr size_t OFF_Q = OFF_YD + 2 * EB;
constexpr size_t OFF_sout = OFF_Q;
constexpr size_t OFF_KtR = OFF_Q + EB;
constexpr size_t OFF_G = OFF_KtR + EB / 2;
constexpr size_t OFF_SU = OFF_G + EB;
constexpr size_t OFF_NVt = OFF_SU + EB;
constexpr size_t OFF_h1 = OFF_NVt + EB;
constexpr size_t OFF_h2 = OFF_act;
static_assert(OFF_h1 + 2 * EB <= OFF_pre1, "mixer buffers overflow the z2+act area");
#define WS_h1 ((u16*)(p.ws + OFF_h1))
#define WS_h2 ((u16*)(p.ws + OFF_h2))
#define WS_mod ((float*)(p.ws + OFF_mod))
#define WS_stats ((float*)(p.ws + OFF_stats))
#define WS_ropetab ((float*)(p.ws + OFF_ropetab))
#define WS_abar ((float*)(p.ws + OFF_abar))
#define WS_pre1 ((float*)(p.ws + OFF_pre1))
#define WS_bbarT ((u16*)(p.ws + OFF_bbarT))
#define WS_cmT ((u16*)(p.ws + OFF_cmT))
#define WS_CK ((u16*)(p.ws + OFF_CK))
#define WS_CVt ((u16*)(p.ws + OFF_CVt))
#define WS_S0t ((u16*)(p.ws + OFF_S0t))
#define WS_Wt ((u16*)(p.ws + OFF_Wt))
#define WS_Q ((u16*)(p.ws + OFF_Q))
#define WS_K ((u16*)(p.ws + OFF_K))
#define WS_VtR ((u16*)(p.ws + OFF_VtR))
#define WS_KtR ((u16*)(p.ws + OFF_KtR))
#define WS_G ((u16*)(p.ws + OFF_G))
#define WS_SU ((u16*)(p.ws + OFF_SU))
#define WS_NQ ((u16*)(p.ws + OFF_NQ))
#define WS_NK ((u16*)(p.ws + OFF_NK))
#define WS_NVt ((u16*)(p.ws + OFF_NVt))
#define WS_GT ((u16*)(p.ws + OFF_GT))
#define WS_rout ((u16*)(p.ws + OFF_rout))
#define WS_sout ((u16*)(p.ws + OFF_sout))
#define WS_nout ((u16*)(p.ws + OFF_nout))
#define WS_YD ((u16*)(p.ws + OFF_YD))
#define WS_merged ((u16*)(p.ws + OFF_merged))
#define WS_z2 ((u16*)(p.ws + OFF_z2))
#define WS_act ((u16*)(p.ws + OFF_act))

__device__ __forceinline__ float bf2f(unsigned h) { return __uint_as_float((h & 0xffffu) << 16); }
__device__ __forceinline__ float bflo(unsigned w) { return __uint_as_float(w << 16); }
__device__ __forceinline__ float bfhi(unsigned w) { return __uint_as_float(w & 0xffff0000u); }
__device__ __forceinline__ float fexp_(float x) { return __builtin_amdgcn_exp2f(x * 1.4426950408889634f); }
__device__ __forceinline__ float sigmoidf_(float x) { return __builtin_amdgcn_rcpf(1.f + fexp_(-x)); }
__device__ __forceinline__ float siluf_(float x) { return x * __builtin_amdgcn_rcpf(1.f + fexp_(-x)); }
__device__ __forceinline__ float geluf_(float x) {
  const float u2 = 1.5957691216057308f * (x + 0.044715f * x * x * x);
  return x * __builtin_amdgcn_rcpf(1.f + fexp_(-u2));
}
__device__ __forceinline__ f16v zero16() {
  return (f16v){0.f, 0.f, 0.f, 0.f, 0.f, 0.f, 0.f, 0.f, 0.f, 0.f, 0.f, 0.f, 0.f, 0.f, 0.f, 0.f};
}
__device__ __forceinline__ int ltid() { int t = threadIdx.x; asm volatile("" : "+v"(t)); return t; }
__device__ __forceinline__ int cond_of_row(int row) { return row < TCTX ? 0 : 1 + ((row - TCTX) >> 10); }

struct AArgs {
  const u16* A16; int lda;
  const float* A32lo; const float* A32hi;
  const float* stats;
  const float* lng; const float* lnb;
  const float* sc; const float* sh;
  const u16* SU; const u16* YD0; const u16* YD1; const float* dsk;
};

#define GST 72
#define LDS_GEMM (2 * 2 * 128 * GST * 2)
#define LDS_BYTES LDS_GEMM

template <int AMODE>
__device__ __forceinline__ void gemm_mainloop(char* smem, const AArgs& a, const u16* __restrict__ Bt, int ldb, int K,
                                              int m0, int n0, f16v (&acc)[2][2]) {
  u16* As = (u16*)smem;
  u16* Bs = As + 2 * 128 * GST;
  const int tid = ltid(), lane = tid & 63, wave = tid >> 6;
  const int wm = wave >> 1, wn = wave & 1;
  const int crow = tid >> 3, cch = tid & 7;
  const int frow = tid >> 4, fch = tid & 15;
  float rs[8], nm[8];
  const float* srow0 = nullptr;
  const float *gsc = nullptr, *gsh = nullptr;
  __syncthreads();
  if constexpr (AMODE == 1) {
    const int ci = cond_of_row(m0);
    gsc = a.sc + ci * 6144; gsh = a.sh + ci * 6144;
#pragma unroll
    for (int i = 0; i < 8; ++i) {
      rs[i] = 1.f; nm[i] = 0.f;
      if (a.stats) {
        const int row = m0 + frow + 16 * i;
        const float s = a.stats[row * 2], q = a.stats[row * 2 + 1];
        const float mu = s * (1.f / 1024.f);
        const float var = q * (1.f / 1024.f) - mu * mu;
        rs[i] = rsqrtf(fmaxf(var, 0.f) + LNEPS);
        nm[i] = -mu * rs[i];
      }
    }
    const int row0 = m0 + frow;
    srow0 = (row0 < TCTX ? a.A32lo + (size_t)row0 * 1024 : a.A32hi + (size_t)(row0 - TCTX) * 1024) + fch * 4;
  }
  acc[0][0] = zero16(); acc[0][1] = zero16(); acc[1][0] = zero16(); acc[1][1] = zero16();

  u4v ra[12], rb[4];
  float4 q0, q1, q2, q3;
  q0 = q1 = q3 = make_float4(0.f, 0.f, 0.f, 0.f); q2 = make_float4(1.f, 1.f, 1.f, 1.f);
  const u16* brow = Bt + (size_t)(n0 + crow) * ldb + cch * 8;
  auto issue = [&](int kt) {
    if constexpr (AMODE == 1) {
      const int k = kt * 64 + fch * 4;
      q0 = *(const float4*)(gsc + k); q1 = *(const float4*)(gsh + k);
      if (a.lng) { q2 = *(const float4*)(a.lng + k); q3 = *(const float4*)(a.lnb + k); }
    } else if constexpr (AMODE == 2) {
      const int k0 = kt * 64 + cch * 8;
      q0 = *(const float4*)(a.dsk + k0); q1 = *(const float4*)(a.dsk + k0 + 4);
    }
    if constexpr (AMODE == 0) {
      const u16* ap = a.A16 + (size_t)(m0 + crow) * a.lda + kt * 64 + cch * 8;
#pragma unroll
      for (int i = 0; i < 4; ++i) ra[i] = *(const u4v*)(ap + (size_t)(32 * i) * a.lda);
    } else if constexpr (AMODE == 1) {
#pragma unroll
      for (int i = 0; i < 8; ++i) ra[i] = *(const u4v*)(srow0 + (size_t)(16 * i) * 1024 + kt * 64);
    } else {
      const size_t o = (size_t)(m0 + crow) * 512 + kt * 64 + cch * 8;
#pragma unroll
      for (int i = 0; i < 4; ++i) {
        ra[i] = *(const u4v*)(a.SU + o + (size_t)(32 * i) * 512);
        ra[4 + i] = *(const u4v*)(a.YD0 + o + (size_t)(32 * i) * 512);
        ra[8 + i] = *(const u4v*)(a.YD1 + o + (size_t)(32 * i) * 512);
      }
    }
#pragma unroll
    for (int i = 0; i < 4; ++i) rb[i] = *(const u4v*)(brow + (size_t)(32 * i) * ldb + kt * 64);
  };
  auto stage = [&](int buf, int kt) {
    u16* Ad = As + buf * (128 * GST);
    if constexpr (AMODE == 0) {
#pragma unroll
      for (int i = 0; i < 4; ++i) *(u4v*)(Ad + (crow + 32 * i) * GST + cch * 8) = ra[i];
    } else if constexpr (AMODE == 1) {
      const float4 sc = q0, sh = q1, g = q2, b = q3;
      const float G0 = g.x * (1.f + sc.x), G1 = g.y * (1.f + sc.y), G2 = g.z * (1.f + sc.z), G3 = g.w * (1.f + sc.w);
      const float B0 = fmaf(b.x, 1.f + sc.x, sh.x), B1 = fmaf(b.y, 1.f + sc.y, sh.y), B2 = fmaf(b.z, 1.f + sc.z, sh.z), B3 = fmaf(b.w, 1.f + sc.w, sh.w);
#pragma unroll
      for (int i = 0; i < 8; ++i) {
        const float h0 = fmaf(fmaf(__uint_as_float(ra[i][0]), rs[i], nm[i]), G0, B0);
        const float h1 = fmaf(fmaf(__uint_as_float(ra[i][1]), rs[i], nm[i]), G1, B1);
        const float h2 = fmaf(fmaf(__uint_as_float(ra[i][2]), rs[i], nm[i]), G2, B2);
        const float h3 = fmaf(fmaf(__uint_as_float(ra[i][3]), rs[i], nm[i]), G3, B3);
        *(uint2*)(Ad + (frow + 16 * i) * GST + fch * 4) = make_uint2(pack2(h0, h1), pack2(h2, h3));
      }
    } else {
      const float4 da = q0, db = q1;
      const float dd[8] = {da.x, da.y, da.z, da.w, db.x, db.y, db.z, db.w};
#pragma unroll
      for (int i = 0; i < 4; ++i) {
        u4v o;
#pragma unroll
        for (int j = 0; j < 4; ++j) {
          const float v0 = geluf_(dd[2 * j] * bflo(ra[i][j]) + bflo(ra[4 + i][j]) + bflo(ra[8 + i][j]));
          const float v1 = geluf_(dd[2 * j + 1] * bfhi(ra[i][j]) + bfhi(ra[4 + i][j]) + bfhi(ra[8 + i][j]));
          o[j] = pack2(v0, v1);
        }
        *(u4v*)(Ad + (crow + 32 * i) * GST + cch * 8) = o;
      }
    }
    u16* Bd = Bs + buf * (128 * GST);
#pragma unroll
    for (int i = 0; i < 4; ++i) *(u4v*)(Bd + (crow + 32 * i) * GST + cch * 8) = rb[i];
  };
  auto compute = [&](int buf) {
    const u16* Ab = As + buf * (128 * GST) + (wm * 64 + (lane & 31)) * GST + (lane >> 5) * 8;
    const u16* Bb = Bs + buf * (128 * GST) + (wn * 64 + (lane & 31)) * GST + (lane >> 5) * 8;
#pragma unroll
    for (int ks = 0; ks < 4; ++ks) {
      s8v af0 = *(const s8v*)(Ab + ks * 16);
      s8v af1 = *(const s8v*)(Ab + 32 * GST + ks * 16);
      s8v bf0 = *(const s8v*)(Bb + ks * 16);
      s8v bf1 = *(const s8v*)(Bb + 32 * GST + ks * 16);
      acc[0][0] = __builtin_amdgcn_mfma_f32_32x32x16_bf16(af0, bf0, acc[0][0], 0, 0, 0);
      acc[0][1] = __builtin_amdgcn_mfma_f32_32x32x16_bf16(af0, bf1, acc[0][1], 0, 0, 0);
      acc[1][0] = __builtin_amdgcn_mfma_f32_32x32x16_bf16(af1, bf0, acc[1][0], 0, 0, 0);
      acc[1][1] = __builtin_amdgcn_mfma_f32_32x32x16_bf16(af1, bf1, acc[1][1], 0, 0, 0);
    }
  };

  const int nk = K >> 6;
  issue(0);
  stage(0, 0);
  __syncthreads();
#pragma unroll 1
  for (int kt = 0; kt < nk; ++kt) {
    const int buf = kt & 1;
    if (kt + 1 < nk) issue(kt + 1);
    compute(buf);
    if (kt + 1 < nk) stage(buf ^ 1, kt + 1);
    __syncthreads();
  }
}

__device__ __forceinline__ void gemm_mainloop0(char* smem, const u16* __restrict__ A, int lda, const u16* __restrict__ Bt, int ldb,
                                               int K, int m0, int n0, f16v (&acc)[2][2]) {
  u16* As = (u16*)smem;
  u16* Bs = As + 2 * 128 * GST;
  const int tid = ltid(), lane = tid & 63, wave = tid >> 6;
  const int wm = wave >> 1, wn = wave & 1;
  const int crow = tid >> 3, cch = tid & 7;
  __syncthreads();
  acc[0][0] = zero16(); acc[0][1] = zero16(); acc[1][0] = zero16(); acc[1][1] = zero16();
  const u16* arow = A + (size_t)(m0 + crow) * lda + cch * 8;
  const u16* brow = Bt + (size_t)(n0 + crow) * ldb + cch * 8;
  const size_t a32 = (size_t)32 * lda, b32 = (size_t)32 * ldb;
  u4v eA0, eA1, eA2, eA3, eB0, eB1, eB2, eB3, oA0, oA1, oA2, oA3, oB0, oB1, oB2, oB3;
#define G0_ISSUE(P, kt)                                                                                   \
  { const u16* ap_ = arow + (kt) * 64; const u16* bp_ = brow + (kt) * 64;                                 \
    P##A0 = *(const u4v*)(ap_); P##A1 = *(const u4v*)(ap_ + a32); P##A2 = *(const u4v*)(ap_ + 2 * a32);   \
    P##A3 = *(const u4v*)(ap_ + 3 * a32);                                                                 \
    P##B0 = *(const u4v*)(bp_); P##B1 = *(const u4v*)(bp_ + b32); P##B2 = *(const u4v*)(bp_ + 2 * b32);   \
    P##B3 = *(const u4v*)(bp_ + 3 * b32); }
#define G0_STAGE(P, buf)                                                                                  \
  { u16* Ad_ = As + (buf) * (128 * GST) + crow * GST + cch * 8; u16* Bd_ = Bs + (buf) * (128 * GST) + crow * GST + cch * 8; \
    *(u4v*)(Ad_) = P##A0; *(u4v*)(Ad_ + 32 * GST) = P##A1; *(u4v*)(Ad_ + 64 * GST) = P##A2; *(u4v*)(Ad_ + 96 * GST) = P##A3; \
    *(u4v*)(Bd_) = P##B0; *(u4v*)(Bd_ + 32 * GST) = P##B1; *(u4v*)(Bd_ + 64 * GST) = P##B2; *(u4v*)(Bd_ + 96 * GST) = P##B3; }
#define G0_COMPUTE(buf)                                                                                   \
  { const u16* Ab = As + (buf) * (128 * GST) + (wm * 64 + (lane & 31)) * GST + (lane >> 5) * 8;           \
    const u16* Bb = Bs + (buf) * (128 * GST) + (wn * 64 + (lane & 31)) * GST + (lane >> 5) * 8;           \
    __builtin_amdgcn_s_setprio(1);                                                                        \
    _Pragma("unroll") for (int ks = 0; ks < 4; ++ks) {                                                    \
      s8v af0 = *(const s8v*)(Ab + ks * 16);                                                              \
      s8v af1 = *(const s8v*)(Ab + 32 * GST + ks * 16);                                                   \
      s8v bf0 = *(const s8v*)(Bb + ks * 16);                                                              \
      s8v bf1 = *(const s8v*)(Bb + 32 * GST + ks * 16);                                                   \
      acc[0][0] = __builtin_amdgcn_mfma_f32_32x32x16_bf16(af0, bf0, acc[0][0], 0, 0, 0);                  \
      acc[0][1] = __builtin_amdgcn_mfma_f32_32x32x16_bf16(af0, bf1, acc[0][1], 0, 0, 0);                  \
      acc[1][0] = __builtin_amdgcn_mfma_f32_32x32x16_bf16(af1, bf0, acc[1][0], 0, 0, 0);                  \
      acc[1][1] = __builtin_amdgcn_mfma_f32_32x32x16_bf16(af1, bf1, acc[1][1], 0, 0, 0);                  \
    }                                                                                                     \
    __builtin_amdgcn_s_setprio(0); }
  const int nk = K >> 6;
  G0_ISSUE(e, 0)
  G0_ISSUE(o, 1)
  G0_STAGE(e, 0)
  __syncthreads();
  int kt = 0;
#pragma unroll 1
  for (; kt + 3 < nk; kt += 2) {
    G0_ISSUE(e, kt + 2)
    __builtin_amdgcn_sched_barrier(0);
    G0_COMPUTE(0)
    G0_STAGE(o, 1)
    __syncthreads();
    G0_ISSUE(o, kt + 3)
    __builtin_amdgcn_sched_barrier(0);
    G0_COMPUTE(1)
    G0_STAGE(e, 0)
    __syncthreads();
  }
  G0_COMPUTE(0)
  G0_STAGE(o, 1)
  __syncthreads();
  G0_COMPUTE(1)
  __syncthreads();
#undef G0_ISSUE
#undef G0_STAGE
#undef G0_COMPUTE
}

#define EPI_ROW(mi, reg) (m0 + wm * 64 + (mi) * 32 + ((reg) & 3) + 8 * ((reg) >> 2) + 4 * (lane >> 5))
#define EPI_COL(ni) (n0 + wn * 64 + (ni) * 32 + (lane & 31))


#define CST 136
__device__ __forceinline__ void cs_store(const u16* Cs, u16* __restrict__ dst, size_t ld, int tid) {
#pragma unroll
  for (int i = 0; i < 8; ++i) {
    const int c = tid + 256 * i, r = c >> 4, ch = c & 15;
    *(u4v*)(dst + (size_t)r * ld + ch * 8) = *(const u4v*)(Cs + r * CST + ch * 8);
  }
}

__device__ __forceinline__ void stats_accum(float* stats, int row, float v0, float v1, int lane) {
  float s = v0 + v1, q = v0 * v0 + v1 * v1;
#pragma unroll
  for (int o = 1; o < 32; o <<= 1) {
    s += __shfl_xor(s, o);
    q += __shfl_xor(q, o);
  }
  if ((lane & 31) == 0) {
    atomicAdd(stats + row * 2, s);
    atomicAdd(stats + row * 2 + 1, q);
  }
}

#define P0_ADA 768
#define P0_ROPE 1
#define P0_CACHE 64
#define P0_S0 64
#define P0_S5 128
#define P0_WT_PER_LAYER (16 * 112 + 8 * 8 + 3 * 8 * 16 + 16 * 16 + 16 * 88 + 44 * 16)
#define P0_WT (2 * P0_WT_PER_LAYER)
#define P0_ITEMS (P0_ADA + P0_ROPE + P0_CACHE + P0_S0 + P0_S5 + P0_WT)

__device__ __forceinline__ void wt_tile(const float* __restrict__ src, int N, u16* __restrict__ dst, int ldd, int kt, int nt, char* smem) {
  float* tile = (float*)smem;
  const int tid = ltid();
  __syncthreads();
  {
    const int c4 = (tid & 15) * 4, r0 = tid >> 4;
#pragma unroll
    for (int i = 0; i < 4; ++i) {
      const int k = r0 + 16 * i;
      const float4 v = *(const float4*)(src + (size_t)(kt * 64 + k) * N + nt * 64 + c4);
      tile[k * 65 + c4] = v.x; tile[k * 65 + c4 + 1] = v.y; tile[k * 65 + c4 + 2] = v.z; tile[k * 65 + c4 + 3] = v.w;
    }
  }
  __syncthreads();
  {
    const int n = tid >> 2, k0 = (tid & 3) * 16;
#define WTP(j) pack2(tile[(k0 + 2 * (j)) * 65 + n], tile[(k0 + 2 * (j) + 1) * 65 + n])
    u4v* d = (u4v*)(dst + (size_t)(nt * 64 + n) * ldd + kt * 64 + k0);
    d[0] = (u4v){WTP(0), WTP(1), WTP(2), WTP(3)};
    d[1] = (u4v){WTP(4), WTP(5), WTP(6), WTP(7)};
#undef WTP
  }
}
__device__ __forceinline__ void wt_item(const Params& p, char* smem, int item) {
  const int l = item / P0_WT_PER_LAYER;
  int it = item % P0_WT_PER_LAYER;
  u16* base = WS_Wt + WT_LAYER * l;
  if (it < 16 * 112) { wt_tile(p.w_in + (size_t)l * 1024 * 7168, 7168, base + WT_IN, 1024, it / 112, it % 112, smem); return; }
  it -= 16 * 112;
  if (it < 64) { wt_tile(p.w_glu + (size_t)l * 512 * 512, 512, base + WT_GLU, 512, it / 8, it % 8, smem); return; }
  it -= 64;
  if (it < 384) { const int br = it / 128; it %= 128;
    wt_tile(p.w_branch + ((size_t)l * 3 + br) * 512 * 1024, 1024, base + WT_BR + (size_t)br * 512 * 1024, 512, it / 16, it % 16, smem); return; }
  it -= 384;
  if (it < 256) { wt_tile(p.w_o + (size_t)l * 1024 * 1024, 1024, base + WT_O, 1024, it / 16, it % 16, smem); return; }
  it -= 256;
  if (it < 16 * 88) { wt_tile(p.w_up + (size_t)l * 1024 * 5632, 5632, base + WT_UP, 1024, it / 88, it % 88, smem); return; }
  it -= 16 * 88;
  wt_tile(p.w_down + (size_t)l * 2816 * 1024, 1024, base + WT_DOWN, 2816, it / 16, it % 16, smem);
}

__device__ __forceinline__ void phase0_item(const Params& p, char* smem, int item) {
  const int tid = ltid();
  if (item < P0_ADA) {
    const int ks = item & 3, cg = (item >> 2) % 96, l = item / 384;
    float* scs = (float*)smem;
    float* red = scs + 5 * 256;
    __syncthreads();
    for (int i = tid; i < 5 * 256; i += 256) {
      int ci = i >> 8, k = ks * 256 + (i & 255);
      float v = ci == 0 ? p.c_ctx[k] : p.c[(ci - 1) * 1024 + k];
      scs[i] = siluf_(v);
    }
    __syncthreads();
    const int ct = tid & 15, kg = tid >> 4;
    const float* wp = p.w_ada + (size_t)l * 1024 * 6144 + (size_t)(ks * 256 + kg * 16) * 6144 + cg * 64 + ct * 4;
    float acc[5][4];
#pragma unroll
    for (int i = 0; i < 5; ++i)
#pragma unroll
      for (int j = 0; j < 4; ++j) acc[i][j] = 0.f;
#pragma unroll 4
    for (int k = 0; k < 16; ++k) {
      float4 w = *(const float4*)(wp + (size_t)k * 6144);
#pragma unroll
      for (int ci = 0; ci < 5; ++ci) {
        float s = scs[ci * 256 + kg * 16 + k];
        acc[ci][0] += s * w.x; acc[ci][1] += s * w.y; acc[ci][2] += s * w.z; acc[ci][3] += s * w.w;
      }
    }
#pragma unroll
    for (int ci = 0; ci < 5; ++ci)
#pragma unroll
      for (int j = 0; j < 4; ++j) red[(kg * 5 + ci) * 64 + ct * 4 + j] = acc[ci][j];
    __syncthreads();
    for (int i = tid; i < 320; i += 256) {
      int ci = i >> 6, col = i & 63;
      float s = 0.f;
#pragma unroll
      for (int g = 0; g < 16; ++g) s += red[(g * 5 + ci) * 64 + col];
      if (ks == 0) s += p.b_ada[l * 6144 + cg * 64 + col];
      atomicAdd(WS_mod + (l * 5 + ci) * 6144 + cg * 64 + col, s);
    }
    return;
  }
  item -= P0_ADA;
  if (item < P0_ROPE) {
    for (int i = tid; i < 64 * 32; i += 256) {
      int pos = i >> 5, fi = i & 31;
      float inv = (float)pow(10000.0, -(double)fi / 32.0);
      float ang = (float)pos * inv;
      WS_ropetab[i * 2] = (float)cos((double)ang);
      WS_ropetab[i * 2 + 1] = (float)sin((double)ang);
    }
    return;
  }
  item -= P0_ROPE;
  if (item < P0_CACHE) {
    const int pc = item & 7, b = (item >> 3) & 3, l = item >> 5;
    const float* ksrc = p.cache_k + ((size_t)(b * 2 + l) * 512 + pc * 64) * 512;
    const float* vsrc = p.cache_v + ((size_t)(b * 2 + l) * 512 + pc * 64) * 512;
    u16* kdst = WS_CK + ((size_t)(l * 4 + b) * 512 + pc * 64) * 512;
    for (int i = tid; i < 64 * 512 / 4; i += 256) {
      float4 v = *(const float4*)(ksrc + (size_t)i * 4);
      *(uint2*)(kdst + (size_t)i * 4) = make_uint2(pack2(v.x, v.y), pack2(v.z, v.w));
    }
    for (int cc = 0; cc < 2; ++cc) {
      const int col = tid + cc * 256;
      u16* vdst = WS_CVt + ((size_t)(l * 4 + b) * 512 + col) * 512 + pc * 64;
      for (int j = 0; j < 8; ++j) {
        float v[8];
#pragma unroll
        for (int e = 0; e < 8; ++e) v[e] = vsrc[(size_t)(j * 8 + e) * 512 + col];
        *(uint4*)(vdst + j * 8) = make_uint4(pack2(v[0], v[1]), pack2(v[2], v[3]), pack2(v[4], v[5]), pack2(v[6], v[7]));
      }
    }
    return;
  }
  item -= P0_CACHE;
  if (item < P0_S0) {
    const int hh = item & 3, dir = (item >> 2) & 1, b = (item >> 3) & 3, l = item >> 5;
    const float* src = p.state_ret + ((size_t)(((b * 2 + l) * 2 + dir) * 4 + hh)) * 16384;
    u16* dst = WS_S0t + ((size_t)(((l * 4 + b) * 2 + dir) * 4 + hh)) * 16384;
    const int dv = tid & 127, kh = tid >> 7;
    for (int j = 0; j < 8; ++j) {
      const int dk0 = kh * 64 + j * 8;
      float v[8];
#pragma unroll
      for (int e = 0; e < 8; ++e) v[e] = src[(size_t)(dk0 + e) * 128 + dv];
      *(uint4*)(dst + (size_t)dv * 128 + dk0) = make_uint4(pack2(v[0], v[1]), pack2(v[2], v[3]), pack2(v[4], v[5]), pack2(v[6], v[7]));
    }
    return;
  }
  item -= P0_S0;
  if (item >= P0_S5) { wt_item(p, smem, item - P0_S5); return; }
  {
    const int g = item & 31, dir = (item >> 5) & 1, l = item >> 6;
    if (tid < 64) {
      const int pp = tid;
      const int ai = ((l * 2 + dir) * 32 + g) * 64 + pp;
      double lre = fmin((double)p.a_re[ai], -1e-4), lim = (double)p.a_im[ai];
      double dt = exp((double)p.log_dt[(l * 2 + dir) * 32 + g]);
      double er = exp(lre * dt);
      double abr = er * cos(lim * dt), abi = er * sin(lim * dt);
      WS_abar[ai * 2] = (float)abr;
      WS_abar[ai * 2 + 1] = (float)abi;
      double nr = abr - 1.0, ni = abi;
      double den = lre * lre + lim * lim;
      double cr = (nr * lre + ni * lim) / den, cim = (ni * lre - nr * lim) / den;
      u16* bt = WS_bbarT + (size_t)((l * 2 + dir) * 32 + g) * 128 * 16;
      const float* br = p.b_re + ((size_t)(l * 32 + g) * 64 + pp) * 16;
      const float* bi = p.b_im + ((size_t)(l * 32 + g) * 64 + pp) * 16;
      for (int c = 0; c < 16; ++c) {
        double xr = br[c], xi = bi[c];
        bt[pp * 16 + c] = f2bf((float)(cr * xr - cim * xi));
        bt[(64 + pp) * 16 + c] = f2bf((float)(cr * xi + cim * xr));
      }
      u16* ct = WS_cmT + (size_t)((l * 2 + dir) * 32 + g) * 16 * 128;
      const float* cre = p.c_re + ((size_t)((l * 2 + dir) * 32 + g) * 16) * 64;
      const float* cie = p.c_im + ((size_t)((l * 2 + dir) * 32 + g) * 16) * 64;
      for (int c = 0; c < 16; ++c) {
        ct[c * 128 + pp] = f2bf(cre[c * 64 + pp]);
        ct[c * 128 + 64 + pp] = f2bf(-cie[c * 64 + pp]);
      }
    }
  }
}


__device__ __forceinline__ void hmat_item(const Params& p, int l, int which, int item) {
  const int c = ltid() * 4;
  const int row0 = item * 8;
  const int ci = cond_of_row(row0);
  const float* mod = WS_mod + (l * 5 + ci) * 6144;
  const float4 sc = *(const float4*)(mod + (which ? 4 : 1) * 1024 + c);
  const float4 sh = *(const float4*)(mod + (which ? 3 : 0) * 1024 + c);
  float4 g = make_float4(1.f, 1.f, 1.f, 1.f), b = make_float4(0.f, 0.f, 0.f, 0.f);
  const float* st = nullptr;
  if (which == 1) { g = *(const float4*)(p.ln1_g + l * 1024 + c); b = *(const float4*)(p.ln1_b + l * 1024 + c); st = WS_stats + (size_t)(l * 2 + 0) * TALL * 2; }
  else if (l == 1) { g = *(const float4*)(p.ln2_g + c); b = *(const float4*)(p.ln2_b + c); st = WS_stats + (size_t)(0 * 2 + 1) * TALL * 2; }
  const float G0 = g.x * (1.f + sc.x), G1 = g.y * (1.f + sc.y), G2 = g.z * (1.f + sc.z), G3 = g.w * (1.f + sc.w);
  const float B0 = fmaf(b.x, 1.f + sc.x, sh.x), B1 = fmaf(b.y, 1.f + sc.y, sh.y), B2 = fmaf(b.z, 1.f + sc.z, sh.z), B3 = fmaf(b.w, 1.f + sc.w, sh.w);
  u16* dst = which ? WS_h2 : WS_h1;
#pragma unroll
  for (int r = 0; r < 8; ++r) {
    const int row = row0 + r;
    const float* src;
    if (which == 1) src = WS_pre1 + (size_t)row * 1024;
    else if (l == 1) src = p.out + (size_t)row * 1024;
    else src = row < TCTX ? p.x_prompt + (size_t)row * 1024 : p.x_sample + (size_t)(row - TCTX) * 1024;
    float rs = 1.f, nm = 0.f;
    if (st) {
      const float s = st[row * 2], q = st[row * 2 + 1];
      const float mu = s * (1.f / 1024.f);
      rs = rsqrtf(fmaxf(q * (1.f / 1024.f) - mu * mu, 0.f) + LNEPS);
      nm = -mu * rs;
    }
    const float4 x = *(const float4*)(src + c);
    const float h0 = fmaf(fmaf(x.x, rs, nm), G0, B0), h1 = fmaf(fmaf(x.y, rs, nm), G1, B1);
    const float h2 = fmaf(fmaf(x.z, rs, nm), G2, B2), h3 = fmaf(fmaf(x.w, rs, nm), G3, B3);
    *(uint2*)(dst + (size_t)row * 1024 + c) = make_uint2(pack2(h0, h1), pack2(h2, h3));
  }
}

__device__ __forceinline__ void p1_item(const Params& p, char* smem, int l, int item) {
  const int mt = item & 63, nt = item >> 6;
  const int m0 = mt * 128, n0 = nt * 128;
  const int tid = ltid(), lane = tid & 63, wave = tid >> 6, wm = wave >> 1, wn = wave & 1;
  f16v acc[2][2];
  gemm_mainloop0(smem, WS_h1, 1024, WS_Wt + WT_LAYER * l + WT_IN, 1024, 1024, m0, n0, acc);

  const bool latent = m0 >= TCTX;
  const int seg = n0 >> 9;
  const int cs0 = n0 & 511;
  const int l31 = lane & 31;
  u16* Cs = (u16*)smem;
  u16* CsT = Cs + 128 * CST;
  const int rl0 = wm * 64 + 4 * (lane >> 5);
  const int cl0 = wn * 64 + l31;
  const bool want_rm = !(seg == 2 || seg == 7);
  const bool want_t = (seg == 2 || seg == 7 || (seg == 1 && !latent));
#pragma unroll
  for (int mi = 0; mi < 2; ++mi)
#pragma unroll
    for (int q = 0; q < 4; ++q) {
      float o0[4], o1[4];
#pragma unroll
      for (int j = 0; j < 4; ++j) {
        const int reg = q * 4 + j;
        float x1 = acc[mi][0][reg], x2 = acc[mi][1][reg];
        if (seg <= 1) {
          if (latent) {
            const int pos = (m0 - TCTX + rl0 + mi * 32 + q * 8 + j) & 1023;
            const int pidx = ((cs0 + wn * 64) & 64) ? (pos & 63) : (pos >> 6);
            const float cs = WS_ropetab[(pidx * 32 + l31) * 2], sn = WS_ropetab[(pidx * 32 + l31) * 2 + 1];
            const float t1 = x1 * cs - x2 * sn, t2 = x1 * sn + x2 * cs;
            x1 = t1; x2 = t2;
          }
          if (seg == 1) { x1 *= 0.08838834764831845f; x2 *= 0.08838834764831845f; }
        } else if (seg == 3) { x1 = siluf_(x1); x2 = siluf_(x2); }
        else if (seg == 5) { x1 *= 0.125f; x2 *= 0.125f; }
        else if (seg >= 8) { x1 = sigmoidf_(x1); x2 = sigmoidf_(x2); }
        o0[j] = x1; o1[j] = x2;
        if (want_rm) {
          const int rl = rl0 + mi * 32 + q * 8 + j;
          Cs[rl * CST + cl0] = f2bf(x1);
          Cs[rl * CST + cl0 + 32] = f2bf(x2);
        }
        if ((seg == 6 || seg == 7) && !latent) {
          const int row = m0 + rl0 + mi * 32 + q * 8 + j;
          float* o = p.out + (seg == 6 ? OUT_CK : OUT_CV) + ((size_t)((row >> 8) * 2 + l) * 256 + (row & 255)) * 512 + cs0 + cl0;
          o[0] = acc[mi][0][reg]; o[32] = acc[mi][1][reg];
        }
      }
      if (want_t) {
        const int rl = rl0 + mi * 32 + q * 8;
        *(uint2*)(CsT + cl0 * CST + rl) = make_uint2(pack2(o0[0], o0[1]), pack2(o0[2], o0[3]));
        *(uint2*)(CsT + (cl0 + 32) * CST + rl) = make_uint2(pack2(o1[0], o1[1]), pack2(o1[2], o1[3]));
      }
    }
  __syncthreads();
  if (want_rm) {
    u16* dst;
    size_t ld = 512;
    if (seg >= 8) { dst = WS_GT + (size_t)m0 * 3072 + (n0 - 4096); ld = 3072; }
    else {
      u16* base = seg == 0 ? WS_Q : seg == 1 ? WS_K : seg == 3 ? WS_G : seg == 4 ? WS_SU : seg == 5 ? WS_NQ : WS_NK;
      dst = base + (size_t)m0 * 512 + cs0;
    }
    cs_store(Cs, dst, ld, tid);
  }
  if (want_t) {
    u16* base = seg == 2 ? WS_VtR : seg == 7 ? WS_NVt : WS_KtR;
    u16* dst;
    size_t ld;
    if (!latent) { dst = base + ((size_t)(m0 >> 8) * 512 + cs0) * 256 + (m0 & 255); ld = 256; }
    else { dst = base + VTR_LAT + ((size_t)((m0 - TCTX) >> 10) * 512 + cs0) * 1024 + ((m0 - TCTX) & 1023); ld = 1024; }
    cs_store(CsT, dst, ld, tid);
  }
}

template <int D, int MODE>
__device__ __forceinline__ void attn_item(const Params& p, char* smem, int l, int idx) {
  constexpr int KSTR = D + 8;
  constexpr int NKS = D / 32;
  constexpr int NB = D / 16;
  constexpr int NCH = D / 32;
  u16* Ks = (u16*)smem;
  u16* Vts = Ks + 64 * KSTR;
  float* rpbs = (float*)(Vts + D * 72);
  const int tid = ltid(), lane = tid & 63, wave = tid >> 6;
  const int l15 = lane & 15, g = lane >> 4;
  const int wave_u = __builtin_amdgcn_readfirstlane(wave);

  int b, hh, qt, L, tokbase, nt;
  bool latent = false;
  int kr0 = 0, rrow = 0;
  if constexpr (MODE == 0) {
    if (idx < 256) { latent = true; b = idx >> 6; hh = (idx >> 4) & 3; qt = idx & 15; L = 1024; tokbase = TCTX + b * 1024; nt = 16 + 4; }
    else { idx -= 256; b = idx >> 4; hh = (idx >> 2) & 3; qt = idx & 3; L = 256; tokbase = b * 256; nt = 4; }
  } else if constexpr (MODE == 1) {
    b = idx >> 5; hh = (idx >> 2) & 7; qt = idx & 3; L = 256; tokbase = b * 256; nt = 4;
  } else {
    b = idx >> 7; hh = (idx >> 4) & 7; qt = idx & 15; rrow = qt; L = 1024; tokbase = TCTX + b * 1024; nt = 16; latent = true;
    kr0 = min(max(rrow - 4, 0), 8);
  }
  const int tq = qt * 64 + wave * 16 + l15;
  const int qtok = tokbase + tq;

  float lgf2 = 0.f, lgb2 = 0.f;
  if constexpr (MODE == 0) {
    float xf = p.ret_decay[(l * 2 + 0) * 4 + hh], xb = p.ret_decay[(l * 2 + 1) * 4 + hh];
    lgf2 = -log1pf(expf(-xf)) * 1.4426950408889634f;
    lgb2 = -log1pf(expf(-xb)) * 1.4426950408889634f;
  }
  float cfw[4][4], cbw[4][4];
  if constexpr (MODE == 0) {
#pragma unroll
    for (int kb = 0; kb < 4; ++kb)
#pragma unroll
      for (int r = 0; r < 4; ++r) {
        const float off = (float)(kb * 16 + g * 4 + r);
        cfw[kb][r] = __builtin_amdgcn_exp2f(-lgf2 * off);
        cbw[kb][r] = __builtin_amdgcn_exp2f(lgb2 * off);
      }
  }

  __syncthreads();
  if constexpr (MODE == 2) {
    for (int i = tid; i < 465; i += 256) rpbs[i] = p.rpb[(size_t)(l * 8 + hh) * 465 + i];
  }

  u4v qf[NKS];
  {
    const u16* qb = (MODE == 0 ? WS_Q : WS_NQ) + (size_t)qtok * 512 + hh * D + g * 8;
#pragma unroll
    for (int ks = 0; ks < NKS; ++ks) qf[ks] = *(const u4v*)(qb + ks * 32);
  }

  f4v ot[NB];
#pragma unroll
  for (int nb = 0; nb < NB; ++nb) ot[nb] = (f4v){0.f, 0.f, 0.f, 0.f};
  float mrun = -1e30f, lsum = 0.f, tmax_pend = -1e30f;

  const int ntk = (MODE == 0) ? (L >> 6) : nt;
  u4v kr[NCH], vr[NCH];
#define ATTN_ISSUE(KT)                                                                                   \
  {                                                                                                      \
    const int kt_ = (KT);                                                                                \
    const u16* kp; const u16* vp; int ldv;                                                               \
    if constexpr (MODE == 0) {                                                                           \
      kp = WS_K + (size_t)(tokbase + kt_ * 64) * 512 + hh * 128;                                          \
      if (latent) { vp = WS_VtR + VTR_LAT + ((size_t)(b * 4 + hh) * 128) * 1024 + kt_ * 64; ldv = 1024; } \
      else { vp = WS_VtR + ((size_t)(b * 4 + hh) * 128) * 256 + kt_ * 64; ldv = 256; }                    \
    } else if constexpr (MODE == 1) {                                                                    \
      kp = WS_NK + (size_t)(tokbase + kt_ * 64) * 512 + hh * 64;                                          \
      vp = WS_NVt + ((size_t)(b * 8 + hh) * 64) * 256 + kt_ * 64; ldv = 256;                              \
    } else {                                                                                             \
      if (kt_ < 8) {                                                                                     \
        const int krow = kr0 + kt_;                                                                      \
        kp = WS_NK + (size_t)(tokbase + krow * 64) * 512 + hh * 64;                                       \
        vp = WS_NVt + NVT_LAT + ((size_t)(b * 8 + hh) * 64) * 1024 + krow * 64; ldv = 1024;               \
      } else {                                                                                           \
        kp = WS_CK + ((size_t)(l * 4 + b) * 512 + (kt_ - 8) * 64) * 512 + hh * 64;                        \
        vp = WS_CVt + ((size_t)((l * 4 + b) * 8 + hh) * 64) * 512 + (kt_ - 8) * 64; ldv = 512;            \
      }                                                                                                  \
    }                                                                                                    \
    _Pragma("unroll") for (int i = 0; i < NCH; ++i) {                                                    \
      const int c = tid + 256 * i;                                                                       \
      const int r = c / (D / 8), cc = c % (D / 8);                                                       \
      kr[i] = *(const u4v*)(kp + (size_t)r * 512 + cc * 8);                                              \
      const int vrw = c >> 3, vc = c & 7;                                                                \
      vr[i] = *(const u4v*)(vp + (size_t)vrw * ldv + vc * 8);                                            \
    }                                                                                                    \
  }
#define ATTN_STAGE()                                                                                     \
  {                                                                                                      \
    _Pragma("unroll") for (int i = 0; i < NCH; ++i) {                                                    \
      const int c = tid + 256 * i;                                                                       \
      const int r = c / (D / 8), cc = c % (D / 8);                                                       \
      *(u4v*)(Ks + r * KSTR + cc * 8) = kr[i];                                                           \
      const int vrw = c >> 3, vc = c & 7;                                                                \
      *(u4v*)(Vts + vrw * 72 + vc * 8) = vr[i];                                                          \
    }                                                                                                    \
  }

  ATTN_ISSUE(0)
#pragma unroll 1
  for (int kt = 0; kt < ntk; ++kt) {
    __syncthreads();
    ATTN_STAGE()
    __syncthreads();
    if (kt + 1 < ntk) ATTN_ISSUE(kt + 1)
    f4v st[4];
    int kb_lo = 0, kb_hi = 3;
    if constexpr (MODE == 2) {
      if (kt < 8) { kb_lo = wave_u >= 2 ? wave_u - 1 : 0; kb_hi = wave_u <= 1 ? wave_u + 1 : 3; }
    }
#pragma unroll
    for (int kb = 0; kb < 4; ++kb) {
      st[kb] = (f4v){0.f, 0.f, 0.f, 0.f};
      if (MODE != 2 || (kb >= kb_lo && kb <= kb_hi)) {
#pragma unroll
        for (int ks = 0; ks < NKS; ++ks) {
          s8v kf = *(const s8v*)(Ks + (kb * 16 + l15) * KSTR + ks * 32 + g * 8);
          st[kb] = __builtin_amdgcn_mfma_f32_16x16x32_bf16(kf, bc8(qf[ks]), st[kb], 0, 0, 0);
        }
      }
    }
    if constexpr (MODE == 0) {
      if (kt < qt) {
        const float rowf = __builtin_amdgcn_exp2f(lgf2 * (float)(tq - kt * 64));
#pragma unroll
        for (int kb = 0; kb < 4; ++kb)
#pragma unroll
          for (int r = 0; r < 4; ++r) st[kb][r] *= rowf * cfw[kb][r];
      } else if (kt > qt) {
        const float rowb = __builtin_amdgcn_exp2f(lgb2 * (float)(kt * 64 - tq));
#pragma unroll
        for (int kb = 0; kb < 4; ++kb)
#pragma unroll
          for (int r = 0; r < 4; ++r) st[kb][r] *= rowb * cbw[kb][r];
      } else {
#pragma unroll
        for (int kb = 0; kb < 4; ++kb)
#pragma unroll
          for (int r = 0; r < 4; ++r) {
            const int ts = kt * 64 + kb * 16 + g * 4 + r;
            const int d = tq - ts;
            float dec = d > 0 ? __builtin_amdgcn_exp2f(lgf2 * (float)d) : (d < 0 ? __builtin_amdgcn_exp2f(lgb2 * (float)(-d)) : 2.f);
            st[kb][r] *= dec;
          }
      }
    } else {
      if constexpr (MODE == 2) {
        if (kt < 8) {
          const int qc = wave * 16 + l15;
          const int ws = min(max(qc - 8, 0), 48);
          const int roff = (kr0 + kt) - rrow + 7;
#pragma unroll
          for (int kb = 0; kb < 4; ++kb) {
            if (kb >= kb_lo && kb <= kb_hi) {
#pragma unroll
              for (int r = 0; r < 4; ++r) {
                const int kc = kb * 16 + g * 4 + r;
                const bool valid = (kc >= ws) && (kc < ws + 16);
                const int coff = min(max(kc - qc + 15, 0), 30);
                const float bias = rpbs[roff * 31 + coff];
                st[kb][r] = valid ? st[kb][r] + bias : -1e30f;
              }
            } else {
              st[kb] = (f4v){-1e30f, -1e30f, -1e30f, -1e30f};
            }
          }
        }
      }
      float tmax = st[0][0];
#pragma unroll
      for (int kb = 0; kb < 4; ++kb)
#pragma unroll
        for (int r = 0; r < 4; ++r) tmax = fmaxf(tmax, st[kb][r]);
      tmax = fmaxf(tmax, __shfl_xor(tmax, 16));
      tmax = fmaxf(tmax, __shfl_xor(tmax, 32));
      tmax_pend = tmax;
      float mref = mrun;
      if (kt == 0) {
        asm volatile("" : "+v"(tmax));
        mref = tmax;
        mrun = tmax;
      }
      float ps = 0.f;
#pragma unroll
      for (int kb = 0; kb < 4; ++kb) {
        if (MODE != 2 || (kb >= kb_lo && kb <= kb_hi)) {
#pragma unroll
          for (int r = 0; r < 4; ++r) {
            float e = __expf(st[kb][r] - mref);
            st[kb][r] = e;
            ps += e;
          }
        } else {
          st[kb] = (f4v){0.f, 0.f, 0.f, 0.f};
        }
      }
      lsum += ps;
    }
    u4v pf[2];
#pragma unroll
    for (int s = 0; s < 2; ++s) {
      pf[s] = (u4v){pack2(st[2 * s][0], st[2 * s][1]), pack2(st[2 * s][2], st[2 * s][3]),
                    pack2(st[2 * s + 1][0], st[2 * s + 1][1]), pack2(st[2 * s + 1][2], st[2 * s + 1][3])};
    }
#pragma unroll
    for (int s = 0; s < 2; ++s) {
      if (MODE == 2 && (2 * s + 1 < kb_lo || 2 * s > kb_hi)) continue;
#pragma unroll
      for (int nb = 0; nb < NB; ++nb) {
        const u16* vb = Vts + (nb * 16 + l15) * 72 + s * 32 + g * 4;
        uint2 lo = *(const uint2*)(vb);
        uint2 hi = *(const uint2*)(vb + 16);
        u4v vf = (u4v){lo.x, lo.y, hi.x, hi.y};
        ot[nb] = __builtin_amdgcn_mfma_f32_16x16x32_bf16(bc8(vf), bc8(pf[s]), ot[nb], 0, 0, 0);
      }
    }
    if constexpr (MODE != 0) {
      const float mnew = fmaxf(mrun, tmax_pend);
      if (__builtin_amdgcn_ballot_w64(mnew > mrun) != 0ull) {
        const float alpha = __expf(mrun - mnew);
        lsum *= alpha;
#pragma unroll
        for (int nb = 0; nb < NB; ++nb) ot[nb] *= alpha;
        mrun = mnew;
      }
    }
  }

  if constexpr (MODE == 0) {
    if (latent) {
#pragma unroll 1
      for (int dir = 0; dir < 2; ++dir) {
        const float scale = dir == 0 ? __builtin_amdgcn_exp2f(lgf2 * (float)(tq + 1)) : __builtin_amdgcn_exp2f(lgb2 * (float)(L - tq));
        const u16* S0 = WS_S0t + ((size_t)(((l * 4 + b) * 2 + dir) * 4 + hh)) * 16384;
#pragma unroll
        for (int s = 0; s < NKS; ++s) {
          u4v pq = (u4v){pack2(bflo(qf[s][0]) * scale, bfhi(qf[s][0]) * scale), pack2(bflo(qf[s][1]) * scale, bfhi(qf[s][1]) * scale),
                         pack2(bflo(qf[s][2]) * scale, bfhi(qf[s][2]) * scale), pack2(bflo(qf[s][3]) * scale, bfhi(qf[s][3]) * scale)};
#pragma unroll
          for (int nb = 0; nb < NB; ++nb) {
            u4v vf = *(const u4v*)(S0 + (size_t)(nb * 16 + l15) * 128 + s * 32 + g * 8);
            ot[nb] = __builtin_amdgcn_mfma_f32_16x16x32_bf16(bc8(vf), bc8(pq), ot[nb], 0, 0, 0);
          }
        }
      }
    }
    float s = 0.f;
#pragma unroll
    for (int nb = 0; nb < NB; ++nb) s += ot[nb][0] + ot[nb][1] + ot[nb][2] + ot[nb][3];
    s += __shfl_xor(s, 16); s += __shfl_xor(s, 32);
    const float mu = s * (1.f / 128.f);
    float q = 0.f;
#pragma unroll
    for (int nb = 0; nb < NB; ++nb)
#pragma unroll
      for (int r = 0; r < 4; ++r) { float dlt = ot[nb][r] - mu; q += dlt * dlt; }
    q += __shfl_xor(q, 16); q += __shfl_xor(q, 32);
    const float rstd = rsqrtf(q * (1.f / 128.f) + LNEPS);
#pragma unroll
    for (int nb = 0; nb < NB; ++nb) {
      const size_t off = (size_t)qtok * 512 + hh * 128 + nb * 16 + g * 4;
      uint2 gg = *(const uint2*)(WS_G + off);
      float o0 = (ot[nb][0] - mu) * rstd * bflo(gg.x);
      float o1 = (ot[nb][1] - mu) * rstd * bfhi(gg.x);
      float o2 = (ot[nb][2] - mu) * rstd * bflo(gg.y);
      float o3 = (ot[nb][3] - mu) * rstd * bfhi(gg.y);
      *(uint2*)(WS_rout + off) = make_uint2(pack2(o0, o1), pack2(o2, o3));
    }
  } else {
    lsum += __shfl_xor(lsum, 16); lsum += __shfl_xor(lsum, 32);
    const float inv = __builtin_amdgcn_rcpf(lsum);
#pragma unroll
    for (int nb = 0; nb < NB; ++nb) {
      const size_t off = (size_t)qtok * 512 + hh * 64 + nb * 16 + g * 4;
      *(uint2*)(WS_nout + off) = make_uint2(pack2(ot[nb][0] * inv, ot[nb][1] * inv), pack2(ot[nb][2] * inv, ot[nb][3] * inv));
    }
  }
}

__device__ __forceinline__ void retstate_item(const Params& p, int l, int idx) {
  const int dir = idx & 1, hh = (idx >> 1) & 3, b = idx >> 3;
  const int tid = ltid(), lane = tid & 63, wave = tid >> 6;
  const int r = lane & 31, h2 = lane >> 5;
  const float x = p.ret_decay[(l * 2 + dir) * 4 + hh];
  const float lg2 = -log1pf(expf(-x)) * 1.4426950408889634f;
  const u16* Kt = WS_KtR + ((size_t)(b * 4 + hh) * 128) * 256;
  const u16* Vt = WS_VtR + ((size_t)(b * 4 + hh) * 128) * 256;
  f16v acc[4];
#pragma unroll
  for (int i = 0; i < 4; ++i) acc[i] = zero16();
#pragma unroll 2
  for (int ks = 0; ks < 16; ++ks) {
    const int tok0 = ks * 16 + h2 * 8;
    const u4v a = *(const u4v*)(Kt + (size_t)(wave * 32 + r) * 256 + tok0);
    u4v af;
#pragma unroll
    for (int w = 0; w < 4; ++w) {
      const int t0 = tok0 + 2 * w, t1 = t0 + 1;
      float w0 = __builtin_amdgcn_exp2f(lg2 * (float)(dir == 0 ? 255 - t0 : t0));
      float w1 = __builtin_amdgcn_exp2f(lg2 * (float)(dir == 0 ? 255 - t1 : t1));
      af[w] = pack2(bflo(a[w]) * w0, bfhi(a[w]) * w1);
    }
#pragma unroll
    for (int nt = 0; nt < 4; ++nt) {
      const u4v bfr = *(const u4v*)(Vt + (size_t)(nt * 32 + r) * 256 + tok0);
      acc[nt] = __builtin_amdgcn_mfma_f32_32x32x16_bf16(bc8(af), bc8(bfr), acc[nt], 0, 0, 0);
    }
  }
  float* o = p.out + OUT_SRET + ((size_t)(((b * 2 + l) * 2 + dir) * 4 + hh)) * 16384;
#pragma unroll
  for (int nt = 0; nt < 4; ++nt)
#pragma unroll
    for (int reg = 0; reg < 16; ++reg) {
      const int dk = wave * 32 + (reg & 3) + 8 * (reg >> 2) + 4 * h2;
      o[(size_t)dk * 128 + nt * 32 + r] = acc[nt][reg];
    }
}

__device__ __forceinline__ void s5_item(const Params& p, char* smem, int l, int item) {
  const int tid = ltid(), lane = tid & 63, wave = tid >> 6;
  const int l15 = lane & 15, g4 = lane >> 4;
  int seq = item * 4 + wave;
  int b, dir, g, L, tokbase;
  bool latent;
  if (seq < 256) { latent = true; b = seq >> 6; dir = (seq >> 5) & 1; g = seq & 31; L = 1024; tokbase = TCTX + b * 1024; }
  else { seq -= 256; latent = false; b = seq >> 6; dir = (seq >> 5) & 1; g = seq & 31; L = 256; tokbase = b * 256; }
  float* buf = (float*)smem + wave * (16 * 132);
  const int tg = (l * 2 + dir) * 32 + g;
  const float ar = WS_abar[(tg * 64 + lane) * 2], ai = WS_abar[(tg * 64 + lane) * 2 + 1];
  u4v bfrag[8];
#pragma unroll
  for (int nt = 0; nt < 8; ++nt) {
    if (g4 < 2) bfrag[nt] = *(const u4v*)(WS_bbarT + ((size_t)tg * 128 + nt * 16 + l15) * 16 + g4 * 8);
    else bfrag[nt] = (u4v){0u, 0u, 0u, 0u};
  }
  u4v cfrag[4];
#pragma unroll
  for (int ks = 0; ks < 4; ++ks) cfrag[ks] = *(const u4v*)(WS_cmT + ((size_t)tg * 16 + l15) * 128 + ks * 32 + g4 * 8);
  float xr = 0.f, xi = 0.f;
  if (latent) {
    const float* h0 = p.state_ssm + ((size_t)(((b * 2 + l) * 2 + dir) * 32 + g) * 64 + lane) * 2;
    xr = h0[0]; xi = h0[1];
  }
  u16* yd = WS_YD + (size_t)dir * TALL * 512;
  __syncthreads();
  const int nsub = L >> 4;
  u4v afn = (u4v){0u, 0u, 0u, 0u};
  if (g4 < 2) {
    const int pos = dir == 0 ? l15 : L - 1 - l15;
    afn = *(const u4v*)(WS_SU + (size_t)(tokbase + pos) * 512 + g * 16 + g4 * 8);
  }
#pragma unroll 1
  for (int sub = 0; sub < nsub; ++sub) {
    const u4v af = afn;
    if (g4 < 2 && sub + 1 < nsub) {
      const int tau = (sub + 1) * 16 + l15;
      const int pos = dir == 0 ? tau : L - 1 - tau;
      afn = *(const u4v*)(WS_SU + (size_t)(tokbase + pos) * 512 + g * 16 + g4 * 8);
    }
#pragma unroll
    for (int nt = 0; nt < 8; ++nt) {
      f4v c = (f4v){0.f, 0.f, 0.f, 0.f};
      c = __builtin_amdgcn_mfma_f32_16x16x32_bf16(bc8(af), bc8(bfrag[nt]), c, 0, 0, 0);
#pragma unroll
      for (int r = 0; r < 4; ++r) buf[(g4 * 4 + r) * 132 + nt * 16 + l15] = c[r];
    }
    __builtin_amdgcn_wave_barrier();
#pragma unroll
    for (int i = 0; i < 16; ++i) {
      const float bur = buf[i * 132 + lane], bui = buf[i * 132 + 64 + lane];
      const float nr = ar * xr - ai * xi + bur;
      const float ni = ar * xi + ai * xr + bui;
      xr = nr; xi = ni;
      buf[i * 132 + lane] = xr;
      buf[i * 132 + 64 + lane] = xi;
    }
    __builtin_amdgcn_wave_barrier();
    f4v y = (f4v){0.f, 0.f, 0.f, 0.f};
#pragma unroll
    for (int ks = 0; ks < 4; ++ks) {
      const float* bp = buf + l15 * 132 + ks * 32 + g4 * 8;
      float4 v0 = *(const float4*)(bp), v1 = *(const float4*)(bp + 4);
      const u4v xa = (u4v){pack2(v0.x, v0.y), pack2(v0.z, v0.w), pack2(v1.x, v1.y), pack2(v1.z, v1.w)};
      y = __builtin_amdgcn_mfma_f32_16x16x32_bf16(bc8(xa), bc8(cfrag[ks]), y, 0, 0, 0);
    }
#pragma unroll
    for (int r = 0; r < 4; ++r) {
      const int tau = sub * 16 + g4 * 4 + r;
      const int pos = dir == 0 ? tau : L - 1 - tau;
      yd[(size_t)(tokbase + pos) * 512 + g * 16 + l15] = f2bf(y[r]);
    }
    __builtin_amdgcn_wave_barrier();
  }
  if (!latent) {
    float* o = p.out + OUT_SSSM + ((size_t)(((b * 2 + l) * 2 + dir) * 32 + g) * 64 + lane) * 2;
    o[0] = xr; o[1] = xi;
  }
}

#define MX_S5 320
#define MX_RET 512
#define MX_NA 512
#define MX_CA 512
#define MX_RS 128
#define MX_ITEMS (MX_S5 + MX_RET + MX_NA + MX_CA + MX_RS)
__device__ __forceinline__ void mixer_item(const Params& p, char* smem, int l, int item) {
  if (item < 64) { s5_item(p, smem, l, item); return; }
  item -= 64;
  if (item < 256) { attn_item<128, 0>(p, smem, l, item); return; }
  item -= 256;
  if (item < 512) { attn_item<64, 2>(p, smem, l, item); return; }
  item -= 512;
  if (item < 256) { s5_item(p, smem, l, 64 + item); return; }
  item -= 256;
  if (item < 256) { attn_item<128, 0>(p, smem, l, 256 + item); return; }
  item -= 256;
  if (item < 512) { attn_item<64, 1>(p, smem, l, item); return; }
  item -= 512;
  retstate_item(p, l, item);
}

__device__ __forceinline__ void p3a_item(const Params& p, char* smem, int l, int item) {
  const int mt = item & 63, nt = item >> 6;
  const int m0 = mt * 128, n0 = nt * 128;
  const int tid = ltid(), lane = tid & 63, wave = tid >> 6, wm = wave >> 1, wn = wave & 1;
  AArgs a{};
  a.SU = WS_SU; a.YD0 = WS_YD; a.YD1 = WS_YD + (size_t)TALL * 512; a.dsk = p.ssm_d + l * 512;
  f16v acc[2][2];
  gemm_mainloop<2>(smem, a, WS_Wt + WT_LAYER * l + WT_GLU, 512, 512, m0, n0, acc);
#pragma unroll
  for (int mi = 0; mi < 2; ++mi)
#pragma unroll
    for (int reg = 0; reg < 16; ++reg) {
      const int row = EPI_ROW(mi, reg);
#pragma unroll
      for (int ni = 0; ni < 2; ++ni) {
        const int col = EPI_COL(ni);
        const size_t off = (size_t)row * 512 + col;
        float y = geluf_(a.dsk[col] * bf2f(WS_SU[off]) + bf2f(a.YD0[off]) + bf2f(a.YD1[off]));
        WS_sout[off] = f2bf(y * sigmoidf_(acc[mi][ni][reg]));
      }
    }
}

__device__ __forceinline__ void p3b_item(const Params& p, char* smem, int l, int item) {
  const int mt = item & 63, nt = item >> 6;
  const int m0 = mt * 128, n0 = nt * 128;
  const int tid = ltid(), lane = tid & 63, wave = tid >> 6, wm = wave >> 1, wn = wave & 1;
  int nbr = 3;
  asm volatile("" : "+s"(nbr));
#pragma unroll 1
  for (int br = 0; br < nbr; ++br) {
    const u16* Abr = br == 0 ? WS_rout : (br == 1 ? WS_sout : WS_nout);
    f16v acc[2][2];
    gemm_mainloop0(smem, Abr, 512, WS_Wt + WT_LAYER * l + WT_BR + (size_t)br * 512 * 1024, 512, 512, m0, n0, acc);
    u16* Cs = (u16*)smem;
    {
      const int rl0 = wm * 64 + 4 * (lane >> 5), cl0 = wn * 64 + (lane & 31);
#pragma unroll
      for (int mi = 0; mi < 2; ++mi)
#pragma unroll
        for (int reg = 0; reg < 16; ++reg) {
          const int rl = rl0 + mi * 32 + (reg & 3) + 8 * (reg >> 2);
          Cs[rl * CST + cl0] = f2bf(acc[mi][0][reg]);
          Cs[rl * CST + cl0 + 32] = f2bf(acc[mi][1][reg]);
        }
    }
    __syncthreads();
    int tl = tid;
    asm volatile("" : "+v"(tl));
#pragma unroll
    for (int i = 0; i < 8; ++i) {
      const int c = tl + 256 * i, r = c >> 4, ch = c & 15;
      const u4v av = *(const u4v*)(Cs + r * CST + ch * 8);
      const u4v gv = *(const u4v*)(WS_GT + (size_t)(m0 + r) * 3072 + br * 1024 + n0 + ch * 8);
      u16* mp = WS_merged + (size_t)(m0 + r) * 1024 + n0 + ch * 8;
      u4v mv = (u4v){0u, 0u, 0u, 0u};
      if (br > 0) mv = *(const u4v*)mp;
      u4v ov;
#pragma unroll
      for (int j = 0; j < 4; ++j)
        ov[j] = pack2(fmaf(bflo(gv[j]), bflo(av[j]), bflo(mv[j])), fmaf(bfhi(gv[j]), bfhi(av[j]), bfhi(mv[j])));
      *(u4v*)mp = ov;
    }
  }
}


#define CFS 132
__device__ __forceinline__ void epi_resid(char* smem, f16v (&acc)[2][2], int m0, int n0, const float* __restrict__ gvec,
                                          const float* __restrict__ xlo, const float* __restrict__ xhi,
                                          const float* __restrict__ xstats, const float* __restrict__ lng,
                                          const float* __restrict__ lnb, float* __restrict__ dst,
                                          float* __restrict__ stats_out, bool do_stats) {
  float* Cf = (float*)smem;
  const int tid = ltid(), lane = tid & 63, wave = tid >> 6, wm = wave >> 1, wn = wave & 1;
  {
    const int rl0 = wm * 64 + 4 * (lane >> 5), cl0 = wn * 64 + (lane & 31);
    const float ga = gvec[n0 + cl0], gb = gvec[n0 + cl0 + 32];
#pragma unroll
    for (int mi = 0; mi < 2; ++mi)
#pragma unroll
      for (int reg = 0; reg < 16; ++reg) {
        const int rl = rl0 + mi * 32 + (reg & 3) + 8 * (reg >> 2);
        Cf[rl * CFS + cl0] = ga * acc[mi][0][reg];
        Cf[rl * CFS + cl0 + 32] = gb * acc[mi][1][reg];
      }
  }
  __syncthreads();
  const int ch = tid & 31, r0 = tid >> 5;
  const int col = n0 + ch * 4;
  float4 g4 = make_float4(1.f, 1.f, 1.f, 1.f), b4 = make_float4(0.f, 0.f, 0.f, 0.f);
  if (xstats) { g4 = *(const float4*)(lng + col); b4 = *(const float4*)(lnb + col); }
  const float* xbase = (m0 < TCTX ? xlo + (size_t)m0 * 1024 : xhi + (size_t)(m0 - TCTX) * 1024) + col;
#pragma unroll 4
  for (int i = 0; i < 16; ++i) {
    const int r = r0 + 8 * i;
    const int row = m0 + r;
    const float4 v = *(const float4*)(Cf + r * CFS + ch * 4);
    float4 x = *(const float4*)(xbase + (size_t)r * 1024);
    if (xstats) {
      const float s = xstats[row * 2], q = xstats[row * 2 + 1];
      const float mu = s * (1.f / 1024.f);
      const float rstd = rsqrtf(fmaxf(q * (1.f / 1024.f) - mu * mu, 0.f) + LNEPS);
      x.x = (x.x - mu) * rstd * g4.x + b4.x; x.y = (x.y - mu) * rstd * g4.y + b4.y;
      x.z = (x.z - mu) * rstd * g4.z + b4.z; x.w = (x.w - mu) * rstd * g4.w + b4.w;
    }
    float4 o;
    o.x = ALPHA * x.x + v.x; o.y = ALPHA * x.y + v.y; o.z = ALPHA * x.z + v.z; o.w = ALPHA * x.w + v.w;
    *(float4*)(dst + (size_t)row * 1024 + col) = o;
    if (do_stats) {
      float ss = o.x + o.y + o.z + o.w, qq = o.x * o.x + o.y * o.y + o.z * o.z + o.w * o.w;
#pragma unroll
      for (int sh = 1; sh < 32; sh <<= 1) { ss += __shfl_xor(ss, sh); qq += __shfl_xor(qq, sh); }
      if (ch == 0) { atomicAdd(stats_out + row * 2, ss); atomicAdd(stats_out + row * 2 + 1, qq); }
    }
  }
}

__device__ __forceinline__ void p3c_item(const Params& p, char* smem, int l, int item, bool do_stats = true) {
  const int mt = item & 63, nt = item >> 6;
  const int m0 = mt * 128, n0 = nt * 128;
  const int tid = ltid(), lane = tid & 63, wave = tid >> 6, wm = wave >> 1, wn = wave & 1;
  f16v acc[2][2];
  gemm_mainloop0(smem, WS_merged, 1024, WS_Wt + WT_LAYER * l + WT_O, 1024, 1024, m0, n0, acc);
  const int ci = cond_of_row(m0);
  const float* g1 = WS_mod + (l * 5 + ci) * 6144 + 2048;
  float* st1 = WS_stats + (size_t)(l * 2 + 0) * TALL * 2;
  if (l == 0)
    epi_resid(smem, acc, m0, n0, g1, p.x_prompt, p.x_sample, nullptr, nullptr, nullptr, WS_pre1, st1, do_stats);
  else
    epi_resid(smem, acc, m0, n0, g1, p.out, p.out + (size_t)TCTX * 1024, WS_stats + (size_t)(0 * 2 + 1) * TALL * 2, p.ln2_g, p.ln2_b,
              WS_pre1, st1, do_stats);
}

__device__ __forceinline__ void p4_item(const Params& p, char* smem, int l, int item) {
  const int mt = item & 63, nt = item >> 6;
  const int m0 = mt * 128, n0 = nt * 128;
  const int tid = ltid(), lane = tid & 63, wave = tid >> 6, wm = wave >> 1, wn = wave & 1;
  f16v acc[2][2];
  gemm_mainloop0(smem, WS_h2, 1024, WS_Wt + WT_LAYER * l + WT_UP, 1024, 1024, m0, n0, acc);
  u16* Cs = (u16*)smem;
  const int rl0 = wm * 64 + 4 * (lane >> 5), cl0 = wn * 64 + (lane & 31);
#pragma unroll
  for (int mi = 0; mi < 2; ++mi)
#pragma unroll
    for (int reg = 0; reg < 16; ++reg) {
      const int rl = rl0 + mi * 32 + (reg & 3) + 8 * (reg >> 2);
      Cs[rl * CST + cl0] = f2bf(acc[mi][0][reg]);
      Cs[rl * CST + cl0 + 32] = f2bf(acc[mi][1][reg]);
    }
  __syncthreads();
  cs_store(Cs, WS_z2 + (size_t)m0 * 5632 + n0, 5632, tid);
}

__device__ __forceinline__ void p4b_item(const Params& p, int l, int item) {
  const int tid = ltid();
  if (tid >= 176) return;
  const int rb = item >> 1, hf = item & 1;
  const int j0 = (hf * 176 + tid) * 8;
  const float* cw = p.conv_w + (size_t)l * 3 * 5632;
  const float* cb = p.conv_b + (size_t)l * 5632;
  float wa[3][8], wb[3][8], ba[8], bb[8];
#pragma unroll
  for (int t = 0; t < 3; ++t)
#pragma unroll
    for (int h = 0; h < 2; ++h) {
      const float4 x = *(const float4*)(cw + t * 5632 + j0 + 4 * h), y = *(const float4*)(cw + t * 5632 + 2816 + j0 + 4 * h);
      wa[t][4 * h] = x.x; wa[t][4 * h + 1] = x.y; wa[t][4 * h + 2] = x.z; wa[t][4 * h + 3] = x.w;
      wb[t][4 * h] = y.x; wb[t][4 * h + 1] = y.y; wb[t][4 * h + 2] = y.z; wb[t][4 * h + 3] = y.w;
    }
#pragma unroll
  for (int h = 0; h < 2; ++h) {
    const float4 x = *(const float4*)(cb + j0 + 4 * h), y = *(const float4*)(cb + 2816 + j0 + 4 * h);
    ba[4 * h] = x.x; ba[4 * h + 1] = x.y; ba[4 * h + 2] = x.z; ba[4 * h + 3] = x.w;
    bb[4 * h] = y.x; bb[4 * h + 1] = y.y; bb[4 * h + 2] = y.z; bb[4 * h + 3] = y.w;
  }
  const int row0 = rb * 32;
  int pos0, L;
  if (row0 < TCTX) { pos0 = row0 & 255; L = 256; } else { pos0 = (row0 - TCTX) & 1023; L = 1024; }
  const u16* zr = WS_z2 + (size_t)row0 * 5632 + j0;
  const u4v zero = (u4v){0u, 0u, 0u, 0u};
  u4v pa = zero, pb = zero;
  if (pos0 > 0) { pa = *(const u4v*)(zr - 5632); pb = *(const u4v*)(zr - 5632 + 2816); }
  u4v ca = *(const u4v*)(zr), cb2 = *(const u4v*)(zr + 2816);
#pragma unroll 2
  for (int r = 0; r < 32; ++r) {
    u4v na = zero, nb = zero;
    if (pos0 + r < L - 1) { na = *(const u4v*)(zr + (size_t)(r + 1) * 5632); nb = *(const u4v*)(zr + (size_t)(r + 1) * 5632 + 2816); }
    u4v ov;
#pragma unroll
    for (int w = 0; w < 4; ++w) {
      const float a0 = wa[0][2 * w] * bflo(pa[w]) + wa[1][2 * w] * bflo(ca[w]) + wa[2][2 * w] * bflo(na[w]) + ba[2 * w];
      const float a1 = wa[0][2 * w + 1] * bfhi(pa[w]) + wa[1][2 * w + 1] * bfhi(ca[w]) + wa[2][2 * w + 1] * bfhi(na[w]) + ba[2 * w + 1];
      const float b0 = wb[0][2 * w] * bflo(pb[w]) + wb[1][2 * w] * bflo(cb2[w]) + wb[2][2 * w] * bflo(nb[w]) + bb[2 * w];
      const float b1 = wb[0][2 * w + 1] * bfhi(pb[w]) + wb[1][2 * w + 1] * bfhi(cb2[w]) + wb[2][2 * w + 1] * bfhi(nb[w]) + bb[2 * w + 1];
      ov[w] = pack2(geluf_(a0) * b0, geluf_(a1) * b1);
    }
    *(u4v*)(WS_act + (size_t)(row0 + r) * 2816 + j0) = ov;
    pa = ca; pb = cb2; ca = na; cb2 = nb;
  }
}

__device__ __forceinline__ void p5_item(const Params& p, char* smem, int l, int item, bool do_stats = true) {
  const int mt = item & 63, nt = item >> 6;
  const int m0 = mt * 128, n0 = nt * 128;
  const int tid = ltid(), lane = tid & 63, wave = tid >> 6, wm = wave >> 1, wn = wave & 1;
  f16v acc[2][2];
  gemm_mainloop0(smem, WS_act, 2816, WS_Wt + WT_LAYER * l + WT_DOWN, 2816, 2816, m0, n0, acc);
  const int ci = cond_of_row(m0);
  const float* g2 = WS_mod + (l * 5 + ci) * 6144 + 5 * 1024;
  epi_resid(smem, acc, m0, n0, g2, WS_pre1, WS_pre1 + (size_t)TCTX * 1024, WS_stats + (size_t)(l * 2 + 0) * TALL * 2,
            p.ln1_g + l * 1024, p.ln1_b + l * 1024, p.out, WS_stats + (size_t)(l * 2 + 1) * TALL * 2, do_stats);
}

__device__ __forceinline__ void final_item(const Params& p, int item) {
  const float* st = WS_stats + (size_t)(1 * 2 + 1) * TALL * 2;
  const int c = ltid() * 4;
  const float4 g = *(const float4*)(p.ln2_g + 1024 + c);
  const float4 b = *(const float4*)(p.ln2_b + 1024 + c);
  for (int r = 0; r < 8; ++r) {
    const int row = item * 8 + r;
    const float s = st[row * 2], q = st[row * 2 + 1];
    const float mu = s * (1.f / 1024.f);
    const float rstd = rsqrtf(fmaxf(q * (1.f / 1024.f) - mu * mu, 0.f) + LNEPS);
    float4 v = *(float4*)(p.out + (size_t)row * 1024 + c);
    v.x = (v.x - mu) * rstd * g.x + b.x;
    v.y = (v.y - mu) * rstd * g.y + b.y;
    v.z = (v.z - mu) * rstd * g.z + b.z;
    v.w = (v.w - mu) * rstd * g.w + b.w;
    *(float4*)(p.out + (size_t)row * 1024 + c) = v;
  }
}

#define XB_TMO      128
#define XB_XCNT(j)  (256  + 64 * (j))
#define XB_XSUB(j)  (1280 + 64 * (j))
#define XB_XGEN(j)  (2304 + 64 * (j))
#define XB_TOP      3328
#define XB_TOPGEN   3392
#define XCD_BAR_WORDS 3456
#define XB_SPIN_CAP (1u << 18)
#define LAS __attribute__((address_space(3)))

__device__ __forceinline__ unsigned xb_ld(unsigned* p)              { return __hip_atomic_load(p, __ATOMIC_RELAXED, __HIP_MEMORY_SCOPE_AGENT); }
__device__ __forceinline__ unsigned xb_add(unsigned* p, unsigned v) { return __hip_atomic_fetch_add(p, v, __ATOMIC_RELAXED, __HIP_MEMORY_SCOPE_AGENT); }
__device__ __forceinline__ unsigned xb_xcc_id() { return (unsigned)__builtin_amdgcn_s_getreg((3 << 11) | 20) & 0xFu; }
#define XB_SPIN(cond, bar) do { unsigned _sp = 0; while (cond) { __builtin_amdgcn_s_sleep(1); \
    if ((++_sp & 255u) == 0u) { if (xb_ld(&(bar)[XB_TMO])) break; if (_sp > XB_SPIN_CAP) { atomicAdd(&(bar)[XB_TMO], 1u); break; } } } } while (0)

struct XcdBarrier {
    unsigned* bar; unsigned x;
    volatile LAS unsigned* st;
};

__device__ __forceinline__ XcdBarrier xcd_barrier_post(unsigned* bar, volatile LAS unsigned* st) {
    XcdBarrier b; b.bar = bar; b.x = xb_xcc_id(); b.st = st;
    if (threadIdx.x == 0) (void)xb_add(&bar[XB_XCNT(b.x)], 1u);
    return b;
}
__device__ __forceinline__ void xcd_barrier_complete(unsigned* bar, unsigned x, unsigned& nloc, unsigned& nx) {
    const unsigned G = gridDim.x * gridDim.y * gridDim.z;
    unsigned sum, cnt, mine, sp = 0u;
    for (;;) {
        sum = 0u; cnt = 0u; mine = 0u;
#pragma unroll
        for (unsigned j = 0; j < 16; ++j) { const unsigned c = xb_ld(&bar[XB_XCNT(j)]); sum += c; cnt += (c > 0u) ? 1u : 0u; mine = (j == x) ? c : mine; }
        if (sum == G) break;
        __builtin_amdgcn_s_sleep(1);
        if ((++sp & 255u) == 0u) { if (xb_ld(&bar[XB_TMO])) break; if (sp > XB_SPIN_CAP) { atomicAdd(&bar[XB_TMO], 1u); break; } }
    }
    nloc = mine > 0u ? mine : 1u; nx = cnt > 0u ? cnt : 1u;
}

__device__ __forceinline__ void xcd_barrier(const XcdBarrier& b) {
    asm volatile("s_waitcnt vmcnt(0)" ::: "memory");
    __syncthreads();
    if (threadIdx.x == 0) {
        unsigned* bar = b.bar;
        __builtin_amdgcn_s_waitcnt(0);
        unsigned nloc = b.st[0], nx = b.st[1];
        if (nloc == 0u) { xcd_barrier_complete(bar, b.x, nloc, nx); b.st[0] = nloc; b.st[1] = nx; }
        const unsigned old = xb_add(&bar[XB_XSUB(b.x)], 1u);
        const unsigned gen = old / nloc;
        if (old + 1u == (gen + 1u) * nloc) {
            __builtin_amdgcn_fence(__ATOMIC_RELEASE, "agent");
            asm volatile("s_waitcnt vmcnt(0)" ::: "memory");
            const unsigned og = xb_add(&bar[XB_TOP], 1u);
            const unsigned tg = og / nx;
            if (og + 1u == (tg + 1u) * nx) xb_add(&bar[XB_TOPGEN], 1u);
            else XB_SPIN(xb_ld(&bar[XB_TOPGEN]) == tg, bar);
            __builtin_amdgcn_fence(__ATOMIC_ACQUIRE, "agent");
            xb_add(&bar[XB_XGEN(b.x)], 1u);
            asm volatile("s_waitcnt vmcnt(0)" ::: "memory");
        } else {
            XB_SPIN(xb_ld(&bar[XB_XGEN(b.x)]) == gen, bar);
            __builtin_amdgcn_fence(__ATOMIC_ACQUIRE, "agent");
            asm volatile("s_waitcnt vmcnt(0)" ::: "memory");
        }
    }
    __syncthreads();
}


#define NPHASES 22
#ifndef REPMASK
#define REPMASK 0
#endif
#define REPS(PH) (((PH) == 0 ? (REPMASK >> 10) : (PH) == 21 ? (REPMASK >> 11) : (REPMASK >> (((PH) - 1) % 10))) & 1)
#define RUN_PHASE(PH, N, CALL)                                              \
  if (ph_lo <= (PH) && (PH) < ph_hi) {                                      \
    for (int rep_ = 0; rep_ <= REPS(PH); ++rep_)                            \
    for (int it = blockIdx.x; it < (N); it += nb) { CALL; }                 \
    if ((PH) + 1 < ph_hi) xcd_barrier(xb);                                  \
  }
#define RUN_GEMM_PHASE(PH, NT, CALL)                                                          \
  if (ph_lo <= (PH) && (PH) < ph_hi) {                                                        \
    const int xcd_ = blockIdx.x & 7, slot_ = blockIdx.x >> 3, spx_ = (int)gridDim.x >> 3;      \
    const int nsuper_ = 8 * (((NT) + 7) >> 3);                                                \
    for (int rep_ = 0; rep_ <= REPS(PH); ++rep_)                                              \
    for (int s_ = xcd_; s_ < nsuper_; s_ += 8)                                                \
      for (int j_ = slot_; j_ < 64; j_ += spx_) {                                             \
        const int mt_ = (s_ & 7) * 8 + (j_ & 7), nt_ = (s_ >> 3) * 8 + (j_ >> 3);             \
        if (nt_ < (NT)) { const int it = nt_ * 64 + mt_; CALL; }                              \
      }                                                                                       \
    if ((PH) + 1 < ph_hi) xcd_barrier(xb);                                                    \
  }
#define RUN_MIXER_PHASE(PH, L)                                                                \
  if (ph_lo <= (PH) && (PH) < ph_hi) {                                                        \
    for (int rep_ = 0; rep_ <= REPS(PH); ++rep_) {                                            \
      unsigned* ctr_ = (unsigned*)(p.ws + OFF_ctr) + 64 * (2 * (L) + rep_);                   \
      for (;;) {                                                                              \
        __syncthreads();                                                                      \
        if (threadIdx.x == 0) wq_item = (int)atomicAdd(ctr_, 1u);                             \
        __syncthreads();                                                                      \
        const int it = wq_item;                                                               \
        if (it >= MX_ITEMS) break;                                                            \
        mixer_item(p, smem, (L), it);                                                         \
      }                                                                                       \
    }                                                                                         \
    if ((PH) + 1 < ph_hi) xcd_barrier(xb);                                                    \
  }
#define RUN_LAYER(L)                                                         \
  RUN_PHASE(1 + 10 * (L) + 0, 1024, hmat_item(p, (L), 0, it))                \
  RUN_GEMM_PHASE(1 + 10 * (L) + 1, 56, p1_item(p, smem, (L), it))            \
  RUN_MIXER_PHASE(1 + 10 * (L) + 2, (L))                                     \
  RUN_GEMM_PHASE(1 + 10 * (L) + 3, 4, p3a_item(p, smem, (L), it))            \
  RUN_GEMM_PHASE(1 + 10 * (L) + 4, 8, p3b_item(p, smem, (L), it))            \
  RUN_GEMM_PHASE(1 + 10 * (L) + 5, 8, p3c_item(p, smem, (L), it, rep_ == 0)) \
  RUN_PHASE(1 + 10 * (L) + 6, 1024, hmat_item(p, (L), 1, it))                \
  RUN_GEMM_PHASE(1 + 10 * (L) + 7, 44, p4_item(p, smem, (L), it))            \
  RUN_PHASE(1 + 10 * (L) + 8, 512, p4b_item(p, (L), it))                     \
  RUN_GEMM_PHASE(1 + 10 * (L) + 9, 8, p5_item(p, smem, (L), it, rep_ == 0))

__global__ void __launch_bounds__(256, 2) mega(Params p, int ph_lo, int ph_hi) {
  extern __shared__ __attribute__((aligned(16))) char smem[];
  __shared__ uint4 xb_words;
  __shared__ int wq_item;
  const int nb = gridDim.x;
  if (threadIdx.x == 0) xb_words = make_uint4(0u, 0u, 0u, 0u);
  __syncthreads();
  XcdBarrier xb;
  xb.bar = (unsigned*)(p.ws + OFF_bar); xb.x = 0; xb.st = (volatile LAS unsigned*)&xb_words;
  if (ph_hi - ph_lo > 1) xb = xcd_barrier_post((unsigned*)(p.ws + OFF_bar), (volatile LAS unsigned*)&xb_words);
  if (ph_hi > 1000) cg::this_grid().sync();
  RUN_PHASE(0, P0_ITEMS, phase0_item(p, smem, it))
  RUN_LAYER(0)
  RUN_LAYER(1)
  RUN_PHASE(21, 1024, final_item(p, it))
}

extern "C" void kernel_launch(void* const* d_in, const int* in_sizes, int n_in, void* d_out, int out_size, void* d_ws,
                              size_t ws_size, hipStream_t stream) {
  Params p{};
  const float** ins = (const float**)&p;
  for (int i = 0; i < 32; ++i) ins[i] = (const float*)d_in[i];
  p.out = (float*)d_out;
  char* ws = (char*)d_ws;
  p.ws = ws;
  if (WS_TOTAL > ws_size) {
    fprintf(stderr, "kernel_launch: workspace too small (%zu needed, %zu given)\n", (size_t)WS_TOTAL, ws_size);
    return;
  }
  (void)hipMemsetAsync(ws, 0, ZERO_BYTES, stream);
#if SINGLE_LAUNCH
  static int grid_blocks = 0;
  if (!grid_blocks) {
    int dev = 0, cus = 0, per_cu = 0;
    (void)hipGetDevice(&dev);
    (void)hipDeviceGetAttribute(&cus, hipDeviceAttributeMultiprocessorCount, dev);
    (void)hipFuncSetAttribute((const void*)mega, hipFuncAttributeMaxDynamicSharedMemorySize, LDS_BYTES);
    (void)hipOccupancyMaxActiveBlocksPerMultiprocessor(&per_cu, mega, 256, LDS_BYTES);
    if (per_cu > 2) per_cu = 2;
    if (per_cu < 1) per_cu = 1;
    grid_blocks = (cus * per_cu) & ~7;
  }
  int lo = 0, hi = NPHASES;
  void* args[] = {&p, &lo, &hi};
  hipError_t e = hipLaunchCooperativeKernel((void*)mega, dim3(grid_blocks), dim3(256), args, LDS_BYTES, stream);
  if (e != hipSuccess) fprintf(stderr, "cooperative launch failed: %s (grid %d)\n", hipGetErrorString(e), grid_blocks);
#else
  for (int ph = 0; ph < NPHASES; ++ph) {
    hipLaunchKernelGGL(mega, dim3(512), dim3(256), LDS_BYTES, stream, p, ph, ph + 1);
  }
#endif
}
```

```cpp
#include <hip/hip_runtime.h>
#include <hip/hip_cooperative_groups.h>
#include <cstdio>
namespace cg = cooperative_groups;

#ifndef SINGLE_LAUNCH
#define SINGLE_LAUNCH 1
#endif

typedef __attribute__((ext_vector_type(8))) short s8v;
typedef __attribute__((ext_vector_type(4))) float f4v;
typedef __attribute__((ext_vector_type(16))) float f16v;
typedef unsigned short u16;
typedef __attribute__((ext_vector_type(4))) unsigned u4v;
__device__ __forceinline__ s8v bc8(u4v x) { return __builtin_bit_cast(s8v, x); }


#define TALL 8192
#define TCTX 4096
#define ALPHA 1.41421356237309515f
#define LNEPS 1e-5f
#define VTR_LAT 2097152
#define NVT_LAT 2097152
#define OUT_SRET 8388608
#define OUT_SSSM 12582912
#define OUT_CK 12845056
#define OUT_CV 17039360
#define WT_IN 0
#define WT_GLU (WT_IN + 7168 * 1024)
#define WT_BR (WT_GLU + 512 * 512)
#define WT_O (WT_BR + 3 * 1024 * 512)
#define WT_UP (WT_O + 1024 * 1024)
#define WT_DOWN (WT_UP + 5632 * 1024)
#define WT_LAYER ((size_t)(WT_DOWN + 1024 * 2816))

struct Params {
  const float *x_prompt, *x_sample, *state_ret, *state_ssm, *cache_k, *cache_v, *c, *c_ctx;
  const float *w_ada, *b_ada, *w_in, *ret_decay, *a_re, *a_im, *log_dt, *b_re, *b_im, *c_re, *c_im;
  const float *ssm_d, *w_glu, *rpb, *w_branch, *w_o, *ln1_g, *ln1_b, *w_up, *conv_w, *conv_b, *w_down, *ln2_g, *ln2_b;
  float* out;
  char* ws;
};

typedef __bf16 bf2v __attribute__((ext_vector_type(2)));
typedef float fl2v __attribute__((ext_vector_type(2)));
__device__ __forceinline__ unsigned pack2(float a, float b) {
  fl2v f = {a, b};
  bf2v h = __builtin_convertvector(f, bf2v);
  return __builtin_bit_cast(unsigned, h);
}
__device__ __forceinline__ u16 f2bf(float f) { return (u16)(pack2(f, 0.f) & 0xffffu); }

constexpr size_t al256(size_t x) { return (x + 255) & ~(size_t)255; }
constexpr size_t EB = (size_t)TALL * 512 * 2;
constexpr size_t OFF_mod = 0;
constexpr size_t OFF_stats = OFF_mod + al256(2 * 5 * 6144 * 4);
constexpr size_t OFF_bar = OFF_stats + al256(2 * 2 * TALL * 2 * 4);
constexpr size_t OFF_ctr = OFF_bar + al256(3456 * 4);
constexpr size_t ZERO_BYTES = OFF_ctr + al256(8 * 256);
constexpr size_t OFF_ropetab = ZERO_BYTES;
constexpr size_t OFF_abar = OFF_ropetab + al256(64 * 32 * 2 * 4);
constexpr size_t OFF_bbarT = OFF_abar + al256(2 * 2 * 32 * 64 * 2 * 4);
constexpr size_t OFF_cmT = OFF_bbarT + al256(2 * 2 * 32 * 128 * 16 * 2);
constexpr size_t OFF_CK = OFF_cmT + al256(2 * 2 * 32 * 16 * 128 * 2);
constexpr size_t OFF_CVt = OFF_CK + al256((size_t)2 * 4 * 512 * 512 * 2);
constexpr size_t OFF_S0t = OFF_CVt + al256((size_t)2 * 4 * 512 * 512 * 2);
constexpr size_t OFF_Wt = OFF_S0t + al256((size_t)2 * 4 * 2 * 4 * 128 * 128 * 2);
constexpr size_t OFF_REGION = OFF_Wt + al256(2 * WT_LAYER * 2);
constexpr size_t OFF_z2 = OFF_REGION;
constexpr size_t OFF_act = OFF_z2 + (size_t)TALL * 5632 * 2;
constexpr size_t OFF_pre1 = OFF_act + (size_t)TALL * 2816 * 2;
constexpr size_t WS_TOTAL = OFF_pre1 + (size_t)TALL * 1024 * 4;
constexpr size_t OFF_K = OFF_pre1;
constexpr size_t OFF_VtR = OFF_K + EB;
constexpr size_t OFF_NQ = OFF_VtR + EB;
constexpr size_t OFF_NK = OFF_NQ + EB;
constexpr size_t OFF_GT = OFF_REGION;
constexpr size_t OFF_rout = OFF_GT + (size_t)TALL * 3072 * 2;
constexpr size_t OFF_nout = OFF_rout + EB;
constexpr size_t OFF_YD = OFF_nout + EB;
constexpr size_t OFF_merged = OFF_YD;
constexpr size_t OFF_Q = OFF_YD + 2 * EB;
constexpr size_t OFF_sout = OFF_Q;
constexpr size_t OFF_KtR = OFF_Q + EB;
constexpr size_t OFF_G = OFF_KtR + EB / 2;
constexpr size_t OFF_SU = OFF_G + EB;
constexpr size_t OFF_NVt = OFF_SU + EB;
constexpr size_t OFF_h1 = OFF_NVt + EB;
constexpr size_t OFF_h2 = OFF_act;
static_assert(OFF_h1 + 2 * EB <= OFF_pre1, "mixer buffers overflow the z2+act area");
#define WS_h1 ((u16*)(p.ws + OFF_h1))
#define WS_h2 ((u16*)(p.ws + OFF_h2))
#define WS_mod ((float*)(p.ws + OFF_mod))
#define WS_stats ((float*)(p.ws + OFF_stats))
#define WS_ropetab ((float*)(p.ws + OFF_ropetab))
#define WS_abar ((float*)(p.ws + OFF_abar))
#define WS_pre1 ((float*)(p.ws + OFF_pre1))
#define WS_bbarT ((u16*)(p.ws + OFF_bbarT))
#define WS_cmT ((u16*)(p.ws + OFF_cmT))
#define WS_CK ((u16*)(p.ws + OFF_CK))
#define WS_CVt ((u16*)(p.ws + OFF_CVt))
#define WS_S0t ((u16*)(p.ws + OFF_S0t))
#define WS_Wt ((u16*)(p.ws + OFF_Wt))
#define WS_Q ((u16*)(p.ws + OFF_Q))
#define WS_K ((u16*)(p.ws + OFF_K))
#define WS_VtR ((u16*)(p.ws + OFF_VtR))
#define WS_KtR ((u16*)(p.ws + OFF_KtR))
#define WS_G ((u16*)(p.ws + OFF_G))
#define WS_SU ((u16*)(p.ws + OFF_SU))
#define WS_NQ ((u16*)(p.ws + OFF_NQ))
#define WS_NK ((u16*)(p.ws + OFF_NK))
#define WS_NVt ((u16*)(p.ws + OFF_NVt))
#define WS_GT ((u16*)(p.ws + OFF_GT))
#define WS_rout ((u16*)(p.ws + OFF_rout))
#define WS_sout ((u16*)(p.ws + OFF_sout))
#define WS_nout ((u16*)(p.ws + OFF_nout))
#define WS_YD ((u16*)(p.ws + OFF_YD))
#define WS_merged ((u16*)(p.ws + OFF_merged))
#define WS_z2 ((u16*)(p.ws + OFF_z2))
#define WS_act ((u16*)(p.ws + OFF_act))

__device__ __forceinline__ float bf2f(unsigned h) { return __uint_as_float((h & 0xffffu) << 16); }
__device__ __forceinline__ float bflo(unsigned w) { return __uint_as_float(w << 16); }
__device__ __forceinline__ float bfhi(unsigned w) { return __uint_as_float(w & 0xffff0000u); }
__device__ __forceinline__ float fexp_(float x) { return __builtin_amdgcn_exp2f(x * 1.4426950408889634f); }
__device__ __forceinline__ float sigmoidf_(float x) { return __builtin_amdgcn_rcpf(1.f + fexp_(-x)); }
__device__ __forceinline__ float siluf_(float x) { return x * __builtin_amdgcn_rcpf(1.f + fexp_(-x)); }
__device__ __forceinline__ float geluf_(float x) {
  const float u2 = 1.5957691216057308f * (x + 0.044715f * x * x * x);
  return x * __builtin_amdgcn_rcpf(1.f + fexp_(-u2));
}
__device__ __forceinline__ f16v zero16() {
  return (f16v){0.f, 0.f, 0.f, 0.f, 0.f, 0.f, 0.f, 0.f, 0.f, 0.f, 0.f, 0.f, 0.f, 0.f, 0.f, 0.f};
}
__device__ __forceinline__ int ltid() { int t = threadIdx.x; asm volatile("" : "+v"(t)); return t; }
__device__ __forceinline__ int cond_of_row(int row) { return row < TCTX ? 0 : 1 + ((row - TCTX) >> 10); }

struct AArgs {
  const u16* A16; int lda;
  const float* A32lo; const float* A32hi;
  const float* stats;
  const float* lng; const float* lnb;
  const float* sc; const float* sh;
  const u16* SU; const u16* YD0; const u16* YD1; const float* dsk;
};

#define GST 72
#define LDS_GEMM (2 * 2 * 128 * GST * 2)
#define LDS_BYTES LDS_GEMM

template <int AMODE>
__device__ __forceinline__ void gemm_mainloop(char* smem, const AArgs& a, const u16* __restrict__ Bt, int ldb, int K,
                                              int m0, int n0, f16v (&acc)[2][2]) {
  u16* As = (u16*)smem;
  u16* Bs = As + 2 * 128 * GST;
  const int tid = ltid(), lane = tid & 63, wave = tid >> 6;
  const int wm = wave >> 1, wn = wave & 1;
  const int crow = tid >> 3, cch = tid & 7;
  const int frow = tid >> 4, fch = tid & 15;
  float rs[8], nm[8];
  const float* srow0 = nullptr;
  const float *gsc = nullptr, *gsh = nullptr;
  __syncthreads();
  if constexpr (AMODE == 1) {
    const int ci = cond_of_row(m0);
    gsc = a.sc + ci * 6144; gsh = a.sh + ci * 6144;
#pragma unroll
    for (int i = 0; i < 8; ++i) {
      rs[i] = 1.f; nm[i] = 0.f;
      if (a.stats) {
        const int row = m0 + frow + 16 * i;
        const float s = a.stats[row * 2], q = a.stats[row * 2 + 1];
        const float mu = s * (1.f / 1024.f);
        const float var = q * (1.f / 1024.f) - mu * mu;
        rs[i] = rsqrtf(fmaxf(var, 0.f) + LNEPS);
        nm[i] = -mu * rs[i];
      }
    }
    const int row0 = m0 + frow;
    srow0 = (row0 < TCTX ? a.A32lo + (size_t)row0 * 1024 : a.A32hi + (size_t)(row0 - TCTX) * 1024) + fch * 4;
  }
  acc[0][0] = zero16(); acc[0][1] = zero16(); acc[1][0] = zero16(); acc[1][1] = zero16();

  u4v ra[12], rb[4];
  float4 q0, q1, q2, q3;
  q0 = q1 = q3 = make_float4(0.f, 0.f, 0.f, 0.f); q2 = make_float4(1.f, 1.f, 1.f, 1.f);
  const u16* brow = Bt + (size_t)(n0 + crow) * ldb + cch * 8;
  auto issue = [&](int kt) {
    if constexpr (AMODE == 1) {
      const int k = kt * 64 + fch * 4;
      q0 = *(const float4*)(gsc + k); q1 = *(const float4*)(gsh + k);
      if (a.lng) { q2 = *(const float4*)(a.lng + k); q3 = *(const float4*)(a.lnb + k); }
    } else if constexpr (AMODE == 2) {
      const int k0 = kt * 64 + cch * 8;
      q0 = *(const float4*)(a.dsk + k0); q1 = *(const float4*)(a.dsk + k0 + 4);
    }
    if constexpr (AMODE == 0) {
      const u16* ap = a.A16 + (size_t)(m0 + crow) * a.lda + kt * 64 + cch * 8;
#pragma unroll
      for (int i = 0; i < 4; ++i) ra[i] = *(const u4v*)(ap + (size_t)(32 * i) * a.lda);
    } else if constexpr (AMODE == 1) {
#pragma unroll
      for (int i = 0; i < 8; ++i) ra[i] = *(const u4v*)(srow0 + (size_t)(16 * i) * 1024 + kt * 64);
    } else {
      const size_t o = (size_t)(m0 + crow) * 512 + kt * 64 + cch * 8;
#pragma unroll
      for (int i = 0; i < 4; ++i) {
        ra[i] = *(const u4v*)(a.SU + o + (size_t)(32 * i) * 512);
        ra[4 + i] = *(const u4v*)(a.YD0 + o + (size_t)(32 * i) * 512);
        ra[8 + i] = *(const u4v*)(a.YD1 + o + (size_t)(32 * i) * 512);
      }
    }
#pragma unroll
    for (int i = 0; i < 4; ++i) rb[i] = *(const u4v*)(brow + (size_t)(32 * i) * ldb + kt * 64);
  };
  auto stage = [&](int buf, int kt) {
    u16* Ad = As + buf * (128 * GST);
    if constexpr (AMODE == 0) {
#pragma unroll
      for (int i = 0; i < 4; ++i) *(u4v*)(Ad + (crow + 32 * i) * GST + cch * 8) = ra[i];
    } else if constexpr (AMODE == 1) {
      const float4 sc = q0, sh = q1, g = q2, b = q3;
      const float G0 = g.x * (1.f + sc.x), G1 = g.y * (1.f + sc.y), G2 = g.z * (1.f + sc.z), G3 = g.w * (1.f + sc.w);
      const float B0 = fmaf(b.x, 1.f + sc.x, sh.x), B1 = fmaf(b.y, 1.f + sc.y, sh.y), B2 = fmaf(b.z, 1.f + sc.z, sh.z), B3 = fmaf(b.w, 1.f + sc.w, sh.w);
#pragma unroll
      for (int i = 0; i < 8; ++i) {
        const float h0 = fmaf(fmaf(__uint_as_float(ra[i][0]), rs[i], nm[i]), G0, B0);
        const float h1 = fmaf(fmaf(__uint_as_float(ra[i][1]), rs[i], nm[i]), G1, B1);
        const float h2 = fmaf(fmaf(__uint_as_float(ra[i][2]), rs[i], nm[i]), G2, B2);
        const float h3 = fmaf(fmaf(__uint_as_float(ra[i][3]), rs[i], nm[i]), G3, B3);
        *(uint2*)(Ad + (frow + 16 * i) * GST + fch * 4) = make_uint2(pack2(h0, h1), pack2(h2, h3));
      }
    } else {
      const float4 da = q0, db = q1;
      const float dd[8] = {da.x, da.y, da.z, da.w, db.x, db.y, db.z, db.w};
#pragma unroll
      for (int i = 0; i < 4; ++i) {
        u4v o;
#pragma unroll
        for (int j = 0; j < 4; ++j) {
          const float v0 = geluf_(dd[2 * j] * bflo(ra[i][j]) + bflo(ra[4 + i][j]) + bflo(ra[8 + i][j]));
          const float v1 = geluf_(dd[2 * j + 1] * bfhi(ra[i][j]) + bfhi(ra[4 + i][j]) + bfhi(ra[8 + i][j]));
          o[j] = pack2(v0, v1);
        }
        *(u4v*)(Ad + (crow + 32 * i) * GST + cch * 8) = o;
      }
    }
    u16* Bd = Bs + buf * (128 * GST);
#pragma unroll
    for (int i = 0; i < 4; ++i) *(u4v*)(Bd + (crow + 32 * i) * GST + cch * 8) = rb[i];
  };
  auto compute = [&](int buf) {
    const u16* Ab = As + buf * (128 * GST) + (wm * 64 + (lane & 31)) * GST + (lane >> 5) * 8;
    const u16* Bb = Bs + buf * (128 * GST) + (wn * 64 + (lane & 31)) * GST + (lane >> 5) * 8;
#pragma unroll
    for (int ks = 0; ks < 4; ++ks) {
      s8v af0 = *(const s8v*)(Ab + ks * 16);
      s8v af1 = *(const s8v*)(Ab + 32 * GST + ks * 16);
      s8v bf0 = *(const s8v*)(Bb + ks * 16);
      s8v bf1 = *(const s8v*)(Bb + 32 * GST + ks * 16);
      acc[0][0] = __builtin_amdgcn_mfma_f32_32x32x16_bf16(af0, bf0, acc[0][0], 0, 0, 0);
      acc[0][1] = __builtin_amdgcn_mfma_f32_32x32x16_bf16(af0, bf1, acc[0][1], 0, 0, 0);
      acc[1][0] = __builtin_amdgcn_mfma_f32_32x32x16_bf16(af1, bf0, acc[1][0], 0, 0, 0);
      acc[1][1] = __builtin_amdgcn_mfma_f32_32x32x16_bf16(af1, bf1, acc[1][1], 0, 0, 0);
    }
  };

  const int nk = K >> 6;
  issue(0);
  stage(0, 0);
  __syncthreads();
#pragma unroll 1
  for (int kt = 0; kt < nk; ++kt) {
    const int buf = kt & 1;
    if (kt + 1 < nk) issue(kt + 1);
    compute(buf);
    if (kt + 1 < nk) stage(buf ^ 1, kt + 1);
    __syncthreads();
  }
}

__device__ __forceinline__ void gemm_mainloop0(char* smem, const u16* __restrict__ A, int lda, const u16* __restrict__ Bt, int ldb,
                                               int K, int m0, int n0, f16v (&acc)[2][2]) {
  u16* As = (u16*)smem;
  u16* Bs = As + 2 * 128 * GST;
  const int tid = ltid(), lane = tid & 63, wave = tid >> 6;
  const int wm = wave >> 1, wn = wave & 1;
  const int crow = tid >> 3, cch = tid & 7;
  __syncthreads();
  acc[0][0] = zero16(); acc[0][1] = zero16(); acc[1][0] = zero16(); acc[1][1] = zero16();
  const u16* arow = A + (size_t)(m0 + crow) * lda + cch * 8;
  const u16* brow = Bt + (size_t)(n0 + crow) * ldb + cch * 8;
  const size_t a32 = (size_t)32 * lda, b32 = (size_t)32 * ldb;
  u4v eA0, eA1, eA2, eA3, eB0, eB1, eB2, eB3, oA0, oA1, oA2, oA3, oB0, oB1, oB2, oB3;
#define G0_ISSUE(P, kt)                                                                                   \
  { const u16* ap_ = arow + (kt) * 64; const u16* bp_ = brow + (kt) * 64;                                 \
    P##A0 = *(const u4v*)(ap_); P##A1 = *(const u4v*)(ap_ + a32); P##A2 = *(const u4v*)(ap_ + 2 * a32);   \
    P##A3 = *(const u4v*)(ap_ + 3 * a32);                                                                 \
    P##B0 = *(const u4v*)(bp_); P##B1 = *(const u4v*)(bp_ + b32); P##B2 = *(const u4v*)(bp_ + 2 * b32);   \
    P##B3 = *(const u4v*)(bp_ + 3 * b32); }
#define G0_STAGE(P, buf)                                                                                  \
  { u16* Ad_ = As + (buf) * (128 * GST) + crow * GST + cch * 8; u16* Bd_ = Bs + (buf) * (128 * GST) + crow * GST + cch * 8; \
    *(u4v*)(Ad_) = P##A0; *(u4v*)(Ad_ + 32 * GST) = P##A1; *(u4v*)(Ad_ + 64 * GST) = P##A2; *(u4v*)(Ad_ + 96 * GST) = P##A3; \
    *(u4v*)(Bd_) = P##B0; *(u4v*)(Bd_ + 32 * GST) = P##B1; *(u4v*)(Bd_ + 64 * GST) = P##B2; *(u4v*)(Bd_ + 96 * GST) = P##B3; }
#define G0_COMPUTE(buf)                                                                                   \
  { const u16* Ab = As + (buf) * (128 * GST) + (wm * 64 + (lane & 31)) * GST + (lane >> 5) * 8;           \
    const u16* Bb = Bs + (buf) * (128 * GST) + (wn * 64 + (lane & 31)) * GST + (lane >> 5) * 8;           \
    __builtin_amdgcn_s_setprio(1);                                                                        \
    _Pragma("unroll") for (int ks = 0; ks < 4; ++ks) {                                                    \
      s8v af0 = *(const s8v*)(Ab + ks * 16);                                                              \
      s8v af1 = *(const s8v*)(Ab + 32 * GST + ks * 16);                                                   \
      s8v bf0 = *(const s8v*)(Bb + ks * 16);                                                              \
      s8v bf1 = *(const s8v*)(Bb + 32 * GST + ks * 16);                                                   \
      acc[0][0] = __builtin_amdgcn_mfma_f32_32x32x16_bf16(af0, bf0, acc[0][0], 0, 0, 0);                  \
      acc[0][1] = __builtin_amdgcn_mfma_f32_32x32x16_bf16(af0, bf1, acc[0][1], 0, 0, 0);                  \
      acc[1][0] = __builtin_amdgcn_mfma_f32_32x32x16_bf16(af1, bf0, acc[1][0], 0, 0, 0);                  \
      acc[1][1] = __builtin_amdgcn_mfma_f32_32x32x16_bf16(af1, bf1, acc[1][1], 0, 0, 0);                  \
    }                                                                                                     \
    __builtin_amdgcn_s_setprio(0); }
  const int nk = K >> 6;
  G0_ISSUE(e, 0)
  G0_ISSUE(o, 1)
  G0_STAGE(e, 0)
  __syncthreads();
  int kt = 0;
#pragma unroll 1
  for (; kt + 3 < nk; kt += 2) {
    G0_ISSUE(e, kt + 2)
    __builtin_amdgcn_sched_barrier(0);
    G0_COMPUTE(0)
    G0_STAGE(o, 1)
    __syncthreads();
    G0_ISSUE(o, kt + 3)
    __builtin_amdgcn_sched_barrier(0);
    G0_COMPUTE(1)
    G0_STAGE(e, 0)
    __syncthreads();
  }
  G0_COMPUTE(0)
  G0_STAGE(o, 1)
  __syncthreads();
  G0_COMPUTE(1)
  __syncthreads();
#undef G0_ISSUE
#undef G0_STAGE
#undef G0_COMPUTE
}

#define EPI_ROW(mi, reg) (m0 + wm * 64 + (mi) * 32 + ((reg) & 3) + 8 * ((reg) >> 2) + 4 * (lane >> 5))
#define EPI_COL(ni) (n0 + wn * 64 + (ni) * 32 + (lane & 31))


#define CST 136
__device__ __forceinline__ void cs_store(const u16* Cs, u16* __restrict__ dst, size_t ld, int tid) {
#pragma unroll
  for (int i = 0; i < 8; ++i) {
    const int c = tid + 256 * i, r = c >> 4, ch = c & 15;
    *(u4v*)(dst + (size_t)r * ld + ch * 8) = *(const u4v*)(Cs + r * CST + ch * 8);
  }
}

__device__ __forceinline__ void stats_accum(float* stats, int row, float v0, float v1, int lane) {
  float s = v0 + v1, q = v0 * v0 + v1 * v1;
#pragma unroll
  for (int o = 1; o < 32; o <<= 1) {
    s += __shfl_xor(s, o);
    q += __shfl_xor(q, o);
  }
  if ((lane & 31) == 0) {
    atomicAdd(stats + row * 2, s);
    atomicAdd(stats + row * 2 + 1, q);
  }
}

#define P0_ADA 768
#define P0_ROPE 1
#define P0_CACHE 64
#define P0_S0 64
#define P0_S5 128
#define P0_WT_PER_LAYER (16 * 112 + 8 * 8 + 3 * 8 * 16 + 16 * 16 + 16 * 88 + 44 * 16)
#define P0_WT (2 * P0_WT_PER_LAYER)
#define P0_ITEMS (P0_ADA + P0_ROPE + P0_CACHE + P0_S0 + P0_S5 + P0_WT)

__device__ __forceinline__ void wt_tile(const float* __restrict__ src, int N, u16* __restrict__ dst, int ldd, int kt, int nt, char* smem) {
  float* tile = (float*)smem;
  const int tid = ltid();
  __syncthreads();
  {
    const int c4 = (tid & 15) * 4, r0 = tid >> 4;
#pragma unroll
    for (int i = 0; i < 4; ++i) {
      const int k = r0 + 16 * i;
      const float4 v = *(const float4*)(src + (size_t)(kt * 64 + k) * N + nt * 64 + c4);
      tile[k * 65 + c4] = v.x; tile[k * 65 + c4 + 1] = v.y; tile[k * 65 + c4 + 2] = v.z; tile[k * 65 + c4 + 3] = v.w;
    }
  }
  __syncthreads();
  {
    const int n = tid >> 2, k0 = (tid & 3) * 16;
#define WTP(j) pack2(tile[(k0 + 2 * (j)) * 65 + n], tile[(k0 + 2 * (j) + 1) * 65 + n])
    u4v* d = (u4v*)(dst + (size_t)(nt * 64 + n) * ldd + kt * 64 + k0);
    d[0] = (u4v){WTP(0), WTP(1), WTP(2), WTP(3)};
    d[1] = (u4v){WTP(4), WTP(5), WTP(6), WTP(7)};
#undef WTP
  }
}
__device__ __forceinline__ void wt_item(const Params& p, char* smem, int item) {
  const int l = item / P0_WT_PER_LAYER;
  int it = item % P0_WT_PER_LAYER;
  u16* base = WS_Wt + WT_LAYER * l;
  if (it < 16 * 112) { wt_tile(p.w_in + (size_t)l * 1024 * 7168, 7168, base + WT_IN, 1024, it / 112, it % 112, smem); return; }
  it -= 16 * 112;
  if (it < 64) { wt_tile(p.w_glu + (size_t)l * 512 * 512, 512, base + WT_GLU, 512, it / 8, it % 8, smem); return; }
  it -= 64;
  if (it < 384) { const int br = it / 128; it %= 128;
    wt_tile(p.w_branch + ((size_t)l * 3 + br) * 512 * 1024, 1024, base + WT_BR + (size_t)br * 512 * 1024, 512, it / 16, it % 16, smem); return; }
  it -= 384;
  if (it < 256) { wt_tile(p.w_o + (size_t)l * 1024 * 1024, 1024, base + WT_O, 1024, it / 16, it % 16, smem); return; }
  it -= 256;
  if (it < 16 * 88) { wt_tile(p.w_up + (size_t)l * 1024 * 5632, 5632, base + WT_UP, 1024, it / 88, it % 88, smem); return; }
  it -= 16 * 88;
  wt_tile(p.w_down + (size_t)l * 2816 * 1024, 1024, base + WT_DOWN, 2816, it / 16, it % 16, smem);
}

__device__ __forceinline__ void phase0_item(const Params& p, char* smem, int item) {
  const int tid = ltid();
  if (item < P0_ADA) {
    const int ks = item & 3, cg = (item >> 2) % 96, l = item / 384;
    float* scs = (float*)smem;
    float* red = scs + 5 * 256;
    __syncthreads();
    for (int i = tid; i < 5 * 256; i += 256) {
      int ci = i >> 8, k = ks * 256 + (i & 255);
      float v = ci == 0 ? p.c_ctx[k] : p.c[(ci - 1) * 1024 + k];
      scs[i] = siluf_(v);
    }
    __syncthreads();
    const int ct = tid & 15, kg = tid >> 4;
    const float* wp = p.w_ada + (size_t)l * 1024 * 6144 + (size_t)(ks * 256 + kg * 16) * 6144 + cg * 64 + ct * 4;
    float acc[5][4];
#pragma unroll
    for (int i = 0; i < 5; ++i)
#pragma unroll
      for (int j = 0; j < 4; ++j) acc[i][j] = 0.f;
#pragma unroll 4
    for (int k = 0; k < 16; ++k) {
      float4 w = *(const float4*)(wp + (size_t)k * 6144);
#pragma unroll
      for (int ci = 0; ci < 5; ++ci) {
        float s = scs[ci * 256 + kg * 16 + k];
        acc[ci][0] += s * w.x; acc[ci][1] += s * w.y; acc[ci][2] += s * w.z; acc[ci][3] += s * w.w;
      }
    }
#pragma unroll
    for (int ci = 0; ci < 5; ++ci)
#pragma unroll
      for (int j = 0; j < 4; ++j) red[(kg * 5 + ci) * 64 + ct * 4 + j] = acc[ci][j];
    __syncthreads();
    for (int i = tid; i < 320; i += 256) {
      int ci = i >> 6, col = i & 63;
      float s = 0.f;
#pragma unroll
      for (int g = 0; g < 16; ++g) s += red[(g * 5 + ci) * 64 + col];
      if (ks == 0) s += p.b_ada[l * 6144 + cg * 64 + col];
      atomicAdd(WS_mod + (l * 5 + ci) * 6144 + cg * 64 + col, s);
    }
    return;
  }
  item -= P0_ADA;
  if (item < P0_ROPE) {
    for (int i = tid; i < 64 * 32; i += 256) {
      int pos = i >> 5, fi = i & 31;
      float inv = (float)pow(10000.0, -(double)fi / 32.0);
      float ang = (float)pos * inv;
      WS_ropetab[i * 2] = (float)cos((double)ang);
      WS_ropetab[i * 2 + 1] = (float)sin((double)ang);
    }
    return;
  }
  item -= P0_ROPE;
  if (item < P0_CACHE) {
    const int pc = item & 7, b = (item >> 3) & 3, l = item >> 5;
    const float* ksrc = p.cache_k + ((size_t)(b * 2 + l) * 512 + pc * 64) * 512;
    const float* vsrc = p.cache_v + ((size_t)(b * 2 + l) * 512 + pc * 64) * 512;
    u16* kdst = WS_CK + ((size_t)(l * 4 + b) * 512 + pc * 64) * 512;
    for (int i = tid; i < 64 * 512 / 4; i += 256) {
      float4 v = *(const float4*)(ksrc + (size_t)i * 4);
      *(uint2*)(kdst + (size_t)i * 4) = make_uint2(pack2(v.x, v.y), pack2(v.z, v.w));
    }
    for (int cc = 0; cc < 2; ++cc) {
      const int col = tid + cc * 256;
      u16* vdst = WS_CVt + ((size_t)(l * 4 + b) * 512 + col) * 512 + pc * 64;
      for (int j = 0; j < 8; ++j) {
        float v[8];
#pragma unroll
        for (int e = 0; e < 8; ++e) v[e] = vsrc[(size_t)(j * 8 + e) * 512 + col];
        *(uint4*)(vdst + j * 8) = make_uint4(pack2(v[0], v[1]), pack2(v[2], v[3]), pack2(v[4], v[5]), pack2(v[6], v[7]));
      }
    }
    return;
  }
  item -= P0_CACHE;
  if (item < P0_S0) {
    const int hh = item & 3, dir = (item >> 2) & 1, b = (item >> 3) & 3, l = item >> 5;
    const float* src = p.state_ret + ((size_t)(((b * 2 + l) * 2 + dir) * 4 + hh)) * 16384;
    u16* dst = WS_S0t + ((size_t)(((l * 4 + b) * 2 + dir) * 4 + hh)) * 16384;
    const int dv = tid & 127, kh = tid >> 7;
    for (int j = 0; j < 8; ++j) {
      const int dk0 = kh * 64 + j * 8;
      float v[8];
#pragma unroll
      for (int e = 0; e < 8; ++e) v[e] = src[(size_t)(dk0 + e) * 128 + dv];
      *(uint4*)(dst + (size_t)dv * 128 + dk0) = make_uint4(pack2(v[0], v[1]), pack2(v[2], v[3]), pack2(v[4], v[5]), pack2(v[6], v[7]));
    }
    return;
  }
  item -= P0_S0;
  if (item >= P0_S5) { wt_item(p, smem, item - P0_S5); return; }
  {
    const int g = item & 31, dir = (item >> 5) & 1, l = item >> 6;
    if (tid < 64) {
      const int pp = tid;
      const int ai = ((l * 2 + dir) * 32 + g) * 64 + pp;
      double lre = fmin((double)p.a_re[ai], -1e-4), lim = (double)p.a_im[ai];
      double dt = exp((double)p.log_dt[(l * 2 + dir) * 32 + g]);
      double er = exp(lre * dt);
      double abr = er * cos(lim * dt), abi = er * sin(lim * dt);
      WS_abar[ai * 2] = (float)abr;
      WS_abar[ai * 2 + 1] = (float)abi;
      double nr = abr - 1.0, ni = abi;
      double den = lre * lre + lim * lim;
      double cr = (nr * lre + ni * lim) / den, cim = (ni * lre - nr * lim) / den;
      u16* bt = WS_bbarT + (size_t)((l * 2 + dir) * 32 + g) * 128 * 16;
      const float* br = p.b_re + ((size_t)(l * 32 + g) * 64 + pp) * 16;
      const float* bi = p.b_im + ((size_t)(l * 32 + g) * 64 + pp) * 16;
      for (int c = 0; c < 16; ++c) {
        double xr = br[c], xi = bi[c];
        bt[pp * 16 + c] = f2bf((float)(cr * xr - cim * xi));
        bt[(64 + pp) * 16 + c] = f2bf((float)(cr * xi + cim * xr));
      }
      u16* ct = WS_cmT + (size_t)((l * 2 + dir) * 32 + g) * 16 * 128;
      const float* cre = p.c_re + ((size_t)((l * 2 + dir) * 32 + g) * 16) * 64;
      const float* cie = p.c_im + ((size_t)((l * 2 + dir) * 32 + g) * 16) * 64;
      for (int c = 0; c < 16; ++c) {
        ct[c * 128 + pp] = f2bf(cre[c * 64 + pp]);
        ct[c * 128 + 64 + pp] = f2bf(-cie[c * 64 + pp]);
      }
    }
  }
}


__device__ __forceinline__ void hmat_item(const Params& p, int l, int which, int item) {
  const int c = ltid() * 4;
  const int row0 = item * 8;
  const int ci = cond_of_row(row0);
  const float* mod = WS_mod + (l * 5 + ci) * 6144;
  const float4 sc = *(const float4*)(mod + (which ? 4 : 1) * 1024 + c);
  const float4 sh = *(const float4*)(mod + (which ? 3 : 0) * 1024 + c);
  float4 g = make_float4(1.f, 1.f, 1.f, 1.f), b = make_float4(0.f, 0.f, 0.f, 0.f);
  const float* st = nullptr;
  if (which == 1) { g = *(const float4*)(p.ln1_g + l * 1024 + c); b = *(const float4*)(p.ln1_b + l * 1024 + c); st = WS_stats + (size_t)(l * 2 + 0) * TALL * 2; }
  else if (l == 1) { g = *(const float4*)(p.ln2_g + c); b = *(const float4*)(p.ln2_b + c); st = WS_stats + (size_t)(0 * 2 + 1) * TALL * 2; }
  const float G0 = g.x * (1.f + sc.x), G1 = g.y * (1.f + sc.y), G2 = g.z * (1.f + sc.z), G3 = g.w * (1.f + sc.w);
  const float B0 = fmaf(b.x, 1.f + sc.x, sh.x), B1 = fmaf(b.y, 1.f + sc.y, sh.y), B2 = fmaf(b.z, 1.f + sc.z, sh.z), B3 = fmaf(b.w, 1.f + sc.w, sh.w);
  u16* dst = which ? WS_h2 : WS_h1;
#pragma unroll
  for (int r = 0; r < 8; ++r) {
    const int row = row0 + r;
    const float* src;
    if (which == 1) src = WS_pre1 + (size_t)row * 1024;
    else if (l == 1) src = p.out + (size_t)row * 1024;
    else src = row < TCTX ? p.x_prompt + (size_t)row * 1024 : p.x_sample + (size_t)(row - TCTX) * 1024;
    float rs = 1.f, nm = 0.f;
    if (st) {
      const float s = st[row * 2], q = st[row * 2 + 1];
      const float mu = s * (1.f / 1024.f);
      rs = rsqrtf(fmaxf(q * (1.f / 1024.f) - mu * mu, 0.f) + LNEPS);
      nm = -mu * rs;
    }
    const float4 x = *(const float4*)(src + c);
    const float h0 = fmaf(fmaf(x.x, rs, nm), G0, B0), h1 = fmaf(fmaf(x.y, rs, nm), G1, B1);
    const float h2 = fmaf(fmaf(x.z, rs, nm), G2, B2), h3 = fmaf(fmaf(x.w, rs, nm), G3, B3);
    *(uint2*)(dst + (size_t)row * 1024 + c) = make_uint2(pack2(h0, h1), pack2(h2, h3));
  }
}

__device__ __forceinline__ void p1_item(const Params& p, char* smem, int l, int item) {
  const int mt = item & 63, nt = item >> 6;
  const int m0 = mt * 128, n0 = nt * 128;
  const int tid = ltid(), lane = tid & 63, wave = tid >> 6, wm = wave >> 1, wn = wave & 1;
  f16v acc[2][2];
  gemm_mainloop0(smem, WS_h1, 1024, WS_Wt + WT_LAYER * l + WT_IN, 1024, 1024, m0, n0, acc);

  const bool latent = m0 >= TCTX;
  const int seg = n0 >> 9;
  const int cs0 = n0 & 511;
  const int l31 = lane & 31;
  u16* Cs = (u16*)smem;
  u16* CsT = Cs + 128 * CST;
  const int rl0 = wm * 64 + 4 * (lane >> 5);
  const int cl0 = wn * 64 + l31;
  const bool want_rm = !(seg == 2 || seg == 7);
  const bool want_t = (seg == 2 || seg == 7 || (seg == 1 && !latent));
#pragma unroll
  for (int mi = 0; mi < 2; ++mi)
#pragma unroll
    for (int q = 0; q < 4; ++q) {
      float o0[4], o1[4];
#pragma unroll
      for (int j = 0; j < 4; ++j) {
        const int reg = q * 4 + j;
        float x1 = acc[mi][0][reg], x2 = acc[mi][1][reg];
        if (seg <= 1) {
          if (latent) {
            const int pos = (m0 - TCTX + rl0 + mi * 32 + q * 8 + j) & 1023;
            const int pidx = ((cs0 + wn * 64) & 64) ? (pos & 63) : (pos >> 6);
            const float cs = WS_ropetab[(pidx * 32 + l31) * 2], sn = WS_ropetab[(pidx * 32 + l31) * 2 + 1];
            const float t1 = x1 * cs - x2 * sn, t2 = x1 * sn + x2 * cs;
            x1 = t1; x2 = t2;
          }
          if (seg == 1) { x1 *= 0.08838834764831845f; x2 *= 0.08838834764831845f; }
        } else if (seg == 3) { x1 = siluf_(x1); x2 = siluf_(x2); }
        else if (seg == 5) { x1 *= 0.125f; x2 *= 0.125f; }
        else if (seg >= 8) { x1 = sigmoidf_(x1); x2 = sigmoidf_(x2); }
        o0[j] = x1; o1[j] = x2;
        if (want_rm) {
          const int rl = rl0 + mi * 32 + q * 8 + j;
          Cs[rl * CST + cl0] = f2bf(x1);
          Cs[rl * CST + cl0 + 32] = f2bf(x2);
        }
        if ((seg == 6 || seg == 7) && !latent) {
          const int row = m0 + rl0 + mi * 32 + q * 8 + j;
          float* o = p.out + (seg == 6 ? OUT_CK : OUT_CV) + ((size_t)((row >> 8) * 2 + l) * 256 + (row & 255)) * 512 + cs0 + cl0;
          o[0] = acc[mi][0][reg]; o[32] = acc[mi][1][reg];
        }
      }
      if (want_t) {
        const int rl = rl0 + mi * 32 + q * 8;
        *(uint2*)(CsT + cl0 * CST + rl) = make_uint2(pack2(o0[0], o0[1]), pack2(o0[2], o0[3]));
        *(uint2*)(CsT + (cl0 + 32) * CST + rl) = make_uint2(pack2(o1[0], o1[1]), pack2(o1[2], o1[3]));
      }
    }
  __syncthreads();
  if (want_rm) {
    u16* dst;
    size_t ld = 512;
    if (seg >= 8) { dst = WS_GT + (size_t)m0 * 3072 + (n0 - 4096); ld = 3072; }
    else {
      u16* base = seg == 0 ? WS_Q : seg == 1 ? WS_K : seg == 3 ? WS_G : seg == 4 ? WS_SU : seg == 5 ? WS_NQ : WS_NK;
      dst = base + (size_t)m0 * 512 + cs0;
    }
    cs_store(Cs, dst, ld, tid);
  }
  if (want_t) {
    u16* base = seg == 2 ? WS_VtR : seg == 7 ? WS_NVt : WS_KtR;
    u16* dst;
    size_t ld;
    if (!latent) { dst = base + ((size_t)(m0 >> 8) * 512 + cs0) * 256 + (m0 & 255); ld = 256; }
    else { dst = base + VTR_LAT + ((size_t)((m0 - TCTX) >> 10) * 512 + cs0) * 1024 + ((m0 - TCTX) & 1023); ld = 1024; }
    cs_store(CsT, dst, ld, tid);
  }
}

template <int D, int MODE>
__device__ __forceinline__ void attn_item(const Params& p, char* smem, int l, int idx) {
  constexpr int KSTR = D + 8;
  constexpr int NKS = D / 32;
  constexpr int NB = D / 16;
  constexpr int NCH = D / 32;
  constexpr int NBUF = (MODE == 0) ? 1 : 2;
  u16* Ks = (u16*)smem;
  u16* Vts = Ks + NBUF * 64 * KSTR;
  float* rpbs = (float*)(Vts + NBUF * D * 72);
  const int tid = ltid(), lane = tid & 63, wave = tid >> 6;
  const int l15 = lane & 15, g = lane >> 4;
  const int wave_u = __builtin_amdgcn_readfirstlane(wave);

  int b, hh, qt, L, tokbase, nt;
  bool latent = false;
  int kr0 = 0, rrow = 0;
  if constexpr (MODE == 0) {
    if (idx < 256) { latent = true; b = idx >> 6; hh = (idx >> 4) & 3; qt = idx & 15; L = 1024; tokbase = TCTX + b * 1024; nt = 16 + 4; }
    else { idx -= 256; b = idx >> 4; hh = (idx >> 2) & 3; qt = idx & 3; L = 256; tokbase = b * 256; nt = 4; }
  } else if constexpr (MODE == 1) {
    b = idx >> 5; hh = (idx >> 2) & 7; qt = idx & 3; L = 256; tokbase = b * 256; nt = 4;
  } else {
    b = idx >> 7; hh = (idx >> 4) & 7; qt = idx & 15; rrow = qt; L = 1024; tokbase = TCTX + b * 1024; nt = 16; latent = true;
    kr0 = min(max(rrow - 4, 0), 8);
  }
  const int tq = qt * 64 + wave * 16 + l15;
  const int qtok = tokbase + tq;

  float lgf2 = 0.f, lgb2 = 0.f;
  if constexpr (MODE == 0) {
    float xf = p.ret_decay[(l * 2 + 0) * 4 + hh], xb = p.ret_decay[(l * 2 + 1) * 4 + hh];
    lgf2 = -log1pf(expf(-xf)) * 1.4426950408889634f;
    lgb2 = -log1pf(expf(-xb)) * 1.4426950408889634f;
  }
  float cfw[4][4], cbw[4][4];
  if constexpr (MODE == 0) {
#pragma unroll
    for (int kb = 0; kb < 4; ++kb)
#pragma unroll
      for (int r = 0; r < 4; ++r) {
        const float off = (float)(kb * 16 + g * 4 + r);
        cfw[kb][r] = __builtin_amdgcn_exp2f(-lgf2 * off);
        cbw[kb][r] = __builtin_amdgcn_exp2f(lgb2 * off);
      }
  }

  __syncthreads();
  if constexpr (MODE == 2) {
    for (int i = tid; i < 465; i += 256) rpbs[i] = p.rpb[(size_t)(l * 8 + hh) * 465 + i];
  }

  u4v qf[NKS];
  {
    const u16* qb = (MODE == 0 ? WS_Q : WS_NQ) + (size_t)qtok * 512 + hh * D + g * 8;
#pragma unroll
    for (int ks = 0; ks < NKS; ++ks) qf[ks] = *(const u4v*)(qb + ks * 32);
  }

  f4v ot[NB];
#pragma unroll
  for (int nb = 0; nb < NB; ++nb) ot[nb] = (f4v){0.f, 0.f, 0.f, 0.f};
  float mrun = -1e30f, lsum = 0.f;

  const int ntk = (MODE == 0) ? (L >> 6) : nt;
  u4v kr[NCH], vr[NCH], kr2[NCH], vr2[NCH];
#define ATTN_ISSUE(KT, KR, VR)                                                                                   \
  {                                                                                                      \
    const int kt_ = (KT);                                                                                \
    const u16* kp; const u16* vp; int ldv;                                                               \
    if constexpr (MODE == 0) {                                                                           \
      kp = WS_K + (size_t)(tokbase + kt_ * 64) * 512 + hh * 128;                                          \
      if (latent) { vp = WS_VtR + VTR_LAT + ((size_t)(b * 4 + hh) * 128) * 1024 + kt_ * 64; ldv = 1024; } \
      else { vp = WS_VtR + ((size_t)(b * 4 + hh) * 128) * 256 + kt_ * 64; ldv = 256; }                    \
    } else if constexpr (MODE == 1) {                                                                    \
      kp = WS_NK + (size_t)(tokbase + kt_ * 64) * 512 + hh * 64;                                          \
      vp = WS_NVt + ((size_t)(b * 8 + hh) * 64) * 256 + kt_ * 64; ldv = 256;                              \
    } else {                                                                                             \
      if (kt_ < 8) {                                                                                     \
        const int krow = kr0 + kt_;                                                                      \
        kp = WS_NK + (size_t)(tokbase + krow * 64) * 512 + hh * 64;                                       \
        vp = WS_NVt + NVT_LAT + ((size_t)(b * 8 + hh) * 64) * 1024 + krow * 64; ldv = 1024;               \
      } else {                                                                                           \
        kp = WS_CK + ((size_t)(l * 4 + b) * 512 + (kt_ - 8) * 64) * 512 + hh * 64;                        \
        vp = WS_CVt + ((size_t)((l * 4 + b) * 8 + hh) * 64) * 512 + (kt_ - 8) * 64; ldv = 512;            \
      }                                                                                                  \
    }                                                                                                    \
    _Pragma("unroll") for (int i = 0; i < NCH; ++i) {                                                    \
      const int c = tid + 256 * i;                                                                       \
      const int r = c / (D / 8), cc = c % (D / 8);                                                       \
      KR[i] = *(const u4v*)(kp + (size_t)r * 512 + cc * 8);                                              \
      const int vrw = c >> 3, vc = c & 7;                                                                \
      VR[i] = *(const u4v*)(vp + (size_t)vrw * ldv + vc * 8);                                            \
    }                                                                                                    \
  }
#define ATTN_STAGE(KR, VR, BUF)                                                                                   \
  {                                                                                                      \
    _Pragma("unroll") for (int i = 0; i < NCH; ++i) {                                                    \
      const int c = tid + 256 * i;                                                                       \
      const int r = c / (D / 8), cc = c % (D / 8);                                                       \
      *(u4v*)(Ks + (BUF) * (64 * KSTR) + r * KSTR + cc * 8) = KR[i];                                                         \
      const int vrw = c >> 3, vc = c & 7;                                                                \
      *(u4v*)(Vts + (BUF) * (D * 72) + vrw * 72 + vc * 8) = VR[i];                                                        \
    }                                                                                                    \
  }

  auto tile_body = [&](const int kt, const u16* Kb, const u16* Vb) {
    f4v st[4];
    int kb_lo = 0, kb_hi = 3;
    if constexpr (MODE == 2) {
      if (kt < 8) { kb_lo = wave_u >= 2 ? wave_u - 1 : 0; kb_hi = wave_u <= 1 ? wave_u + 1 : 3; }
    }
#pragma unroll
    for (int kb = 0; kb < 4; ++kb) {
      st[kb] = (f4v){0.f, 0.f, 0.f, 0.f};
      if (MODE != 2 || (kb >= kb_lo && kb <= kb_hi)) {
#pragma unroll
        for (int ks = 0; ks < NKS; ++ks) {
          s8v kf = *(const s8v*)(Kb + (kb * 16 + l15) * KSTR + ks * 32 + g * 8);
          st[kb] = __builtin_amdgcn_mfma_f32_16x16x32_bf16(kf, bc8(qf[ks]), st[kb], 0, 0, 0);
        }
      }
    }
    if constexpr (MODE == 0) {
      if (kt < qt) {
        const float rowf = __builtin_amdgcn_exp2f(lgf2 * (float)(tq - kt * 64));
#pragma unroll
        for (int kb = 0; kb < 4; ++kb)
#pragma unroll
          for (int r = 0; r < 4; ++r) st[kb][r] *= rowf * cfw[kb][r];
      } else if (kt > qt) {
        const float rowb = __builtin_amdgcn_exp2f(lgb2 * (float)(kt * 64 - tq));
#pragma unroll
        for (int kb = 0; kb < 4; ++kb)
#pragma unroll
          for (int r = 0; r < 4; ++r) st[kb][r] *= rowb * cbw[kb][r];
      } else {
#pragma unroll
        for (int kb = 0; kb < 4; ++kb)
#pragma unroll
          for (int r = 0; r < 4; ++r) {
            const int ts = kt * 64 + kb * 16 + g * 4 + r;
            const int d = tq - ts;
            float dec = d > 0 ? __builtin_amdgcn_exp2f(lgf2 * (float)d) : (d < 0 ? __builtin_amdgcn_exp2f(lgb2 * (float)(-d)) : 2.f);
            st[kb][r] *= dec;
          }
      }
    } else {
      if constexpr (MODE == 2) {
        if (kt < 8) {
          const int qc = wave * 16 + l15;
          const int ws = min(max(qc - 8, 0), 48);
          const int roff = (kr0 + kt) - rrow + 7;
#pragma unroll
          for (int kb = 0; kb < 4; ++kb) {
            if (kb >= kb_lo && kb <= kb_hi) {
#pragma unroll
              for (int r = 0; r < 4; ++r) {
                const int kc = kb * 16 + g * 4 + r;
                const bool valid = (kc >= ws) && (kc < ws + 16);
                const int coff = min(max(kc - qc + 15, 0), 30);
                const float bias = rpbs[roff * 31 + coff];
                st[kb][r] = valid ? st[kb][r] + bias : -1e30f;
              }
            } else {
              st[kb] = (f4v){-1e30f, -1e30f, -1e30f, -1e30f};
            }
          }
        }
      }
      float tmax = st[0][0];
#pragma unroll
      for (int kb = 0; kb < 4; ++kb)
#pragma unroll
        for (int r = 0; r < 4; ++r) tmax = fmaxf(tmax, st[kb][r]);
      tmax = fmaxf(tmax, __shfl_xor(tmax, 16));
      tmax = fmaxf(tmax, __shfl_xor(tmax, 32));
      const float mnew = fmaxf(mrun, tmax);
      const float alpha = __expf(mrun - mnew);
      float ps = 0.f;
#pragma unroll
      for (int kb = 0; kb < 4; ++kb) {
        if (MODE != 2 || (kb >= kb_lo && kb <= kb_hi)) {
#pragma unroll
          for (int r = 0; r < 4; ++r) {
            float e = __expf(st[kb][r] - mnew);
            st[kb][r] = e;
            ps += e;
          }
        } else {
          st[kb] = (f4v){0.f, 0.f, 0.f, 0.f};
        }
      }
      lsum = lsum * alpha + ps;
      mrun = mnew;
#pragma unroll
      for (int nb = 0; nb < NB; ++nb) ot[nb] *= alpha;
    }
    u4v pf[2];
#pragma unroll
    for (int s = 0; s < 2; ++s) {
      pf[s] = (u4v){pack2(st[2 * s][0], st[2 * s][1]), pack2(st[2 * s][2], st[2 * s][3]),
                    pack2(st[2 * s + 1][0], st[2 * s + 1][1]), pack2(st[2 * s + 1][2], st[2 * s + 1][3])};
    }
#pragma unroll
    for (int s = 0; s < 2; ++s) {
      if (MODE == 2 && (2 * s + 1 < kb_lo || 2 * s > kb_hi)) continue;
#pragma unroll
      for (int nb = 0; nb < NB; ++nb) {
        const u16* vb = Vb + (nb * 16 + l15) * 72 + s * 32 + g * 4;
        uint2 lo = *(const uint2*)(vb);
        uint2 hi = *(const uint2*)(vb + 16);
        u4v vf = (u4v){lo.x, lo.y, hi.x, hi.y};
        ot[nb] = __builtin_amdgcn_mfma_f32_16x16x32_bf16(bc8(vf), bc8(pf[s]), ot[nb], 0, 0, 0);
      }
    }
  };
  if constexpr (MODE == 0) {
    ATTN_ISSUE(0, kr, vr)
#pragma unroll 1
    for (int kt = 0; kt < ntk; ++kt) {
      __syncthreads();
      ATTN_STAGE(kr, vr, 0)
      __syncthreads();
      if (kt + 1 < ntk) ATTN_ISSUE(kt + 1, kr, vr)
      tile_body(kt, Ks, Vts);
    }
  } else {
    ATTN_ISSUE(0, kr, vr)
    ATTN_ISSUE(1, kr2, vr2)
#pragma unroll 1
    for (int kt = 0; kt < ntk; kt += 2) {
      __syncthreads();
      ATTN_STAGE(kr, vr, 0)
      ATTN_STAGE(kr2, vr2, 1)
      __syncthreads();
      if (kt + 2 < ntk) {
        ATTN_ISSUE(kt + 2, kr, vr)
        ATTN_ISSUE(kt + 3, kr2, vr2)
      }
      tile_body(kt, Ks, Vts);
      tile_body(kt + 1, Ks + (NBUF - 1) * 64 * KSTR, Vts + (NBUF - 1) * D * 72);
    }
  }

  if constexpr (MODE == 0) {
    if (latent) {
#pragma unroll 1
      for (int dir = 0; dir < 2; ++dir) {
        const float scale = dir == 0 ? __builtin_amdgcn_exp2f(lgf2 * (float)(tq + 1)) : __builtin_amdgcn_exp2f(lgb2 * (float)(L - tq));
        const u16* S0 = WS_S0t + ((size_t)(((l * 4 + b) * 2 + dir) * 4 + hh)) * 16384;
#pragma unroll
        for (int s = 0; s < NKS; ++s) {
          u4v pq = (u4v){pack2(bflo(qf[s][0]) * scale, bfhi(qf[s][0]) * scale), pack2(bflo(qf[s][1]) * scale, bfhi(qf[s][1]) * scale),
                         pack2(bflo(qf[s][2]) * scale, bfhi(qf[s][2]) * scale), pack2(bflo(qf[s][3]) * scale, bfhi(qf[s][3]) * scale)};
#pragma unroll
          for (int nb = 0; nb < NB; ++nb) {
            u4v vf = *(const u4v*)(S0 + (size_t)(nb * 16 + l15) * 128 + s * 32 + g * 8);
            ot[nb] = __builtin_amdgcn_mfma_f32_16x16x32_bf16(bc8(vf), bc8(pq), ot[nb], 0, 0, 0);
          }
        }
      }
    }
    float s = 0.f;
#pragma unroll
    for (int nb = 0; nb < NB; ++nb) s += ot[nb][0] + ot[nb][1] + ot[nb][2] + ot[nb][3];
    s += __shfl_xor(s, 16); s += __shfl_xor(s, 32);
    const float mu = s * (1.f / 128.f);
    float q = 0.f;
#pragma unroll
    for (int nb = 0; nb < NB; ++nb)
#pragma unroll
      for (int r = 0; r < 4; ++r) { float dlt = ot[nb][r] - mu; q += dlt * dlt; }
    q += __shfl_xor(q, 16); q += __shfl_xor(q, 32);
    const float rstd = rsqrtf(q * (1.f / 128.f) + LNEPS);
#pragma unroll
    for (int nb = 0; nb < NB; ++nb) {
      const size_t off = (size_t)qtok * 512 + hh * 128 + nb * 16 + g * 4;
      uint2 gg = *(const uint2*)(WS_G + off);
      float o0 = (ot[nb][0] - mu) * rstd * bflo(gg.x);
      float o1 = (ot[nb][1] - mu) * rstd * bfhi(gg.x);
      float o2 = (ot[nb][2] - mu) * rstd * bflo(gg.y);
      float o3 = (ot[nb][3] - mu) * rstd * bfhi(gg.y);
      *(uint2*)(WS_rout + off) = make_uint2(pack2(o0, o1), pack2(o2, o3));
    }
  } else {
    lsum += __shfl_xor(lsum, 16); lsum += __shfl_xor(lsum, 32);
    const float inv = __builtin_amdgcn_rcpf(lsum);
#pragma unroll
    for (int nb = 0; nb < NB; ++nb) {
      const size_t off = (size_t)qtok * 512 + hh * 64 + nb * 16 + g * 4;
      *(uint2*)(WS_nout + off) = make_uint2(pack2(ot[nb][0] * inv, ot[nb][1] * inv), pack2(ot[nb][2] * inv, ot[nb][3] * inv));
    }
  }
}

__device__ __forceinline__ void retstate_item(const Params& p, int l, int idx) {
  const int dir = idx & 1, hh = (idx >> 1) & 3, b = idx >> 3;
  const int tid = ltid(), lane = tid & 63, wave = tid >> 6;
  const int r = lane & 31, h2 = lane >> 5;
  const float x = p.ret_decay[(l * 2 + dir) * 4 + hh];
  const float lg2 = -log1pf(expf(-x)) * 1.4426950408889634f;
  const u16* Kt = WS_KtR + ((size_t)(b * 4 + hh) * 128) * 256;
  const u16* Vt = WS_VtR + ((size_t)(b * 4 + hh) * 128) * 256;
  f16v acc[4];
#pragma unroll
  for (int i = 0; i < 4; ++i) acc[i] = zero16();
#pragma unroll 2
  for (int ks = 0; ks < 16; ++ks) {
    const int tok0 = ks * 16 + h2 * 8;
    const u4v a = *(const u4v*)(Kt + (size_t)(wave * 32 + r) * 256 + tok0);
    u4v af;
#pragma unroll
    for (int w = 0; w < 4; ++w) {
      const int t0 = tok0 + 2 * w, t1 = t0 + 1;
      float w0 = __builtin_amdgcn_exp2f(lg2 * (float)(dir == 0 ? 255 - t0 : t0));
      float w1 = __builtin_amdgcn_exp2f(lg2 * (float)(dir == 0 ? 255 - t1 : t1));
      af[w] = pack2(bflo(a[w]) * w0, bfhi(a[w]) * w1);
    }
#pragma unroll
    for (int nt = 0; nt < 4; ++nt) {
      const u4v bfr = *(const u4v*)(Vt + (size_t)(nt * 32 + r) * 256 + tok0);
      acc[nt] = __builtin_amdgcn_mfma_f32_32x32x16_bf16(bc8(af), bc8(bfr), acc[nt], 0, 0, 0);
    }
  }
  float* o = p.out + OUT_SRET + ((size_t)(((b * 2 + l) * 2 + dir) * 4 + hh)) * 16384;
#pragma unroll
  for (int nt = 0; nt < 4; ++nt)
#pragma unroll
    for (int reg = 0; reg < 16; ++reg) {
      const int dk = wave * 32 + (reg & 3) + 8 * (reg >> 2) + 4 * h2;
      o[(size_t)dk * 128 + nt * 32 + r] = acc[nt][reg];
    }
}

__device__ __forceinline__ void s5_item(const Params& p, char* smem, int l, int item) {
  const int tid = ltid(), lane = tid & 63, wave = tid >> 6;
  const int l15 = lane & 15, g4 = lane >> 4;
  int seq = item * 4 + wave;
  int b, dir, g, L, tokbase;
  bool latent;
  if (seq < 256) { latent = true; b = seq >> 6; dir = (seq >> 5) & 1; g = seq & 31; L = 1024; tokbase = TCTX + b * 1024; }
  else { seq -= 256; latent = false; b = seq >> 6; dir = (seq >> 5) & 1; g = seq & 31; L = 256; tokbase = b * 256; }
  float* buf = (float*)smem + wave * (16 * 132);
  const int tg = (l * 2 + dir) * 32 + g;
  const float ar = WS_abar[(tg * 64 + lane) * 2], ai = WS_abar[(tg * 64 + lane) * 2 + 1];
  u4v bfrag[8];
#pragma unroll
  for (int nt = 0; nt < 8; ++nt) {
    if (g4 < 2) bfrag[nt] = *(const u4v*)(WS_bbarT + ((size_t)tg * 128 + nt * 16 + l15) * 16 + g4 * 8);
    else bfrag[nt] = (u4v){0u, 0u, 0u, 0u};
  }
  u4v cfrag[4];
#pragma unroll
  for (int ks = 0; ks < 4; ++ks) cfrag[ks] = *(const u4v*)(WS_cmT + ((size_t)tg * 16 + l15) * 128 + ks * 32 + g4 * 8);
  float xr = 0.f, xi = 0.f;
  if (latent) {
    const float* h0 = p.state_ssm + ((size_t)(((b * 2 + l) * 2 + dir) * 32 + g) * 64 + lane) * 2;
    xr = h0[0]; xi = h0[1];
  }
  u16* yd = WS_YD + (size_t)dir * TALL * 512;
  __syncthreads();
  const int nsub = L >> 4;
  u4v afn = (u4v){0u, 0u, 0u, 0u};
  if (g4 < 2) {
    const int pos = dir == 0 ? l15 : L - 1 - l15;
    afn = *(const u4v*)(WS_SU + (size_t)(tokbase + pos) * 512 + g * 16 + g4 * 8);
  }
#pragma unroll 1
  for (int sub = 0; sub < nsub; ++sub) {
    const u4v af = afn;
    if (g4 < 2 && sub + 1 < nsub) {
      const int tau = (sub + 1) * 16 + l15;
      const int pos = dir == 0 ? tau : L - 1 - tau;
      afn = *(const u4v*)(WS_SU + (size_t)(tokbase + pos) * 512 + g * 16 + g4 * 8);
    }
#pragma unroll
    for (int nt = 0; nt < 8; ++nt) {
      f4v c = (f4v){0.f, 0.f, 0.f, 0.f};
      c = __builtin_amdgcn_mfma_f32_16x16x32_bf16(bc8(af), bc8(bfrag[nt]), c, 0, 0, 0);
#pragma unroll
      for (int r = 0; r < 4; ++r) buf[(g4 * 4 + r) * 132 + nt * 16 + l15] = c[r];
    }
    __builtin_amdgcn_wave_barrier();
#pragma unroll
    for (int i = 0; i < 16; ++i) {
      const float bur = buf[i * 132 + lane], bui = buf[i * 132 + 64 + lane];
      const float nr = ar * xr - ai * xi + bur;
      const float ni = ar * xi + ai * xr + bui;
      xr = nr; xi = ni;
      buf[i * 132 + lane] = xr;
      buf[i * 132 + 64 + lane] = xi;
    }
    __builtin_amdgcn_wave_barrier();
    f4v y = (f4v){0.f, 0.f, 0.f, 0.f};
#pragma unroll
    for (int ks = 0; ks < 4; ++ks) {
      const float* bp = buf + l15 * 132 + ks * 32 + g4 * 8;
      float4 v0 = *(const float4*)(bp), v1 = *(const float4*)(bp + 4);
      const u4v xa = (u4v){pack2(v0.x, v0.y), pack2(v0.z, v0.w), pack2(v1.x, v1.y), pack2(v1.z, v1.w)};
      y = __builtin_amdgcn_mfma_f32_16x16x32_bf16(bc8(xa), bc8(cfrag[ks]), y, 0, 0, 0);
    }
#pragma unroll
    for (int r = 0; r < 4; ++r) {
      const int tau = sub * 16 + g4 * 4 + r;
      const int pos = dir == 0 ? tau : L - 1 - tau;
      yd[(size_t)(tokbase + pos) * 512 + g * 16 + l15] = f2bf(y[r]);
    }
    __builtin_amdgcn_wave_barrier();
  }
  if (!latent) {
    float* o = p.out + OUT_SSSM + ((size_t)(((b * 2 + l) * 2 + dir) * 32 + g) * 64 + lane) * 2;
    o[0] = xr; o[1] = xi;
  }
}

#define MX_S5 320
#define MX_RET 512
#define MX_NA 512
#define MX_CA 512
#define MX_RS 128
#define MX_ITEMS (MX_S5 + MX_RET + MX_NA + MX_CA + MX_RS)
__device__ __forceinline__ void mixer_item(const Params& p, char* smem, int l, int item) {
  if (item < 64) { s5_item(p, smem, l, item); return; }
  item -= 64;
  if (item < 256) { attn_item<128, 0>(p, smem, l, item); return; }
  item -= 256;
  if (item < 512) { attn_item<64, 2>(p, smem, l, item); return; }
  item -= 512;
  if (item < 256) { s5_item(p, smem, l, 64 + item); return; }
  item -= 256;
  if (item < 256) { attn_item<128, 0>(p, smem, l, 256 + item); return; }
  item -= 256;
  if (item < 512) { attn_item<64, 1>(p, smem, l, item); return; }
  item -= 512;
  retstate_item(p, l, item);
}

__device__ __forceinline__ void p3a_item(const Params& p, char* smem, int l, int item) {
  const int mt = item & 63, nt = item >> 6;
  const int m0 = mt * 128, n0 = nt * 128;
  const int tid = ltid(), lane = tid & 63, wave = tid >> 6, wm = wave >> 1, wn = wave & 1;
  AArgs a{};
  a.SU = WS_SU; a.YD0 = WS_YD; a.YD1 = WS_YD + (size_t)TALL * 512; a.dsk = p.ssm_d + l * 512;
  f16v acc[2][2];
  gemm_mainloop<2>(smem, a, WS_Wt + WT_LAYER * l + WT_GLU, 512, 512, m0, n0, acc);
#pragma unroll
  for (int mi = 0; mi < 2; ++mi)
#pragma unroll
    for (int reg = 0; reg < 16; ++reg) {
      const int row = EPI_ROW(mi, reg);
#pragma unroll
      for (int ni = 0; ni < 2; ++ni) {
        const int col = EPI_COL(ni);
        const size_t off = (size_t)row * 512 + col;
        float y = geluf_(a.dsk[col] * bf2f(WS_SU[off]) + bf2f(a.YD0[off]) + bf2f(a.YD1[off]));
        WS_sout[off] = f2bf(y * sigmoidf_(acc[mi][ni][reg]));
      }
    }
}

__device__ __forceinline__ void p3b_item(const Params& p, char* smem, int l, int item) {
  const int mt = item & 63, nt = item >> 6;
  const int m0 = mt * 128, n0 = nt * 128;
  const int tid = ltid(), lane = tid & 63, wave = tid >> 6, wm = wave >> 1, wn = wave & 1;
  int nbr = 3;
  asm volatile("" : "+s"(nbr));
#pragma unroll 1
  for (int br = 0; br < nbr; ++br) {
    const u16* Abr = br == 0 ? WS_rout : (br == 1 ? WS_sout : WS_nout);
    f16v acc[2][2];
    gemm_mainloop0(smem, Abr, 512, WS_Wt + WT_LAYER * l + WT_BR + (size_t)br * 512 * 1024, 512, 512, m0, n0, acc);
    u16* Cs = (u16*)smem;
    {
      const int rl0 = wm * 64 + 4 * (lane >> 5), cl0 = wn * 64 + (lane & 31);
#pragma unroll
      for (int mi = 0; mi < 2; ++mi)
#pragma unroll
        for (int reg = 0; reg < 16; ++reg) {
          const int rl = rl0 + mi * 32 + (reg & 3) + 8 * (reg >> 2);
          Cs[rl * CST + cl0] = f2bf(acc[mi][0][reg]);
          Cs[rl * CST + cl0 + 32] = f2bf(acc[mi][1][reg]);
        }
    }
    __syncthreads();
    int tl = tid;
    asm volatile("" : "+v"(tl));
#pragma unroll
    for (int i = 0; i < 8; ++i) {
      const int c = tl + 256 * i, r = c >> 4, ch = c & 15;
      const u4v av = *(const u4v*)(Cs + r * CST + ch * 8);
      const u4v gv = *(const u4v*)(WS_GT + (size_t)(m0 + r) * 3072 + br * 1024 + n0 + ch * 8);
      u16* mp = WS_merged + (size_t)(m0 + r) * 1024 + n0 + ch * 8;
      u4v mv = (u4v){0u, 0u, 0u, 0u};
      if (br > 0) mv = *(const u4v*)mp;
      u4v ov;
#pragma unroll
      for (int j = 0; j < 4; ++j)
        ov[j] = pack2(fmaf(bflo(gv[j]), bflo(av[j]), bflo(mv[j])), fmaf(bfhi(gv[j]), bfhi(av[j]), bfhi(mv[j])));
      *(u4v*)mp = ov;
    }
  }
}


#define CFS 132
__device__ __forceinline__ void epi_resid(char* smem, f16v (&acc)[2][2], int m0, int n0, const float* __restrict__ gvec,
                                          const float* __restrict__ xlo, const float* __restrict__ xhi,
                                          const float* __restrict__ xstats, const float* __restrict__ lng,
                                          const float* __restrict__ lnb, float* __restrict__ dst,
                                          float* __restrict__ stats_out, bool do_stats) {
  float* Cf = (float*)smem;
  const int tid = ltid(), lane = tid & 63, wave = tid >> 6, wm = wave >> 1, wn = wave & 1;
  {
    const int rl0 = wm * 64 + 4 * (lane >> 5), cl0 = wn * 64 + (lane & 31);
    const float ga = gvec[n0 + cl0], gb = gvec[n0 + cl0 + 32];
#pragma unroll
    for (int mi = 0; mi < 2; ++mi)
#pragma unroll
      for (int reg = 0; reg < 16; ++reg) {
        const int rl = rl0 + mi * 32 + (reg & 3) + 8 * (reg >> 2);
        Cf[rl * CFS + cl0] = ga * acc[mi][0][reg];
        Cf[rl * CFS + cl0 + 32] = gb * acc[mi][1][reg];
      }
  }
  __syncthreads();
  const int ch = tid & 31, r0 = tid >> 5;
  const int col = n0 + ch * 4;
  float4 g4 = make_float4(1.f, 1.f, 1.f, 1.f), b4 = make_float4(0.f, 0.f, 0.f, 0.f);
  if (xstats) { g4 = *(const float4*)(lng + col); b4 = *(const float4*)(lnb + col); }
  const float* xbase = (m0 < TCTX ? xlo + (size_t)m0 * 1024 : xhi + (size_t)(m0 - TCTX) * 1024) + col;
#pragma unroll 4
  for (int i = 0; i < 16; ++i) {
    const int r = r0 + 8 * i;
    const int row = m0 + r;
    const float4 v = *(const float4*)(Cf + r * CFS + ch * 4);
    float4 x = *(const float4*)(xbase + (size_t)r * 1024);
    if (xstats) {
      const float s = xstats[row * 2], q = xstats[row * 2 + 1];
      const float mu = s * (1.f / 1024.f);
      const float rstd = rsqrtf(fmaxf(q * (1.f / 1024.f) - mu * mu, 0.f) + LNEPS);
      x.x = (x.x - mu) * rstd * g4.x + b4.x; x.y = (x.y - mu) * rstd * g4.y + b4.y;
      x.z = (x.z - mu) * rstd * g4.z + b4.z; x.w = (x.w - mu) * rstd * g4.w + b4.w;
    }
    float4 o;
    o.x = ALPHA * x.x + v.x; o.y = ALPHA * x.y + v.y; o.z = ALPHA * x.z + v.z; o.w = ALPHA * x.w + v.w;
    *(float4*)(dst + (size_t)row * 1024 + col) = o;
    if (do_stats) {
      float ss = o.x + o.y + o.z + o.w, qq = o.x * o.x + o.y * o.y + o.z * o.z + o.w * o.w;
#pragma unroll
      for (int sh = 1; sh < 32; sh <<= 1) { ss += __shfl_xor(ss, sh); qq += __shfl_xor(qq, sh); }
      if (ch == 0) { atomicAdd(stats_out + row * 2, ss); atomicAdd(stats_out + row * 2 + 1, qq); }
    }
  }
}

__device__ __forceinline__ void p3c_item(const Params& p, char* smem, int l, int item, bool do_stats = true) {
  const int mt = item & 63, nt = item >> 6;
  const int m0 = mt * 128, n0 = nt * 128;
  const int tid = ltid(), lane = tid & 63, wave = tid >> 6, wm = wave >> 1, wn = wave & 1;
  f16v acc[2][2];
  gemm_mainloop0(smem, WS_merged, 1024, WS_Wt + WT_LAYER * l + WT_O, 1024, 1024, m0, n0, acc);
  const int ci = cond_of_row(m0);
  const float* g1 = WS_mod + (l * 5 + ci) * 6144 + 2048;
  float* st1 = WS_stats + (size_t)(l * 2 + 0) * TALL * 2;
  if (l == 0)
    epi_resid(smem, acc, m0, n0, g1, p.x_prompt, p.x_sample, nullptr, nullptr, nullptr, WS_pre1, st1, do_stats);
  else
    epi_resid(smem, acc, m0, n0, g1, p.out, p.out + (size_t)TCTX * 1024, WS_stats + (size_t)(0 * 2 + 1) * TALL * 2, p.ln2_g, p.ln2_b,
              WS_pre1, st1, do_stats);
}

__device__ __forceinline__ void p4_item(const Params& p, char* smem, int l, int item) {
  const int mt = item & 63, nt = item >> 6;
  const int m0 = mt * 128, n0 = nt * 128;
  const int tid = ltid(), lane = tid & 63, wave = tid >> 6, wm = wave >> 1, wn = wave & 1;
  f16v acc[2][2];
  gemm_mainloop0(smem, WS_h2, 1024, WS_Wt + WT_LAYER * l + WT_UP, 1024, 1024, m0, n0, acc);
  u16* Cs = (u16*)smem;
  const int rl0 = wm * 64 + 4 * (lane >> 5), cl0 = wn * 64 + (lane & 31);
#pragma unroll
  for (int mi = 0; mi < 2; ++mi)
#pragma unroll
    for (int reg = 0; reg < 16; ++reg) {
      const int rl = rl0 + mi * 32 + (reg & 3) + 8 * (reg >> 2);
      Cs[rl * CST + cl0] = f2bf(acc[mi][0][reg]);
      Cs[rl * CST + cl0 + 32] = f2bf(acc[mi][1][reg]);
    }
  __syncthreads();
  cs_store(Cs, WS_z2 + (size_t)m0 * 5632 + n0, 5632, tid);
}

__device__ __forceinline__ void p4b_item(const Params& p, int l, int item) {
  const int tid = ltid();
  if (tid >= 176) return;
  const int rb = item >> 1, hf = item & 1;
  const int j0 = (hf * 176 + tid) * 8;
  const float* cw = p.conv_w + (size_t)l * 3 * 5632;
  const float* cb = p.conv_b + (size_t)l * 5632;
  float wa[3][8], wb[3][8], ba[8], bb[8];
#pragma unroll
  for (int t = 0; t < 3; ++t)
#pragma unroll
    for (int h = 0; h < 2; ++h) {
      const float4 x = *(const float4*)(cw + t * 5632 + j0 + 4 * h), y = *(const float4*)(cw + t * 5632 + 2816 + j0 + 4 * h);
      wa[t][4 * h] = x.x; wa[t][4 * h + 1] = x.y; wa[t][4 * h + 2] = x.z; wa[t][4 * h + 3] = x.w;
      wb[t][4 * h] = y.x; wb[t][4 * h + 1] = y.y; wb[t][4 * h + 2] = y.z; wb[t][4 * h + 3] = y.w;
    }
#pragma unroll
  for (int h = 0; h < 2; ++h) {
    const float4 x = *(const float4*)(cb + j0 + 4 * h), y = *(const float4*)(cb + 2816 + j0 + 4 * h);
    ba[4 * h] = x.x; ba[4 * h + 1] = x.y; ba[4 * h + 2] = x.z; ba[4 * h + 3] = x.w;
    bb[4 * h] = y.x; bb[4 * h + 1] = y.y; bb[4 * h + 2] = y.z; bb[4 * h + 3] = y.w;
  }
  const int row0 = rb * 32;
  int pos0, L;
  if (row0 < TCTX) { pos0 = row0 & 255; L = 256; } else { pos0 = (row0 - TCTX) & 1023; L = 1024; }
  const u16* zr = WS_z2 + (size_t)row0 * 5632 + j0;
  const u4v zero = (u4v){0u, 0u, 0u, 0u};
  u4v pa = zero, pb = zero;
  if (pos0 > 0) { pa = *(const u4v*)(zr - 5632); pb = *(const u4v*)(zr - 5632 + 2816); }
  u4v ca = *(const u4v*)(zr), cb2 = *(const u4v*)(zr + 2816);
#pragma unroll 2
  for (int r = 0; r < 32; ++r) {
    u4v na = zero, nb = zero;
    if (pos0 + r < L - 1) { na = *(const u4v*)(zr + (size_t)(r + 1) * 5632); nb = *(const u4v*)(zr + (size_t)(r + 1) * 5632 + 2816); }
    u4v ov;
#pragma unroll
    for (int w = 0; w < 4; ++w) {
      const float a0 = wa[0][2 * w] * bflo(pa[w]) + wa[1][2 * w] * bflo(ca[w]) + wa[2][2 * w] * bflo(na[w]) + ba[2 * w];
      const float a1 = wa[0][2 * w + 1] * bfhi(pa[w]) + wa[1][2 * w + 1] * bfhi(ca[w]) + wa[2][2 * w + 1] * bfhi(na[w]) + ba[2 * w + 1];
      const float b0 = wb[0][2 * w] * bflo(pb[w]) + wb[1][2 * w] * bflo(cb2[w]) + wb[2][2 * w] * bflo(nb[w]) + bb[2 * w];
      const float b1 = wb[0][2 * w + 1] * bfhi(pb[w]) + wb[1][2 * w + 1] * bfhi(cb2[w]) + wb[2][2 * w + 1] * bfhi(nb[w]) + bb[2 * w + 1];
      ov[w] = pack2(geluf_(a0) * b0, geluf_(a1) * b1);
    }
    *(u4v*)(WS_act + (size_t)(row0 + r) * 2816 + j0) = ov;
    pa = ca; pb = cb2; ca = na; cb2 = nb;
  }
}

__device__ __forceinline__ void p5_item(const Params& p, char* smem, int l, int item, bool do_stats = true) {
  const int mt = item & 63, nt = item >> 6;
  const int m0 = mt * 128, n0 = nt * 128;
  const int tid = ltid(), lane = tid & 63, wave = tid >> 6, wm = wave >> 1, wn = wave & 1;
  f16v acc[2][2];
  gemm_mainloop0(smem, WS_act, 2816, WS_Wt + WT_LAYER * l + WT_DOWN, 2816, 2816, m0, n0, acc);
  const int ci = cond_of_row(m0);
  const float* g2 = WS_mod + (l * 5 + ci) * 6144 + 5 * 1024;
  epi_resid(smem, acc, m0, n0, g2, WS_pre1, WS_pre1 + (size_t)TCTX * 1024, WS_stats + (size_t)(l * 2 + 0) * TALL * 2,
            p.ln1_g + l * 1024, p.ln1_b + l * 1024, p.out, WS_stats + (size_t)(l * 2 + 1) * TALL * 2, do_stats);
}

__device__ __forceinline__ void final_item(const Params& p, int item) {
  const float* st = WS_stats + (size_t)(1 * 2 + 1) * TALL * 2;
  const int c = ltid() * 4;
  const float4 g = *(const float4*)(p.ln2_g + 1024 + c);
  const float4 b = *(const float4*)(p.ln2_b + 1024 + c);
  for (int r = 0; r < 8; ++r) {
    const int row = item * 8 + r;
    const float s = st[row * 2], q = st[row * 2 + 1];
    const float mu = s * (1.f / 1024.f);
    const float rstd = rsqrtf(fmaxf(q * (1.f / 1024.f) - mu * mu, 0.f) + LNEPS);
    float4 v = *(float4*)(p.out + (size_t)row * 1024 + c);
    v.x = (v.x - mu) * rstd * g.x + b.x;
    v.y = (v.y - mu) * rstd * g.y + b.y;
    v.z = (v.z - mu) * rstd * g.z + b.z;
    v.w = (v.w - mu) * rstd * g.w + b.w;
    *(float4*)(p.out + (size_t)row * 1024 + c) = v;
  }
}

#define XB_TMO      128
#define XB_XCNT(j)  (256  + 64 * (j))
#define XB_XSUB(j)  (1280 + 64 * (j))
#define XB_XGEN(j)  (2304 + 64 * (j))
#define XB_TOP      3328
#define XB_TOPGEN   3392
#define XCD_BAR_WORDS 3456
#define XB_SPIN_CAP (1u << 18)
#define LAS __attribute__((address_space(3)))

__device__ __forceinline__ unsigned xb_ld(unsigned* p)              { return __hip_atomic_load(p, __ATOMIC_RELAXED, __HIP_MEMORY_SCOPE_AGENT); }
__device__ __forceinline__ unsigned xb_add(unsigned* p, unsigned v) { return __hip_atomic_fetch_add(p, v, __ATOMIC_RELAXED, __HIP_MEMORY_SCOPE_AGENT); }
__device__ __forceinline__ unsigned xb_xcc_id() { return (unsigned)__builtin_amdgcn_s_getreg((3 << 11) | 20) & 0xFu; }
#define XB_SPIN(cond, bar) do { unsigned _sp = 0; while (cond) { __builtin_amdgcn_s_sleep(1); \
    if ((++_sp & 255u) == 0u) { if (xb_ld(&(bar)[XB_TMO])) break; if (_sp > XB_SPIN_CAP) { atomicAdd(&(bar)[XB_TMO], 1u); break; } } } } while (0)

struct XcdBarrier {
    unsigned* bar; unsigned x;
    volatile LAS unsigned* st;
};

__device__ __forceinline__ XcdBarrier xcd_barrier_post(unsigned* bar, volatile LAS unsigned* st) {
    XcdBarrier b; b.bar = bar; b.x = xb_xcc_id(); b.st = st;
    if (threadIdx.x == 0) (void)xb_add(&bar[XB_XCNT(b.x)], 1u);
    return b;
}
__device__ __forceinline__ void xcd_barrier_complete(unsigned* bar, unsigned x, unsigned& nloc, unsigned& nx) {
    const unsigned G = gridDim.x * gridDim.y * gridDim.z;
    unsigned sum, cnt, mine, sp = 0u;
    for (;;) {
        sum = 0u; cnt = 0u; mine = 0u;
#pragma unroll
        for (unsigned j = 0; j < 16; ++j) { const unsigned c = xb_ld(&bar[XB_XCNT(j)]); sum += c; cnt += (c > 0u) ? 1u : 0u; mine = (j == x) ? c : mine; }
        if (sum == G) break;
        __builtin_amdgcn_s_sleep(1);
        if ((++sp & 255u) == 0u) { if (xb_ld(&bar[XB_TMO])) break; if (sp > XB_SPIN_CAP) { atomicAdd(&bar[XB_TMO], 1u); break; } }
    }
    nloc = mine > 0u ? mine : 1u; nx = cnt > 0u ? cnt : 1u;
}

__device__ __forceinline__ void xcd_barrier(const XcdBarrier& b) {
    asm volatile("s_waitcnt vmcnt(0)" ::: "memory");
    __syncthreads();
    if (threadIdx.x == 0) {
        unsigned* bar = b.bar;
        __builtin_amdgcn_s_waitcnt(0);
        unsigned nloc = b.st[0], nx = b.st[1];
        if (nloc == 0u) { xcd_barrier_complete(bar, b.x, nloc, nx); b.st[0] = nloc; b.st[1] = nx; }
        const unsigned old = xb_add(&bar[XB_XSUB(b.x)], 1u);
        const unsigned gen = old / nloc;
        if (old + 1u == (gen + 1u) * nloc) {
            __builtin_amdgcn_fence(__ATOMIC_RELEASE, "agent");
            asm volatile("s_waitcnt vmcnt(0)" ::: "memory");
            const unsigned og = xb_add(&bar[XB_TOP], 1u);
            const unsigned tg = og / nx;
            if (og + 1u == (tg + 1u) * nx) xb_add(&bar[XB_TOPGEN], 1u);
            else XB_SPIN(xb_ld(&bar[XB_TOPGEN]) == tg, bar);
            __builtin_amdgcn_fence(__ATOMIC_ACQUIRE, "agent");
            xb_add(&bar[XB_XGEN(b.x)], 1u);
            asm volatile("s_waitcnt vmcnt(0)" ::: "memory");
        } else {
            XB_SPIN(xb_ld(&bar[XB_XGEN(b.x)]) == gen, bar);
            __builtin_amdgcn_fence(__ATOMIC_ACQUIRE, "agent");
            asm volatile("s_waitcnt vmcnt(0)" ::: "memory");
        }
    }
    __syncthreads();
}


#define NPHASES 22
#ifndef REPMASK
#define REPMASK 0
#endif
#define REPS(PH) (((PH) == 0 ? (REPMASK >> 10) : (PH) == 21 ? (REPMASK >> 11) : (REPMASK >> (((PH) - 1) % 10))) & 1)
#define RUN_PHASE(PH, N, CALL)                                              \
  if (ph_lo <= (PH) && (PH) < ph_hi) {                                      \
    for (int rep_ = 0; rep_ <= REPS(PH); ++rep_)                            \
    for (int it = blockIdx.x; it < (N); it += nb) { CALL; }                 \
    if ((PH) + 1 < ph_hi) xcd_barrier(xb);                                  \
  }
#define RUN_GEMM_PHASE(PH, NT, CALL)                                                          \
  if (ph_lo <= (PH) && (PH) < ph_hi) {                                                        \
    const int xcd_ = blockIdx.x & 7, slot_ = blockIdx.x >> 3, spx_ = (int)gridDim.x >> 3;      \
    const int nsuper_ = 8 * (((NT) + 7) >> 3);                                                \
    for (int rep_ = 0; rep_ <= REPS(PH); ++rep_)                                              \
    for (int s_ = xcd_; s_ < nsuper_; s_ += 8)                                                \
      for (int j_ = slot_; j_ < 64; j_ += spx_) {                                             \
        const int mt_ = (s_ & 7) * 8 + (j_ & 7), nt_ = (s_ >> 3) * 8 + (j_ >> 3);             \
        if (nt_ < (NT)) { const int it = nt_ * 64 + mt_; CALL; }                              \
      }                                                                                       \
    if ((PH) + 1 < ph_hi) xcd_barrier(xb);                                                    \
  }
#define RUN_MIXER_PHASE(PH, L)                                                                \
  if (ph_lo <= (PH) && (PH) < ph_hi) {                                                        \
    for (int rep_ = 0; rep_ <= REPS(PH); ++rep_) {                                            \
      unsigned* ctr_ = (unsigned*)(p.ws + OFF_ctr) + 64 * (2 * (L) + rep_);                   \
      for (;;) {                                                                              \
        __syncthreads();                                                                      \
        if (threadIdx.x == 0) wq_item = (int)atomicAdd(ctr_, 1u);                             \
        __syncthreads();                                                                      \
        const int it = wq_item;                                                               \
        if (it >= MX_ITEMS) break;                                                            \
        mixer_item(p, smem, (L), it);                                                         \
      }                                                                                       \
    }                                                                                         \
    if ((PH) + 1 < ph_hi) xcd_barrier(xb);                                                    \
  }
#define RUN_LAYER(L)                                                         \
  RUN_PHASE(1 + 10 * (L) + 0, 1024, hmat_item(p, (L), 0, it))                \
  RUN_GEMM_PHASE(1 + 10 * (L) + 1, 56, p1_item(p, smem, (L), it))            \
  RUN_MIXER_PHASE(1 + 10 * (L) + 2, (L))                                     \
  RUN_GEMM_PHASE(1 + 10 * (L) + 3, 4, p3a_item(p, smem, (L), it))            \
  RUN_GEMM_PHASE(1 + 10 * (L) + 4, 8, p3b_item(p, smem, (L), it))            \
  RUN_GEMM_PHASE(1 + 10 * (L) + 5, 8, p3c_item(p, smem, (L), it, rep_ == 0)) \
  RUN_PHASE(1 + 10 * (L) + 6, 1024, hmat_item(p, (L), 1, it))                \
  RUN_GEMM_PHASE(1 + 10 * (L) + 7, 44, p4_item(p, smem, (L), it))            \
  RUN_PHASE(1 + 10 * (L) + 8, 512, p4b_item(p, (L), it))                     \
  RUN_GEMM_PHASE(1 + 10 * (L) + 9, 8, p5_item(p, smem, (L), it, rep_ == 0))

__global__ void __launch_bounds__(256, 2) mega(Params p, int ph_lo, int ph_hi) {
  extern __shared__ __attribute__((aligned(16))) char smem[];
  __shared__ uint4 xb_words;
  __shared__ int wq_item;
  const int nb = gridDim.x;
  if (threadIdx.x == 0) xb_words = make_uint4(0u, 0u, 0u, 0u);
  __syncthreads();
  XcdBarrier xb;
  xb.bar = (unsigned*)(p.ws + OFF_bar); xb.x = 0; xb.st = (volatile LAS unsigned*)&xb_words;
  if (ph_hi - ph_lo > 1) xb = xcd_barrier_post((unsigned*)(p.ws + OFF_bar), (volatile LAS unsigned*)&xb_words);
  if (ph_hi > 1000) cg::this_grid().sync();
  RUN_PHASE(0, P0_ITEMS, phase0_item(p, smem, it))
  RUN_LAYER(0)
  RUN_LAYER(1)
  RUN_PHASE(21, 1024, final_item(p, it))
}

extern "C" void kernel_launch(void* const* d_in, const int* in_sizes, int n_in, void* d_out, int out_size, void* d_ws,
                              size_t ws_size, hipStream_t stream) {
  Params p{};
  const float** ins = (const float**)&p;
  for (int i = 0; i < 32; ++i) ins[i] = (const float*)d_in[i];
  p.out = (float*)d_out;
  char* ws = (char*)d_ws;
  p.ws = ws;
  if (WS_TOTAL > ws_size) {
    fprintf(stderr, "kernel_launch: workspace too small (%zu needed, %zu given)\n", (size_t)WS_TOTAL, ws_size);
    return;
  }
  (void)hipMemsetAsync(ws, 0, ZERO_BYTES, stream);
#if SINGLE_LAUNCH
  static int grid_blocks = 0;
  if (!grid_blocks) {
    int dev = 0, cus = 0, per_cu = 0;
    (void)hipGetDevice(&dev);
    (void)hipDeviceGetAttribute(&cus, hipDeviceAttributeMultiprocessorCount, dev);
    (void)hipFuncSetAttribute((const void*)mega, hipFuncAttributeMaxDynamicSharedMemorySize, LDS_BYTES);
    (void)hipOccupancyMaxActiveBlocksPerMultiprocessor(&per_cu, mega, 256, LDS_BYTES);
    if (per_cu > 2) per_cu = 2;
    if (per_cu < 1) per_cu = 1;
    grid_blocks = (cus * per_cu) & ~7;
  }
  int lo = 0, hi = NPHASES;
  void* args[] = {&p, &lo, &hi};
  hipError_t e = hipLaunchCooperativeKernel((void*)mega, dim3(grid_blocks), dim3(256), args, LDS_BYTES, stream);
  if (e != hipSuccess) fprintf(stderr, "cooperative launch failed: %s (grid %d)\n", hipGetErrorString(e), grid_blocks);
#else
  for (int ph = 0; ph < NPHASES; ++ph) {
    hipLaunchKernelGGL(mega, dim3(512), dim3(256), LDS_BYTES, stream, p, ph, ph + 1);
  }
#endif
}
```

```cpp
#include <hip/hip_runtime.h>
#include <hip/hip_cooperative_groups.h>
#include <cstdio>
namespace cg = cooperative_groups;

#ifndef SINGLE_LAUNCH
#define SINGLE_LAUNCH 1
#endif

typedef __attribute__((ext_vector_type(8))) short s8v;
typedef __attribute__((ext_vector_type(4))) float f4v;
typedef __attribute__((ext_vector_type(16))) float f16v;
typedef unsigned short u16;
typedef __attribute__((ext_vector_type(4))) unsigned u4v;
__device__ __forceinline__ s8v bc8(u4v x) { return __builtin_bit_cast(s8v, x); }


#define TALL 8192
#define TCTX 4096
#define ALPHA 1.41421356237309515f
#define LNEPS 1e-5f
#define VTR_LAT 2097152
#define NVT_LAT 2097152
#define OUT_SRET 8388608
#define OUT_SSSM 12582912
#define OUT_CK 12845056
#define OUT_CV 17039360
#define WT_IN 0
#define WT_GLU (WT_IN + 7168 * 1024)
#define WT_BR (WT_GLU + 512 * 512)
#define WT_O (WT_BR + 3 * 1024 * 512)
#define WT_UP (WT_O + 1024 * 1024)
#define WT_DOWN (WT_UP + 5632 * 1024)
#define WT_LAYER ((size_t)(WT_DOWN + 1024 * 2816))

struct Params {
  const float *x_prompt, *x_sample, *state_ret, *state_ssm, *cache_k, *cache_v, *c, *c_ctx;
  const float *w_ada, *b_ada, *w_in, *ret_decay, *a_re, *a_im, *log_dt, *b_re, *b_im, *c_re, *c_im;
  const float *ssm_d, *w_glu, *rpb, *w_branch, *w_o, *ln1_g, *ln1_b, *w_up, *conv_w, *conv_b, *w_down, *ln2_g, *ln2_b;
  float* out;
  char* ws;
};

typedef __bf16 bf2v __attribute__((ext_vector_type(2)));
typedef float fl2v __attribute__((ext_vector_type(2)));
__device__ __forceinline__ unsigned pack2(float a, float b) {
  fl2v f = {a, b};
  bf2v h = __builtin_convertvector(f, bf2v);
  return __builtin_bit_cast(unsigned, h);
}
__device__ __forceinline__ u16 f2bf(float f) { return (u16)(pack2(f, 0.f) & 0xffffu); }

constexpr size_t al256(size_t x) { return (x + 255) & ~(size_t)255; }
constexpr size_t EB = (size_t)TALL * 512 * 2;
constexpr size_t OFF_mod = 0;
constexpr size_t OFF_stats = OFF_mod + al256(2 * 5 * 6144 * 4);
constexpr size_t OFF_bar = OFF_stats + al256(2 * 2 * TALL * 2 * 4);
constexpr size_t OFF_ctr = OFF_bar + al256(3456 * 4);
constexpr size_t ZERO_BYTES = OFF_ctr + al256(8 * 256);
constexpr size_t OFF_ropetab = ZERO_BYTES;
constexpr size_t OFF_abar = OFF_ropetab + al256(64 * 32 * 2 * 4);
constexpr size_t OFF_bbarT = OFF_abar + al256(2 * 2 * 32 * 64 * 2 * 4);
constexpr size_t OFF_cmT = OFF_bbarT + al256(2 * 2 * 32 * 128 * 16 * 2);
constexpr size_t OFF_CK = OFF_cmT + al256(2 * 2 * 32 * 16 * 128 * 2);
constexpr size_t OFF_CVt = OFF_CK + al256((size_t)2 * 4 * 512 * 512 * 2);
constexpr size_t OFF_S0t = OFF_CVt + al256((size_t)2 * 4 * 512 * 512 * 2);
constexpr size_t OFF_Wt = OFF_S0t + al256((size_t)2 * 4 * 2 * 4 * 128 * 128 * 2);
constexpr size_t OFF_REGION = OFF_Wt + al256(2 * WT_LAYER * 2);
constexpr size_t OFF_z2 = OFF_REGION;
constexpr size_t OFF_act = OFF_z2 + (size_t)TALL * 5632 * 2;
constexpr size_t OFF_pre1 = OFF_act + (size_t)TALL * 2816 * 2;
constexpr size_t WS_TOTAL = OFF_pre1 + (size_t)TALL * 1024 * 4;
constexpr size_t OFF_K = OFF_pre1;
constexpr size_t OFF_VtR = OFF_K + EB;
constexpr size_t OFF_NQ = OFF_VtR + EB;
constexpr size_t OFF_NK = OFF_NQ + EB;
constexpr size_t OFF_GT = OFF_REGION;
constexpr size_t OFF_rout = OFF_GT + (size_t)TALL * 3072 * 2;
constexpr size_t OFF_nout = OFF_rout + EB;
constexpr size_t OFF_YD = OFF_nout + EB;
constexpr size_t OFF_merged = OFF_YD;
constexpr size_t OFF_Q = OFF_YD + 2 * EB;
constexpr size_t OFF_sout = OFF_Q;
constexpr size_t OFF_KtR = OFF_Q + EB;
constexpr size_t OFF_G = OFF_KtR + EB / 2;
constexpr size_t OFF_SU = OFF_G + EB;
constexpr size_t OFF_NVt = OFF_SU + EB;
constexpr size_t OFF_h1 = OFF_NVt + EB;
constexpr size_t OFF_h2 = OFF_act;
static_assert(OFF_h1 + 2 * EB <= OFF_pre1, "mixer buffers overflow the z2+act area");
#define WS_h1 ((u16*)(p.ws + OFF_h1))
#define WS_h2 ((u16*)(p.ws + OFF_h2))
#define WS_mod ((float*)(p.ws + OFF_mod))
#define WS_stats ((float*)(p.ws + OFF_stats))
#define WS_ropetab ((float*)(p.ws + OFF_ropetab))
#define WS_abar ((float*)(p.ws + OFF_abar))
#define WS_pre1 ((float*)(p.ws + OFF_pre1))
#define WS_bbarT ((u16*)(p.ws + OFF_bbarT))
#define WS_cmT ((u16*)(p.ws + OFF_cmT))
#define WS_CK ((u16*)(p.ws + OFF_CK))
#define WS_CVt ((u16*)(p.ws + OFF_CVt))
#define WS_S0t ((u16*)(p.ws + OFF_S0t))
#define WS_Wt ((u16*)(p.ws + OFF_Wt))
#define WS_Q ((u16*)(p.ws + OFF_Q))
#define WS_K ((u16*)(p.ws + OFF_K))
#define WS_VtR ((u16*)(p.ws + OFF_VtR))
#define WS_KtR ((u16*)(p.ws + OFF_KtR))
#define WS_G ((u16*)(p.ws + OFF_G))
#define WS_SU ((u16*)(p.ws + OFF_SU))
#define WS_NQ ((u16*)(p.ws + OFF_NQ))
#define WS_NK ((u16*)(p.ws + OFF_NK))
#define WS_NVt ((u16*)(p.ws + OFF_NVt))
#define WS_GT ((u16*)(p.ws + OFF_GT))
#define WS_rout ((u16*)(p.ws + OFF_rout))
#define WS_sout ((u16*)(p.ws + OFF_sout))
#define WS_nout ((u16*)(p.ws + OFF_nout))
#define WS_YD ((u16*)(p.ws + OFF_YD))
#define WS_merged ((u16*)(p.ws + OFF_merged))
#define WS_z2 ((u16*)(p.ws + OFF_z2))
#define WS_act ((u16*)(p.ws + OFF_act))

__device__ __forceinline__ float bf2f(unsigned h) { return __uint_as_float((h & 0xffffu) << 16); }
__device__ __forceinline__ float bflo(unsigned w) { return __uint_as_float(w << 16); }
__device__ __forceinline__ float bfhi(unsigned w) { return __uint_as_float(w & 0xffff0000u); }
__device__ __forceinline__ float fexp_(float x) { return __builtin_amdgcn_exp2f(x * 1.4426950408889634f); }
__device__ __forceinline__ float sigmoidf_(float x) { return __builtin_amdgcn_rcpf(1.f + fexp_(-x)); }
__device__ __forceinline__ float siluf_(float x) { return x * __builtin_amdgcn_rcpf(1.f + fexp_(-x)); }
__device__ __forceinline__ float geluf_(float x) {
  const float u2 = 1.5957691216057308f * (x + 0.044715f * x * x * x);
  return x * __builtin_amdgcn_rcpf(1.f + fexp_(-u2));
}
__device__ __forceinline__ f16v zero16() {
  return (f16v){0.f, 0.f, 0.f, 0.f, 0.f, 0.f, 0.f, 0.f, 0.f, 0.f, 0.f, 0.f, 0.f, 0.f, 0.f, 0.f};
}
__device__ __forceinline__ int ltid() { int t = threadIdx.x; asm volatile("" : "+v"(t)); return t; }
__device__ __forceinline__ int cond_of_row(int row) { return row < TCTX ? 0 : 1 + ((row - TCTX) >> 10); }

struct AArgs {
  const u16* A16; int lda;
  const float* A32lo; const float* A32hi;
  const float* stats;
  const float* lng; const float* lnb;
  const float* sc; const float* sh;
  const u16* SU; const u16* YD0; const u16* YD1; const float* dsk;
};

#define GST 72
#define LDS_GEMM (2 * 2 * 128 * GST * 2)
#define LDS_BYTES LDS_GEMM

template <int AMODE>
__device__ __forceinline__ void gemm_mainloop(char* smem, const AArgs& a, const u16* __restrict__ Bt, int ldb, int K,
                                              int m0, int n0, f16v (&acc)[2][2]) {
  u16* As = (u16*)smem;
  u16* Bs = As + 2 * 128 * GST;
  const int tid = ltid(), lane = tid & 63, wave = tid >> 6;
  const int wm = wave >> 1, wn = wave & 1;
  const int crow = tid >> 3, cch = tid & 7;
  const int frow = tid >> 4, fch = tid & 15;
  float rs[8], nm[8];
  const float* srow0 = nullptr;
  const float *gsc = nullptr, *gsh = nullptr;
  __syncthreads();
  if constexpr (AMODE == 1) {
    const int ci = cond_of_row(m0);
    gsc = a.sc + ci * 6144; gsh = a.sh + ci * 6144;
#pragma unroll
    for (int i = 0; i < 8; ++i) {
      rs[i] = 1.f; nm[i] = 0.f;
      if (a.stats) {
        const int row = m0 + frow + 16 * i;
        const float s = a.stats[row * 2], q = a.stats[row * 2 + 1];
        const float mu = s * (1.f / 1024.f);
        const float var = q * (1.f / 1024.f) - mu * mu;
        rs[i] = rsqrtf(fmaxf(var, 0.f) + LNEPS);
        nm[i] = -mu * rs[i];
      }
    }
    const int row0 = m0 + frow;
    srow0 = (row0 < TCTX ? a.A32lo + (size_t)row0 * 1024 : a.A32hi + (size_t)(row0 - TCTX) * 1024) + fch * 4;
  }
  acc[0][0] = zero16(); acc[0][1] = zero16(); acc[1][0] = zero16(); acc[1][1] = zero16();

  u4v ra[12], rb[4];
  float4 q0, q1, q2, q3;
  q0 = q1 = q3 = make_float4(0.f, 0.f, 0.f, 0.f); q2 = make_float4(1.f, 1.f, 1.f, 1.f);
  const u16* brow = Bt + (size_t)(n0 + crow) * ldb + cch * 8;
  auto issue = [&](int kt) {
    if constexpr (AMODE == 1) {
      const int k = kt * 64 + fch * 4;
      q0 = *(const float4*)(gsc + k); q1 = *(const float4*)(gsh + k);
      if (a.lng) { q2 = *(const float4*)(a.lng + k); q3 = *(const float4*)(a.lnb + k); }
    } else if constexpr (AMODE == 2) {
      const int k0 = kt * 64 + cch * 8;
      q0 = *(const float4*)(a.dsk + k0); q1 = *(const float4*)(a.dsk + k0 + 4);
    }
    if constexpr (AMODE == 0) {
      const u16* ap = a.A16 + (size_t)(m0 + crow) * a.lda + kt * 64 + cch * 8;
#pragma unroll
      for (int i = 0; i < 4; ++i) ra[i] = *(const u4v*)(ap + (size_t)(32 * i) * a.lda);
    } else if constexpr (AMODE == 1) {
#pragma unroll
      for (int i = 0; i < 8; ++i) ra[i] = *(const u4v*)(srow0 + (size_t)(16 * i) * 1024 + kt * 64);
    } else {
      const size_t o = (size_t)(m0 + crow) * 512 + kt * 64 + cch * 8;
#pragma unroll
      for (int i = 0; i < 4; ++i) {
        ra[i] = *(const u4v*)(a.SU + o + (size_t)(32 * i) * 512);
        ra[4 + i] = *(const u4v*)(a.YD0 + o + (size_t)(32 * i) * 512);
        ra[8 + i] = *(const u4v*)(a.YD1 + o + (size_t)(32 * i) * 512);
      }
    }
#pragma unroll
    for (int i = 0; i < 4; ++i) rb[i] = *(const u4v*)(brow + (size_t)(32 * i) * ldb + kt * 64);
  };
  auto stage = [&](int buf, int kt) {
    u16* Ad = As + buf * (128 * GST);
    if constexpr (AMODE == 0) {
#pragma unroll
      for (int i = 0; i < 4; ++i) *(u4v*)(Ad + (crow + 32 * i) * GST + cch * 8) = ra[i];
    } else if constexpr (AMODE == 1) {
      const float4 sc = q0, sh = q1, g = q2, b = q3;
      const float G0 = g.x * (1.f + sc.x), G1 = g.y * (1.f + sc.y), G2 = g.z * (1.f + sc.z), G3 = g.w * (1.f + sc.w);
      const float B0 = fmaf(b.x, 1.f + sc.x, sh.x), B1 = fmaf(b.y, 1.f + sc.y, sh.y), B2 = fmaf(b.z, 1.f + sc.z, sh.z), B3 = fmaf(b.w, 1.f + sc.w, sh.w);
#pragma unroll
      for (int i = 0; i < 8; ++i) {
        const float h0 = fmaf(fmaf(__uint_as_float(ra[i][0]), rs[i], nm[i]), G0, B0);
        const float h1 = fmaf(fmaf(__uint_as_float(ra[i][1]), rs[i], nm[i]), G1, B1);
        const float h2 = fmaf(fmaf(__uint_as_float(ra[i][2]), rs[i], nm[i]), G2, B2);
        const float h3 = fmaf(fmaf(__uint_as_float(ra[i][3]), rs[i], nm[i]), G3, B3);
        *(uint2*)(Ad + (frow + 16 * i) * GST + fch * 4) = make_uint2(pack2(h0, h1), pack2(h2, h3));
      }
    } else {
      const float4 da = q0, db = q1;
      const float dd[8] = {da.x, da.y, da.z, da.w, db.x, db.y, db.z, db.w};
#pragma unroll
      for (int i = 0; i < 4; ++i) {
        u4v o;
#pragma unroll
        for (int j = 0; j < 4; ++j) {
          const float v0 = geluf_(dd[2 * j] * bflo(ra[i][j]) + bflo(ra[4 + i][j]) + bflo(ra[8 + i][j]));
          const float v1 = geluf_(dd[2 * j + 1] * bfhi(ra[i][j]) + bfhi(ra[4 + i][j]) + bfhi(ra[8 + i][j]));
          o[j] = pack2(v0, v1);
        }
        *(u4v*)(Ad + (crow + 32 * i) * GST + cch * 8) = o;
      }
    }
    u16* Bd = Bs + buf * (128 * GST);
#pragma unroll
    for (int i = 0; i < 4; ++i) *(u4v*)(Bd + (crow + 32 * i) * GST + cch * 8) = rb[i];
  };
  auto compute = [&](int buf) {
    const u16* Ab = As + buf * (128 * GST) + (wm * 64 + (lane & 31)) * GST + (lane >> 5) * 8;
    const u16* Bb = Bs + buf * (128 * GST) + (wn * 64 + (lane & 31)) * GST + (lane >> 5) * 8;
#pragma unroll
    for (int ks = 0; ks < 4; ++ks) {
      s8v af0 = *(const s8v*)(Ab + ks * 16);
      s8v af1 = *(const s8v*)(Ab + 32 * GST + ks * 16);
      s8v bf0 = *(const s8v*)(Bb + ks * 16);
      s8v bf1 = *(const s8v*)(Bb + 32 * GST + ks * 16);
      acc[0][0] = __builtin_amdgcn_mfma_f32_32x32x16_bf16(af0, bf0, acc[0][0], 0, 0, 0);
      acc[0][1] = __builtin_amdgcn_mfma_f32_32x32x16_bf16(af0, bf1, acc[0][1], 0, 0, 0);
      acc[1][0] = __builtin_amdgcn_mfma_f32_32x32x16_bf16(af1, bf0, acc[1][0], 0, 0, 0);
      acc[1][1] = __builtin_amdgcn_mfma_f32_32x32x16_bf16(af1, bf1, acc[1][1], 0, 0, 0);
    }
  };

  const int nk = K >> 6;
  issue(0);
  stage(0, 0);
  __syncthreads();
#pragma unroll 1
  for (int kt = 0; kt < nk; ++kt) {
    const int buf = kt & 1;
    if (kt + 1 < nk) issue(kt + 1);
    compute(buf);
    if (kt + 1 < nk) stage(buf ^ 1, kt + 1);
    __syncthreads();
  }
}

__device__ __forceinline__ void gemm_mainloop0(char* smem, const u16* __restrict__ A, int lda, const u16* __restrict__ Bt, int ldb,
                                               int K, int m0, int n0, f16v (&acc)[2][2]) {
  u16* As = (u16*)smem;
  u16* Bs = As + 2 * 128 * GST;
  const int tid = ltid(), lane = tid & 63, wave = tid >> 6;
  const int wm = wave >> 1, wn = wave & 1;
  const int crow = tid >> 3, cch = tid & 7;
  __syncthreads();
  acc[0][0] = zero16(); acc[0][1] = zero16(); acc[1][0] = zero16(); acc[1][1] = zero16();
  const u16* arow = A + (size_t)(m0 + crow) * lda + cch * 8;
  const u16* brow = Bt + (size_t)(n0 + crow) * ldb + cch * 8;
  const size_t a32 = (size_t)32 * lda, b32 = (size_t)32 * ldb;
  u4v eA0, eA1, eA2, eA3, eB0, eB1, eB2, eB3, oA0, oA1, oA2, oA3, oB0, oB1, oB2, oB3;
#define G0_ISSUE(P, kt)                                                                                   \
  { const u16* ap_ = arow + (kt) * 64; const u16* bp_ = brow + (kt) * 64;                                 \
    P##A0 = *(const u4v*)(ap_); P##A1 = *(const u4v*)(ap_ + a32); P##A2 = *(const u4v*)(ap_ + 2 * a32);   \
    P##A3 = *(const u4v*)(ap_ + 3 * a32);                                                                 \
    P##B0 = *(const u4v*)(bp_); P##B1 = *(const u4v*)(bp_ + b32); P##B2 = *(const u4v*)(bp_ + 2 * b32);   \
    P##B3 = *(const u4v*)(bp_ + 3 * b32); }
#define G0_STAGE(P, buf)                                                                                  \
  { u16* Ad_ = As + (buf) * (128 * GST) + crow * GST + cch * 8; u16* Bd_ = Bs + (buf) * (128 * GST) + crow * GST + cch * 8; \
    *(u4v*)(Ad_) = P##A0; *(u4v*)(Ad_ + 32 * GST) = P##A1; *(u4v*)(Ad_ + 64 * GST) = P##A2; *(u4v*)(Ad_ + 96 * GST) = P##A3; \
    *(u4v*)(Bd_) = P##B0; *(u4v*)(Bd_ + 32 * GST) = P##B1; *(u4v*)(Bd_ + 64 * GST) = P##B2; *(u4v*)(Bd_ + 96 * GST) = P##B3; }
#define G0_COMPUTE(buf)                                                                                   \
  { const u16* Ab = As + (buf) * (128 * GST) + (wm * 64 + (lane & 31)) * GST + (lane >> 5) * 8;           \
    const u16* Bb = Bs + (buf) * (128 * GST) + (wn * 64 + (lane & 31)) * GST + (lane >> 5) * 8;           \
    __builtin_amdgcn_s_setprio(1);                                                                        \
    _Pragma("unroll") for (int ks = 0; ks < 4; ++ks) {                                                    \
      s8v af0 = *(const s8v*)(Ab + ks * 16);                                                              \
      s8v af1 = *(const s8v*)(Ab + 32 * GST + ks * 16);                                                   \
      s8v bf0 = *(const s8v*)(Bb + ks * 16);                                                              \
      s8v bf1 = *(const s8v*)(Bb + 32 * GST + ks * 16);                                                   \
      acc[0][0] = __builtin_amdgcn_mfma_f32_32x32x16_bf16(af0, bf0, acc[0][0], 0, 0, 0);                  \
      acc[0][1] = __builtin_amdgcn_mfma_f32_32x32x16_bf16(af0, bf1, acc[0][1], 0, 0, 0);                  \
      acc[1][0] = __builtin_amdgcn_mfma_f32_32x32x16_bf16(af1, bf0, acc[1][0], 0, 0, 0);                  \
      acc[1][1] = __builtin_amdgcn_mfma_f32_32x32x16_bf16(af1, bf1, acc[1][1], 0, 0, 0);                  \
    }                                                                                                     \
    __builtin_amdgcn_s_setprio(0); }
  const int nk = K >> 6;
  G0_ISSUE(e, 0)
  G0_ISSUE(o, 1)
  G0_STAGE(e, 0)
  __syncthreads();
  int kt = 0;
#pragma unroll 1
  for (; kt + 3 < nk; kt += 2) {
    G0_ISSUE(e, kt + 2)
    __builtin_amdgcn_sched_barrier(0);
    G0_COMPUTE(0)
    G0_STAGE(o, 1)
    __syncthreads();
    G0_ISSUE(o, kt + 3)
    __builtin_amdgcn_sched_barrier(0);
    G0_COMPUTE(1)
    G0_STAGE(e, 0)
    __syncthreads();
  }
  G0_COMPUTE(0)
  G0_STAGE(o, 1)
  __syncthreads();
  G0_COMPUTE(1)
  __syncthreads();
#undef G0_ISSUE
#undef G0_STAGE
#undef G0_COMPUTE
}

#define EPI_ROW(mi, reg) (m0 + wm * 64 + (mi) * 32 + ((reg) & 3) + 8 * ((reg) >> 2) + 4 * (lane >> 5))
#define EPI_COL(ni) (n0 + wn * 64 + (ni) * 32 + (lane & 31))


#define CST 136
__device__ __forceinline__ void cs_store(const u16* Cs, u16* __restrict__ dst, size_t ld, int tid) {
#pragma unroll
  for (int i = 0; i < 8; ++i) {
    const int c = tid + 256 * i, r = c >> 4, ch = c & 15;
    *(u4v*)(dst + (size_t)r * ld + ch * 8) = *(const u4v*)(Cs + r * CST + ch * 8);
  }
}

__device__ __forceinline__ void stats_accum(float* stats, int row, float v0, float v1, int lane) {
  float s = v0 + v1, q = v0 * v0 + v1 * v1;
#pragma unroll
  for (int o = 1; o < 32; o <<= 1) {
    s += __shfl_xor(s, o);
    q += __shfl_xor(q, o);
  }
  if ((lane & 31) == 0) {
    atomicAdd(stats + row * 2, s);
    atomicAdd(stats + row * 2 + 1, q);
  }
}

#define P0_ADA 768
#define P0_ROPE 1
#define P0_CACHE 64
#define P0_S0 64
#define P0_S5 128
#define P0_WT_PER_LAYER (16 * 112 + 8 * 8 + 3 * 8 * 16 + 16 * 16 + 16 * 88 + 44 * 16)
#define P0_WT (P0_WT_PER_LAYER)
#define P0_ITEMS (P0_ADA + P0_ROPE + P0_CACHE + P0_S0 + P0_S5 + P0_WT)

__device__ __forceinline__ void wt_tile(const float* __restrict__ src, int N, u16* __restrict__ dst, int ldd, int kt, int nt, char* smem) {
  float* tile = (float*)smem;
  const int tid = ltid();
  __syncthreads();
  {
    const int c4 = (tid & 15) * 4, r0 = tid >> 4;
#pragma unroll
    for (int i = 0; i < 4; ++i) {
      const int k = r0 + 16 * i;
      const float4 v = *(const float4*)(src + (size_t)(kt * 64 + k) * N + nt * 64 + c4);
      tile[k * 65 + c4] = v.x; tile[k * 65 + c4 + 1] = v.y; tile[k * 65 + c4 + 2] = v.z; tile[k * 65 + c4 + 3] = v.w;
    }
  }
  __syncthreads();
  {
    const int n = tid >> 2, k0 = (tid & 3) * 16;
#define WTP(j) pack2(tile[(k0 + 2 * (j)) * 65 + n], tile[(k0 + 2 * (j) + 1) * 65 + n])
    u4v* d = (u4v*)(dst + (size_t)(nt * 64 + n) * ldd + kt * 64 + k0);
    d[0] = (u4v){WTP(0), WTP(1), WTP(2), WTP(3)};
    d[1] = (u4v){WTP(4), WTP(5), WTP(6), WTP(7)};
#undef WTP
  }
}
__device__ __forceinline__ void wt_item(const Params& p, char* smem, int item) {
  const int l = item / P0_WT_PER_LAYER;
  int it = item % P0_WT_PER_LAYER;
  u16* base = WS_Wt + WT_LAYER * l;
  if (it < 16 * 112) { wt_tile(p.w_in + (size_t)l * 1024 * 7168, 7168, base + WT_IN, 1024, it / 112, it % 112, smem); return; }
  it -= 16 * 112;
  if (it < 64) { wt_tile(p.w_glu + (size_t)l * 512 * 512, 512, base + WT_GLU, 512, it / 8, it % 8, smem); return; }
  it -= 64;
  if (it < 384) { const int br = it / 128; it %= 128;
    wt_tile(p.w_branch + ((size_t)l * 3 + br) * 512 * 1024, 1024, base + WT_BR + (size_t)br * 512 * 1024, 512, it / 16, it % 16, smem); return; }
  it -= 384;
  if (it < 256) { wt_tile(p.w_o + (size_t)l * 1024 * 1024, 1024, base + WT_O, 1024, it / 16, it % 16, smem); return; }
  it -= 256;
  if (it < 16 * 88) { wt_tile(p.w_up + (size_t)l * 1024 * 5632, 5632, base + WT_UP, 1024, it / 88, it % 88, smem); return; }
  it -= 16 * 88;
  wt_tile(p.w_down + (size_t)l * 2816 * 1024, 1024, base + WT_DOWN, 2816, it / 16, it % 16, smem);
}

__device__ __forceinline__ void phase0_item(const Params& p, char* smem, int item) {
  const int tid = ltid();
  if (item < P0_ADA) {
    const int ks = item & 3, cg = (item >> 2) % 96, l = item / 384;
    float* scs = (float*)smem;
    float* red = scs + 5 * 256;
    __syncthreads();
    for (int i = tid; i < 5 * 256; i += 256) {
      int ci = i >> 8, k = ks * 256 + (i & 255);
      float v = ci == 0 ? p.c_ctx[k] : p.c[(ci - 1) * 1024 + k];
      scs[i] = siluf_(v);
    }
    __syncthreads();
    const int ct = tid & 15, kg = tid >> 4;
    const float* wp = p.w_ada + (size_t)l * 1024 * 6144 + (size_t)(ks * 256 + kg * 16) * 6144 + cg * 64 + ct * 4;
    float acc[5][4];
#pragma unroll
    for (int i = 0; i < 5; ++i)
#pragma unroll
      for (int j = 0; j < 4; ++j) acc[i][j] = 0.f;
#pragma unroll 4
    for (int k = 0; k < 16; ++k) {
      float4 w = *(const float4*)(wp + (size_t)k * 6144);
#pragma unroll
      for (int ci = 0; ci < 5; ++ci) {
        float s = scs[ci * 256 + kg * 16 + k];
        acc[ci][0] += s * w.x; acc[ci][1] += s * w.y; acc[ci][2] += s * w.z; acc[ci][3] += s * w.w;
      }
    }
#pragma unroll
    for (int ci = 0; ci < 5; ++ci)
#pragma unroll
      for (int j = 0; j < 4; ++j) red[(kg * 5 + ci) * 64 + ct * 4 + j] = acc[ci][j];
    __syncthreads();
    for (int i = tid; i < 320; i += 256) {
      int ci = i >> 6, col = i & 63;
      float s = 0.f;
#pragma unroll
      for (int g = 0; g < 16; ++g) s += red[(g * 5 + ci) * 64 + col];
      if (ks == 0) s += p.b_ada[l * 6144 + cg * 64 + col];
      atomicAdd(WS_mod + (l * 5 + ci) * 6144 + cg * 64 + col, s);
    }
    return;
  }
  item -= P0_ADA;
  if (item < P0_ROPE) {
    for (int i = tid; i < 64 * 32; i += 256) {
      int pos = i >> 5, fi = i & 31;
      float inv = (float)pow(10000.0, -(double)fi / 32.0);
      float ang = (float)pos * inv;
      WS_ropetab[i * 2] = (float)cos((double)ang);
      WS_ropetab[i * 2 + 1] = (float)sin((double)ang);
    }
    return;
  }
  item -= P0_ROPE;
  if (item < P0_CACHE) {
    const int pc = item & 7, b = (item >> 3) & 3, l = item >> 5;
    const float* ksrc = p.cache_k + ((size_t)(b * 2 + l) * 512 + pc * 64) * 512;
    const float* vsrc = p.cache_v + ((size_t)(b * 2 + l) * 512 + pc * 64) * 512;
    u16* kdst = WS_CK + ((size_t)(l * 4 + b) * 512 + pc * 64) * 512;
    for (int i = tid; i < 64 * 512 / 4; i += 256) {
      float4 v = *(const float4*)(ksrc + (size_t)i * 4);
      *(uint2*)(kdst + (size_t)i * 4) = make_uint2(pack2(v.x, v.y), pack2(v.z, v.w));
    }
    for (int cc = 0; cc < 2; ++cc) {
      const int col = tid + cc * 256;
      u16* vdst = WS_CVt + ((size_t)(l * 4 + b) * 512 + col) * 512 + pc * 64;
      for (int j = 0; j < 8; ++j) {
        float v[8];
#pragma unroll
        for (int e = 0; e < 8; ++e) v[e] = vsrc[(size_t)(j * 8 + e) * 512 + col];
        *(uint4*)(vdst + j * 8) = make_uint4(pack2(v[0], v[1]), pack2(v[2], v[3]), pack2(v[4], v[5]), pack2(v[6], v[7]));
      }
    }
    return;
  }
  item -= P0_CACHE;
  if (item < P0_S0) {
    const int hh = item & 3, dir = (item >> 2) & 1, b = (item >> 3) & 3, l = item >> 5;
    const float* src = p.state_ret + ((size_t)(((b * 2 + l) * 2 + dir) * 4 + hh)) * 16384;
    u16* dst = WS_S0t + ((size_t)(((l * 4 + b) * 2 + dir) * 4 + hh)) * 16384;
    const int dv = tid & 127, kh = tid >> 7;
    for (int j = 0; j < 8; ++j) {
      const int dk0 = kh * 64 + j * 8;
      float v[8];
#pragma unroll
      for (int e = 0; e < 8; ++e) v[e] = src[(size_t)(dk0 + e) * 128 + dv];
      *(uint4*)(dst + (size_t)dv * 128 + dk0) = make_uint4(pack2(v[0], v[1]), pack2(v[2], v[3]), pack2(v[4], v[5]), pack2(v[6], v[7]));
    }
    return;
  }
  item -= P0_S0;
  if (item >= P0_S5) { wt_item(p, smem, item - P0_S5); return; }
  {
    const int g = item & 31, dir = (item >> 5) & 1, l = item >> 6;
    if (tid < 64) {
      const int pp = tid;
      const int ai = ((l * 2 + dir) * 32 + g) * 64 + pp;
      double lre = fmin((double)p.a_re[ai], -1e-4), lim = (double)p.a_im[ai];
      double dt = exp((double)p.log_dt[(l * 2 + dir) * 32 + g]);
      double er = exp(lre * dt);
      double abr = er * cos(lim * dt), abi = er * sin(lim * dt);
      WS_abar[ai * 2] = (float)abr;
      WS_abar[ai * 2 + 1] = (float)abi;
      double nr = abr - 1.0, ni = abi;
      double den = lre * lre + lim * lim;
      double cr = (nr * lre + ni * lim) / den, cim = (ni * lre - nr * lim) / den;
      u16* bt = WS_bbarT + (size_t)((l * 2 + dir) * 32 + g) * 128 * 16;
      const float* br = p.b_re + ((size_t)(l * 32 + g) * 64 + pp) * 16;
      const float* bi = p.b_im + ((size_t)(l * 32 + g) * 64 + pp) * 16;
      for (int c = 0; c < 16; ++c) {
        double xr = br[c], xi = bi[c];
        bt[pp * 16 + c] = f2bf((float)(cr * xr - cim * xi));
        bt[(64 + pp) * 16 + c] = f2bf((float)(cr * xi + cim * xr));
      }
      u16* ct = WS_cmT + (size_t)((l * 2 + dir) * 32 + g) * 16 * 128;
      const float* cre = p.c_re + ((size_t)((l * 2 + dir) * 32 + g) * 16) * 64;
      const float* cie = p.c_im + ((size_t)((l * 2 + dir) * 32 + g) * 16) * 64;
      for (int c = 0; c < 16; ++c) {
        ct[c * 128 + pp] = f2bf(cre[c * 64 + pp]);
        ct[c * 128 + 64 + pp] = f2bf(-cie[c * 64 + pp]);
      }
    }
  }
}


__device__ __forceinline__ void hmat_item(const Params& p, int l, int which, int item) {
  const int c = ltid() * 4;
  const int row0 = item * 8;
  const int ci = cond_of_row(row0);
  const float* mod = WS_mod + (l * 5 + ci) * 6144;
  const float4 sc = *(const float4*)(mod + (which ? 4 : 1) * 1024 + c);
  const float4 sh = *(const float4*)(mod + (which ? 3 : 0) * 1024 + c);
  float4 g = make_float4(1.f, 1.f, 1.f, 1.f), b = make_float4(0.f, 0.f, 0.f, 0.f);
  const float* st = nullptr;
  if (which == 1) { g = *(const float4*)(p.ln1_g + l * 1024 + c); b = *(const float4*)(p.ln1_b + l * 1024 + c); st = WS_stats + (size_t)(l * 2 + 0) * TALL * 2; }
  else if (l == 1) { g = *(const float4*)(p.ln2_g + c); b = *(const float4*)(p.ln2_b + c); st = WS_stats + (size_t)(0 * 2 + 1) * TALL * 2; }
  const float G0 = g.x * (1.f + sc.x), G1 = g.y * (1.f + sc.y), G2 = g.z * (1.f + sc.z), G3 = g.w * (1.f + sc.w);
  const float B0 = fmaf(b.x, 1.f + sc.x, sh.x), B1 = fmaf(b.y, 1.f + sc.y, sh.y), B2 = fmaf(b.z, 1.f + sc.z, sh.z), B3 = fmaf(b.w, 1.f + sc.w, sh.w);
  u16* dst = which ? WS_h2 : WS_h1;
#pragma unroll
  for (int r = 0; r < 8; ++r) {
    const int row = row0 + r;
    const float* src;
    if (which == 1) src = WS_pre1 + (size_t)row * 1024;
    else if (l == 1) src = p.out + (size_t)row * 1024;
    else src = row < TCTX ? p.x_prompt + (size_t)row * 1024 : p.x_sample + (size_t)(row - TCTX) * 1024;
    float rs = 1.f, nm = 0.f;
    if (st) {
      const float s = st[row * 2], q = st[row * 2 + 1];
      const float mu = s * (1.f / 1024.f);
      rs = rsqrtf(fmaxf(q * (1.f / 1024.f) - mu * mu, 0.f) + LNEPS);
      nm = -mu * rs;
    }
    const float4 x = *(const float4*)(src + c);
    const float h0 = fmaf(fmaf(x.x, rs, nm), G0, B0), h1 = fmaf(fmaf(x.y, rs, nm), G1, B1);
    const float h2 = fmaf(fmaf(x.z, rs, nm), G2, B2), h3 = fmaf(fmaf(x.w, rs, nm), G3, B3);
    *(uint2*)(dst + (size_t)row * 1024 + c) = make_uint2(pack2(h0, h1), pack2(h2, h3));
  }
}

__device__ __forceinline__ void p1_item(const Params& p, char* smem, int l, int item) {
  const int mt = item & 63, nt = item >> 6;
  const int m0 = mt * 128, n0 = nt * 128;
  const int tid = ltid(), lane = tid & 63, wave = tid >> 6, wm = wave >> 1, wn = wave & 1;
  f16v acc[2][2];
  gemm_mainloop0(smem, WS_h1, 1024, WS_Wt + WT_LAYER * l + WT_IN, 1024, 1024, m0, n0, acc);

  const bool latent = m0 >= TCTX;
  const int seg = n0 >> 9;
  const int cs0 = n0 & 511;
  const int l31 = lane & 31;
  u16* Cs = (u16*)smem;
  u16* CsT = Cs + 128 * CST;
  const int rl0 = wm * 64 + 4 * (lane >> 5);
  const int cl0 = wn * 64 + l31;
  const bool want_rm = !(seg == 2 || seg == 7);
  const bool want_t = (seg == 2 || seg == 7 || (seg == 1 && !latent));
#pragma unroll
  for (int mi = 0; mi < 2; ++mi)
#pragma unroll
    for (int q = 0; q < 4; ++q) {
      float o0[4], o1[4];
#pragma unroll
      for (int j = 0; j < 4; ++j) {
        const int reg = q * 4 + j;
        float x1 = acc[mi][0][reg], x2 = acc[mi][1][reg];
        if (seg <= 1) {
          if (latent) {
            const int pos = (m0 - TCTX + rl0 + mi * 32 + q * 8 + j) & 1023;
            const int pidx = ((cs0 + wn * 64) & 64) ? (pos & 63) : (pos >> 6);
            const float cs = WS_ropetab[(pidx * 32 + l31) * 2], sn = WS_ropetab[(pidx * 32 + l31) * 2 + 1];
            const float t1 = x1 * cs - x2 * sn, t2 = x1 * sn + x2 * cs;
            x1 = t1; x2 = t2;
          }
          if (seg == 1) { x1 *= 0.08838834764831845f; x2 *= 0.08838834764831845f; }
        } else if (seg == 3) { x1 = siluf_(x1); x2 = siluf_(x2); }
        else if (seg == 5) { x1 *= 0.125f; x2 *= 0.125f; }
        else if (seg >= 8) { x1 = sigmoidf_(x1); x2 = sigmoidf_(x2); }
        o0[j] = x1; o1[j] = x2;
        if (want_rm) {
          const int rl = rl0 + mi * 32 + q * 8 + j;
          Cs[rl * CST + cl0] = f2bf(x1);
          Cs[rl * CST + cl0 + 32] = f2bf(x2);
        }
        if ((seg == 6 || seg == 7) && !latent) {
          const int row = m0 + rl0 + mi * 32 + q * 8 + j;
          float* o = p.out + (seg == 6 ? OUT_CK : OUT_CV) + ((size_t)((row >> 8) * 2 + l) * 256 + (row & 255)) * 512 + cs0 + cl0;
          o[0] = acc[mi][0][reg]; o[32] = acc[mi][1][reg];
        }
      }
      if (want_t) {
        const int rl = rl0 + mi * 32 + q * 8;
        *(uint2*)(CsT + cl0 * CST + rl) = make_uint2(pack2(o0[0], o0[1]), pack2(o0[2], o0[3]));
        *(uint2*)(CsT + (cl0 + 32) * CST + rl) = make_uint2(pack2(o1[0], o1[1]), pack2(o1[2], o1[3]));
      }
    }
  __syncthreads();
  if (want_rm) {
    u16* dst;
    size_t ld = 512;
    if (seg >= 8) { dst = WS_GT + (size_t)m0 * 3072 + (n0 - 4096); ld = 3072; }
    else {
      u16* base = seg == 0 ? WS_Q : seg == 1 ? WS_K : seg == 3 ? WS_G : seg == 4 ? WS_SU : seg == 5 ? WS_NQ : WS_NK;
      dst = base + (size_t)m0 * 512 + cs0;
    }
    cs_store(Cs, dst, ld, tid);
  }
  if (want_t) {
    u16* base = seg == 2 ? WS_VtR : seg == 7 ? WS_NVt : WS_KtR;
    u16* dst;
    size_t ld;
    if (!latent) { dst = base + ((size_t)(m0 >> 8) * 512 + cs0) * 256 + (m0 & 255); ld = 256; }
    else { dst = base + VTR_LAT + ((size_t)((m0 - TCTX) >> 10) * 512 + cs0) * 1024 + ((m0 - TCTX) & 1023); ld = 1024; }
    cs_store(CsT, dst, ld, tid);
  }
}

template <int D, int MODE>
__device__ __forceinline__ void attn_item(const Params& p, char* smem, int l, int idx) {
  constexpr int KSTR = D + 8;
  constexpr int NKS = D / 32;
  constexpr int NB = D / 16;
  constexpr int NCH = D / 32;
  constexpr int NBUF = (MODE == 0) ? 1 : 2;
  u16* Ks = (u16*)smem;
  u16* Vts = Ks + NBUF * 64 * KSTR;
  float* rpbs = (float*)(Vts + NBUF * D * 72);
  const int tid = ltid(), lane = tid & 63, wave = tid >> 6;
  const int l15 = lane & 15, g = lane >> 4;
  const int wave_u = __builtin_amdgcn_readfirstlane(wave);

  int b, hh, qt, L, tokbase, nt;
  bool latent = false;
  int kr0 = 0, rrow = 0;
  if constexpr (MODE == 0) {
    if (idx < 256) { latent = true; b = idx >> 6; hh = (idx >> 4) & 3; qt = idx & 15; L = 1024; tokbase = TCTX + b * 1024; nt = 16 + 4; }
    else { idx -= 256; b = idx >> 4; hh = (idx >> 2) & 3; qt = idx & 3; L = 256; tokbase = b * 256; nt = 4; }
  } else if constexpr (MODE == 1) {
    b = idx >> 5; hh = (idx >> 2) & 7; qt = idx & 3; L = 256; tokbase = b * 256; nt = 4;
  } else {
    b = idx >> 7; hh = (idx >> 4) & 7; qt = idx & 15; rrow = qt; L = 1024; tokbase = TCTX + b * 1024; nt = 16; latent = true;
    kr0 = min(max(rrow - 4, 0), 8);
  }
  const int tq = qt * 64 + wave * 16 + l15;
  const int qtok = tokbase + tq;

  float lgf2 = 0.f, lgb2 = 0.f;
  if constexpr (MODE == 0) {
    float xf = p.ret_decay[(l * 2 + 0) * 4 + hh], xb = p.ret_decay[(l * 2 + 1) * 4 + hh];
    lgf2 = -log1pf(expf(-xf)) * 1.4426950408889634f;
    lgb2 = -log1pf(expf(-xb)) * 1.4426950408889634f;
  }
  float cfw[4][4], cbw[4][4];
  if constexpr (MODE == 0) {
#pragma unroll
    for (int kb = 0; kb < 4; ++kb)
#pragma unroll
      for (int r = 0; r < 4; ++r) {
        const float off = (float)(kb * 16 + g * 4 + r);
        cfw[kb][r] = __builtin_amdgcn_exp2f(-lgf2 * off);
        cbw[kb][r] = __builtin_amdgcn_exp2f(lgb2 * off);
      }
  }

  __syncthreads();
  if constexpr (MODE == 2) {
    for (int i = tid; i < 465; i += 256) rpbs[i] = p.rpb[(size_t)(l * 8 + hh) * 465 + i];
  }

  u4v qf[NKS];
  {
    const u16* qb = (MODE == 0 ? WS_Q : WS_NQ) + (size_t)qtok * 512 + hh * D + g * 8;
#pragma unroll
    for (int ks = 0; ks < NKS; ++ks) qf[ks] = *(const u4v*)(qb + ks * 32);
  }

  f4v ot[NB];
#pragma unroll
  for (int nb = 0; nb < NB; ++nb) ot[nb] = (f4v){0.f, 0.f, 0.f, 0.f};
  float mrun = -1e30f, lsum = 0.f;

  const int ntk = (MODE == 0) ? (L >> 6) : nt;
  u4v kr[NCH], vr[NCH], kr2[NCH], vr2[NCH];
#define ATTN_ISSUE(KT, KR, VR)                                                                                   \
  {                                                                                                      \
    const int kt_ = (KT);                                                                                \
    const u16* kp; const u16* vp; int ldv;                                                               \
    if constexpr (MODE == 0) {                                                                           \
      kp = WS_K + (size_t)(tokbase + kt_ * 64) * 512 + hh * 128;                                          \
      if (latent) { vp = WS_VtR + VTR_LAT + ((size_t)(b * 4 + hh) * 128) * 1024 + kt_ * 64; ldv = 1024; } \
      else { vp = WS_VtR + ((size_t)(b * 4 + hh) * 128) * 256 + kt_ * 64; ldv = 256; }                    \
    } else if constexpr (MODE == 1) {                                                                    \
      kp = WS_NK + (size_t)(tokbase + kt_ * 64) * 512 + hh * 64;                                          \
      vp = WS_NVt + ((size_t)(b * 8 + hh) * 64) * 256 + kt_ * 64; ldv = 256;                              \
    } else {                                                                                             \
      if (kt_ < 8) {                                                                                     \
        const int krow = kr0 + kt_;                                                                      \
        kp = WS_NK + (size_t)(tokbase + krow * 64) * 512 + hh * 64;                                       \
        vp = WS_NVt + NVT_LAT + ((size_t)(b * 8 + hh) * 64) * 1024 + krow * 64; ldv = 1024;               \
      } else {                                                                                           \
        kp = WS_CK + ((size_t)(l * 4 + b) * 512 + (kt_ - 8) * 64) * 512 + hh * 64;                        \
        vp = WS_CVt + ((size_t)((l * 4 + b) * 8 + hh) * 64) * 512 + (kt_ - 8) * 64; ldv = 512;            \
      }                                                                                                  \
    }                                                                                                    \
    _Pragma("unroll") for (int i = 0; i < NCH; ++i) {                                                    \
      const int c = tid + 256 * i;                                                                       \
      const int r = c / (D / 8), cc = c % (D / 8);                                                       \
      KR[i] = *(const u4v*)(kp + (size_t)r * 512 + cc * 8);                                              \
      const int vrw = c >> 3, vc = c & 7;                                                                \
      VR[i] = *(const u4v*)(vp + (size_t)vrw * ldv + vc * 8);                                            \
    }                                                                                                    \
  }
#define ATTN_STAGE(KR, VR, BUF)                                                                                   \
  {                                                                                                      \
    _Pragma("unroll") for (int i = 0; i < NCH; ++i) {                                                    \
      const int c = tid + 256 * i;                                                                       \
      const int r = c / (D / 8), cc = c % (D / 8);                                                       \
      *(u4v*)(Ks + (BUF) * (64 * KSTR) + r * KSTR + cc * 8) = KR[i];                                                         \
      const int vrw = c >> 3, vc = c & 7;                                                                \
      *(u4v*)(Vts + (BUF) * (D * 72) + vrw * 72 + vc * 8) = VR[i];                                                        \
    }                                                                                                    \
  }

  auto tile_body = [&](const int kt, const u16* Kb, const u16* Vb) {
    f4v st[4];
    int kb_lo = 0, kb_hi = 3;
    if constexpr (MODE == 2) {
      if (kt < 8) { kb_lo = wave_u >= 2 ? wave_u - 1 : 0; kb_hi = wave_u <= 1 ? wave_u + 1 : 3; }
    }
#pragma unroll
    for (int kb = 0; kb < 4; ++kb) {
      st[kb] = (f4v){0.f, 0.f, 0.f, 0.f};
      if (MODE != 2 || (kb >= kb_lo && kb <= kb_hi)) {
#pragma unroll
        for (int ks = 0; ks < NKS; ++ks) {
          s8v kf = *(const s8v*)(Kb + (kb * 16 + l15) * KSTR + ks * 32 + g * 8);
          st[kb] = __builtin_amdgcn_mfma_f32_16x16x32_bf16(kf, bc8(qf[ks]), st[kb], 0, 0, 0);
        }
      }
    }
    if constexpr (MODE == 0) {
      if (kt < qt) {
        const float rowf = __builtin_amdgcn_exp2f(lgf2 * (float)(tq - kt * 64));
#pragma unroll
        for (int kb = 0; kb < 4; ++kb)
#pragma unroll
          for (int r = 0; r < 4; ++r) st[kb][r] *= rowf * cfw[kb][r];
      } else if (kt > qt) {
        const float rowb = __builtin_amdgcn_exp2f(lgb2 * (float)(kt * 64 - tq));
#pragma unroll
        for (int kb = 0; kb < 4; ++kb)
#pragma unroll
          for (int r = 0; r < 4; ++r) st[kb][r] *= rowb * cbw[kb][r];
      } else {
#pragma unroll
        for (int kb = 0; kb < 4; ++kb)
#pragma unroll
          for (int r = 0; r < 4; ++r) {
            const int ts = kt * 64 + kb * 16 + g * 4 + r;
            const int d = tq - ts;
            float dec = d > 0 ? __builtin_amdgcn_exp2f(lgf2 * (float)d) : (d < 0 ? __builtin_amdgcn_exp2f(lgb2 * (float)(-d)) : 2.f);
            st[kb][r] *= dec;
          }
      }
    } else {
      if constexpr (MODE == 2) {
        if (kt < 8) {
          const int qc = wave * 16 + l15;
          const int ws = min(max(qc - 8, 0), 48);
          const int roff = (kr0 + kt) - rrow + 7;
#pragma unroll
          for (int kb = 0; kb < 4; ++kb) {
            if (kb >= kb_lo && kb <= kb_hi) {
#pragma unroll
              for (int r = 0; r < 4; ++r) {
                const int kc = kb * 16 + g * 4 + r;
                const bool valid = (kc >= ws) && (kc < ws + 16);
                const int coff = min(max(kc - qc + 15, 0), 30);
                const float bias = rpbs[roff * 31 + coff];
                st[kb][r] = valid ? st[kb][r] + bias : -1e30f;
              }
            } else {
              st[kb] = (f4v){-1e30f, -1e30f, -1e30f, -1e30f};
            }
          }
        }
      }
      float tmax = st[0][0];
#pragma unroll
      for (int kb = 0; kb < 4; ++kb)
#pragma unroll
        for (int r = 0; r < 4; ++r) tmax = fmaxf(tmax, st[kb][r]);
      tmax = fmaxf(tmax, __shfl_xor(tmax, 16));
      tmax = fmaxf(tmax, __shfl_xor(tmax, 32));
      const float mnew = fmaxf(mrun, tmax);
      const float alpha = __expf(mrun - mnew);
      float ps = 0.f;
#pragma unroll
      for (int kb = 0; kb < 4; ++kb) {
        if (MODE != 2 || (kb >= kb_lo && kb <= kb_hi)) {
#pragma unroll
          for (int r = 0; r < 4; ++r) {
            float e = __expf(st[kb][r] - mnew);
            st[kb][r] = e;
            ps += e;
          }
        } else {
          st[kb] = (f4v){0.f, 0.f, 0.f, 0.f};
        }
      }
      lsum = lsum * alpha + ps;
      mrun = mnew;
#pragma unroll
      for (int nb = 0; nb < NB; ++nb) ot[nb] *= alpha;
    }
    u4v pf[2];
#pragma unroll
    for (int s = 0; s < 2; ++s) {
      pf[s] = (u4v){pack2(st[2 * s][0], st[2 * s][1]), pack2(st[2 * s][2], st[2 * s][3]),
                    pack2(st[2 * s + 1][0], st[2 * s + 1][1]), pack2(st[2 * s + 1][2], st[2 * s + 1][3])};
    }
#pragma unroll
    for (int s = 0; s < 2; ++s) {
      if (MODE == 2 && (2 * s + 1 < kb_lo || 2 * s > kb_hi)) continue;
#pragma unroll
      for (int nb = 0; nb < NB; ++nb) {
        const u16* vb = Vb + (nb * 16 + l15) * 72 + s * 32 + g * 4;
        uint2 lo = *(const uint2*)(vb);
        uint2 hi = *(const uint2*)(vb + 16);
        u4v vf = (u4v){lo.x, lo.y, hi.x, hi.y};
        ot[nb] = __builtin_amdgcn_mfma_f32_16x16x32_bf16(bc8(vf), bc8(pf[s]), ot[nb], 0, 0, 0);
      }
    }
  };
  if constexpr (MODE == 0) {
    ATTN_ISSUE(0, kr, vr)
#pragma unroll 1
    for (int kt = 0; kt < ntk; ++kt) {
      __syncthreads();
      ATTN_STAGE(kr, vr, 0)
      __syncthreads();
      if (kt + 1 < ntk) ATTN_ISSUE(kt + 1, kr, vr)
      tile_body(kt, Ks, Vts);
    }
  } else {
    ATTN_ISSUE(0, kr, vr)
    ATTN_ISSUE(1, kr2, vr2)
#pragma unroll 1
    for (int kt = 0; kt < ntk; kt += 2) {
      __syncthreads();
      ATTN_STAGE(kr, vr, 0)
      ATTN_STAGE(kr2, vr2, 1)
      __syncthreads();
      if (kt + 2 < ntk) {
        ATTN_ISSUE(kt + 2, kr, vr)
        ATTN_ISSUE(kt + 3, kr2, vr2)
      }
      tile_body(kt, Ks, Vts);
      tile_body(kt + 1, Ks + (NBUF - 1) * 64 * KSTR, Vts + (NBUF - 1) * D * 72);
    }
  }

  if constexpr (MODE == 0) {
    if (latent) {
#pragma unroll 1
      for (int dir = 0; dir < 2; ++dir) {
        const float scale = dir == 0 ? __builtin_amdgcn_exp2f(lgf2 * (float)(tq + 1)) : __builtin_amdgcn_exp2f(lgb2 * (float)(L - tq));
        const u16* S0 = WS_S0t + ((size_t)(((l * 4 + b) * 2 + dir) * 4 + hh)) * 16384;
#pragma unroll
        for (int s = 0; s < NKS; ++s) {
          u4v pq = (u4v){pack2(bflo(qf[s][0]) * scale, bfhi(qf[s][0]) * scale), pack2(bflo(qf[s][1]) * scale, bfhi(qf[s][1]) * scale),
                         pack2(bflo(qf[s][2]) * scale, bfhi(qf[s][2]) * scale), pack2(bflo(qf[s][3]) * scale, bfhi(qf[s][3]) * scale)};
#pragma unroll
          for (int nb = 0; nb < NB; ++nb) {
            u4v vf = *(const u4v*)(S0 + (size_t)(nb * 16 + l15) * 128 + s * 32 + g * 8);
            ot[nb] = __builtin_amdgcn_mfma_f32_16x16x32_bf16(bc8(vf), bc8(pq), ot[nb], 0, 0, 0);
          }
        }
      }
    }
    float s = 0.f;
#pragma unroll
    for (int nb = 0; nb < NB; ++nb) s += ot[nb][0] + ot[nb][1] + ot[nb][2] + ot[nb][3];
    s += __shfl_xor(s, 16); s += __shfl_xor(s, 32);
    const float mu = s * (1.f / 128.f);
    float q = 0.f;
#pragma unroll
    for (int nb = 0; nb < NB; ++nb)
#pragma unroll
      for (int r = 0; r < 4; ++r) { float dlt = ot[nb][r] - mu; q += dlt * dlt; }
    q += __shfl_xor(q, 16); q += __shfl_xor(q, 32);
    const float rstd = rsqrtf(q * (1.f / 128.f) + LNEPS);
#pragma unroll
    for (int nb = 0; nb < NB; ++nb) {
      const size_t off = (size_t)qtok * 512 + hh * 128 + nb * 16 + g * 4;
      uint2 gg = *(const uint2*)(WS_G + off);
      float o0 = (ot[nb][0] - mu) * rstd * bflo(gg.x);
      float o1 = (ot[nb][1] - mu) * rstd * bfhi(gg.x);
      float o2 = (ot[nb][2] - mu) * rstd * bflo(gg.y);
      float o3 = (ot[nb][3] - mu) * rstd * bfhi(gg.y);
      *(uint2*)(WS_rout + off) = make_uint2(pack2(o0, o1), pack2(o2, o3));
    }
  } else {
    lsum += __shfl_xor(lsum, 16); lsum += __shfl_xor(lsum, 32);
    const float inv = __builtin_amdgcn_rcpf(lsum);
#pragma unroll
    for (int nb = 0; nb < NB; ++nb) {
      const size_t off = (size_t)qtok * 512 + hh * 64 + nb * 16 + g * 4;
      *(uint2*)(WS_nout + off) = make_uint2(pack2(ot[nb][0] * inv, ot[nb][1] * inv), pack2(ot[nb][2] * inv, ot[nb][3] * inv));
    }
  }
}

__device__ __forceinline__ void retstate_item(const Params& p, int l, int idx) {
  const int dir = idx & 1, hh = (idx >> 1) & 3, b = idx >> 3;
  const int tid = ltid(), lane = tid & 63, wave = tid >> 6;
  const int r = lane & 31, h2 = lane >> 5;
  const float x = p.ret_decay[(l * 2 + dir) * 4 + hh];
  const float lg2 = -log1pf(expf(-x)) * 1.4426950408889634f;
  const u16* Kt = WS_KtR + ((size_t)(b * 4 + hh) * 128) * 256;
  const u16* Vt = WS_VtR + ((size_t)(b * 4 + hh) * 128) * 256;
  f16v acc[4];
#pragma unroll
  for (int i = 0; i < 4; ++i) acc[i] = zero16();
#pragma unroll 2
  for (int ks = 0; ks < 16; ++ks) {
    const int tok0 = ks * 16 + h2 * 8;
    const u4v a = *(const u4v*)(Kt + (size_t)(wave * 32 + r) * 256 + tok0);
    u4v af;
#pragma unroll
    for (int w = 0; w < 4; ++w) {
      const int t0 = tok0 + 2 * w, t1 = t0 + 1;
      float w0 = __builtin_amdgcn_exp2f(lg2 * (float)(dir == 0 ? 255 - t0 : t0));
      float w1 = __builtin_amdgcn_exp2f(lg2 * (float)(dir == 0 ? 255 - t1 : t1));
      af[w] = pack2(bflo(a[w]) * w0, bfhi(a[w]) * w1);
    }
#pragma unroll
    for (int nt = 0; nt < 4; ++nt) {
      const u4v bfr = *(const u4v*)(Vt + (size_t)(nt * 32 + r) * 256 + tok0);
      acc[nt] = __builtin_amdgcn_mfma_f32_32x32x16_bf16(bc8(af), bc8(bfr), acc[nt], 0, 0, 0);
    }
  }
  float* o = p.out + OUT_SRET + ((size_t)(((b * 2 + l) * 2 + dir) * 4 + hh)) * 16384;
#pragma unroll
  for (int nt = 0; nt < 4; ++nt)
#pragma unroll
    for (int reg = 0; reg < 16; ++reg) {
      const int dk = wave * 32 + (reg & 3) + 8 * (reg >> 2) + 4 * h2;
      o[(size_t)dk * 128 + nt * 32 + r] = acc[nt][reg];
    }
}

__device__ __forceinline__ void s5_item(const Params& p, char* smem, int l, int item) {
  const int tid = ltid(), lane = tid & 63, wave = tid >> 6;
  const int l15 = lane & 15, g4 = lane >> 4;
  int seq = item * 4 + wave;
  int b, dir, g, L, tokbase;
  bool latent;
  if (seq < 256) { latent = true; b = seq >> 6; dir = (seq >> 5) & 1; g = seq & 31; L = 1024; tokbase = TCTX + b * 1024; }
  else { seq -= 256; latent = false; b = seq >> 6; dir = (seq >> 5) & 1; g = seq & 31; L = 256; tokbase = b * 256; }
  float* buf = (float*)smem + wave * (16 * 132);
  const int tg = (l * 2 + dir) * 32 + g;
  const float ar = WS_abar[(tg * 64 + lane) * 2], ai = WS_abar[(tg * 64 + lane) * 2 + 1];
  u4v bfrag[8];
#pragma unroll
  for (int nt = 0; nt < 8; ++nt) {
    if (g4 < 2) bfrag[nt] = *(const u4v*)(WS_bbarT + ((size_t)tg * 128 + nt * 16 + l15) * 16 + g4 * 8);
    else bfrag[nt] = (u4v){0u, 0u, 0u, 0u};
  }
  u4v cfrag[4];
#pragma unroll
  for (int ks = 0; ks < 4; ++ks) cfrag[ks] = *(const u4v*)(WS_cmT + ((size_t)tg * 16 + l15) * 128 + ks * 32 + g4 * 8);
  float xr = 0.f, xi = 0.f;
  if (latent) {
    const float* h0 = p.state_ssm + ((size_t)(((b * 2 + l) * 2 + dir) * 32 + g) * 64 + lane) * 2;
    xr = h0[0]; xi = h0[1];
  }
  u16* yd = WS_YD + (size_t)dir * TALL * 512;
  __syncthreads();
  const int nsub = L >> 4;
  u4v afn = (u4v){0u, 0u, 0u, 0u};
  if (g4 < 2) {
    const int pos = dir == 0 ? l15 : L - 1 - l15;
    afn = *(const u4v*)(WS_SU + (size_t)(tokbase + pos) * 512 + g * 16 + g4 * 8);
  }
#pragma unroll 1
  for (int sub = 0; sub < nsub; ++sub) {
    const u4v af = afn;
    if (g4 < 2 && sub + 1 < nsub) {
      const int tau = (sub + 1) * 16 + l15;
      const int pos = dir == 0 ? tau : L - 1 - tau;
      afn = *(const u4v*)(WS_SU + (size_t)(tokbase + pos) * 512 + g * 16 + g4 * 8);
    }
#pragma unroll
    for (int nt = 0; nt < 8; ++nt) {
      f4v c = (f4v){0.f, 0.f, 0.f, 0.f};
      c = __builtin_amdgcn_mfma_f32_16x16x32_bf16(bc8(af), bc8(bfrag[nt]), c, 0, 0, 0);
#pragma unroll
      for (int r = 0; r < 4; ++r) buf[(g4 * 4 + r) * 132 + nt * 16 + l15] = c[r];
    }
    __builtin_amdgcn_wave_barrier();
#pragma unroll
    for (int i = 0; i < 16; ++i) {
      const float bur = buf[i * 132 + lane], bui = buf[i * 132 + 64 + lane];
      const float nr = ar * xr - ai * xi + bur;
      const float ni = ar * xi + ai * xr + bui;
      xr = nr; xi = ni;
      buf[i * 132 + lane] = xr;
      buf[i * 132 + 64 + lane] = xi;
    }
    __builtin_amdgcn_wave_barrier();
    f4v y = (f4v){0.f, 0.f, 0.f, 0.f};
#pragma unroll
    for (int ks = 0; ks < 4; ++ks) {
      const float* bp = buf + l15 * 132 + ks * 32 + g4 * 8;
      float4 v0 = *(const float4*)(bp), v1 = *(const float4*)(bp + 4);
      const u4v xa = (u4v){pack2(v0.x, v0.y), pack2(v0.z, v0.w), pack2(v1.x, v1.y), pack2(v1.z, v1.w)};
      y = __builtin_amdgcn_mfma_f32_16x16x32_bf16(bc8(xa), bc8(cfrag[ks]), y, 0, 0, 0);
    }
#pragma unroll
    for (int r = 0; r < 4; ++r) {
      const int tau = sub * 16 + g4 * 4 + r;
      const int pos = dir == 0 ? tau : L - 1 - tau;
      yd[(size_t)(tokbase + pos) * 512 + g * 16 + l15] = f2bf(y[r]);
    }
    __builtin_amdgcn_wave_barrier();
  }
  if (!latent) {
    float* o = p.out + OUT_SSSM + ((size_t)(((b * 2 + l) * 2 + dir) * 32 + g) * 64 + lane) * 2;
    o[0] = xr; o[1] = xi;
  }
}

#define MX_S5 320
#define MX_RET 512
#define MX_NA 512
#define MX_CA 512
#define MX_RS 128
#define MX_ITEMS (MX_S5 + MX_RET + MX_NA + MX_CA + MX_RS)
__device__ __forceinline__ void mixer_item(const Params& p, char* smem, int l, int item) {
  if (item < 64) { s5_item(p, smem, l, item); return; }
  item -= 64;
  if (item < 256) { attn_item<128, 0>(p, smem, l, item); return; }
  item -= 256;
  if (item < 512) { attn_item<64, 2>(p, smem, l, item); return; }
  item -= 512;
  if (item < 256) { s5_item(p, smem, l, 64 + item); return; }
  item -= 256;
  if (item < 256) { attn_item<128, 0>(p, smem, l, 256 + item); return; }
  item -= 256;
  if (item < 512) { attn_item<64, 1>(p, smem, l, item); return; }
  item -= 512;
  retstate_item(p, l, item);
}

__device__ __forceinline__ void p3a_item(const Params& p, char* smem, int l, int item) {
  const int mt = item & 63, nt = item >> 6;
  const int m0 = mt * 128, n0 = nt * 128;
  const int tid = ltid(), lane = tid & 63, wave = tid >> 6, wm = wave >> 1, wn = wave & 1;
  AArgs a{};
  a.SU = WS_SU; a.YD0 = WS_YD; a.YD1 = WS_YD + (size_t)TALL * 512; a.dsk = p.ssm_d + l * 512;
  f16v acc[2][2];
  gemm_mainloop<2>(smem, a, WS_Wt + WT_LAYER * l + WT_GLU, 512, 512, m0, n0, acc);
#pragma unroll
  for (int mi = 0; mi < 2; ++mi)
#pragma unroll
    for (int reg = 0; reg < 16; ++reg) {
      const int row = EPI_ROW(mi, reg);
#pragma unroll
      for (int ni = 0; ni < 2; ++ni) {
        const int col = EPI_COL(ni);
        const size_t off = (size_t)row * 512 + col;
        float y = geluf_(a.dsk[col] * bf2f(WS_SU[off]) + bf2f(a.YD0[off]) + bf2f(a.YD1[off]));
        WS_sout[off] = f2bf(y * sigmoidf_(acc[mi][ni][reg]));
      }
    }
}

__device__ __forceinline__ void p3b_item(const Params& p, char* smem, int l, int item) {
  const int mt = item & 63, nt = item >> 6;
  const int m0 = mt * 128, n0 = nt * 128;
  const int tid = ltid(), lane = tid & 63, wave = tid >> 6, wm = wave >> 1, wn = wave & 1;
  int nbr = 3;
  asm volatile("" : "+s"(nbr));
#pragma unroll 1
  for (int br = 0; br < nbr; ++br) {
    const u16* Abr = br == 0 ? WS_rout : (br == 1 ? WS_sout : WS_nout);
    f16v acc[2][2];
    gemm_mainloop0(smem, Abr, 512, WS_Wt + WT_LAYER * l + WT_BR + (size_t)br * 512 * 1024, 512, 512, m0, n0, acc);
    u16* Cs = (u16*)smem;
    {
      const int rl0 = wm * 64 + 4 * (lane >> 5), cl0 = wn * 64 + (lane & 31);
#pragma unroll
      for (int mi = 0; mi < 2; ++mi)
#pragma unroll
        for (int reg = 0; reg < 16; ++reg) {
          const int rl = rl0 + mi * 32 + (reg & 3) + 8 * (reg >> 2);
          Cs[rl * CST + cl0] = f2bf(acc[mi][0][reg]);
          Cs[rl * CST + cl0 + 32] = f2bf(acc[mi][1][reg]);
        }
    }
    __syncthreads();
    int tl = tid;
    asm volatile("" : "+v"(tl));
#pragma unroll
    for (int i = 0; i < 8; ++i) {
      const int c = tl + 256 * i, r = c >> 4, ch = c & 15;
      const u4v av = *(const u4v*)(Cs + r * CST + ch * 8);
      const u4v gv = *(const u4v*)(WS_GT + (size_t)(m0 + r) * 3072 + br * 1024 + n0 + ch * 8);
      u16* mp = WS_merged + (size_t)(m0 + r) * 1024 + n0 + ch * 8;
      u4v mv = (u4v){0u, 0u, 0u, 0u};
      if (br > 0) mv = *(const u4v*)mp;
      u4v ov;
#pragma unroll
      for (int j = 0; j < 4; ++j)
        ov[j] = pack2(fmaf(bflo(gv[j]), bflo(av[j]), bflo(mv[j])), fmaf(bfhi(gv[j]), bfhi(av[j]), bfhi(mv[j])));
      *(u4v*)mp = ov;
    }
  }
}


#define CFS 132
__device__ __forceinline__ void epi_resid(char* smem, f16v (&acc)[2][2], int m0, int n0, const float* __restrict__ gvec,
                                          const float* __restrict__ xlo, const float* __restrict__ xhi,
                                          const float* __restrict__ xstats, const float* __restrict__ lng,
                                          const float* __restrict__ lnb, float* __restrict__ dst,
                                          float* __restrict__ stats_out, bool do_stats) {
  float* Cf = (float*)smem;
  const int tid = ltid(), lane = tid & 63, wave = tid >> 6, wm = wave >> 1, wn = wave & 1;
  {
    const int rl0 = wm * 64 + 4 * (lane >> 5), cl0 = wn * 64 + (lane & 31);
    const float ga = gvec[n0 + cl0], gb = gvec[n0 + cl0 + 32];
#pragma unroll
    for (int mi = 0; mi < 2; ++mi)
#pragma unroll
      for (int reg = 0; reg < 16; ++reg) {
        const int rl = rl0 + mi * 32 + (reg & 3) + 8 * (reg >> 2);
        Cf[rl * CFS + cl0] = ga * acc[mi][0][reg];
        Cf[rl * CFS + cl0 + 32] = gb * acc[mi][1][reg];
      }
  }
  __syncthreads();
  const int ch = tid & 31, r0 = tid >> 5;
  const int col = n0 + ch * 4;
  float4 g4 = make_float4(1.f, 1.f, 1.f, 1.f), b4 = make_float4(0.f, 0.f, 0.f, 0.f);
  if (xstats) { g4 = *(const float4*)(lng + col); b4 = *(const float4*)(lnb + col); }
  const float* xbase = (m0 < TCTX ? xlo + (size_t)m0 * 1024 : xhi + (size_t)(m0 - TCTX) * 1024) + col;
#pragma unroll 4
  for (int i = 0; i < 16; ++i) {
    const int r = r0 + 8 * i;
    const int row = m0 + r;
    const float4 v = *(const float4*)(Cf + r * CFS + ch * 4);
    float4 x = *(const float4*)(xbase + (size_t)r * 1024);
    if (xstats) {
      const float s = xstats[row * 2], q = xstats[row * 2 + 1];
      const float mu = s * (1.f / 1024.f);
      const float rstd = rsqrtf(fmaxf(q * (1.f / 1024.f) - mu * mu, 0.f) + LNEPS);
      x.x = (x.x - mu) * rstd * g4.x + b4.x; x.y = (x.y - mu) * rstd * g4.y + b4.y;
      x.z = (x.z - mu) * rstd * g4.z + b4.z; x.w = (x.w - mu) * rstd * g4.w + b4.w;
    }
    float4 o;
    o.x = ALPHA * x.x + v.x; o.y = ALPHA * x.y + v.y; o.z = ALPHA * x.z + v.z; o.w = ALPHA * x.w + v.w;
    *(float4*)(dst + (size_t)row * 1024 + col) = o;
    if (do_stats) {
      float ss = o.x + o.y + o.z + o.w, qq = o.x * o.x + o.y * o.y + o.z * o.z + o.w * o.w;
#pragma unroll
      for (int sh = 1; sh < 32; sh <<= 1) { ss += __shfl_xor(ss, sh); qq += __shfl_xor(qq, sh); }
      if (ch == 0) { atomicAdd(stats_out + row * 2, ss); atomicAdd(stats_out + row * 2 + 1, qq); }
    }
  }
}

__device__ __forceinline__ void p3c_item(const Params& p, char* smem, int l, int item, bool do_stats = true) {
  const int mt = item & 63, nt = item >> 6;
  const int m0 = mt * 128, n0 = nt * 128;
  const int tid = ltid(), lane = tid & 63, wave = tid >> 6, wm = wave >> 1, wn = wave & 1;
  f16v acc[2][2];
  gemm_mainloop0(smem, WS_merged, 1024, WS_Wt + WT_LAYER * l + WT_O, 1024, 1024, m0, n0, acc);
  const int ci = cond_of_row(m0);
  const float* g1 = WS_mod + (l * 5 + ci) * 6144 + 2048;
  float* st1 = WS_stats + (size_t)(l * 2 + 0) * TALL * 2;
  if (l == 0)
    epi_resid(smem, acc, m0, n0, g1, p.x_prompt, p.x_sample, nullptr, nullptr, nullptr, WS_pre1, st1, do_stats);
  else
    epi_resid(smem, acc, m0, n0, g1, p.out, p.out + (size_t)TCTX * 1024, WS_stats + (size_t)(0 * 2 + 1) * TALL * 2, p.ln2_g, p.ln2_b,
              WS_pre1, st1, do_stats);
}

__device__ __forceinline__ void p4_item(const Params& p, char* smem, int l, int item) {
  const int mt = item & 63, nt = item >> 6;
  const int m0 = mt * 128, n0 = nt * 128;
  const int tid = ltid(), lane = tid & 63, wave = tid >> 6, wm = wave >> 1, wn = wave & 1;
  f16v acc[2][2];
  gemm_mainloop0(smem, WS_h2, 1024, WS_Wt + WT_LAYER * l + WT_UP, 1024, 1024, m0, n0, acc);
  u16* Cs = (u16*)smem;
  const int rl0 = wm * 64 + 4 * (lane >> 5), cl0 = wn * 64 + (lane & 31);
#pragma unroll
  for (int mi = 0; mi < 2; ++mi)
#pragma unroll
    for (int reg = 0; reg < 16; ++reg) {
      const int rl = rl0 + mi * 32 + (reg & 3) + 8 * (reg >> 2);
      Cs[rl * CST + cl0] = f2bf(acc[mi][0][reg]);
      Cs[rl * CST + cl0 + 32] = f2bf(acc[mi][1][reg]);
    }
  __syncthreads();
  cs_store(Cs, WS_z2 + (size_t)m0 * 5632 + n0, 5632, tid);
}

__device__ __forceinline__ void p4b_item(const Params& p, int l, int item) {
  const int tid = ltid();
  if (tid >= 176) return;
  const int rb = item >> 1, hf = item & 1;
  const int j0 = (hf * 176 + tid) * 8;
  const float* cw = p.conv_w + (size_t)l * 3 * 5632;
  const float* cb = p.conv_b + (size_t)l * 5632;
  float wa[3][8], wb[3][8], ba[8], bb[8];
#pragma unroll
  for (int t = 0; t < 3; ++t)
#pragma unroll
    for (int h = 0; h < 2; ++h) {
      const float4 x = *(const float4*)(cw + t * 5632 + j0 + 4 * h), y = *(const float4*)(cw + t * 5632 + 2816 + j0 + 4 * h);
      wa[t][4 * h] = x.x; wa[t][4 * h + 1] = x.y; wa[t][4 * h + 2] = x.z; wa[t][4 * h + 3] = x.w;
      wb[t][4 * h] = y.x; wb[t][4 * h + 1] = y.y; wb[t][4 * h + 2] = y.z; wb[t][4 * h + 3] = y.w;
    }
#pragma unroll
  for (int h = 0; h < 2; ++h) {
    const float4 x = *(const float4*)(cb + j0 + 4 * h), y = *(const float4*)(cb + 2816 + j0 + 4 * h);
    ba[4 * h] = x.x; ba[4 * h + 1] = x.y; ba[4 * h + 2] = x.z; ba[4 * h + 3] = x.w;
    bb[4 * h] = y.x; bb[4 * h + 1] = y.y; bb[4 * h + 2] = y.z; bb[4 * h + 3] = y.w;
  }
  const int row0 = rb * 32;
  int pos0, L;
  if (row0 < TCTX) { pos0 = row0 & 255; L = 256; } else { pos0 = (row0 - TCTX) & 1023; L = 1024; }
  const u16* zr = WS_z2 + (size_t)row0 * 5632 + j0;
  const u4v zero = (u4v){0u, 0u, 0u, 0u};
  u4v pa = zero, pb = zero;
  if (pos0 > 0) { pa = *(const u4v*)(zr - 5632); pb = *(const u4v*)(zr - 5632 + 2816); }
  u4v ca = *(const u4v*)(zr), cb2 = *(const u4v*)(zr + 2816);
#pragma unroll 2
  for (int r = 0; r < 32; ++r) {
    u4v na = zero, nb = zero;
    if (pos0 + r < L - 1) { na = *(const u4v*)(zr + (size_t)(r + 1) * 5632); nb = *(const u4v*)(zr + (size_t)(r + 1) * 5632 + 2816); }
    u4v ov;
#pragma unroll
    for (int w = 0; w < 4; ++w) {
      const float a0 = wa[0][2 * w] * bflo(pa[w]) + wa[1][2 * w] * bflo(ca[w]) + wa[2][2 * w] * bflo(na[w]) + ba[2 * w];
      const float a1 = wa[0][2 * w + 1] * bfhi(pa[w]) + wa[1][2 * w + 1] * bfhi(ca[w]) + wa[2][2 * w + 1] * bfhi(na[w]) + ba[2 * w + 1];
      const float b0 = wb[0][2 * w] * bflo(pb[w]) + wb[1][2 * w] * bflo(cb2[w]) + wb[2][2 * w] * bflo(nb[w]) + bb[2 * w];
      const float b1 = wb[0][2 * w + 1] * bfhi(pb[w]) + wb[1][2 * w + 1] * bfhi(cb2[w]) + wb[2][2 * w + 1] * bfhi(nb[w]) + bb[2 * w + 1];
      ov[w] = pack2(geluf_(a0) * b0, geluf_(a1) * b1);
    }
    *(u4v*)(WS_act + (size_t)(row0 + r) * 2816 + j0) = ov;
    pa = ca; pb = cb2; ca = na; cb2 = nb;
  }
}

__device__ __forceinline__ void p5_item(const Params& p, char* smem, int l, int item, bool do_stats = true) {
  const int mt = item & 63, nt = item >> 6;
  const int m0 = mt * 128, n0 = nt * 128;
  const int tid = ltid(), lane = tid & 63, wave = tid >> 6, wm = wave >> 1, wn = wave & 1;
  f16v acc[2][2];
  gemm_mainloop0(smem, WS_act, 2816, WS_Wt + WT_LAYER * l + WT_DOWN, 2816, 2816, m0, n0, acc);
  const int ci = cond_of_row(m0);
  const float* g2 = WS_mod + (l * 5 + ci) * 6144 + 5 * 1024;
  epi_resid(smem, acc, m0, n0, g2, WS_pre1, WS_pre1 + (size_t)TCTX * 1024, WS_stats + (size_t)(l * 2 + 0) * TALL * 2,
            p.ln1_g + l * 1024, p.ln1_b + l * 1024, p.out, WS_stats + (size_t)(l * 2 + 1) * TALL * 2, do_stats);
}

__device__ __forceinline__ void final_item(const Params& p, int item) {
  const float* st = WS_stats + (size_t)(1 * 2 + 1) * TALL * 2;
  const int c = ltid() * 4;
  const float4 g = *(const float4*)(p.ln2_g + 1024 + c);
  const float4 b = *(const float4*)(p.ln2_b + 1024 + c);
  for (int r = 0; r < 8; ++r) {
    const int row = item * 8 + r;
    const float s = st[row * 2], q = st[row * 2 + 1];
    const float mu = s * (1.f / 1024.f);
    const float rstd = rsqrtf(fmaxf(q * (1.f / 1024.f) - mu * mu, 0.f) + LNEPS);
    float4 v = *(float4*)(p.out + (size_t)row * 1024 + c);
    v.x = (v.x - mu) * rstd * g.x + b.x;
    v.y = (v.y - mu) * rstd * g.y + b.y;
    v.z = (v.z - mu) * rstd * g.z + b.z;
    v.w = (v.w - mu) * rstd * g.w + b.w;
    *(float4*)(p.out + (size_t)row * 1024 + c) = v;
  }
}

#define XB_TMO      128
#define XB_XCNT(j)  (256  + 64 * (j))
#define XB_XSUB(j)  (1280 + 64 * (j))
#define XB_XGEN(j)  (2304 + 64 * (j))
#define XB_TOP      3328
#define XB_TOPGEN   3392
#define XCD_BAR_WORDS 3456
#define XB_SPIN_CAP (1u << 18)
#define LAS __attribute__((address_space(3)))

__device__ __forceinline__ unsigned xb_ld(unsigned* p)              { return __hip_atomic_load(p, __ATOMIC_RELAXED, __HIP_MEMORY_SCOPE_AGENT); }
__device__ __forceinline__ unsigned xb_add(unsigned* p, unsigned v) { return __hip_atomic_fetch_add(p, v, __ATOMIC_RELAXED, __HIP_MEMORY_SCOPE_AGENT); }
__device__ __forceinline__ unsigned xb_xcc_id() { return (unsigned)__builtin_amdgcn_s_getreg((3 << 11) | 20) & 0xFu; }
#define XB_SPIN(cond, bar) do { unsigned _sp = 0; while (cond) { __builtin_amdgcn_s_sleep(1); \
    if ((++_sp & 255u) == 0u) { if (xb_ld(&(bar)[XB_TMO])) break; if (_sp > XB_SPIN_CAP) { atomicAdd(&(bar)[XB_TMO], 1u); break; } } } } while (0)

struct XcdBarrier {
    unsigned* bar; unsigned x;
    volatile LAS unsigned* st;
};

__device__ __forceinline__ XcdBarrier xcd_barrier_post(unsigned* bar, volatile LAS unsigned* st) {
    XcdBarrier b; b.bar = bar; b.x = xb_xcc_id(); b.st = st;
    if (threadIdx.x == 0) (void)xb_add(&bar[XB_XCNT(b.x)], 1u);
    return b;
}
__device__ __forceinline__ void xcd_barrier_complete(unsigned* bar, unsigned x, unsigned& nloc, unsigned& nx) {
    const unsigned G = gridDim.x * gridDim.y * gridDim.z;
    unsigned sum, cnt, mine, sp = 0u;
    for (;;) {
        sum = 0u; cnt = 0u; mine = 0u;
#pragma unroll
        for (unsigned j = 0; j < 16; ++j) { const unsigned c = xb_ld(&bar[XB_XCNT(j)]); sum += c; cnt += (c > 0u) ? 1u : 0u; mine = (j == x) ? c : mine; }
        if (sum == G) break;
        __builtin_amdgcn_s_sleep(1);
        if ((++sp & 255u) == 0u) { if (xb_ld(&bar[XB_TMO])) break; if (sp > XB_SPIN_CAP) { atomicAdd(&bar[XB_TMO], 1u); break; } }
    }
    nloc = mine > 0u ? mine : 1u; nx = cnt > 0u ? cnt : 1u;
}

__device__ __forceinline__ void xcd_barrier(const XcdBarrier& b) {
    asm volatile("s_waitcnt vmcnt(0)" ::: "memory");
    __syncthreads();
    if (threadIdx.x == 0) {
        unsigned* bar = b.bar;
        __builtin_amdgcn_s_waitcnt(0);
        unsigned nloc = b.st[0], nx = b.st[1];
        if (nloc == 0u) { xcd_barrier_complete(bar, b.x, nloc, nx); b.st[0] = nloc; b.st[1] = nx; }
        const unsigned old = xb_add(&bar[XB_XSUB(b.x)], 1u);
        const unsigned gen = old / nloc;
        if (old + 1u == (gen + 1u) * nloc) {
            __builtin_amdgcn_fence(__ATOMIC_RELEASE, "agent");
            asm volatile("s_waitcnt vmcnt(0)" ::: "memory");
            const unsigned og = xb_add(&bar[XB_TOP], 1u);
            const unsigned tg = og / nx;
            if (og + 1u == (tg + 1u) * nx) xb_add(&bar[XB_TOPGEN], 1u);
            else XB_SPIN(xb_ld(&bar[XB_TOPGEN]) == tg, bar);
            __builtin_amdgcn_fence(__ATOMIC_ACQUIRE, "agent");
            xb_add(&bar[XB_XGEN(b.x)], 1u);
            asm volatile("s_waitcnt vmcnt(0)" ::: "memory");
        } else {
            XB_SPIN(xb_ld(&bar[XB_XGEN(b.x)]) == gen, bar);
            __builtin_amdgcn_fence(__ATOMIC_ACQUIRE, "agent");
            asm volatile("s_waitcnt vmcnt(0)" ::: "memory");
        }
    }
    __syncthreads();
}


#define NPHASES 22
#ifndef REPMASK
#define REPMASK 0
#endif
#define REPS(PH) (((PH) == 0 ? (REPMASK >> 10) : (PH) == 21 ? (REPMASK >> 11) : (REPMASK >> (((PH) - 1) % 10))) & 1)
#define RUN_PHASE(PH, N, CALL)                                              \
  if (ph_lo <= (PH) && (PH) < ph_hi) {                                      \
    for (int rep_ = 0; rep_ <= REPS(PH); ++rep_)                            \
    for (int it = blockIdx.x; it < (N); it += nb) { CALL; }                 \
    if ((PH) + 1 < ph_hi) xcd_barrier(xb);                                  \
  }
#define RUN_GEMM_PHASE(PH, NT, CALL)                                                          \
  if (ph_lo <= (PH) && (PH) < ph_hi) {                                                        \
    const int xcd_ = blockIdx.x & 7, slot_ = blockIdx.x >> 3, spx_ = (int)gridDim.x >> 3;      \
    const int nsuper_ = 8 * (((NT) + 7) >> 3);                                                \
    for (int rep_ = 0; rep_ <= REPS(PH); ++rep_)                                              \
    for (int s_ = xcd_; s_ < nsuper_; s_ += 8)                                                \
      for (int j_ = slot_; j_ < 64; j_ += spx_) {                                             \
        const int mt_ = (s_ & 7) * 8 + (j_ & 7), nt_ = (s_ >> 3) * 8 + (j_ >> 3);             \
        if (nt_ < (NT)) { const int it = nt_ * 64 + mt_; CALL; }                              \
      }                                                                                       \
    if ((PH) + 1 < ph_hi) xcd_barrier(xb);                                                    \
  }
#define RUN_MIXER_PHASE(PH, L)                                                                \
  if (ph_lo <= (PH) && (PH) < ph_hi) {                                                        \
    for (int rep_ = 0; rep_ <= REPS(PH); ++rep_) {                                            \
      unsigned* ctr_ = (unsigned*)(p.ws + OFF_ctr) + 64 * (2 * (L) + rep_);                   \
      for (;;) {                                                                              \
        __syncthreads();                                                                      \
        if (threadIdx.x == 0) wq_item = (int)atomicAdd(ctr_, 1u);                             \
        __syncthreads();                                                                      \
        const int it = wq_item;                                                               \
        if (it >= MX_ITEMS) break;                                                            \
        mixer_item(p, smem, (L), it);                                                         \
      }                                                                                       \
    }                                                                                         \
    if ((PH) + 1 < ph_hi) xcd_barrier(xb);                                                    \
  }
#define RUN_P3A_PHASE(PH, L)                                                                  \
  if (ph_lo <= (PH) && (PH) < ph_hi) {                                                        \
    const int xcd_ = blockIdx.x & 7, slot_ = blockIdx.x >> 3, spx_ = (int)gridDim.x >> 3;      \
    for (int rep_ = 0; rep_ <= REPS(PH); ++rep_)                                              \
      for (int j_ = slot_; j_ < 32; j_ += spx_) {                                             \
        const int it = (j_ >> 3) * 64 + xcd_ * 8 + (j_ & 7);                                  \
        p3a_item(p, smem, (L), it);                                                           \
      }                                                                                       \
    if ((L) == 0) {                                                                           \
      const int nidle_ = spx_ > 32 ? 8 * (spx_ - 32) : 0;                                     \
      if (nidle_ == 0) {                                                                      \
        for (int w_ = blockIdx.x; w_ < P0_WT_PER_LAYER; w_ += nb) wt_item(p, smem, P0_WT_PER_LAYER + w_); \
      } else if (slot_ >= 32) {                                                               \
        for (int w_ = xcd_ * (spx_ - 32) + (slot_ - 32); w_ < P0_WT_PER_LAYER; w_ += nidle_)  \
          wt_item(p, smem, P0_WT_PER_LAYER + w_);                                             \
      }                                                                                       \
    }                                                                                         \
    if ((PH) + 1 < ph_hi) xcd_barrier(xb);                                                    \
  }
#define RUN_LAYER(L)                                                         \
  RUN_PHASE(1 + 10 * (L) + 0, 1024, hmat_item(p, (L), 0, it))                \
  RUN_GEMM_PHASE(1 + 10 * (L) + 1, 56, p1_item(p, smem, (L), it))            \
  RUN_MIXER_PHASE(1 + 10 * (L) + 2, (L))                                     \
  RUN_P3A_PHASE(1 + 10 * (L) + 3, (L))                                       \
  RUN_GEMM_PHASE(1 + 10 * (L) + 4, 8, p3b_item(p, smem, (L), it))            \
  RUN_GEMM_PHASE(1 + 10 * (L) + 5, 8, p3c_item(p, smem, (L), it, rep_ == 0)) \
  RUN_PHASE(1 + 10 * (L) + 6, 1024, hmat_item(p, (L), 1, it))                \
  RUN_GEMM_PHASE(1 + 10 * (L) + 7, 44, p4_item(p, smem, (L), it))            \
  RUN_PHASE(1 + 10 * (L) + 8, 512, p4b_item(p, (L), it))                     \
  RUN_GEMM_PHASE(1 + 10 * (L) + 9, 8, p5_item(p, smem, (L), it, rep_ == 0))

__global__ void __launch_bounds__(256, 2) mega(Params p, int ph_lo, int ph_hi) {
  extern __shared__ __attribute__((aligned(16))) char smem[];
  __shared__ uint4 xb_words;
  __shared__ int wq_item;
  const int nb = gridDim.x;
  if (threadIdx.x == 0) xb_words = make_uint4(0u, 0u, 0u, 0u);
  __syncthreads();
  XcdBarrier xb;
  xb.bar = (unsigned*)(p.ws + OFF_bar); xb.x = 0; xb.st = (volatile LAS unsigned*)&xb_words;
  if (ph_hi - ph_lo > 1) xb = xcd_barrier_post((unsigned*)(p.ws + OFF_bar), (volatile LAS unsigned*)&xb_words);
  if (ph_hi > 1000) cg::this_grid().sync();
  RUN_PHASE(0, P0_ITEMS, phase0_item(p, smem, it))
  RUN_LAYER(0)
  RUN_LAYER(1)
  RUN_PHASE(21, 1024, final_item(p, it))
}

extern "C" void kernel_launch(void* const* d_in, const int* in_sizes, int n_in, void* d_out, int out_size, void* d_ws,
                              size_t ws_size, hipStream_t stream) {
  Params p{};
  const float** ins = (const float**)&p;
  for (int i = 0; i < 32; ++i) ins[i] = (const float*)d_in[i];
  p.out = (float*)d_out;
  char* ws = (char*)d_ws;
  p.ws = ws;
  if (WS_TOTAL > ws_size) {
    fprintf(stderr, "kernel_launch: workspace too small (%zu needed, %zu given)\n", (size_t)WS_TOTAL, ws_size);
    return;
  }
  (void)hipMemsetAsync(ws, 0, ZERO_BYTES, stream);
#if SINGLE_LAUNCH
  static int grid_blocks = 0;
  if (!grid_blocks) {
    int dev = 0, cus = 0, per_cu = 0;
    (void)hipGetDevice(&dev);
    (void)hipDeviceGetAttribute(&cus, hipDeviceAttributeMultiprocessorCount, dev);
    (void)hipFuncSetAttribute((const void*)mega, hipFuncAttributeMaxDynamicSharedMemorySize, LDS_BYTES);
    (void)hipOccupancyMaxActiveBlocksPerMultiprocessor(&per_cu, mega, 256, LDS_BYTES);
    if (per_cu > 2) per_cu = 2;
    if (per_cu < 1) per_cu = 1;
    grid_blocks = (cus * per_cu) & ~7;
  }
  int lo = 0, hi = NPHASES;
  void* args[] = {&p, &lo, &hi};
  hipError_t e = hipLaunchCooperativeKernel((void*)mega, dim3(grid_blocks), dim3(256), args, LDS_BYTES, stream);
  if (e != hipSuccess) fprintf(stderr, "cooperative launch failed: %s (grid %d)\n", hipGetErrorString(e), grid_blocks);
#else
  for (int ph = 0; ph < NPHASES; ++ph) {
    hipLaunchKernelGGL(mega, dim3(512), dim3(256), LDS_BYTES, stream, p, ph, ph + 1);
  }
#endif
}
```

```cpp
#include <hip/hip_runtime.h>
#include <hip/hip_cooperative_groups.h>
#include <cstdio>
namespace cg = cooperative_groups;

#ifndef SINGLE_LAUNCH
#define SINGLE_LAUNCH 1
#endif

typedef __attribute__((ext_vector_type(8))) short s8v;
typedef __attribute__((ext_vector_type(4))) float f4v;
typedef __attribute__((ext_vector_type(16))) float f16v;
typedef unsigned short u16;
typedef __attribute__((ext_vector_type(4))) unsigned u4v;
__device__ __forceinline__ s8v bc8(u4v x) { return __builtin_bit_cast(s8v, x); }


#define TALL 8192
#define TCTX 4096
#define ALPHA 1.41421356237309515f
#define LNEPS 1e-5f
#define VTR_LAT 2097152
#define NVT_LAT 2097152
#define OUT_SRET 8388608
#define OUT_SSSM 12582912
#define OUT_CK 12845056
#define OUT_CV 17039360
#define WT_IN 0
#define WT_GLU (WT_IN + 7168 * 1024)
#define WT_BR (WT_GLU + 512 * 512)
#define WT_O (WT_BR + 3 * 1024 * 512)
#define WT_UP (WT_O + 1024 * 1024)
#define WT_DOWN (WT_UP + 5632 * 1024)
#define WT_LAYER ((size_t)(WT_DOWN + 1024 * 2816))

struct Params {
  const float *x_prompt, *x_sample, *state_ret, *state_ssm, *cache_k, *cache_v, *c, *c_ctx;
  const float *w_ada, *b_ada, *w_in, *ret_decay, *a_re, *a_im, *log_dt, *b_re, *b_im, *c_re, *c_im;
  const float *ssm_d, *w_glu, *rpb, *w_branch, *w_o, *ln1_g, *ln1_b, *w_up, *conv_w, *conv_b, *w_down, *ln2_g, *ln2_b;
  float* out;
  char* ws;
};

typedef __bf16 bf2v __attribute__((ext_vector_type(2)));
typedef float fl2v __attribute__((ext_vector_type(2)));
__device__ __forceinline__ unsigned pack2(float a, float b) {
  fl2v f = {a, b};
  bf2v h = __builtin_convertvector(f, bf2v);
  return __builtin_bit_cast(unsigned, h);
}
__device__ __forceinline__ u16 f2bf(float f) { return (u16)(pack2(f, 0.f) & 0xffffu); }

constexpr size_t al256(size_t x) { return (x + 255) & ~(size_t)255; }
constexpr size_t EB = (size_t)TALL * 512 * 2;
constexpr size_t OFF_mod = 0;
constexpr size_t OFF_stats = OFF_mod + al256(2 * 5 * 6144 * 4);
constexpr size_t OFF_bar = OFF_stats + al256(2 * 2 * TALL * 2 * 4);
constexpr size_t OFF_ctr = OFF_bar + al256(3456 * 4);
constexpr size_t ZERO_BYTES = OFF_ctr + al256(8 * 256);
constexpr size_t OFF_ropetab = ZERO_BYTES;
constexpr size_t OFF_abar = OFF_ropetab + al256(64 * 32 * 2 * 4);
constexpr size_t OFF_bbarT = OFF_abar + al256(2 * 2 * 32 * 64 * 2 * 4);
constexpr size_t OFF_cmT = OFF_bbarT + al256(2 * 2 * 32 * 128 * 16 * 2);
constexpr size_t OFF_CK = OFF_cmT + al256(2 * 2 * 32 * 16 * 128 * 2);
constexpr size_t OFF_CVt = OFF_CK + al256((size_t)2 * 4 * 512 * 512 * 2);
constexpr size_t OFF_S0t = OFF_CVt + al256((size_t)2 * 4 * 512 * 512 * 2);
constexpr size_t OFF_Wt = OFF_S0t + al256((size_t)2 * 4 * 2 * 4 * 128 * 128 * 2);
constexpr size_t OFF_REGION = OFF_Wt + al256(2 * WT_LAYER * 2);
constexpr size_t OFF_z2 = OFF_REGION;
constexpr size_t OFF_act = OFF_z2 + (size_t)TALL * 5632 * 2;
constexpr size_t OFF_pre1 = OFF_act + (size_t)TALL * 2816 * 2;
constexpr size_t WS_TOTAL = OFF_pre1 + (size_t)TALL * 1024 * 4;
constexpr size_t OFF_K = OFF_pre1;
constexpr size_t OFF_VtR = OFF_K + EB;
constexpr size_t OFF_NQ = OFF_VtR + EB;
constexpr size_t OFF_NK = OFF_NQ + EB;
constexpr size_t OFF_GT = OFF_REGION;
constexpr size_t OFF_rout = OFF_GT + (size_t)TALL * 3072 * 2;
constexpr size_t OFF_nout = OFF_rout + EB;
constexpr size_t OFF_YD = OFF_nout + EB;
constexpr size_t OFF_merged = OFF_YD;
constexpr size_t OFF_Q = OFF_YD + 2 * EB;
constexpr size_t OFF_sout = OFF_Q;
constexpr size_t OFF_KtR = OFF_Q + EB;
constexpr size_t OFF_G = OFF_KtR + EB / 2;
constexpr size_t OFF_SU = OFF_G + EB;
constexpr size_t OFF_NVt = OFF_SU + EB;
constexpr size_t OFF_h1 = OFF_NVt + EB;
constexpr size_t OFF_h2 = OFF_act;
static_assert(OFF_h1 + 2 * EB <= OFF_pre1, "mixer buffers overflow the z2+act area");
#define WS_h1 ((u16*)(p.ws + OFF_h1))
#define WS_h2 ((u16*)(p.ws + OFF_h2))
#define WS_mod ((float*)(p.ws + OFF_mod))
#define WS_stats ((float*)(p.ws + OFF_stats))
#define WS_ropetab ((float*)(p.ws + OFF_ropetab))
#define WS_abar ((float*)(p.ws + OFF_abar))
#define WS_pre1 ((float*)(p.ws + OFF_pre1))
#define WS_bbarT ((u16*)(p.ws + OFF_bbarT))
#define WS_cmT ((u16*)(p.ws + OFF_cmT))
#define WS_CK ((u16*)(p.ws + OFF_CK))
#define WS_CVt ((u16*)(p.ws + OFF_CVt))
#define WS_S0t ((u16*)(p.ws + OFF_S0t))
#define WS_Wt ((u16*)(p.ws + OFF_Wt))
#define WS_Q ((u16*)(p.ws + OFF_Q))
#define WS_K ((u16*)(p.ws + OFF_K))
#define WS_VtR ((u16*)(p.ws + OFF_VtR))
#define WS_KtR ((u16*)(p.ws + OFF_KtR))
#define WS_G ((u16*)(p.ws + OFF_G))
#define WS_SU ((u16*)(p.ws + OFF_SU))
#define WS_NQ ((u16*)(p.ws + OFF_NQ))
#define WS_NK ((u16*)(p.ws + OFF_NK))
#define WS_NVt ((u16*)(p.ws + OFF_NVt))
#define WS_GT ((u16*)(p.ws + OFF_GT))
#define WS_rout ((u16*)(p.ws + OFF_rout))
#define WS_sout ((u16*)(p.ws + OFF_sout))
#define WS_nout ((u16*)(p.ws + OFF_nout))
#define WS_YD ((u16*)(p.ws + OFF_YD))
#define WS_merged ((u16*)(p.ws + OFF_merged))
#define WS_z2 ((u16*)(p.ws + OFF_z2))
#define WS_act ((u16*)(p.ws + OFF_act))

__device__ __forceinline__ float bf2f(unsigned h) { return __uint_as_float((h & 0xffffu) << 16); }
__device__ __forceinline__ float bflo(unsigned w) { return __uint_as_float(w << 16); }
__device__ __forceinline__ float bfhi(unsigned w) { return __uint_as_float(w & 0xffff0000u); }
__device__ __forceinline__ float fexp_(float x) { return __builtin_amdgcn_exp2f(x * 1.4426950408889634f); }
__device__ __forceinline__ float sigmoidf_(float x) { return __builtin_amdgcn_rcpf(1.f + fexp_(-x)); }
__device__ __forceinline__ float siluf_(float x) { return x * __builtin_amdgcn_rcpf(1.f + fexp_(-x)); }
__device__ __forceinline__ float geluf_(float x) {
  const float u2 = 1.5957691216057308f * (x + 0.044715f * x * x * x);
  return x * __builtin_amdgcn_rcpf(1.f + fexp_(-u2));
}
__device__ __forceinline__ f16v zero16() {
  return (f16v){0.f, 0.f, 0.f, 0.f, 0.f, 0.f, 0.f, 0.f, 0.f, 0.f, 0.f, 0.f, 0.f, 0.f, 0.f, 0.f};
}
__device__ __forceinline__ int ltid() { int t = threadIdx.x; asm volatile("" : "+v"(t)); return t; }
__device__ __forceinline__ int cond_of_row(int row) { return row < TCTX ? 0 : 1 + ((row - TCTX) >> 10); }

struct AArgs {
  const u16* A16; int lda;
  const float* A32lo; const float* A32hi;
  const float* stats;
  const float* lng; const float* lnb;
  const float* sc; const float* sh;
  const u16* SU; const u16* YD0; const u16* YD1; const float* dsk;
};

#define GST 72
#define LDS_GEMM (2 * 2 * 128 * GST * 2)
#define LDS_BYTES LDS_GEMM

template <int AMODE>
__device__ __forceinline__ void gemm_mainloop(char* smem, const AArgs& a, const u16* __restrict__ Bt, int ldb, int K,
                                              int m0, int n0, f16v (&acc)[2][2]) {
  u16* As = (u16*)smem;
  u16* Bs = As + 2 * 128 * GST;
  const int tid = ltid(), lane = tid & 63, wave = tid >> 6;
  const int wm = wave >> 1, wn = wave & 1;
  const int crow = tid >> 3, cch = tid & 7;
  const int frow = tid >> 4, fch = tid & 15;
  float rs[8], nm[8];
  const float* srow0 = nullptr;
  const float *gsc = nullptr, *gsh = nullptr;
  __syncthreads();
  if constexpr (AMODE == 1) {
    const int ci = cond_of_row(m0);
    gsc = a.sc + ci * 6144; gsh = a.sh + ci * 6144;
#pragma unroll
    for (int i = 0; i < 8; ++i) {
      rs[i] = 1.f; nm[i] = 0.f;
      if (a.stats) {
        const int row = m0 + frow + 16 * i;
        const float s = a.stats[row * 2], q = a.stats[row * 2 + 1];
        const float mu = s * (1.f / 1024.f);
        const float var = q * (1.f / 1024.f) - mu * mu;
        rs[i] = rsqrtf(fmaxf(var, 0.f) + LNEPS);
        nm[i] = -mu * rs[i];
      }
    }
    const int row0 = m0 + frow;
    srow0 = (row0 < TCTX ? a.A32lo + (size_t)row0 * 1024 : a.A32hi + (size_t)(row0 - TCTX) * 1024) + fch * 4;
  }
  acc[0][0] = zero16(); acc[0][1] = zero16(); acc[1][0] = zero16(); acc[1][1] = zero16();

  u4v ra[12], rb[4];
  float4 q0, q1, q2, q3;
  q0 = q1 = q3 = make_float4(0.f, 0.f, 0.f, 0.f); q2 = make_float4(1.f, 1.f, 1.f, 1.f);
  const u16* brow = Bt + (size_t)(n0 + crow) * ldb + cch * 8;
  auto issue = [&](int kt) {
    if constexpr (AMODE == 1) {
      const int k = kt * 64 + fch * 4;
      q0 = *(const float4*)(gsc + k); q1 = *(const float4*)(gsh + k);
      if (a.lng) { q2 = *(const float4*)(a.lng + k); q3 = *(const float4*)(a.lnb + k); }
    } else if constexpr (AMODE == 2) {
      const int k0 = kt * 64 + cch * 8;
      q0 = *(const float4*)(a.dsk + k0); q1 = *(const float4*)(a.dsk + k0 + 4);
    }
    if constexpr (AMODE == 0) {
      const u16* ap = a.A16 + (size_t)(m0 + crow) * a.lda + kt * 64 + cch * 8;
#pragma unroll
      for (int i = 0; i < 4; ++i) ra[i] = *(const u4v*)(ap + (size_t)(32 * i) * a.lda);
    } else if constexpr (AMODE == 1) {
#pragma unroll
      for (int i = 0; i < 8; ++i) ra[i] = *(const u4v*)(srow0 + (size_t)(16 * i) * 1024 + kt * 64);
    } else {
      const size_t o = (size_t)(m0 + crow) * 512 + kt * 64 + cch * 8;
#pragma unroll
      for (int i = 0; i < 4; ++i) {
        ra[i] = *(const u4v*)(a.SU + o + (size_t)(32 * i) * 512);
        ra[4 + i] = *(const u4v*)(a.YD0 + o + (size_t)(32 * i) * 512);
        ra[8 + i] = *(const u4v*)(a.YD1 + o + (size_t)(32 * i) * 512);
      }
    }
#pragma unroll
    for (int i = 0; i < 4; ++i) rb[i] = *(const u4v*)(brow + (size_t)(32 * i) * ldb + kt * 64);
  };
  auto stage = [&](int buf, int kt) {
    u16* Ad = As + buf * (128 * GST);
    if constexpr (AMODE == 0) {
#pragma unroll
      for (int i = 0; i < 4; ++i) *(u4v*)(Ad + (crow + 32 * i) * GST + cch * 8) = ra[i];
    } else if constexpr (AMODE == 1) {
      const float4 sc = q0, sh = q1, g = q2, b = q3;
      const float G0 = g.x * (1.f + sc.x), G1 = g.y * (1.f + sc.y), G2 = g.z * (1.f + sc.z), G3 = g.w * (1.f + sc.w);
      const float B0 = fmaf(b.x, 1.f + sc.x, sh.x), B1 = fmaf(b.y, 1.f + sc.y, sh.y), B2 = fmaf(b.z, 1.f + sc.z, sh.z), B3 = fmaf(b.w, 1.f + sc.w, sh.w);
#pragma unroll
      for (int i = 0; i < 8; ++i) {
        const float h0 = fmaf(fmaf(__uint_as_float(ra[i][0]), rs[i], nm[i]), G0, B0);
        const float h1 = fmaf(fmaf(__uint_as_float(ra[i][1]), rs[i], nm[i]), G1, B1);
        const float h2 = fmaf(fmaf(__uint_as_float(ra[i][2]), rs[i], nm[i]), G2, B2);
        const float h3 = fmaf(fmaf(__uint_as_float(ra[i][3]), rs[i], nm[i]), G3, B3);
        *(uint2*)(Ad + (frow + 16 * i) * GST + fch * 4) = make_uint2(pack2(h0, h1), pack2(h2, h3));
      }
    } else {
      const float4 da = q0, db = q1;
      const float dd[8] = {da.x, da.y, da.z, da.w, db.x, db.y, db.z, db.w};
#pragma unroll
      for (int i = 0; i < 4; ++i) {
        u4v o;
#pragma unroll
        for (int j = 0; j < 4; ++j) {
          const float v0 = geluf_(dd[2 * j] * bflo(ra[i][j]) + bflo(ra[4 + i][j]) + bflo(ra[8 + i][j]));
          const float v1 = geluf_(dd[2 * j + 1] * bfhi(ra[i][j]) + bfhi(ra[4 + i][j]) + bfhi(ra[8 + i][j]));
          o[j] = pack2(v0, v1);
        }
        *(u4v*)(Ad + (crow + 32 * i) * GST + cch * 8) = o;
      }
    }
    u16* Bd = Bs + buf * (128 * GST);
#pragma unroll
    for (int i = 0; i < 4; ++i) *(u4v*)(Bd + (crow + 32 * i) * GST + cch * 8) = rb[i];
  };
  auto compute = [&](int buf) {
    const u16* Ab = As + buf * (128 * GST) + (wm * 64 + (lane & 31)) * GST + (lane >> 5) * 8;
    const u16* Bb = Bs + buf * (128 * GST) + (wn * 64 + (lane & 31)) * GST + (lane >> 5) * 8;
#pragma unroll
    for (int ks = 0; ks < 4; ++ks) {
      s8v af0 = *(const s8v*)(Ab + ks * 16);
      s8v af1 = *(const s8v*)(Ab + 32 * GST + ks * 16);
      s8v bf0 = *(const s8v*)(Bb + ks * 16);
      s8v bf1 = *(const s8v*)(Bb + 32 * GST + ks * 16);
      acc[0][0] = __builtin_amdgcn_mfma_f32_32x32x16_bf16(af0, bf0, acc[0][0], 0, 0, 0);
      acc[0][1] = __builtin_amdgcn_mfma_f32_32x32x16_bf16(af0, bf1, acc[0][1], 0, 0, 0);
      acc[1][0] = __builtin_amdgcn_mfma_f32_32x32x16_bf16(af1, bf0, acc[1][0], 0, 0, 0);
      acc[1][1] = __builtin_amdgcn_mfma_f32_32x32x16_bf16(af1, bf1, acc[1][1], 0, 0, 0);
    }
  };

  const int nk = K >> 6;
  issue(0);
  stage(0, 0);
  __syncthreads();
#pragma unroll 1
  for (int kt = 0; kt < nk; ++kt) {
    const int buf = kt & 1;
    if (kt + 1 < nk) issue(kt + 1);
    compute(buf);
    if (kt + 1 < nk) stage(buf ^ 1, kt + 1);
    __syncthreads();
  }
}

__device__ __forceinline__ void gemm_mainloop0(char* smem, const u16* __restrict__ A, int lda, const u16* __restrict__ Bt, int ldb,
                                               int K, int m0, int n0, f16v (&acc)[2][2]) {
  u16* As = (u16*)smem;
  u16* Bs = As + 2 * 128 * GST;
  const int tid = ltid(), lane = tid & 63, wave = tid >> 6;
  const int wm = wave >> 1, wn = wave & 1;
  const int crow = tid >> 3, cch = tid & 7;
  __syncthreads();
  acc[0][0] = zero16(); acc[0][1] = zero16(); acc[1][0] = zero16(); acc[1][1] = zero16();
  const u16* arow = A + (size_t)(m0 + crow) * lda + cch * 8;
  const u16* brow = Bt + (size_t)(n0 + crow) * ldb + cch * 8;
  const size_t a32 = (size_t)32 * lda, b32 = (size_t)32 * ldb;
  u4v eA0, eA1, eA2, eA3, eB0, eB1, eB2, eB3, oA0, oA1, oA2, oA3, oB0, oB1, oB2, oB3;
#define G0_ISSUE(P, kt)                                                                                   \
  { const u16* ap_ = arow + (kt) * 64; const u16* bp_ = brow + (kt) * 64;                                 \
    P##A0 = *(const u4v*)(ap_); P##A1 = *(const u4v*)(ap_ + a32); P##A2 = *(const u4v*)(ap_ + 2 * a32);   \
    P##A3 = *(const u4v*)(ap_ + 3 * a32);                                                                 \
    P##B0 = *(const u4v*)(bp_); P##B1 = *(const u4v*)(bp_ + b32); P##B2 = *(const u4v*)(bp_ + 2 * b32);   \
    P##B3 = *(const u4v*)(bp_ + 3 * b32); }
#define G0_STAGE(P, buf)                                                                                  \
  { u16* Ad_ = As + (buf) * (128 * GST) + crow * GST + cch * 8; u16* Bd_ = Bs + (buf) * (128 * GST) + crow * GST + cch * 8; \
    *(u4v*)(Ad_) = P##A0; *(u4v*)(Ad_ + 32 * GST) = P##A1; *(u4v*)(Ad_ + 64 * GST) = P##A2; *(u4v*)(Ad_ + 96 * GST) = P##A3; \
    *(u4v*)(Bd_) = P##B0; *(u4v*)(Bd_ + 32 * GST) = P##B1; *(u4v*)(Bd_ + 64 * GST) = P##B2; *(u4v*)(Bd_ + 96 * GST) = P##B3; }
#define G0_COMPUTE(buf)                                                                                   \
  { const u16* Ab = As + (buf) * (128 * GST) + (wm * 64 + (lane & 31)) * GST + (lane >> 5) * 8;           \
    const u16* Bb = Bs + (buf) * (128 * GST) + (wn * 64 + (lane & 31)) * GST + (lane >> 5) * 8;           \
    __builtin_amdgcn_s_setprio(1);                                                                        \
    _Pragma("unroll") for (int ks = 0; ks < 4; ++ks) {                                                    \
      s8v af0 = *(const s8v*)(Ab + ks * 16);                                                              \
      s8v af1 = *(const s8v*)(Ab + 32 * GST + ks * 16);                                                   \
      s8v bf0 = *(const s8v*)(Bb + ks * 16);                                                              \
      s8v bf1 = *(const s8v*)(Bb + 32 * GST + ks * 16);                                                   \
      acc[0][0] = __builtin_amdgcn_mfma_f32_32x32x16_bf16(af0, bf0, acc[0][0], 0, 0, 0);                  \
      acc[0][1] = __builtin_amdgcn_mfma_f32_32x32x16_bf16(af0, bf1, acc[0][1], 0, 0, 0);                  \
      acc[1][0] = __builtin_amdgcn_mfma_f32_32x32x16_bf16(af1, bf0, acc[1][0], 0, 0, 0);                  \
      acc[1][1] = __builtin_amdgcn_mfma_f32_32x32x16_bf16(af1, bf1, acc[1][1], 0, 0, 0);                  \
    }                                                                                                     \
    __builtin_amdgcn_s_setprio(0); }
  const int nk = K >> 6;
  G0_ISSUE(e, 0)
  G0_ISSUE(o, 1)
  G0_STAGE(e, 0)
  __syncthreads();
  int kt = 0;
#pragma unroll 1
  for (; kt + 3 < nk; kt += 2) {
    G0_ISSUE(e, kt + 2)
    __builtin_amdgcn_sched_barrier(0);
    G0_COMPUTE(0)
    G0_STAGE(o, 1)
    __syncthreads();
    G0_ISSUE(o, kt + 3)
    __builtin_amdgcn_sched_barrier(0);
    G0_COMPUTE(1)
    G0_STAGE(e, 0)
    __syncthreads();
  }
  G0_COMPUTE(0)
  G0_STAGE(o, 1)
  __syncthreads();
  G0_COMPUTE(1)
  __syncthreads();
#undef G0_ISSUE
#undef G0_STAGE
#undef G0_COMPUTE
}

#define EPI_ROW(mi, reg) (m0 + wm * 64 + (mi) * 32 + ((reg) & 3) + 8 * ((reg) >> 2) + 4 * (lane >> 5))
#define EPI_COL(ni) (n0 + wn * 64 + (ni) * 32 + (lane & 31))


#define CST 136
__device__ __forceinline__ void cs_store(const u16* Cs, u16* __restrict__ dst, size_t ld, int tid) {
#pragma unroll
  for (int i = 0; i < 8; ++i) {
    const int c = tid + 256 * i, r = c >> 4, ch = c & 15;
    *(u4v*)(dst + (size_t)r * ld + ch * 8) = *(const u4v*)(Cs + r * CST + ch * 8);
  }
}

__device__ __forceinline__ void stats_accum(float* stats, int row, float v0, float v1, int lane) {
  float s = v0 + v1, q = v0 * v0 + v1 * v1;
#pragma unroll
  for (int o = 1; o < 32; o <<= 1) {
    s += __shfl_xor(s, o);
    q += __shfl_xor(q, o);
  }
  if ((lane & 31) == 0) {
    atomicAdd(stats + row * 2, s);
    atomicAdd(stats + row * 2 + 1, q);
  }
}

#define P0_ADA 768
#define P0_ROPE 1
#define P0_CACHE 64
#define P0_S0 64
#define P0_S5 128
#define P0_WT_PER_LAYER (16 * 112 + 8 * 8 + 3 * 8 * 16 + 16 * 16 + 16 * 88 + 44 * 16)
#define WT_EARLY (16 * 112 + 8 * 8)
#define P0_WT (WT_EARLY)
#define P0_ITEMS (P0_ADA + P0_ROPE + P0_CACHE + P0_S0 + P0_S5 + P0_WT)

__device__ __forceinline__ void wt_tile(const float* __restrict__ src, int N, u16* __restrict__ dst, int ldd, int kt, int nt, char* smem) {
  float* tile = (float*)smem;
  const int tid = ltid();
  __syncthreads();
  {
    const int c4 = (tid & 15) * 4, r0 = tid >> 4;
#pragma unroll
    for (int i = 0; i < 4; ++i) {
      const int k = r0 + 16 * i;
      const float4 v = *(const float4*)(src + (size_t)(kt * 64 + k) * N + nt * 64 + c4);
      tile[k * 65 + c4] = v.x; tile[k * 65 + c4 + 1] = v.y; tile[k * 65 + c4 + 2] = v.z; tile[k * 65 + c4 + 3] = v.w;
    }
  }
  __syncthreads();
  {
    const int n = tid >> 2, k0 = (tid & 3) * 16;
#define WTP(j) pack2(tile[(k0 + 2 * (j)) * 65 + n], tile[(k0 + 2 * (j) + 1) * 65 + n])
    u4v* d = (u4v*)(dst + (size_t)(nt * 64 + n) * ldd + kt * 64 + k0);
    d[0] = (u4v){WTP(0), WTP(1), WTP(2), WTP(3)};
    d[1] = (u4v){WTP(4), WTP(5), WTP(6), WTP(7)};
#undef WTP
  }
}
__device__ __forceinline__ void wt_item(const Params& p, char* smem, int item) {
  const int l = item / P0_WT_PER_LAYER;
  int it = item % P0_WT_PER_LAYER;
  u16* base = WS_Wt + WT_LAYER * l;
  if (it < 16 * 112) { wt_tile(p.w_in + (size_t)l * 1024 * 7168, 7168, base + WT_IN, 1024, it / 112, it % 112, smem); return; }
  it -= 16 * 112;
  if (it < 64) { wt_tile(p.w_glu + (size_t)l * 512 * 512, 512, base + WT_GLU, 512, it / 8, it % 8, smem); return; }
  it -= 64;
  if (it < 384) { const int br = it / 128; it %= 128;
    wt_tile(p.w_branch + ((size_t)l * 3 + br) * 512 * 1024, 1024, base + WT_BR + (size_t)br * 512 * 1024, 512, it / 16, it % 16, smem); return; }
  it -= 384;
  if (it < 256) { wt_tile(p.w_o + (size_t)l * 1024 * 1024, 1024, base + WT_O, 1024, it / 16, it % 16, smem); return; }
  it -= 256;
  if (it < 16 * 88) { wt_tile(p.w_up + (size_t)l * 1024 * 5632, 5632, base + WT_UP, 1024, it / 88, it % 88, smem); return; }
  it -= 16 * 88;
  wt_tile(p.w_down + (size_t)l * 2816 * 1024, 1024, base + WT_DOWN, 2816, it / 16, it % 16, smem);
}

__device__ __forceinline__ void phase0_item(const Params& p, char* smem, int item) {
  const int tid = ltid();
  if (item < P0_ADA) {
    const int ks = item & 3, cg = (item >> 2) % 96, l = item / 384;
    float* scs = (float*)smem;
    float* red = scs + 5 * 256;
    __syncthreads();
    for (int i = tid; i < 5 * 256; i += 256) {
      int ci = i >> 8, k = ks * 256 + (i & 255);
      float v = ci == 0 ? p.c_ctx[k] : p.c[(ci - 1) * 1024 + k];
      scs[i] = siluf_(v);
    }
    __syncthreads();
    const int ct = tid & 15, kg = tid >> 4;
    const float* wp = p.w_ada + (size_t)l * 1024 * 6144 + (size_t)(ks * 256 + kg * 16) * 6144 + cg * 64 + ct * 4;
    float acc[5][4];
#pragma unroll
    for (int i = 0; i < 5; ++i)
#pragma unroll
      for (int j = 0; j < 4; ++j) acc[i][j] = 0.f;
#pragma unroll 4
    for (int k = 0; k < 16; ++k) {
      float4 w = *(const float4*)(wp + (size_t)k * 6144);
#pragma unroll
      for (int ci = 0; ci < 5; ++ci) {
        float s = scs[ci * 256 + kg * 16 + k];
        acc[ci][0] += s * w.x; acc[ci][1] += s * w.y; acc[ci][2] += s * w.z; acc[ci][3] += s * w.w;
      }
    }
#pragma unroll
    for (int ci = 0; ci < 5; ++ci)
#pragma unroll
      for (int j = 0; j < 4; ++j) red[(kg * 5 + ci) * 64 + ct * 4 + j] = acc[ci][j];
    __syncthreads();
    for (int i = tid; i < 320; i += 256) {
      int ci = i >> 6, col = i & 63;
      float s = 0.f;
#pragma unroll
      for (int g = 0; g < 16; ++g) s += red[(g * 5 + ci) * 64 + col];
      if (ks == 0) s += p.b_ada[l * 6144 + cg * 64 + col];
      atomicAdd(WS_mod + (l * 5 + ci) * 6144 + cg * 64 + col, s);
    }
    return;
  }
  item -= P0_ADA;
  if (item < P0_ROPE) {
    for (int i = tid; i < 64 * 32; i += 256) {
      int pos = i >> 5, fi = i & 31;
      float inv = (float)pow(10000.0, -(double)fi / 32.0);
      float ang = (float)pos * inv;
      WS_ropetab[i * 2] = (float)cos((double)ang);
      WS_ropetab[i * 2 + 1] = (float)sin((double)ang);
    }
    return;
  }
  item -= P0_ROPE;
  if (item < P0_CACHE) {
    const int pc = item & 7, b = (item >> 3) & 3, l = item >> 5;
    const float* ksrc = p.cache_k + ((size_t)(b * 2 + l) * 512 + pc * 64) * 512;
    const float* vsrc = p.cache_v + ((size_t)(b * 2 + l) * 512 + pc * 64) * 512;
    u16* kdst = WS_CK + ((size_t)(l * 4 + b) * 512 + pc * 64) * 512;
    for (int i = tid; i < 64 * 512 / 4; i += 256) {
      float4 v = *(const float4*)(ksrc + (size_t)i * 4);
      *(uint2*)(kdst + (size_t)i * 4) = make_uint2(pack2(v.x, v.y), pack2(v.z, v.w));
    }
    for (int cc = 0; cc < 2; ++cc) {
      const int col = tid + cc * 256;
      u16* vdst = WS_CVt + ((size_t)(l * 4 + b) * 512 + col) * 512 + pc * 64;
      for (int j = 0; j < 8; ++j) {
        float v[8];
#pragma unroll
        for (int e = 0; e < 8; ++e) v[e] = vsrc[(size_t)(j * 8 + e) * 512 + col];
        *(uint4*)(vdst + j * 8) = make_uint4(pack2(v[0], v[1]), pack2(v[2], v[3]), pack2(v[4], v[5]), pack2(v[6], v[7]));
      }
    }
    return;
  }
  item -= P0_CACHE;
  if (item < P0_S0) {
    const int hh = item & 3, dir = (item >> 2) & 1, b = (item >> 3) & 3, l = item >> 5;
    const float* src = p.state_ret + ((size_t)(((b * 2 + l) * 2 + dir) * 4 + hh)) * 16384;
    u16* dst = WS_S0t + ((size_t)(((l * 4 + b) * 2 + dir) * 4 + hh)) * 16384;
    const int dv = tid & 127, kh = tid >> 7;
    for (int j = 0; j < 8; ++j) {
      const int dk0 = kh * 64 + j * 8;
      float v[8];
#pragma unroll
      for (int e = 0; e < 8; ++e) v[e] = src[(size_t)(dk0 + e) * 128 + dv];
      *(uint4*)(dst + (size_t)dv * 128 + dk0) = make_uint4(pack2(v[0], v[1]), pack2(v[2], v[3]), pack2(v[4], v[5]), pack2(v[6], v[7]));
    }
    return;
  }
  item -= P0_S0;
  if (item >= P0_S5) { wt_item(p, smem, item - P0_S5); return; }
  {
    const int g = item & 31, dir = (item >> 5) & 1, l = item >> 6;
    if (tid < 64) {
      const int pp = tid;
      const int ai = ((l * 2 + dir) * 32 + g) * 64 + pp;
      double lre = fmin((double)p.a_re[ai], -1e-4), lim = (double)p.a_im[ai];
      double dt = exp((double)p.log_dt[(l * 2 + dir) * 32 + g]);
      double er = exp(lre * dt);
      double abr = er * cos(lim * dt), abi = er * sin(lim * dt);
      WS_abar[ai * 2] = (float)abr;
      WS_abar[ai * 2 + 1] = (float)abi;
      double nr = abr - 1.0, ni = abi;
      double den = lre * lre + lim * lim;
      double cr = (nr * lre + ni * lim) / den, cim = (ni * lre - nr * lim) / den;
      u16* bt = WS_bbarT + (size_t)((l * 2 + dir) * 32 + g) * 128 * 16;
      const float* br = p.b_re + ((size_t)(l * 32 + g) * 64 + pp) * 16;
      const float* bi = p.b_im + ((size_t)(l * 32 + g) * 64 + pp) * 16;
      for (int c = 0; c < 16; ++c) {
        double xr = br[c], xi = bi[c];
        bt[pp * 16 + c] = f2bf((float)(cr * xr - cim * xi));
        bt[(64 + pp) * 16 + c] = f2bf((float)(cr * xi + cim * xr));
      }
      u16* ct = WS_cmT + (size_t)((l * 2 + dir) * 32 + g) * 16 * 128;
      const float* cre = p.c_re + ((size_t)((l * 2 + dir) * 32 + g) * 16) * 64;
      const float* cie = p.c_im + ((size_t)((l * 2 + dir) * 32 + g) * 16) * 64;
      for (int c = 0; c < 16; ++c) {
        ct[c * 128 + pp] = f2bf(cre[c * 64 + pp]);
        ct[c * 128 + 64 + pp] = f2bf(-cie[c * 64 + pp]);
      }
    }
  }
}


__device__ __forceinline__ void hmat_item(const Params& p, int l, int which, int item) {
  const int c = ltid() * 4;
  const int row0 = item * 8;
  const int ci = cond_of_row(row0);
  const float* mod = WS_mod + (l * 5 + ci) * 6144;
  const float4 sc = *(const float4*)(mod + (which ? 4 : 1) * 1024 + c);
  const float4 sh = *(const float4*)(mod + (which ? 3 : 0) * 1024 + c);
  float4 g = make_float4(1.f, 1.f, 1.f, 1.f), b = make_float4(0.f, 0.f, 0.f, 0.f);
  const float* st = nullptr;
  if (which == 1) { g = *(const float4*)(p.ln1_g + l * 1024 + c); b = *(const float4*)(p.ln1_b + l * 1024 + c); st = WS_stats + (size_t)(l * 2 + 0) * TALL * 2; }
  else if (l == 1) { g = *(const float4*)(p.ln2_g + c); b = *(const float4*)(p.ln2_b + c); st = WS_stats + (size_t)(0 * 2 + 1) * TALL * 2; }
  const float G0 = g.x * (1.f + sc.x), G1 = g.y * (1.f + sc.y), G2 = g.z * (1.f + sc.z), G3 = g.w * (1.f + sc.w);
  const float B0 = fmaf(b.x, 1.f + sc.x, sh.x), B1 = fmaf(b.y, 1.f + sc.y, sh.y), B2 = fmaf(b.z, 1.f + sc.z, sh.z), B3 = fmaf(b.w, 1.f + sc.w, sh.w);
  u16* dst = which ? WS_h2 : WS_h1;
#pragma unroll
  for (int r = 0; r < 8; ++r) {
    const int row = row0 + r;
    const float* src;
    if (which == 1) src = WS_pre1 + (size_t)row * 1024;
    else if (l == 1) src = p.out + (size_t)row * 1024;
    else src = row < TCTX ? p.x_prompt + (size_t)row * 1024 : p.x_sample + (size_t)(row - TCTX) * 1024;
    float rs = 1.f, nm = 0.f;
    if (st) {
      const float s = st[row * 2], q = st[row * 2 + 1];
      const float mu = s * (1.f / 1024.f);
      rs = rsqrtf(fmaxf(q * (1.f / 1024.f) - mu * mu, 0.f) + LNEPS);
      nm = -mu * rs;
    }
    const float4 x = *(const float4*)(src + c);
    const float h0 = fmaf(fmaf(x.x, rs, nm), G0, B0), h1 = fmaf(fmaf(x.y, rs, nm), G1, B1);
    const float h2 = fmaf(fmaf(x.z, rs, nm), G2, B2), h3 = fmaf(fmaf(x.w, rs, nm), G3, B3);
    *(uint2*)(dst + (size_t)row * 1024 + c) = make_uint2(pack2(h0, h1), pack2(h2, h3));
  }
}

__device__ __forceinline__ void p1_item(const Params& p, char* smem, int l, int item) {
  const int mt = item & 63, nt = item >> 6;
  const int m0 = mt * 128, n0 = nt * 128;
  const int tid = ltid(), lane = tid & 63, wave = tid >> 6, wm = wave >> 1, wn = wave & 1;
  f16v acc[2][2];
  gemm_mainloop0(smem, WS_h1, 1024, WS_Wt + WT_LAYER * l + WT_IN, 1024, 1024, m0, n0, acc);

  const bool latent = m0 >= TCTX;
  const int seg = n0 >> 9;
  const int cs0 = n0 & 511;
  const int l31 = lane & 31;
  u16* Cs = (u16*)smem;
  u16* CsT = Cs + 128 * CST;
  const int rl0 = wm * 64 + 4 * (lane >> 5);
  const int cl0 = wn * 64 + l31;
  const bool want_rm = !(seg == 2 || seg == 7);
  const bool want_t = (seg == 2 || seg == 7 || (seg == 1 && !latent));
#pragma unroll
  for (int mi = 0; mi < 2; ++mi)
#pragma unroll
    for (int q = 0; q < 4; ++q) {
      float o0[4], o1[4];
#pragma unroll
      for (int j = 0; j < 4; ++j) {
        const int reg = q * 4 + j;
        float x1 = acc[mi][0][reg], x2 = acc[mi][1][reg];
        if (seg <= 1) {
          if (latent) {
            const int pos = (m0 - TCTX + rl0 + mi * 32 + q * 8 + j) & 1023;
            const int pidx = ((cs0 + wn * 64) & 64) ? (pos & 63) : (pos >> 6);
            const float cs = WS_ropetab[(pidx * 32 + l31) * 2], sn = WS_ropetab[(pidx * 32 + l31) * 2 + 1];
            const float t1 = x1 * cs - x2 * sn, t2 = x1 * sn + x2 * cs;
            x1 = t1; x2 = t2;
          }
          if (seg == 1) { x1 *= 0.08838834764831845f; x2 *= 0.08838834764831845f; }
        } else if (seg == 3) { x1 = siluf_(x1); x2 = siluf_(x2); }
        else if (seg == 5) { x1 *= 0.125f; x2 *= 0.125f; }
        else if (seg >= 8) { x1 = sigmoidf_(x1); x2 = sigmoidf_(x2); }
        o0[j] = x1; o1[j] = x2;
        if (want_rm) {
          const int rl = rl0 + mi * 32 + q * 8 + j;
          Cs[rl * CST + cl0] = f2bf(x1);
          Cs[rl * CST + cl0 + 32] = f2bf(x2);
        }
        if ((seg == 6 || seg == 7) && !latent) {
          const int row = m0 + rl0 + mi * 32 + q * 8 + j;
          float* o = p.out + (seg == 6 ? OUT_CK : OUT_CV) + ((size_t)((row >> 8) * 2 + l) * 256 + (row & 255)) * 512 + cs0 + cl0;
          o[0] = acc[mi][0][reg]; o[32] = acc[mi][1][reg];
        }
      }
      if (want_t) {
        const int rl = rl0 + mi * 32 + q * 8;
        *(uint2*)(CsT + cl0 * CST + rl) = make_uint2(pack2(o0[0], o0[1]), pack2(o0[2], o0[3]));
        *(uint2*)(CsT + (cl0 + 32) * CST + rl) = make_uint2(pack2(o1[0], o1[1]), pack2(o1[2], o1[3]));
      }
    }
  __syncthreads();
  if (want_rm) {
    u16* dst;
    size_t ld = 512;
    if (seg >= 8) { dst = WS_GT + (size_t)m0 * 3072 + (n0 - 4096); ld = 3072; }
    else {
      u16* base = seg == 0 ? WS_Q : seg == 1 ? WS_K : seg == 3 ? WS_G : seg == 4 ? WS_SU : seg == 5 ? WS_NQ : WS_NK;
      dst = base + (size_t)m0 * 512 + cs0;
    }
    cs_store(Cs, dst, ld, tid);
  }
  if (want_t) {
    u16* base = seg == 2 ? WS_VtR : seg == 7 ? WS_NVt : WS_KtR;
    u16* dst;
    size_t ld;
    if (!latent) { dst = base + ((size_t)(m0 >> 8) * 512 + cs0) * 256 + (m0 & 255); ld = 256; }
    else { dst = base + VTR_LAT + ((size_t)((m0 - TCTX) >> 10) * 512 + cs0) * 1024 + ((m0 - TCTX) & 1023); ld = 1024; }
    cs_store(CsT, dst, ld, tid);
  }
}

template <int D, int MODE>
__device__ __forceinline__ void attn_item(const Params& p, char* smem, int l, int idx) {
  constexpr int KSTR = D + 8;
  constexpr int NKS = D / 32;
  constexpr int NB = D / 16;
  constexpr int NCH = D / 32;
  constexpr int NBUF = (MODE == 0) ? 1 : 2;
  u16* Ks = (u16*)smem;
  u16* Vts = Ks + NBUF * 64 * KSTR;
  float* rpbs = (float*)(Vts + NBUF * D * 72);
  const int tid = ltid(), lane = tid & 63, wave = tid >> 6;
  const int l15 = lane & 15, g = lane >> 4;
  const int wave_u = __builtin_amdgcn_readfirstlane(wave);

  int b, hh, qt, L, tokbase, nt;
  bool latent = false;
  int kr0 = 0, rrow = 0;
  if constexpr (MODE == 0) {
    if (idx < 256) { latent = true; b = idx >> 6; hh = (idx >> 4) & 3; qt = idx & 15; L = 1024; tokbase = TCTX + b * 1024; nt = 16 + 4; }
    else { idx -= 256; b = idx >> 4; hh = (idx >> 2) & 3; qt = idx & 3; L = 256; tokbase = b * 256; nt = 4; }
  } else if constexpr (MODE == 1) {
    b = idx >> 5; hh = (idx >> 2) & 7; qt = idx & 3; L = 256; tokbase = b * 256; nt = 4;
  } else {
    b = idx >> 7; hh = (idx >> 4) & 7; qt = idx & 15; rrow = qt; L = 1024; tokbase = TCTX + b * 1024; nt = 16; latent = true;
    kr0 = min(max(rrow - 4, 0), 8);
  }
  const int tq = qt * 64 + wave * 16 + l15;
  const int qtok = tokbase + tq;

  float lgf2 = 0.f, lgb2 = 0.f;
  if constexpr (MODE == 0) {
    float xf = p.ret_decay[(l * 2 + 0) * 4 + hh], xb = p.ret_decay[(l * 2 + 1) * 4 + hh];
    lgf2 = -log1pf(expf(-xf)) * 1.4426950408889634f;
    lgb2 = -log1pf(expf(-xb)) * 1.4426950408889634f;
  }
  float cfw[4][4], cbw[4][4];
  if constexpr (MODE == 0) {
#pragma unroll
    for (int kb = 0; kb < 4; ++kb)
#pragma unroll
      for (int r = 0; r < 4; ++r) {
        const float off = (float)(kb * 16 + g * 4 + r);
        cfw[kb][r] = __builtin_amdgcn_exp2f(-lgf2 * off);
        cbw[kb][r] = __builtin_amdgcn_exp2f(lgb2 * off);
      }
  }

  __syncthreads();
  if constexpr (MODE == 2) {
    for (int i = tid; i < 465; i += 256) rpbs[i] = p.rpb[(size_t)(l * 8 + hh) * 465 + i];
  }

  u4v qf[NKS];
  {
    const u16* qb = (MODE == 0 ? WS_Q : WS_NQ) + (size_t)qtok * 512 + hh * D + g * 8;
#pragma unroll
    for (int ks = 0; ks < NKS; ++ks) qf[ks] = *(const u4v*)(qb + ks * 32);
  }

  f4v ot[NB];
#pragma unroll
  for (int nb = 0; nb < NB; ++nb) ot[nb] = (f4v){0.f, 0.f, 0.f, 0.f};
  float mrun = -1e30f, lsum = 0.f;

  const int ntk = (MODE == 0) ? (L >> 6) : nt;
  u4v kr[NCH], vr[NCH], kr2[NCH], vr2[NCH];
#define ATTN_ISSUE(KT, KR, VR)                                                                                   \
  {                                                                                                      \
    const int kt_ = (KT);                                                                                \
    const u16* kp; const u16* vp; int ldv;                                                               \
    if constexpr (MODE == 0) {                                                                           \
      kp = WS_K + (size_t)(tokbase + kt_ * 64) * 512 + hh * 128;                                          \
      if (latent) { vp = WS_VtR + VTR_LAT + ((size_t)(b * 4 + hh) * 128) * 1024 + kt_ * 64; ldv = 1024; } \
      else { vp = WS_VtR + ((size_t)(b * 4 + hh) * 128) * 256 + kt_ * 64; ldv = 256; }                    \
    } else if constexpr (MODE == 1) {                                                                    \
      kp = WS_NK + (size_t)(tokbase + kt_ * 64) * 512 + hh * 64;                                          \
      vp = WS_NVt + ((size_t)(b * 8 + hh) * 64) * 256 + kt_ * 64; ldv = 256;                              \
    } else {                                                                                             \
      if (kt_ < 8) {                                                                                     \
        const int krow = kr0 + kt_;                                                                      \
        kp = WS_NK + (size_t)(tokbase + krow * 64) * 512 + hh * 64;                                       \
        vp = WS_NVt + NVT_LAT + ((size_t)(b * 8 + hh) * 64) * 1024 + krow * 64; ldv = 1024;               \
      } else {                                                                                           \
        kp = WS_CK + ((size_t)(l * 4 + b) * 512 + (kt_ - 8) * 64) * 512 + hh * 64;                        \
        vp = WS_CVt + ((size_t)((l * 4 + b) * 8 + hh) * 64) * 512 + (kt_ - 8) * 64; ldv = 512;            \
      }                                                                                                  \
    }                                                                                                    \
    _Pragma("unroll") for (int i = 0; i < NCH; ++i) {                                                    \
      const int c = tid + 256 * i;                                                                       \
      const int r = c / (D / 8), cc = c % (D / 8);                                                       \
      KR[i] = *(const u4v*)(kp + (size_t)r * 512 + cc * 8);                                              \
      const int vrw = c >> 3, vc = c & 7;                                                                \
      VR[i] = *(const u4v*)(vp + (size_t)vrw * ldv + vc * 8);                                            \
    }                                                                                                    \
  }
#define ATTN_STAGE(KR, VR, BUF)                                                                                   \
  {                                                                                                      \
    _Pragma("unroll") for (int i = 0; i < NCH; ++i) {                                                    \
      const int c = tid + 256 * i;                                                                       \
      const int r = c / (D / 8), cc = c % (D / 8);                                                       \
      *(u4v*)(Ks + (BUF) * (64 * KSTR) + r * KSTR + cc * 8) = KR[i];                                                         \
      const int vrw = c >> 3, vc = c & 7;                                                                \
      *(u4v*)(Vts + (BUF) * (D * 72) + vrw * 72 + vc * 8) = VR[i];                                                        \
    }                                                                                                    \
  }

  auto tile_body = [&](const int kt, const u16* Kb, const u16* Vb) {
    f4v st[4];
    int kb_lo = 0, kb_hi = 3;
    if constexpr (MODE == 2) {
      if (kt < 8) { kb_lo = wave_u >= 2 ? wave_u - 1 : 0; kb_hi = wave_u <= 1 ? wave_u + 1 : 3; }
    }
#pragma unroll
    for (int kb = 0; kb < 4; ++kb) {
      st[kb] = (f4v){0.f, 0.f, 0.f, 0.f};
      if (MODE != 2 || (kb >= kb_lo && kb <= kb_hi)) {
#pragma unroll
        for (int ks = 0; ks < NKS; ++ks) {
          s8v kf = *(const s8v*)(Kb + (kb * 16 + l15) * KSTR + ks * 32 + g * 8);
          st[kb] = __builtin_amdgcn_mfma_f32_16x16x32_bf16(kf, bc8(qf[ks]), st[kb], 0, 0, 0);
        }
      }
    }
    if constexpr (MODE == 0) {
      if (kt < qt) {
        const float rowf = __builtin_amdgcn_exp2f(lgf2 * (float)(tq - kt * 64));
#pragma unroll
        for (int kb = 0; kb < 4; ++kb)
#pragma unroll
          for (int r = 0; r < 4; ++r) st[kb][r] *= rowf * cfw[kb][r];
      } else if (kt > qt) {
        const float rowb = __builtin_amdgcn_exp2f(lgb2 * (float)(kt * 64 - tq));
#pragma unroll
        for (int kb = 0; kb < 4; ++kb)
#pragma unroll
          for (int r = 0; r < 4; ++r) st[kb][r] *= rowb * cbw[kb][r];
      } else {
#pragma unroll
        for (int kb = 0; kb < 4; ++kb)
#pragma unroll
          for (int r = 0; r < 4; ++r) {
            const int ts = kt * 64 + kb * 16 + g * 4 + r;
            const int d = tq - ts;
            float dec = d > 0 ? __builtin_amdgcn_exp2f(lgf2 * (float)d) : (d < 0 ? __builtin_amdgcn_exp2f(lgb2 * (float)(-d)) : 2.f);
            st[kb][r] *= dec;
          }
      }
    } else {
      if constexpr (MODE == 2) {
        if (kt < 8) {
          const int qc = wave * 16 + l15;
          const int ws = min(max(qc - 8, 0), 48);
          const int roff = (kr0 + kt) - rrow + 7;
#pragma unroll
          for (int kb = 0; kb < 4; ++kb) {
            if (kb >= kb_lo && kb <= kb_hi) {
#pragma unroll
              for (int r = 0; r < 4; ++r) {
                const int kc = kb * 16 + g * 4 + r;
                const bool valid = (kc >= ws) && (kc < ws + 16);
                const int coff = min(max(kc - qc + 15, 0), 30);
                const float bias = rpbs[roff * 31 + coff];
                st[kb][r] = valid ? st[kb][r] + bias : -1e30f;
              }
            } else {
              st[kb] = (f4v){-1e30f, -1e30f, -1e30f, -1e30f};
            }
          }
        }
      }
      float tmax = st[0][0];
#pragma unroll
      for (int kb = 0; kb < 4; ++kb)
#pragma unroll
        for (int r = 0; r < 4; ++r) tmax = fmaxf(tmax, st[kb][r]);
      tmax = fmaxf(tmax, __shfl_xor(tmax, 16));
      tmax = fmaxf(tmax, __shfl_xor(tmax, 32));
      const float mnew = fmaxf(mrun, tmax);
      const float alpha = __expf(mrun - mnew);
      float ps = 0.f;
#pragma unroll
      for (int kb = 0; kb < 4; ++kb) {
        if (MODE != 2 || (kb >= kb_lo && kb <= kb_hi)) {
#pragma unroll
          for (int r = 0; r < 4; ++r) {
            float e = __expf(st[kb][r] - mnew);
            st[kb][r] = e;
            ps += e;
          }
        } else {
          st[kb] = (f4v){0.f, 0.f, 0.f, 0.f};
        }
      }
      lsum = lsum * alpha + ps;
      mrun = mnew;
#pragma unroll
      for (int nb = 0; nb < NB; ++nb) ot[nb] *= alpha;
    }
    u4v pf[2];
#pragma unroll
    for (int s = 0; s < 2; ++s) {
      pf[s] = (u4v){pack2(st[2 * s][0], st[2 * s][1]), pack2(st[2 * s][2], st[2 * s][3]),
                    pack2(st[2 * s + 1][0], st[2 * s + 1][1]), pack2(st[2 * s + 1][2], st[2 * s + 1][3])};
    }
#pragma unroll
    for (int s = 0; s < 2; ++s) {
      if (MODE == 2 && (2 * s + 1 < kb_lo || 2 * s > kb_hi)) continue;
#pragma unroll
      for (int nb = 0; nb < NB; ++nb) {
        const u16* vb = Vb + (nb * 16 + l15) * 72 + s * 32 + g * 4;
        uint2 lo = *(const uint2*)(vb);
        uint2 hi = *(const uint2*)(vb + 16);
        u4v vf = (u4v){lo.x, lo.y, hi.x, hi.y};
        ot[nb] = __builtin_amdgcn_mfma_f32_16x16x32_bf16(bc8(vf), bc8(pf[s]), ot[nb], 0, 0, 0);
      }
    }
  };
  if constexpr (MODE == 0) {
    ATTN_ISSUE(0, kr, vr)
#pragma unroll 1
    for (int kt = 0; kt < ntk; ++kt) {
      __syncthreads();
      ATTN_STAGE(kr, vr, 0)
      __syncthreads();
      if (kt + 1 < ntk) ATTN_ISSUE(kt + 1, kr, vr)
      tile_body(kt, Ks, Vts);
    }
  } else {
    ATTN_ISSUE(0, kr, vr)
    ATTN_ISSUE(1, kr2, vr2)
#pragma unroll 1
    for (int kt = 0; kt < ntk; kt += 2) {
      __syncthreads();
      ATTN_STAGE(kr, vr, 0)
      ATTN_STAGE(kr2, vr2, 1)
      __syncthreads();
      if (kt + 2 < ntk) {
        ATTN_ISSUE(kt + 2, kr, vr)
        ATTN_ISSUE(kt + 3, kr2, vr2)
      }
      tile_body(kt, Ks, Vts);
      tile_body(kt + 1, Ks + (NBUF - 1) * 64 * KSTR, Vts + (NBUF - 1) * D * 72);
    }
  }

  if constexpr (MODE == 0) {
    if (latent) {
#pragma unroll 1
      for (int dir = 0; dir < 2; ++dir) {
        const float scale = dir == 0 ? __builtin_amdgcn_exp2f(lgf2 * (float)(tq + 1)) : __builtin_amdgcn_exp2f(lgb2 * (float)(L - tq));
        const u16* S0 = WS_S0t + ((size_t)(((l * 4 + b) * 2 + dir) * 4 + hh)) * 16384;
#pragma unroll
        for (int s = 0; s < NKS; ++s) {
          u4v pq = (u4v){pack2(bflo(qf[s][0]) * scale, bfhi(qf[s][0]) * scale), pack2(bflo(qf[s][1]) * scale, bfhi(qf[s][1]) * scale),
                         pack2(bflo(qf[s][2]) * scale, bfhi(qf[s][2]) * scale), pack2(bflo(qf[s][3]) * scale, bfhi(qf[s][3]) * scale)};
#pragma unroll
          for (int nb = 0; nb < NB; ++nb) {
            u4v vf = *(const u4v*)(S0 + (size_t)(nb * 16 + l15) * 128 + s * 32 + g * 8);
            ot[nb] = __builtin_amdgcn_mfma_f32_16x16x32_bf16(bc8(vf), bc8(pq), ot[nb], 0, 0, 0);
          }
        }
      }
    }
    float s = 0.f;
#pragma unroll
    for (int nb = 0; nb < NB; ++nb) s += ot[nb][0] + ot[nb][1] + ot[nb][2] + ot[nb][3];
    s += __shfl_xor(s, 16); s += __shfl_xor(s, 32);
    const float mu = s * (1.f / 128.f);
    float q = 0.f;
#pragma unroll
    for (int nb = 0; nb < NB; ++nb)
#pragma unroll
      for (int r = 0; r < 4; ++r) { float dlt = ot[nb][r] - mu; q += dlt * dlt; }
    q += __shfl_xor(q, 16); q += __shfl_xor(q, 32);
    const float rstd = rsqrtf(q * (1.f / 128.f) + LNEPS);
#pragma unroll
    for (int nb = 0; nb < NB; ++nb) {
      const size_t off = (size_t)qtok * 512 + hh * 128 + nb * 16 + g * 4;
      uint2 gg = *(const uint2*)(WS_G + off);
      float o0 = (ot[nb][0] - mu) * rstd * bflo(gg.x);
      float o1 = (ot[nb][1] - mu) * rstd * bfhi(gg.x);
      float o2 = (ot[nb][2] - mu) * rstd * bflo(gg.y);
      float o3 = (ot[nb][3] - mu) * rstd * bfhi(gg.y);
      *(uint2*)(WS_rout + off) = make_uint2(pack2(o0, o1), pack2(o2, o3));
    }
  } else {
    lsum += __shfl_xor(lsum, 16); lsum += __shfl_xor(lsum, 32);
    const float inv = __builtin_amdgcn_rcpf(lsum);
#pragma unroll
    for (int nb = 0; nb < NB; ++nb) {
      const size_t off = (size_t)qtok * 512 + hh * 64 + nb * 16 + g * 4;
      *(uint2*)(WS_nout + off) = make_uint2(pack2(ot[nb][0] * inv, ot[nb][1] * inv), pack2(ot[nb][2] * inv, ot[nb][3] * inv));
    }
  }
}

__device__ __forceinline__ void retstate_item(const Params& p, int l, int idx) {
  const int dir = idx & 1, hh = (idx >> 1) & 3, b = idx >> 3;
  const int tid = ltid(), lane = tid & 63, wave = tid >> 6;
  const int r = lane & 31, h2 = lane >> 5;
  const float x = p.ret_decay[(l * 2 + dir) * 4 + hh];
  const float lg2 = -log1pf(expf(-x)) * 1.4426950408889634f;
  const u16* Kt = WS_KtR + ((size_t)(b * 4 + hh) * 128) * 256;
  const u16* Vt = WS_VtR + ((size_t)(b * 4 + hh) * 128) * 256;
  f16v acc[4];
#pragma unroll
  for (int i = 0; i < 4; ++i) acc[i] = zero16();
#pragma unroll 2
  for (int ks = 0; ks < 16; ++ks) {
    const int tok0 = ks * 16 + h2 * 8;
    const u4v a = *(const u4v*)(Kt + (size_t)(wave * 32 + r) * 256 + tok0);
    u4v af;
#pragma unroll
    for (int w = 0; w < 4; ++w) {
      const int t0 = tok0 + 2 * w, t1 = t0 + 1;
      float w0 = __builtin_amdgcn_exp2f(lg2 * (float)(dir == 0 ? 255 - t0 : t0));
      float w1 = __builtin_amdgcn_exp2f(lg2 * (float)(dir == 0 ? 255 - t1 : t1));
      af[w] = pack2(bflo(a[w]) * w0, bfhi(a[w]) * w1);
    }
#pragma unroll
    for (int nt = 0; nt < 4; ++nt) {
      const u4v bfr = *(const u4v*)(Vt + (size_t)(nt * 32 + r) * 256 + tok0);
      acc[nt] = __builtin_amdgcn_mfma_f32_32x32x16_bf16(bc8(af), bc8(bfr), acc[nt], 0, 0, 0);
    }
  }
  float* o = p.out + OUT_SRET + ((size_t)(((b * 2 + l) * 2 + dir) * 4 + hh)) * 16384;
#pragma unroll
  for (int nt = 0; nt < 4; ++nt)
#pragma unroll
    for (int reg = 0; reg < 16; ++reg) {
      const int dk = wave * 32 + (reg & 3) + 8 * (reg >> 2) + 4 * h2;
      o[(size_t)dk * 128 + nt * 32 + r] = acc[nt][reg];
    }
}

__device__ __forceinline__ void s5_item(const Params& p, char* smem, int l, int item) {
  const int tid = ltid(), lane = tid & 63, wave = tid >> 6;
  const int l15 = lane & 15, g4 = lane >> 4;
  int seq = item * 4 + wave;
  int b, dir, g, L, tokbase;
  bool latent;
  if (seq < 256) { latent = true; b = seq >> 6; dir = (seq >> 5) & 1; g = seq & 31; L = 1024; tokbase = TCTX + b * 1024; }
  else { seq -= 256; latent = false; b = seq >> 6; dir = (seq >> 5) & 1; g = seq & 31; L = 256; tokbase = b * 256; }
  float* buf = (float*)smem + wave * (16 * 132);
  const int tg = (l * 2 + dir) * 32 + g;
  const float ar = WS_abar[(tg * 64 + lane) * 2], ai = WS_abar[(tg * 64 + lane) * 2 + 1];
  u4v bfrag[8];
#pragma unroll
  for (int nt = 0; nt < 8; ++nt) {
    if (g4 < 2) bfrag[nt] = *(const u4v*)(WS_bbarT + ((size_t)tg * 128 + nt * 16 + l15) * 16 + g4 * 8);
    else bfrag[nt] = (u4v){0u, 0u, 0u, 0u};
  }
  u4v cfrag[4];
#pragma unroll
  for (int ks = 0; ks < 4; ++ks) cfrag[ks] = *(const u4v*)(WS_cmT + ((size_t)tg * 16 + l15) * 128 + ks * 32 + g4 * 8);
  float xr = 0.f, xi = 0.f;
  if (latent) {
    const float* h0 = p.state_ssm + ((size_t)(((b * 2 + l) * 2 + dir) * 32 + g) * 64 + lane) * 2;
    xr = h0[0]; xi = h0[1];
  }
  u16* yd = WS_YD + (size_t)dir * TALL * 512;
  __syncthreads();
  const int nsub = L >> 4;
  u4v afn = (u4v){0u, 0u, 0u, 0u};
  if (g4 < 2) {
    const int pos = dir == 0 ? l15 : L - 1 - l15;
    afn = *(const u4v*)(WS_SU + (size_t)(tokbase + pos) * 512 + g * 16 + g4 * 8);
  }
#pragma unroll 1
  for (int sub = 0; sub < nsub; ++sub) {
    const u4v af = afn;
    if (g4 < 2 && sub + 1 < nsub) {
      const int tau = (sub + 1) * 16 + l15;
      const int pos = dir == 0 ? tau : L - 1 - tau;
      afn = *(const u4v*)(WS_SU + (size_t)(tokbase + pos) * 512 + g * 16 + g4 * 8);
    }
#pragma unroll
    for (int nt = 0; nt < 8; ++nt) {
      f4v c = (f4v){0.f, 0.f, 0.f, 0.f};
      c = __builtin_amdgcn_mfma_f32_16x16x32_bf16(bc8(af), bc8(bfrag[nt]), c, 0, 0, 0);
#pragma unroll
      for (int r = 0; r < 4; ++r) buf[(g4 * 4 + r) * 132 + nt * 16 + l15] = c[r];
    }
    __builtin_amdgcn_wave_barrier();
#pragma unroll
    for (int i = 0; i < 16; ++i) {
      const float bur = buf[i * 132 + lane], bui = buf[i * 132 + 64 + lane];
      const float nr = ar * xr - ai * xi + bur;
      const float ni = ar * xi + ai * xr + bui;
      xr = nr; xi = ni;
      buf[i * 132 + lane] = xr;
      buf[i * 132 + 64 + lane] = xi;
    }
    __builtin_amdgcn_wave_barrier();
    f4v y = (f4v){0.f, 0.f, 0.f, 0.f};
#pragma unroll
    for (int ks = 0; ks < 4; ++ks) {
      const float* bp = buf + l15 * 132 + ks * 32 + g4 * 8;
      float4 v0 = *(const float4*)(bp), v1 = *(const float4*)(bp + 4);
      const u4v xa = (u4v){pack2(v0.x, v0.y), pack2(v0.z, v0.w), pack2(v1.x, v1.y), pack2(v1.z, v1.w)};
      y = __builtin_amdgcn_mfma_f32_16x16x32_bf16(bc8(xa), bc8(cfrag[ks]), y, 0, 0, 0);
    }
#pragma unroll
    for (int r = 0; r < 4; ++r) {
      const int tau = sub * 16 + g4 * 4 + r;
      const int pos = dir == 0 ? tau : L - 1 - tau;
      yd[(size_t)(tokbase + pos) * 512 + g * 16 + l15] = f2bf(y[r]);
    }
    __builtin_amdgcn_wave_barrier();
  }
  if (!latent) {
    float* o = p.out + OUT_SSSM + ((size_t)(((b * 2 + l) * 2 + dir) * 32 + g) * 64 + lane) * 2;
    o[0] = xr; o[1] = xi;
  }
}

#define MX_S5 320
#define MX_RET 512
#define MX_NA 512
#define MX_CA 512
#define MX_RS 128
#define MX_ITEMS (MX_S5 + MX_RET + MX_NA + MX_CA + MX_RS)
__device__ __forceinline__ void mixer_item(const Params& p, char* smem, int l, int item) {
  if (item < 64) { s5_item(p, smem, l, item); return; }
  item -= 64;
  if (item < 256) { attn_item<128, 0>(p, smem, l, item); return; }
  item -= 256;
  if (item < 512) { attn_item<64, 2>(p, smem, l, item); return; }
  item -= 512;
  if (item < 256) { s5_item(p, smem, l, 64 + item); return; }
  item -= 256;
  if (item < 256) { attn_item<128, 0>(p, smem, l, 256 + item); return; }
  item -= 256;
  if (item < 512) { attn_item<64, 1>(p, smem, l, item); return; }
  item -= 512;
  retstate_item(p, l, item);
}

__device__ __forceinline__ void p3a_item(const Params& p, char* smem, int l, int item) {
  const int mt = item & 63, nt = item >> 6;
  const int m0 = mt * 128, n0 = nt * 128;
  const int tid = ltid(), lane = tid & 63, wave = tid >> 6, wm = wave >> 1, wn = wave & 1;
  AArgs a{};
  a.SU = WS_SU; a.YD0 = WS_YD; a.YD1 = WS_YD + (size_t)TALL * 512; a.dsk = p.ssm_d + l * 512;
  f16v acc[2][2];
  gemm_mainloop<2>(smem, a, WS_Wt + WT_LAYER * l + WT_GLU, 512, 512, m0, n0, acc);
#pragma unroll
  for (int mi = 0; mi < 2; ++mi)
#pragma unroll
    for (int reg = 0; reg < 16; ++reg) {
      const int row = EPI_ROW(mi, reg);
#pragma unroll
      for (int ni = 0; ni < 2; ++ni) {
        const int col = EPI_COL(ni);
        const size_t off = (size_t)row * 512 + col;
        float y = geluf_(a.dsk[col] * bf2f(WS_SU[off]) + bf2f(a.YD0[off]) + bf2f(a.YD1[off]));
        WS_sout[off] = f2bf(y * sigmoidf_(acc[mi][ni][reg]));
      }
    }
}

__device__ __forceinline__ void p3b_item(const Params& p, char* smem, int l, int item) {
  const int mt = item & 63, nt = item >> 6;
  const int m0 = mt * 128, n0 = nt * 128;
  const int tid = ltid(), lane = tid & 63, wave = tid >> 6, wm = wave >> 1, wn = wave & 1;
  int nbr = 3;
  asm volatile("" : "+s"(nbr));
#pragma unroll 1
  for (int br = 0; br < nbr; ++br) {
    const u16* Abr = br == 0 ? WS_rout : (br == 1 ? WS_sout : WS_nout);
    f16v acc[2][2];
    gemm_mainloop0(smem, Abr, 512, WS_Wt + WT_LAYER * l + WT_BR + (size_t)br * 512 * 1024, 512, 512, m0, n0, acc);
    u16* Cs = (u16*)smem;
    {
      const int rl0 = wm * 64 + 4 * (lane >> 5), cl0 = wn * 64 + (lane & 31);
#pragma unroll
      for (int mi = 0; mi < 2; ++mi)
#pragma unroll
        for (int reg = 0; reg < 16; ++reg) {
          const int rl = rl0 + mi * 32 + (reg & 3) + 8 * (reg >> 2);
          Cs[rl * CST + cl0] = f2bf(acc[mi][0][reg]);
          Cs[rl * CST + cl0 + 32] = f2bf(acc[mi][1][reg]);
        }
    }
    __syncthreads();
    int tl = tid;
    asm volatile("" : "+v"(tl));
#pragma unroll
    for (int i = 0; i < 8; ++i) {
      const int c = tl + 256 * i, r = c >> 4, ch = c & 15;
      const u4v av = *(const u4v*)(Cs + r * CST + ch * 8);
      const u4v gv = *(const u4v*)(WS_GT + (size_t)(m0 + r) * 3072 + br * 1024 + n0 + ch * 8);
      u16* mp = WS_merged + (size_t)(m0 + r) * 1024 + n0 + ch * 8;
      u4v mv = (u4v){0u, 0u, 0u, 0u};
      if (br > 0) mv = *(const u4v*)mp;
      u4v ov;
#pragma unroll
      for (int j = 0; j < 4; ++j)
        ov[j] = pack2(fmaf(bflo(gv[j]), bflo(av[j]), bflo(mv[j])), fmaf(bfhi(gv[j]), bfhi(av[j]), bfhi(mv[j])));
      *(u4v*)mp = ov;
    }
  }
}


#define CFS 132
__device__ __forceinline__ void epi_resid(char* smem, f16v (&acc)[2][2], int m0, int n0, const float* __restrict__ gvec,
                                          const float* __restrict__ xlo, const float* __restrict__ xhi,
                                          const float* __restrict__ xstats, const float* __restrict__ lng,
                                          const float* __restrict__ lnb, float* __restrict__ dst,
                                          float* __restrict__ stats_out, bool do_stats) {
  float* Cf = (float*)smem;
  const int tid = ltid(), lane = tid & 63, wave = tid >> 6, wm = wave >> 1, wn = wave & 1;
  {
    const int rl0 = wm * 64 + 4 * (lane >> 5), cl0 = wn * 64 + (lane & 31);
    const float ga = gvec[n0 + cl0], gb = gvec[n0 + cl0 + 32];
#pragma unroll
    for (int mi = 0; mi < 2; ++mi)
#pragma unroll
      for (int reg = 0; reg < 16; ++reg) {
        const int rl = rl0 + mi * 32 + (reg & 3) + 8 * (reg >> 2);
        Cf[rl * CFS + cl0] = ga * acc[mi][0][reg];
        Cf[rl * CFS + cl0 + 32] = gb * acc[mi][1][reg];
      }
  }
  __syncthreads();
  const int ch = tid & 31, r0 = tid >> 5;
  const int col = n0 + ch * 4;
  float4 g4 = make_float4(1.f, 1.f, 1.f, 1.f), b4 = make_float4(0.f, 0.f, 0.f, 0.f);
  if (xstats) { g4 = *(const float4*)(lng + col); b4 = *(const float4*)(lnb + col); }
  const float* xbase = (m0 < TCTX ? xlo + (size_t)m0 * 1024 : xhi + (size_t)(m0 - TCTX) * 1024) + col;
#pragma unroll 4
  for (int i = 0; i < 16; ++i) {
    const int r = r0 + 8 * i;
    const int row = m0 + r;
    const float4 v = *(const float4*)(Cf + r * CFS + ch * 4);
    float4 x = *(const float4*)(xbase + (size_t)r * 1024);
    if (xstats) {
      const float s = xstats[row * 2], q = xstats[row * 2 + 1];
      const float mu = s * (1.f / 1024.f);
      const float rstd = rsqrtf(fmaxf(q * (1.f / 1024.f) - mu * mu, 0.f) + LNEPS);
      x.x = (x.x - mu) * rstd * g4.x + b4.x; x.y = (x.y - mu) * rstd * g4.y + b4.y;
      x.z = (x.z - mu) * rstd * g4.z + b4.z; x.w = (x.w - mu) * rstd * g4.w + b4.w;
    }
    float4 o;
    o.x = ALPHA * x.x + v.x; o.y = ALPHA * x.y + v.y; o.z = ALPHA * x.z + v.z; o.w = ALPHA * x.w + v.w;
    *(float4*)(dst + (size_t)row * 1024 + col) = o;
    if (do_stats) {
      float ss = o.x + o.y + o.z + o.w, qq = o.x * o.x + o.y * o.y + o.z * o.z + o.w * o.w;
#pragma unroll
      for (int sh = 1; sh < 32; sh <<= 1) { ss += __shfl_xor(ss, sh); qq += __shfl_xor(qq, sh); }
      if (ch == 0) { atomicAdd(stats_out + row * 2, ss); atomicAdd(stats_out + row * 2 + 1, qq); }
    }
  }
}

__device__ __forceinline__ void p3c_item(const Params& p, char* smem, int l, int item, bool do_stats = true) {
  const int mt = item & 63, nt = item >> 6;
  const int m0 = mt * 128, n0 = nt * 128;
  const int tid = ltid(), lane = tid & 63, wave = tid >> 6, wm = wave >> 1, wn = wave & 1;
  f16v acc[2][2];
  gemm_mainloop0(smem, WS_merged, 1024, WS_Wt + WT_LAYER * l + WT_O, 1024, 1024, m0, n0, acc);
  const int ci = cond_of_row(m0);
  const float* g1 = WS_mod + (l * 5 + ci) * 6144 + 2048;
  float* st1 = WS_stats + (size_t)(l * 2 + 0) * TALL * 2;
  if (l == 0)
    epi_resid(smem, acc, m0, n0, g1, p.x_prompt, p.x_sample, nullptr, nullptr, nullptr, WS_pre1, st1, do_stats);
  else
    epi_resid(smem, acc, m0, n0, g1, p.out, p.out + (size_t)TCTX * 1024, WS_stats + (size_t)(0 * 2 + 1) * TALL * 2, p.ln2_g, p.ln2_b,
              WS_pre1, st1, do_stats);
}

__device__ __forceinline__ void p4_item(const Params& p, char* smem, int l, int item) {
  const int mt = item & 63, nt = item >> 6;
  const int m0 = mt * 128, n0 = nt * 128;
  const int tid = ltid(), lane = tid & 63, wave = tid >> 6, wm = wave >> 1, wn = wave & 1;
  f16v acc[2][2];
  gemm_mainloop0(smem, WS_h2, 1024, WS_Wt + WT_LAYER * l + WT_UP, 1024, 1024, m0, n0, acc);
  u16* Cs = (u16*)smem;
  const int rl0 = wm * 64 + 4 * (lane >> 5), cl0 = wn * 64 + (lane & 31);
#pragma unroll
  for (int mi = 0; mi < 2; ++mi)
#pragma unroll
    for (int reg = 0; reg < 16; ++reg) {
      const int rl = rl0 + mi * 32 + (reg & 3) + 8 * (reg >> 2);
      Cs[rl * CST + cl0] = f2bf(acc[mi][0][reg]);
      Cs[rl * CST + cl0 + 32] = f2bf(acc[mi][1][reg]);
    }
  __syncthreads();
  cs_store(Cs, WS_z2 + (size_t)m0 * 5632 + n0, 5632, tid);
}

__device__ __forceinline__ void p4b_item(const Params& p, int l, int item) {
  const int tid = ltid();
  if (tid >= 176) return;
  const int rb = item >> 1, hf = item & 1;
  const int j0 = (hf * 176 + tid) * 8;
  const float* cw = p.conv_w + (size_t)l * 3 * 5632;
  const float* cb = p.conv_b + (size_t)l * 5632;
  float wa[3][8], wb[3][8], ba[8], bb[8];
#pragma unroll
  for (int t = 0; t < 3; ++t)
#pragma unroll
    for (int h = 0; h < 2; ++h) {
      const float4 x = *(const float4*)(cw + t * 5632 + j0 + 4 * h), y = *(const float4*)(cw + t * 5632 + 2816 + j0 + 4 * h);
      wa[t][4 * h] = x.x; wa[t][4 * h + 1] = x.y; wa[t][4 * h + 2] = x.z; wa[t][4 * h + 3] = x.w;
      wb[t][4 * h] = y.x; wb[t][4 * h + 1] = y.y; wb[t][4 * h + 2] = y.z; wb[t][4 * h + 3] = y.w;
    }
#pragma unroll
  for (int h = 0; h < 2; ++h) {
    const float4 x = *(const float4*)(cb + j0 + 4 * h), y = *(const float4*)(cb + 2816 + j0 + 4 * h);
    ba[4 * h] = x.x; ba[4 * h + 1] = x.y; ba[4 * h + 2] = x.z; ba[4 * h + 3] = x.w;
    bb[4 * h] = y.x; bb[4 * h + 1] = y.y; bb[4 * h + 2] = y.z; bb[4 * h + 3] = y.w;
  }
  const int row0 = rb * 32;
  int pos0, L;
  if (row0 < TCTX) { pos0 = row0 & 255; L = 256; } else { pos0 = (row0 - TCTX) & 1023; L = 1024; }
  const u16* zr = WS_z2 + (size_t)row0 * 5632 + j0;
  const u4v zero = (u4v){0u, 0u, 0u, 0u};
  u4v pa = zero, pb = zero;
  if (pos0 > 0) { pa = *(const u4v*)(zr - 5632); pb = *(const u4v*)(zr - 5632 + 2816); }
  u4v ca = *(const u4v*)(zr), cb2 = *(const u4v*)(zr + 2816);
#pragma unroll 2
  for (int r = 0; r < 32; ++r) {
    u4v na = zero, nb = zero;
    if (pos0 + r < L - 1) { na = *(const u4v*)(zr + (size_t)(r + 1) * 5632); nb = *(const u4v*)(zr + (size_t)(r + 1) * 5632 + 2816); }
    u4v ov;
#pragma unroll
    for (int w = 0; w < 4; ++w) {
      const float a0 = wa[0][2 * w] * bflo(pa[w]) + wa[1][2 * w] * bflo(ca[w]) + wa[2][2 * w] * bflo(na[w]) + ba[2 * w];
      const float a1 = wa[0][2 * w + 1] * bfhi(pa[w]) + wa[1][2 * w + 1] * bfhi(ca[w]) + wa[2][2 * w + 1] * bfhi(na[w]) + ba[2 * w + 1];
      const float b0 = wb[0][2 * w] * bflo(pb[w]) + wb[1][2 * w] * bflo(cb2[w]) + wb[2][2 * w] * bflo(nb[w]) + bb[2 * w];
      const float b1 = wb[0][2 * w + 1] * bfhi(pb[w]) + wb[1][2 * w + 1] * bfhi(cb2[w]) + wb[2][2 * w + 1] * bfhi(nb[w]) + bb[2 * w + 1];
      ov[w] = pack2(geluf_(a0) * b0, geluf_(a1) * b1);
    }
    *(u4v*)(WS_act + (size_t)(row0 + r) * 2816 + j0) = ov;
    pa = ca; pb = cb2; ca = na; cb2 = nb;
  }
}

__device__ __forceinline__ void p5_item(const Params& p, char* smem, int l, int item, bool do_stats = true) {
  const int mt = item & 63, nt = item >> 6;
  const int m0 = mt * 128, n0 = nt * 128;
  const int tid = ltid(), lane = tid & 63, wave = tid >> 6, wm = wave >> 1, wn = wave & 1;
  f16v acc[2][2];
  gemm_mainloop0(smem, WS_act, 2816, WS_Wt + WT_LAYER * l + WT_DOWN, 2816, 2816, m0, n0, acc);
  const int ci = cond_of_row(m0);
  const float* g2 = WS_mod + (l * 5 + ci) * 6144 + 5 * 1024;
  epi_resid(smem, acc, m0, n0, g2, WS_pre1, WS_pre1 + (size_t)TCTX * 1024, WS_stats + (size_t)(l * 2 + 0) * TALL * 2,
            p.ln1_g + l * 1024, p.ln1_b + l * 1024, p.out, WS_stats + (size_t)(l * 2 + 1) * TALL * 2, do_stats);
}

__device__ __forceinline__ void final_item(const Params& p, int item) {
  const float* st = WS_stats + (size_t)(1 * 2 + 1) * TALL * 2;
  const int c = ltid() * 4;
  const float4 g = *(const float4*)(p.ln2_g + 1024 + c);
  const float4 b = *(const float4*)(p.ln2_b + 1024 + c);
  for (int r = 0; r < 8; ++r) {
    const int row = item * 8 + r;
    const float s = st[row * 2], q = st[row * 2 + 1];
    const float mu = s * (1.f / 1024.f);
    const float rstd = rsqrtf(fmaxf(q * (1.f / 1024.f) - mu * mu, 0.f) + LNEPS);
    float4 v = *(float4*)(p.out + (size_t)row * 1024 + c);
    v.x = (v.x - mu) * rstd * g.x + b.x;
    v.y = (v.y - mu) * rstd * g.y + b.y;
    v.z = (v.z - mu) * rstd * g.z + b.z;
    v.w = (v.w - mu) * rstd * g.w + b.w;
    *(float4*)(p.out + (size_t)row * 1024 + c) = v;
  }
}

#define XB_TMO      128
#define XB_XCNT(j)  (256  + 64 * (j))
#define XB_XSUB(j)  (1280 + 64 * (j))
#define XB_XGEN(j)  (2304 + 64 * (j))
#define XB_TOP      3328
#define XB_TOPGEN   3392
#define XCD_BAR_WORDS 3456
#define XB_SPIN_CAP (1u << 18)
#define LAS __attribute__((address_space(3)))

__device__ __forceinline__ unsigned xb_ld(unsigned* p)              { return __hip_atomic_load(p, __ATOMIC_RELAXED, __HIP_MEMORY_SCOPE_AGENT); }
__device__ __forceinline__ unsigned xb_add(unsigned* p, unsigned v) { return __hip_atomic_fetch_add(p, v, __ATOMIC_RELAXED, __HIP_MEMORY_SCOPE_AGENT); }
__device__ __forceinline__ unsigned xb_xcc_id() { return (unsigned)__builtin_amdgcn_s_getreg((3 << 11) | 20) & 0xFu; }
#define XB_SPIN(cond, bar) do { unsigned _sp = 0; while (cond) { __builtin_amdgcn_s_sleep(1); \
    if ((++_sp & 255u) == 0u) { if (xb_ld(&(bar)[XB_TMO])) break; if (_sp > XB_SPIN_CAP) { atomicAdd(&(bar)[XB_TMO], 1u); break; } } } } while (0)

struct XcdBarrier {
    unsigned* bar; unsigned x;
    volatile LAS unsigned* st;
};

__device__ __forceinline__ XcdBarrier xcd_barrier_post(unsigned* bar, volatile LAS unsigned* st) {
    XcdBarrier b; b.bar = bar; b.x = xb_xcc_id(); b.st = st;
    if (threadIdx.x == 0) (void)xb_add(&bar[XB_XCNT(b.x)], 1u);
    return b;
}
__device__ __forceinline__ void xcd_barrier_complete(unsigned* bar, unsigned x, unsigned& nloc, unsigned& nx) {
    const unsigned G = gridDim.x * gridDim.y * gridDim.z;
    unsigned sum, cnt, mine, sp = 0u;
    for (;;) {
        sum = 0u; cnt = 0u; mine = 0u;
#pragma unroll
        for (unsigned j = 0; j < 16; ++j) { const unsigned c = xb_ld(&bar[XB_XCNT(j)]); sum += c; cnt += (c > 0u) ? 1u : 0u; mine = (j == x) ? c : mine; }
        if (sum == G) break;
        __builtin_amdgcn_s_sleep(1);
        if ((++sp & 255u) == 0u) { if (xb_ld(&bar[XB_TMO])) break; if (sp > XB_SPIN_CAP) { atomicAdd(&bar[XB_TMO], 1u); break; } }
    }
    nloc = mine > 0u ? mine : 1u; nx = cnt > 0u ? cnt : 1u;
}

__device__ __forceinline__ void xcd_barrier(const XcdBarrier& b) {
    asm volatile("s_waitcnt vmcnt(0)" ::: "memory");
    __syncthreads();
    if (threadIdx.x == 0) {
        unsigned* bar = b.bar;
        __builtin_amdgcn_s_waitcnt(0);
        unsigned nloc = b.st[0], nx = b.st[1];
        if (nloc == 0u) { xcd_barrier_complete(bar, b.x, nloc, nx); b.st[0] = nloc; b.st[1] = nx; }
        const unsigned old = xb_add(&bar[XB_XSUB(b.x)], 1u);
        const unsigned gen = old / nloc;
        if (old + 1u == (gen + 1u) * nloc) {
            __builtin_amdgcn_fence(__ATOMIC_RELEASE, "agent");
            asm volatile("s_waitcnt vmcnt(0)" ::: "memory");
            const unsigned og = xb_add(&bar[XB_TOP], 1u);
            const unsigned tg = og / nx;
            if (og + 1u == (tg + 1u) * nx) xb_add(&bar[XB_TOPGEN], 1u);
            else XB_SPIN(xb_ld(&bar[XB_TOPGEN]) == tg, bar);
            __builtin_amdgcn_fence(__ATOMIC_ACQUIRE, "agent");
            xb_add(&bar[XB_XGEN(b.x)], 1u);
            asm volatile("s_waitcnt vmcnt(0)" ::: "memory");
        } else {
            XB_SPIN(xb_ld(&bar[XB_XGEN(b.x)]) == gen, bar);
            __builtin_amdgcn_fence(__ATOMIC_ACQUIRE, "agent");
            asm volatile("s_waitcnt vmcnt(0)" ::: "memory");
        }
    }
    __syncthreads();
}


#define NPHASES 22
#ifndef REPMASK
#define REPMASK 0
#endif
#define REPS(PH) (((PH) == 0 ? (REPMASK >> 10) : (PH) == 21 ? (REPMASK >> 11) : (REPMASK >> (((PH) - 1) % 10))) & 1)
#define RUN_PHASE(PH, N, CALL)                                              \
  if (ph_lo <= (PH) && (PH) < ph_hi) {                                      \
    for (int rep_ = 0; rep_ <= REPS(PH); ++rep_)                            \
    for (int it = blockIdx.x; it < (N); it += nb) { CALL; }                 \
    if ((PH) + 1 < ph_hi) xcd_barrier(xb);                                  \
  }
#define RUN_GEMM_PHASE(PH, NT, CALL)                                                          \
  if (ph_lo <= (PH) && (PH) < ph_hi) {                                                        \
    const int xcd_ = blockIdx.x & 7, slot_ = blockIdx.x >> 3, spx_ = (int)gridDim.x >> 3;      \
    const int nsuper_ = 8 * (((NT) + 7) >> 3);                                                \
    for (int rep_ = 0; rep_ <= REPS(PH); ++rep_)                                              \
    for (int s_ = xcd_; s_ < nsuper_; s_ += 8)                                                \
      for (int j_ = slot_; j_ < 64; j_ += spx_) {                                             \
        const int mt_ = (s_ & 7) * 8 + (j_ & 7), nt_ = (s_ >> 3) * 8 + (j_ >> 3);             \
        if (nt_ < (NT)) { const int it = nt_ * 64 + mt_; CALL; }                              \
      }                                                                                       \
    if ((PH) + 1 < ph_hi) xcd_barrier(xb);                                                    \
  }
#define RUN_MIXER_PHASE(PH, L)                                                                \
  if (ph_lo <= (PH) && (PH) < ph_hi) {                                                        \
    for (int rep_ = 0; rep_ <= REPS(PH); ++rep_) {                                            \
      unsigned* ctr_ = (unsigned*)(p.ws + OFF_ctr) + 64 * (2 * (L) + rep_);                   \
      for (;;) {                                                                              \
        __syncthreads();                                                                      \
        if (threadIdx.x == 0) wq_item = (int)atomicAdd(ctr_, 1u);                             \
        __syncthreads();                                                                      \
        const int it = wq_item;                                                               \
        if (it >= MX_ITEMS) break;                                                            \
        mixer_item(p, smem, (L), it);                                                         \
      }                                                                                       \
    }                                                                                         \
    if ((PH) + 1 < ph_hi) xcd_barrier(xb);                                                    \
  }
#define RUN_P3A_PHASE(PH, L)                                                                  \
  if (ph_lo <= (PH) && (PH) < ph_hi) {                                                        \
    const int xcd_ = blockIdx.x & 7, slot_ = blockIdx.x >> 3, spx_ = (int)gridDim.x >> 3;      \
    for (int rep_ = 0; rep_ <= REPS(PH); ++rep_)                                              \
      for (int j_ = slot_; j_ < 32; j_ += spx_) {                                             \
        const int it = (j_ >> 3) * 64 + xcd_ * 8 + (j_ & 7);                                  \
        p3a_item(p, smem, (L), it);                                                           \
      }                                                                                       \
    {                                                                                         \
        \
      const int nlate_ = P0_WT_PER_LAYER - WT_EARLY;                                          \
      const int nup_ = 16 * 88 + 44 * 16;                                                     \
      const int nwork_ = (L) == 0 ? nlate_ + (P0_WT_PER_LAYER - nup_) : nup_;                 \
      const int nidle_ = spx_ > 32 ? 8 * (spx_ - 32) : 0;                                     \
      const int w0_ = nidle_ == 0 ? (int)blockIdx.x : (slot_ >= 32 ? xcd_ * (spx_ - 32) + (slot_ - 32) : nwork_); \
      const int wst_ = nidle_ == 0 ? nb : nidle_;                                             \
      for (int w_ = w0_; w_ < nwork_; w_ += wst_) {                                           \
        int wi_;                                                                              \
        if ((L) == 0) wi_ = w_ < nlate_ ? WT_EARLY + w_ : P0_WT_PER_LAYER + (w_ - nlate_);    \
        else wi_ = P0_WT_PER_LAYER + (P0_WT_PER_LAYER - nup_) + w_;                           \
        wt_item(p, smem, wi_);                                                                \
      }                                                                                       \
    }                                                                                         \
    if ((PH) + 1 < ph_hi) xcd_barrier(xb);                                                    \
  }
#define RUN_LAYER(L)                                                         \
  RUN_PHASE(1 + 10 * (L) + 0, 1024, hmat_item(p, (L), 0, it))                \
  RUN_GEMM_PHASE(1 + 10 * (L) + 1, 56, p1_item(p, smem, (L), it))            \
  RUN_MIXER_PHASE(1 + 10 * (L) + 2, (L))                                     \
  RUN_P3A_PHASE(1 + 10 * (L) + 3, (L))                                       \
  RUN_GEMM_PHASE(1 + 10 * (L) + 4, 8, p3b_item(p, smem, (L), it))            \
  RUN_GEMM_PHASE(1 + 10 * (L) + 5, 8, p3c_item(p, smem, (L), it, rep_ == 0)) \
  RUN_PHASE(1 + 10 * (L) + 6, 1024, hmat_item(p, (L), 1, it))                \
  RUN_GEMM_PHASE(1 + 10 * (L) + 7, 44, p4_item(p, smem, (L), it))            \
  RUN_PHASE(1 + 10 * (L) + 8, 512, p4b_item(p, (L), it))                     \
  RUN_GEMM_PHASE(1 + 10 * (L) + 9, 8, p5_item(p, smem, (L), it, rep_ == 0))

__global__ void __launch_bounds__(256, 2) mega(Params p, int ph_lo, int ph_hi) {
  extern __shared__ __attribute__((aligned(16))) char smem[];
  __shared__ uint4 xb_words;
  __shared__ int wq_item;
  const int nb = gridDim.x;
  if (threadIdx.x == 0) xb_words = make_uint4(0u, 0u, 0u, 0u);
  __syncthreads();
  XcdBarrier xb;
  xb.bar = (unsigned*)(p.ws + OFF_bar); xb.x = 0; xb.st = (volatile LAS unsigned*)&xb_words;
  if (ph_hi - ph_lo > 1) xb = xcd_barrier_post((unsigned*)(p.ws + OFF_bar), (volatile LAS unsigned*)&xb_words);
  if (ph_hi > 1000) cg::this_grid().sync();
  RUN_PHASE(0, P0_ITEMS, phase0_item(p, smem, it))
  RUN_LAYER(0)
  RUN_LAYER(1)
  RUN_PHASE(21, 1024, final_item(p, it))
}

extern "C" void kernel_launch(void* const* d_in, const int* in_sizes, int n_in, void* d_out, int out_size, void* d_ws,
                              size_t ws_size, hipStream_t stream) {
  Params p{};
  const float** ins = (const float**)&p;
  for (int i = 0; i < 32; ++i) ins[i] = (const float*)d_in[i];
  p.out = (float*)d_out;
  char* ws = (char*)d_ws;
  p.ws = ws;
  if (WS_TOTAL > ws_size) {
    fprintf(stderr, "kernel_launch: workspace too small (%zu needed, %zu given)\n", (size_t)WS_TOTAL, ws_size);
    return;
  }
  (void)hipMemsetAsync(ws, 0, ZERO_BYTES, stream);
#if SINGLE_LAUNCH
  static int grid_blocks = 0;
  if (!grid_blocks) {
    int dev = 0, cus = 0, per_cu = 0;
    (void)hipGetDevice(&dev);
    (void)hipDeviceGetAttribute(&cus, hipDeviceAttributeMultiprocessorCount, dev);
    (void)hipFuncSetAttribute((const void*)mega, hipFuncAttributeMaxDynamicSharedMemorySize, LDS_BYTES);
    (void)hipOccupancyMaxActiveBlocksPerMultiprocessor(&per_cu, mega, 256, LDS_BYTES);
    if (per_cu > 2) per_cu = 2;
    if (per_cu < 1) per_cu = 1;
    grid_blocks = (cus * per_cu) & ~7;
  }
  int lo = 0, hi = NPHASES;
  void* args[] = {&p, &lo, &hi};
  hipError_t e = hipLaunchCooperativeKernel((void*)mega, dim3(grid_blocks), dim3(256), args, LDS_BYTES, stream);
  if (e != hipSuccess) fprintf(stderr, "cooperative launch failed: %s (grid %d)\n", hipGetErrorString(e), grid_blocks);
#else
  for (int ph = 0; ph < NPHASES; ++ph) {
    hipLaunchKernelGGL(mega, dim3(512), dim3(256), LDS_BYTES, stream, p, ph, ph + 1);
  }
#endif
}
```
